# Optimizing an MI355X kernel written in HIP

```python
import math
import jax, jax.numpy as jnp
from jax import lax
import numpy as np

D_MODEL = 1024
BATCH = 16
SEQ = 4096
DEPTH = 4

N_MIXERS = 2
N_ATTN_LAYERS = (DEPTH + 1) // 2
N_CONV_LAYERS = DEPTH // 2
N_HEADS = 8
HEAD_DIM = D_MODEL // N_HEADS // 2
V_DIM = 2 * HEAD_DIM
Q_BLOCK = 128
NUM_BUCKETS = 32
MAX_DISTANCE = 128
CONV_WIDTH = 3
N_EXPERTS = 32
TOP_K = 4
D_EXPERT = D_MODEL
SWIGLU_ALPHA = 1.702
SWIGLU_LIMIT = 7.0
MOE_BLOCK = 512
DEEPNORM_ALPHA = (2.0 * DEPTH) ** 0.25
DEEPNORM_BETA = (8.0 * DEPTH) ** -0.25
LN_EPS = 1e-5

kernel_name = "hybrid_diffattn_shortconv_moe_encoder"


def layer_norm(x, g, b):
    xf = x.astype(jnp.float32)
    mu = jnp.mean(xf, axis=-1, keepdims=True)
    var = jnp.mean(jnp.square(xf - mu), axis=-1, keepdims=True)
    y = (xf - mu) * lax.rsqrt(var + LN_EPS) * g.astype(jnp.float32) + b.astype(jnp.float32)
    return y.astype(x.dtype)


def rms_norm(x, g):
    xf = x.astype(jnp.float32)
    y = xf * lax.rsqrt(jnp.mean(jnp.square(xf), axis=-1, keepdims=True) + LN_EPS) * g.astype(jnp.float32)
    return y.astype(x.dtype)


def rel_bucket(rel):
    nb = NUM_BUCKETS // 2
    max_exact = nb // 2
    ret = jnp.where(rel > 0, nb, 0)
    n = jnp.abs(rel)
    nf = jnp.maximum(n, 1).astype(jnp.float32)
    large = max_exact + (jnp.log(nf / max_exact) / math.log(MAX_DISTANCE / max_exact)
                         * (nb - max_exact)).astype(jnp.int32)
    large = jnp.minimum(large, nb - 1)
    return ret + jnp.where(n < max_exact, n, large)


def diff_attention(x, w_in, w_out, lam_p, subln_g, rel_bias, lambda_init):
    B, S, D = x.shape
    qkv = x @ w_in
    q, k, v = jnp.split(qkv, 3, axis=-1)
    q = q.reshape(B, S, N_HEADS, 2, HEAD_DIM) * (HEAD_DIM ** -0.5)
    k = k.reshape(B, S, N_HEADS, 2, HEAD_DIM)
    v = v.reshape(B, S, N_HEADS, V_DIM)
    lf = lam_p.astype(jnp.float32)
    lam = jnp.exp(jnp.sum(lf[0] * lf[1])) - jnp.exp(jnp.sum(lf[2] * lf[3])) + lambda_init
    nqb = S // Q_BLOCK
    qb = q.reshape(B, nqb, Q_BLOCK, N_HEADS, 2, HEAD_DIM).transpose(1, 0, 2, 3, 4, 5)
    k_pos = jnp.arange(S, dtype=jnp.int32)

    def block(args):
        qblk, start = args
        q_pos = start + jnp.arange(Q_BLOCK, dtype=jnp.int32)
        bucket = rel_bucket(k_pos[None, :] - q_pos[:, None])
        bias = rel_bias[bucket].astype(jnp.float32).transpose(2, 0, 1)
        s = jnp.einsum('bqhmd,bkhmd->bmhqk', qblk, k).astype(jnp.float32) + bias
        a = jax.nn.softmax(s, axis=-1)
        diff = a[:, 0] - lam * a[:, 1]
        return jnp.einsum('bhqk,bkhv->bqhv', diff.astype(v.dtype), v)

    o = lax.map(block, (qb, jnp.arange(nqb, dtype=jnp.int32) * Q_BLOCK))
    o = o.transpose(1, 0, 2, 3, 4).reshape(B, S, N_HEADS, V_DIM)
    o = rms_norm(o, subln_g) * (1.0 - lambda_init)
    return o.reshape(B, S, N_HEADS * V_DIM) @ w_out


def short_conv(x, w_in, conv_w, w_out):
    B, S, D = x.shape
    h = x @ w_in
    gate_b, gate_c, u = jnp.split(h, 3, axis=-1)
    z = gate_c * u
    zc = lax.conv_general_dilated(z, conv_w.reshape(CONV_WIDTH, 1, D).astype(z.dtype),
                                  window_strides=(1,), padding=((CONV_WIDTH // 2, CONV_WIDTH // 2),),
                                  dimension_numbers=('NWC', 'WIO', 'NWC'),
                                  feature_group_count=D)
    return (gate_b * zc) @ w_out


def clamped_swiglu(h):
    glu = jnp.minimum(h[..., ::2], SWIGLU_LIMIT)
    lin = jnp.clip(h[..., 1::2], -SWIGLU_LIMIT, SWIGLU_LIMIT)
    return glu * jax.nn.sigmoid(SWIGLU_ALPHA * glu) * (lin + 1.0)


def moe(x2d, router_w, router_b, w1, b1, w2, b2):
    N, D = x2d.shape
    NK = N * TOP_K
    logits = (x2d @ router_w).astype(jnp.float32) + router_b.astype(jnp.float32)
    top_v, top_e = lax.top_k(logits, TOP_K)
    gates = jax.nn.softmax(top_v, axis=-1)
    flat_e = top_e.reshape(-1).astype(jnp.int32)
    flat_tok = jnp.arange(NK, dtype=jnp.int32) // TOP_K
    flat_g = gates.reshape(-1)
    order = jnp.argsort(flat_e)
    se, st, sg = flat_e[order], flat_tok[order], flat_g[order]
    counts = jnp.bincount(flat_e, length=N_EXPERTS).astype(jnp.int32)
    padded = (counts + MOE_BLOCK - 1) // MOE_BLOCK * MOE_BLOCK
    g_start = jnp.cumsum(counts) - counts
    p_end = jnp.cumsum(padded)
    p_start = p_end - padded
    dest = p_start[se] + jnp.arange(NK, dtype=jnp.int32) - g_start[se]
    n_blocks = (NK + N_EXPERTS * (MOE_BLOCK - 1) + MOE_BLOCK - 1) // MOE_BLOCK
    P = n_blocks * MOE_BLOCK
    row_tok = jnp.zeros((P,), jnp.int32).at[dest].set(st)
    row_gate = jnp.zeros((P,), jnp.float32).at[dest].set(sg)
    blk_e = jnp.minimum(jnp.searchsorted(p_end, jnp.arange(n_blocks, dtype=jnp.int32) * MOE_BLOCK,
                                         side='right'), N_EXPERTS - 1)

    def expert_block(args):
        tok, g, e = args
        h = x2d[tok] @ w1[e] + b1[e]
        y = clamped_swiglu(h) @ w2[e] + b2[e]
        return y * g[:, None].astype(y.dtype)

    rows = lax.map(expert_block, (row_tok.reshape(n_blocks, MOE_BLOCK),
                                  row_gate.reshape(n_blocks, MOE_BLOCK), blk_e))
    return jnp.zeros_like(x2d).at[row_tok].add(rows.reshape(P, D).astype(x2d.dtype))


def setup_inputs(seed: int = 0) -> dict:
    key = jax.random.key(seed)
    ks = jax.random.split(key, 20)
    D, E, F = D_MODEL, N_EXPERTS, D_EXPERT
    nrm = jax.random.normal
    return {
        "x": nrm(ks[0], (BATCH, SEQ, D), jnp.float32),
        "rel_bias": 0.5 * nrm(ks[1], (NUM_BUCKETS, N_HEADS), jnp.float32),
        "attn_w_in": nrm(ks[2], (N_ATTN_LAYERS, D, 3 * D), jnp.float32) * D ** -0.5,
        "attn_lambda": 0.1 * nrm(ks[3], (N_ATTN_LAYERS, 4, HEAD_DIM), jnp.float32),
        "attn_subln": 1.0 + 0.01 * nrm(ks[4], (N_ATTN_LAYERS, V_DIM), jnp.float32),
        "attn_w_out": nrm(ks[5], (N_ATTN_LAYERS, N_HEADS * V_DIM, D), jnp.float32) * (N_HEADS * V_DIM) ** -0.5 * DEEPNORM_BETA,
        "conv_w_in": nrm(ks[6], (N_CONV_LAYERS, D, 3 * D), jnp.float32) * D ** -0.5,
        "conv_w": nrm(ks[7], (N_CONV_LAYERS, CONV_WIDTH, D), jnp.float32) * CONV_WIDTH ** -0.5,
        "conv_w_out": nrm(ks[8], (N_CONV_LAYERS, D, D), jnp.float32) * D ** -0.5 * DEEPNORM_BETA,
        "router_w": nrm(ks[9], (DEPTH, D, E), jnp.float32) * D ** -0.5,
        "router_b": 0.01 * nrm(ks[10], (DEPTH, E), jnp.float32),
        "w1": nrm(ks[11], (DEPTH, E, D, 2 * F), jnp.float32) * D ** -0.5,
        "b1": 0.01 * nrm(ks[12], (DEPTH, E, 2 * F), jnp.float32),
        "w2": nrm(ks[13], (DEPTH, E, F, D), jnp.float32) * F ** -0.5 * DEEPNORM_BETA,
        "b2": 0.01 * nrm(ks[14], (DEPTH, E, D), jnp.float32),
        "ln_g": 1.0 + 0.01 * nrm(ks[15], (DEPTH, 2, D), jnp.float32),
        "ln_b": 0.01 * nrm(ks[16], (DEPTH, 2, D), jnp.float32),
    }


def reference(x, rel_bias, attn_w_in, attn_lambda, attn_subln, attn_w_out,
              conv_w_in, conv_w, conv_w_out, router_w, router_b, w1, b1, w2, b2,
              ln_g, ln_b):
    B, S, D = x.shape
    for i in range(DEPTH):
        j = i // N_MIXERS
        if i % N_MIXERS == 0:
            lambda_init = 0.8 - 0.6 * math.exp(-0.3 * i)
            h = diff_attention(x, attn_w_in[j], attn_w_out[j], attn_lambda[j], attn_subln[j],
                               rel_bias, lambda_init)
        else:
            h = short_conv(x, conv_w_in[j], conv_w[j], conv_w_out[j])
        x = layer_norm(DEEPNORM_ALPHA * x + h, ln_g[i, 0], ln_b[i, 0])
        m = moe(x.reshape(B * S, D), router_w[i], router_b[i], w1[i], b1[i], w2[i], b2[i])
        x = layer_norm(DEEPNORM_ALPHA * x + m.reshape(B, S, D), ln_g[i, 1], ln_b[i, 1])
    return x
```

```cpp
#include <hip/hip_runtime.h>
#include <hip/hip_bf16.h>
#include <cstdio>
#include <cstdint>

constexpr int BATCH = 16, SEQ = 4096, D = 1024, M = BATCH * SEQ, DEPTH = 4, NH = 8, NE = 32, TOPK = 4;
constexpr float LN_EPS = 1e-5f;
constexpr float ALPHA = 1.6817928305074290f;
constexpr float LOG2E = 1.4426950408889634f;
constexpr float QSCALE = 0.125f * LOG2E;
constexpr int LCAP = 65536;
constexpr int MAXRT = 1056;

constexpr size_t MiB = 1ull << 20;
constexpr size_t WS_CTL = 0, CTL_ZERO_BYTES = 1 * MiB;
constexpr size_t WS_WAI = 1 * MiB;
constexpr size_t WS_WAO = WS_WAI + 12 * MiB;
constexpr size_t WS_WCI = WS_WAO + 4 * MiB;
constexpr size_t WS_WCO = WS_WCI + 12 * MiB;
constexpr size_t WS_WR  = WS_WCO + 4 * MiB;
constexpr size_t WS_W1  = WS_WR + 1 * MiB;
constexpr size_t WS_W2  = WS_W1 + 256 * MiB;
constexpr size_t WS_S1  = WS_W2 + 128 * MiB;
constexpr size_t WS_S2  = WS_S1 + 1 * MiB;
constexpr size_t WS_SD  = WS_S2 + 512 * 1024;
constexpr size_t WS_RS  = WS_SD + 64 * 1024;
constexpr size_t WS_XB  = WS_S2 + 1 * MiB;
constexpr size_t WS_XI  = WS_XB + 128 * MiB;
constexpr size_t WS_X8  = WS_XI + 128 * MiB;
constexpr size_t WS_YP  = WS_X8 + 64 * MiB;
constexpr size_t WS_Q   = WS_YP + 128 * MiB;
constexpr size_t WS_K   = WS_Q + 128 * MiB;
constexpr size_t WS_V   = WS_K + 128 * MiB;
constexpr size_t WS_O   = WS_V + 128 * MiB;
constexpr size_t WS_LS  = WS_O + 128 * MiB;
constexpr size_t WS_LG  = WS_LS + 8 * MiB;
constexpr size_t WS_A2  = WS_LG + 8 * MiB;
constexpr size_t WS_Y   = WS_A2 + 264 * MiB;
constexpr size_t WS_WA16 = WS_Y + 513 * MiB;
constexpr size_t WS_WC16 = WS_WA16 + 12 * MiB;
constexpr size_t WS_WAO8 = WS_WC16 + 12 * MiB;
constexpr size_t WS_WCO8 = WS_WAO8 + 2 * MiB;
constexpr size_t WS_END = WS_WCO8 + 2 * MiB;
#ifndef F8_QKV_MASK
#define F8_QKV_MASK 3
#endif
#ifndef F8_CONV_MASK
#define F8_CONV_MASK 3
#endif
#ifndef F8_AOUT_MASK
#define F8_AOUT_MASK 3
#endif
#ifndef F8_COUT_MASK
#define F8_COUT_MASK 3
#endif
constexpr int QM = F8_QKV_MASK, CM = F8_CONV_MASK, AOM = F8_AOUT_MASK, COM = F8_COUT_MASK;
constexpr int NA8 = (AOM & 1) + (AOM >> 1), NO8 = (COM & 1) + (COM >> 1), AJ0 = (AOM & 1) ? 0 : 1, OJ0 = (COM & 1) ? 0 : 1;
constexpr int NA16 = 2 - NA8, NO16 = 2 - NO8, AK0 = (AOM & 1) ? 1 : 0, OK0 = (COM & 1) ? 1 : 0;
constexpr int NQ8 = (QM & 1) + (QM >> 1), NC8 = (CM & 1) + (CM >> 1), QJ0 = (QM & 1) ? 0 : 1, CJ0 = (CM & 1) ? 0 : 1;
constexpr int NQ16 = 2 - NQ8, NC16 = 2 - NC8, QK0 = (QM & 1) ? 1 : 0, CK0 = (CM & 1) ? 1 : 0;
constexpr float F8MAX = 448.0f * 0.999f;
constexpr bool I8P = true;
constexpr float QMAXP = I8P ? 127.0f : 448.0f * 0.999f;
constexpr float YSCALE = 16.0f;
constexpr float A2SCALE = 8.0f;
constexpr int CW_TMO = 0, CW_CODE = 1;
constexpr int CW_BAR = 4096;
constexpr int CW_CNT = 16384;

constexpr int RING_OFF = 0, RING_BYTES = 131072;
constexpr int LDSCTL_OFF = RING_BYTES, MISC_OFF = LDSCTL_OFF + 1024;
constexpr int XL_OFF = LDSCTL_OFF + 4096;
constexpr int LDS_BYTES = 147456;

#define GAS __attribute__((address_space(1)))
#define LAS __attribute__((address_space(3)))
typedef unsigned short bf16_t;
typedef unsigned v4u __attribute__((ext_vector_type(4)));
typedef float f32x4 __attribute__((ext_vector_type(4)));
typedef float f32x2 __attribute__((ext_vector_type(2)));
typedef short bf16x8 __attribute__((ext_vector_type(8)));
typedef float f32x16 __attribute__((ext_vector_type(16)));
typedef short s16x4 __attribute__((ext_vector_type(4)));
typedef GAS unsigned gu32;
#define RLX_AGENT __ATOMIC_RELAXED, __HIP_MEMORY_SCOPE_AGENT
#define LDS_WAIT() asm volatile("s_waitcnt lgkmcnt(0)" ::: "memory")
#define VM_WAIT() asm volatile("s_waitcnt vmcnt(0)" ::: "memory")

__device__ __forceinline__ unsigned cvt_pk_bf16(float lo, float hi) { unsigned r; asm volatile("v_cvt_pk_bf16_f32 %0, %1, %2" : "=v"(r) : "v"(lo), "v"(hi)); return r; }
__device__ __forceinline__ float bf_lo(unsigned u) { return __uint_as_float(u << 16); }
__device__ __forceinline__ float bf_hi(unsigned u) { return __uint_as_float(u & 0xffff0000u); }
__device__ __forceinline__ float wave_sum(float v) {
#pragma unroll
    for (int o = 1; o < 64; o <<= 1) v += __shfl_xor(v, o);
    return v;
}

#ifndef KREP_MOE
#define KREP_MOE 1
#endif
namespace pg8 {
constexpr float KREP_MOE_ = (float)KREP_MOE;
#define PG8_LAS __attribute__((address_space(3)))
constexpr int BM = 256, BK = 64, HALF = 128, HTB = HALF * BK * 2, STAGE_BYTES = 8 * HTB, NXCD = 8, WGM = 8, KD = 1024, NTK = KD / BK;

__host__ __device__ __forceinline__ int lds_byte(int r, int c) { const int st = (r >> 4) * 2 + (c >> 5), rr = r & 15, cc = c & 31, ob = rr * 64 + cc * 2; return st * 1024 + (ob ^ (((ob >> 9) & 1) << 5)); }
__host__ __device__ __forceinline__ void stage_rc(int b, int& R, int& C) { const int st = b / 1024, sb = b % 1024, swz = sb ^ (((sb >> 9) & 1) << 5); R = (st >> 1) * 16 + swz / 64; C = (st & 1) * 32 + (swz % 64) / 2; }
__host__ __device__ __forceinline__ int perm32(int rho) { const int n = rho >> 4, i = rho & 15; return 8 * (i >> 2) + 4 * n + (i & 3); }

struct Unit { int pm, pn, e, valid, lr0; };
__device__ __forceinline__ void dma1k(const void* src, PG8_LAS unsigned char* dst, int lane) {
    __builtin_amdgcn_global_load_lds((const __attribute__((address_space(1))) unsigned*)((const char*)src + lane * 16), (PG8_LAS unsigned*)dst, 16, 0, 0);
}
constexpr int XL_EPI = 4096, XL_GATHER = 1024, XL_BYTES = 2 * (XL_EPI + XL_GATHER);

template <bool F8> struct DenseProbT {
    static constexpr bool GATHER = false;
    static constexpr int RP = F8 ? 1024 : 2048;
    const char* A; const char* Bt; int nM, nN, nwg, G, c, tid;
    __device__ void init(const void* A_, const void* Bt_, int Mrows, int N, int G_, int c_, int tid_) { A = (const char*)A_; Bt = (const char*)Bt_; nM = Mrows / BM; nN = N / BM; nwg = nM * nN; G = G_; c = c_; tid = tid_; }
    __device__ __forceinline__ bool next(int i, Unit& u) const {
        const long L = (long)i * G + c; if (L >= nwg) return false;
        int wgid = (int)L; { const int q = nwg / NXCD, r = nwg % NXCD, xcd = wgid % NXCD, off = wgid / NXCD; wgid = (xcd < r ? xcd * (q + 1) : r * (q + 1) + (xcd - r) * q) + off; }
        const int nig = WGM * nN, gid = wgid / nig, fm = gid * WGM, gsz = (nM - fm) < WGM ? (nM - fm) : WGM;
        u.pm = fm + ((wgid % nig) % gsz); u.pn = (wgid % nig) / gsz; u.e = 0; u.valid = 256; u.lr0 = 0; return true;
    }
    __device__ __forceinline__ void a_off(const Unit& u, const int (&RA)[2], const int (&CA)[2], unsigned (&vo)[2][2]) const {
#pragma unroll
        for (int h = 0; h < 2; ++h)
#pragma unroll
            for (int i = 0; i < 2; ++i) vo[h][i] = (unsigned)((u.pm * BM + h * HALF + RA[i]) * RP + CA[i] * 2);
    }
    __device__ __forceinline__ unsigned a_tile(const Unit& u) const { return (unsigned)u.pm * (unsigned)(BM * RP); }
    __device__ __forceinline__ unsigned b_off(const Unit& u) const { return (unsigned)u.pn * (unsigned)(BM * RP); }    __device__ __forceinline__ void dma_rows(const Unit&, PG8_LAS unsigned char*, int, int) const {}
    __device__ __forceinline__ void a_off_lds(const Unit&, const int (&)[2], const int (&)[2], const PG8_LAS unsigned char*, unsigned (&)[2][2]) const {}
};
typedef DenseProbT<false> DenseProb;

template <bool GATHER_, bool F8> struct MoeProb {
    static constexpr bool GATHER = GATHER_;
    static constexpr int RP = F8 ? 1024 : 2048;
    const char* A; const char* Bt; size_t b_estride; int nN, G, v, RT; const PG8_LAS int* tb; const PG8_LAS int* cn; const int* lslot; int lane, tid;
    __device__ __forceinline__ bool next(int i, Unit& u) const {
        const int L = i * G + v; if (L >= RT * nN) return false;
        const int rt = L / nN; u.pm = rt; u.pn = L - rt * nN;
        const unsigned long long bal = __ballot(lane < 32 && rt >= tb[(lane & 31) + 1]);
        const int e = __builtin_amdgcn_readfirstlane(__popcll(bal)); u.e = e;
        const int tb_e = __builtin_amdgcn_readfirstlane(tb[e]), cn_e = __builtin_amdgcn_readfirstlane(cn[e]);
        u.lr0 = 256 * (rt - tb_e); const int rem = cn_e - u.lr0; u.valid = rem < 256 ? rem : 256; return true;
    }
    __device__ __forceinline__ void a_off(const Unit& u, const int (&RA)[2], const int (&CA)[2], unsigned (&vo)[2][2]) const {
        if constexpr (GATHER) {
            const int* ls = lslot + (size_t)u.e * LCAP + u.lr0;
#pragma unroll
            for (int h = 0; h < 2; ++h)
#pragma unroll
                for (int i = 0; i < 2; ++i) { const int rl = h * HALF + RA[i]; const int slot = ls[rl < u.valid ? rl : 0]; vo[h][i] = (unsigned)((slot >> 2) * RP + CA[i] * 2); }
        } else {
#pragma unroll
            for (int h = 0; h < 2; ++h)
#pragma unroll
                for (int i = 0; i < 2; ++i) vo[h][i] = (unsigned)((u.pm * BM + h * HALF + RA[i]) * RP + CA[i] * 2);
        }
    }
    __device__ __forceinline__ unsigned a_tile(const Unit& u) const { return (unsigned)u.pm * (unsigned)(BM * RP); }
    __device__ __forceinline__ unsigned b_off(const Unit& u) const { return (unsigned)u.e * (unsigned)b_estride + (unsigned)u.pn * (unsigned)(BM * RP); }
    __device__ __forceinline__ void dma_rows(const Unit& u, PG8_LAS unsigned char* dst, int wid, int lane_) const { if constexpr (GATHER) { if (wid == 0) dma1k(lslot + (size_t)u.e * LCAP + u.lr0, dst, lane_); } }
    __device__ __forceinline__ void a_off_lds(const Unit& u, const int (&RA)[2], const int (&CA)[2], const PG8_LAS unsigned char* src, unsigned (&vo)[2][2]) const {
        if constexpr (GATHER) { const PG8_LAS int* ls = (const PG8_LAS int*)src;
#pragma unroll
            for (int h = 0; h < 2; ++h)
#pragma unroll
                for (int i = 0; i < 2; ++i) { const int rl = h * HALF + RA[i]; const int slot = ls[rl < u.valid ? rl : 0]; vo[h][i] = (unsigned)((slot >> 2) * RP + CA[i] * 2); } }
    }
};

__device__ __forceinline__ v4u pack8(const f32x4 v0, const f32x4 v1) { v4u w; w.x = cvt_pk_bf16(v0[0], v0[1]); w.y = cvt_pk_bf16(v0[2], v0[3]); w.z = cvt_pk_bf16(v1[0], v1[1]); w.w = cvt_pk_bf16(v1[2], v1[3]); return w; }

__device__ __forceinline__ void st16(void* base, unsigned off, v4u v) { *(v4u*)((char*)base + off) = v; }
struct EpiQKV {
    __device__ __forceinline__ void dma(const Unit&, PG8_LAS unsigned char*, int, int) const {}
    bf16_t* O; size_t stride; float scale0;
    __device__ __forceinline__ void operator()(const f32x4 (&acc)[2][2][4][2], const Unit& u, int wr, int wc, int fr_, int fq_, const PG8_LAS unsigned char* xl) const {
        int fr = fr_, fq = fq_; asm volatile("" : "+v"(fr), "+v"(fq));
        const int row0 = u.pm * BM + wr * 64 + fr; const int t = u.pn >> 2; const int colt = (u.pn & 3) * BM;
        bf16_t* base = O + (size_t)t * stride; const float sc = (t == 0) ? scale0 : 1.f; const unsigned off0 = (unsigned)(row0 * D + colt + wc * 32 + 8 * fq) * 2u;
#pragma unroll
        for (int ai = 0; ai < 2; ++ai)
#pragma unroll
            for (int m = 0; m < 4; ++m)
#pragma unroll
                for (int bj = 0; bj < 2; ++bj) st16(base, off0 + (unsigned)((ai * HALF + m * 16) * D + bj * HALF) * 2u, pack8(acc[ai][bj][m][0] * sc, acc[ai][bj][m][1] * sc));
    }
};
struct EpiConvIn {
    __device__ __forceinline__ void dma(const Unit&, PG8_LAS unsigned char*, int, int) const {}
    bf16_t* GB; bf16_t* Z;
    __device__ __forceinline__ void operator()(const f32x4 (&acc)[2][2][4][2], const Unit& u, int wr, int wc, int fr_, int fq_, const PG8_LAS unsigned char* xl) const {
        int fr = fr_, fq = fq_; asm volatile("" : "+v"(fr), "+v"(fq));
        const int row0 = u.pm * BM + wr * 64 + fr;
        if (u.pn < 4) { const unsigned off0 = (unsigned)(row0 * D + u.pn * BM + wc * 32 + 8 * fq) * 2u;
#pragma unroll
            for (int ai = 0; ai < 2; ++ai)
#pragma unroll
                for (int m = 0; m < 4; ++m)
#pragma unroll
                    for (int bj = 0; bj < 2; ++bj) st16(GB, off0 + (unsigned)((ai * HALF + m * 16) * D + bj * HALF) * 2u, pack8(acc[ai][bj][m][0], acc[ai][bj][m][1]));
        } else { const unsigned off0 = (unsigned)(row0 * D + (u.pn - 4) * HALF + wc * 32 + 8 * fq) * 2u;
#pragma unroll
            for (int ai = 0; ai < 2; ++ai)
#pragma unroll
                for (int m = 0; m < 4; ++m) st16(Z, off0 + (unsigned)((ai * HALF + m * 16) * D) * 2u, pack8(acc[ai][0][m][0] * acc[ai][1][m][0], acc[ai][0][m][1] * acc[ai][1][m][1]));
        }
    }
};
struct EpiQKV8 {
    bf16_t* O; size_t stride; float scale0; const float* sw; const float* rs;
    __device__ __forceinline__ void dma(const Unit& u, PG8_LAS unsigned char* xl, int wid, int lane) const {
        if (wid == 0) dma1k(sw + u.pn * BM, xl, lane); else if (wid == 1) dma1k(rs + u.pm * BM, xl + 1024, lane);
    }
    __device__ __forceinline__ void operator()(const f32x4 (&acc)[2][2][4][2], const Unit& u, int wr, int wc, int fr_, int fq_, const PG8_LAS unsigned char* xl) const {
        int fr = fr_, fq = fq_; asm volatile("" : "+v"(fr), "+v"(fq));
        const int row0 = u.pm * BM + wr * 64 + fr; const int t = u.pn >> 2; const int colt = (u.pn & 3) * BM; const int cl = wc * 32 + 8 * fq;
        bf16_t* base = O + (size_t)t * stride; const float sc = (t == 0) ? scale0 : 1.f; const unsigned off0 = (unsigned)(row0 * D + colt + cl) * 2u;
        const PG8_LAS float* sp = (const PG8_LAS float*)xl + cl; const PG8_LAS float* rp = (const PG8_LAS float*)(xl + 1024) + wr * 64 + fr;
        f32x4 sv[2][2];
#pragma unroll
        for (int bj = 0; bj < 2; ++bj)
#pragma unroll
            for (int n = 0; n < 2; ++n) sv[bj][n] = *(const PG8_LAS f32x4*)(sp + bj * HALF + 4 * n) * sc;
#pragma unroll
        for (int ai = 0; ai < 2; ++ai)
#pragma unroll
            for (int m = 0; m < 4; ++m) { const float r = rp[ai * HALF + m * 16];
#pragma unroll
                for (int bj = 0; bj < 2; ++bj) st16(base, off0 + (unsigned)((ai * HALF + m * 16) * D + bj * HALF) * 2u, pack8(acc[ai][bj][m][0] * (sv[bj][0] * r), acc[ai][bj][m][1] * (sv[bj][1] * r))); }
    }
};
struct EpiConvIn8 {
    bf16_t* GB; bf16_t* Z; const float* sw; const float* rs;
    __device__ __forceinline__ void dma(const Unit& u, PG8_LAS unsigned char* xl, int wid, int lane) const { if (wid == 0) dma1k(sw + u.pn * BM, xl, lane); else if (wid == 1) dma1k(rs + u.pm * BM, xl + 1024, lane); }
    __device__ __forceinline__ void operator()(const f32x4 (&acc)[2][2][4][2], const Unit& u, int wr, int wc, int fr_, int fq_, const PG8_LAS unsigned char* xl) const {
        int fr = fr_, fq = fq_; asm volatile("" : "+v"(fr), "+v"(fq));
        const int row0 = u.pm * BM + wr * 64 + fr; const int cl = wc * 32 + 8 * fq;
        const PG8_LAS float* sp = (const PG8_LAS float*)xl + cl; const PG8_LAS float* rp = (const PG8_LAS float*)(xl + 1024) + wr * 64 + fr;
        f32x4 sv[2][2];
#pragma unroll
        for (int bj = 0; bj < 2; ++bj)
#pragma unroll
            for (int n = 0; n < 2; ++n) sv[bj][n] = *(const PG8_LAS f32x4*)(sp + bj * HALF + 4 * n);
        if (u.pn < 4) { const unsigned off0 = (unsigned)(row0 * D + u.pn * BM + cl) * 2u;
#pragma unroll
            for (int ai = 0; ai < 2; ++ai)
#pragma unroll
                for (int m = 0; m < 4; ++m) { const float r = rp[ai * HALF + m * 16];
#pragma unroll
                    for (int bj = 0; bj < 2; ++bj) st16(GB, off0 + (unsigned)((ai * HALF + m * 16) * D + bj * HALF) * 2u, pack8(acc[ai][bj][m][0] * (sv[bj][0] * r), acc[ai][bj][m][1] * (sv[bj][1] * r))); }
        } else { const unsigned off0 = (unsigned)(row0 * D + (u.pn - 4) * HALF + cl) * 2u;
            const f32x4 sz0 = sv[0][0] * sv[1][0], sz1 = sv[0][1] * sv[1][1];
#pragma unroll
            for (int ai = 0; ai < 2; ++ai)
#pragma unroll
                for (int m = 0; m < 4; ++m) { const float r = rp[ai * HALF + m * 16], r2 = r * r;
                    st16(Z, off0 + (unsigned)((ai * HALF + m * 16) * D) * 2u, pack8(acc[ai][0][m][0] * acc[ai][1][m][0] * (sz0 * r2), acc[ai][0][m][1] * acc[ai][1][m][1] * (sz1 * r2))); }
        }
    }
};
struct EpiResid {
    __device__ __forceinline__ void dma(const Unit&, PG8_LAS unsigned char*, int, int) const {}
    const bf16_t* X; bf16_t* Yp;
    __device__ __forceinline__ void operator()(const f32x4 (&acc)[2][2][4][2], const Unit& u, int wr, int wc, int fr_, int fq_, const PG8_LAS unsigned char* xl) const {
        int fr = fr_, fq = fq_; asm volatile("" : "+v"(fr), "+v"(fq));
        const unsigned off0 = (unsigned)((u.pm * BM + wr * 64 + fr) * D + u.pn * BM + wc * 32 + 8 * fq) * 2u;
#pragma unroll
        for (int ai = 0; ai < 2; ++ai)
#pragma unroll
            for (int m = 0; m < 4; ++m)
#pragma unroll
                for (int bj = 0; bj < 2; ++bj) { const unsigned off = off0 + (unsigned)((ai * HALF + m * 16) * D + bj * HALF) * 2u; const v4u xr = *(const v4u*)((const char*)X + off);
                    f32x4 v0 = acc[ai][bj][m][0], v1 = acc[ai][bj][m][1];
                    v0[0] += ALPHA * bf_lo(xr.x); v0[1] += ALPHA * bf_hi(xr.x); v0[2] += ALPHA * bf_lo(xr.y); v0[3] += ALPHA * bf_hi(xr.y);
                    v1[0] += ALPHA * bf_lo(xr.z); v1[1] += ALPHA * bf_hi(xr.z); v1[2] += ALPHA * bf_lo(xr.w); v1[3] += ALPHA * bf_hi(xr.w);
                    st16(Yp, off, pack8(v0, v1)); }
    }
};
template <bool ROWS> struct EpiResid8 {
    const bf16_t* X; bf16_t* Yp; const float* sw; const float* rs; float rsc;
    __device__ __forceinline__ void dma(const Unit& u, PG8_LAS unsigned char* xl, int wid, int lane) const {
        if (wid == 0) dma1k(sw + u.pn * BM, xl, lane); else if (ROWS && wid == 1) dma1k(rs + u.pm * BM, xl + 1024, lane);
    }
    __device__ __forceinline__ void operator()(const f32x4 (&acc)[2][2][4][2], const Unit& u, int wr, int wc, int fr_, int fq_, const PG8_LAS unsigned char* xl) const {
        int fr = fr_, fq = fq_; asm volatile("" : "+v"(fr), "+v"(fq));
        const int cl = wc * 32 + 8 * fq;
        const unsigned off0 = (unsigned)((u.pm * BM + wr * 64 + fr) * D + u.pn * BM + cl) * 2u;
        const PG8_LAS float* sp = (const PG8_LAS float*)xl + cl; const PG8_LAS float* rp = (const PG8_LAS float*)(xl + 1024) + wr * 64 + fr;
        f32x4 sv[2][2];
#pragma unroll
        for (int bj = 0; bj < 2; ++bj)
#pragma unroll
            for (int n = 0; n < 2; ++n) sv[bj][n] = *(const PG8_LAS f32x4*)(sp + bj * HALF + 4 * n) * (ROWS ? 1.0f : rsc);
#pragma unroll
        for (int ai = 0; ai < 2; ++ai)
#pragma unroll
            for (int m = 0; m < 4; ++m) { float r = 1.0f; if (ROWS) r = rp[ai * HALF + m * 16];
#pragma unroll
                for (int bj = 0; bj < 2; ++bj) { const unsigned off = off0 + (unsigned)((ai * HALF + m * 16) * D + bj * HALF) * 2u; const v4u xr = *(const v4u*)((const char*)X + off);
                    f32x4 v0 = acc[ai][bj][m][0] * sv[bj][0], v1 = acc[ai][bj][m][1] * sv[bj][1]; if (ROWS) { v0 *= r; v1 *= r; }
                    v0[0] += ALPHA * bf_lo(xr.x); v0[1] += ALPHA * bf_hi(xr.x); v0[2] += ALPHA * bf_lo(xr.y); v0[3] += ALPHA * bf_hi(xr.y);
                    v1[0] += ALPHA * bf_lo(xr.z); v1[1] += ALPHA * bf_hi(xr.z); v1[2] += ALPHA * bf_lo(xr.w); v1[3] += ALPHA * bf_hi(xr.w);
                    st16(Yp, off, pack8(v0, v1)); } }
    }
};
__device__ __forceinline__ unsigned pk4_fp8(float a, float b, float c, float d) { int p = 0; p = __builtin_amdgcn_cvt_pk_fp8_f32(a, b, p, false); p = __builtin_amdgcn_cvt_pk_fp8_f32(c, d, p, true); return (unsigned)p; }
__device__ __forceinline__ unsigned pk4_i8(float a, float b, float c, float d) {
    unsigned r = 0;
    r = __builtin_amdgcn_cvt_pk_u8_f32(__builtin_rintf(a + 128.f), 0, r); r = __builtin_amdgcn_cvt_pk_u8_f32(__builtin_rintf(b + 128.f), 1, r);
    r = __builtin_amdgcn_cvt_pk_u8_f32(__builtin_rintf(c + 128.f), 2, r); r = __builtin_amdgcn_cvt_pk_u8_f32(__builtin_rintf(d + 128.f), 3, r);
    return r ^ 0x80808080u;
}
template <bool I8> __device__ __forceinline__ unsigned pkq4(float a, float b, float c, float d) { if constexpr (I8) return pk4_i8(a, b, c, d); else return pk4_fp8(a, b, c, d); }
__device__ __forceinline__ f32x2 swiglu8_pk(f32x2 g, f32x2 l8) {
    g.x = fminf(g.x, 7.0f); g.y = fminf(g.y, 7.0f);
    l8.x = fminf(fmaxf(l8.x, -56.0f), 56.0f); l8.y = fminf(fmaxf(l8.y, -56.0f), 56.0f);
    const f32x2 t = g * (-1.702f * LOG2E);
    f32x2 e; e.x = __builtin_amdgcn_exp2f(t.x); e.y = __builtin_amdgcn_exp2f(t.y);
    const f32x2 d = e + 1.0f;
    f32x2 r; r.x = __builtin_amdgcn_rcpf(d.x); r.y = __builtin_amdgcn_rcpf(d.y);
    return (g * r) * (l8 + A2SCALE);
}
struct EpiMoe1 {
    unsigned char* A2; const float* b1; const float* sw; float inv_sa;
    __device__ __forceinline__ void dma(const Unit& u, PG8_LAS unsigned char* xl, int wid, int lane) const {
        if (wid == 0) dma1k(b1 + (size_t)u.e * 2048 + u.pn * BM, xl, lane); else if (wid == 1) dma1k(sw + (size_t)u.e * 2048 + u.pn * BM, xl + 1024, lane);
    }
    __device__ __forceinline__ void operator()(const f32x4 (&acc)[2][2][4][2], const Unit& u, int wr, int wc, int fr_, int fq_, const PG8_LAS unsigned char* xl) const {
        int fr = fr_, fq = fq_; asm volatile("" : "+v"(fr), "+v"(fq));
        const int cl = wc * 32 + 8 * fq; const unsigned off0 = (unsigned)((u.pm * BM + wr * 64 + fr) * D + u.pn * HALF + cl);
        const PG8_LAS float* bp = (const PG8_LAS float*)xl + 2 * cl; f32x4 bb[4];
#pragma unroll
        for (int j = 0; j < 4; ++j) bb[j] = *(const PG8_LAS f32x4*)(bp + 4 * j);
        const PG8_LAS float* sp = (const PG8_LAS float*)(xl + 1024) + cl;
        const f32x4 sg0 = *(const PG8_LAS f32x4*)(sp) * inv_sa, sg1 = *(const PG8_LAS f32x4*)(sp + 4) * inv_sa;
        const f32x4 sl0 = *(const PG8_LAS f32x4*)(sp + HALF) * (inv_sa * A2SCALE), sl1 = *(const PG8_LAS f32x4*)(sp + HALF + 4) * (inv_sa * A2SCALE);
        f32x2 sgp[4] = {{sg0[0], sg0[1]}, {sg0[2], sg0[3]}, {sg1[0], sg1[1]}, {sg1[2], sg1[3]}}, slp[4] = {{sl0[0], sl0[1]}, {sl0[2], sl0[3]}, {sl1[0], sl1[1]}, {sl1[2], sl1[3]}};
        f32x2 bgp[4], blp[4];
#pragma unroll
        for (int q = 0; q < 4; ++q) { bgp[q] = (f32x2){bb[q][0], bb[q][2]}; blp[q] = (f32x2){bb[q][1] * A2SCALE, bb[q][3] * A2SCALE}; }
#pragma unroll
        for (int ai = 0; ai < 2; ++ai)
#pragma unroll
            for (int m = 0; m < 4; ++m) { f32x2 o[4];
#pragma unroll
                for (int q = 0; q < 4; ++q) { const f32x4 ga = acc[ai][0][m][q >> 1], la = acc[ai][1][m][q >> 1]; const int h2 = (q & 1) * 2;
                    const f32x2 g = (f32x2){ga[h2], ga[h2 + 1]} * sgp[q] + bgp[q], l8 = (f32x2){la[h2], la[h2 + 1]} * slp[q] + blp[q];
                    o[q] = swiglu8_pk(g, l8); }
                typedef unsigned u32x2 __attribute__((ext_vector_type(2))); u32x2 w;
                w.x = pk4_fp8(o[0].x, o[0].y, o[1].x, o[1].y); w.y = pk4_fp8(o[2].x, o[2].y, o[3].x, o[3].y);
                *(u32x2*)(A2 + (off0 + (unsigned)((ai * HALF + m * 16) * D))) = w; }
    }
};
struct EpiMoe2 {
    unsigned char* Y; const float* b2; const float* sw; const int* lslot; const float* lgate;
    __device__ __forceinline__ void dma(const Unit& u, PG8_LAS unsigned char* xl, int wid, int lane) const {
        const size_t lb = (size_t)u.e * LCAP + u.lr0;
        if (wid == 0) dma1k(b2 + (size_t)u.e * 1024 + u.pn * BM, xl, lane); else if (wid == 1) dma1k(sw + (size_t)u.e * 1024 + u.pn * BM, xl + 1024, lane);
        else if (wid == 2) dma1k(lslot + lb, xl + 2048, lane); else if (wid == 3) dma1k(lgate + lb, xl + 3072, lane);
    }
    __device__ __forceinline__ void operator()(const f32x4 (&acc)[2][2][4][2], const Unit& u, int wr, int wc, int fr_, int fq_, const PG8_LAS unsigned char* xl) const {
        int fr = fr_, fq = fq_; asm volatile("" : "+v"(fr), "+v"(fq));
        const int rl0 = wr * 64 + fr, cl = wc * 32 + 8 * fq, col0 = u.pn * BM + cl;
        const PG8_LAS float* bp = (const PG8_LAS float*)xl + cl; const PG8_LAS float* sp = (const PG8_LAS float*)(xl + 1024) + cl; f32x4 bv[2][2], sv[2][2];
#pragma unroll
        for (int bj = 0; bj < 2; ++bj)
#pragma unroll
            for (int n = 0; n < 2; ++n) { bv[bj][n] = *(const PG8_LAS f32x4*)(bp + bj * HALF + 4 * n); sv[bj][n] = *(const PG8_LAS f32x4*)(sp + bj * HALF + 4 * n) * (1.0f / (A2SCALE * KREP_MOE_)); }
        const PG8_LAS int* sl = (const PG8_LAS int*)(xl + 2048); const PG8_LAS float* gl = (const PG8_LAS float*)(xl + 3072);
#pragma unroll
        for (int ai = 0; ai < 2; ++ai)
#pragma unroll
            for (int m = 0; m < 4; ++m) { const int rl = rl0 + ai * HALF + m * 16;
                const bool ok = rl < u.valid; const int slot = ok ? sl[rl] : M * 4; const float g = gl[rl] * YSCALE;
                const unsigned off = (unsigned)(slot * D + col0);
#pragma unroll
                for (int bj = 0; bj < 2; ++bj) { f32x4 v0 = (acc[ai][bj][m][0] * sv[bj][0] + bv[bj][0]) * g, v1 = (acc[ai][bj][m][1] * sv[bj][1] + bv[bj][1]) * g;
#pragma unroll
                    for (int i = 0; i < 4; ++i) { v0[i] = fminf(fmaxf(v0[i], -448.0f), 448.0f); v1[i] = fminf(fmaxf(v1[i], -448.0f), 448.0f); }
                    typedef unsigned u32x2 __attribute__((ext_vector_type(2))); u32x2 w; w.x = pk4_fp8(v0[0], v0[1], v0[2], v0[3]); w.y = pk4_fp8(v1[0], v1[1], v1[2], v1[3]);
                    *(u32x2*)(Y + (off + (unsigned)(bj * HALF))) = w; } }
    }
};

typedef int v8i_t __attribute__((ext_vector_type(8))); typedef int v4i_t __attribute__((ext_vector_type(4)));
__device__ __forceinline__ v8i_t cat8(bf16x8 lo, bf16x8 hi) { const v4i_t a = __builtin_bit_cast(v4i_t, lo), b = __builtin_bit_cast(v4i_t, hi); return __builtin_shufflevector(a, b, 0, 1, 2, 3, 4, 5, 6, 7); }
template <class Prob, class Epi, bool ALIGN_EPI, bool F8 = false, int KREP = 1, bool I8 = false>
__device__ __forceinline__ void gemm_phase(PG8_LAS unsigned char* lds, PG8_LAS unsigned char* xl, const Prob& P, const Epi& E) {
    int tid_ = P.tid; asm volatile("" : "+v"(tid_));
    const int tid = tid_, wid = __builtin_amdgcn_readfirstlane(tid >> 6), lane = tid & 63, wr = wid >> 2, wc = wid & 3, fr = lane & 15, fq = lane >> 4;
    constexpr int RP = F8 ? 1024 : 2048, nt = F8 ? 8 : NTK;
    constexpr bool GA = Prob::GATHER;
    int RA[2], CA[2]; unsigned voffB[2], voffA[2];
#pragma unroll
    for (int i = 0; i < 2; ++i) { int R, C; stage_rc(tid * 16 + i * 8192, R, C); const int Rb = (R & ~31) + perm32(R & 31); RA[i] = R; CA[i] = C; voffB[i] = (unsigned)(Rb * RP + C * 2); voffA[i] = (unsigned)(R * RP + C * 2); }
    constexpr unsigned kstep = (unsigned)(BK * 2);
    constexpr unsigned hstep = (unsigned)HALF * RP;
    const unsigned ldsw = (unsigned)wid * 1024u;
    const int aoff = lds_byte(wr * 64 + fr, fq * 8), boff = lds_byte(wc * 32 + fr, fq * 8);
    typedef const __attribute__((address_space(1))) unsigned* gptr_t;
#define PG8_SA(b, h) (((b) * 2 + (h)) * HTB)
#define PG8_SB(b, h) ((4 + (b) * 2 + (h)) * HTB)
#define PG8_STAGE_B(bufoff, uoff) do { _Pragma("unroll") for (int _i = 0; _i < 2; ++_i) \
        __builtin_amdgcn_global_load_lds((gptr_t)(Bb + (voffB[_i] + (unsigned)(uoff))), (PG8_LAS unsigned*)(lds + (bufoff) + ldsw + _i * 8192), 16, 0, 0); } while (0)
#define PG8_STAGE_A(bufoff, koff, h, NX) do { _Pragma("unroll") for (int _i = 0; _i < 2; ++_i) { unsigned _o; \
        if constexpr (GA) _o = ((NX) ? vn[h][_i] : vc[h][_i]) + (unsigned)(koff); else _o = voffA[_i] + (((NX) ? nAo : cAo) + (unsigned)(h) * hstep + (unsigned)(koff)); \
        __builtin_amdgcn_global_load_lds((gptr_t)(Ab + _o), (PG8_LAS unsigned*)(lds + (bufoff) + ldsw + _i * 8192), 16, 0, 0); } } while (0)
#define PG8_LDA(dst, b, h) do { _Pragma("unroll") for (int m = 0; m < 4; ++m) _Pragma("unroll") for (int k = 0; k < 2; ++k) dst[m][k] = *(const PG8_LAS bf16x8*)(lds + PG8_SA(b, h) + aoff + m * 2048 + k * 1024); } while (0)
#define PG8_LDB(dst, b, h) do { _Pragma("unroll") for (int n = 0; n < 2; ++n) _Pragma("unroll") for (int k = 0; k < 2; ++k) dst[n][k] = *(const PG8_LAS bf16x8*)(lds + PG8_SB(b, h) + boff + n * 2048 + k * 1024); } while (0)
#define PG8_MMA(ai, bj, At, Bt) do { __builtin_amdgcn_s_setprio(1); _Pragma("unroll") for (int m = 0; m < 4; ++m) _Pragma("unroll") for (int n = 0; n < 2; ++n) _Pragma("unroll") for (int k = 0; k < 2; ++k) \
        acc[ai][bj][m][n] = __builtin_amdgcn_mfma_f32_16x16x32_bf16(Bt[n][k], At[m][k], acc[ai][bj][m][n], 0, 0, 0); __builtin_amdgcn_s_setprio(0); } while (0)
#define PG8_MMA8(ai, bj, At, Bt) do { __builtin_amdgcn_s_setprio(1); if constexpr (I8) { _Pragma("unroll") for (int k = 0; k < 2; ++k) _Pragma("unroll") for (int m = 0; m < 4; ++m) _Pragma("unroll") for (int n = 0; n < 2; ++n) \
        asm volatile("v_mfma_i32_16x16x64_i8 %0, %1, %2, %0" : "+v"(acc[ai][bj][m][n]) : "v"(Bt[n][k]), "v"(At[m][k])); } else { _Pragma("unroll") for (int m = 0; m < 4; ++m) _Pragma("unroll") for (int n = 0; n < 2; ++n) \
        asm volatile("v_mfma_f32_16x16x128_f8f6f4 %0, %1, %2, %0" : "+v"(acc[ai][bj][m][n]) : "v"(cat8(Bt[n][0], Bt[n][1])), "v"(cat8(At[m][0], At[m][1]))); } __builtin_amdgcn_s_setprio(0); } while (0)
#define PG8_MMA8Z(ai, bj, At, Bt) do { __builtin_amdgcn_s_setprio(1); if constexpr (I8) { _Pragma("unroll") for (int m = 0; m < 4; ++m) _Pragma("unroll") for (int n = 0; n < 2; ++n) \
        asm volatile("v_mfma_i32_16x16x64_i8 %0, %1, %2, 0" : "=&v"(acc[ai][bj][m][n]) : "v"(Bt[n][0]), "v"(At[m][0])); _Pragma("unroll") for (int m = 0; m < 4; ++m) _Pragma("unroll") for (int n = 0; n < 2; ++n) \
        asm volatile("v_mfma_i32_16x16x64_i8 %0, %1, %2, %0" : "+v"(acc[ai][bj][m][n]) : "v"(Bt[n][1]), "v"(At[m][1])); } else { _Pragma("unroll") for (int m = 0; m < 4; ++m) _Pragma("unroll") for (int n = 0; n < 2; ++n) \
        asm volatile("v_mfma_f32_16x16x128_f8f6f4 %0, %1, %2, 0" : "=&v"(acc[ai][bj][m][n]) : "v"(cat8(Bt[n][0], Bt[n][1])), "v"(cat8(At[m][0], At[m][1]))); } __builtin_amdgcn_s_setprio(0); } while (0)
#define PG8_MM(ai, bj, At, Bt) do { if constexpr (F8) PG8_MMA8(ai, bj, At, Bt); else PG8_MMA(ai, bj, At, Bt); } while (0)
#define PG8_MM2(FIRST, ai, At) do { if constexpr (F8) { if (FIRST) { PG8_MMA8Z(ai, 0, At, B0); PG8_MMA8Z(ai, 1, At, B1); } else { PG8_MMA8(ai, 0, At, B0); PG8_MMA8(ai, 1, At, B1); } } else { PG8_MMA(ai, 0, At, B0); PG8_MMA(ai, 1, At, B1); } } while (0)
#define PG8_WAIT_V(n) asm volatile("s_waitcnt vmcnt(" #n ")" ::: "memory")
#define PG8_WAIT_L(n) asm volatile("s_waitcnt lgkmcnt(" #n ")" ::: "memory")
#define PG8_BAR __builtin_amdgcn_s_barrier()
#define PG8_SCHED __builtin_amdgcn_sched_barrier(0)
    Unit cur, nxt; int ui = 0;
    if (!P.next(0, cur)) return;
    f32x4 acc[2][2][4][2];
    if constexpr (!F8) {
#pragma unroll
    for (int a = 0; a < 2; ++a)
#pragma unroll
        for (int b = 0; b < 2; ++b)
#pragma unroll
            for (int m = 0; m < 4; ++m)
#pragma unroll
                for (int n = 0; n < 2; ++n) acc[a][b][m][n] = (f32x4){0.f, 0.f, 0.f, 0.f};
    }
    bf16x8 At[4][2], B0[2][2], B1[2][2];
    unsigned vc[2][2], vn[2][2]; unsigned cAo = 0, nAo = 0;
    if constexpr (GA) { P.a_off(cur, RA, CA, vc); vn[0][0] = vc[0][0]; vn[0][1] = vc[0][1]; vn[1][0] = vc[1][0]; vn[1][1] = vc[1][1]; } else { cAo = P.a_tile(cur); nAo = cAo; vc[0][0] = vn[0][0] = 0; }
    const char* const Ab = P.A; const char* const Bb = P.Bt; unsigned cBo = P.b_off(cur), nBo = cBo;
    PG8_STAGE_B(PG8_SB(0, 0), cBo); PG8_STAGE_B(PG8_SB(0, 1), cBo + hstep); PG8_STAGE_A(PG8_SA(0, 0), 0u, 0, false); PG8_STAGE_A(PG8_SA(0, 1), 0u, 1, false);
    if (wr == 1) PG8_BAR;
    PG8_WAIT_V(2); PG8_BAR;
    PG8_STAGE_B(PG8_SB(1, 0), cBo + kstep); PG8_STAGE_A(PG8_SA(1, 0), kstep, 0, false); PG8_STAGE_B(PG8_SB(1, 1), cBo + hstep + kstep);
    PG8_WAIT_V(6); PG8_BAR;
    for (;;) {
        const bool has_next = P.next(ui + 1, nxt);
        PG8_LAS unsigned char* const xe = xl + (ui & 1) * XL_EPI;
        PG8_LAS unsigned char* const xg = xl + 2 * XL_EPI + ((ui + 1) & 1) * XL_GATHER;
        E.dma(cur, xe, wid, lane);
        if (has_next) { if constexpr (GA) P.dma_rows(nxt, xg, wid, lane); else nAo = P.a_tile(nxt); nBo = P.b_off(nxt); }
        else { nAo = cAo; nBo = cBo; }
#pragma unroll 1
        for (int rep = 0; rep < KREP; ++rep)
#pragma unroll 1
        for (int t = 0; t < nt; t += 2) {
            const bool lastt = (t == nt - 2); const bool last = lastt && (rep == KREP - 1); const bool first = (t == 0) && (rep == 0); (void)first;
            if constexpr (GA) { if (last) { if (has_next) P.a_off_lds(nxt, RA, CA, xg, vn); else { vn[0][0] = vc[0][0]; vn[0][1] = vc[0][1]; vn[1][0] = vc[1][0]; vn[1][1] = vc[1][1]; } } }
            const unsigned k1 = (unsigned)(t + 1) * kstep;
            const unsigned k2 = lastt ? 0u : (unsigned)(t + 2) * kstep, k3 = k2 + kstep;
            const unsigned b2 = (last ? nBo : cBo) + k2, b3 = b2 + kstep;
            PG8_LDB(B0, 0, 0); PG8_LDB(B1, 0, 1); PG8_SCHED; PG8_LDA(At, 0, 0); PG8_STAGE_A(PG8_SA(1, 1), k1, 1, false);
            PG8_WAIT_V(8); PG8_WAIT_L(0); PG8_BAR; PG8_MM2(first, 0, At); PG8_BAR; PG8_SCHED;
            PG8_LDA(At, 0, 1); PG8_STAGE_B(PG8_SB(0, 0), b2); PG8_STAGE_B(PG8_SB(0, 1), b2 + hstep); PG8_STAGE_A(PG8_SA(0, 0), k2, 0, last);
            PG8_WAIT_V(8); PG8_WAIT_L(0); PG8_BAR; PG8_MM2(first, 1, At); PG8_BAR; PG8_SCHED;
            PG8_LDB(B0, 1, 0); PG8_LDB(B1, 1, 1); PG8_SCHED; PG8_LDA(At, 1, 0); PG8_STAGE_A(PG8_SA(0, 1), k2, 1, last);
            PG8_WAIT_V(8); PG8_WAIT_L(0); PG8_BAR; PG8_MM(0, 0, At, B0); PG8_MM(0, 1, At, B1); PG8_BAR; PG8_SCHED;
            PG8_LDA(At, 1, 1); PG8_STAGE_B(PG8_SB(1, 0), b3); PG8_STAGE_B(PG8_SB(1, 1), b3 + hstep); PG8_STAGE_A(PG8_SA(1, 0), k3, 0, last);
            PG8_WAIT_V(8); PG8_WAIT_L(0); PG8_BAR; PG8_MM(1, 0, At, B0); PG8_MM(1, 1, At, B1); PG8_BAR; PG8_SCHED;
        }
        if constexpr (ALIGN_EPI) { if (wr == 0) PG8_BAR; }
        if constexpr (F8) asm volatile("s_nop 15\n\ts_nop 7" ::: "memory");
        if constexpr (I8) {
#pragma unroll
            for (int a = 0; a < 2; ++a)
#pragma unroll
                for (int b = 0; b < 2; ++b)
#pragma unroll
                    for (int m = 0; m < 4; ++m)
#pragma unroll
                        for (int n = 0; n < 2; ++n)
#pragma unroll
                            for (int i = 0; i < 4; ++i) acc[a][b][m][n][i] = (float)__float_as_int(acc[a][b][m][n][i]);
        }
        E(acc, cur, wr, wc, fr, fq, xe);
        if (!has_next) break;
        if constexpr (!F8)
#pragma unroll
        for (int a = 0; a < 2; ++a)
#pragma unroll
            for (int b = 0; b < 2; ++b)
#pragma unroll
                for (int m = 0; m < 4; ++m)
#pragma unroll
                    for (int n = 0; n < 2; ++n) acc[a][b][m][n] = (f32x4){0.f, 0.f, 0.f, 0.f};
        cur = nxt; cBo = nBo; cAo = nAo; ++ui;
        if constexpr (GA) { vc[0][0] = vn[0][0]; vc[0][1] = vn[0][1]; vc[1][0] = vn[1][0]; vc[1][1] = vn[1][1]; }
        if constexpr (ALIGN_EPI) { if (wr == 1) PG8_BAR; }
    }
    PG8_WAIT_V(0);
    if constexpr (!ALIGN_EPI) { if (wr == 0) PG8_BAR; }
    PG8_BAR;
#undef PG8_SA
#undef PG8_SB
#undef PG8_STAGE_A
#undef PG8_STAGE_B
#undef PG8_LDA
#undef PG8_LDB
#undef PG8_MMA
#undef PG8_MMA8
#undef PG8_MM
#undef PG8_MM2
#undef PG8_MMA8Z
#undef PG8_WAIT_V
#undef PG8_WAIT_L
#undef PG8_BAR
#undef PG8_SCHED
}
}

namespace att {
constexpr int QBLK = 32, KVBLK = 64, LDX = 1024, NT = SEQ / KVBLK;
constexpr int SHM_V = KVBLK * 128 * 2, SHM_K = KVBLK * 128 * 2, NSLOT = 3;
constexpr int OFF_V = 0, OFF_K = NSLOT * SHM_V, OFF_WS = NSLOT * (SHM_V + SHM_K), OFF_TBL = OFF_WS + 8 * 64 * 4, ATT_LDS = OFF_TBL + 2048;
constexpr float THR2 = 8.0f * LOG2E;
#define KSWZ(row, colB) ((row) * 256 + ((colB) ^ (((row) & 7) << 4)))
#define SBAR() __builtin_amdgcn_sched_barrier(0)
__device__ __forceinline__ int crow(int r, int hi) { return (r & 3) + 8 * (r >> 2) + 4 * hi; }
__device__ __forceinline__ int v_st(int k, int c) { const int kk = (k & ~0xC) | ((k & 4) << 1) | ((k & 8) >> 1); return ((kk >> 3) * 4 + (c >> 5)) * 512 + ((kk & 7) * 32 + (c & 31)) * 2; }
__device__ __forceinline__ int v_rd_base(int lane) { return ((lane & 3) << 3) | (((lane >> 2) & 3) << 6) | (((lane >> 4) & 1) << 5) | (((lane >> 5) & 1) << 8); }
constexpr int v_rd_off(int d0, int ks, int half) { return d0 * 512 + ks * 4096 + half * 2048; }
template <int OFF> __device__ __forceinline__ s16x4 tr_read(int vb) { s16x4 r; asm volatile("ds_read_b64_tr_b16 %0, %1 offset:%2" : "=&v"(r) : "v"(vb), "i"(OFF) : "memory"); return r; }
#define ATT_RD8(L, H, D0) do { \
    asm volatile("ds_read_b64_tr_b16 %0, %1 offset:%2" : "=&v"(L[0]) : "v"(vb), "i"(v_rd_off(D0, 0, 0)) : "memory"); asm volatile("ds_read_b64_tr_b16 %0, %1 offset:%2" : "=&v"(H[0]) : "v"(vb), "i"(v_rd_off(D0, 0, 1)) : "memory"); \
    asm volatile("ds_read_b64_tr_b16 %0, %1 offset:%2" : "=&v"(L[1]) : "v"(vb), "i"(v_rd_off(D0, 1, 0)) : "memory"); asm volatile("ds_read_b64_tr_b16 %0, %1 offset:%2" : "=&v"(H[1]) : "v"(vb), "i"(v_rd_off(D0, 1, 1)) : "memory"); \
    asm volatile("ds_read_b64_tr_b16 %0, %1 offset:%2" : "=&v"(L[2]) : "v"(vb), "i"(v_rd_off(D0, 2, 0)) : "memory"); asm volatile("ds_read_b64_tr_b16 %0, %1 offset:%2" : "=&v"(H[2]) : "v"(vb), "i"(v_rd_off(D0, 2, 1)) : "memory"); \
    asm volatile("ds_read_b64_tr_b16 %0, %1 offset:%2" : "=&v"(L[3]) : "v"(vb), "i"(v_rd_off(D0, 3, 0)) : "memory"); asm volatile("ds_read_b64_tr_b16 %0, %1 offset:%2" : "=&v"(H[3]) : "v"(vb), "i"(v_rd_off(D0, 3, 1)) : "memory"); } while (0)
#define ATT_PK(L, H) (bf16x8){L[0], L[1], L[2], L[3], H[0], H[1], H[2], H[3]}
#define ATT_MM4(OD, L, H) do { OD = __builtin_amdgcn_mfma_f32_32x32x16_bf16(pa0, ATT_PK(L[0], H[0]), OD, 0, 0, 0); OD = __builtin_amdgcn_mfma_f32_32x32x16_bf16(pa1, ATT_PK(L[1], H[1]), OD, 0, 0, 0); \
    OD = __builtin_amdgcn_mfma_f32_32x32x16_bf16(pa2, ATT_PK(L[2], H[2]), OD, 0, 0, 0); OD = __builtin_amdgcn_mfma_f32_32x32x16_bf16(pa3, ATT_PK(L[3], H[3]), OD, 0, 0, 0); } while (0)
__device__ __forceinline__ void pv_d0(f32x16* o, int vb, bf16x8 pa0, bf16x8 pa1, bf16x8 pa2, bf16x8 pa3) {
  s16x4 la[4], ha[4], lb[4], hb[4];
  ATT_RD8(la, ha, 0); ATT_RD8(lb, hb, 1);
  asm volatile("s_waitcnt lgkmcnt(8)" ::: "memory"); SBAR(); ATT_MM4(o[0], la, ha); SBAR();
  ATT_RD8(la, ha, 2);
  asm volatile("s_waitcnt lgkmcnt(8)" ::: "memory"); SBAR(); ATT_MM4(o[1], lb, hb); SBAR();
  ATT_RD8(lb, hb, 3);
  asm volatile("s_waitcnt lgkmcnt(8)" ::: "memory"); SBAR(); ATT_MM4(o[2], la, ha); SBAR();
  asm volatile("s_waitcnt lgkmcnt(0)" ::: "memory"); SBAR(); ATT_MM4(o[3], lb, hb);
  const bf16x8 ones = {(short)0x3F80, (short)0x3F80, (short)0x3F80, (short)0x3F80, (short)0x3F80, (short)0x3F80, (short)0x3F80, (short)0x3F80};
  o[4] = __builtin_amdgcn_mfma_f32_32x32x16_bf16(pa0, ones, o[4], 0, 0, 0); o[4] = __builtin_amdgcn_mfma_f32_32x32x16_bf16(pa1, ones, o[4], 0, 0, 0);
  o[4] = __builtin_amdgcn_mfma_f32_32x32x16_bf16(pa2, ones, o[4], 0, 0, 0); o[4] = __builtin_amdgcn_mfma_f32_32x32x16_bf16(pa3, ones, o[4], 0, 0, 0);
}
__device__ __forceinline__ void pv_softmax(f32x16* o, int vb, bf16x8 pa0, bf16x8 pa1, bf16x8 pa2, bf16x8 pa3, f32x16& p0, f32x16& p1, float& m_reg, float& alpha, bool& resc) {
  s16x4 la[4], ha[4], lb[4], hb[4];
  ATT_RD8(la, ha, 0); ATT_RD8(lb, hb, 1);
  asm volatile("s_waitcnt lgkmcnt(8)" ::: "memory"); SBAR();
  float a = fmaxf(fmaxf(p0[0], p0[1]), p1[0]), b = fmaxf(fmaxf(p0[2], p0[3]), p1[1]); a = fmaxf(fmaxf(a, p1[2]), p1[3]);
#pragma unroll
  for (int r = 4; r < 16; r += 4) { a = fmaxf(fmaxf(a, p0[r]), p0[r + 1]); b = fmaxf(fmaxf(b, p0[r + 2]), p0[r + 3]); a = fmaxf(fmaxf(a, p1[r]), p1[r + 1]); b = fmaxf(fmaxf(b, p1[r + 2]), p1[r + 3]); }
  float pmax = fmaxf(a, b);
  ATT_MM4(o[0], la, ha); SBAR();
  ATT_RD8(la, ha, 2);
  asm volatile("s_waitcnt lgkmcnt(8)" ::: "memory"); SBAR();
  { auto rr = __builtin_amdgcn_permlane32_swap(__float_as_uint(pmax), __float_as_uint(pmax), false, false);
    pmax = fmaxf(__uint_as_float(rr[0]), __uint_as_float(rr[1])); }
  resc = false; alpha = 1.f;
  if (__builtin_expect(!__all(pmax <= THR2), 0)) { const float dl = fmaxf(pmax, 0.f); m_reg += dl; alpha = __builtin_amdgcn_exp2f(-dl); resc = true;
#pragma unroll
    for (int r = 0; r < 16; ++r) { p0[r] -= dl; p1[r] -= dl; } }
  ATT_MM4(o[1], lb, hb); SBAR();
  ATT_RD8(lb, hb, 3);
  asm volatile("s_waitcnt lgkmcnt(8)" ::: "memory"); SBAR();
#pragma unroll
  for (int r = 0; r < 16; ++r) p0[r] = __builtin_amdgcn_exp2f(p0[r]);
  ATT_MM4(o[2], la, ha); SBAR();
  asm volatile("s_waitcnt lgkmcnt(0)" ::: "memory"); SBAR();
#pragma unroll
  for (int r = 0; r < 16; ++r) p1[r] = __builtin_amdgcn_exp2f(p1[r]);
  ATT_MM4(o[3], lb, hb);
  const bf16x8 ones = {(short)0x3F80, (short)0x3F80, (short)0x3F80, (short)0x3F80, (short)0x3F80, (short)0x3F80, (short)0x3F80, (short)0x3F80};
  o[4] = __builtin_amdgcn_mfma_f32_32x32x16_bf16(pa0, ones, o[4], 0, 0, 0); o[4] = __builtin_amdgcn_mfma_f32_32x32x16_bf16(pa1, ones, o[4], 0, 0, 0);
  o[4] = __builtin_amdgcn_mfma_f32_32x32x16_bf16(pa2, ones, o[4], 0, 0, 0); o[4] = __builtin_amdgcn_mfma_f32_32x32x16_bf16(pa3, ones, o[4], 0, 0, 0);
}
__device__ __forceinline__ void near_bias(f32x16& p0, f32x16& p1, int dq, const float* tbl) {
#pragma unroll
  for (int r = 0; r < 16; ++r) { const int c0 = (r & 3) + 8 * (r >> 2); p0[r] += tbl[dq + c0]; p1[r] += tbl[dq + c0 + 32]; }
}
__device__ __forceinline__ void qkt(f32x16& p0, f32x16& p1, const char* Ks, const bf16x8* qr, int r32, int hi, int mapB) {
  bf16x8 k0[4], k1[4];
#pragma unroll
  for (int d0 = 0; d0 < 4; ++d0) { const int cb = mapB + (d0 * 16 + hi * 8) * 2;
    k0[d0] = *reinterpret_cast<const bf16x8*>(Ks + KSWZ(r32, cb)); k1[d0] = *reinterpret_cast<const bf16x8*>(Ks + KSWZ(32 + r32, cb)); }
  p0 = f32x16{}; p1 = f32x16{};
#pragma unroll
  for (int d0 = 0; d0 < 4; ++d0) {
    p0 = __builtin_amdgcn_mfma_f32_32x32x16_bf16(k0[d0], qr[d0], p0, 0, 0, 0);
    p1 = __builtin_amdgcn_mfma_f32_32x32x16_bf16(k1[d0], qr[d0], p1, 0, 0, 0); }
}
__device__ __forceinline__ void qkt_seed(f32x16& p0, f32x16& p1, const char* Ks, const bf16x8* qr, const int (&koff)[4], const f32x16& seed) {
#pragma unroll
  for (int d0 = 0; d0 < 4; ++d0) {
    const bf16x8 b0 = *reinterpret_cast<const bf16x8*>(Ks + koff[d0]);
    const bf16x8 b1 = *reinterpret_cast<const bf16x8*>(Ks + koff[d0] + 8192);
    if (d0 == 0) { p0 = __builtin_amdgcn_mfma_f32_32x32x16_bf16(b0, qr[0], seed, 0, 0, 0); p1 = __builtin_amdgcn_mfma_f32_32x32x16_bf16(b1, qr[0], seed, 0, 0, 0); }
    else { p0 = __builtin_amdgcn_mfma_f32_32x32x16_bf16(b0, qr[d0], p0, 0, 0, 0); p1 = __builtin_amdgcn_mfma_f32_32x32x16_bf16(b1, qr[d0], p1, 0, 0, 0); } }
}
__device__ __forceinline__ void partialSM_seeded(f32x16& p0, f32x16& p1, float& m_reg, float& alpha, bool& resc, int mode, int dq, const float* tbl) {
  if (mode == 0) {
#pragma unroll
    for (int r = 0; r < 16; ++r) { const int c0 = (r & 3) + 8 * (r >> 2);
      p0[r] += tbl[dq + c0]; p1[r] += tbl[dq + c0 + 32]; }
  }
  float a = fmaxf(fmaxf(p0[0], p0[1]), p1[0]), b = fmaxf(fmaxf(p0[2], p0[3]), p1[1]); a = fmaxf(fmaxf(a, p1[2]), p1[3]);
#pragma unroll
  for (int r = 4; r < 16; r += 4) { a = fmaxf(fmaxf(a, p0[r]), p0[r + 1]); b = fmaxf(fmaxf(b, p0[r + 2]), p0[r + 3]); a = fmaxf(fmaxf(a, p1[r]), p1[r + 1]); b = fmaxf(fmaxf(b, p1[r + 2]), p1[r + 3]); }
  float pmax = fmaxf(a, b);
  { auto rr = __builtin_amdgcn_permlane32_swap(__float_as_uint(pmax), __float_as_uint(pmax), false, false);
    pmax = fmaxf(__uint_as_float(rr[0]), __uint_as_float(rr[1])); }
  resc = false; alpha = 1.f;
  if (__builtin_expect(!__all(pmax <= THR2), 0)) { const float dl = fmaxf(pmax, 0.f); m_reg += dl; alpha = __builtin_amdgcn_exp2f(-dl); resc = true;
#pragma unroll
    for (int r = 0; r < 16; ++r) { p0[r] -= dl; p1[r] -= dl; } }
#pragma unroll
  for (int r = 0; r < 16; ++r) p0[r] = __builtin_amdgcn_exp2f(p0[r]);
}
__device__ __forceinline__ void partialSM(f32x16& p0, f32x16& p1, float& m_reg, float& mn, float& alpha, int mode, float cL, float cR, int dq, const float* tbl) {
  float cadd;
  if (mode == 0) {
#pragma unroll
    for (int r = 0; r < 16; ++r) { const int c0 = (r & 3) + 8 * (r >> 2);
      p0[r] += tbl[dq + c0]; p1[r] += tbl[dq + c0 + 32]; }
    cadd = 0.f;
  } else cadd = (mode < 0) ? cL : cR;
  float pmax = p0[0];
#pragma unroll
  for (int r = 1; r < 16; ++r) pmax = fmaxf(pmax, p0[r]);
#pragma unroll
  for (int r = 0; r < 16; ++r) pmax = fmaxf(pmax, p1[r]);
  { auto rr = __builtin_amdgcn_permlane32_swap(__float_as_uint(pmax), __float_as_uint(pmax), false, false);
    pmax = fmaxf(__uint_as_float(rr[0]), __uint_as_float(rr[1])); }
  pmax += cadd;
  if (__builtin_expect(__all(pmax - m_reg <= THR2), 1)) { mn = m_reg; alpha = 1.f; }
  else { mn = fmaxf(m_reg, pmax); alpha = __builtin_amdgcn_exp2f(m_reg - mn); m_reg = mn; }
  const float sh = cadd - mn;
#pragma unroll
  for (int r = 0; r < 16; ++r) p0[r] += sh;
#pragma unroll
  for (int r = 0; r < 16; ++r) p1[r] += sh;
#pragma unroll
  for (int r = 0; r < 16; ++r) p0[r] = __builtin_amdgcn_exp2f(p0[r]);
}
__device__ __forceinline__ void finishSM(f32x16& p0, f32x16& p1, bf16x8& pa0, bf16x8& pa1, bf16x8& pa2, bf16x8& pa3) {
#define PK8(P, BASE, OUT) do { v4u w = {cvt_pk_bf16(P[BASE + 0], P[BASE + 1]), cvt_pk_bf16(P[BASE + 2], P[BASE + 3]), cvt_pk_bf16(P[BASE + 4], P[BASE + 5]), cvt_pk_bf16(P[BASE + 6], P[BASE + 7])}; OUT = *reinterpret_cast<bf16x8*>(&w); } while (0)
  PK8(p0, 0, pa0); PK8(p0, 8, pa1); PK8(p1, 0, pa2); PK8(p1, 8, pa3);
#undef PK8
}
__device__ __forceinline__ int rel_bucket(int rel) {
  const int n = rel < 0 ? -rel : rel; int b;
  if (n < 8) b = n; else if (n < 12) b = 8; else if (n < 16) b = 9; else if (n < 23) b = 10; else if (n < 32) b = 11; else if (n < 46) b = 12; else if (n < 64) b = 13; else if (n < 91) b = 14; else b = 15;
  return (rel > 0 ? 16 : 0) + b;
}

__device__ __forceinline__ void attn_unit(int b, int h, int qb, const bf16_t* __restrict__ Q, const bf16_t* __restrict__ K, const bf16_t* __restrict__ V, bf16_t* __restrict__ O,
                                          float lam, float osc, const float* __restrict__ g, const float* __restrict__ rel_bias, char* lds, int tid_in, bool build_tbl, bool o8) {
  int tid_ = tid_in; asm volatile("" : "+v"(tid_));
  const int tid = tid_, wid = __builtin_amdgcn_readfirstlane(tid >> 6), lane = tid & 63, r32 = lane & 31, hi = lane >> 5;
  const int map = wid & 1, jq = wid >> 1;
  char* V_lds = lds + OFF_V; char* K_lds = lds + OFF_K;
  float* ws = (float*)(lds + OFF_WS) + wid * 64; float* li_l = ws; float* al_l = ws + 32;
  float* tbl = (float*)(lds + OFF_TBL);
  if (build_tbl) tbl[tid] = rel_bias[rel_bucket(tid - 256) * NH + h] * LOG2E;
  const float cL = rel_bias[15 * NH + h] * LOG2E, cR = rel_bias[31 * NH + h] * LOG2E;
  const long rowbase = (long)b * SEQ; const int qs = qb * 128 + jq * QBLK;
  float m_reg = -1e30f; f32x16 o[5] = {}; bf16x8 qr[4];
  const bf16_t* Qw = Q + (rowbase + qs + r32) * LDX + h * 128 + map * 64 + hi * 8;
#pragma unroll
  for (int d0 = 0; d0 < 4; ++d0) qr[d0] = *reinterpret_cast<const bf16x8*>(Qw + d0 * 16);
  const bf16_t* Kh = K + rowbase * LDX + h * 128; const bf16_t* Vh = V + rowbase * LDX + h * 128;
  const int vb0 = (int)(uintptr_t)V_lds + v_rd_base(lane);
  const int mapB = map * 128;
  int koff[4];
#pragma unroll
  for (int d0 = 0; d0 < 4; ++d0) koff[d0] = KSWZ(r32, mapB + (d0 * 16 + hi * 8) * 2);
  const int dq0 = 256 + 4 * hi - (qs + r32);
  unsigned ksrc[2], vsrc[2];
#pragma unroll
  for (int i = 0; i < 2; ++i) { const int pk = wid + 8 * i;
    const int krow = 4 * pk + (lane >> 4), kc = (lane & 15) ^ (krow & 7); ksrc[i] = (unsigned)(krow * (LDX * 2) + kc * 16);
    const int st = 2 * pk + (lane >> 5), kk = (st >> 2) * 8 + ((lane & 31) >> 2), vk = kk  , vc = (st & 3) * 32 + (lane & 3) * 8;
    vsrc[i] = (unsigned)(vk * (LDX * 2) + vc * 2); }
  typedef const __attribute__((address_space(1))) unsigned* gptr_t; typedef __attribute__((address_space(3))) unsigned* lptr_t;
  const char* const Kg = (const char*)Kh; const char* const Vg = (const char*)Vh;
  const lptr_t kdst = (lptr_t)(__attribute__((address_space(3))) char*)(K_lds) + 0; (void)kdst;
#define DMA_TILE(t, slot) do { const unsigned tb_ = (unsigned)(t) * (unsigned)(KVBLK * LDX * 2); \
    _Pragma("unroll") for (int i_ = 0; i_ < 2; ++i_) { \
      __builtin_amdgcn_global_load_lds((gptr_t)(Kg + (ksrc[i_] + tb_)), (lptr_t)((__attribute__((address_space(3))) char*)K_lds + (slot) + (wid + 8 * i_) * 1024), 16, 0, 0); \
      __builtin_amdgcn_global_load_lds((gptr_t)(Vg + (vsrc[i_] + tb_)), (lptr_t)((__attribute__((address_space(3))) char*)V_lds + (slot) + (wid + 8 * i_) * 1024), 16, 0, 0); } } while (0)
#define WAIT_BAR() do { asm volatile("s_waitcnt vmcnt(0) lgkmcnt(0)" ::: "memory"); __builtin_amdgcn_s_barrier(); asm volatile("" ::: "memory"); } while (0)
#define RESC(a, rs) do { if (rs) { if (hi == 0) al_l[r32] = (a); asm volatile("s_waitcnt lgkmcnt(0)" ::: "memory"); \
    _Pragma("unroll") for (int d = 0; d < 5; ++d) _Pragma("unroll") for (int r = 0; r < 16; ++r) o[d][r] *= al_l[crow(r, hi)]; } } while (0)
#define SEED(md) do { const int md_ = (md); const float sv_ = (md_ == 0 ? 0.f : (md_ < 0 ? cL : cR)) - m_reg; _Pragma("unroll") for (int r = 0; r < 16; ++r) seed[r] = sv_; } while (0)
#define TMODE(k0) (((k0) >= qs + 122) ? 1 : (((k0) <= qs - 154) ? -1 : 0))
#define ROT() do { const int t_ = sl_prev; sl_prev = sl_cur; sl_cur = sl_next; sl_next = t_; } while (0)
  f32x16 pA0, pA1, pB0, pB1, seed; float mnA, alA, alB; bool rsA = false, rsB = false; bf16x8 pa0, pa1, pa2, pa3;
  int sl_prev = 2 * SHM_V, sl_cur = 0, sl_next = SHM_V;
  if (wid >= 4) __builtin_amdgcn_s_setprio(1);
  DMA_TILE(0, 0); DMA_TILE(1, SHM_V);
  WAIT_BAR();
  DMA_TILE(2, 2 * SHM_V);
  qkt(pA0, pA1, K_lds, qr, r32, hi, mapB); partialSM(pA0, pA1, m_reg, mnA, alA, TMODE(0), cL, cR, dq0, tbl);
  _Pragma("unroll") for (int r = 0; r < 16; ++r) pA1[r] = __builtin_amdgcn_exp2f(pA1[r]);
  ROT();
#define QK_SEEDED(P0, P1, DMA_STMT, SEED_STMT) do { bf16x8 k0_[4], k1_[4]; const char* Ks_ = K_lds + sl_cur; \
    _Pragma("unroll") for (int d0 = 0; d0 < 4; ++d0) { k0_[d0] = *reinterpret_cast<const bf16x8*>(Ks_ + koff[d0]); k1_[d0] = *reinterpret_cast<const bf16x8*>(Ks_ + koff[d0] + 8192); } \
    DMA_STMT; SEED_STMT; \
    P0 = __builtin_amdgcn_mfma_f32_32x32x16_bf16(k0_[0], qr[0], seed, 0, 0, 0); P1 = __builtin_amdgcn_mfma_f32_32x32x16_bf16(k1_[0], qr[0], seed, 0, 0, 0); \
    _Pragma("unroll") for (int d0 = 1; d0 < 4; ++d0) { P0 = __builtin_amdgcn_mfma_f32_32x32x16_bf16(k0_[d0], qr[d0], P0, 0, 0, 0); P1 = __builtin_amdgcn_mfma_f32_32x32x16_bf16(k1_[d0], qr[d0], P1, 0, 0, 0); } } while (0)
  for (int j = 1; j + 1 < NT; j += 2) {
    SBAR(); QK_SEEDED(pB0, pB1, if (j > 1) DMA_TILE(j + 1, sl_next), SEED(TMODE(j * KVBLK)));
    finishSM(pA0, pA1, pa0, pa1, pa2, pa3); SBAR();
    if (TMODE(j * KVBLK) == 0) near_bias(pB0, pB1, dq0 + j * KVBLK, tbl);
    pv_softmax(o, vb0 + sl_prev, pa0, pa1, pa2, pa3, pB0, pB1, m_reg, alB, rsB);
    WAIT_BAR();
    RESC(alB, rsB); ROT();
    SBAR(); QK_SEEDED(pA0, pA1, DMA_TILE(j + 2, sl_next), SEED(TMODE((j + 1) * KVBLK)));
    finishSM(pB0, pB1, pa0, pa1, pa2, pa3); SBAR();
    if (TMODE((j + 1) * KVBLK) == 0) near_bias(pA0, pA1, dq0 + (j + 1) * KVBLK, tbl);
    pv_softmax(o, vb0 + sl_prev, pa0, pa1, pa2, pa3, pA0, pA1, m_reg, alA, rsA);
    WAIT_BAR();
    RESC(alA, rsA); ROT();
  }
  SBAR(); QK_SEEDED(pB0, pB1, (void)0, SEED(TMODE((NT - 1) * KVBLK)));
  finishSM(pA0, pA1, pa0, pa1, pa2, pa3); SBAR();
  if (TMODE((NT - 1) * KVBLK) == 0) near_bias(pB0, pB1, dq0 + (NT - 1) * KVBLK, tbl);
  pv_softmax(o, vb0 + sl_prev, pa0, pa1, pa2, pa3, pB0, pB1, m_reg, alB, rsB);
  RESC(alB, rsB);
  finishSM(pB0, pB1, pa0, pa1, pa2, pa3); SBAR();
  pv_d0(o, vb0 + sl_cur, pa0, pa1, pa2, pa3);
  __builtin_amdgcn_s_setprio(0);
  float rli[16];
#pragma unroll
  for (int r = 0; r < 16; ++r) rli[r] = __builtin_amdgcn_rcpf(o[4][r]);
  __syncthreads();
  float* X = (float*)(lds + jq * 16384);
  if (map == 1) {
#pragma unroll
    for (int r = 0; r < 16; ++r) { const int orow = crow(r, hi); const float s = rli[r] * lam;
#pragma unroll
      for (int d0 = 0; d0 < 4; ++d0) X[orow * 128 + d0 * 32 + r32] = o[d0][r] * s; }
  }
  __syncthreads();
  if (map == 0) {
    float ss[16];
#pragma unroll
    for (int r = 0; r < 16; ++r) { const int orow = crow(r, hi); float a = 0.f;
#pragma unroll
      for (int d0 = 0; d0 < 4; ++d0) { const float v = o[d0][r] * rli[r] - X[orow * 128 + d0 * 32 + r32]; o[d0][r] = v; a += v * v; }
      ss[r] = a; }
#pragma unroll
    for (int s = 1; s < 32; s <<= 1)
#pragma unroll
      for (int r = 0; r < 16; ++r) ss[r] += __shfl_xor(ss[r], s);
    float gg[4];
#pragma unroll
    for (int d0 = 0; d0 < 4; ++d0) gg[d0] = g[d0 * 32 + r32] * osc;
    asm volatile("s_waitcnt lgkmcnt(0)" ::: "memory");
    bf16_t* stg = (bf16_t*)X;
#pragma unroll
    for (int r = 0; r < 16; ++r) { const int orow = crow(r, hi); const float rs = __builtin_amdgcn_rsqf(ss[r] * (1.0f / 128.0f) + LN_EPS);
#pragma unroll
      for (int d0 = 0; d0 < 4; ++d0) { const float v = o[d0][r] * rs * gg[d0]; stg[orow * 128 + d0 * 32 + r32] = (bf16_t)(cvt_pk_bf16(v, v) & 0xffffu); } }
    asm volatile("s_waitcnt lgkmcnt(0)" ::: "memory");
    bf16_t* Ow = O + (rowbase + qs) * LDX + h * 128;
#pragma unroll
    for (int i = 0; i < 8; ++i) { const int row = i * 4 + (lane >> 4), ch = lane & 15; const v4u v = *(const v4u*)(stg + row * 128 + ch * 8);
      if (!o8) *(v4u*)(Ow + (long)row * LDX + ch * 8) = v;
      else { typedef unsigned u32x2 __attribute__((ext_vector_type(2))); u32x2 q8; q8.x = pg8::pk4_fp8(bf_lo(v.x), bf_hi(v.x), bf_lo(v.y), bf_hi(v.y)); q8.y = pg8::pk4_fp8(bf_lo(v.z), bf_hi(v.z), bf_lo(v.w), bf_hi(v.w));
        *(u32x2*)((unsigned char*)O + (size_t)(rowbase + qs + row) * LDX + h * 128 + ch * 8) = q8; } }
    asm volatile("s_waitcnt lgkmcnt(0)" ::: "memory");
  }
  __syncthreads();
#undef DMA_TILE
#undef WAIT_BAR
#undef ROT
#undef RESC
#undef SEED
#undef QK_SEEDED
#undef TMODE
}
#undef KSWZ
#undef SBAR
}

#define XB_TMO      128
#define XB_XCNT(j)  (256  + 64 * (j))
#define XB_XSUB(j)  (1280 + 64 * (j))
#define XB_XGEN(j)  (2304 + 64 * (j))
#define XB_TOP      3328
#define XB_TOPGEN   3392
#define XCD_BAR_WORDS 3456
#define XB_SPIN_CAP (1u << 18)
__device__ __forceinline__ unsigned xb_ld(unsigned* p)              { return __hip_atomic_load(p, __ATOMIC_RELAXED, __HIP_MEMORY_SCOPE_AGENT); }
__device__ __forceinline__ unsigned xb_add(unsigned* p, unsigned v) { return __hip_atomic_fetch_add(p, v, __ATOMIC_RELAXED, __HIP_MEMORY_SCOPE_AGENT); }
__device__ __forceinline__ unsigned xb_xcc_id() { return (unsigned)__builtin_amdgcn_s_getreg((3 << 11) | 20) & 0xFu; }
#define XB_SPIN(cond, bar) do { unsigned _sp = 0; while (cond) { __builtin_amdgcn_s_sleep(1); \
    if ((++_sp & 255u) == 0u) { if (xb_ld(&(bar)[XB_TMO])) break; if (_sp > XB_SPIN_CAP) { atomicAdd(&(bar)[XB_TMO], 1u); break; } } } } while (0)
struct XcdBarrier { unsigned* bar; unsigned x; volatile LAS unsigned* st; };
__device__ __forceinline__ XcdBarrier xcd_barrier_post(unsigned* bar, volatile LAS unsigned* st) {
    XcdBarrier b; b.bar = bar; b.x = xb_xcc_id(); b.st = st;
    if (threadIdx.x == 0) (void)xb_add(&bar[XB_XCNT(b.x)], 1u);
    return b;
}
__device__ __forceinline__ void xcd_barrier_complete(unsigned* bar, unsigned x, unsigned& nloc, unsigned& nx) {
    const unsigned G = gridDim.x * gridDim.y * gridDim.z;
    unsigned sum, cnt, mine, sp = 0u;
    for (;;) {
        sum = 0u; cnt = 0u; mine = 0u;
#pragma unroll
        for (unsigned j = 0; j < 16; ++j) { const unsigned c = xb_ld(&bar[XB_XCNT(j)]); sum += c; cnt += (c > 0u) ? 1u : 0u; mine = (j == x) ? c : mine; }
        if (sum == G) break;
        __builtin_amdgcn_s_sleep(1);
        if ((++sp & 255u) == 0u) { if (xb_ld(&bar[XB_TMO])) break; if (sp > XB_SPIN_CAP) { atomicAdd(&bar[XB_TMO], 1u); break; } }
    }
    nloc = mine > 0u ? mine : 1u; nx = cnt > 0u ? cnt : 1u;
}
__device__ __forceinline__ void xcd_barrier(const XcdBarrier& b) {
    asm volatile("s_waitcnt vmcnt(0)" ::: "memory");
    __syncthreads();
    if (threadIdx.x == 0) {
        unsigned* bar = b.bar;
        __builtin_amdgcn_s_waitcnt(0);
        unsigned nloc = b.st[0], nx = b.st[1];
        if (nloc == 0u) { xcd_barrier_complete(bar, b.x, nloc, nx); b.st[0] = nloc; b.st[1] = nx; }
        const unsigned old = xb_add(&bar[XB_XSUB(b.x)], 1u);
        const unsigned gen = old / nloc;
        if (old + 1u == (gen + 1u) * nloc) {
            __builtin_amdgcn_fence(__ATOMIC_RELEASE, "agent");
            asm volatile("s_waitcnt vmcnt(0)" ::: "memory");
            const unsigned og = xb_add(&bar[XB_TOP], 1u);
            const unsigned tg = og / nx;
            if (og + 1u == (tg + 1u) * nx) xb_add(&bar[XB_TOPGEN], 1u);
            else XB_SPIN(xb_ld(&bar[XB_TOPGEN]) == tg, bar);
            __builtin_amdgcn_fence(__ATOMIC_ACQUIRE, "agent");
            xb_add(&bar[XB_XGEN(b.x)], 1u);
            asm volatile("s_waitcnt vmcnt(0)" ::: "memory");
        } else {
            XB_SPIN(xb_ld(&bar[XB_XGEN(b.x)]) == gen, bar);
            __builtin_amdgcn_fence(__ATOMIC_ACQUIRE, "agent");
            asm volatile("s_waitcnt vmcnt(0)" ::: "memory");
        }
    }
    __syncthreads();
}

template <int MODE> __device__ __forceinline__ int dst_row(int n) {
    if (MODE == 1) { if (n < 1024) return n; const int b = (n - 1024) >> 10, f = (n - 1024) & 1023; return 1024 + (f >> 7) * 256 + b * 128 + (f & 127); }
    if (MODE == 2) { const int b = n & 1, j = n >> 1; return (j >> 7) * 256 + b * 128 + (j & 127); }
    return n;
}
template <int MODE> __device__ __forceinline__ void p0_transpose_item(const float* W, int K, int N, bf16_t* WT, LAS float* scr, int item, int lane, const float* kscale = nullptr) {
    const int nblk = N / 32, kb = item / nblk, nb = item % nblk, k0 = 64 * kb, n0 = 32 * nb;
#pragma unroll 8
    for (int i = 0; i < 32; ++i) { const int kk = 2 * i + (lane >> 5); float w = W[(size_t)(k0 + kk) * N + n0 + (lane & 31)]; if (kscale) w *= kscale[k0 + kk]; scr[kk * 33 + (lane & 31)] = w; }
    LDS_WAIT(); asm volatile("" ::: "memory");
    const int c = lane & 7;
#pragma unroll
    for (int j = 0; j < 4; ++j) { const int n = (lane >> 3) + 8 * j; const LAS float* s = scr + (8 * c) * 33 + n;
        v4u o; o.x = cvt_pk_bf16(s[0 * 33], s[1 * 33]); o.y = cvt_pk_bf16(s[2 * 33], s[3 * 33]); o.z = cvt_pk_bf16(s[4 * 33], s[5 * 33]); o.w = cvt_pk_bf16(s[6 * 33], s[7 * 33]);
        *(GAS v4u*)(WT + (size_t)dst_row<MODE>(n0 + n) * K + k0 + 8 * c) = o; }
    LDS_WAIT(); asm volatile("" ::: "memory");
}

template <int MODE, bool I8 = false> __device__ __forceinline__ void p0_quant_strip(const float* W, int N, unsigned char* W8, float* SC, int strip, LAS unsigned char* lds, int wave, int lane) {
    constexpr float QM_ = I8 ? 127.0f : F8MAX;
    LAS float* scr = (LAS float*)(lds + wave * 16384); LAS float* red = (LAS float*)(lds + LDSCTL_OFF + 2048);
    const int n0 = strip * 32, k0 = wave * 128, kk = lane >> 5, n = lane & 31;
    float am = 0.f;
#pragma unroll 16
    for (int i = 0; i < 64; ++i) { const float v = W[(size_t)(k0 + 2 * i + kk) * N + n0 + n]; scr[(2 * i + kk) * 32 + n] = v; am = fmaxf(am, fabsf(v)); }
    am = fmaxf(am, __shfl_xor(am, 32));
    if (lane < 32) red[wave * 32 + n] = am;
    __syncthreads();
    float amax = red[n];
#pragma unroll
    for (int w = 1; w < 8; ++w) amax = fmaxf(amax, red[w * 32 + n]);
    const float q = amax > 0.f ? QM_ / amax : 0.f;
    const int dr = dst_row<MODE>(n0 + n);
    if (wave == 0 && lane < 32) SC[dr] = amax * (1.0f / QM_);
#pragma unroll
    for (int c = 0; c < 4; ++c) { float v[16];
#pragma unroll
        for (int j = 0; j < 16; ++j) v[j] = scr[(kk * 64 + c * 16 + j) * 32 + n] * q;
        v4u o; o.x = pg8::pkq4<I8>(v[0], v[1], v[2], v[3]); o.y = pg8::pkq4<I8>(v[4], v[5], v[6], v[7]); o.z = pg8::pkq4<I8>(v[8], v[9], v[10], v[11]); o.w = pg8::pkq4<I8>(v[12], v[13], v[14], v[15]);
        *(GAS v4u*)(W8 + (size_t)dr * 1024 + k0 + kk * 64 + c * 16) = o; }
    __syncthreads();
}
__device__ __forceinline__ float ln_bound(const float* g, const float* b, int lane) {
    float mg = 0.f, mb = 0.f;
#pragma unroll
    for (int j = 0; j < 4; ++j) { const f32x4 a = *(const f32x4*)(g + j * 256 + lane * 4), c = *(const f32x4*)(b + j * 256 + lane * 4);
        mg = fmaxf(mg, fmaxf(fmaxf(fabsf(a[0]), fabsf(a[1])), fmaxf(fabsf(a[2]), fabsf(a[3])))); mb = fmaxf(mb, fmaxf(fmaxf(fabsf(c[0]), fabsf(c[1])), fmaxf(fabsf(c[2]), fabsf(c[3])))); }
#pragma unroll
    for (int o = 1; o < 64; o <<= 1) { mg = fmaxf(mg, __shfl_xor(mg, o)); mb = fmaxf(mb, __shfl_xor(mb, o)); }
    return 31.984371f * mg + mb;
}

struct Ptrs {
    const float *x, *rel_bias, *attn_w_in, *attn_lambda, *attn_subln, *attn_w_out, *conv_w_in, *conv_w, *conv_w_out, *router_w, *router_b, *w1, *b1, *w2, *b2, *ln_g, *ln_b;
    float* out; unsigned char* ws;
};

constexpr int NWAVES_ = 8;
__device__ __forceinline__ void p0_prologue(const Ptrs& P, LAS unsigned char* lds, int gw, int NGW, int wave, int lane) {
    LAS float* scr = (LAS float*)(lds + RING_OFF + wave * 16384);
    unsigned char* ws = P.ws;
    constexpr int I_OUT = 16 * 32, I_R = 16;
    constexpr int I_IN = 16 * 96;
    constexpr int S1 = NA16 * I_OUT, S3 = S1 + NO16 * I_OUT, S4 = S3 + 4 * I_R, S5 = S4 + NQ16 * I_IN, S6 = S5 + NC16 * I_IN;
    { const int wg = gw / NWAVES_, NWG = NGW / NWAVES_;
      constexpr int T1 = 128 * 64, T2 = T1 + 128 * 32, T3 = T2 + NQ8 * 96, T4 = T3 + NC8 * 96, T5 = T4 + NA8 * 32, T6 = T5 + NO8 * 32;
#pragma unroll 1
      for (int st = wg; st < T6; st += NWG) {
        if (st < T1) { const int j = st >> 6, r = st & 63; p0_quant_strip<2>(P.w1 + (size_t)j * 1024 * 2048, 2048, ws + WS_W1 + (size_t)j * 2048 * 1024, (float*)(ws + WS_S1) + (size_t)j * 2048, r, lds, wave, lane); }
        else if (st < T2) { const int q = st - T1, j = q >> 5, r = q & 31; p0_quant_strip<0>(P.w2 + (size_t)j * 1024 * 1024, 1024, ws + WS_W2 + (size_t)j * 1024 * 1024, (float*)(ws + WS_S2) + (size_t)j * 1024, r, lds, wave, lane); }
        else if (st < T3) { const int q = st - T2, j = QJ0 + q / 96, r = q % 96; p0_quant_strip<0, I8P>(P.attn_w_in + (size_t)j * 1024 * 3072, 3072, ws + WS_WAI + (size_t)j * 3072 * 1024, (float*)(ws + WS_SD) + (size_t)j * 3072, r, lds, wave, lane); }
        else if (st < T4) { const int q = st - T3, j = CJ0 + q / 96, r = q % 96; p0_quant_strip<1, I8P>(P.conv_w_in + (size_t)j * 1024 * 3072, 3072, ws + WS_WCI + (size_t)j * 3072 * 1024, (float*)(ws + WS_SD + 32 * 1024) + (size_t)j * 3072, r, lds, wave, lane); }
        else if (st < T5) { const int q = st - T4, j = AJ0 + q / 32, r = q % 32; p0_quant_strip<0>(P.attn_w_out + (size_t)j * 1024 * 1024, 1024, ws + WS_WAO8 + (size_t)j * 1024 * 1024, (float*)(ws + WS_SD + 24 * 1024) + (size_t)j * 1024, r, lds, wave, lane); }
        else { const int q = st - T5, j = OJ0 + q / 32, r = q % 32; p0_quant_strip<0, I8P>(P.conv_w_out + (size_t)j * 1024 * 1024, 1024, ws + WS_WCO8 + (size_t)j * 1024 * 1024, (float*)(ws + WS_SD + 56 * 1024) + (size_t)j * 1024, r, lds, wave, lane); }
      } }
    for (int it = gw; it < S6; it += NGW) {
        if (it >= S5) { const int q = it - S5, j = CK0 + q / I_IN, r = q % I_IN; p0_transpose_item<1>(P.conv_w_in + (size_t)j * 1024 * 3072, 1024, 3072, (bf16_t*)(ws + WS_WC16) + (size_t)j * 3072 * 1024, scr, r, lane); }
        else if (it >= S4) { const int q = it - S4, j = QK0 + q / I_IN, r = q % I_IN; p0_transpose_item<0>(P.attn_w_in + (size_t)j * 1024 * 3072, 1024, 3072, (bf16_t*)(ws + WS_WA16) + (size_t)j * 3072 * 1024, scr, r, lane); }
        else if (it < S1) { const int q = it, j = AK0 + q / I_OUT, r = q % I_OUT; p0_transpose_item<0>(P.attn_w_out + (size_t)j * 1024 * 1024, 1024, 1024, (bf16_t*)(ws + WS_WAO) + (size_t)j * 1024 * 1024, scr, r, lane); }
        else if (it < S3) { const int q = it - S1, j = OK0 + q / I_OUT, r = q % I_OUT; p0_transpose_item<0>(P.conv_w_out + (size_t)j * 1024 * 1024, 1024, 1024, (bf16_t*)(ws + WS_WCO) + (size_t)j * 1024 * 1024, scr, r, lane); }
        else { const int q = it - S3, j = q / I_R, r = q % I_R; p0_transpose_item<0>(P.router_w + (size_t)j * 1024 * 32, 1024, 32, (bf16_t*)(ws + WS_WR) + (size_t)j * 32 * 1024, scr, r, lane, P.ln_g + (size_t)(j * 2 + 0) * D); }
    }
    for (int row = gw; row < M; row += NGW) {
        f32x4 a[2][2]; float am = 0.f;
#pragma unroll
        for (int h = 0; h < 2; ++h)
#pragma unroll
            for (int q = 0; q < 2; ++q) { a[h][q] = *(const GAS f32x4*)(P.x + (size_t)row * D + h * 512 + lane * 8 + q * 4);
                am = fmaxf(am, fmaxf(fmaxf(fabsf(a[h][q][0]), fabsf(a[h][q][1])), fmaxf(fabsf(a[h][q][2]), fabsf(a[h][q][3])))); }
#pragma unroll
        for (int o = 1; o < 64; o <<= 1) am = fmaxf(am, __shfl_xor(am, o));
        const float qs = QMAXP / fmaxf(am, 1e-30f);
        if ((QM & 1) && lane == 0) ((float*)(ws + WS_RS))[row] = am * (1.0f / QMAXP);
#pragma unroll
        for (int h = 0; h < 2; ++h) { v4u o; o.x = cvt_pk_bf16(a[h][0][0], a[h][0][1]); o.y = cvt_pk_bf16(a[h][0][2], a[h][0][3]); o.z = cvt_pk_bf16(a[h][1][0], a[h][1][1]); o.w = cvt_pk_bf16(a[h][1][2], a[h][1][3]);
            *(GAS v4u*)((bf16_t*)(ws + WS_XB) + (size_t)row * D + h * 512 + lane * 8) = o;
            if (QM & 1) { typedef unsigned u32x2 __attribute__((ext_vector_type(2))); u32x2 q8;
            q8.x = pg8::pkq4<I8P>(a[h][0][0] * qs, a[h][0][1] * qs, a[h][0][2] * qs, a[h][0][3] * qs); q8.y = pg8::pkq4<I8P>(a[h][1][0] * qs, a[h][1][1] * qs, a[h][1][2] * qs, a[h][1][3] * qs);
            *(GAS u32x2*)(ws + WS_XI + (size_t)row * D + h * 512 + lane * 8) = q8; } }
    }
}

__device__ __forceinline__ void conv_phase(const bf16_t* GB, const bf16_t* Z, const float* cw, bf16_t* Gout, float* RS, bool o8, int gw, int NGW, int lane) {
    float w[3][16];
#pragma unroll
    for (int j = 0; j < 3; ++j)
#pragma unroll
        for (int h = 0; h < 2; ++h)
#pragma unroll
            for (int q = 0; q < 2; ++q) { const f32x4 t = *(const f32x4*)(cw + j * D + h * 512 + lane * 8 + q * 4); w[j][h * 8 + q * 4 + 0] = t[0]; w[j][h * 8 + q * 4 + 1] = t[1]; w[j][h * 8 + q * 4 + 2] = t[2]; w[j][h * 8 + q * 4 + 3] = t[3]; }
    for (int run = gw; run < M / 32; run += NGW) {
        const int t0 = run * 32; const bool first = (t0 % SEQ) == 0, lastr = ((t0 + 32) % SEQ) == 0;
        v4u zp[2], zc[2], zn[2];
#pragma unroll
        for (int h = 0; h < 2; ++h) { zp[h] = first ? (v4u){0u, 0u, 0u, 0u} : *(const v4u*)(Z + (size_t)(t0 - 1) * D + h * 512 + lane * 8); zc[h] = *(const v4u*)(Z + (size_t)t0 * D + h * 512 + lane * 8); }
        for (int r = 0; r < 32; ++r) { const int t = t0 + r; const bool pad = lastr && (r == 31);
            float o[2][8];
#pragma unroll
            for (int h = 0; h < 2; ++h) {
                zn[h] = pad ? (v4u){0u, 0u, 0u, 0u} : *(const v4u*)(Z + (size_t)(t + 1) * D + h * 512 + lane * 8);
                const v4u gb = *(const v4u*)(GB + (size_t)t * D + h * 512 + lane * 8);
#pragma unroll
                for (int q = 0; q < 4; ++q) { const unsigned up = zp[h][q], uc = zc[h][q], un = zn[h][q], ug = gb[q]; const int c = h * 8 + q * 2;
                    o[h][q * 2 + 0] = bf_lo(ug) * (w[0][c] * bf_lo(up) + w[1][c] * bf_lo(uc) + w[2][c] * bf_lo(un));
                    o[h][q * 2 + 1] = bf_hi(ug) * (w[0][c + 1] * bf_hi(up) + w[1][c + 1] * bf_hi(uc) + w[2][c + 1] * bf_hi(un)); }
                if (!o8) { v4u ov; ov.x = cvt_pk_bf16(o[h][0], o[h][1]); ov.y = cvt_pk_bf16(o[h][2], o[h][3]); ov.z = cvt_pk_bf16(o[h][4], o[h][5]); ov.w = cvt_pk_bf16(o[h][6], o[h][7]);
                    *(v4u*)(Gout + (size_t)t * D + h * 512 + lane * 8) = ov; }
                zp[h] = zc[h]; zc[h] = zn[h];
            }
            if (o8) { float am = 0.f;
#pragma unroll
                for (int h = 0; h < 2; ++h)
#pragma unroll
                    for (int i = 0; i < 8; ++i) am = fmaxf(am, fabsf(o[h][i]));
#pragma unroll
                for (int s_ = 1; s_ < 64; s_ <<= 1) am = fmaxf(am, __shfl_xor(am, s_));
                const float qs = QMAXP / fmaxf(am, 1e-30f);
                if (lane == 0) RS[t] = am * (1.0f / QMAXP);
#pragma unroll
                for (int h = 0; h < 2; ++h) { typedef unsigned u32x2 __attribute__((ext_vector_type(2))); u32x2 q8;
                    q8.x = pg8::pkq4<I8P>(o[h][0] * qs, o[h][1] * qs, o[h][2] * qs, o[h][3] * qs); q8.y = pg8::pkq4<I8P>(o[h][4] * qs, o[h][5] * qs, o[h][6] * qs, o[h][7] * qs);
                    *(u32x2*)((unsigned char*)Gout + (size_t)t * D + h * 512 + lane * 8) = q8; } }
        }
    }
}

__device__ __forceinline__ void ln2_phase(const bf16_t* Yp, const float* g1, const float* b1, const unsigned char* Y, const float* g, const float* bta, bf16_t* XB, float* out, unsigned char* XI, float* RS, int gw, int NGW, int lane) {
    float gg[16], bb[16];
#pragma unroll
    for (int h = 0; h < 2; ++h)
#pragma unroll
        for (int q = 0; q < 2; ++q) { const f32x4 t = *(const f32x4*)(g + h * 512 + lane * 8 + q * 4), s = *(const f32x4*)(bta + h * 512 + lane * 8 + q * 4);
#pragma unroll
            for (int i = 0; i < 4; ++i) { gg[h * 8 + q * 4 + i] = t[i]; bb[h * 8 + q * 4 + i] = s[i]; } }
    float sXb = 0.f, rsXb = 0.f; if constexpr (!I8P) { const float lb = ln_bound(g, bta, lane); sXb = F8MAX / lb; rsXb = lb * (1.0f / F8MAX); }
    for (int row = gw; row < M; row += NGW) {
        float v[16];
#pragma unroll
        for (int h = 0; h < 2; ++h) { const v4u xr = *(const v4u*)(Yp + (size_t)row * D + h * 512 + lane * 8);
#pragma unroll
            for (int q = 0; q < 4; ++q) { v[h * 8 + q * 2] = bf_lo(xr[q]); v[h * 8 + q * 2 + 1] = bf_hi(xr[q]); } }
        { float s1 = 0.f;
#pragma unroll
          for (int i = 0; i < 16; ++i) s1 += v[i];
          const float m1 = wave_sum(s1) * (1.f / D); float q1 = 0.f;
#pragma unroll
          for (int i = 0; i < 16; ++i) { v[i] -= m1; q1 += v[i] * v[i]; }
          const float r1 = ALPHA / sqrtf(wave_sum(q1) * (1.f / D) + LN_EPS);
#pragma unroll
          for (int h = 0; h < 2; ++h)
#pragma unroll
            for (int q = 0; q < 2; ++q) { const f32x4 t = *(const f32x4*)(g1 + h * 512 + lane * 8 + q * 4), u = *(const f32x4*)(b1 + h * 512 + lane * 8 + q * 4);
#pragma unroll
              for (int i = 0; i < 4; ++i) v[h * 8 + q * 4 + i] = v[h * 8 + q * 4 + i] * r1 * t[i] + ALPHA * u[i]; } }
#pragma unroll
        for (int k = 0; k < 4; ++k)
#pragma unroll
            for (int h = 0; h < 2; ++h) { typedef unsigned u32x2 __attribute__((ext_vector_type(2))); const u32x2 yr = *(const u32x2*)(Y + ((size_t)row * 4 + k) * D + h * 512 + lane * 8);
#pragma unroll
                for (int q = 0; q < 2; ++q) { const f32x2 lo = __builtin_amdgcn_cvt_pk_f32_fp8((int)yr[q], false), hi2 = __builtin_amdgcn_cvt_pk_f32_fp8((int)yr[q], true);
                    v[h * 8 + q * 4 + 0] += lo[0] * (1.0f / YSCALE); v[h * 8 + q * 4 + 1] += lo[1] * (1.0f / YSCALE); v[h * 8 + q * 4 + 2] += hi2[0] * (1.0f / YSCALE); v[h * 8 + q * 4 + 3] += hi2[1] * (1.0f / YSCALE); } }
        float s = 0.f;
#pragma unroll
        for (int i = 0; i < 16; ++i) s += v[i];
        const float mean = wave_sum(s) * (1.f / D); float s2 = 0.f;
#pragma unroll
        for (int i = 0; i < 16; ++i) { v[i] -= mean; s2 += v[i] * v[i]; }
        const float rstd = 1.f / sqrtf(wave_sum(s2) * (1.f / D) + LN_EPS);
#pragma unroll
        for (int i = 0; i < 16; ++i) v[i] = v[i] * rstd * gg[i] + bb[i];
        float sX = sXb, rsX = rsXb;
        if (I8P && XI) { float am = 0.f;
#pragma unroll
            for (int i = 0; i < 16; ++i) am = fmaxf(am, fabsf(v[i]));
#pragma unroll
            for (int o = 1; o < 64; o <<= 1) am = fmaxf(am, __shfl_xor(am, o));
            sX = QMAXP / fmaxf(am, 1e-30f); rsX = am * (1.0f / QMAXP); }
#pragma unroll
        for (int h = 0; h < 2; ++h) { v4u ov; ov.x = cvt_pk_bf16(v[h * 8 + 0], v[h * 8 + 1]); ov.y = cvt_pk_bf16(v[h * 8 + 2], v[h * 8 + 3]); ov.z = cvt_pk_bf16(v[h * 8 + 4], v[h * 8 + 5]); ov.w = cvt_pk_bf16(v[h * 8 + 6], v[h * 8 + 7]);
            if (!out) *(v4u*)(XB + (size_t)row * D + h * 512 + lane * 8) = ov;
            if (XI) { typedef unsigned u32x2 __attribute__((ext_vector_type(2))); u32x2 q8; q8.x = pg8::pkq4<I8P>(v[h * 8 + 0] * sX, v[h * 8 + 1] * sX, v[h * 8 + 2] * sX, v[h * 8 + 3] * sX); q8.y = pg8::pkq4<I8P>(v[h * 8 + 4] * sX, v[h * 8 + 5] * sX, v[h * 8 + 6] * sX, v[h * 8 + 7] * sX);
                *(u32x2*)(XI + (size_t)row * D + h * 512 + lane * 8) = q8; if (h == 0 && lane == 0) RS[row] = rsX; }
            if (out) { *(f32x4*)(out + (size_t)row * D + h * 512 + lane * 8) = (f32x4){v[h * 8 + 0], v[h * 8 + 1], v[h * 8 + 2], v[h * 8 + 3]};
                       *(f32x4*)(out + (size_t)row * D + h * 512 + lane * 8 + 4) = (f32x4){v[h * 8 + 4], v[h * 8 + 5], v[h * 8 + 6], v[h * 8 + 7]}; } }
    }
}

constexpr int RT_PITCH = 2064, R_OFF_G = 32 * RT_PITCH, R_OFF_LG = R_OFF_G + 8192, R_OFF_CNT = R_OFF_LG + 8 * 16 * 33 * 4, R_OFF_SW = R_OFF_CNT + 256, R_LDS = R_OFF_SW + 256;
typedef __bf16 bf16x2_t __attribute__((ext_vector_type(2)));
__device__ __forceinline__ void router_phase(const bf16_t* Yp, const float* g, const float* bta, const bf16_t* RTg, const float* Wr, const float* rb, unsigned char* X8, int* lslot, float* lgate, unsigned* cnt,
                                             char* lds, int blk0, int G, int tid, int wave, int lane) {
    for (int i = tid; i < 32 * 128; i += 512) { const int e = i >> 7, c = i & 127; *(v4u*)(lds + e * RT_PITCH + c * 16) = *(const v4u*)(RTg + (size_t)e * 1024 + c * 8); }
    float* gl = (float*)(lds + R_OFF_G); float* bl = gl + 1024;
    for (int i = tid; i < 1024; i += 512) { gl[i] = g[i]; bl[i] = bta[i]; }
    float* LG = (float*)(lds + R_OFF_LG) + wave * (16 * 33);
    int* lcnt = (int*)(lds + R_OFF_CNT); int* lbase = lcnt + 32;
    float* sWl = (float*)(lds + R_OFF_SW); float* cBl = sWl + 32;
    __syncthreads();
#pragma unroll 1
    for (int j = 0; j < 4; ++j) { const int e = wave * 4 + j; float a = 0.f, c = 0.f;
#pragma unroll 4
        for (int i = 0; i < 16; ++i) { const int k = lane + 64 * i; a += __uint_as_float((unsigned)(*(const bf16_t*)(lds + e * RT_PITCH + k * 2)) << 16); c += bl[k] * Wr[(size_t)k * 32 + e]; }
        a = wave_sum(a); c = wave_sum(c); if (lane == 0) { sWl[e] = a; cBl[e] = c + rb[e]; } }
    const int t16 = lane & 15, kq = lane >> 4;
    const float sA = F8MAX / ln_bound(g, bta, lane);
#pragma unroll 1
    for (int blk = blk0; blk < M / 128; blk += G) {
        if (tid < 32) lcnt[tid] = 0;
        __syncthreads();
        int my_e, my_rank, my_slot; float my_gate;
        const int r0 = blk * 128 + wave * 16; const size_t rowoff = (size_t)(r0 + t16) * D + kq * 8;
        v4u yv[32];
#pragma unroll
        for (int kb = 0; kb < 32; ++kb) yv[kb] = *(const v4u*)(Yp + rowoff + kb * 32);
        f32x4 acc0 = {0.f, 0.f, 0.f, 0.f}, acc1 = {0.f, 0.f, 0.f, 0.f}, accs = {0.f, 0.f, 0.f, 0.f}, accq = {0.f, 0.f, 0.f, 0.f};
        const bf16x8 ones8 = {(short)0x3F80, (short)0x3F80, (short)0x3F80, (short)0x3F80, (short)0x3F80, (short)0x3F80, (short)0x3F80, (short)0x3F80};
#pragma unroll
        for (int kb = 0; kb < 32; ++kb) { const int c0 = kb * 32 + kq * 8;
            const bf16x8 w0 = *(const bf16x8*)(lds + t16 * RT_PITCH + c0 * 2), w1 = *(const bf16x8*)(lds + (16 + t16) * RT_PITCH + c0 * 2);
            const bf16x8 xb = __builtin_bit_cast(bf16x8, yv[kb]);
            acc0 = __builtin_amdgcn_mfma_f32_16x16x32_bf16(w0, xb, acc0, 0, 0, 0);
            acc1 = __builtin_amdgcn_mfma_f32_16x16x32_bf16(w1, xb, acc1, 0, 0, 0);
            accs = __builtin_amdgcn_mfma_f32_16x16x32_bf16(ones8, xb, accs, 0, 0, 0);
            accq = __builtin_amdgcn_mfma_f32_16x16x32_bf16(xb, xb, accq, 0, 0, 0); }
        const float s = accs[0];
        const int dsel = t16 & 3; float dq_ = dsel == 0 ? accq[0] : (dsel == 1 ? accq[1] : (dsel == 2 ? accq[2] : accq[3]));
        const float s2 = __shfl(dq_, (t16 >> 2) * 16 + t16);
        const float mean = s * (1.f / D); const float var = fmaxf(s2 * (1.f / D) - mean * mean, 0.f);
        const float rstd = 1.f / sqrtf(var + LN_EPS);
        {
            float* lgr = LG + t16 * 33;
#pragma unroll
            for (int i = 0; i < 4; ++i) { const int e0 = kq * 4 + i, e1 = 16 + kq * 4 + i;
                lgr[e0] = rstd * (acc0[i] - mean * sWl[e0]) + cBl[e0]; lgr[e1] = rstd * (acc1[i] - mean * sWl[e1]) + cBl[e1]; }
            LDS_WAIT(); asm volatile("" ::: "memory");
            float t0 = -INFINITY, t1 = -INFINITY, t2 = -INFINITY, t3 = -INFINITY; int i0 = 0, i1 = 0, i2 = 0, i3 = 0;
#pragma unroll
            for (int e = 0; e < 32; ++e) { const float v = lgr[e];
                const bool c0 = v > t0, c1 = v > t1, c2 = v > t2, c3 = v > t3;
                t3 = c2 ? t2 : (c3 ? v : t3); i3 = c2 ? i2 : (c3 ? e : i3);
                t2 = c1 ? t1 : (c2 ? v : t2); i2 = c1 ? i1 : (c2 ? e : i2);
                t1 = c0 ? t0 : (c1 ? v : t1); i1 = c0 ? i0 : (c1 ? e : i1);
                t0 = c0 ? v : t0; i0 = c0 ? e : i0; }
            const float e1 = __expf(t1 - t0), e2 = __expf(t2 - t0), e3 = __expf(t3 - t0); const float inv = 1.f / (1.f + e1 + e2 + e3);
            const int ek = kq == 0 ? i0 : (kq == 1 ? i1 : (kq == 2 ? i2 : i3)); const float gk = (kq == 0 ? 1.f : (kq == 1 ? e1 : (kq == 2 ? e2 : e3))) * inv;
            my_e = ek; my_gate = gk; my_slot = (r0 + t16) * 4 + kq; my_rank = atomicAdd(&lcnt[ek], 1);
            LDS_WAIT(); asm volatile("" ::: "memory");
        }
        const float rs = rstd * sA;
#pragma unroll
        for (int kb = 0; kb < 32; ++kb) { const int c0 = kb * 32 + kq * 8; const v4u y = yv[kb];
            const f32x4 g0 = *(const f32x4*)(gl + c0) * rs, g1 = *(const f32x4*)(gl + c0 + 4) * rs, b0 = *(const f32x4*)(bl + c0) * sA, b1 = *(const f32x4*)(bl + c0 + 4) * sA;
            typedef unsigned u32x2 __attribute__((ext_vector_type(2))); u32x2 q8;
            q8.x = pg8::pk4_fp8((bf_lo(y.x) - mean) * g0[0] + b0[0], (bf_hi(y.x) - mean) * g0[1] + b0[1], (bf_lo(y.y) - mean) * g0[2] + b0[2], (bf_hi(y.y) - mean) * g0[3] + b0[3]);
            q8.y = pg8::pk4_fp8((bf_lo(y.z) - mean) * g1[0] + b1[0], (bf_hi(y.z) - mean) * g1[1] + b1[1], (bf_lo(y.w) - mean) * g1[2] + b1[2], (bf_hi(y.w) - mean) * g1[3] + b1[3]);
            *(u32x2*)(X8 + rowoff + kb * 32) = q8;
            asm volatile("" ::: "memory"); }
        __syncthreads();
        if (tid < 32) lbase[tid] = (int)__hip_atomic_fetch_add(cnt + tid * 64, (unsigned)lcnt[tid], RLX_AGENT);
        __syncthreads();
        { const int pos = lbase[my_e] + my_rank; lslot[(size_t)my_e * LCAP + pos] = my_slot; lgate[(size_t)my_e * LCAP + pos] = my_gate; }
        __syncthreads();
    }
}

__device__ __forceinline__ float attn_obound(const float* gsub, float osc, int lane) {
    float mg = fmaxf(fabsf(gsub[lane]), fabsf(gsub[64 + lane]));
#pragma unroll
    for (int o = 1; o < 64; o <<= 1) mg = fmaxf(mg, __shfl_xor(mg, o));
    return 11.3137085f * mg * fabsf(osc);
}

constexpr int NWAVES = 8;
constexpr int N_PHASES = 1 + DEPTH * 7;
#ifndef REP_ATTN
#define REP_ATTN 1
#endif
#ifndef KREP_MOE
#define KREP_MOE 1
#endif
#ifndef REP_MOE
#define REP_MOE 1
#endif
#ifndef REP_P0
#define REP_P0 1
#endif
#ifndef REP_THIN
#define REP_THIN 1
#endif
#ifndef REP_DENSE
#define REP_DENSE 1
#endif
#ifndef MK_SPLIT
#define MK_SPLIT 0
#endif
struct Args { const float* in[17]; float* out; unsigned char* ws; int ph_lo, ph_hi, li, pad; };
typedef const __attribute__((address_space(4))) Args* ArgsP;
enum { I_X = 0, I_RELB, I_AWIN, I_ALAM, I_ASUB, I_AWOUT, I_CWIN, I_CW, I_CWOUT, I_RW, I_RB, I_W1, I_B1, I_W2, I_B2, I_LNG, I_LNB };
__global__ void __launch_bounds__(NWAVES * 64, 2) mk_fwd(Args args) {
    extern __shared__ __attribute__((aligned(16))) unsigned char lds[];
    LAS unsigned char* ldsl = (LAS unsigned char*)lds;
    volatile LAS unsigned* MISC = (volatile LAS unsigned*)(ldsl + MISC_OFF);
    const int tid0 = threadIdx.x;
    const int wave0 = __builtin_amdgcn_readfirstlane(tid0 >> 6);
    const int G0 = gridDim.x, bx0 = blockIdx.x;
#define PHASE_BEGIN() int wv_ = wave0; asm volatile("" : "+s"(wv_)); int ln_; asm volatile("v_mbcnt_lo_u32_b32 %0, -1, 0\n\tv_mbcnt_hi_u32_b32 %0, -1, %0" : "=v"(ln_)); int tid = wv_ * 64 + ln_; int G = G0, bx = bx0; asm volatile("" : "+s"(G), "+s"(bx)); const int vcu = (G % 8 == 0) ? (bx % 8) * (G / 8) + bx / 8 : bx; const int NGW = G * NWAVES; \
        const int lane = tid & 63, wave = __builtin_amdgcn_readfirstlane(tid >> 6); const int gw = vcu * NWAVES + wave; (void)lane; (void)gw; (void)NGW; \
        ArgsP ap = (ArgsP)__builtin_amdgcn_kernarg_segment_ptr(); asm volatile("" : "+s"(ap)); unsigned char* ws = ap->ws; gu32* ctl = (gu32*)(ws + WS_CTL); (void)ctl
    for (int u = tid0; u < (LDS_BYTES - LDSCTL_OFF) / 4; u += NWAVES * 64) ((LAS unsigned*)(ldsl + LDSCTL_OFF))[u] = 0u;
    __syncthreads();
    XcdBarrier bar = xcd_barrier_post((unsigned*)(args.ws + WS_CTL) + CW_BAR + (size_t)args.li * 4096, MISC + 8);
    const int lo = args.ph_lo, hi = args.ph_hi;
#define IN(k) (lo <= (k) && (k) < hi)
#define SEAM(k) do { if (IN((k) + 1)) xcd_barrier(bar); } while (0)
    LAS int* tb = (LAS int*)(ldsl + LDSCTL_OFF); LAS int* cn = tb + 64;

    if (IN(0)) { PHASE_BEGIN();
        Ptrs P; P.x = ap->in[I_X]; P.attn_w_in = ap->in[I_AWIN]; P.attn_w_out = ap->in[I_AWOUT]; P.conv_w_in = ap->in[I_CWIN]; P.conv_w_out = ap->in[I_CWOUT]; P.router_w = ap->in[I_RW]; P.ln_g = ap->in[I_LNG]; P.w1 = ap->in[I_W1]; P.w2 = ap->in[I_W2]; P.ws = ws;
        _Pragma("unroll 1") for (int rep = 0; rep < REP_P0; ++rep) p0_prologue(P, ldsl, gw, NGW, wave, lane); SEAM(0); }

#define MOE_GEMMS(L, pb) do { \
            if (IN((pb) + 4)) { PHASE_BEGIN(); \
                pg8::MoeProb<true, true> S{(const char*)(ws + WS_X8), (const char*)(ws + WS_W1) + (size_t)(L) * 32 * 2048 * 1024, (size_t)2048 * 1024, 8, G, vcu, (int)tb[32], tb, cn, (const int*)(ws + WS_LS), lane, tid}; \
                pg8::EpiMoe1 E{ws + WS_A2, ap->in[I_B1] + (size_t)(L) * 32 * 2048, (const float*)(ws + WS_S1) + (size_t)(L) * 32 * 2048, ln_bound(ap->in[I_LNG] + ((L) * 2 + 0) * D, ap->in[I_LNB] + ((L) * 2 + 0) * D, lane) * (1.0f / F8MAX) * (1.0f / KREP_MOE)}; \
                pg8::gemm_phase<pg8::MoeProb<true, true>, pg8::EpiMoe1, true, true, KREP_MOE>(ldsl + RING_OFF, ldsl + XL_OFF, S, E); \
                SEAM((pb) + 4); \
            } \
            if (IN((pb) + 5)) { PHASE_BEGIN(); \
                pg8::MoeProb<false, true> S{(const char*)(ws + WS_A2), (const char*)(ws + WS_W2) + (size_t)(L) * 32 * 1024 * 1024, (size_t)1024 * 1024, 4, G, vcu, (int)tb[32], tb, cn, (const int*)(ws + WS_LS), lane, tid}; \
                pg8::EpiMoe2 E{ws + WS_Y, ap->in[I_B2] + (size_t)(L) * 32 * 1024, (const float*)(ws + WS_S2) + (size_t)(L) * 32 * 1024, (const int*)(ws + WS_LS), (const float*)(ws + WS_LG)}; \
                pg8::gemm_phase<pg8::MoeProb<false, true>, pg8::EpiMoe2, true, true, KREP_MOE>(ldsl + RING_OFF, ldsl + XL_OFF, S, E); \
                SEAM((pb) + 5); \
            } \
        } while (0)
#if REP_MOE == 2
#define MOE_GEMMS_REP(L, pb) MOE_GEMMS(L, pb)
#else
#define MOE_GEMMS_REP(L, pb) do {} while (0)
#endif
#define MOE_HALF(L, pb) do { \
            if (IN((pb) + 3)) { PHASE_BEGIN(); \
                router_phase((const bf16_t*)(ws + WS_YP), ap->in[I_LNG] + ((L) * 2 + 0) * D, ap->in[I_LNB] + ((L) * 2 + 0) * D, (const bf16_t*)(ws + WS_WR) + (size_t)(L) * 32 * 1024, ap->in[I_RW] + (size_t)(L) * 1024 * 32, ap->in[I_RB] + (L) * 32, \
                             ws + WS_X8, (int*)(ws + WS_LS), (float*)(ws + WS_LG), (unsigned*)(ctl + CW_CNT) + (L) * 32 * 64, (char*)lds + RING_OFF, vcu, G, tid, wave, lane); \
                SEAM((pb) + 3); \
            } \
            if (IN((pb) + 4) || IN((pb) + 5)) { PHASE_BEGIN(); \
                if (tid < 64) { const int c_ = (lane < 32) ? (int)__hip_atomic_load(ctl + CW_CNT + ((L) * 32 + (lane & 31)) * 64, RLX_AGENT) : 0; const int t_ = (c_ + 255) >> 8; int p_ = t_; \
                    _Pragma("unroll") for (int o_ = 1; o_ < 32; o_ <<= 1) { const int q_ = __shfl_up(p_, o_); if (lane >= o_) p_ += q_; } \
                    if (lane < 32) { cn[lane] = c_; tb[lane + 1] = p_; } if (lane == 0) tb[0] = 0; } \
                __syncthreads(); \
            } \
            MOE_GEMMS(L, pb); MOE_GEMMS_REP(L, pb); \
            if (REP_THIN == 2 && IN((pb) + 6)) { PHASE_BEGIN(); \
                ln2_phase((const bf16_t*)(ws + WS_YP), ap->in[I_LNG] + ((L) * 2 + 0) * D, ap->in[I_LNB] + ((L) * 2 + 0) * D, (const unsigned char*)(ws + WS_Y), ap->in[I_LNG] + ((L) * 2 + 1) * D, ap->in[I_LNB] + ((L) * 2 + 1) * D, (bf16_t*)(ws + WS_XB), ((L) == DEPTH - 1) ? ap->out : nullptr, ((((L) == 0) && (CM & 1)) || (((L) == 1) && (QM & 2)) || (((L) == 2) && (CM & 2))) ? ws + WS_XI : nullptr, (float*)(ws + WS_RS), gw, NGW, lane); \
            } \
            if (IN((pb) + 6)) { PHASE_BEGIN(); \
                ln2_phase((const bf16_t*)(ws + WS_YP), ap->in[I_LNG] + ((L) * 2 + 0) * D, ap->in[I_LNB] + ((L) * 2 + 0) * D, (const unsigned char*)(ws + WS_Y), ap->in[I_LNG] + ((L) * 2 + 1) * D, ap->in[I_LNB] + ((L) * 2 + 1) * D, (bf16_t*)(ws + WS_XB), ((L) == DEPTH - 1) ? ap->out : nullptr, ((((L) == 0) && (CM & 1)) || (((L) == 1) && (QM & 2)) || (((L) == 2) && (CM & 2))) ? ws + WS_XI : nullptr, (float*)(ws + WS_RS), gw, NGW, lane); \
                if ((pb) + 7 < N_PHASES) SEAM((pb) + 6); \
            } \
        } while (0)

#pragma unroll 1
    for (int lp = 0; lp < DEPTH / 2; ++lp) {
        {
            const int L = 2 * lp, pb = 1 + L * 7;
            if (IN(pb + 0)) {
                PHASE_BEGIN();
                if (QM == 3 || (QM != 0 && ((QM >> lp) & 1))) {
                pg8::DenseProbT<true> S; S.init(ws + WS_XI, ws + WS_WAI + (size_t)lp * 3072 * 1024, M, 3072, G, bx, tid);
                pg8::EpiQKV8 E{(bf16_t*)(ws + WS_Q), (size_t)(WS_K - WS_Q) / 2, QSCALE, (const float*)(ws + WS_SD) + lp * 3072, (const float*)(ws + WS_RS)};
                pg8::gemm_phase<pg8::DenseProbT<true>, pg8::EpiQKV8, true, true, 1, I8P>(ldsl + RING_OFF, ldsl + XL_OFF, S, E);
                } else {
                pg8::DenseProb S; S.init(ws + WS_XB, (const bf16_t*)(ws + WS_WA16) + (size_t)lp * 3072 * 1024, M, 3072, G, bx, tid);
                pg8::EpiQKV E{(bf16_t*)(ws + WS_Q), (size_t)(WS_K - WS_Q) / 2, QSCALE};
                pg8::gemm_phase<pg8::DenseProb, pg8::EpiQKV, true>(ldsl + RING_OFF, ldsl + XL_OFF, S, E);
                }
                SEAM(pb + 0);
            }
            if (IN(pb + 1)) {
                PHASE_BEGIN();
                const float* lf = ap->in[I_ALAM] + lp * 256;
                const float s1 = wave_sum(lf[lane] * lf[64 + lane]), s2 = wave_sum(lf[128 + lane] * lf[192 + lane]);
                const float lam_init = (lp == 0) ? 0.2f : (0.8f - 0.6f * 0.54881163609402643f);
                const float lam = __expf(s1) - __expf(s2) + lam_init;
                const bool o8 = (AOM == 3) || (AOM != 0 && ((AOM >> lp) & 1));
                const float oscl = o8 ? (1.0f - lam_init) * (F8MAX / attn_obound(ap->in[I_ASUB] + lp * 128, 1.0f - lam_init, lane)) : (1.0f - lam_init);
                int hprev = -1;
#pragma unroll 1
                for (int rep = 0; rep < REP_ATTN; ++rep)
#pragma unroll 1
                for (int i = 0; i < (BATCH * NH * 32) / 256; ++i) {
                    const int item = i * G + vcu;
                    if (item >= BATCH * NH * 32) break;
                    const int bh = item >> 5, qb = item & 31;
                    const bool newh = (i == 0) || ((bh & 7) != hprev); hprev = bh & 7;
                    att::attn_unit(bh >> 3, bh & 7, qb, (const bf16_t*)(ws + WS_Q), (const bf16_t*)(ws + WS_K), (const bf16_t*)(ws + WS_V), (bf16_t*)(ws + WS_O), lam, oscl,
                                   ap->in[I_ASUB] + lp * 128, ap->in[I_RELB], (char*)lds + RING_OFF, tid, newh, o8);
                }
                SEAM(pb + 1);
            }
            if (IN(pb + 2)) {
                PHASE_BEGIN();
                if ((AOM == 3) || (AOM != 0 && ((AOM >> lp) & 1))) {
                const float lam_init = (lp == 0) ? 0.2f : (0.8f - 0.6f * 0.54881163609402643f);
                pg8::DenseProbT<true> S; S.init(ws + WS_O, ws + WS_WAO8 + (size_t)lp * 1024 * 1024, M, 1024, G, bx, tid);
                pg8::EpiResid8<false> E{(const bf16_t*)(ws + WS_XB), (bf16_t*)(ws + WS_YP), (const float*)(ws + WS_SD + 24 * 1024) + lp * 1024, nullptr, attn_obound(ap->in[I_ASUB] + lp * 128, 1.0f - lam_init, lane) * (1.0f / F8MAX)};
                pg8::gemm_phase<pg8::DenseProbT<true>, pg8::EpiResid8<false>, true, true>(ldsl + RING_OFF, ldsl + XL_OFF, S, E);
                } else {
                pg8::DenseProb S; S.init(ws + WS_O, (const bf16_t*)(ws + WS_WAO) + (size_t)lp * 1024 * 1024, M, 1024, G, bx, tid);
                pg8::EpiResid E{(const bf16_t*)(ws + WS_XB), (bf16_t*)(ws + WS_YP)};
                pg8::gemm_phase<pg8::DenseProb, pg8::EpiResid, true>(ldsl + RING_OFF, ldsl + XL_OFF, S, E);
                }
                SEAM(pb + 2);
            }
            MOE_HALF(L, pb);
        }
        {
            const int L = 2 * lp + 1, pb = 1 + L * 7;
            if (IN(pb + 0)) {
                PHASE_BEGIN();
                if (CM == 3 || (CM != 0 && ((CM >> lp) & 1))) {
                pg8::DenseProbT<true> S; S.init(ws + WS_XI, ws + WS_WCI + (size_t)lp * 3072 * 1024, M, 3072, G, bx, tid);
                pg8::EpiConvIn8 E{(bf16_t*)(ws + WS_Q), (bf16_t*)(ws + WS_K), (const float*)(ws + WS_SD + 32 * 1024) + lp * 3072, (const float*)(ws + WS_RS)};
                pg8::gemm_phase<pg8::DenseProbT<true>, pg8::EpiConvIn8, true, true, 1, I8P>(ldsl + RING_OFF, ldsl + XL_OFF, S, E);
                } else {
                pg8::DenseProb S; S.init(ws + WS_XB, (const bf16_t*)(ws + WS_WC16) + (size_t)lp * 3072 * 1024, M, 3072, G, bx, tid);
                pg8::EpiConvIn E{(bf16_t*)(ws + WS_Q), (bf16_t*)(ws + WS_K)};
                pg8::gemm_phase<pg8::DenseProb, pg8::EpiConvIn, true>(ldsl + RING_OFF, ldsl + XL_OFF, S, E);
                }
                SEAM(pb + 0);
            }
            if (IN(pb + 1)) { PHASE_BEGIN(); conv_phase((const bf16_t*)(ws + WS_Q), (const bf16_t*)(ws + WS_K), ap->in[I_CW] + lp * 3 * D, (bf16_t*)(ws + WS_O), (float*)(ws + WS_RS), (COM == 3) || (COM != 0 && ((COM >> lp) & 1)), gw, NGW, lane); SEAM(pb + 1); }
            if (IN(pb + 2)) {
                PHASE_BEGIN();
                if ((COM == 3) || (COM != 0 && ((COM >> lp) & 1))) {
                pg8::DenseProbT<true> S; S.init(ws + WS_O, ws + WS_WCO8 + (size_t)lp * 1024 * 1024, M, 1024, G, bx, tid);
                pg8::EpiResid8<true> E{(const bf16_t*)(ws + WS_XB), (bf16_t*)(ws + WS_YP), (const float*)(ws + WS_SD + 56 * 1024) + lp * 1024, (const float*)(ws + WS_RS), 1.0f};
                pg8::gemm_phase<pg8::DenseProbT<true>, pg8::EpiResid8<true>, true, true, 1, I8P>(ldsl + RING_OFF, ldsl + XL_OFF, S, E);
                } else {
                pg8::DenseProb S; S.init(ws + WS_O, (const bf16_t*)(ws + WS_WCO) + (size_t)lp * 1024 * 1024, M, 1024, G, bx, tid);
                pg8::EpiResid E{(const bf16_t*)(ws + WS_XB), (bf16_t*)(ws + WS_YP)};
                pg8::gemm_phase<pg8::DenseProb, pg8::EpiResid, true>(ldsl + RING_OFF, ldsl + XL_OFF, S, E);
                }
                SEAM(pb + 2);
            }
            MOE_HALF(L, pb);
        }
    }
#undef IN
#undef SEAM
}

extern "C" void kernel_launch(void* const* d_in, const int* in_sizes, int n_in, void* d_out, int out_size, void* d_ws, size_t ws_size, hipStream_t stream) {
    static int grid = 0;
    if (grid == 0) {
        if (n_in != 17 || in_sizes[0] != M * D || out_size != M * D || ws_size < WS_END) {
            fprintf(stderr, "kernel_launch: shape mismatch: n_in %d in0 %d out %d ws %zu (need %zu)\n", n_in, n_in > 0 ? in_sizes[0] : -1, out_size, ws_size, (size_t)WS_END); grid = -1; return; }
        int dev = 0, cus = 0, per_cu = 0;
        if (hipGetDevice(&dev) != hipSuccess || hipDeviceGetAttribute(&cus, hipDeviceAttributeMultiprocessorCount, dev) != hipSuccess) { grid = -1; return; }
        if (hipFuncSetAttribute((const void*)mk_fwd, hipFuncAttributeMaxDynamicSharedMemorySize, LDS_BYTES) != hipSuccess) { fprintf(stderr, "kernel_launch: hipFuncSetAttribute failed\n"); grid = -1; return; }
        if (hipOccupancyMaxActiveBlocksPerMultiprocessor(&per_cu, (const void*)mk_fwd, NWAVES * 64, LDS_BYTES) != hipSuccess || per_cu < 1)
            fprintf(stderr, "kernel_launch: occupancy query reports %d workgroups per CU\n", per_cu);
        (void)hipGetLastError();
        grid = cus;
    }
    if (grid < 0) return;
    if (hipMemsetAsync((char*)d_ws + WS_CTL, 0, CTL_ZERO_BYTES, stream) != hipSuccess) { fprintf(stderr, "kernel_launch: memset failed\n"); return; }
    Args a{};
    for (int i = 0; i < 17; ++i) a.in[i] = (const float*)d_in[i];
    a.out = (float*)d_out; a.ws = (unsigned char*)d_ws; a.pad = 0;
#if MK_SPLIT
    for (int p = 0; p < N_PHASES; ++p) { a.ph_lo = p; a.ph_hi = p + 1; a.li = p; hipLaunchKernelGGL(mk_fwd, dim3(grid), dim3(NWAVES * 64), LDS_BYTES, stream, a); }
#else
    a.ph_lo = 0; a.ph_hi = N_PHASES; a.li = 0;
    hipLaunchKernelGGL(mk_fwd, dim3(grid), dim3(NWAVES * 64), LDS_BYTES, stream, a);
#endif
    const hipError_t le = hipPeekAtLastError();
    if (le != hipSuccess) fprintf(stderr, "kernel_launch: launch failed: %s\n", hipGetErrorName(le));
}
```

```cpp
#include <hip/hip_runtime.h>
#include <hip/hip_bf16.h>
#include <cstdio>
#include <cstdint>

constexpr int BATCH = 16, SEQ = 4096, D = 1024, M = BATCH * SEQ, DEPTH = 4, NH = 8, NE = 32, TOPK = 4;
constexpr float LN_EPS = 1e-5f;
constexpr float ALPHA = 1.6817928305074290f;
constexpr float LOG2E = 1.4426950408889634f;
constexpr float QSCALE = 0.125f * LOG2E;
constexpr int LCAP = 65536;
constexpr int MAXRT = 1056;

constexpr size_t MiB = 1ull << 20;
constexpr size_t WS_CTL = 0, CTL_ZERO_BYTES = 1 * MiB;
constexpr size_t WS_WAI = 1 * MiB;
constexpr size_t WS_WAO = WS_WAI + 12 * MiB;
constexpr size_t WS_WCI = WS_WAO + 4 * MiB;
constexpr size_t WS_WCO = WS_WCI + 12 * MiB;
constexpr size_t WS_WR  = WS_WCO + 4 * MiB;
constexpr size_t WS_W1  = WS_WR + 1 * MiB;
constexpr size_t WS_W2  = WS_W1 + 256 * MiB;
constexpr size_t WS_S1  = WS_W2 + 128 * MiB;
constexpr size_t WS_S2  = WS_S1 + 1 * MiB;
constexpr size_t WS_SD  = WS_S2 + 512 * 1024;
constexpr size_t WS_RS  = WS_SD + 64 * 1024;
constexpr size_t WS_XB  = WS_S2 + 1 * MiB;
constexpr size_t WS_XI  = WS_XB + 128 * MiB;
constexpr size_t WS_X8  = WS_XI + 128 * MiB;
constexpr size_t WS_YP  = WS_X8 + 64 * MiB;
constexpr size_t WS_Q   = WS_YP + 128 * MiB;
constexpr size_t WS_K   = WS_Q + 128 * MiB;
constexpr size_t WS_V   = WS_K + 128 * MiB;
constexpr size_t WS_O   = WS_V + 128 * MiB;
constexpr size_t WS_LS  = WS_O + 128 * MiB;
constexpr size_t WS_LG  = WS_LS + 8 * MiB;
constexpr size_t WS_A2  = WS_LG + 8 * MiB;
constexpr size_t WS_Y   = WS_A2 + 264 * MiB;
constexpr size_t WS_WA16 = WS_Y + 513 * MiB;
constexpr size_t WS_WC16 = WS_WA16 + 12 * MiB;
constexpr size_t WS_WAO8 = WS_WC16 + 12 * MiB;
constexpr size_t WS_WCO8 = WS_WAO8 + 2 * MiB;
constexpr size_t WS_END = WS_WCO8 + 2 * MiB;
#ifndef F8_QKV_MASK
#define F8_QKV_MASK 3
#endif
#ifndef F8_CONV_MASK
#define F8_CONV_MASK 3
#endif
#ifndef F8_AOUT_MASK
#define F8_AOUT_MASK 3
#endif
#ifndef F8_COUT_MASK
#define F8_COUT_MASK 3
#endif
constexpr int QM = F8_QKV_MASK, CM = F8_CONV_MASK, AOM = F8_AOUT_MASK, COM = F8_COUT_MASK;
constexpr int NA8 = (AOM & 1) + (AOM >> 1), NO8 = (COM & 1) + (COM >> 1), AJ0 = (AOM & 1) ? 0 : 1, OJ0 = (COM & 1) ? 0 : 1;
constexpr int NA16 = 2 - NA8, NO16 = 2 - NO8, AK0 = (AOM & 1) ? 1 : 0, OK0 = (COM & 1) ? 1 : 0;
constexpr int NQ8 = (QM & 1) + (QM >> 1), NC8 = (CM & 1) + (CM >> 1), QJ0 = (QM & 1) ? 0 : 1, CJ0 = (CM & 1) ? 0 : 1;
constexpr int NQ16 = 2 - NQ8, NC16 = 2 - NC8, QK0 = (QM & 1) ? 1 : 0, CK0 = (CM & 1) ? 1 : 0;
constexpr float F8MAX = 448.0f * 0.999f;
constexpr bool I8P = true;
constexpr float QMAXP = I8P ? 127.0f : 448.0f * 0.999f;
constexpr float YSCALE = 16.0f;
constexpr float A2SCALE = 8.0f;
constexpr int CW_TMO = 0, CW_CODE = 1;
constexpr int CW_BAR = 4096;
constexpr int CW_CNT = 16384;

constexpr int RING_OFF = 0, RING_BYTES = 131072;
constexpr int LDSCTL_OFF = RING_BYTES, MISC_OFF = LDSCTL_OFF + 1024;
constexpr int XL_OFF = LDSCTL_OFF + 4096;
constexpr int LDS_BYTES = 147456;

#define GAS __attribute__((address_space(1)))
#define LAS __attribute__((address_space(3)))
typedef unsigned short bf16_t;
typedef unsigned v4u __attribute__((ext_vector_type(4)));
typedef float f32x4 __attribute__((ext_vector_type(4)));
typedef float f32x2 __attribute__((ext_vector_type(2)));
typedef short bf16x8 __attribute__((ext_vector_type(8)));
typedef float f32x16 __attribute__((ext_vector_type(16)));
typedef short s16x4 __attribute__((ext_vector_type(4)));
typedef GAS unsigned gu32;
#define RLX_AGENT __ATOMIC_RELAXED, __HIP_MEMORY_SCOPE_AGENT
#define LDS_WAIT() asm volatile("s_waitcnt lgkmcnt(0)" ::: "memory")
#define VM_WAIT() asm volatile("s_waitcnt vmcnt(0)" ::: "memory")

__device__ __forceinline__ unsigned cvt_pk_bf16(float lo, float hi) { unsigned r; asm volatile("v_cvt_pk_bf16_f32 %0, %1, %2" : "=v"(r) : "v"(lo), "v"(hi)); return r; }
__device__ __forceinline__ float bf_lo(unsigned u) { return __uint_as_float(u << 16); }
__device__ __forceinline__ float bf_hi(unsigned u) { return __uint_as_float(u & 0xffff0000u); }
__device__ __forceinline__ float wave_sum(float v) {
#pragma unroll
    for (int o = 1; o < 64; o <<= 1) v += __shfl_xor(v, o);
    return v;
}

#ifndef KREP_MOE
#define KREP_MOE 1
#endif
namespace pg8 {
constexpr float KREP_MOE_ = (float)KREP_MOE;
#define PG8_LAS __attribute__((address_space(3)))
constexpr int BM = 256, BK = 64, HALF = 128, HTB = HALF * BK * 2, STAGE_BYTES = 8 * HTB, NXCD = 8, WGM = 8, KD = 1024, NTK = KD / BK;

__host__ __device__ __forceinline__ int lds_byte(int r, int c) { const int st = (r >> 4) * 2 + (c >> 5), rr = r & 15, cc = c & 31, ob = rr * 64 + cc * 2; return st * 1024 + (ob ^ (((ob >> 9) & 1) << 5)); }
__host__ __device__ __forceinline__ void stage_rc(int b, int& R, int& C) { const int st = b / 1024, sb = b % 1024, swz = sb ^ (((sb >> 9) & 1) << 5); R = (st >> 1) * 16 + swz / 64; C = (st & 1) * 32 + (swz % 64) / 2; }
__host__ __device__ __forceinline__ int perm32(int rho) { const int n = rho >> 4, i = rho & 15; return 8 * (i >> 2) + 4 * n + (i & 3); }

struct Unit { int pm, pn, e, valid, lr0; };
__device__ __forceinline__ void dma1k(const void* src, PG8_LAS unsigned char* dst, int lane) {
    __builtin_amdgcn_global_load_lds((const __attribute__((address_space(1))) unsigned*)((const char*)src + lane * 16), (PG8_LAS unsigned*)dst, 16, 0, 0);
}
constexpr int XL_EPI = 4096, XL_GATHER = 1024, XL_BYTES = 2 * (XL_EPI + XL_GATHER);

template <bool F8> struct DenseProbT {
    static constexpr bool GATHER = false;
    static constexpr int RP = F8 ? 1024 : 2048;
    const char* A; const char* Bt; int nM, nN, nwg, G, c, tid;
    __device__ void init(const void* A_, const void* Bt_, int Mrows, int N, int G_, int c_, int tid_) { A = (const char*)A_; Bt = (const char*)Bt_; nM = Mrows / BM; nN = N / BM; nwg = nM * nN; G = G_; c = c_; tid = tid_; }
    __device__ __forceinline__ bool next(int i, Unit& u) const {
        const long L = (long)i * G + c; if (L >= nwg) return false;
        int wgid = (int)L; { const int q = nwg / NXCD, r = nwg % NXCD, xcd = wgid % NXCD, off = wgid / NXCD; wgid = (xcd < r ? xcd * (q + 1) : r * (q + 1) + (xcd - r) * q) + off; }
        const int nig = WGM * nN, gid = wgid / nig, fm = gid * WGM, gsz = (nM - fm) < WGM ? (nM - fm) : WGM;
        u.pm = fm + ((wgid % nig) % gsz); u.pn = (wgid % nig) / gsz; u.e = 0; u.valid = 256; u.lr0 = 0; return true;
    }
    __device__ __forceinline__ void a_off(const Unit& u, const int (&RA)[2], const int (&CA)[2], unsigned (&vo)[2][2]) const {
#pragma unroll
        for (int h = 0; h < 2; ++h)
#pragma unroll
            for (int i = 0; i < 2; ++i) vo[h][i] = (unsigned)((u.pm * BM + h * HALF + RA[i]) * RP + CA[i] * 2);
    }
    __device__ __forceinline__ unsigned a_tile(const Unit& u) const { return (unsigned)u.pm * (unsigned)(BM * RP); }
    __device__ __forceinline__ unsigned b_off(const Unit& u) const { return (unsigned)u.pn * (unsigned)(BM * RP); }    __device__ __forceinline__ void dma_rows(const Unit&, PG8_LAS unsigned char*, int, int) const {}
    __device__ __forceinline__ void a_off_lds(const Unit&, const int (&)[2], const int (&)[2], const PG8_LAS unsigned char*, unsigned (&)[2][2]) const {}
};
typedef DenseProbT<false> DenseProb;

template <bool GATHER_, bool F8> struct MoeProb {
    static constexpr bool GATHER = GATHER_;
    static constexpr int RP = F8 ? 1024 : 2048;
    const char* A; const char* Bt; size_t b_estride; int nN, G, v, RT; const PG8_LAS int* tb; const PG8_LAS int* cn; const int* lslot; int lane, tid;
    __device__ __forceinline__ bool next(int i, Unit& u) const {
        const int L = i * G + v; if (L >= RT * nN) return false;
        const int rt = L / nN; u.pm = rt; u.pn = L - rt * nN;
        const unsigned long long bal = __ballot(lane < 32 && rt >= tb[(lane & 31) + 1]);
        const int e = __builtin_amdgcn_readfirstlane(__popcll(bal)); u.e = e;
        const int tb_e = __builtin_amdgcn_readfirstlane(tb[e]), cn_e = __builtin_amdgcn_readfirstlane(cn[e]);
        u.lr0 = 256 * (rt - tb_e); const int rem = cn_e - u.lr0; u.valid = rem < 256 ? rem : 256; return true;
    }
    __device__ __forceinline__ void a_off(const Unit& u, const int (&RA)[2], const int (&CA)[2], unsigned (&vo)[2][2]) const {
        if constexpr (GATHER) {
            const int* ls = lslot + (size_t)u.e * LCAP + u.lr0;
#pragma unroll
            for (int h = 0; h < 2; ++h)
#pragma unroll
                for (int i = 0; i < 2; ++i) { const int rl = h * HALF + RA[i]; const int slot = ls[rl < u.valid ? rl : 0]; vo[h][i] = (unsigned)((slot >> 2) * RP + CA[i] * 2); }
        } else {
#pragma unroll
            for (int h = 0; h < 2; ++h)
#pragma unroll
                for (int i = 0; i < 2; ++i) vo[h][i] = (unsigned)((u.pm * BM + h * HALF + RA[i]) * RP + CA[i] * 2);
        }
    }
    __device__ __forceinline__ unsigned a_tile(const Unit& u) const { return (unsigned)u.pm * (unsigned)(BM * RP); }
    __device__ __forceinline__ unsigned b_off(const Unit& u) const { return (unsigned)u.e * (unsigned)b_estride + (unsigned)u.pn * (unsigned)(BM * RP); }
    __device__ __forceinline__ void dma_rows(const Unit& u, PG8_LAS unsigned char* dst, int wid, int lane_) const { if constexpr (GATHER) { if (wid == 0) dma1k(lslot + (size_t)u.e * LCAP + u.lr0, dst, lane_); } }
    __device__ __forceinline__ void a_off_lds(const Unit& u, const int (&RA)[2], const int (&CA)[2], const PG8_LAS unsigned char* src, unsigned (&vo)[2][2]) const {
        if constexpr (GATHER) { const PG8_LAS int* ls = (const PG8_LAS int*)src;
#pragma unroll
            for (int h = 0; h < 2; ++h)
#pragma unroll
                for (int i = 0; i < 2; ++i) { const int rl = h * HALF + RA[i]; const int slot = ls[rl < u.valid ? rl : 0]; vo[h][i] = (unsigned)((slot >> 2) * RP + CA[i] * 2); } }
    }
};

__device__ __forceinline__ v4u pack8(const f32x4 v0, const f32x4 v1) { v4u w; w.x = cvt_pk_bf16(v0[0], v0[1]); w.y = cvt_pk_bf16(v0[2], v0[3]); w.z = cvt_pk_bf16(v1[0], v1[1]); w.w = cvt_pk_bf16(v1[2], v1[3]); return w; }

__device__ __forceinline__ void st16(void* base, unsigned off, v4u v) { *(v4u*)((char*)base + off) = v; }
struct EpiQKV {
    __device__ __forceinline__ void dma(const Unit&, PG8_LAS unsigned char*, int, int) const {}
    bf16_t* O; size_t stride; float scale0;
    __device__ __forceinline__ void operator()(const f32x4 (&acc)[2][2][4][2], const Unit& u, int wr, int wc, int fr_, int fq_, const PG8_LAS unsigned char* xl) const {
        int fr = fr_, fq = fq_; asm volatile("" : "+v"(fr), "+v"(fq));
        const int row0 = u.pm * BM + wr * 64 + fr; const int t = u.pn >> 2; const int colt = (u.pn & 3) * BM;
        bf16_t* base = O + (size_t)t * stride; const float sc = (t == 0) ? scale0 : 1.f; const unsigned off0 = (unsigned)(row0 * D + colt + wc * 32 + 8 * fq) * 2u;
#pragma unroll
        for (int ai = 0; ai < 2; ++ai)
#pragma unroll
            for (int m = 0; m < 4; ++m)
#pragma unroll
                for (int bj = 0; bj < 2; ++bj) st16(base, off0 + (unsigned)((ai * HALF + m * 16) * D + bj * HALF) * 2u, pack8(acc[ai][bj][m][0] * sc, acc[ai][bj][m][1] * sc));
    }
};
struct EpiConvIn {
    __device__ __forceinline__ void dma(const Unit&, PG8_LAS unsigned char*, int, int) const {}
    bf16_t* GB; bf16_t* Z;
    __device__ __forceinline__ void operator()(const f32x4 (&acc)[2][2][4][2], const Unit& u, int wr, int wc, int fr_, int fq_, const PG8_LAS unsigned char* xl) const {
        int fr = fr_, fq = fq_; asm volatile("" : "+v"(fr), "+v"(fq));
        const int row0 = u.pm * BM + wr * 64 + fr;
        if (u.pn < 4) { const unsigned off0 = (unsigned)(row0 * D + u.pn * BM + wc * 32 + 8 * fq) * 2u;
#pragma unroll
            for (int ai = 0; ai < 2; ++ai)
#pragma unroll
                for (int m = 0; m < 4; ++m)
#pragma unroll
                    for (int bj = 0; bj < 2; ++bj) st16(GB, off0 + (unsigned)((ai * HALF + m * 16) * D + bj * HALF) * 2u, pack8(acc[ai][bj][m][0], acc[ai][bj][m][1]));
        } else { const unsigned off0 = (unsigned)(row0 * D + (u.pn - 4) * HALF + wc * 32 + 8 * fq) * 2u;
#pragma unroll
            for (int ai = 0; ai < 2; ++ai)
#pragma unroll
                for (int m = 0; m < 4; ++m) st16(Z, off0 + (unsigned)((ai * HALF + m * 16) * D) * 2u, pack8(acc[ai][0][m][0] * acc[ai][1][m][0], acc[ai][0][m][1] * acc[ai][1][m][1]));
        }
    }
};
struct EpiQKV8 {
    bf16_t* O; size_t stride; float scale0; const float* sw; const float* rs;
    __device__ __forceinline__ void dma(const Unit& u, PG8_LAS unsigned char* xl, int wid, int lane) const {
        if (wid == 0) dma1k(sw + u.pn * BM, xl, lane); else if (wid == 1) dma1k(rs + u.pm * BM, xl + 1024, lane);
    }
    __device__ __forceinline__ void operator()(const f32x4 (&acc)[2][2][4][2], const Unit& u, int wr, int wc, int fr_, int fq_, const PG8_LAS unsigned char* xl) const {
        int fr = fr_, fq = fq_; asm volatile("" : "+v"(fr), "+v"(fq));
        const int row0 = u.pm * BM + wr * 64 + fr; const int t = u.pn >> 2; const int colt = (u.pn & 3) * BM; const int cl = wc * 32 + 8 * fq;
        bf16_t* base = O + (size_t)t * stride; const float sc = (t == 0) ? scale0 : 1.f; const unsigned off0 = (unsigned)(row0 * D + colt + cl) * 2u;
        const PG8_LAS float* sp = (const PG8_LAS float*)xl + cl; const PG8_LAS float* rp = (const PG8_LAS float*)(xl + 1024) + wr * 64 + fr;
        f32x4 sv[2][2];
#pragma unroll
        for (int bj = 0; bj < 2; ++bj)
#pragma unroll
            for (int n = 0; n < 2; ++n) sv[bj][n] = *(const PG8_LAS f32x4*)(sp + bj * HALF + 4 * n) * sc;
#pragma unroll
        for (int ai = 0; ai < 2; ++ai)
#pragma unroll
            for (int m = 0; m < 4; ++m) { const float r = rp[ai * HALF + m * 16];
#pragma unroll
                for (int bj = 0; bj < 2; ++bj) st16(base, off0 + (unsigned)((ai * HALF + m * 16) * D + bj * HALF) * 2u, pack8(acc[ai][bj][m][0] * (sv[bj][0] * r), acc[ai][bj][m][1] * (sv[bj][1] * r))); }
    }
};
struct EpiConvIn8 {
    bf16_t* GB; bf16_t* Z; const float* sw; const float* rs;
    __device__ __forceinline__ void dma(const Unit& u, PG8_LAS unsigned char* xl, int wid, int lane) const { if (wid == 0) dma1k(sw + u.pn * BM, xl, lane); else if (wid == 1) dma1k(rs + u.pm * BM, xl + 1024, lane); }
    __device__ __forceinline__ void operator()(const f32x4 (&acc)[2][2][4][2], const Unit& u, int wr, int wc, int fr_, int fq_, const PG8_LAS unsigned char* xl) const {
        int fr = fr_, fq = fq_; asm volatile("" : "+v"(fr), "+v"(fq));
        const int row0 = u.pm * BM + wr * 64 + fr; const int cl = wc * 32 + 8 * fq;
        const PG8_LAS float* sp = (const PG8_LAS float*)xl + cl; const PG8_LAS float* rp = (const PG8_LAS float*)(xl + 1024) + wr * 64 + fr;
        f32x4 sv[2][2];
#pragma unroll
        for (int bj = 0; bj < 2; ++bj)
#pragma unroll
            for (int n = 0; n < 2; ++n) sv[bj][n] = *(const PG8_LAS f32x4*)(sp + bj * HALF + 4 * n);
        if (u.pn < 4) { const unsigned off0 = (unsigned)(row0 * D + u.pn * BM + cl) * 2u;
#pragma unroll
            for (int ai = 0; ai < 2; ++ai)
#pragma unroll
                for (int m = 0; m < 4; ++m) { const float r = rp[ai * HALF + m * 16];
#pragma unroll
                    for (int bj = 0; bj < 2; ++bj) st16(GB, off0 + (unsigned)((ai * HALF + m * 16) * D + bj * HALF) * 2u, pack8(acc[ai][bj][m][0] * (sv[bj][0] * r), acc[ai][bj][m][1] * (sv[bj][1] * r))); }
        } else { const unsigned off0 = (unsigned)(row0 * D + (u.pn - 4) * HALF + cl) * 2u;
            const f32x4 sz0 = sv[0][0] * sv[1][0], sz1 = sv[0][1] * sv[1][1];
#pragma unroll
            for (int ai = 0; ai < 2; ++ai)
#pragma unroll
                for (int m = 0; m < 4; ++m) { const float r = rp[ai * HALF + m * 16], r2 = r * r;
                    st16(Z, off0 + (unsigned)((ai * HALF + m * 16) * D) * 2u, pack8(acc[ai][0][m][0] * acc[ai][1][m][0] * (sz0 * r2), acc[ai][0][m][1] * acc[ai][1][m][1] * (sz1 * r2))); }
        }
    }
};
struct EpiResid {
    __device__ __forceinline__ void dma(const Unit&, PG8_LAS unsigned char*, int, int) const {}
    const bf16_t* X; bf16_t* Yp;
    __device__ __forceinline__ void operator()(const f32x4 (&acc)[2][2][4][2], const Unit& u, int wr, int wc, int fr_, int fq_, const PG8_LAS unsigned char* xl) const {
        int fr = fr_, fq = fq_; asm volatile("" : "+v"(fr), "+v"(fq));
        const unsigned off0 = (unsigned)((u.pm * BM + wr * 64 + fr) * D + u.pn * BM + wc * 32 + 8 * fq) * 2u;
#pragma unroll
        for (int ai = 0; ai < 2; ++ai)
#pragma unroll
            for (int m = 0; m < 4; ++m)
#pragma unroll
                for (int bj = 0; bj < 2; ++bj) { const unsigned off = off0 + (unsigned)((ai * HALF + m * 16) * D + bj * HALF) * 2u; const v4u xr = *(const v4u*)((const char*)X + off);
                    f32x4 v0 = acc[ai][bj][m][0], v1 = acc[ai][bj][m][1];
                    v0[0] += ALPHA * bf_lo(xr.x); v0[1] += ALPHA * bf_hi(xr.x); v0[2] += ALPHA * bf_lo(xr.y); v0[3] += ALPHA * bf_hi(xr.y);
                    v1[0] += ALPHA * bf_lo(xr.z); v1[1] += ALPHA * bf_hi(xr.z); v1[2] += ALPHA * bf_lo(xr.w); v1[3] += ALPHA * bf_hi(xr.w);
                    st16(Yp, off, pack8(v0, v1)); }
    }
};
template <bool ROWS> struct EpiResid8 {
    const bf16_t* X; bf16_t* Yp; const float* sw; const float* rs; float rsc;
    __device__ __forceinline__ void dma(const Unit& u, PG8_LAS unsigned char* xl, int wid, int lane) const {
        if (wid == 0) dma1k(sw + u.pn * BM, xl, lane); else if (ROWS && wid == 1) dma1k(rs + u.pm * BM, xl + 1024, lane);
    }
    __device__ __forceinline__ void operator()(const f32x4 (&acc)[2][2][4][2], const Unit& u, int wr, int wc, int fr_, int fq_, const PG8_LAS unsigned char* xl) const {
        int fr = fr_, fq = fq_; asm volatile("" : "+v"(fr), "+v"(fq));
        const int cl = wc * 32 + 8 * fq;
        const unsigned off0 = (unsigned)((u.pm * BM + wr * 64 + fr) * D + u.pn * BM + cl) * 2u;
        const PG8_LAS float* sp = (const PG8_LAS float*)xl + cl; const PG8_LAS float* rp = (const PG8_LAS float*)(xl + 1024) + wr * 64 + fr;
        f32x4 sv[2][2];
#pragma unroll
        for (int bj = 0; bj < 2; ++bj)
#pragma unroll
            for (int n = 0; n < 2; ++n) sv[bj][n] = *(const PG8_LAS f32x4*)(sp + bj * HALF + 4 * n) * (ROWS ? 1.0f : rsc);
#pragma unroll
        for (int ai = 0; ai < 2; ++ai)
#pragma unroll
            for (int m = 0; m < 4; ++m) { float r = 1.0f; if (ROWS) r = rp[ai * HALF + m * 16];
#pragma unroll
                for (int bj = 0; bj < 2; ++bj) { const unsigned off = off0 + (unsigned)((ai * HALF + m * 16) * D + bj * HALF) * 2u; const v4u xr = *(const v4u*)((const char*)X + off);
                    f32x4 v0 = acc[ai][bj][m][0] * sv[bj][0], v1 = acc[ai][bj][m][1] * sv[bj][1]; if (ROWS) { v0 *= r; v1 *= r; }
                    v0[0] += ALPHA * bf_lo(xr.x); v0[1] += ALPHA * bf_hi(xr.x); v0[2] += ALPHA * bf_lo(xr.y); v0[3] += ALPHA * bf_hi(xr.y);
                    v1[0] += ALPHA * bf_lo(xr.z); v1[1] += ALPHA * bf_hi(xr.z); v1[2] += ALPHA * bf_lo(xr.w); v1[3] += ALPHA * bf_hi(xr.w);
                    st16(Yp, off, pack8(v0, v1)); } }
    }
};
__device__ __forceinline__ unsigned pk4_fp8(float a, float b, float c, float d) { int p = 0; p = __builtin_amdgcn_cvt_pk_fp8_f32(a, b, p, false); p = __builtin_amdgcn_cvt_pk_fp8_f32(c, d, p, true); return (unsigned)p; }
__device__ __forceinline__ unsigned pk4_i8(float a, float b, float c, float d) {
    unsigned r = 0;
    r = __builtin_amdgcn_cvt_pk_u8_f32(__builtin_rintf(a + 128.f), 0, r); r = __builtin_amdgcn_cvt_pk_u8_f32(__builtin_rintf(b + 128.f), 1, r);
    r = __builtin_amdgcn_cvt_pk_u8_f32(__builtin_rintf(c + 128.f), 2, r); r = __builtin_amdgcn_cvt_pk_u8_f32(__builtin_rintf(d + 128.f), 3, r);
    return r ^ 0x80808080u;
}
template <bool I8> __device__ __forceinline__ unsigned pkq4(float a, float b, float c, float d) { if constexpr (I8) return pk4_i8(a, b, c, d); else return pk4_fp8(a, b, c, d); }
__device__ __forceinline__ f32x2 swiglu8_pk(f32x2 g, f32x2 l8) {
    g.x = fminf(g.x, 7.0f); g.y = fminf(g.y, 7.0f);
    l8.x = fminf(fmaxf(l8.x, -56.0f), 56.0f); l8.y = fminf(fmaxf(l8.y, -56.0f), 56.0f);
    const f32x2 t = g * (-1.702f * LOG2E);
    f32x2 e; e.x = __builtin_amdgcn_exp2f(t.x); e.y = __builtin_amdgcn_exp2f(t.y);
    const f32x2 d = e + 1.0f;
    f32x2 r; r.x = __builtin_amdgcn_rcpf(d.x); r.y = __builtin_amdgcn_rcpf(d.y);
    return (g * r) * (l8 + A2SCALE);
}
struct EpiMoe1 {
    unsigned char* A2; const float* b1; const float* sw; float inv_sa;
    __device__ __forceinline__ void dma(const Unit& u, PG8_LAS unsigned char* xl, int wid, int lane) const {
        if (wid == 0) dma1k(b1 + (size_t)u.e * 2048 + u.pn * BM, xl, lane); else if (wid == 1) dma1k(sw + (size_t)u.e * 2048 + u.pn * BM, xl + 1024, lane);
    }
    __device__ __forceinline__ void operator()(const f32x4 (&acc)[2][2][4][2], const Unit& u, int wr, int wc, int fr_, int fq_, const PG8_LAS unsigned char* xl) const {
        int fr = fr_, fq = fq_; asm volatile("" : "+v"(fr), "+v"(fq));
        const int cl = wc * 32 + 8 * fq; const unsigned off0 = (unsigned)((u.pm * BM + wr * 64 + fr) * D + u.pn * HALF + cl);
        const PG8_LAS float* bp = (const PG8_LAS float*)xl + 2 * cl; f32x4 bb[4];
#pragma unroll
        for (int j = 0; j < 4; ++j) bb[j] = *(const PG8_LAS f32x4*)(bp + 4 * j);
        const PG8_LAS float* sp = (const PG8_LAS float*)(xl + 1024) + cl;
        const f32x4 sg0 = *(const PG8_LAS f32x4*)(sp) * inv_sa, sg1 = *(const PG8_LAS f32x4*)(sp + 4) * inv_sa;
        const f32x4 sl0 = *(const PG8_LAS f32x4*)(sp + HALF) * (inv_sa * A2SCALE), sl1 = *(const PG8_LAS f32x4*)(sp + HALF + 4) * (inv_sa * A2SCALE);
        f32x2 sgp[4] = {{sg0[0], sg0[1]}, {sg0[2], sg0[3]}, {sg1[0], sg1[1]}, {sg1[2], sg1[3]}}, slp[4] = {{sl0[0], sl0[1]}, {sl0[2], sl0[3]}, {sl1[0], sl1[1]}, {sl1[2], sl1[3]}};
        f32x2 bgp[4], blp[4];
#pragma unroll
        for (int q = 0; q < 4; ++q) { bgp[q] = (f32x2){bb[q][0], bb[q][2]}; blp[q] = (f32x2){bb[q][1] * A2SCALE, bb[q][3] * A2SCALE}; }
        const unsigned offp = off0 + ((fq & 1) ? (unsigned)(16 * D - 8) : 0u);
#pragma unroll
        for (int ai = 0; ai < 2; ++ai)
#pragma unroll
            for (int mp = 0; mp < 2; ++mp) { typedef unsigned u32x2 __attribute__((ext_vector_type(2))); u32x2 w[2];
#pragma unroll
                for (int mm = 0; mm < 2; ++mm) { const int m = 2 * mp + mm; f32x2 o[4];
#pragma unroll
                    for (int q = 0; q < 4; ++q) { const f32x4 ga = acc[ai][0][m][q >> 1], la = acc[ai][1][m][q >> 1]; const int h2 = (q & 1) * 2;
                        const f32x2 g = (f32x2){ga[h2], ga[h2 + 1]} * sgp[q] + bgp[q], l8 = (f32x2){la[h2], la[h2 + 1]} * slp[q] + blp[q];
                        o[q] = swiglu8_pk(g, l8); }
                    w[mm].x = pk4_fp8(o[0].x, o[0].y, o[1].x, o[1].y); w[mm].y = pk4_fp8(o[2].x, o[2].y, o[3].x, o[3].y); }
                const auto sx = __builtin_amdgcn_permlane16_swap(w[0].x, w[1].x, false, false); const auto sy = __builtin_amdgcn_permlane16_swap(w[0].y, w[1].y, false, false);
                const v4u ov = {sx[0], sy[0], sx[1], sy[1]};
                *(v4u*)(A2 + (offp + (unsigned)((ai * HALF + mp * 32) * D))) = ov; }
    }
};
struct EpiMoe2 {
    unsigned char* Y; const float* b2; const float* sw; const int* lslot; const float* lgate;
    __device__ __forceinline__ void dma(const Unit& u, PG8_LAS unsigned char* xl, int wid, int lane) const {
        const size_t lb = (size_t)u.e * LCAP + u.lr0;
        if (wid == 0) dma1k(b2 + (size_t)u.e * 1024 + u.pn * BM, xl, lane); else if (wid == 1) dma1k(sw + (size_t)u.e * 1024 + u.pn * BM, xl + 1024, lane);
        else if (wid == 2) dma1k(lslot + lb, xl + 2048, lane); else if (wid == 3) dma1k(lgate + lb, xl + 3072, lane);
    }
    __device__ __forceinline__ void operator()(const f32x4 (&acc)[2][2][4][2], const Unit& u, int wr, int wc, int fr_, int fq_, const PG8_LAS unsigned char* xl) const {
        int fr = fr_, fq = fq_; asm volatile("" : "+v"(fr), "+v"(fq));
        const int rl0 = wr * 64 + fr, cl = wc * 32 + 8 * fq, col0 = u.pn * BM + cl;
        const PG8_LAS float* bp = (const PG8_LAS float*)xl + cl; const PG8_LAS float* sp = (const PG8_LAS float*)(xl + 1024) + cl; f32x4 bv[2][2], sv[2][2];
#pragma unroll
        for (int bj = 0; bj < 2; ++bj)
#pragma unroll
            for (int n = 0; n < 2; ++n) { bv[bj][n] = *(const PG8_LAS f32x4*)(bp + bj * HALF + 4 * n); sv[bj][n] = *(const PG8_LAS f32x4*)(sp + bj * HALF + 4 * n) * (1.0f / (A2SCALE * KREP_MOE_)); }
        const PG8_LAS int* sl = (const PG8_LAS int*)(xl + 2048); const PG8_LAS float* gl = (const PG8_LAS float*)(xl + 3072);
        const unsigned cadj = (unsigned)(u.pn * BM + ((fq & 1) ? (HALF + cl - 8) : cl));
#pragma unroll
        for (int ai = 0; ai < 2; ++ai)
#pragma unroll
            for (int m = 0; m < 4; ++m) { const int rl = rl0 + ai * HALF + m * 16;
                const bool ok = rl < u.valid; const int slot = ok ? sl[rl] : M * 4; const float g = gl[rl] * YSCALE;
                typedef unsigned u32x2 __attribute__((ext_vector_type(2))); u32x2 w[2];
#pragma unroll
                for (int bj = 0; bj < 2; ++bj) { f32x4 v0 = (acc[ai][bj][m][0] * sv[bj][0] + bv[bj][0]) * g, v1 = (acc[ai][bj][m][1] * sv[bj][1] + bv[bj][1]) * g;
#pragma unroll
                    for (int i = 0; i < 4; ++i) { v0[i] = fminf(fmaxf(v0[i], -448.0f), 448.0f); v1[i] = fminf(fmaxf(v1[i], -448.0f), 448.0f); }
                    w[bj].x = pk4_fp8(v0[0], v0[1], v0[2], v0[3]); w[bj].y = pk4_fp8(v1[0], v1[1], v1[2], v1[3]); }
                const auto sx = __builtin_amdgcn_permlane16_swap(w[0].x, w[1].x, false, false); const auto sy = __builtin_amdgcn_permlane16_swap(w[0].y, w[1].y, false, false);
                const v4u o = {sx[0], sy[0], sx[1], sy[1]};
                *(v4u*)(Y + ((unsigned)(slot * D) + cadj)) = o; }
    }
};

typedef int v8i_t __attribute__((ext_vector_type(8))); typedef int v4i_t __attribute__((ext_vector_type(4)));
__device__ __forceinline__ v8i_t cat8(bf16x8 lo, bf16x8 hi) { const v4i_t a = __builtin_bit_cast(v4i_t, lo), b = __builtin_bit_cast(v4i_t, hi); return __builtin_shufflevector(a, b, 0, 1, 2, 3, 4, 5, 6, 7); }
template <class Prob, class Epi, bool ALIGN_EPI, bool F8 = false, int KREP = 1, bool I8 = false>
__device__ __forceinline__ void gemm_phase(PG8_LAS unsigned char* lds, PG8_LAS unsigned char* xl, const Prob& P, const Epi& E) {
    int tid_ = P.tid; asm volatile("" : "+v"(tid_));
    const int tid = tid_, wid = __builtin_amdgcn_readfirstlane(tid >> 6), lane = tid & 63, wr = wid >> 2, wc = wid & 3, fr = lane & 15, fq = lane >> 4;
    constexpr int RP = F8 ? 1024 : 2048, nt = F8 ? 8 : NTK;
    constexpr bool GA = Prob::GATHER;
    int RA[2], CA[2]; unsigned voffB[2], voffA[2];
#pragma unroll
    for (int i = 0; i < 2; ++i) { int R, C; stage_rc(tid * 16 + i * 8192, R, C); const int Rb = (R & ~31) + perm32(R & 31); RA[i] = R; CA[i] = C; voffB[i] = (unsigned)(Rb * RP + C * 2); voffA[i] = (unsigned)(R * RP + C * 2); }
    constexpr unsigned kstep = (unsigned)(BK * 2);
    constexpr unsigned hstep = (unsigned)HALF * RP;
    const unsigned ldsw = (unsigned)wid * 1024u;
    const int aoff = lds_byte(wr * 64 + fr, fq * 8), boff = lds_byte(wc * 32 + fr, fq * 8);
    typedef const __attribute__((address_space(1))) unsigned* gptr_t;
#define PG8_SA(b, h) (((b) * 2 + (h)) * HTB)
#define PG8_SB(b, h) ((4 + (b) * 2 + (h)) * HTB)
#define PG8_STAGE_B(bufoff, uoff) do { _Pragma("unroll") for (int _i = 0; _i < 2; ++_i) \
        __builtin_amdgcn_global_load_lds((gptr_t)(Bb + (voffB[_i] + (unsigned)(uoff))), (PG8_LAS unsigned*)(lds + (bufoff) + ldsw + _i * 8192), 16, 0, 0); } while (0)
#define PG8_STAGE_A(bufoff, koff, h, NX) do { _Pragma("unroll") for (int _i = 0; _i < 2; ++_i) { unsigned _o; \
        if constexpr (GA) _o = ((NX) ? vn[h][_i] : vc[h][_i]) + (unsigned)(koff); else _o = voffA[_i] + (((NX) ? nAo : cAo) + (unsigned)(h) * hstep + (unsigned)(koff)); \
        __builtin_amdgcn_global_load_lds((gptr_t)(Ab + _o), (PG8_LAS unsigned*)(lds + (bufoff) + ldsw + _i * 8192), 16, 0, 0); } } while (0)
#define PG8_LDA(dst, b, h) do { _Pragma("unroll") for (int m = 0; m < 4; ++m) _Pragma("unroll") for (int k = 0; k < 2; ++k) dst[m][k] = *(const PG8_LAS bf16x8*)(lds + PG8_SA(b, h) + aoff + m * 2048 + k * 1024); } while (0)
#define PG8_LDB(dst, b, h) do { _Pragma("unroll") for (int n = 0; n < 2; ++n) _Pragma("unroll") for (int k = 0; k < 2; ++k) dst[n][k] = *(const PG8_LAS bf16x8*)(lds + PG8_SB(b, h) + boff + n * 2048 + k * 1024); } while (0)
#define PG8_MMA(ai, bj, At, Bt) do { __builtin_amdgcn_s_setprio(1); _Pragma("unroll") for (int m = 0; m < 4; ++m) _Pragma("unroll") for (int n = 0; n < 2; ++n) _Pragma("unroll") for (int k = 0; k < 2; ++k) \
        acc[ai][bj][m][n] = __builtin_amdgcn_mfma_f32_16x16x32_bf16(Bt[n][k], At[m][k], acc[ai][bj][m][n], 0, 0, 0); __builtin_amdgcn_s_setprio(0); } while (0)
#define PG8_MMA8(ai, bj, At, Bt) do { __builtin_amdgcn_s_setprio(1); if constexpr (I8) { _Pragma("unroll") for (int k = 0; k < 2; ++k) _Pragma("unroll") for (int m = 0; m < 4; ++m) _Pragma("unroll") for (int n = 0; n < 2; ++n) \
        asm volatile("v_mfma_i32_16x16x64_i8 %0, %1, %2, %0" : "+v"(acc[ai][bj][m][n]) : "v"(Bt[n][k]), "v"(At[m][k])); } else { _Pragma("unroll") for (int m = 0; m < 4; ++m) _Pragma("unroll") for (int n = 0; n < 2; ++n) \
        asm volatile("v_mfma_f32_16x16x128_f8f6f4 %0, %1, %2, %0" : "+v"(acc[ai][bj][m][n]) : "v"(cat8(Bt[n][0], Bt[n][1])), "v"(cat8(At[m][0], At[m][1]))); } __builtin_amdgcn_s_setprio(0); } while (0)
#define PG8_MMA8Z(ai, bj, At, Bt) do { __builtin_amdgcn_s_setprio(1); if constexpr (I8) { _Pragma("unroll") for (int m = 0; m < 4; ++m) _Pragma("unroll") for (int n = 0; n < 2; ++n) \
        asm volatile("v_mfma_i32_16x16x64_i8 %0, %1, %2, 0" : "=&v"(acc[ai][bj][m][n]) : "v"(Bt[n][0]), "v"(At[m][0])); _Pragma("unroll") for (int m = 0; m < 4; ++m) _Pragma("unroll") for (int n = 0; n < 2; ++n) \
        asm volatile("v_mfma_i32_16x16x64_i8 %0, %1, %2, %0" : "+v"(acc[ai][bj][m][n]) : "v"(Bt[n][1]), "v"(At[m][1])); } else { _Pragma("unroll") for (int m = 0; m < 4; ++m) _Pragma("unroll") for (int n = 0; n < 2; ++n) \
        asm volatile("v_mfma_f32_16x16x128_f8f6f4 %0, %1, %2, 0" : "=&v"(acc[ai][bj][m][n]) : "v"(cat8(Bt[n][0], Bt[n][1])), "v"(cat8(At[m][0], At[m][1]))); } __builtin_amdgcn_s_setprio(0); } while (0)
#define PG8_MM(ai, bj, At, Bt) do { if constexpr (F8) PG8_MMA8(ai, bj, At, Bt); else PG8_MMA(ai, bj, At, Bt); } while (0)
#define PG8_MM2(FIRST, ai, At) do { if constexpr (F8) { if (FIRST) { PG8_MMA8Z(ai, 0, At, B0); PG8_MMA8Z(ai, 1, At, B1); } else { PG8_MMA8(ai, 0, At, B0); PG8_MMA8(ai, 1, At, B1); } } else { PG8_MMA(ai, 0, At, B0); PG8_MMA(ai, 1, At, B1); } } while (0)
#define PG8_WAIT_V(n) asm volatile("s_waitcnt vmcnt(" #n ")" ::: "memory")
#define PG8_WAIT_L(n) asm volatile("s_waitcnt lgkmcnt(" #n ")" ::: "memory")
#define PG8_BAR __builtin_amdgcn_s_barrier()
#define PG8_SCHED __builtin_amdgcn_sched_barrier(0)
    Unit cur, nxt; int ui = 0;
    if (!P.next(0, cur)) return;
    f32x4 acc[2][2][4][2];
    if constexpr (!F8) {
#pragma unroll
    for (int a = 0; a < 2; ++a)
#pragma unroll
        for (int b = 0; b < 2; ++b)
#pragma unroll
            for (int m = 0; m < 4; ++m)
#pragma unroll
                for (int n = 0; n < 2; ++n) acc[a][b][m][n] = (f32x4){0.f, 0.f, 0.f, 0.f};
    }
    bf16x8 At[4][2], B0[2][2], B1[2][2];
    unsigned vc[2][2], vn[2][2]; unsigned cAo = 0, nAo = 0;
    if constexpr (GA) { P.a_off(cur, RA, CA, vc); vn[0][0] = vc[0][0]; vn[0][1] = vc[0][1]; vn[1][0] = vc[1][0]; vn[1][1] = vc[1][1]; } else { cAo = P.a_tile(cur); nAo = cAo; vc[0][0] = vn[0][0] = 0; }
    const char* const Ab = P.A; const char* const Bb = P.Bt; unsigned cBo = P.b_off(cur), nBo = cBo;
    PG8_STAGE_B(PG8_SB(0, 0), cBo); PG8_STAGE_B(PG8_SB(0, 1), cBo + hstep); PG8_STAGE_A(PG8_SA(0, 0), 0u, 0, false); PG8_STAGE_A(PG8_SA(0, 1), 0u, 1, false);
    if (wr == 1) PG8_BAR;
    PG8_WAIT_V(2); PG8_BAR;
    PG8_STAGE_B(PG8_SB(1, 0), cBo + kstep); PG8_STAGE_A(PG8_SA(1, 0), kstep, 0, false); PG8_STAGE_B(PG8_SB(1, 1), cBo + hstep + kstep);
    PG8_WAIT_V(6); PG8_BAR;
    for (;;) {
        const bool has_next = P.next(ui + 1, nxt);
        PG8_LAS unsigned char* const xe = xl + (ui & 1) * XL_EPI;
        PG8_LAS unsigned char* const xg = xl + 2 * XL_EPI + ((ui + 1) & 1) * XL_GATHER;
        E.dma(cur, xe, wid, lane);
        if (has_next) { if constexpr (GA) P.dma_rows(nxt, xg, wid, lane); else nAo = P.a_tile(nxt); nBo = P.b_off(nxt); }
        else { nAo = cAo; nBo = cBo; }
#pragma unroll 1
        for (int rep = 0; rep < KREP; ++rep)
#pragma unroll 1
        for (int t = 0; t < nt; t += 2) {
            const bool lastt = (t == nt - 2); const bool last = lastt && (rep == KREP - 1); const bool first = (t == 0) && (rep == 0); (void)first;
            if constexpr (GA) { if (last) { if (has_next) P.a_off_lds(nxt, RA, CA, xg, vn); else { vn[0][0] = vc[0][0]; vn[0][1] = vc[0][1]; vn[1][0] = vc[1][0]; vn[1][1] = vc[1][1]; } } }
            const unsigned k1 = (unsigned)(t + 1) * kstep;
            const unsigned k2 = lastt ? 0u : (unsigned)(t + 2) * kstep, k3 = k2 + kstep;
            const unsigned b2 = (last ? nBo : cBo) + k2, b3 = b2 + kstep;
            PG8_LDB(B0, 0, 0); PG8_LDB(B1, 0, 1); PG8_SCHED; PG8_LDA(At, 0, 0); PG8_STAGE_A(PG8_SA(1, 1), k1, 1, false);
            PG8_WAIT_V(8); PG8_WAIT_L(0); PG8_BAR; PG8_MM2(first, 0, At); PG8_BAR; PG8_SCHED;
            PG8_LDA(At, 0, 1); PG8_STAGE_B(PG8_SB(0, 0), b2); PG8_STAGE_B(PG8_SB(0, 1), b2 + hstep); PG8_STAGE_A(PG8_SA(0, 0), k2, 0, last);
            PG8_WAIT_V(8); PG8_WAIT_L(0); PG8_BAR; PG8_MM2(first, 1, At); PG8_BAR; PG8_SCHED;
            PG8_LDB(B0, 1, 0); PG8_LDB(B1, 1, 1); PG8_SCHED; PG8_LDA(At, 1, 0); PG8_STAGE_A(PG8_SA(0, 1), k2, 1, last);
            PG8_WAIT_V(8); PG8_WAIT_L(0); PG8_BAR; PG8_MM(0, 0, At, B0); PG8_MM(0, 1, At, B1); PG8_BAR; PG8_SCHED;
            PG8_LDA(At, 1, 1); PG8_STAGE_B(PG8_SB(1, 0), b3); PG8_STAGE_B(PG8_SB(1, 1), b3 + hstep); PG8_STAGE_A(PG8_SA(1, 0), k3, 0, last);
            PG8_WAIT_V(8); PG8_WAIT_L(0); PG8_BAR; PG8_MM(1, 0, At, B0); PG8_MM(1, 1, At, B1); PG8_BAR; PG8_SCHED;
        }
        if constexpr (ALIGN_EPI) { if (wr == 0) PG8_BAR; }
        if constexpr (F8) asm volatile("s_nop 15\n\ts_nop 7" ::: "memory");
        if constexpr (I8) {
#pragma unroll
            for (int a = 0; a < 2; ++a)
#pragma unroll
                for (int b = 0; b < 2; ++b)
#pragma unroll
                    for (int m = 0; m < 4; ++m)
#pragma unroll
                        for (int n = 0; n < 2; ++n)
#pragma unroll
                            for (int i = 0; i < 4; ++i) acc[a][b][m][n][i] = (float)__float_as_int(acc[a][b][m][n][i]);
        }
        E(acc, cur, wr, wc, fr, fq, xe);
        if (!has_next) break;
        if constexpr (!F8)
#pragma unroll
        for (int a = 0; a < 2; ++a)
#pragma unroll
            for (int b = 0; b < 2; ++b)
#pragma unroll
                for (int m = 0; m < 4; ++m)
#pragma unroll
                    for (int n = 0; n < 2; ++n) acc[a][b][m][n] = (f32x4){0.f, 0.f, 0.f, 0.f};
        cur = nxt; cBo = nBo; cAo = nAo; ++ui;
        if constexpr (GA) { vc[0][0] = vn[0][0]; vc[0][1] = vn[0][1]; vc[1][0] = vn[1][0]; vc[1][1] = vn[1][1]; }
        if constexpr (ALIGN_EPI) { if (wr == 1) PG8_BAR; }
    }
    PG8_WAIT_V(0);
    if constexpr (!ALIGN_EPI) { if (wr == 0) PG8_BAR; }
    PG8_BAR;
#undef PG8_SA
#undef PG8_SB
#undef PG8_STAGE_A
#undef PG8_STAGE_B
#undef PG8_LDA
#undef PG8_LDB
#undef PG8_MMA
#undef PG8_MMA8
#undef PG8_MM
#undef PG8_MM2
#undef PG8_MMA8Z
#undef PG8_WAIT_V
#undef PG8_WAIT_L
#undef PG8_BAR
#undef PG8_SCHED
}
}

namespace att {
constexpr int QBLK = 32, KVBLK = 64, LDX = 1024, NT = SEQ / KVBLK;
constexpr int SHM_V = KVBLK * 128 * 2, SHM_K = KVBLK * 128 * 2, NSLOT = 3;
constexpr int OFF_V = 0, OFF_K = NSLOT * SHM_V, OFF_WS = NSLOT * (SHM_V + SHM_K), OFF_TBL = OFF_WS + 8 * 64 * 4, ATT_LDS = OFF_TBL + 2048;
constexpr float THR2 = 8.0f * LOG2E;
#define KSWZ(row, colB) ((row) * 256 + ((colB) ^ (((row) & 7) << 4)))
#define SBAR() __builtin_amdgcn_sched_barrier(0)
__device__ __forceinline__ int crow(int r, int hi) { return (r & 3) + 8 * (r >> 2) + 4 * hi; }
__device__ __forceinline__ int v_st(int k, int c) { const int kk = (k & ~0xC) | ((k & 4) << 1) | ((k & 8) >> 1); return ((kk >> 3) * 4 + (c >> 5)) * 512 + ((kk & 7) * 32 + (c & 31)) * 2; }
__device__ __forceinline__ int v_rd_base(int lane) { return ((lane & 3) << 3) | (((lane >> 2) & 3) << 6) | (((lane >> 4) & 1) << 5) | (((lane >> 5) & 1) << 8); }
constexpr int v_rd_off(int d0, int ks, int half) { return d0 * 512 + ks * 4096 + half * 2048; }
template <int OFF> __device__ __forceinline__ s16x4 tr_read(int vb) { s16x4 r; asm volatile("ds_read_b64_tr_b16 %0, %1 offset:%2" : "=&v"(r) : "v"(vb), "i"(OFF) : "memory"); return r; }
#define ATT_RD8(L, H, D0) do { \
    asm volatile("ds_read_b64_tr_b16 %0, %1 offset:%2" : "=&v"(L[0]) : "v"(vb), "i"(v_rd_off(D0, 0, 0)) : "memory"); asm volatile("ds_read_b64_tr_b16 %0, %1 offset:%2" : "=&v"(H[0]) : "v"(vb), "i"(v_rd_off(D0, 0, 1)) : "memory"); \
    asm volatile("ds_read_b64_tr_b16 %0, %1 offset:%2" : "=&v"(L[1]) : "v"(vb), "i"(v_rd_off(D0, 1, 0)) : "memory"); asm volatile("ds_read_b64_tr_b16 %0, %1 offset:%2" : "=&v"(H[1]) : "v"(vb), "i"(v_rd_off(D0, 1, 1)) : "memory"); \
    asm volatile("ds_read_b64_tr_b16 %0, %1 offset:%2" : "=&v"(L[2]) : "v"(vb), "i"(v_rd_off(D0, 2, 0)) : "memory"); asm volatile("ds_read_b64_tr_b16 %0, %1 offset:%2" : "=&v"(H[2]) : "v"(vb), "i"(v_rd_off(D0, 2, 1)) : "memory"); \
    asm volatile("ds_read_b64_tr_b16 %0, %1 offset:%2" : "=&v"(L[3]) : "v"(vb), "i"(v_rd_off(D0, 3, 0)) : "memory"); asm volatile("ds_read_b64_tr_b16 %0, %1 offset:%2" : "=&v"(H[3]) : "v"(vb), "i"(v_rd_off(D0, 3, 1)) : "memory"); } while (0)
#define ATT_PK(L, H) (bf16x8){L[0], L[1], L[2], L[3], H[0], H[1], H[2], H[3]}
#define ATT_MM4(OD, L, H) do { OD = __builtin_amdgcn_mfma_f32_32x32x16_bf16(pa0, ATT_PK(L[0], H[0]), OD, 0, 0, 0); OD = __builtin_amdgcn_mfma_f32_32x32x16_bf16(pa1, ATT_PK(L[1], H[1]), OD, 0, 0, 0); \
    OD = __builtin_amdgcn_mfma_f32_32x32x16_bf16(pa2, ATT_PK(L[2], H[2]), OD, 0, 0, 0); OD = __builtin_amdgcn_mfma_f32_32x32x16_bf16(pa3, ATT_PK(L[3], H[3]), OD, 0, 0, 0); } while (0)
__device__ __forceinline__ void pv_d0(f32x16* o, int vb, bf16x8 pa0, bf16x8 pa1, bf16x8 pa2, bf16x8 pa3) {
  s16x4 la[4], ha[4], lb[4], hb[4];
  ATT_RD8(la, ha, 0); ATT_RD8(lb, hb, 1);
  asm volatile("s_waitcnt lgkmcnt(8)" ::: "memory"); SBAR(); ATT_MM4(o[0], la, ha); SBAR();
  ATT_RD8(la, ha, 2);
  asm volatile("s_waitcnt lgkmcnt(8)" ::: "memory"); SBAR(); ATT_MM4(o[1], lb, hb); SBAR();
  ATT_RD8(lb, hb, 3);
  asm volatile("s_waitcnt lgkmcnt(8)" ::: "memory"); SBAR(); ATT_MM4(o[2], la, ha); SBAR();
  asm volatile("s_waitcnt lgkmcnt(0)" ::: "memory"); SBAR(); ATT_MM4(o[3], lb, hb);
  const bf16x8 ones = {(short)0x3F80, (short)0x3F80, (short)0x3F80, (short)0x3F80, (short)0x3F80, (short)0x3F80, (short)0x3F80, (short)0x3F80};
  o[4] = __builtin_amdgcn_mfma_f32_32x32x16_bf16(pa0, ones, o[4], 0, 0, 0); o[4] = __builtin_amdgcn_mfma_f32_32x32x16_bf16(pa1, ones, o[4], 0, 0, 0);
  o[4] = __builtin_amdgcn_mfma_f32_32x32x16_bf16(pa2, ones, o[4], 0, 0, 0); o[4] = __builtin_amdgcn_mfma_f32_32x32x16_bf16(pa3, ones, o[4], 0, 0, 0);
}
__device__ __forceinline__ void pv_softmax(f32x16* o, int vb, bf16x8 pa0, bf16x8 pa1, bf16x8 pa2, bf16x8 pa3, f32x16& p0, f32x16& p1, float& m_reg, float& alpha, bool& resc) {
  s16x4 la[4], ha[4], lb[4], hb[4];
  ATT_RD8(la, ha, 0); ATT_RD8(lb, hb, 1);
  asm volatile("s_waitcnt lgkmcnt(8)" ::: "memory"); SBAR();
  float a = fmaxf(fmaxf(p0[0], p0[1]), p1[0]), b = fmaxf(fmaxf(p0[2], p0[3]), p1[1]); a = fmaxf(fmaxf(a, p1[2]), p1[3]);
#pragma unroll
  for (int r = 4; r < 16; r += 4) { a = fmaxf(fmaxf(a, p0[r]), p0[r + 1]); b = fmaxf(fmaxf(b, p0[r + 2]), p0[r + 3]); a = fmaxf(fmaxf(a, p1[r]), p1[r + 1]); b = fmaxf(fmaxf(b, p1[r + 2]), p1[r + 3]); }
  float pmax = fmaxf(a, b);
  ATT_MM4(o[0], la, ha); SBAR();
  ATT_RD8(la, ha, 2);
  asm volatile("s_waitcnt lgkmcnt(8)" ::: "memory"); SBAR();
  { auto rr = __builtin_amdgcn_permlane32_swap(__float_as_uint(pmax), __float_as_uint(pmax), false, false);
    pmax = fmaxf(__uint_as_float(rr[0]), __uint_as_float(rr[1])); }
  resc = false; alpha = 1.f;
  if (__builtin_expect(!__all(pmax <= THR2), 0)) { const float dl = fmaxf(pmax, 0.f); m_reg += dl; alpha = __builtin_amdgcn_exp2f(-dl); resc = true;
#pragma unroll
    for (int r = 0; r < 16; ++r) { p0[r] -= dl; p1[r] -= dl; } }
  ATT_MM4(o[1], lb, hb); SBAR();
  ATT_RD8(lb, hb, 3);
  asm volatile("s_waitcnt lgkmcnt(8)" ::: "memory"); SBAR();
#pragma unroll
  for (int r = 0; r < 16; ++r) p0[r] = __builtin_amdgcn_exp2f(p0[r]);
  ATT_MM4(o[2], la, ha); SBAR();
  asm volatile("s_waitcnt lgkmcnt(0)" ::: "memory"); SBAR();
#pragma unroll
  for (int r = 0; r < 16; ++r) p1[r] = __builtin_amdgcn_exp2f(p1[r]);
  ATT_MM4(o[3], lb, hb);
  const bf16x8 ones = {(short)0x3F80, (short)0x3F80, (short)0x3F80, (short)0x3F80, (short)0x3F80, (short)0x3F80, (short)0x3F80, (short)0x3F80};
  o[4] = __builtin_amdgcn_mfma_f32_32x32x16_bf16(pa0, ones, o[4], 0, 0, 0); o[4] = __builtin_amdgcn_mfma_f32_32x32x16_bf16(pa1, ones, o[4], 0, 0, 0);
  o[4] = __builtin_amdgcn_mfma_f32_32x32x16_bf16(pa2, ones, o[4], 0, 0, 0); o[4] = __builtin_amdgcn_mfma_f32_32x32x16_bf16(pa3, ones, o[4], 0, 0, 0);
}
__device__ __forceinline__ void near_bias(f32x16& p0, f32x16& p1, int dq, const float* tbl) {
#pragma unroll
  for (int r = 0; r < 16; ++r) { const int c0 = (r & 3) + 8 * (r >> 2); p0[r] += tbl[dq + c0]; p1[r] += tbl[dq + c0 + 32]; }
}
__device__ __forceinline__ void qkt(f32x16& p0, f32x16& p1, const char* Ks, const bf16x8* qr, int r32, int hi, int mapB) {
  bf16x8 k0[4], k1[4];
#pragma unroll
  for (int d0 = 0; d0 < 4; ++d0) { const int cb = mapB + (d0 * 16 + hi * 8) * 2;
    k0[d0] = *reinterpret_cast<const bf16x8*>(Ks + KSWZ(r32, cb)); k1[d0] = *reinterpret_cast<const bf16x8*>(Ks + KSWZ(32 + r32, cb)); }
  p0 = f32x16{}; p1 = f32x16{};
#pragma unroll
  for (int d0 = 0; d0 < 4; ++d0) {
    p0 = __builtin_amdgcn_mfma_f32_32x32x16_bf16(k0[d0], qr[d0], p0, 0, 0, 0);
    p1 = __builtin_amdgcn_mfma_f32_32x32x16_bf16(k1[d0], qr[d0], p1, 0, 0, 0); }
}
__device__ __forceinline__ void qkt_seed(f32x16& p0, f32x16& p1, const char* Ks, const bf16x8* qr, const int (&koff)[4], const f32x16& seed) {
#pragma unroll
  for (int d0 = 0; d0 < 4; ++d0) {
    const bf16x8 b0 = *reinterpret_cast<const bf16x8*>(Ks + koff[d0]);
    const bf16x8 b1 = *reinterpret_cast<const bf16x8*>(Ks + koff[d0] + 8192);
    if (d0 == 0) { p0 = __builtin_amdgcn_mfma_f32_32x32x16_bf16(b0, qr[0], seed, 0, 0, 0); p1 = __builtin_amdgcn_mfma_f32_32x32x16_bf16(b1, qr[0], seed, 0, 0, 0); }
    else { p0 = __builtin_amdgcn_mfma_f32_32x32x16_bf16(b0, qr[d0], p0, 0, 0, 0); p1 = __builtin_amdgcn_mfma_f32_32x32x16_bf16(b1, qr[d0], p1, 0, 0, 0); } }
}
__device__ __forceinline__ void partialSM_seeded(f32x16& p0, f32x16& p1, float& m_reg, float& alpha, bool& resc, int mode, int dq, const float* tbl) {
  if (mode == 0) {
#pragma unroll
    for (int r = 0; r < 16; ++r) { const int c0 = (r & 3) + 8 * (r >> 2);
      p0[r] += tbl[dq + c0]; p1[r] += tbl[dq + c0 + 32]; }
  }
  float a = fmaxf(fmaxf(p0[0], p0[1]), p1[0]), b = fmaxf(fmaxf(p0[2], p0[3]), p1[1]); a = fmaxf(fmaxf(a, p1[2]), p1[3]);
#pragma unroll
  for (int r = 4; r < 16; r += 4) { a = fmaxf(fmaxf(a, p0[r]), p0[r + 1]); b = fmaxf(fmaxf(b, p0[r + 2]), p0[r + 3]); a = fmaxf(fmaxf(a, p1[r]), p1[r + 1]); b = fmaxf(fmaxf(b, p1[r + 2]), p1[r + 3]); }
  float pmax = fmaxf(a, b);
  { auto rr = __builtin_amdgcn_permlane32_swap(__float_as_uint(pmax), __float_as_uint(pmax), false, false);
    pmax = fmaxf(__uint_as_float(rr[0]), __uint_as_float(rr[1])); }
  resc = false; alpha = 1.f;
  if (__builtin_expect(!__all(pmax <= THR2), 0)) { const float dl = fmaxf(pmax, 0.f); m_reg += dl; alpha = __builtin_amdgcn_exp2f(-dl); resc = true;
#pragma unroll
    for (int r = 0; r < 16; ++r) { p0[r] -= dl; p1[r] -= dl; } }
#pragma unroll
  for (int r = 0; r < 16; ++r) p0[r] = __builtin_amdgcn_exp2f(p0[r]);
}
__device__ __forceinline__ void partialSM(f32x16& p0, f32x16& p1, float& m_reg, float& mn, float& alpha, int mode, float cL, float cR, int dq, const float* tbl) {
  float cadd;
  if (mode == 0) {
#pragma unroll
    for (int r = 0; r < 16; ++r) { const int c0 = (r & 3) + 8 * (r >> 2);
      p0[r] += tbl[dq + c0]; p1[r] += tbl[dq + c0 + 32]; }
    cadd = 0.f;
  } else cadd = (mode < 0) ? cL : cR;
  float pmax = p0[0];
#pragma unroll
  for (int r = 1; r < 16; ++r) pmax = fmaxf(pmax, p0[r]);
#pragma unroll
  for (int r = 0; r < 16; ++r) pmax = fmaxf(pmax, p1[r]);
  { auto rr = __builtin_amdgcn_permlane32_swap(__float_as_uint(pmax), __float_as_uint(pmax), false, false);
    pmax = fmaxf(__uint_as_float(rr[0]), __uint_as_float(rr[1])); }
  pmax += cadd;
  if (__builtin_expect(__all(pmax - m_reg <= THR2), 1)) { mn = m_reg; alpha = 1.f; }
  else { mn = fmaxf(m_reg, pmax); alpha = __builtin_amdgcn_exp2f(m_reg - mn); m_reg = mn; }
  const float sh = cadd - mn;
#pragma unroll
  for (int r = 0; r < 16; ++r) p0[r] += sh;
#pragma unroll
  for (int r = 0; r < 16; ++r) p1[r] += sh;
#pragma unroll
  for (int r = 0; r < 16; ++r) p0[r] = __builtin_amdgcn_exp2f(p0[r]);
}
__device__ __forceinline__ void finishSM(f32x16& p0, f32x16& p1, bf16x8& pa0, bf16x8& pa1, bf16x8& pa2, bf16x8& pa3) {
#define PK8(P, BASE, OUT) do { v4u w = {cvt_pk_bf16(P[BASE + 0], P[BASE + 1]), cvt_pk_bf16(P[BASE + 2], P[BASE + 3]), cvt_pk_bf16(P[BASE + 4], P[BASE + 5]), cvt_pk_bf16(P[BASE + 6], P[BASE + 7])}; OUT = *reinterpret_cast<bf16x8*>(&w); } while (0)
  PK8(p0, 0, pa0); PK8(p0, 8, pa1); PK8(p1, 0, pa2); PK8(p1, 8, pa3);
#undef PK8
}
__device__ __forceinline__ int rel_bucket(int rel) {
  const int n = rel < 0 ? -rel : rel; int b;
  if (n < 8) b = n; else if (n < 12) b = 8; else if (n < 16) b = 9; else if (n < 23) b = 10; else if (n < 32) b = 11; else if (n < 46) b = 12; else if (n < 64) b = 13; else if (n < 91) b = 14; else b = 15;
  return (rel > 0 ? 16 : 0) + b;
}

__device__ __forceinline__ void attn_unit(int b, int h, int qb, const bf16_t* __restrict__ Q, const bf16_t* __restrict__ K, const bf16_t* __restrict__ V, bf16_t* __restrict__ O,
                                          float lam, float osc, const float* __restrict__ g, const float* __restrict__ rel_bias, char* lds, int tid_in, bool build_tbl, bool o8) {
  int tid_ = tid_in; asm volatile("" : "+v"(tid_));
  const int tid = tid_, wid = __builtin_amdgcn_readfirstlane(tid >> 6), lane = tid & 63, r32 = lane & 31, hi = lane >> 5;
  const int map = wid & 1, jq = wid >> 1;
  char* V_lds = lds + OFF_V; char* K_lds = lds + OFF_K;
  float* ws = (float*)(lds + OFF_WS) + wid * 64; float* li_l = ws; float* al_l = ws + 32;
  float* tbl = (float*)(lds + OFF_TBL);
  if (build_tbl) tbl[tid] = rel_bias[rel_bucket(tid - 256) * NH + h] * LOG2E;
  const float cL = rel_bias[15 * NH + h] * LOG2E, cR = rel_bias[31 * NH + h] * LOG2E;
  const long rowbase = (long)b * SEQ; const int qs = qb * 128 + jq * QBLK;
  float m_reg = -1e30f; f32x16 o[5] = {}; bf16x8 qr[4];
  const bf16_t* Qw = Q + (rowbase + qs + r32) * LDX + h * 128 + map * 64 + hi * 8;
#pragma unroll
  for (int d0 = 0; d0 < 4; ++d0) qr[d0] = *reinterpret_cast<const bf16x8*>(Qw + d0 * 16);
  const bf16_t* Kh = K + rowbase * LDX + h * 128; const bf16_t* Vh = V + rowbase * LDX + h * 128;
  const int vb0 = (int)(uintptr_t)V_lds + v_rd_base(lane);
  const int mapB = map * 128;
  int koff[4];
#pragma unroll
  for (int d0 = 0; d0 < 4; ++d0) koff[d0] = KSWZ(r32, mapB + (d0 * 16 + hi * 8) * 2);
  const int dq0 = 256 + 4 * hi - (qs + r32);
  unsigned ksrc[2], vsrc[2];
#pragma unroll
  for (int i = 0; i < 2; ++i) { const int pk = wid + 8 * i;
    const int krow = 4 * pk + (lane >> 4), kc = (lane & 15) ^ (krow & 7); ksrc[i] = (unsigned)(krow * (LDX * 2) + kc * 16);
    const int st = 2 * pk + (lane >> 5), kk = (st >> 2) * 8 + ((lane & 31) >> 2), vk = kk  , vc = (st & 3) * 32 + (lane & 3) * 8;
    vsrc[i] = (unsigned)(vk * (LDX * 2) + vc * 2); }
  typedef const __attribute__((address_space(1))) unsigned* gptr_t; typedef __attribute__((address_space(3))) unsigned* lptr_t;
  const char* const Kg = (const char*)Kh; const char* const Vg = (const char*)Vh;
  const lptr_t kdst = (lptr_t)(__attribute__((address_space(3))) char*)(K_lds) + 0; (void)kdst;
#define DMA_TILE(t, slot) do { const unsigned tb_ = (unsigned)(t) * (unsigned)(KVBLK * LDX * 2); \
    _Pragma("unroll") for (int i_ = 0; i_ < 2; ++i_) { \
      __builtin_amdgcn_global_load_lds((gptr_t)(Kg + (ksrc[i_] + tb_)), (lptr_t)((__attribute__((address_space(3))) char*)K_lds + (slot) + (wid + 8 * i_) * 1024), 16, 0, 0); \
      __builtin_amdgcn_global_load_lds((gptr_t)(Vg + (vsrc[i_] + tb_)), (lptr_t)((__attribute__((address_space(3))) char*)V_lds + (slot) + (wid + 8 * i_) * 1024), 16, 0, 0); } } while (0)
#define WAIT_BAR() do { asm volatile("s_waitcnt vmcnt(0) lgkmcnt(0)" ::: "memory"); __builtin_amdgcn_s_barrier(); asm volatile("" ::: "memory"); } while (0)
#define RESC(a, rs) do { if (rs) { if (hi == 0) al_l[r32] = (a); asm volatile("s_waitcnt lgkmcnt(0)" ::: "memory"); \
    _Pragma("unroll") for (int d = 0; d < 5; ++d) _Pragma("unroll") for (int r = 0; r < 16; ++r) o[d][r] *= al_l[crow(r, hi)]; } } while (0)
#define SEED(md) do { const int md_ = (md); const float sv_ = (md_ == 0 ? 0.f : (md_ < 0 ? cL : cR)) - m_reg; _Pragma("unroll") for (int r = 0; r < 16; ++r) seed[r] = sv_; } while (0)
#define TMODE(k0) (((k0) >= qs + 122) ? 1 : (((k0) <= qs - 154) ? -1 : 0))
#define ROT() do { const int t_ = sl_prev; sl_prev = sl_cur; sl_cur = sl_next; sl_next = t_; } while (0)
  f32x16 pA0, pA1, pB0, pB1, seed; float mnA, alA, alB; bool rsA = false, rsB = false; bf16x8 pa0, pa1, pa2, pa3;
  int sl_prev = 2 * SHM_V, sl_cur = 0, sl_next = SHM_V;
  if (wid >= 4) __builtin_amdgcn_s_setprio(1);
  DMA_TILE(0, 0); DMA_TILE(1, SHM_V);
  WAIT_BAR();
  DMA_TILE(2, 2 * SHM_V);
  qkt(pA0, pA1, K_lds, qr, r32, hi, mapB); partialSM(pA0, pA1, m_reg, mnA, alA, TMODE(0), cL, cR, dq0, tbl);
  _Pragma("unroll") for (int r = 0; r < 16; ++r) pA1[r] = __builtin_amdgcn_exp2f(pA1[r]);
  ROT();
#define QK_SEEDED(P0, P1, DMA_STMT, SEED_STMT) do { bf16x8 k0_[4], k1_[4]; const char* Ks_ = K_lds + sl_cur; \
    _Pragma("unroll") for (int d0 = 0; d0 < 4; ++d0) { k0_[d0] = *reinterpret_cast<const bf16x8*>(Ks_ + koff[d0]); k1_[d0] = *reinterpret_cast<const bf16x8*>(Ks_ + koff[d0] + 8192); } \
    DMA_STMT; SEED_STMT; \
    P0 = __builtin_amdgcn_mfma_f32_32x32x16_bf16(k0_[0], qr[0], seed, 0, 0, 0); P1 = __builtin_amdgcn_mfma_f32_32x32x16_bf16(k1_[0], qr[0], seed, 0, 0, 0); \
    _Pragma("unroll") for (int d0 = 1; d0 < 4; ++d0) { P0 = __builtin_amdgcn_mfma_f32_32x32x16_bf16(k0_[d0], qr[d0], P0, 0, 0, 0); P1 = __builtin_amdgcn_mfma_f32_32x32x16_bf16(k1_[d0], qr[d0], P1, 0, 0, 0); } } while (0)
  for (int j = 1; j + 1 < NT; j += 2) {
    SBAR(); QK_SEEDED(pB0, pB1, if (j > 1) DMA_TILE(j + 1, sl_next), SEED(TMODE(j * KVBLK)));
    finishSM(pA0, pA1, pa0, pa1, pa2, pa3); SBAR();
    if (TMODE(j * KVBLK) == 0) near_bias(pB0, pB1, dq0 + j * KVBLK, tbl);
    pv_softmax(o, vb0 + sl_prev, pa0, pa1, pa2, pa3, pB0, pB1, m_reg, alB, rsB);
    WAIT_BAR();
    RESC(alB, rsB); ROT();
    SBAR(); QK_SEEDED(pA0, pA1, DMA_TILE(j + 2, sl_next), SEED(TMODE((j + 1) * KVBLK)));
    finishSM(pB0, pB1, pa0, pa1, pa2, pa3); SBAR();
    if (TMODE((j + 1) * KVBLK) == 0) near_bias(pA0, pA1, dq0 + (j + 1) * KVBLK, tbl);
    pv_softmax(o, vb0 + sl_prev, pa0, pa1, pa2, pa3, pA0, pA1, m_reg, alA, rsA);
    WAIT_BAR();
    RESC(alA, rsA); ROT();
  }
  SBAR(); QK_SEEDED(pB0, pB1, (void)0, SEED(TMODE((NT - 1) * KVBLK)));
  finishSM(pA0, pA1, pa0, pa1, pa2, pa3); SBAR();
  if (TMODE((NT - 1) * KVBLK) == 0) near_bias(pB0, pB1, dq0 + (NT - 1) * KVBLK, tbl);
  pv_softmax(o, vb0 + sl_prev, pa0, pa1, pa2, pa3, pB0, pB1, m_reg, alB, rsB);
  RESC(alB, rsB);
  finishSM(pB0, pB1, pa0, pa1, pa2, pa3); SBAR();
  pv_d0(o, vb0 + sl_cur, pa0, pa1, pa2, pa3);
  __builtin_amdgcn_s_setprio(0);
  float rli[16];
#pragma unroll
  for (int r = 0; r < 16; ++r) rli[r] = __builtin_amdgcn_rcpf(o[4][r]);
  __syncthreads();
  float* X = (float*)(lds + jq * 16384);
  if (map == 1) {
#pragma unroll
    for (int r = 0; r < 16; ++r) { const int orow = crow(r, hi); const float s = rli[r] * lam;
#pragma unroll
      for (int d0 = 0; d0 < 4; ++d0) X[orow * 128 + d0 * 32 + r32] = o[d0][r] * s; }
  }
  __syncthreads();
  if (map == 0) {
    float ss[16];
#pragma unroll
    for (int r = 0; r < 16; ++r) { const int orow = crow(r, hi); float a = 0.f;
#pragma unroll
      for (int d0 = 0; d0 < 4; ++d0) { const float v = o[d0][r] * rli[r] - X[orow * 128 + d0 * 32 + r32]; o[d0][r] = v; a += v * v; }
      ss[r] = a; }
#pragma unroll
    for (int s = 1; s < 32; s <<= 1)
#pragma unroll
      for (int r = 0; r < 16; ++r) ss[r] += __shfl_xor(ss[r], s);
    float gg[4];
#pragma unroll
    for (int d0 = 0; d0 < 4; ++d0) gg[d0] = g[d0 * 32 + r32] * osc;
    asm volatile("s_waitcnt lgkmcnt(0)" ::: "memory");
    bf16_t* stg = (bf16_t*)X;
#pragma unroll
    for (int r = 0; r < 16; ++r) { const int orow = crow(r, hi); const float rs = __builtin_amdgcn_rsqf(ss[r] * (1.0f / 128.0f) + LN_EPS);
#pragma unroll
      for (int d0 = 0; d0 < 4; ++d0) { const float v = o[d0][r] * rs * gg[d0]; stg[orow * 128 + d0 * 32 + r32] = (bf16_t)(cvt_pk_bf16(v, v) & 0xffffu); } }
    asm volatile("s_waitcnt lgkmcnt(0)" ::: "memory");
    bf16_t* Ow = O + (rowbase + qs) * LDX + h * 128;
#pragma unroll
    for (int i = 0; i < 8; ++i) { const int row = i * 4 + (lane >> 4), ch = lane & 15; const v4u v = *(const v4u*)(stg + row * 128 + ch * 8);
      if (!o8) *(v4u*)(Ow + (long)row * LDX + ch * 8) = v;
      else { typedef unsigned u32x2 __attribute__((ext_vector_type(2))); u32x2 q8; q8.x = pg8::pk4_fp8(bf_lo(v.x), bf_hi(v.x), bf_lo(v.y), bf_hi(v.y)); q8.y = pg8::pk4_fp8(bf_lo(v.z), bf_hi(v.z), bf_lo(v.w), bf_hi(v.w));
        *(u32x2*)((unsigned char*)O + (size_t)(rowbase + qs + row) * LDX + h * 128 + ch * 8) = q8; } }
    asm volatile("s_waitcnt lgkmcnt(0)" ::: "memory");
  }
  __syncthreads();
#undef DMA_TILE
#undef WAIT_BAR
#undef ROT
#undef RESC
#undef SEED
#undef QK_SEEDED
#undef TMODE
}
#undef KSWZ
#undef SBAR
}

#define XB_TMO      128
#define XB_XCNT(j)  (256  + 64 * (j))
#define XB_XSUB(j)  (1280 + 64 * (j))
#define XB_XGEN(j)  (2304 + 64 * (j))
#define XB_TOP      3328
#define XB_TOPGEN   3392
#define XCD_BAR_WORDS 3456
#define XB_SPIN_CAP (1u << 18)
__device__ __forceinline__ unsigned xb_ld(unsigned* p)              { return __hip_atomic_load(p, __ATOMIC_RELAXED, __HIP_MEMORY_SCOPE_AGENT); }
__device__ __forceinline__ unsigned xb_add(unsigned* p, unsigned v) { return __hip_atomic_fetch_add(p, v, __ATOMIC_RELAXED, __HIP_MEMORY_SCOPE_AGENT); }
__device__ __forceinline__ unsigned xb_xcc_id() { return (unsigned)__builtin_amdgcn_s_getreg((3 << 11) | 20) & 0xFu; }
#define XB_SPIN(cond, bar) do { unsigned _sp = 0; while (cond) { __builtin_amdgcn_s_sleep(1); \
    if ((++_sp & 255u) == 0u) { if (xb_ld(&(bar)[XB_TMO])) break; if (_sp > XB_SPIN_CAP) { atomicAdd(&(bar)[XB_TMO], 1u); break; } } } } while (0)
struct XcdBarrier { unsigned* bar; unsigned x; volatile LAS unsigned* st; };
__device__ __forceinline__ XcdBarrier xcd_barrier_post(unsigned* bar, volatile LAS unsigned* st) {
    XcdBarrier b; b.bar = bar; b.x = xb_xcc_id(); b.st = st;
    if (threadIdx.x == 0) (void)xb_add(&bar[XB_XCNT(b.x)], 1u);
    return b;
}
__device__ __forceinline__ void xcd_barrier_complete(unsigned* bar, unsigned x, unsigned& nloc, unsigned& nx) {
    const unsigned G = gridDim.x * gridDim.y * gridDim.z;
    unsigned sum, cnt, mine, sp = 0u;
    for (;;) {
        sum = 0u; cnt = 0u; mine = 0u;
#pragma unroll
        for (unsigned j = 0; j < 16; ++j) { const unsigned c = xb_ld(&bar[XB_XCNT(j)]); sum += c; cnt += (c > 0u) ? 1u : 0u; mine = (j == x) ? c : mine; }
        if (sum == G) break;
        __builtin_amdgcn_s_sleep(1);
        if ((++sp & 255u) == 0u) { if (xb_ld(&bar[XB_TMO])) break; if (sp > XB_SPIN_CAP) { atomicAdd(&bar[XB_TMO], 1u); break; } }
    }
    nloc = mine > 0u ? mine : 1u; nx = cnt > 0u ? cnt : 1u;
}
__device__ __forceinline__ void xcd_barrier(const XcdBarrier& b) {
    asm volatile("s_waitcnt vmcnt(0)" ::: "memory");
    __syncthreads();
    if (threadIdx.x == 0) {
        unsigned* bar = b.bar;
        __builtin_amdgcn_s_waitcnt(0);
        unsigned nloc = b.st[0], nx = b.st[1];
        if (nloc == 0u) { xcd_barrier_complete(bar, b.x, nloc, nx); b.st[0] = nloc; b.st[1] = nx; }
        const unsigned old = xb_add(&bar[XB_XSUB(b.x)], 1u);
        const unsigned gen = old / nloc;
        if (old + 1u == (gen + 1u) * nloc) {
            __builtin_amdgcn_fence(__ATOMIC_RELEASE, "agent");
            asm volatile("s_waitcnt vmcnt(0)" ::: "memory");
            const unsigned og = xb_add(&bar[XB_TOP], 1u);
            const unsigned tg = og / nx;
            if (og + 1u == (tg + 1u) * nx) xb_add(&bar[XB_TOPGEN], 1u);
            else XB_SPIN(xb_ld(&bar[XB_TOPGEN]) == tg, bar);
            __builtin_amdgcn_fence(__ATOMIC_ACQUIRE, "agent");
            xb_add(&bar[XB_XGEN(b.x)], 1u);
            asm volatile("s_waitcnt vmcnt(0)" ::: "memory");
        } else {
            XB_SPIN(xb_ld(&bar[XB_XGEN(b.x)]) == gen, bar);
            __builtin_amdgcn_fence(__ATOMIC_ACQUIRE, "agent");
            asm volatile("s_waitcnt vmcnt(0)" ::: "memory");
        }
    }
    __syncthreads();
}

template <int MODE> __device__ __forceinline__ int dst_row(int n) {
    if (MODE == 1) { if (n < 1024) return n; const int b = (n - 1024) >> 10, f = (n - 1024) & 1023; return 1024 + (f >> 7) * 256 + b * 128 + (f & 127); }
    if (MODE == 2) { const int b = n & 1, j = n >> 1; return (j >> 7) * 256 + b * 128 + (j & 127); }
    return n;
}
template <int MODE> __device__ __forceinline__ void p0_transpose_item(const float* W, int K, int N, bf16_t* WT, LAS float* scr, int item, int lane, const float* kscale = nullptr) {
    const int nblk = N / 32, kb = item / nblk, nb = item % nblk, k0 = 64 * kb, n0 = 32 * nb;
#pragma unroll 8
    for (int i = 0; i < 32; ++i) { const int kk = 2 * i + (lane >> 5); float w = W[(size_t)(k0 + kk) * N + n0 + (lane & 31)]; if (kscale) w *= kscale[k0 + kk]; scr[kk * 33 + (lane & 31)] = w; }
    LDS_WAIT(); asm volatile("" ::: "memory");
    const int c = lane & 7;
#pragma unroll
    for (int j = 0; j < 4; ++j) { const int n = (lane >> 3) + 8 * j; const LAS float* s = scr + (8 * c) * 33 + n;
        v4u o; o.x = cvt_pk_bf16(s[0 * 33], s[1 * 33]); o.y = cvt_pk_bf16(s[2 * 33], s[3 * 33]); o.z = cvt_pk_bf16(s[4 * 33], s[5 * 33]); o.w = cvt_pk_bf16(s[6 * 33], s[7 * 33]);
        *(GAS v4u*)(WT + (size_t)dst_row<MODE>(n0 + n) * K + k0 + 8 * c) = o; }
    LDS_WAIT(); asm volatile("" ::: "memory");
}

template <int MODE, bool I8 = false> __device__ __forceinline__ void p0_quant_strip(const float* W, int N, unsigned char* W8, float* SC, int strip, LAS unsigned char* lds, int wave, int lane) {
    constexpr float QM_ = I8 ? 127.0f : F8MAX;
    LAS float* scr = (LAS float*)(lds + wave * 16384); LAS float* red = (LAS float*)(lds + LDSCTL_OFF + 2048);
    const int n0 = strip * 32, k0 = wave * 128, kk = lane >> 5, n = lane & 31;
    float am = 0.f;
#pragma unroll 16
    for (int i = 0; i < 64; ++i) { const float v = W[(size_t)(k0 + 2 * i + kk) * N + n0 + n]; scr[(2 * i + kk) * 32 + n] = v; am = fmaxf(am, fabsf(v)); }
    am = fmaxf(am, __shfl_xor(am, 32));
    if (lane < 32) red[wave * 32 + n] = am;
    __syncthreads();
    float amax = red[n];
#pragma unroll
    for (int w = 1; w < 8; ++w) amax = fmaxf(amax, red[w * 32 + n]);
    const float q = amax > 0.f ? QM_ / amax : 0.f;
    const int dr = dst_row<MODE>(n0 + n);
    if (wave == 0 && lane < 32) SC[dr] = amax * (1.0f / QM_);
#pragma unroll
    for (int c = 0; c < 4; ++c) { float v[16];
#pragma unroll
        for (int j = 0; j < 16; ++j) v[j] = scr[(kk * 64 + c * 16 + j) * 32 + n] * q;
        v4u o; o.x = pg8::pkq4<I8>(v[0], v[1], v[2], v[3]); o.y = pg8::pkq4<I8>(v[4], v[5], v[6], v[7]); o.z = pg8::pkq4<I8>(v[8], v[9], v[10], v[11]); o.w = pg8::pkq4<I8>(v[12], v[13], v[14], v[15]);
        *(GAS v4u*)(W8 + (size_t)dr * 1024 + k0 + kk * 64 + c * 16) = o; }
    __syncthreads();
}
__device__ __forceinline__ float ln_bound(const float* g, const float* b, int lane) {
    float mg = 0.f, mb = 0.f;
#pragma unroll
    for (int j = 0; j < 4; ++j) { const f32x4 a = *(const f32x4*)(g + j * 256 + lane * 4), c = *(const f32x4*)(b + j * 256 + lane * 4);
        mg = fmaxf(mg, fmaxf(fmaxf(fabsf(a[0]), fabsf(a[1])), fmaxf(fabsf(a[2]), fabsf(a[3])))); mb = fmaxf(mb, fmaxf(fmaxf(fabsf(c[0]), fabsf(c[1])), fmaxf(fabsf(c[2]), fabsf(c[3])))); }
#pragma unroll
    for (int o = 1; o < 64; o <<= 1) { mg = fmaxf(mg, __shfl_xor(mg, o)); mb = fmaxf(mb, __shfl_xor(mb, o)); }
    return 31.984371f * mg + mb;
}

struct Ptrs {
    const float *x, *rel_bias, *attn_w_in, *attn_lambda, *attn_subln, *attn_w_out, *conv_w_in, *conv_w, *conv_w_out, *router_w, *router_b, *w1, *b1, *w2, *b2, *ln_g, *ln_b;
    float* out; unsigned char* ws;
};

constexpr int NWAVES_ = 8;
__device__ __forceinline__ void p0_prologue(const Ptrs& P, LAS unsigned char* lds, int gw, int NGW, int wave, int lane) {
    LAS float* scr = (LAS float*)(lds + RING_OFF + wave * 16384);
    unsigned char* ws = P.ws;
    constexpr int I_OUT = 16 * 32, I_R = 16;
    constexpr int I_IN = 16 * 96;
    constexpr int S1 = NA16 * I_OUT, S3 = S1 + NO16 * I_OUT, S4 = S3 + 4 * I_R, S5 = S4 + NQ16 * I_IN, S6 = S5 + NC16 * I_IN;
    { const int wg = gw / NWAVES_, NWG = NGW / NWAVES_;
      constexpr int T1 = 128 * 64, T2 = T1 + 128 * 32, T3 = T2 + NQ8 * 96, T4 = T3 + NC8 * 96, T5 = T4 + NA8 * 32, T6 = T5 + NO8 * 32;
#pragma unroll 1
      for (int st = wg; st < T6; st += NWG) {
        if (st < T1) { const int j = st >> 6, r = st & 63; p0_quant_strip<2>(P.w1 + (size_t)j * 1024 * 2048, 2048, ws + WS_W1 + (size_t)j * 2048 * 1024, (float*)(ws + WS_S1) + (size_t)j * 2048, r, lds, wave, lane); }
        else if (st < T2) { const int q = st - T1, j = q >> 5, r = q & 31; p0_quant_strip<0>(P.w2 + (size_t)j * 1024 * 1024, 1024, ws + WS_W2 + (size_t)j * 1024 * 1024, (float*)(ws + WS_S2) + (size_t)j * 1024, r, lds, wave, lane); }
        else if (st < T3) { const int q = st - T2, j = QJ0 + q / 96, r = q % 96; p0_quant_strip<0, I8P>(P.attn_w_in + (size_t)j * 1024 * 3072, 3072, ws + WS_WAI + (size_t)j * 3072 * 1024, (float*)(ws + WS_SD) + (size_t)j * 3072, r, lds, wave, lane); }
        else if (st < T4) { const int q = st - T3, j = CJ0 + q / 96, r = q % 96; p0_quant_strip<1, I8P>(P.conv_w_in + (size_t)j * 1024 * 3072, 3072, ws + WS_WCI + (size_t)j * 3072 * 1024, (float*)(ws + WS_SD + 32 * 1024) + (size_t)j * 3072, r, lds, wave, lane); }
        else if (st < T5) { const int q = st - T4, j = AJ0 + q / 32, r = q % 32; p0_quant_strip<0>(P.attn_w_out + (size_t)j * 1024 * 1024, 1024, ws + WS_WAO8 + (size_t)j * 1024 * 1024, (float*)(ws + WS_SD + 24 * 1024) + (size_t)j * 1024, r, lds, wave, lane); }
        else { const int q = st - T5, j = OJ0 + q / 32, r = q % 32; p0_quant_strip<0, I8P>(P.conv_w_out + (size_t)j * 1024 * 1024, 1024, ws + WS_WCO8 + (size_t)j * 1024 * 1024, (float*)(ws + WS_SD + 56 * 1024) + (size_t)j * 1024, r, lds, wave, lane); }
      } }
    for (int it = gw; it < S6; it += NGW) {
        if (it >= S5) { const int q = it - S5, j = CK0 + q / I_IN, r = q % I_IN; p0_transpose_item<1>(P.conv_w_in + (size_t)j * 1024 * 3072, 1024, 3072, (bf16_t*)(ws + WS_WC16) + (size_t)j * 3072 * 1024, scr, r, lane); }
        else if (it >= S4) { const int q = it - S4, j = QK0 + q / I_IN, r = q % I_IN; p0_transpose_item<0>(P.attn_w_in + (size_t)j * 1024 * 3072, 1024, 3072, (bf16_t*)(ws + WS_WA16) + (size_t)j * 3072 * 1024, scr, r, lane); }
        else if (it < S1) { const int q = it, j = AK0 + q / I_OUT, r = q % I_OUT; p0_transpose_item<0>(P.attn_w_out + (size_t)j * 1024 * 1024, 1024, 1024, (bf16_t*)(ws + WS_WAO) + (size_t)j * 1024 * 1024, scr, r, lane); }
        else if (it < S3) { const int q = it - S1, j = OK0 + q / I_OUT, r = q % I_OUT; p0_transpose_item<0>(P.conv_w_out + (size_t)j * 1024 * 1024, 1024, 1024, (bf16_t*)(ws + WS_WCO) + (size_t)j * 1024 * 1024, scr, r, lane); }
        else { const int q = it - S3, j = q / I_R, r = q % I_R; p0_transpose_item<0>(P.router_w + (size_t)j * 1024 * 32, 1024, 32, (bf16_t*)(ws + WS_WR) + (size_t)j * 32 * 1024, scr, r, lane, P.ln_g + (size_t)(j * 2 + 0) * D); }
    }
    for (int row = gw; row < M; row += NGW) {
        f32x4 a[2][2]; float am = 0.f;
#pragma unroll
        for (int h = 0; h < 2; ++h)
#pragma unroll
            for (int q = 0; q < 2; ++q) { a[h][q] = *(const GAS f32x4*)(P.x + (size_t)row * D + h * 512 + lane * 8 + q * 4);
                am = fmaxf(am, fmaxf(fmaxf(fabsf(a[h][q][0]), fabsf(a[h][q][1])), fmaxf(fabsf(a[h][q][2]), fabsf(a[h][q][3])))); }
#pragma unroll
        for (int o = 1; o < 64; o <<= 1) am = fmaxf(am, __shfl_xor(am, o));
        const float qs = QMAXP / fmaxf(am, 1e-30f);
        if ((QM & 1) && lane == 0) ((float*)(ws + WS_RS))[row] = am * (1.0f / QMAXP);
#pragma unroll
        for (int h = 0; h < 2; ++h) { v4u o; o.x = cvt_pk_bf16(a[h][0][0], a[h][0][1]); o.y = cvt_pk_bf16(a[h][0][2], a[h][0][3]); o.z = cvt_pk_bf16(a[h][1][0], a[h][1][1]); o.w = cvt_pk_bf16(a[h][1][2], a[h][1][3]);
            *(GAS v4u*)((bf16_t*)(ws + WS_XB) + (size_t)row * D + h * 512 + lane * 8) = o;
            if (QM & 1) { typedef unsigned u32x2 __attribute__((ext_vector_type(2))); u32x2 q8;
            q8.x = pg8::pkq4<I8P>(a[h][0][0] * qs, a[h][0][1] * qs, a[h][0][2] * qs, a[h][0][3] * qs); q8.y = pg8::pkq4<I8P>(a[h][1][0] * qs, a[h][1][1] * qs, a[h][1][2] * qs, a[h][1][3] * qs);
            *(GAS u32x2*)(ws + WS_XI + (size_t)row * D + h * 512 + lane * 8) = q8; } }
    }
}

__device__ __forceinline__ void conv_phase(const bf16_t* GB, const bf16_t* Z, const float* cw, bf16_t* Gout, float* RS, bool o8, int gw, int NGW, int lane) {
    float w[3][16];
#pragma unroll
    for (int j = 0; j < 3; ++j)
#pragma unroll
        for (int h = 0; h < 2; ++h)
#pragma unroll
            for (int q = 0; q < 2; ++q) { const f32x4 t = *(const f32x4*)(cw + j * D + h * 512 + lane * 8 + q * 4); w[j][h * 8 + q * 4 + 0] = t[0]; w[j][h * 8 + q * 4 + 1] = t[1]; w[j][h * 8 + q * 4 + 2] = t[2]; w[j][h * 8 + q * 4 + 3] = t[3]; }
    for (int run = gw; run < M / 32; run += NGW) {
        const int t0 = run * 32; const bool first = (t0 % SEQ) == 0, lastr = ((t0 + 32) % SEQ) == 0;
        v4u zp[2], zc[2], zn[2];
#pragma unroll
        for (int h = 0; h < 2; ++h) { zp[h] = first ? (v4u){0u, 0u, 0u, 0u} : *(const v4u*)(Z + (size_t)(t0 - 1) * D + h * 512 + lane * 8); zc[h] = *(const v4u*)(Z + (size_t)t0 * D + h * 512 + lane * 8); }
        for (int r = 0; r < 32; ++r) { const int t = t0 + r; const bool pad = lastr && (r == 31);
            float o[2][8];
#pragma unroll
            for (int h = 0; h < 2; ++h) {
                zn[h] = pad ? (v4u){0u, 0u, 0u, 0u} : *(const v4u*)(Z + (size_t)(t + 1) * D + h * 512 + lane * 8);
                const v4u gb = *(const v4u*)(GB + (size_t)t * D + h * 512 + lane * 8);
#pragma unroll
                for (int q = 0; q < 4; ++q) { const unsigned up = zp[h][q], uc = zc[h][q], un = zn[h][q], ug = gb[q]; const int c = h * 8 + q * 2;
                    o[h][q * 2 + 0] = bf_lo(ug) * (w[0][c] * bf_lo(up) + w[1][c] * bf_lo(uc) + w[2][c] * bf_lo(un));
                    o[h][q * 2 + 1] = bf_hi(ug) * (w[0][c + 1] * bf_hi(up) + w[1][c + 1] * bf_hi(uc) + w[2][c + 1] * bf_hi(un)); }
                if (!o8) { v4u ov; ov.x = cvt_pk_bf16(o[h][0], o[h][1]); ov.y = cvt_pk_bf16(o[h][2], o[h][3]); ov.z = cvt_pk_bf16(o[h][4], o[h][5]); ov.w = cvt_pk_bf16(o[h][6], o[h][7]);
                    *(v4u*)(Gout + (size_t)t * D + h * 512 + lane * 8) = ov; }
                zp[h] = zc[h]; zc[h] = zn[h];
            }
            if (o8) { float am = 0.f;
#pragma unroll
                for (int h = 0; h < 2; ++h)
#pragma unroll
                    for (int i = 0; i < 8; ++i) am = fmaxf(am, fabsf(o[h][i]));
#pragma unroll
                for (int s_ = 1; s_ < 64; s_ <<= 1) am = fmaxf(am, __shfl_xor(am, s_));
                const float qs = QMAXP / fmaxf(am, 1e-30f);
                if (lane == 0) RS[t] = am * (1.0f / QMAXP);
#pragma unroll
                for (int h = 0; h < 2; ++h) { typedef unsigned u32x2 __attribute__((ext_vector_type(2))); u32x2 q8;
                    q8.x = pg8::pkq4<I8P>(o[h][0] * qs, o[h][1] * qs, o[h][2] * qs, o[h][3] * qs); q8.y = pg8::pkq4<I8P>(o[h][4] * qs, o[h][5] * qs, o[h][6] * qs, o[h][7] * qs);
                    *(u32x2*)((unsigned char*)Gout + (size_t)t * D + h * 512 + lane * 8) = q8; } }
        }
    }
}

__device__ __forceinline__ void ln2_phase(const bf16_t* Yp, const float* g1, const float* b1, const unsigned char* Y, const float* g, const float* bta, bf16_t* XB, float* out, unsigned char* XI, float* RS, int gw, int NGW, int lane) {
    float gg[16], bb[16];
#pragma unroll
    for (int h = 0; h < 2; ++h)
#pragma unroll
        for (int q = 0; q < 2; ++q) { const f32x4 t = *(const f32x4*)(g + h * 512 + lane * 8 + q * 4), s = *(const f32x4*)(bta + h * 512 + lane * 8 + q * 4);
#pragma unroll
            for (int i = 0; i < 4; ++i) { gg[h * 8 + q * 4 + i] = t[i]; bb[h * 8 + q * 4 + i] = s[i]; } }
    float sXb = 0.f, rsXb = 0.f; if constexpr (!I8P) { const float lb = ln_bound(g, bta, lane); sXb = F8MAX / lb; rsXb = lb * (1.0f / F8MAX); }
    for (int row = gw; row < M; row += NGW) {
        float v[16];
#pragma unroll
        for (int h = 0; h < 2; ++h) { const v4u xr = *(const v4u*)(Yp + (size_t)row * D + h * 512 + lane * 8);
#pragma unroll
            for (int q = 0; q < 4; ++q) { v[h * 8 + q * 2] = bf_lo(xr[q]); v[h * 8 + q * 2 + 1] = bf_hi(xr[q]); } }
        { float s1 = 0.f;
#pragma unroll
          for (int i = 0; i < 16; ++i) s1 += v[i];
          const float m1 = wave_sum(s1) * (1.f / D); float q1 = 0.f;
#pragma unroll
          for (int i = 0; i < 16; ++i) { v[i] -= m1; q1 += v[i] * v[i]; }
          const float r1 = ALPHA / sqrtf(wave_sum(q1) * (1.f / D) + LN_EPS);
#pragma unroll
          for (int h = 0; h < 2; ++h)
#pragma unroll
            for (int q = 0; q < 2; ++q) { const f32x4 t = *(const f32x4*)(g1 + h * 512 + lane * 8 + q * 4), u = *(const f32x4*)(b1 + h * 512 + lane * 8 + q * 4);
#pragma unroll
              for (int i = 0; i < 4; ++i) v[h * 8 + q * 4 + i] = v[h * 8 + q * 4 + i] * r1 * t[i] + ALPHA * u[i]; } }
#pragma unroll
        for (int k = 0; k < 4; ++k)
#pragma unroll
            for (int h = 0; h < 2; ++h) { typedef unsigned u32x2 __attribute__((ext_vector_type(2))); const u32x2 yr = *(const u32x2*)(Y + ((size_t)row * 4 + k) * D + h * 512 + lane * 8);
#pragma unroll
                for (int q = 0; q < 2; ++q) { const f32x2 lo = __builtin_amdgcn_cvt_pk_f32_fp8((int)yr[q], false), hi2 = __builtin_amdgcn_cvt_pk_f32_fp8((int)yr[q], true);
                    v[h * 8 + q * 4 + 0] += lo[0] * (1.0f / YSCALE); v[h * 8 + q * 4 + 1] += lo[1] * (1.0f / YSCALE); v[h * 8 + q * 4 + 2] += hi2[0] * (1.0f / YSCALE); v[h * 8 + q * 4 + 3] += hi2[1] * (1.0f / YSCALE); } }
        float s = 0.f;
#pragma unroll
        for (int i = 0; i < 16; ++i) s += v[i];
        const float mean = wave_sum(s) * (1.f / D); float s2 = 0.f;
#pragma unroll
        for (int i = 0; i < 16; ++i) { v[i] -= mean; s2 += v[i] * v[i]; }
        const float rstd = 1.f / sqrtf(wave_sum(s2) * (1.f / D) + LN_EPS);
#pragma unroll
        for (int i = 0; i < 16; ++i) v[i] = v[i] * rstd * gg[i] + bb[i];
        float sX = sXb, rsX = rsXb;
        if (I8P && XI) { float am = 0.f;
#pragma unroll
            for (int i = 0; i < 16; ++i) am = fmaxf(am, fabsf(v[i]));
#pragma unroll
            for (int o = 1; o < 64; o <<= 1) am = fmaxf(am, __shfl_xor(am, o));
            sX = QMAXP / fmaxf(am, 1e-30f); rsX = am * (1.0f / QMAXP); }
#pragma unroll
        for (int h = 0; h < 2; ++h) { v4u ov; ov.x = cvt_pk_bf16(v[h * 8 + 0], v[h * 8 + 1]); ov.y = cvt_pk_bf16(v[h * 8 + 2], v[h * 8 + 3]); ov.z = cvt_pk_bf16(v[h * 8 + 4], v[h * 8 + 5]); ov.w = cvt_pk_bf16(v[h * 8 + 6], v[h * 8 + 7]);
            if (!out) *(v4u*)(XB + (size_t)row * D + h * 512 + lane * 8) = ov;
            if (XI) { typedef unsigned u32x2 __attribute__((ext_vector_type(2))); u32x2 q8; q8.x = pg8::pkq4<I8P>(v[h * 8 + 0] * sX, v[h * 8 + 1] * sX, v[h * 8 + 2] * sX, v[h * 8 + 3] * sX); q8.y = pg8::pkq4<I8P>(v[h * 8 + 4] * sX, v[h * 8 + 5] * sX, v[h * 8 + 6] * sX, v[h * 8 + 7] * sX);
                *(u32x2*)(XI + (size_t)row * D + h * 512 + lane * 8) = q8; if (h == 0 && lane == 0) RS[row] = rsX; }
            if (out) { *(f32x4*)(out + (size_t)row * D + h * 512 + lane * 8) = (f32x4){v[h * 8 + 0], v[h * 8 + 1], v[h * 8 + 2], v[h * 8 + 3]};
                       *(f32x4*)(out + (size_t)row * D + h * 512 + lane * 8 + 4) = (f32x4){v[h * 8 + 4], v[h * 8 + 5], v[h * 8 + 6], v[h * 8 + 7]}; } }
    }
}

constexpr int RT_PITCH = 2064, R_OFF_G = 32 * RT_PITCH, R_OFF_LG = R_OFF_G + 8192, R_OFF_CNT = R_OFF_LG + 8 * 16 * 33 * 4, R_OFF_SW = R_OFF_CNT + 256, R_LDS = R_OFF_SW + 256;
typedef __bf16 bf16x2_t __attribute__((ext_vector_type(2)));
__device__ __forceinline__ void router_phase(const bf16_t* Yp, const float* g, const float* bta, const bf16_t* RTg, const float* Wr, const float* rb, unsigned char* X8, int* lslot, float* lgate, unsigned* cnt,
                                             char* lds, int blk0, int G, int tid, int wave, int lane) {
    for (int i = tid; i < 32 * 128; i += 512) { const int e = i >> 7, c = i & 127; *(v4u*)(lds + e * RT_PITCH + c * 16) = *(const v4u*)(RTg + (size_t)e * 1024 + c * 8); }
    float* gl = (float*)(lds + R_OFF_G); float* bl = gl + 1024;
    for (int i = tid; i < 1024; i += 512) { gl[i] = g[i]; bl[i] = bta[i]; }
    float* LG = (float*)(lds + R_OFF_LG) + wave * (16 * 33);
    int* lcnt = (int*)(lds + R_OFF_CNT); int* lbase = lcnt + 32;
    float* sWl = (float*)(lds + R_OFF_SW); float* cBl = sWl + 32;
    __syncthreads();
#pragma unroll 1
    for (int j = 0; j < 4; ++j) { const int e = wave * 4 + j; float a = 0.f, c = 0.f;
#pragma unroll 4
        for (int i = 0; i < 16; ++i) { const int k = lane + 64 * i; a += __uint_as_float((unsigned)(*(const bf16_t*)(lds + e * RT_PITCH + k * 2)) << 16); c += bl[k] * Wr[(size_t)k * 32 + e]; }
        a = wave_sum(a); c = wave_sum(c); if (lane == 0) { sWl[e] = a; cBl[e] = c + rb[e]; } }
    const int t16 = lane & 15, kq = lane >> 4;
    const float sA = F8MAX / ln_bound(g, bta, lane);
#pragma unroll 1
    for (int blk = blk0; blk < M / 128; blk += G) {
        if (tid < 32) lcnt[tid] = 0;
        __syncthreads();
        int my_e, my_rank, my_slot; float my_gate;
        const int r0 = blk * 128 + wave * 16; const size_t rowoff = (size_t)(r0 + t16) * D + kq * 8;
        v4u yv[32];
#pragma unroll
        for (int kb = 0; kb < 32; ++kb) yv[kb] = *(const v4u*)(Yp + rowoff + kb * 32);
        f32x4 acc0 = {0.f, 0.f, 0.f, 0.f}, acc1 = {0.f, 0.f, 0.f, 0.f}, accs = {0.f, 0.f, 0.f, 0.f}, accq = {0.f, 0.f, 0.f, 0.f};
        const bf16x8 ones8 = {(short)0x3F80, (short)0x3F80, (short)0x3F80, (short)0x3F80, (short)0x3F80, (short)0x3F80, (short)0x3F80, (short)0x3F80};
#pragma unroll
        for (int kb = 0; kb < 32; ++kb) { const int c0 = kb * 32 + kq * 8;
            const bf16x8 w0 = *(const bf16x8*)(lds + t16 * RT_PITCH + c0 * 2), w1 = *(const bf16x8*)(lds + (16 + t16) * RT_PITCH + c0 * 2);
            const bf16x8 xb = __builtin_bit_cast(bf16x8, yv[kb]);
            acc0 = __builtin_amdgcn_mfma_f32_16x16x32_bf16(w0, xb, acc0, 0, 0, 0);
            acc1 = __builtin_amdgcn_mfma_f32_16x16x32_bf16(w1, xb, acc1, 0, 0, 0);
            accs = __builtin_amdgcn_mfma_f32_16x16x32_bf16(ones8, xb, accs, 0, 0, 0);
            accq = __builtin_amdgcn_mfma_f32_16x16x32_bf16(xb, xb, accq, 0, 0, 0); }
        const float s = accs[0];
        const int dsel = t16 & 3; float dq_ = dsel == 0 ? accq[0] : (dsel == 1 ? accq[1] : (dsel == 2 ? accq[2] : accq[3]));
        const float s2 = __shfl(dq_, (t16 >> 2) * 16 + t16);
        const float mean = s * (1.f / D); const float var = fmaxf(s2 * (1.f / D) - mean * mean, 0.f);
        const float rstd = 1.f / sqrtf(var + LN_EPS);
        {
            float* lgr = LG + t16 * 33;
#pragma unroll
            for (int i = 0; i < 4; ++i) { const int e0 = kq * 4 + i, e1 = 16 + kq * 4 + i;
                lgr[e0] = rstd * (acc0[i] - mean * sWl[e0]) + cBl[e0]; lgr[e1] = rstd * (acc1[i] - mean * sWl[e1]) + cBl[e1]; }
            LDS_WAIT(); asm volatile("" ::: "memory");
            float t0 = -INFINITY, t1 = -INFINITY, t2 = -INFINITY, t3 = -INFINITY; int i0 = 0, i1 = 0, i2 = 0, i3 = 0;
#pragma unroll
            for (int e = 0; e < 32; ++e) { const float v = lgr[e];
                const bool c0 = v > t0, c1 = v > t1, c2 = v > t2, c3 = v > t3;
                t3 = c2 ? t2 : (c3 ? v : t3); i3 = c2 ? i2 : (c3 ? e : i3);
                t2 = c1 ? t1 : (c2 ? v : t2); i2 = c1 ? i1 : (c2 ? e : i2);
                t1 = c0 ? t0 : (c1 ? v : t1); i1 = c0 ? i0 : (c1 ? e : i1);
                t0 = c0 ? v : t0; i0 = c0 ? e : i0; }
            const float e1 = __expf(t1 - t0), e2 = __expf(t2 - t0), e3 = __expf(t3 - t0); const float inv = 1.f / (1.f + e1 + e2 + e3);
            const int ek = kq == 0 ? i0 : (kq == 1 ? i1 : (kq == 2 ? i2 : i3)); const float gk = (kq == 0 ? 1.f : (kq == 1 ? e1 : (kq == 2 ? e2 : e3))) * inv;
            my_e = ek; my_gate = gk; my_slot = (r0 + t16) * 4 + kq; my_rank = atomicAdd(&lcnt[ek], 1);
            LDS_WAIT(); asm volatile("" ::: "memory");
        }
        const float rs = rstd * sA;
#pragma unroll
        for (int kb = 0; kb < 32; ++kb) { const int c0 = kb * 32 + kq * 8; const v4u y = yv[kb];
            const f32x4 g0 = *(const f32x4*)(gl + c0) * rs, g1 = *(const f32x4*)(gl + c0 + 4) * rs, b0 = *(const f32x4*)(bl + c0) * sA, b1 = *(const f32x4*)(bl + c0 + 4) * sA;
            typedef unsigned u32x2 __attribute__((ext_vector_type(2))); u32x2 q8;
            q8.x = pg8::pk4_fp8((bf_lo(y.x) - mean) * g0[0] + b0[0], (bf_hi(y.x) - mean) * g0[1] + b0[1], (bf_lo(y.y) - mean) * g0[2] + b0[2], (bf_hi(y.y) - mean) * g0[3] + b0[3]);
            q8.y = pg8::pk4_fp8((bf_lo(y.z) - mean) * g1[0] + b1[0], (bf_hi(y.z) - mean) * g1[1] + b1[1], (bf_lo(y.w) - mean) * g1[2] + b1[2], (bf_hi(y.w) - mean) * g1[3] + b1[3]);
            *(u32x2*)(X8 + rowoff + kb * 32) = q8;
            asm volatile("" ::: "memory"); }
        __syncthreads();
        if (tid < 32) lbase[tid] = (int)__hip_atomic_fetch_add(cnt + tid * 64, (unsigned)lcnt[tid], RLX_AGENT);
        __syncthreads();
        { const int pos = lbase[my_e] + my_rank; lslot[(size_t)my_e * LCAP + pos] = my_slot; lgate[(size_t)my_e * LCAP + pos] = my_gate; }
        __syncthreads();
    }
}

__device__ __forceinline__ float attn_obound(const float* gsub, float osc, int lane) {
    float mg = fmaxf(fabsf(gsub[lane]), fabsf(gsub[64 + lane]));
#pragma unroll
    for (int o = 1; o < 64; o <<= 1) mg = fmaxf(mg, __shfl_xor(mg, o));
    return 11.3137085f * mg * fabsf(osc);
}

constexpr int NWAVES = 8;
constexpr int N_PHASES = 1 + DEPTH * 7;
#ifndef REP_ATTN
#define REP_ATTN 1
#endif
#ifndef KREP_MOE
#define KREP_MOE 1
#endif
#ifndef REP_MOE
#define REP_MOE 1
#endif
#ifndef REP_P0
#define REP_P0 1
#endif
#ifndef REP_THIN
#define REP_THIN 1
#endif
#ifndef REP_DENSE
#define REP_DENSE 1
#endif
#ifndef MK_SPLIT
#define MK_SPLIT 0
#endif
struct Args { const float* in[17]; float* out; unsigned char* ws; int ph_lo, ph_hi, li, pad; };
typedef const __attribute__((address_space(4))) Args* ArgsP;
enum { I_X = 0, I_RELB, I_AWIN, I_ALAM, I_ASUB, I_AWOUT, I_CWIN, I_CW, I_CWOUT, I_RW, I_RB, I_W1, I_B1, I_W2, I_B2, I_LNG, I_LNB };
__global__ void __launch_bounds__(NWAVES * 64, 2) mk_fwd(Args args) {
    extern __shared__ __attribute__((aligned(16))) unsigned char lds[];
    LAS unsigned char* ldsl = (LAS unsigned char*)lds;
    volatile LAS unsigned* MISC = (volatile LAS unsigned*)(ldsl + MISC_OFF);
    const int tid0 = threadIdx.x;
    const int wave0 = __builtin_amdgcn_readfirstlane(tid0 >> 6);
    const int G0 = gridDim.x, bx0 = blockIdx.x;
#define PHASE_BEGIN() int wv_ = wave0; asm volatile("" : "+s"(wv_)); int ln_; asm volatile("v_mbcnt_lo_u32_b32 %0, -1, 0\n\tv_mbcnt_hi_u32_b32 %0, -1, %0" : "=v"(ln_)); int tid = wv_ * 64 + ln_; int G = G0, bx = bx0; asm volatile("" : "+s"(G), "+s"(bx)); const int vcu = (G % 8 == 0) ? (bx % 8) * (G / 8) + bx / 8 : bx; const int NGW = G * NWAVES; \
        const int lane = tid & 63, wave = __builtin_amdgcn_readfirstlane(tid >> 6); const int gw = vcu * NWAVES + wave; (void)lane; (void)gw; (void)NGW; \
        ArgsP ap = (ArgsP)__builtin_amdgcn_kernarg_segment_ptr(); asm volatile("" : "+s"(ap)); unsigned char* ws = ap->ws; gu32* ctl = (gu32*)(ws + WS_CTL); (void)ctl
    for (int u = tid0; u < (LDS_BYTES - LDSCTL_OFF) / 4; u += NWAVES * 64) ((LAS unsigned*)(ldsl + LDSCTL_OFF))[u] = 0u;
    __syncthreads();
    XcdBarrier bar = xcd_barrier_post((unsigned*)(args.ws + WS_CTL) + CW_BAR + (size_t)args.li * 4096, MISC + 8);
    const int lo = args.ph_lo, hi = args.ph_hi;
#define IN(k) (lo <= (k) && (k) < hi)
#define SEAM(k) do { if (IN((k) + 1)) xcd_barrier(bar); } while (0)
    LAS int* tb = (LAS int*)(ldsl + LDSCTL_OFF); LAS int* cn = tb + 64;

    if (IN(0)) { PHASE_BEGIN();
        Ptrs P; P.x = ap->in[I_X]; P.attn_w_in = ap->in[I_AWIN]; P.attn_w_out = ap->in[I_AWOUT]; P.conv_w_in = ap->in[I_CWIN]; P.conv_w_out = ap->in[I_CWOUT]; P.router_w = ap->in[I_RW]; P.ln_g = ap->in[I_LNG]; P.w1 = ap->in[I_W1]; P.w2 = ap->in[I_W2]; P.ws = ws;
        _Pragma("unroll 1") for (int rep = 0; rep < REP_P0; ++rep) p0_prologue(P, ldsl, gw, NGW, wave, lane); SEAM(0); }

#define MOE_GEMMS(L, pb) do { \
            if (IN((pb) + 4)) { PHASE_BEGIN(); \
                pg8::MoeProb<true, true> S{(const char*)(ws + WS_X8), (const char*)(ws + WS_W1) + (size_t)(L) * 32 * 2048 * 1024, (size_t)2048 * 1024, 8, G, vcu, (int)tb[32], tb, cn, (const int*)(ws + WS_LS), lane, tid}; \
                pg8::EpiMoe1 E{ws + WS_A2, ap->in[I_B1] + (size_t)(L) * 32 * 2048, (const float*)(ws + WS_S1) + (size_t)(L) * 32 * 2048, ln_bound(ap->in[I_LNG] + ((L) * 2 + 0) * D, ap->in[I_LNB] + ((L) * 2 + 0) * D, lane) * (1.0f / F8MAX) * (1.0f / KREP_MOE)}; \
                pg8::gemm_phase<pg8::MoeProb<true, true>, pg8::EpiMoe1, true, true, KREP_MOE>(ldsl + RING_OFF, ldsl + XL_OFF, S, E); \
                SEAM((pb) + 4); \
            } \
            if (IN((pb) + 5)) { PHASE_BEGIN(); \
                pg8::MoeProb<false, true> S{(const char*)(ws + WS_A2), (const char*)(ws + WS_W2) + (size_t)(L) * 32 * 1024 * 1024, (size_t)1024 * 1024, 4, G, vcu, (int)tb[32], tb, cn, (const int*)(ws + WS_LS), lane, tid}; \
                pg8::EpiMoe2 E{ws + WS_Y, ap->in[I_B2] + (size_t)(L) * 32 * 1024, (const float*)(ws + WS_S2) + (size_t)(L) * 32 * 1024, (const int*)(ws + WS_LS), (const float*)(ws + WS_LG)}; \
                pg8::gemm_phase<pg8::MoeProb<false, true>, pg8::EpiMoe2, true, true, KREP_MOE>(ldsl + RING_OFF, ldsl + XL_OFF, S, E); \
                SEAM((pb) + 5); \
            } \
        } while (0)
#if REP_MOE == 2
#define MOE_GEMMS_REP(L, pb) MOE_GEMMS(L, pb)
#else
#define MOE_GEMMS_REP(L, pb) do {} while (0)
#endif
#define MOE_HALF(L, pb) do { \
            if (IN((pb) + 3)) { PHASE_BEGIN(); \
                router_phase((const bf16_t*)(ws + WS_YP), ap->in[I_LNG] + ((L) * 2 + 0) * D, ap->in[I_LNB] + ((L) * 2 + 0) * D, (const bf16_t*)(ws + WS_WR) + (size_t)(L) * 32 * 1024, ap->in[I_RW] + (size_t)(L) * 1024 * 32, ap->in[I_RB] + (L) * 32, \
                             ws + WS_X8, (int*)(ws + WS_LS), (float*)(ws + WS_LG), (unsigned*)(ctl + CW_CNT) + (L) * 32 * 64, (char*)lds + RING_OFF, vcu, G, tid, wave, lane); \
                SEAM((pb) + 3); \
            } \
            if (IN((pb) + 4) || IN((pb) + 5)) { PHASE_BEGIN(); \
                if (tid < 64) { const int c_ = (lane < 32) ? (int)__hip_atomic_load(ctl + CW_CNT + ((L) * 32 + (lane & 31)) * 64, RLX_AGENT) : 0; const int t_ = (c_ + 255) >> 8; int p_ = t_; \
                    _Pragma("unroll") for (int o_ = 1; o_ < 32; o_ <<= 1) { const int q_ = __shfl_up(p_, o_); if (lane >= o_) p_ += q_; } \
                    if (lane < 32) { cn[lane] = c_; tb[lane + 1] = p_; } if (lane == 0) tb[0] = 0; } \
                __syncthreads(); \
            } \
            MOE_GEMMS(L, pb); MOE_GEMMS_REP(L, pb); \
            if (REP_THIN == 2 && IN((pb) + 6)) { PHASE_BEGIN(); \
                ln2_phase((const bf16_t*)(ws + WS_YP), ap->in[I_LNG] + ((L) * 2 + 0) * D, ap->in[I_LNB] + ((L) * 2 + 0) * D, (const unsigned char*)(ws + WS_Y), ap->in[I_LNG] + ((L) * 2 + 1) * D, ap->in[I_LNB] + ((L) * 2 + 1) * D, (bf16_t*)(ws + WS_XB), ((L) == DEPTH - 1) ? ap->out : nullptr, ((((L) == 0) && (CM & 1)) || (((L) == 1) && (QM & 2)) || (((L) == 2) && (CM & 2))) ? ws + WS_XI : nullptr, (float*)(ws + WS_RS), gw, NGW, lane); \
            } \
            if (IN((pb) + 6)) { PHASE_BEGIN(); \
                ln2_phase((const bf16_t*)(ws + WS_YP), ap->in[I_LNG] + ((L) * 2 + 0) * D, ap->in[I_LNB] + ((L) * 2 + 0) * D, (const unsigned char*)(ws + WS_Y), ap->in[I_LNG] + ((L) * 2 + 1) * D, ap->in[I_LNB] + ((L) * 2 + 1) * D, (bf16_t*)(ws + WS_XB), ((L) == DEPTH - 1) ? ap->out : nullptr, ((((L) == 0) && (CM & 1)) || (((L) == 1) && (QM & 2)) || (((L) == 2) && (CM & 2))) ? ws + WS_XI : nullptr, (float*)(ws + WS_RS), gw, NGW, lane); \
                if ((pb) + 7 < N_PHASES) SEAM((pb) + 6); \
            } \
        } while (0)

#pragma unroll 1
    for (int lp = 0; lp < DEPTH / 2; ++lp) {
        {
            const int L = 2 * lp, pb = 1 + L * 7;
            if (IN(pb + 0)) {
                PHASE_BEGIN();
                if (QM == 3 || (QM != 0 && ((QM >> lp) & 1))) {
                pg8::DenseProbT<true> S; S.init(ws + WS_XI, ws + WS_WAI + (size_t)lp * 3072 * 1024, M, 3072, G, bx, tid);
                pg8::EpiQKV8 E{(bf16_t*)(ws + WS_Q), (size_t)(WS_K - WS_Q) / 2, QSCALE, (const float*)(ws + WS_SD) + lp * 3072, (const float*)(ws + WS_RS)};
                pg8::gemm_phase<pg8::DenseProbT<true>, pg8::EpiQKV8, true, true, 1, I8P>(ldsl + RING_OFF, ldsl + XL_OFF, S, E);
                } else {
                pg8::DenseProb S; S.init(ws + WS_XB, (const bf16_t*)(ws + WS_WA16) + (size_t)lp * 3072 * 1024, M, 3072, G, bx, tid);
                pg8::EpiQKV E{(bf16_t*)(ws + WS_Q), (size_t)(WS_K - WS_Q) / 2, QSCALE};
                pg8::gemm_phase<pg8::DenseProb, pg8::EpiQKV, true>(ldsl + RING_OFF, ldsl + XL_OFF, S, E);
                }
                SEAM(pb + 0);
            }
            if (IN(pb + 1)) {
                PHASE_BEGIN();
                const float* lf = ap->in[I_ALAM] + lp * 256;
                const float s1 = wave_sum(lf[lane] * lf[64 + lane]), s2 = wave_sum(lf[128 + lane] * lf[192 + lane]);
                const float lam_init = (lp == 0) ? 0.2f : (0.8f - 0.6f * 0.54881163609402643f);
                const float lam = __expf(s1) - __expf(s2) + lam_init;
                const bool o8 = (AOM == 3) || (AOM != 0 && ((AOM >> lp) & 1));
                const float oscl = o8 ? (1.0f - lam_init) * (F8MAX / attn_obound(ap->in[I_ASUB] + lp * 128, 1.0f - lam_init, lane)) : (1.0f - lam_init);
                int hprev = -1;
#pragma unroll 1
                for (int rep = 0; rep < REP_ATTN; ++rep)
#pragma unroll 1
                for (int i = 0; i < (BATCH * NH * 32) / 256; ++i) {
                    const int item = i * G + vcu;
                    if (item >= BATCH * NH * 32) break;
                    const int bh = item >> 5, qb = item & 31;
                    const bool newh = (i == 0) || ((bh & 7) != hprev); hprev = bh & 7;
                    att::attn_unit(bh >> 3, bh & 7, qb, (const bf16_t*)(ws + WS_Q), (const bf16_t*)(ws + WS_K), (const bf16_t*)(ws + WS_V), (bf16_t*)(ws + WS_O), lam, oscl,
                                   ap->in[I_ASUB] + lp * 128, ap->in[I_RELB], (char*)lds + RING_OFF, tid, newh, o8);
                }
                SEAM(pb + 1);
            }
            if (IN(pb + 2)) {
                PHASE_BEGIN();
                if ((AOM == 3) || (AOM != 0 && ((AOM >> lp) & 1))) {
                const float lam_init = (lp == 0) ? 0.2f : (0.8f - 0.6f * 0.54881163609402643f);
                pg8::DenseProbT<true> S; S.init(ws + WS_O, ws + WS_WAO8 + (size_t)lp * 1024 * 1024, M, 1024, G, bx, tid);
                pg8::EpiResid8<false> E{(const bf16_t*)(ws + WS_XB), (bf16_t*)(ws + WS_YP), (const float*)(ws + WS_SD + 24 * 1024) + lp * 1024, nullptr, attn_obound(ap->in[I_ASUB] + lp * 128, 1.0f - lam_init, lane) * (1.0f / F8MAX)};
                pg8::gemm_phase<pg8::DenseProbT<true>, pg8::EpiResid8<false>, true, true>(ldsl + RING_OFF, ldsl + XL_OFF, S, E);
                } else {
                pg8::DenseProb S; S.init(ws + WS_O, (const bf16_t*)(ws + WS_WAO) + (size_t)lp * 1024 * 1024, M, 1024, G, bx, tid);
                pg8::EpiResid E{(const bf16_t*)(ws + WS_XB), (bf16_t*)(ws + WS_YP)};
                pg8::gemm_phase<pg8::DenseProb, pg8::EpiResid, true>(ldsl + RING_OFF, ldsl + XL_OFF, S, E);
                }
                SEAM(pb + 2);
            }
            MOE_HALF(L, pb);
        }
        {
            const int L = 2 * lp + 1, pb = 1 + L * 7;
            if (IN(pb + 0)) {
                PHASE_BEGIN();
                if (CM == 3 || (CM != 0 && ((CM >> lp) & 1))) {
                pg8::DenseProbT<true> S; S.init(ws + WS_XI, ws + WS_WCI + (size_t)lp * 3072 * 1024, M, 3072, G, bx, tid);
                pg8::EpiConvIn8 E{(bf16_t*)(ws + WS_Q), (bf16_t*)(ws + WS_K), (const float*)(ws + WS_SD + 32 * 1024) + lp * 3072, (const float*)(ws + WS_RS)};
                pg8::gemm_phase<pg8::DenseProbT<true>, pg8::EpiConvIn8, true, true, 1, I8P>(ldsl + RING_OFF, ldsl + XL_OFF, S, E);
                } else {
                pg8::DenseProb S; S.init(ws + WS_XB, (const bf16_t*)(ws + WS_WC16) + (size_t)lp * 3072 * 1024, M, 3072, G, bx, tid);
                pg8::EpiConvIn E{(bf16_t*)(ws + WS_Q), (bf16_t*)(ws + WS_K)};
                pg8::gemm_phase<pg8::DenseProb, pg8::EpiConvIn, true>(ldsl + RING_OFF, ldsl + XL_OFF, S, E);
                }
                SEAM(pb + 0);
            }
            if (IN(pb + 1)) { PHASE_BEGIN(); conv_phase((const bf16_t*)(ws + WS_Q), (const bf16_t*)(ws + WS_K), ap->in[I_CW] + lp * 3 * D, (bf16_t*)(ws + WS_O), (float*)(ws + WS_RS), (COM == 3) || (COM != 0 && ((COM >> lp) & 1)), gw, NGW, lane); SEAM(pb + 1); }
            if (IN(pb + 2)) {
                PHASE_BEGIN();
                if ((COM == 3) || (COM != 0 && ((COM >> lp) & 1))) {
                pg8::DenseProbT<true> S; S.init(ws + WS_O, ws + WS_WCO8 + (size_t)lp * 1024 * 1024, M, 1024, G, bx, tid);
                pg8::EpiResid8<true> E{(const bf16_t*)(ws + WS_XB), (bf16_t*)(ws + WS_YP), (const float*)(ws + WS_SD + 56 * 1024) + lp * 1024, (const float*)(ws + WS_RS), 1.0f};
                pg8::gemm_phase<pg8::DenseProbT<true>, pg8::EpiResid8<true>, true, true, 1, I8P>(ldsl + RING_OFF, ldsl + XL_OFF, S, E);
                } else {
                pg8::DenseProb S; S.init(ws + WS_O, (const bf16_t*)(ws + WS_WCO) + (size_t)lp * 1024 * 1024, M, 1024, G, bx, tid);
                pg8::EpiResid E{(const bf16_t*)(ws + WS_XB), (bf16_t*)(ws + WS_YP)};
                pg8::gemm_phase<pg8::DenseProb, pg8::EpiResid, true>(ldsl + RING_OFF, ldsl + XL_OFF, S, E);
                }
                SEAM(pb + 2);
            }
            MOE_HALF(L, pb);
        }
    }
#undef IN
#undef SEAM
}

extern "C" void kernel_launch(void* const* d_in, const int* in_sizes, int n_in, void* d_out, int out_size, void* d_ws, size_t ws_size, hipStream_t stream) {
    static int grid = 0;
    if (grid == 0) {
        if (n_in != 17 || in_sizes[0] != M * D || out_size != M * D || ws_size < WS_END) {
            fprintf(stderr, "kernel_launch: shape mismatch: n_in %d in0 %d out %d ws %zu (need %zu)\n", n_in, n_in > 0 ? in_sizes[0] : -1, out_size, ws_size, (size_t)WS_END); grid = -1; return; }
        int dev = 0, cus = 0, per_cu = 0;
        if (hipGetDevice(&dev) != hipSuccess || hipDeviceGetAttribute(&cus, hipDeviceAttributeMultiprocessorCount, dev) != hipSuccess) { grid = -1; return; }
        if (hipFuncSetAttribute((const void*)mk_fwd, hipFuncAttributeMaxDynamicSharedMemorySize, LDS_BYTES) != hipSuccess) { fprintf(stderr, "kernel_launch: hipFuncSetAttribute failed\n"); grid = -1; return; }
        if (hipOccupancyMaxActiveBlocksPerMultiprocessor(&per_cu, (const void*)mk_fwd, NWAVES * 64, LDS_BYTES) != hipSuccess || per_cu < 1)
            fprintf(stderr, "kernel_launch: occupancy query reports %d workgroups per CU\n", per_cu);
        (void)hipGetLastError();
        grid = cus;
    }
    if (grid < 0) return;
    if (hipMemsetAsync((char*)d_ws + WS_CTL, 0, CTL_ZERO_BYTES, stream) != hipSuccess) { fprintf(stderr, "kernel_launch: memset failed\n"); return; }
    Args a{};
    for (int i = 0; i < 17; ++i) a.in[i] = (const float*)d_in[i];
    a.out = (float*)d_out; a.ws = (unsigned char*)d_ws; a.pad = 0;
#if MK_SPLIT
    for (int p = 0; p < N_PHASES; ++p) { a.ph_lo = p; a.ph_hi = p + 1; a.li = p; hipLaunchKernelGGL(mk_fwd, dim3(grid), dim3(NWAVES * 64), LDS_BYTES, stream, a); }
#else
    a.ph_lo = 0; a.ph_hi = N_PHASES; a.li = 0;
    hipLaunchKernelGGL(mk_fwd, dim3(grid), dim3(NWAVES * 64), LDS_BYTES, stream, a);
#endif
    const hipError_t le = hipPeekAtLastError();
    if (le != hipSuccess) fprintf(stderr, "kernel_launch: launch failed: %s\n", hipGetErrorName(le));
}
```

```cpp
#include <hip/hip_runtime.h>
#include <hip/hip_bf16.h>
#include <cstdio>
#include <cstdint>

constexpr int BATCH = 16, SEQ = 4096, D = 1024, M = BATCH * SEQ, DEPTH = 4, NH = 8, NE = 32, TOPK = 4;
constexpr float LN_EPS = 1e-5f;
constexpr float ALPHA = 1.6817928305074290f;
constexpr float LOG2E = 1.4426950408889634f;
constexpr float QSCALE = 0.125f * LOG2E;
constexpr int LCAP = 65536;
constexpr int MAXRT = 1056;

constexpr size_t MiB = 1ull << 20;
constexpr size_t WS_CTL = 0, CTL_ZERO_BYTES = 1 * MiB;
constexpr size_t WS_WAI = 1 * MiB;
constexpr size_t WS_WAO = WS_WAI + 12 * MiB;
constexpr size_t WS_WCI = WS_WAO + 4 * MiB;
constexpr size_t WS_WCO = WS_WCI + 12 * MiB;
constexpr size_t WS_WR  = WS_WCO + 4 * MiB;
constexpr size_t WS_W1  = WS_WR + 1 * MiB;
constexpr size_t WS_W2  = WS_W1 + 256 * MiB;
constexpr size_t WS_S1  = WS_W2 + 128 * MiB;
constexpr size_t WS_S2  = WS_S1 + 1 * MiB;
constexpr size_t WS_SD  = WS_S2 + 512 * 1024;
constexpr size_t WS_RS  = WS_SD + 64 * 1024;
constexpr size_t WS_XB  = WS_S2 + 1 * MiB;
constexpr size_t WS_XI  = WS_XB + 128 * MiB;
constexpr size_t WS_X8  = WS_XI + 128 * MiB;
constexpr size_t WS_YP  = WS_X8 + 64 * MiB;
constexpr size_t WS_Q   = WS_YP + 128 * MiB;
constexpr size_t WS_K   = WS_Q + 128 * MiB;
constexpr size_t WS_V   = WS_K + 128 * MiB;
constexpr size_t WS_O   = WS_V + 128 * MiB;
constexpr size_t WS_LS  = WS_O + 128 * MiB;
constexpr size_t WS_LG  = WS_LS + 8 * MiB;
constexpr size_t WS_A2  = WS_LG + 8 * MiB;
constexpr size_t WS_Y   = WS_A2 + 264 * MiB;
constexpr size_t WS_WA16 = WS_Y + 513 * MiB;
constexpr size_t WS_WC16 = WS_WA16 + 12 * MiB;
constexpr size_t WS_WAO8 = WS_WC16 + 12 * MiB;
constexpr size_t WS_WCO8 = WS_WAO8 + 2 * MiB;
constexpr size_t WS_END = WS_WCO8 + 2 * MiB;
#ifndef F8_QKV_MASK
#define F8_QKV_MASK 3
#endif
#ifndef F8_CONV_MASK
#define F8_CONV_MASK 3
#endif
#ifndef F8_AOUT_MASK
#define F8_AOUT_MASK 3
#endif
#ifndef F8_COUT_MASK
#define F8_COUT_MASK 3
#endif
constexpr int QM = F8_QKV_MASK, CM = F8_CONV_MASK, AOM = F8_AOUT_MASK, COM = F8_COUT_MASK;
constexpr int NA8 = (AOM & 1) + (AOM >> 1), NO8 = (COM & 1) + (COM >> 1), AJ0 = (AOM & 1) ? 0 : 1, OJ0 = (COM & 1) ? 0 : 1;
constexpr int NA16 = 2 - NA8, NO16 = 2 - NO8, AK0 = (AOM & 1) ? 1 : 0, OK0 = (COM & 1) ? 1 : 0;
constexpr int NQ8 = (QM & 1) + (QM >> 1), NC8 = (CM & 1) + (CM >> 1), QJ0 = (QM & 1) ? 0 : 1, CJ0 = (CM & 1) ? 0 : 1;
constexpr int NQ16 = 2 - NQ8, NC16 = 2 - NC8, QK0 = (QM & 1) ? 1 : 0, CK0 = (CM & 1) ? 1 : 0;
constexpr float F8MAX = 448.0f * 0.999f;
constexpr bool I8P = true;
constexpr float QMAXP = I8P ? 127.0f : 448.0f * 0.999f;
constexpr float YSCALE = 16.0f;
constexpr float A2SCALE = 8.0f;
constexpr int CW_TMO = 0, CW_CODE = 1;
constexpr int CW_BAR = 4096;
constexpr int CW_CNT = 16384;

constexpr int RING_OFF = 0, RING_BYTES = 131072;
constexpr int LDSCTL_OFF = RING_BYTES, MISC_OFF = LDSCTL_OFF + 1024;
constexpr int XL_OFF = LDSCTL_OFF + 4096;
constexpr int LDS_BYTES = 147456;

#define GAS __attribute__((address_space(1)))
#define LAS __attribute__((address_space(3)))
typedef unsigned short bf16_t;
typedef unsigned v4u __attribute__((ext_vector_type(4)));
typedef float f32x4 __attribute__((ext_vector_type(4)));
typedef float f32x2 __attribute__((ext_vector_type(2)));
typedef short bf16x8 __attribute__((ext_vector_type(8)));
typedef float f32x16 __attribute__((ext_vector_type(16)));
typedef short s16x4 __attribute__((ext_vector_type(4)));
typedef GAS unsigned gu32;
#define RLX_AGENT __ATOMIC_RELAXED, __HIP_MEMORY_SCOPE_AGENT
#define LDS_WAIT() asm volatile("s_waitcnt lgkmcnt(0)" ::: "memory")
#define VM_WAIT() asm volatile("s_waitcnt vmcnt(0)" ::: "memory")

__device__ __forceinline__ unsigned cvt_pk_bf16(float lo, float hi) { unsigned r; asm volatile("v_cvt_pk_bf16_f32 %0, %1, %2" : "=v"(r) : "v"(lo), "v"(hi)); return r; }
__device__ __forceinline__ float bf_lo(unsigned u) { return __uint_as_float(u << 16); }
__device__ __forceinline__ float bf_hi(unsigned u) { return __uint_as_float(u & 0xffff0000u); }
__device__ __forceinline__ int lane_local() { int l; asm volatile("v_mbcnt_lo_u32_b32 %0, -1, 0\n\tv_mbcnt_hi_u32_b32 %0, -1, %0" : "=v"(l)); return l; }
__device__ __forceinline__ float shx(float v, int m, int l) { return __int_as_float(__builtin_amdgcn_ds_bpermute((l ^ m) << 2, __float_as_int(v))); }
__device__ __forceinline__ float shx(float v, int m) { return shx(v, m, lane_local()); }
__device__ __forceinline__ float wave_sum(float v) {
    const int l_ = lane_local();
#pragma unroll
    for (int o = 1; o < 64; o <<= 1) v += shx(v, o, l_);
    return v;
}

#ifndef KREP_MOE
#define KREP_MOE 1
#endif
namespace pg8 {
constexpr float KREP_MOE_ = (float)KREP_MOE;
#define PG8_LAS __attribute__((address_space(3)))
constexpr int BM = 256, BK = 64, HALF = 128, HTB = HALF * BK * 2, STAGE_BYTES = 8 * HTB, NXCD = 8, WGM = 8, KD = 1024, NTK = KD / BK;

__host__ __device__ __forceinline__ int lds_byte(int r, int c) { const int st = (r >> 4) * 2 + (c >> 5), rr = r & 15, cc = c & 31, ob = rr * 64 + cc * 2; return st * 1024 + (ob ^ (((ob >> 9) & 1) << 5)); }
__host__ __device__ __forceinline__ void stage_rc(int b, int& R, int& C) { const int st = b / 1024, sb = b % 1024, swz = sb ^ (((sb >> 9) & 1) << 5); R = (st >> 1) * 16 + swz / 64; C = (st & 1) * 32 + (swz % 64) / 2; }
__host__ __device__ __forceinline__ int perm32(int rho) { const int n = rho >> 4, i = rho & 15; return 8 * (i >> 2) + 4 * n + (i & 3); }

struct Unit { int pm, pn, e, valid, lr0; };
__device__ __forceinline__ void dma1k(const void* src, PG8_LAS unsigned char* dst, int lane) {
    __builtin_amdgcn_global_load_lds((const __attribute__((address_space(1))) unsigned*)((const char*)src + lane * 16), (PG8_LAS unsigned*)dst, 16, 0, 0);
}
constexpr int XL_EPI = 4096, XL_GATHER = 1024, XL_BYTES = 2 * (XL_EPI + XL_GATHER);

template <bool F8> struct DenseProbT {
    static constexpr bool GATHER = false;
    static constexpr int RP = F8 ? 1024 : 2048;
    const char* A; const char* Bt; int nM, nN, nwg, G, c, tid;
    __device__ void init(const void* A_, const void* Bt_, int Mrows, int N, int G_, int c_, int tid_) { A = (const char*)A_; Bt = (const char*)Bt_; nM = Mrows / BM; nN = N / BM; nwg = nM * nN; G = G_; c = c_; tid = tid_; }
    __device__ __forceinline__ bool next(int i, Unit& u) const {
        const long L = (long)i * G + c; if (L >= nwg) return false;
        int wgid = (int)L; { const int q = nwg / NXCD, r = nwg % NXCD, xcd = wgid % NXCD, off = wgid / NXCD; wgid = (xcd < r ? xcd * (q + 1) : r * (q + 1) + (xcd - r) * q) + off; }
        const int nig = WGM * nN, gid = wgid / nig, fm = gid * WGM, gsz = (nM - fm) < WGM ? (nM - fm) : WGM;
        u.pm = fm + ((wgid % nig) % gsz); u.pn = (wgid % nig) / gsz; u.e = 0; u.valid = 256; u.lr0 = 0; return true;
    }
    __device__ __forceinline__ void a_off(const Unit& u, const int (&RA)[2], const int (&CA)[2], unsigned (&vo)[2][2]) const {
#pragma unroll
        for (int h = 0; h < 2; ++h)
#pragma unroll
            for (int i = 0; i < 2; ++i) vo[h][i] = (unsigned)((u.pm * BM + h * HALF + RA[i]) * RP + CA[i] * 2);
    }
    __device__ __forceinline__ unsigned a_tile(const Unit& u) const { return (unsigned)u.pm * (unsigned)(BM * RP); }
    __device__ __forceinline__ unsigned b_off(const Unit& u) const { return (unsigned)u.pn * (unsigned)(BM * RP); }    __device__ __forceinline__ void dma_rows(const Unit&, PG8_LAS unsigned char*, int, int) const {}
    __device__ __forceinline__ void a_off_lds(const Unit&, const int (&)[2], const int (&)[2], const PG8_LAS unsigned char*, unsigned (&)[2][2]) const {}
};
typedef DenseProbT<false> DenseProb;

template <bool GATHER_, bool F8> struct MoeProb {
    static constexpr bool GATHER = GATHER_;
    static constexpr int RP = F8 ? 1024 : 2048;
    const char* A; const char* Bt; size_t b_estride; int nN, G, v, RT; const PG8_LAS int* tb; const PG8_LAS int* cn; const int* lslot; int lane, tid;
    __device__ __forceinline__ bool next(int i, Unit& u) const {
        const int L = i * G + v; if (L >= RT * nN) return false;
        const int rt = L / nN; u.pm = rt; u.pn = L - rt * nN;
        const unsigned long long bal = __ballot(lane < 32 && rt >= tb[(lane & 31) + 1]);
        const int e = __builtin_amdgcn_readfirstlane(__popcll(bal)); u.e = e;
        const int tb_e = __builtin_amdgcn_readfirstlane(tb[e]), cn_e = __builtin_amdgcn_readfirstlane(cn[e]);
        u.lr0 = 256 * (rt - tb_e); const int rem = cn_e - u.lr0; u.valid = rem < 256 ? rem : 256; return true;
    }
    __device__ __forceinline__ void a_off(const Unit& u, const int (&RA)[2], const int (&CA)[2], unsigned (&vo)[2][2]) const {
        if constexpr (GATHER) {
            const int* ls = lslot + (size_t)u.e * LCAP + u.lr0;
#pragma unroll
            for (int h = 0; h < 2; ++h)
#pragma unroll
                for (int i = 0; i < 2; ++i) { const int rl = h * HALF + RA[i]; const int slot = ls[rl < u.valid ? rl : 0]; vo[h][i] = (unsigned)((slot >> 2) * RP + CA[i] * 2); }
        } else {
#pragma unroll
            for (int h = 0; h < 2; ++h)
#pragma unroll
                for (int i = 0; i < 2; ++i) vo[h][i] = (unsigned)((u.pm * BM + h * HALF + RA[i]) * RP + CA[i] * 2);
        }
    }
    __device__ __forceinline__ unsigned a_tile(const Unit& u) const { return (unsigned)u.pm * (unsigned)(BM * RP); }
    __device__ __forceinline__ unsigned b_off(const Unit& u) const { return (unsigned)u.e * (unsigned)b_estride + (unsigned)u.pn * (unsigned)(BM * RP); }
    __device__ __forceinline__ void dma_rows(const Unit& u, PG8_LAS unsigned char* dst, int wid, int lane_) const { if constexpr (GATHER) { if (wid == 0) dma1k(lslot + (size_t)u.e * LCAP + u.lr0, dst, lane_); } }
    __device__ __forceinline__ void a_off_lds(const Unit& u, const int (&RA)[2], const int (&CA)[2], const PG8_LAS unsigned char* src, unsigned (&vo)[2][2]) const {
        if constexpr (GATHER) { const PG8_LAS int* ls = (const PG8_LAS int*)src;
#pragma unroll
            for (int h = 0; h < 2; ++h)
#pragma unroll
                for (int i = 0; i < 2; ++i) { const int rl = h * HALF + RA[i]; const int slot = ls[rl < u.valid ? rl : 0]; vo[h][i] = (unsigned)((slot >> 2) * RP + CA[i] * 2); } }
    }
};

__device__ __forceinline__ v4u pack8(const f32x4 v0, const f32x4 v1) { v4u w; w.x = cvt_pk_bf16(v0[0], v0[1]); w.y = cvt_pk_bf16(v0[2], v0[3]); w.z = cvt_pk_bf16(v1[0], v1[1]); w.w = cvt_pk_bf16(v1[2], v1[3]); return w; }

__device__ __forceinline__ void st16(void* base, unsigned off, v4u v) { *(v4u*)((char*)base + off) = v; }
struct EpiQKV {
    __device__ __forceinline__ void dma(const Unit&, PG8_LAS unsigned char*, int, int) const {}
    bf16_t* O; size_t stride; float scale0;
    __device__ __forceinline__ void operator()(const f32x4 (&acc)[2][2][4][2], const Unit& u, int wr, int wc, int fr_, int fq_, const PG8_LAS unsigned char* xl) const {
        int fr = fr_, fq = fq_; asm volatile("" : "+v"(fr), "+v"(fq));
        const int row0 = u.pm * BM + wr * 64 + fr; const int t = u.pn >> 2; const int colt = (u.pn & 3) * BM;
        bf16_t* base = O + (size_t)t * stride; const float sc = (t == 0) ? scale0 : 1.f; const unsigned off0 = (unsigned)(row0 * D + colt + wc * 32 + 8 * fq) * 2u;
#pragma unroll
        for (int ai = 0; ai < 2; ++ai)
#pragma unroll
            for (int m = 0; m < 4; ++m)
#pragma unroll
                for (int bj = 0; bj < 2; ++bj) st16(base, off0 + (unsigned)((ai * HALF + m * 16) * D + bj * HALF) * 2u, pack8(acc[ai][bj][m][0] * sc, acc[ai][bj][m][1] * sc));
    }
};
struct EpiConvIn {
    __device__ __forceinline__ void dma(const Unit&, PG8_LAS unsigned char*, int, int) const {}
    bf16_t* GB; bf16_t* Z;
    __device__ __forceinline__ void operator()(const f32x4 (&acc)[2][2][4][2], const Unit& u, int wr, int wc, int fr_, int fq_, const PG8_LAS unsigned char* xl) const {
        int fr = fr_, fq = fq_; asm volatile("" : "+v"(fr), "+v"(fq));
        const int row0 = u.pm * BM + wr * 64 + fr;
        if (u.pn < 4) { const unsigned off0 = (unsigned)(row0 * D + u.pn * BM + wc * 32 + 8 * fq) * 2u;
#pragma unroll
            for (int ai = 0; ai < 2; ++ai)
#pragma unroll
                for (int m = 0; m < 4; ++m)
#pragma unroll
                    for (int bj = 0; bj < 2; ++bj) st16(GB, off0 + (unsigned)((ai * HALF + m * 16) * D + bj * HALF) * 2u, pack8(acc[ai][bj][m][0], acc[ai][bj][m][1]));
        } else { const unsigned off0 = (unsigned)(row0 * D + (u.pn - 4) * HALF + wc * 32 + 8 * fq) * 2u;
#pragma unroll
            for (int ai = 0; ai < 2; ++ai)
#pragma unroll
                for (int m = 0; m < 4; ++m) st16(Z, off0 + (unsigned)((ai * HALF + m * 16) * D) * 2u, pack8(acc[ai][0][m][0] * acc[ai][1][m][0], acc[ai][0][m][1] * acc[ai][1][m][1]));
        }
    }
};
struct EpiQKV8 {
    bf16_t* O; size_t stride; float scale0; const float* sw; const float* rs;
    __device__ __forceinline__ void dma(const Unit& u, PG8_LAS unsigned char* xl, int wid, int lane) const {
        if (wid == 0) dma1k(sw + u.pn * BM, xl, lane); else if (wid == 1) dma1k(rs + u.pm * BM, xl + 1024, lane);
    }
    __device__ __forceinline__ void operator()(const f32x4 (&acc)[2][2][4][2], const Unit& u, int wr, int wc, int fr_, int fq_, const PG8_LAS unsigned char* xl) const {
        int fr = fr_, fq = fq_; asm volatile("" : "+v"(fr), "+v"(fq));
        const int row0 = u.pm * BM + wr * 64 + fr; const int t = u.pn >> 2; const int colt = (u.pn & 3) * BM; const int cl = wc * 32 + 8 * fq;
        bf16_t* base = O + (size_t)t * stride; const float sc = (t == 0) ? scale0 : 1.f; const unsigned off0 = (unsigned)(row0 * D + colt + cl) * 2u;
        const PG8_LAS float* sp = (const PG8_LAS float*)xl + cl; const PG8_LAS float* rp = (const PG8_LAS float*)(xl + 1024) + wr * 64 + fr;
        f32x4 sv[2][2];
#pragma unroll
        for (int bj = 0; bj < 2; ++bj)
#pragma unroll
            for (int n = 0; n < 2; ++n) sv[bj][n] = *(const PG8_LAS f32x4*)(sp + bj * HALF + 4 * n) * sc;
#pragma unroll
        for (int ai = 0; ai < 2; ++ai)
#pragma unroll
            for (int m = 0; m < 4; ++m) { const float r = rp[ai * HALF + m * 16];
#pragma unroll
                for (int bj = 0; bj < 2; ++bj) st16(base, off0 + (unsigned)((ai * HALF + m * 16) * D + bj * HALF) * 2u, pack8(acc[ai][bj][m][0] * (sv[bj][0] * r), acc[ai][bj][m][1] * (sv[bj][1] * r))); }
    }
};
struct EpiConvIn8 {
    bf16_t* GB; bf16_t* Z; const float* sw; const float* rs;
    __device__ __forceinline__ void dma(const Unit& u, PG8_LAS unsigned char* xl, int wid, int lane) const { if (wid == 0) dma1k(sw + u.pn * BM, xl, lane); else if (wid == 1) dma1k(rs + u.pm * BM, xl + 1024, lane); }
    __device__ __forceinline__ void operator()(const f32x4 (&acc)[2][2][4][2], const Unit& u, int wr, int wc, int fr_, int fq_, const PG8_LAS unsigned char* xl) const {
        int fr = fr_, fq = fq_; asm volatile("" : "+v"(fr), "+v"(fq));
        const int row0 = u.pm * BM + wr * 64 + fr; const int cl = wc * 32 + 8 * fq;
        const PG8_LAS float* sp = (const PG8_LAS float*)xl + cl; const PG8_LAS float* rp = (const PG8_LAS float*)(xl + 1024) + wr * 64 + fr;
        f32x4 sv[2][2];
#pragma unroll
        for (int bj = 0; bj < 2; ++bj)
#pragma unroll
            for (int n = 0; n < 2; ++n) sv[bj][n] = *(const PG8_LAS f32x4*)(sp + bj * HALF + 4 * n);
        if (u.pn < 4) { const unsigned off0 = (unsigned)(row0 * D + u.pn * BM + cl) * 2u;
#pragma unroll
            for (int ai = 0; ai < 2; ++ai)
#pragma unroll
                for (int m = 0; m < 4; ++m) { const float r = rp[ai * HALF + m * 16];
#pragma unroll
                    for (int bj = 0; bj < 2; ++bj) st16(GB, off0 + (unsigned)((ai * HALF + m * 16) * D + bj * HALF) * 2u, pack8(acc[ai][bj][m][0] * (sv[bj][0] * r), acc[ai][bj][m][1] * (sv[bj][1] * r))); }
        } else { const unsigned off0 = (unsigned)(row0 * D + (u.pn - 4) * HALF + cl) * 2u;
            const f32x4 sz0 = sv[0][0] * sv[1][0], sz1 = sv[0][1] * sv[1][1];
#pragma unroll
            for (int ai = 0; ai < 2; ++ai)
#pragma unroll
                for (int m = 0; m < 4; ++m) { const float r = rp[ai * HALF + m * 16], r2 = r * r;
                    st16(Z, off0 + (unsigned)((ai * HALF + m * 16) * D) * 2u, pack8(acc[ai][0][m][0] * acc[ai][1][m][0] * (sz0 * r2), acc[ai][0][m][1] * acc[ai][1][m][1] * (sz1 * r2))); }
        }
    }
};
struct EpiResid {
    __device__ __forceinline__ void dma(const Unit&, PG8_LAS unsigned char*, int, int) const {}
    const bf16_t* X; bf16_t* Yp;
    __device__ __forceinline__ void operator()(const f32x4 (&acc)[2][2][4][2], const Unit& u, int wr, int wc, int fr_, int fq_, const PG8_LAS unsigned char* xl) const {
        int fr = fr_, fq = fq_; asm volatile("" : "+v"(fr), "+v"(fq));
        const unsigned off0 = (unsigned)((u.pm * BM + wr * 64 + fr) * D + u.pn * BM + wc * 32 + 8 * fq) * 2u;
#pragma unroll
        for (int ai = 0; ai < 2; ++ai)
#pragma unroll
            for (int m = 0; m < 4; ++m)
#pragma unroll
                for (int bj = 0; bj < 2; ++bj) { const unsigned off = off0 + (unsigned)((ai * HALF + m * 16) * D + bj * HALF) * 2u; const v4u xr = *(const v4u*)((const char*)X + off);
                    f32x4 v0 = acc[ai][bj][m][0], v1 = acc[ai][bj][m][1];
                    v0[0] += ALPHA * bf_lo(xr.x); v0[1] += ALPHA * bf_hi(xr.x); v0[2] += ALPHA * bf_lo(xr.y); v0[3] += ALPHA * bf_hi(xr.y);
                    v1[0] += ALPHA * bf_lo(xr.z); v1[1] += ALPHA * bf_hi(xr.z); v1[2] += ALPHA * bf_lo(xr.w); v1[3] += ALPHA * bf_hi(xr.w);
                    st16(Yp, off, pack8(v0, v1)); }
    }
};
template <bool ROWS> struct EpiResid8 {
    const bf16_t* X; bf16_t* Yp; const float* sw; const float* rs; float rsc;
    __device__ __forceinline__ void dma(const Unit& u, PG8_LAS unsigned char* xl, int wid, int lane) const {
        if (wid == 0) dma1k(sw + u.pn * BM, xl, lane); else if (ROWS && wid == 1) dma1k(rs + u.pm * BM, xl + 1024, lane);
    }
    __device__ __forceinline__ void operator()(const f32x4 (&acc)[2][2][4][2], const Unit& u, int wr, int wc, int fr_, int fq_, const PG8_LAS unsigned char* xl) const {
        int fr = fr_, fq = fq_; asm volatile("" : "+v"(fr), "+v"(fq));
        const int cl = wc * 32 + 8 * fq;
        const unsigned off0 = (unsigned)((u.pm * BM + wr * 64 + fr) * D + u.pn * BM + cl) * 2u;
        const PG8_LAS float* sp = (const PG8_LAS float*)xl + cl; const PG8_LAS float* rp = (const PG8_LAS float*)(xl + 1024) + wr * 64 + fr;
        f32x4 sv[2][2];
#pragma unroll
        for (int bj = 0; bj < 2; ++bj)
#pragma unroll
            for (int n = 0; n < 2; ++n) sv[bj][n] = *(const PG8_LAS f32x4*)(sp + bj * HALF + 4 * n) * (ROWS ? 1.0f : rsc);
#pragma unroll
        for (int ai = 0; ai < 2; ++ai)
#pragma unroll
            for (int m = 0; m < 4; ++m) { float r = 1.0f; if (ROWS) r = rp[ai * HALF + m * 16];
#pragma unroll
                for (int bj = 0; bj < 2; ++bj) { const unsigned off = off0 + (unsigned)((ai * HALF + m * 16) * D + bj * HALF) * 2u; const v4u xr = *(const v4u*)((const char*)X + off);
                    f32x4 v0 = acc[ai][bj][m][0] * sv[bj][0], v1 = acc[ai][bj][m][1] * sv[bj][1]; if (ROWS) { v0 *= r; v1 *= r; }
                    v0[0] += ALPHA * bf_lo(xr.x); v0[1] += ALPHA * bf_hi(xr.x); v0[2] += ALPHA * bf_lo(xr.y); v0[3] += ALPHA * bf_hi(xr.y);
                    v1[0] += ALPHA * bf_lo(xr.z); v1[1] += ALPHA * bf_hi(xr.z); v1[2] += ALPHA * bf_lo(xr.w); v1[3] += ALPHA * bf_hi(xr.w);
                    st16(Yp, off, pack8(v0, v1)); } }
    }
};
__device__ __forceinline__ unsigned pk4_fp8(float a, float b, float c, float d) { int p = 0; p = __builtin_amdgcn_cvt_pk_fp8_f32(a, b, p, false); p = __builtin_amdgcn_cvt_pk_fp8_f32(c, d, p, true); return (unsigned)p; }
__device__ __forceinline__ unsigned pk4_i8(float a, float b, float c, float d) {
    unsigned r = 0;
    r = __builtin_amdgcn_cvt_pk_u8_f32(__builtin_rintf(a + 128.f), 0, r); r = __builtin_amdgcn_cvt_pk_u8_f32(__builtin_rintf(b + 128.f), 1, r);
    r = __builtin_amdgcn_cvt_pk_u8_f32(__builtin_rintf(c + 128.f), 2, r); r = __builtin_amdgcn_cvt_pk_u8_f32(__builtin_rintf(d + 128.f), 3, r);
    return r ^ 0x80808080u;
}
template <bool I8> __device__ __forceinline__ unsigned pkq4(float a, float b, float c, float d) { if constexpr (I8) return pk4_i8(a, b, c, d); else return pk4_fp8(a, b, c, d); }
__device__ __forceinline__ f32x2 swiglu8_pk(f32x2 g, f32x2 l8) {
    g.x = fminf(g.x, 7.0f); g.y = fminf(g.y, 7.0f);
    l8.x = fminf(fmaxf(l8.x, -56.0f), 56.0f); l8.y = fminf(fmaxf(l8.y, -56.0f), 56.0f);
    const f32x2 t = g * (-1.702f * LOG2E);
    f32x2 e; e.x = __builtin_amdgcn_exp2f(t.x); e.y = __builtin_amdgcn_exp2f(t.y);
    const f32x2 d = e + 1.0f;
    f32x2 r; r.x = __builtin_amdgcn_rcpf(d.x); r.y = __builtin_amdgcn_rcpf(d.y);
    return (g * r) * (l8 + A2SCALE);
}
struct EpiMoe1 {
    unsigned char* A2; const float* b1; const float* sw; float inv_sa;
    __device__ __forceinline__ void dma(const Unit& u, PG8_LAS unsigned char* xl, int wid, int lane) const {
        if (wid == 0) dma1k(b1 + (size_t)u.e * 2048 + u.pn * BM, xl, lane); else if (wid == 1) dma1k(sw + (size_t)u.e * 2048 + u.pn * BM, xl + 1024, lane);
    }
    __device__ __forceinline__ void operator()(const f32x4 (&acc)[2][2][4][2], const Unit& u, int wr, int wc, int fr_, int fq_, const PG8_LAS unsigned char* xl) const {
        int fr = fr_, fq = fq_; asm volatile("" : "+v"(fr), "+v"(fq));
        const int cl = wc * 32 + 8 * fq; const unsigned off0 = (unsigned)((u.pm * BM + wr * 64 + fr) * D + u.pn * HALF + cl);
        const PG8_LAS float* bp = (const PG8_LAS float*)xl + 2 * cl; f32x4 bb[4];
#pragma unroll
        for (int j = 0; j < 4; ++j) bb[j] = *(const PG8_LAS f32x4*)(bp + 4 * j);
        const PG8_LAS float* sp = (const PG8_LAS float*)(xl + 1024) + cl;
        const f32x4 sg0 = *(const PG8_LAS f32x4*)(sp) * inv_sa, sg1 = *(const PG8_LAS f32x4*)(sp + 4) * inv_sa;
        const f32x4 sl0 = *(const PG8_LAS f32x4*)(sp + HALF) * (inv_sa * A2SCALE), sl1 = *(const PG8_LAS f32x4*)(sp + HALF + 4) * (inv_sa * A2SCALE);
        f32x2 sgp[4] = {{sg0[0], sg0[1]}, {sg0[2], sg0[3]}, {sg1[0], sg1[1]}, {sg1[2], sg1[3]}}, slp[4] = {{sl0[0], sl0[1]}, {sl0[2], sl0[3]}, {sl1[0], sl1[1]}, {sl1[2], sl1[3]}};
        f32x2 bgp[4], blp[4];
#pragma unroll
        for (int q = 0; q < 4; ++q) { bgp[q] = (f32x2){bb[q][0], bb[q][2]}; blp[q] = (f32x2){bb[q][1] * A2SCALE, bb[q][3] * A2SCALE}; }
        const unsigned offp = off0 + ((fq & 1) ? (unsigned)(16 * D - 8) : 0u);
#pragma unroll
        for (int ai = 0; ai < 2; ++ai)
#pragma unroll
            for (int mp = 0; mp < 2; ++mp) { typedef unsigned u32x2 __attribute__((ext_vector_type(2))); u32x2 w[2];
#pragma unroll
                for (int mm = 0; mm < 2; ++mm) { const int m = 2 * mp + mm; f32x2 o[4];
#pragma unroll
                    for (int q = 0; q < 4; ++q) { const f32x4 ga = acc[ai][0][m][q >> 1], la = acc[ai][1][m][q >> 1]; const int h2 = (q & 1) * 2;
                        const f32x2 g = (f32x2){ga[h2], ga[h2 + 1]} * sgp[q] + bgp[q], l8 = (f32x2){la[h2], la[h2 + 1]} * slp[q] + blp[q];
                        o[q] = swiglu8_pk(g, l8); }
                    w[mm].x = pk4_fp8(o[0].x, o[0].y, o[1].x, o[1].y); w[mm].y = pk4_fp8(o[2].x, o[2].y, o[3].x, o[3].y); }
                const auto sx = __builtin_amdgcn_permlane16_swap(w[0].x, w[1].x, false, false); const auto sy = __builtin_amdgcn_permlane16_swap(w[0].y, w[1].y, false, false);
                const v4u ov = {sx[0], sy[0], sx[1], sy[1]};
                *(v4u*)(A2 + (offp + (unsigned)((ai * HALF + mp * 32) * D))) = ov; }
    }
};
struct EpiMoe2 {
    unsigned char* Y; const float* b2; const float* sw; const int* lslot; const float* lgate;
    __device__ __forceinline__ void dma(const Unit& u, PG8_LAS unsigned char* xl, int wid, int lane) const {
        const size_t lb = (size_t)u.e * LCAP + u.lr0;
        if (wid == 0) dma1k(b2 + (size_t)u.e * 1024 + u.pn * BM, xl, lane); else if (wid == 1) dma1k(sw + (size_t)u.e * 1024 + u.pn * BM, xl + 1024, lane);
        else if (wid == 2) dma1k(lslot + lb, xl + 2048, lane); else if (wid == 3) dma1k(lgate + lb, xl + 3072, lane);
    }
    __device__ __forceinline__ void operator()(const f32x4 (&acc)[2][2][4][2], const Unit& u, int wr, int wc, int fr_, int fq_, const PG8_LAS unsigned char* xl) const {
        int fr = fr_, fq = fq_; asm volatile("" : "+v"(fr), "+v"(fq));
        const int rl0 = wr * 64 + fr, cl = wc * 32 + 8 * fq, col0 = u.pn * BM + cl;
        const PG8_LAS float* bp = (const PG8_LAS float*)xl + cl; const PG8_LAS float* sp = (const PG8_LAS float*)(xl + 1024) + cl; f32x4 bv[2][2], sv[2][2];
#pragma unroll
        for (int bj = 0; bj < 2; ++bj)
#pragma unroll
            for (int n = 0; n < 2; ++n) { bv[bj][n] = *(const PG8_LAS f32x4*)(bp + bj * HALF + 4 * n); sv[bj][n] = *(const PG8_LAS f32x4*)(sp + bj * HALF + 4 * n) * (1.0f / (A2SCALE * KREP_MOE_)); }
        const PG8_LAS int* sl = (const PG8_LAS int*)(xl + 2048); const PG8_LAS float* gl = (const PG8_LAS float*)(xl + 3072);
        const unsigned cadj = (unsigned)(u.pn * BM + ((fq & 1) ? (HALF + cl - 8) : cl));
#pragma unroll
        for (int ai = 0; ai < 2; ++ai)
#pragma unroll
            for (int m = 0; m < 4; ++m) { const int rl = rl0 + ai * HALF + m * 16;
                const bool ok = rl < u.valid; const int slot = ok ? sl[rl] : M * 4; const float g = gl[rl] * YSCALE;
                typedef unsigned u32x2 __attribute__((ext_vector_type(2))); u32x2 w[2];
#pragma unroll
                for (int bj = 0; bj < 2; ++bj) { f32x4 v0 = (acc[ai][bj][m][0] * sv[bj][0] + bv[bj][0]) * g, v1 = (acc[ai][bj][m][1] * sv[bj][1] + bv[bj][1]) * g;
#pragma unroll
                    for (int i = 0; i < 4; ++i) { v0[i] = fminf(fmaxf(v0[i], -448.0f), 448.0f); v1[i] = fminf(fmaxf(v1[i], -448.0f), 448.0f); }
                    w[bj].x = pk4_fp8(v0[0], v0[1], v0[2], v0[3]); w[bj].y = pk4_fp8(v1[0], v1[1], v1[2], v1[3]); }
                const auto sx = __builtin_amdgcn_permlane16_swap(w[0].x, w[1].x, false, false); const auto sy = __builtin_amdgcn_permlane16_swap(w[0].y, w[1].y, false, false);
                const v4u o = {sx[0], sy[0], sx[1], sy[1]};
                *(v4u*)(Y + ((unsigned)(slot * D) + cadj)) = o; }
    }
};

typedef int v8i_t __attribute__((ext_vector_type(8))); typedef int v4i_t __attribute__((ext_vector_type(4)));
__device__ __forceinline__ v8i_t cat8(bf16x8 lo, bf16x8 hi) { const v4i_t a = __builtin_bit_cast(v4i_t, lo), b = __builtin_bit_cast(v4i_t, hi); return __builtin_shufflevector(a, b, 0, 1, 2, 3, 4, 5, 6, 7); }
template <class Prob, class Epi, bool ALIGN_EPI, bool F8 = false, int KREP = 1, bool I8 = false>
__device__ __forceinline__ void gemm_phase(PG8_LAS unsigned char* lds, PG8_LAS unsigned char* xl, const Prob& P, const Epi& E) {
    int tid_ = P.tid; asm volatile("" : "+v"(tid_));
    const int tid = tid_, wid = __builtin_amdgcn_readfirstlane(tid >> 6), lane = tid & 63, wr = wid >> 2, wc = wid & 3, fr = lane & 15, fq = lane >> 4;
    constexpr int RP = F8 ? 1024 : 2048, nt = F8 ? 8 : NTK;
    constexpr bool GA = Prob::GATHER;
    int RA[2], CA[2]; unsigned voffB[2], voffA[2];
#pragma unroll
    for (int i = 0; i < 2; ++i) { int R, C; stage_rc(tid * 16 + i * 8192, R, C); const int Rb = (R & ~31) + perm32(R & 31); RA[i] = R; CA[i] = C; voffB[i] = (unsigned)(Rb * RP + C * 2); voffA[i] = (unsigned)(R * RP + C * 2); }
    constexpr unsigned kstep = (unsigned)(BK * 2);
    constexpr unsigned hstep = (unsigned)HALF * RP;
    const unsigned ldsw = (unsigned)wid * 1024u;
    const int aoff = lds_byte(wr * 64 + fr, fq * 8), boff = lds_byte(wc * 32 + fr, fq * 8);
    typedef const __attribute__((address_space(1))) unsigned* gptr_t;
#define PG8_SA(b, h) (((b) * 2 + (h)) * HTB)
#define PG8_SB(b, h) ((4 + (b) * 2 + (h)) * HTB)
#define PG8_STAGE_B(bufoff, uoff) do { _Pragma("unroll") for (int _i = 0; _i < 2; ++_i) \
        __builtin_amdgcn_global_load_lds((gptr_t)(Bb + (voffB[_i] + (unsigned)(uoff))), (PG8_LAS unsigned*)(lds + (bufoff) + ldsw + _i * 8192), 16, 0, 0); } while (0)
#define PG8_STAGE_A(bufoff, koff, h, NX) do { _Pragma("unroll") for (int _i = 0; _i < 2; ++_i) { unsigned _o; \
        if constexpr (GA) _o = ((NX) ? vn[h][_i] : vc[h][_i]) + (unsigned)(koff); else _o = voffA[_i] + (((NX) ? nAo : cAo) + (unsigned)(h) * hstep + (unsigned)(koff)); \
        __builtin_amdgcn_global_load_lds((gptr_t)(Ab + _o), (PG8_LAS unsigned*)(lds + (bufoff) + ldsw + _i * 8192), 16, 0, 0); } } while (0)
#define PG8_LDA(dst, b, h) do { _Pragma("unroll") for (int m = 0; m < 4; ++m) _Pragma("unroll") for (int k = 0; k < 2; ++k) dst[m][k] = *(const PG8_LAS bf16x8*)(lds + PG8_SA(b, h) + aoff + m * 2048 + k * 1024); } while (0)
#define PG8_LDB(dst, b, h) do { _Pragma("unroll") for (int n = 0; n < 2; ++n) _Pragma("unroll") for (int k = 0; k < 2; ++k) dst[n][k] = *(const PG8_LAS bf16x8*)(lds + PG8_SB(b, h) + boff + n * 2048 + k * 1024); } while (0)
#define PG8_MMA(ai, bj, At, Bt) do { __builtin_amdgcn_s_setprio(1); _Pragma("unroll") for (int m = 0; m < 4; ++m) _Pragma("unroll") for (int n = 0; n < 2; ++n) _Pragma("unroll") for (int k = 0; k < 2; ++k) \
        acc[ai][bj][m][n] = __builtin_amdgcn_mfma_f32_16x16x32_bf16(Bt[n][k], At[m][k], acc[ai][bj][m][n], 0, 0, 0); __builtin_amdgcn_s_setprio(0); } while (0)
#define PG8_MMA8(ai, bj, At, Bt) do { __builtin_amdgcn_s_setprio(1); if constexpr (I8) { _Pragma("unroll") for (int k = 0; k < 2; ++k) _Pragma("unroll") for (int m = 0; m < 4; ++m) _Pragma("unroll") for (int n = 0; n < 2; ++n) \
        asm volatile("v_mfma_i32_16x16x64_i8 %0, %1, %2, %0" : "+v"(acc[ai][bj][m][n]) : "v"(Bt[n][k]), "v"(At[m][k])); } else { _Pragma("unroll") for (int m = 0; m < 4; ++m) _Pragma("unroll") for (int n = 0; n < 2; ++n) \
        asm volatile("v_mfma_f32_16x16x128_f8f6f4 %0, %1, %2, %0" : "+v"(acc[ai][bj][m][n]) : "v"(cat8(Bt[n][0], Bt[n][1])), "v"(cat8(At[m][0], At[m][1]))); } __builtin_amdgcn_s_setprio(0); } while (0)
#define PG8_MMA8Z(ai, bj, At, Bt) do { __builtin_amdgcn_s_setprio(1); if constexpr (I8) { _Pragma("unroll") for (int m = 0; m < 4; ++m) _Pragma("unroll") for (int n = 0; n < 2; ++n) \
        asm volatile("v_mfma_i32_16x16x64_i8 %0, %1, %2, 0" : "=&v"(acc[ai][bj][m][n]) : "v"(Bt[n][0]), "v"(At[m][0])); _Pragma("unroll") for (int m = 0; m < 4; ++m) _Pragma("unroll") for (int n = 0; n < 2; ++n) \
        asm volatile("v_mfma_i32_16x16x64_i8 %0, %1, %2, %0" : "+v"(acc[ai][bj][m][n]) : "v"(Bt[n][1]), "v"(At[m][1])); } else { _Pragma("unroll") for (int m = 0; m < 4; ++m) _Pragma("unroll") for (int n = 0; n < 2; ++n) \
        asm volatile("v_mfma_f32_16x16x128_f8f6f4 %0, %1, %2, 0" : "=&v"(acc[ai][bj][m][n]) : "v"(cat8(Bt[n][0], Bt[n][1])), "v"(cat8(At[m][0], At[m][1]))); } __builtin_amdgcn_s_setprio(0); } while (0)
#define PG8_MM(ai, bj, At, Bt) do { if constexpr (F8) PG8_MMA8(ai, bj, At, Bt); else PG8_MMA(ai, bj, At, Bt); } while (0)
#define PG8_MM2(FIRST, ai, At) do { if constexpr (F8) { if (FIRST) { PG8_MMA8Z(ai, 0, At, B0); PG8_MMA8Z(ai, 1, At, B1); } else { PG8_MMA8(ai, 0, At, B0); PG8_MMA8(ai, 1, At, B1); } } else { PG8_MMA(ai, 0, At, B0); PG8_MMA(ai, 1, At, B1); } } while (0)
#define PG8_WAIT_V(n) asm volatile("s_waitcnt vmcnt(" #n ")" ::: "memory")
#define PG8_WAIT_L(n) asm volatile("s_waitcnt lgkmcnt(" #n ")" ::: "memory")
#define PG8_BAR __builtin_amdgcn_s_barrier()
#define PG8_SCHED __builtin_amdgcn_sched_barrier(0)
    Unit cur, nxt; int ui = 0;
    if (!P.next(0, cur)) return;
    f32x4 acc[2][2][4][2];
    if constexpr (!F8) {
#pragma unroll
    for (int a = 0; a < 2; ++a)
#pragma unroll
        for (int b = 0; b < 2; ++b)
#pragma unroll
            for (int m = 0; m < 4; ++m)
#pragma unroll
                for (int n = 0; n < 2; ++n) acc[a][b][m][n] = (f32x4){0.f, 0.f, 0.f, 0.f};
    }
    bf16x8 At[4][2], B0[2][2], B1[2][2];
    unsigned vc[2][2], vn[2][2]; unsigned cAo = 0, nAo = 0;
    if constexpr (GA) { P.a_off(cur, RA, CA, vc); vn[0][0] = vc[0][0]; vn[0][1] = vc[0][1]; vn[1][0] = vc[1][0]; vn[1][1] = vc[1][1]; } else { cAo = P.a_tile(cur); nAo = cAo; vc[0][0] = vn[0][0] = 0; }
    const char* const Ab = P.A; const char* const Bb = P.Bt; unsigned cBo = P.b_off(cur), nBo = cBo;
    PG8_STAGE_B(PG8_SB(0, 0), cBo); PG8_STAGE_B(PG8_SB(0, 1), cBo + hstep); PG8_STAGE_A(PG8_SA(0, 0), 0u, 0, false); PG8_STAGE_A(PG8_SA(0, 1), 0u, 1, false);
    if (wr == 1) PG8_BAR;
    PG8_WAIT_V(2); PG8_BAR;
    PG8_STAGE_B(PG8_SB(1, 0), cBo + kstep); PG8_STAGE_A(PG8_SA(1, 0), kstep, 0, false); PG8_STAGE_B(PG8_SB(1, 1), cBo + hstep + kstep);
    PG8_WAIT_V(6); PG8_BAR;
    for (;;) {
        const bool has_next = P.next(ui + 1, nxt);
        PG8_LAS unsigned char* const xe = xl + (ui & 1) * XL_EPI;
        PG8_LAS unsigned char* const xg = xl + 2 * XL_EPI + ((ui + 1) & 1) * XL_GATHER;
        E.dma(cur, xe, wid, lane);
        if (has_next) { if constexpr (GA) P.dma_rows(nxt, xg, wid, lane); else nAo = P.a_tile(nxt); nBo = P.b_off(nxt); }
        else { nAo = cAo; nBo = cBo; }
#pragma unroll 1
        for (int rep = 0; rep < KREP; ++rep)
#pragma unroll 1
        for (int t = 0; t < nt; t += 2) {
            const bool lastt = (t == nt - 2); const bool last = lastt && (rep == KREP - 1); const bool first = (t == 0) && (rep == 0); (void)first;
            if constexpr (GA) { if (last) { if (has_next) P.a_off_lds(nxt, RA, CA, xg, vn); else { vn[0][0] = vc[0][0]; vn[0][1] = vc[0][1]; vn[1][0] = vc[1][0]; vn[1][1] = vc[1][1]; } } }
            const unsigned k1 = (unsigned)(t + 1) * kstep;
            const unsigned k2 = lastt ? 0u : (unsigned)(t + 2) * kstep, k3 = k2 + kstep;
            const unsigned b2 = (last ? nBo : cBo) + k2, b3 = b2 + kstep;
            PG8_LDB(B0, 0, 0); PG8_LDB(B1, 0, 1); PG8_SCHED; PG8_LDA(At, 0, 0); PG8_STAGE_A(PG8_SA(1, 1), k1, 1, false);
            PG8_WAIT_V(8); PG8_WAIT_L(0); PG8_BAR; PG8_MM2(first, 0, At); PG8_BAR; PG8_SCHED;
            PG8_LDA(At, 0, 1); PG8_STAGE_B(PG8_SB(0, 0), b2); PG8_STAGE_B(PG8_SB(0, 1), b2 + hstep); PG8_STAGE_A(PG8_SA(0, 0), k2, 0, last);
            PG8_WAIT_V(8); PG8_WAIT_L(0); PG8_BAR; PG8_MM2(first, 1, At); PG8_BAR; PG8_SCHED;
            PG8_LDB(B0, 1, 0); PG8_LDB(B1, 1, 1); PG8_SCHED; PG8_LDA(At, 1, 0); PG8_STAGE_A(PG8_SA(0, 1), k2, 1, last);
            PG8_WAIT_V(8); PG8_WAIT_L(0); PG8_BAR; PG8_MM(0, 0, At, B0); PG8_MM(0, 1, At, B1); PG8_BAR; PG8_SCHED;
            PG8_LDA(At, 1, 1); PG8_STAGE_B(PG8_SB(1, 0), b3); PG8_STAGE_B(PG8_SB(1, 1), b3 + hstep); PG8_STAGE_A(PG8_SA(1, 0), k3, 0, last);
            PG8_WAIT_V(8); PG8_WAIT_L(0); PG8_BAR; PG8_MM(1, 0, At, B0); PG8_MM(1, 1, At, B1); PG8_BAR; PG8_SCHED;
        }
        if constexpr (ALIGN_EPI) { if (wr == 0) PG8_BAR; }
        if constexpr (F8) asm volatile("s_nop 15\n\ts_nop 7" ::: "memory");
        if constexpr (I8) {
#pragma unroll
            for (int a = 0; a < 2; ++a)
#pragma unroll
                for (int b = 0; b < 2; ++b)
#pragma unroll
                    for (int m = 0; m < 4; ++m)
#pragma unroll
                        for (int n = 0; n < 2; ++n)
#pragma unroll
                            for (int i = 0; i < 4; ++i) acc[a][b][m][n][i] = (float)__float_as_int(acc[a][b][m][n][i]);
        }
        E(acc, cur, wr, wc, fr, fq, xe);
        if (!has_next) break;
        if constexpr (!F8)
#pragma unroll
        for (int a = 0; a < 2; ++a)
#pragma unroll
            for (int b = 0; b < 2; ++b)
#pragma unroll
                for (int m = 0; m < 4; ++m)
#pragma unroll
                    for (int n = 0; n < 2; ++n) acc[a][b][m][n] = (f32x4){0.f, 0.f, 0.f, 0.f};
        cur = nxt; cBo = nBo; cAo = nAo; ++ui;
        if constexpr (GA) { vc[0][0] = vn[0][0]; vc[0][1] = vn[0][1]; vc[1][0] = vn[1][0]; vc[1][1] = vn[1][1]; }
        if constexpr (ALIGN_EPI) { if (wr == 1) PG8_BAR; }
    }
    PG8_WAIT_V(0);
    if constexpr (!ALIGN_EPI) { if (wr == 0) PG8_BAR; }
    PG8_BAR;
#undef PG8_SA
#undef PG8_SB
#undef PG8_STAGE_A
#undef PG8_STAGE_B
#undef PG8_LDA
#undef PG8_LDB
#undef PG8_MMA
#undef PG8_MMA8
#undef PG8_MM
#undef PG8_MM2
#undef PG8_MMA8Z
#undef PG8_WAIT_V
#undef PG8_WAIT_L
#undef PG8_BAR
#undef PG8_SCHED
}
}

namespace att {
constexpr int QBLK = 32, KVBLK = 64, LDX = 1024, NT = SEQ / KVBLK;
constexpr int SHM_V = KVBLK * 128 * 2, SHM_K = KVBLK * 128 * 2, NSLOT = 3;
constexpr int OFF_V = 0, OFF_K = NSLOT * SHM_V, OFF_WS = NSLOT * (SHM_V + SHM_K), OFF_TBL = OFF_WS + 8 * 64 * 4, ATT_LDS = OFF_TBL + 2048;
constexpr float THR2 = 8.0f * LOG2E;
#define KSWZ(row, colB) ((row) * 256 + ((colB) ^ (((row) & 7) << 4)))
#define SBAR() __builtin_amdgcn_sched_barrier(0)
__device__ __forceinline__ int crow(int r, int hi) { return (r & 3) + 8 * (r >> 2) + 4 * hi; }
__device__ __forceinline__ int v_st(int k, int c) { const int kk = (k & ~0xC) | ((k & 4) << 1) | ((k & 8) >> 1); return ((kk >> 3) * 4 + (c >> 5)) * 512 + ((kk & 7) * 32 + (c & 31)) * 2; }
__device__ __forceinline__ int v_rd_base(int lane) { return ((lane & 3) << 3) | (((lane >> 2) & 3) << 6) | (((lane >> 4) & 1) << 5) | (((lane >> 5) & 1) << 8); }
constexpr int v_rd_off(int d0, int ks, int half) { return d0 * 512 + ks * 4096 + half * 2048; }
template <int OFF> __device__ __forceinline__ s16x4 tr_read(int vb) { s16x4 r; asm volatile("ds_read_b64_tr_b16 %0, %1 offset:%2" : "=&v"(r) : "v"(vb), "i"(OFF) : "memory"); return r; }
#define ATT_RD8(L, H, D0) do { \
    asm volatile("ds_read_b64_tr_b16 %0, %1 offset:%2" : "=&v"(L[0]) : "v"(vb), "i"(v_rd_off(D0, 0, 0)) : "memory"); asm volatile("ds_read_b64_tr_b16 %0, %1 offset:%2" : "=&v"(H[0]) : "v"(vb), "i"(v_rd_off(D0, 0, 1)) : "memory"); \
    asm volatile("ds_read_b64_tr_b16 %0, %1 offset:%2" : "=&v"(L[1]) : "v"(vb), "i"(v_rd_off(D0, 1, 0)) : "memory"); asm volatile("ds_read_b64_tr_b16 %0, %1 offset:%2" : "=&v"(H[1]) : "v"(vb), "i"(v_rd_off(D0, 1, 1)) : "memory"); \
    asm volatile("ds_read_b64_tr_b16 %0, %1 offset:%2" : "=&v"(L[2]) : "v"(vb), "i"(v_rd_off(D0, 2, 0)) : "memory"); asm volatile("ds_read_b64_tr_b16 %0, %1 offset:%2" : "=&v"(H[2]) : "v"(vb), "i"(v_rd_off(D0, 2, 1)) : "memory"); \
    asm volatile("ds_read_b64_tr_b16 %0, %1 offset:%2" : "=&v"(L[3]) : "v"(vb), "i"(v_rd_off(D0, 3, 0)) : "memory"); asm volatile("ds_read_b64_tr_b16 %0, %1 offset:%2" : "=&v"(H[3]) : "v"(vb), "i"(v_rd_off(D0, 3, 1)) : "memory"); } while (0)
#define ATT_PK(L, H) (bf16x8){L[0], L[1], L[2], L[3], H[0], H[1], H[2], H[3]}
#define ATT_MM4(OD, L, H) do { OD = __builtin_amdgcn_mfma_f32_32x32x16_bf16(pa0, ATT_PK(L[0], H[0]), OD, 0, 0, 0); OD = __builtin_amdgcn_mfma_f32_32x32x16_bf16(pa1, ATT_PK(L[1], H[1]), OD, 0, 0, 0); \
    OD = __builtin_amdgcn_mfma_f32_32x32x16_bf16(pa2, ATT_PK(L[2], H[2]), OD, 0, 0, 0); OD = __builtin_amdgcn_mfma_f32_32x32x16_bf16(pa3, ATT_PK(L[3], H[3]), OD, 0, 0, 0); } while (0)
__device__ __forceinline__ void pv_d0(f32x16* o, int vb, bf16x8 pa0, bf16x8 pa1, bf16x8 pa2, bf16x8 pa3) {
  s16x4 la[4], ha[4], lb[4], hb[4];
  ATT_RD8(la, ha, 0); ATT_RD8(lb, hb, 1);
  asm volatile("s_waitcnt lgkmcnt(8)" ::: "memory"); SBAR(); ATT_MM4(o[0], la, ha); SBAR();
  ATT_RD8(la, ha, 2);
  asm volatile("s_waitcnt lgkmcnt(8)" ::: "memory"); SBAR(); ATT_MM4(o[1], lb, hb); SBAR();
  ATT_RD8(lb, hb, 3);
  asm volatile("s_waitcnt lgkmcnt(8)" ::: "memory"); SBAR(); ATT_MM4(o[2], la, ha); SBAR();
  asm volatile("s_waitcnt lgkmcnt(0)" ::: "memory"); SBAR(); ATT_MM4(o[3], lb, hb);
  const bf16x8 ones = {(short)0x3F80, (short)0x3F80, (short)0x3F80, (short)0x3F80, (short)0x3F80, (short)0x3F80, (short)0x3F80, (short)0x3F80};
  o[4] = __builtin_amdgcn_mfma_f32_32x32x16_bf16(pa0, ones, o[4], 0, 0, 0); o[4] = __builtin_amdgcn_mfma_f32_32x32x16_bf16(pa1, ones, o[4], 0, 0, 0);
  o[4] = __builtin_amdgcn_mfma_f32_32x32x16_bf16(pa2, ones, o[4], 0, 0, 0); o[4] = __builtin_amdgcn_mfma_f32_32x32x16_bf16(pa3, ones, o[4], 0, 0, 0);
}
__device__ __forceinline__ void pv_softmax(f32x16* o, int vb, bf16x8 pa0, bf16x8 pa1, bf16x8 pa2, bf16x8 pa3, f32x16& p0, f32x16& p1, float& m_reg, float& alpha, bool& resc) {
  s16x4 la[4], ha[4], lb[4], hb[4];
  ATT_RD8(la, ha, 0); ATT_RD8(lb, hb, 1);
  asm volatile("s_waitcnt lgkmcnt(8)" ::: "memory"); SBAR();
  float a = fmaxf(fmaxf(p0[0], p0[1]), p1[0]), b = fmaxf(fmaxf(p0[2], p0[3]), p1[1]); a = fmaxf(fmaxf(a, p1[2]), p1[3]);
#pragma unroll
  for (int r = 4; r < 16; r += 4) { a = fmaxf(fmaxf(a, p0[r]), p0[r + 1]); b = fmaxf(fmaxf(b, p0[r + 2]), p0[r + 3]); a = fmaxf(fmaxf(a, p1[r]), p1[r + 1]); b = fmaxf(fmaxf(b, p1[r + 2]), p1[r + 3]); }
  float pmax = fmaxf(a, b);
  ATT_MM4(o[0], la, ha); SBAR();
  ATT_RD8(la, ha, 2);
  asm volatile("s_waitcnt lgkmcnt(8)" ::: "memory"); SBAR();
  { auto rr = __builtin_amdgcn_permlane32_swap(__float_as_uint(pmax), __float_as_uint(pmax), false, false);
    pmax = fmaxf(__uint_as_float(rr[0]), __uint_as_float(rr[1])); }
  resc = false; alpha = 1.f;
  if (__builtin_expect(!__all(pmax <= THR2), 0)) { const float dl = fmaxf(pmax, 0.f); m_reg += dl; alpha = __builtin_amdgcn_exp2f(-dl); resc = true;
#pragma unroll
    for (int r = 0; r < 16; ++r) { p0[r] -= dl; p1[r] -= dl; } }
  ATT_MM4(o[1], lb, hb); SBAR();
  ATT_RD8(lb, hb, 3);
  asm volatile("s_waitcnt lgkmcnt(8)" ::: "memory"); SBAR();
#pragma unroll
  for (int r = 0; r < 16; ++r) p0[r] = __builtin_amdgcn_exp2f(p0[r]);
  ATT_MM4(o[2], la, ha); SBAR();
  asm volatile("s_waitcnt lgkmcnt(0)" ::: "memory"); SBAR();
#pragma unroll
  for (int r = 0; r < 16; ++r) p1[r] = __builtin_amdgcn_exp2f(p1[r]);
  ATT_MM4(o[3], lb, hb);
  const bf16x8 ones = {(short)0x3F80, (short)0x3F80, (short)0x3F80, (short)0x3F80, (short)0x3F80, (short)0x3F80, (short)0x3F80, (short)0x3F80};
  o[4] = __builtin_amdgcn_mfma_f32_32x32x16_bf16(pa0, ones, o[4], 0, 0, 0); o[4] = __builtin_amdgcn_mfma_f32_32x32x16_bf16(pa1, ones, o[4], 0, 0, 0);
  o[4] = __builtin_amdgcn_mfma_f32_32x32x16_bf16(pa2, ones, o[4], 0, 0, 0); o[4] = __builtin_amdgcn_mfma_f32_32x32x16_bf16(pa3, ones, o[4], 0, 0, 0);
}
__device__ __forceinline__ void near_bias(f32x16& p0, f32x16& p1, int dq, const float* tbl) {
#pragma unroll
  for (int r = 0; r < 16; ++r) { const int c0 = (r & 3) + 8 * (r >> 2); p0[r] += tbl[dq + c0]; p1[r] += tbl[dq + c0 + 32]; }
}
__device__ __forceinline__ void qkt(f32x16& p0, f32x16& p1, const char* Ks, const bf16x8* qr, int r32, int hi, int mapB) {
  bf16x8 k0[4], k1[4];
#pragma unroll
  for (int d0 = 0; d0 < 4; ++d0) { const int cb = mapB + (d0 * 16 + hi * 8) * 2;
    k0[d0] = *reinterpret_cast<const bf16x8*>(Ks + KSWZ(r32, cb)); k1[d0] = *reinterpret_cast<const bf16x8*>(Ks + KSWZ(32 + r32, cb)); }
  p0 = f32x16{}; p1 = f32x16{};
#pragma unroll
  for (int d0 = 0; d0 < 4; ++d0) {
    p0 = __builtin_amdgcn_mfma_f32_32x32x16_bf16(k0[d0], qr[d0], p0, 0, 0, 0);
    p1 = __builtin_amdgcn_mfma_f32_32x32x16_bf16(k1[d0], qr[d0], p1, 0, 0, 0); }
}
__device__ __forceinline__ void qkt_seed(f32x16& p0, f32x16& p1, const char* Ks, const bf16x8* qr, const int (&koff)[4], const f32x16& seed) {
#pragma unroll
  for (int d0 = 0; d0 < 4; ++d0) {
    const bf16x8 b0 = *reinterpret_cast<const bf16x8*>(Ks + koff[d0]);
    const bf16x8 b1 = *reinterpret_cast<const bf16x8*>(Ks + koff[d0] + 8192);
    if (d0 == 0) { p0 = __builtin_amdgcn_mfma_f32_32x32x16_bf16(b0, qr[0], seed, 0, 0, 0); p1 = __builtin_amdgcn_mfma_f32_32x32x16_bf16(b1, qr[0], seed, 0, 0, 0); }
    else { p0 = __builtin_amdgcn_mfma_f32_32x32x16_bf16(b0, qr[d0], p0, 0, 0, 0); p1 = __builtin_amdgcn_mfma_f32_32x32x16_bf16(b1, qr[d0], p1, 0, 0, 0); } }
}
__device__ __forceinline__ void partialSM_seeded(f32x16& p0, f32x16& p1, float& m_reg, float& alpha, bool& resc, int mode, int dq, const float* tbl) {
  if (mode == 0) {
#pragma unroll
    for (int r = 0; r < 16; ++r) { const int c0 = (r & 3) + 8 * (r >> 2);
      p0[r] += tbl[dq + c0]; p1[r] += tbl[dq + c0 + 32]; }
  }
  float a = fmaxf(fmaxf(p0[0], p0[1]), p1[0]), b = fmaxf(fmaxf(p0[2], p0[3]), p1[1]); a = fmaxf(fmaxf(a, p1[2]), p1[3]);
#pragma unroll
  for (int r = 4; r < 16; r += 4) { a = fmaxf(fmaxf(a, p0[r]), p0[r + 1]); b = fmaxf(fmaxf(b, p0[r + 2]), p0[r + 3]); a = fmaxf(fmaxf(a, p1[r]), p1[r + 1]); b = fmaxf(fmaxf(b, p1[r + 2]), p1[r + 3]); }
  float pmax = fmaxf(a, b);
  { auto rr = __builtin_amdgcn_permlane32_swap(__float_as_uint(pmax), __float_as_uint(pmax), false, false);
    pmax = fmaxf(__uint_as_float(rr[0]), __uint_as_float(rr[1])); }
  resc = false; alpha = 1.f;
  if (__builtin_expect(!__all(pmax <= THR2), 0)) { const float dl = fmaxf(pmax, 0.f); m_reg += dl; alpha = __builtin_amdgcn_exp2f(-dl); resc = true;
#pragma unroll
    for (int r = 0; r < 16; ++r) { p0[r] -= dl; p1[r] -= dl; } }
#pragma unroll
  for (int r = 0; r < 16; ++r) p0[r] = __builtin_amdgcn_exp2f(p0[r]);
}
__device__ __forceinline__ void partialSM(f32x16& p0, f32x16& p1, float& m_reg, float& mn, float& alpha, int mode, float cL, float cR, int dq, const float* tbl) {
  float cadd;
  if (mode == 0) {
#pragma unroll
    for (int r = 0; r < 16; ++r) { const int c0 = (r & 3) + 8 * (r >> 2);
      p0[r] += tbl[dq + c0]; p1[r] += tbl[dq + c0 + 32]; }
    cadd = 0.f;
  } else cadd = (mode < 0) ? cL : cR;
  float pmax = p0[0];
#pragma unroll
  for (int r = 1; r < 16; ++r) pmax = fmaxf(pmax, p0[r]);
#pragma unroll
  for (int r = 0; r < 16; ++r) pmax = fmaxf(pmax, p1[r]);
  { auto rr = __builtin_amdgcn_permlane32_swap(__float_as_uint(pmax), __float_as_uint(pmax), false, false);
    pmax = fmaxf(__uint_as_float(rr[0]), __uint_as_float(rr[1])); }
  pmax += cadd;
  if (__builtin_expect(__all(pmax - m_reg <= THR2), 1)) { mn = m_reg; alpha = 1.f; }
  else { mn = fmaxf(m_reg, pmax); alpha = __builtin_amdgcn_exp2f(m_reg - mn); m_reg = mn; }
  const float sh = cadd - mn;
#pragma unroll
  for (int r = 0; r < 16; ++r) p0[r] += sh;
#pragma unroll
  for (int r = 0; r < 16; ++r) p1[r] += sh;
#pragma unroll
  for (int r = 0; r < 16; ++r) p0[r] = __builtin_amdgcn_exp2f(p0[r]);
}
__device__ __forceinline__ void finishSM(f32x16& p0, f32x16& p1, bf16x8& pa0, bf16x8& pa1, bf16x8& pa2, bf16x8& pa3) {
#define PK8(P, BASE, OUT) do { v4u w = {cvt_pk_bf16(P[BASE + 0], P[BASE + 1]), cvt_pk_bf16(P[BASE + 2], P[BASE + 3]), cvt_pk_bf16(P[BASE + 4], P[BASE + 5]), cvt_pk_bf16(P[BASE + 6], P[BASE + 7])}; OUT = *reinterpret_cast<bf16x8*>(&w); } while (0)
  PK8(p0, 0, pa0); PK8(p0, 8, pa1); PK8(p1, 0, pa2); PK8(p1, 8, pa3);
#undef PK8
}
__device__ __forceinline__ int rel_bucket(int rel) {
  const int n = rel < 0 ? -rel : rel; int b;
  if (n < 8) b = n; else if (n < 12) b = 8; else if (n < 16) b = 9; else if (n < 23) b = 10; else if (n < 32) b = 11; else if (n < 46) b = 12; else if (n < 64) b = 13; else if (n < 91) b = 14; else b = 15;
  return (rel > 0 ? 16 : 0) + b;
}

__device__ __forceinline__ void attn_unit(int b, int h, int qb, const bf16_t* __restrict__ Q, const bf16_t* __restrict__ K, const bf16_t* __restrict__ V, bf16_t* __restrict__ O,
                                          float lam, float osc, const float* __restrict__ g, const float* __restrict__ rel_bias, char* lds, int tid_in, bool build_tbl, bool o8) {
  int tid_ = tid_in; asm volatile("" : "+v"(tid_));
  const int tid = tid_, wid = __builtin_amdgcn_readfirstlane(tid >> 6), lane = tid & 63, r32 = lane & 31, hi = lane >> 5;
  const int map = wid & 1, jq = wid >> 1;
  char* V_lds = lds + OFF_V; char* K_lds = lds + OFF_K;
  float* ws = (float*)(lds + OFF_WS) + wid * 64; float* li_l = ws; float* al_l = ws + 32;
  float* tbl = (float*)(lds + OFF_TBL);
  if (build_tbl) tbl[tid] = rel_bias[rel_bucket(tid - 256) * NH + h] * LOG2E;
  const float cL = rel_bias[15 * NH + h] * LOG2E, cR = rel_bias[31 * NH + h] * LOG2E;
  const long rowbase = (long)b * SEQ; const int qs = qb * 128 + jq * QBLK;
  float m_reg = -1e30f; f32x16 o[5] = {}; bf16x8 qr[4];
  const bf16_t* Qw = Q + (rowbase + qs + r32) * LDX + h * 128 + map * 64 + hi * 8;
#pragma unroll
  for (int d0 = 0; d0 < 4; ++d0) qr[d0] = *reinterpret_cast<const bf16x8*>(Qw + d0 * 16);
  const bf16_t* Kh = K + rowbase * LDX + h * 128; const bf16_t* Vh = V + rowbase * LDX + h * 128;
  const int vb0 = (int)(uintptr_t)V_lds + v_rd_base(lane);
  const int mapB = map * 128;
  int koff[4];
#pragma unroll
  for (int d0 = 0; d0 < 4; ++d0) koff[d0] = KSWZ(r32, mapB + (d0 * 16 + hi * 8) * 2);
  const int dq0 = 256 + 4 * hi - (qs + r32);
  unsigned ksrc[2], vsrc[2];
#pragma unroll
  for (int i = 0; i < 2; ++i) { const int pk = wid + 8 * i;
    const int krow = 4 * pk + (lane >> 4), kc = (lane & 15) ^ (krow & 7); ksrc[i] = (unsigned)(krow * (LDX * 2) + kc * 16);
    const int st = 2 * pk + (lane >> 5), kk = (st >> 2) * 8 + ((lane & 31) >> 2), vk = kk  , vc = (st & 3) * 32 + (lane & 3) * 8;
    vsrc[i] = (unsigned)(vk * (LDX * 2) + vc * 2); }
  typedef const __attribute__((address_space(1))) unsigned* gptr_t; typedef __attribute__((address_space(3))) unsigned* lptr_t;
  const char* const Kg = (const char*)Kh; const char* const Vg = (const char*)Vh;
  const lptr_t kdst = (lptr_t)(__attribute__((address_space(3))) char*)(K_lds) + 0; (void)kdst;
#define DMA_TILE(t, slot) do { const unsigned tb_ = (unsigned)(t) * (unsigned)(KVBLK * LDX * 2); \
    _Pragma("unroll") for (int i_ = 0; i_ < 2; ++i_) { \
      __builtin_amdgcn_global_load_lds((gptr_t)(Kg + (ksrc[i_] + tb_)), (lptr_t)((__attribute__((address_space(3))) char*)K_lds + (slot) + (wid + 8 * i_) * 1024), 16, 0, 0); \
      __builtin_amdgcn_global_load_lds((gptr_t)(Vg + (vsrc[i_] + tb_)), (lptr_t)((__attribute__((address_space(3))) char*)V_lds + (slot) + (wid + 8 * i_) * 1024), 16, 0, 0); } } while (0)
#define WAIT_BAR() do { asm volatile("s_waitcnt vmcnt(0) lgkmcnt(0)" ::: "memory"); __builtin_amdgcn_s_barrier(); asm volatile("" ::: "memory"); } while (0)
#define RESC(a, rs) do { if (rs) { if (hi == 0) al_l[r32] = (a); asm volatile("s_waitcnt lgkmcnt(0)" ::: "memory"); \
    _Pragma("unroll") for (int d = 0; d < 5; ++d) _Pragma("unroll") for (int r = 0; r < 16; ++r) o[d][r] *= al_l[crow(r, hi)]; } } while (0)
#define SEED(md) do { const int md_ = (md); const float sv_ = (md_ == 0 ? 0.f : (md_ < 0 ? cL : cR)) - m_reg; _Pragma("unroll") for (int r = 0; r < 16; ++r) seed[r] = sv_; } while (0)
#define TMODE(k0) (((k0) >= qs + 122) ? 1 : (((k0) <= qs - 154) ? -1 : 0))
#define ROT() do { const int t_ = sl_prev; sl_prev = sl_cur; sl_cur = sl_next; sl_next = t_; } while (0)
  f32x16 pA0, pA1, pB0, pB1, seed; float mnA, alA, alB; bool rsA = false, rsB = false; bf16x8 pa0, pa1, pa2, pa3;
  int sl_prev = 2 * SHM_V, sl_cur = 0, sl_next = SHM_V;
  if (wid >= 4) __builtin_amdgcn_s_setprio(1);
  DMA_TILE(0, 0); DMA_TILE(1, SHM_V);
  WAIT_BAR();
  DMA_TILE(2, 2 * SHM_V);
  qkt(pA0, pA1, K_lds, qr, r32, hi, mapB); partialSM(pA0, pA1, m_reg, mnA, alA, TMODE(0), cL, cR, dq0, tbl);
  _Pragma("unroll") for (int r = 0; r < 16; ++r) pA1[r] = __builtin_amdgcn_exp2f(pA1[r]);
  ROT();
#define QK_SEEDED(P0, P1, DMA_STMT, SEED_STMT) do { bf16x8 k0_[4], k1_[4]; const char* Ks_ = K_lds + sl_cur; \
    _Pragma("unroll") for (int d0 = 0; d0 < 4; ++d0) { k0_[d0] = *reinterpret_cast<const bf16x8*>(Ks_ + koff[d0]); k1_[d0] = *reinterpret_cast<const bf16x8*>(Ks_ + koff[d0] + 8192); } \
    DMA_STMT; SEED_STMT; \
    P0 = __builtin_amdgcn_mfma_f32_32x32x16_bf16(k0_[0], qr[0], seed, 0, 0, 0); P1 = __builtin_amdgcn_mfma_f32_32x32x16_bf16(k1_[0], qr[0], seed, 0, 0, 0); \
    _Pragma("unroll") for (int d0 = 1; d0 < 4; ++d0) { P0 = __builtin_amdgcn_mfma_f32_32x32x16_bf16(k0_[d0], qr[d0], P0, 0, 0, 0); P1 = __builtin_amdgcn_mfma_f32_32x32x16_bf16(k1_[d0], qr[d0], P1, 0, 0, 0); } } while (0)
  for (int j = 1; j + 1 < NT; j += 2) {
    SBAR(); QK_SEEDED(pB0, pB1, if (j > 1) DMA_TILE(j + 1, sl_next), SEED(TMODE(j * KVBLK)));
    finishSM(pA0, pA1, pa0, pa1, pa2, pa3); SBAR();
    if (TMODE(j * KVBLK) == 0) near_bias(pB0, pB1, dq0 + j * KVBLK, tbl);
    pv_softmax(o, vb0 + sl_prev, pa0, pa1, pa2, pa3, pB0, pB1, m_reg, alB, rsB);
    WAIT_BAR();
    RESC(alB, rsB); ROT();
    SBAR(); QK_SEEDED(pA0, pA1, DMA_TILE(j + 2, sl_next), SEED(TMODE((j + 1) * KVBLK)));
    finishSM(pB0, pB1, pa0, pa1, pa2, pa3); SBAR();
    if (TMODE((j + 1) * KVBLK) == 0) near_bias(pA0, pA1, dq0 + (j + 1) * KVBLK, tbl);
    pv_softmax(o, vb0 + sl_prev, pa0, pa1, pa2, pa3, pA0, pA1, m_reg, alA, rsA);
    WAIT_BAR();
    RESC(alA, rsA); ROT();
  }
  SBAR(); QK_SEEDED(pB0, pB1, (void)0, SEED(TMODE((NT - 1) * KVBLK)));
  finishSM(pA0, pA1, pa0, pa1, pa2, pa3); SBAR();
  if (TMODE((NT - 1) * KVBLK) == 0) near_bias(pB0, pB1, dq0 + (NT - 1) * KVBLK, tbl);
  pv_softmax(o, vb0 + sl_prev, pa0, pa1, pa2, pa3, pB0, pB1, m_reg, alB, rsB);
  RESC(alB, rsB);
  finishSM(pB0, pB1, pa0, pa1, pa2, pa3); SBAR();
  pv_d0(o, vb0 + sl_cur, pa0, pa1, pa2, pa3);
  __builtin_amdgcn_s_setprio(0);
  float rli[16];
#pragma unroll
  for (int r = 0; r < 16; ++r) rli[r] = __builtin_amdgcn_rcpf(o[4][r]);
  __syncthreads();
  float* X = (float*)(lds + jq * 16384);
  if (map == 1) {
#pragma unroll
    for (int r = 0; r < 16; ++r) { const int orow = crow(r, hi); const float s = rli[r] * lam;
#pragma unroll
      for (int d0 = 0; d0 < 4; ++d0) X[orow * 128 + d0 * 32 + r32] = o[d0][r] * s; }
  }
  __syncthreads();
  if (map == 0) {
    float ss[16];
#pragma unroll
    for (int r = 0; r < 16; ++r) { const int orow = crow(r, hi); float a = 0.f;
#pragma unroll
      for (int d0 = 0; d0 < 4; ++d0) { const float v = o[d0][r] * rli[r] - X[orow * 128 + d0 * 32 + r32]; o[d0][r] = v; a += v * v; }
      ss[r] = a; }
#pragma unroll
    for (int s = 1; s < 32; s <<= 1)
#pragma unroll
      for (int r = 0; r < 16; ++r) ss[r] += shx(ss[r], s);
    float gg[4];
#pragma unroll
    for (int d0 = 0; d0 < 4; ++d0) gg[d0] = g[d0 * 32 + r32] * osc;
    asm volatile("s_waitcnt lgkmcnt(0)" ::: "memory");
    bf16_t* stg = (bf16_t*)X;
#pragma unroll
    for (int r = 0; r < 16; ++r) { const int orow = crow(r, hi); const float rs = __builtin_amdgcn_rsqf(ss[r] * (1.0f / 128.0f) + LN_EPS);
#pragma unroll
      for (int d0 = 0; d0 < 4; ++d0) { const float v = o[d0][r] * rs * gg[d0]; stg[orow * 128 + d0 * 32 + r32] = (bf16_t)(cvt_pk_bf16(v, v) & 0xffffu); } }
    asm volatile("s_waitcnt lgkmcnt(0)" ::: "memory");
    bf16_t* Ow = O + (rowbase + qs) * LDX + h * 128;
#pragma unroll
    for (int i = 0; i < 8; ++i) { const int row = i * 4 + (lane >> 4), ch = lane & 15; const v4u v = *(const v4u*)(stg + row * 128 + ch * 8);
      if (!o8) *(v4u*)(Ow + (long)row * LDX + ch * 8) = v;
      else { typedef unsigned u32x2 __attribute__((ext_vector_type(2))); u32x2 q8; q8.x = pg8::pk4_fp8(bf_lo(v.x), bf_hi(v.x), bf_lo(v.y), bf_hi(v.y)); q8.y = pg8::pk4_fp8(bf_lo(v.z), bf_hi(v.z), bf_lo(v.w), bf_hi(v.w));
        *(u32x2*)((unsigned char*)O + (size_t)(rowbase + qs + row) * LDX + h * 128 + ch * 8) = q8; } }
    asm volatile("s_waitcnt lgkmcnt(0)" ::: "memory");
  }
  __syncthreads();
#undef DMA_TILE
#undef WAIT_BAR
#undef ROT
#undef RESC
#undef SEED
#undef QK_SEEDED
#undef TMODE
}
#undef KSWZ
#undef SBAR
}

#define XB_TMO      128
#define XB_XCNT(j)  (256  + 64 * (j))
#define XB_XSUB(j)  (1280 + 64 * (j))
#define XB_XGEN(j)  (2304 + 64 * (j))
#define XB_TOP      3328
#define XB_TOPGEN   3392
#define XCD_BAR_WORDS 3456
#define XB_SPIN_CAP (1u << 18)
__device__ __forceinline__ unsigned xb_ld(unsigned* p)              { return __hip_atomic_load(p, __ATOMIC_RELAXED, __HIP_MEMORY_SCOPE_AGENT); }
__device__ __forceinline__ unsigned xb_add(unsigned* p, unsigned v) { return __hip_atomic_fetch_add(p, v, __ATOMIC_RELAXED, __HIP_MEMORY_SCOPE_AGENT); }
__device__ __forceinline__ unsigned xb_xcc_id() { return (unsigned)__builtin_amdgcn_s_getreg((3 << 11) | 20) & 0xFu; }
#define XB_SPIN(cond, bar) do { unsigned _sp = 0; while (cond) { __builtin_amdgcn_s_sleep(1); \
    if ((++_sp & 255u) == 0u) { if (xb_ld(&(bar)[XB_TMO])) break; if (_sp > XB_SPIN_CAP) { atomicAdd(&(bar)[XB_TMO], 1u); break; } } } } while (0)
struct XcdBarrier { unsigned* bar; unsigned x; volatile LAS unsigned* st; };
__device__ __forceinline__ XcdBarrier xcd_barrier_post(unsigned* bar, volatile LAS unsigned* st) {
    XcdBarrier b; b.bar = bar; b.x = xb_xcc_id(); b.st = st;
    if (threadIdx.x == 0) (void)xb_add(&bar[XB_XCNT(b.x)], 1u);
    return b;
}
__device__ __forceinline__ void xcd_barrier_complete(unsigned* bar, unsigned x, unsigned& nloc, unsigned& nx) {
    const unsigned G = gridDim.x * gridDim.y * gridDim.z;
    unsigned sum, cnt, mine, sp = 0u;
    for (;;) {
        sum = 0u; cnt = 0u; mine = 0u;
#pragma unroll
        for (unsigned j = 0; j < 16; ++j) { const unsigned c = xb_ld(&bar[XB_XCNT(j)]); sum += c; cnt += (c > 0u) ? 1u : 0u; mine = (j == x) ? c : mine; }
        if (sum == G) break;
        __builtin_amdgcn_s_sleep(1);
        if ((++sp & 255u) == 0u) { if (xb_ld(&bar[XB_TMO])) break; if (sp > XB_SPIN_CAP) { atomicAdd(&bar[XB_TMO], 1u); break; } }
    }
    nloc = mine > 0u ? mine : 1u; nx = cnt > 0u ? cnt : 1u;
}
__device__ __forceinline__ void xcd_barrier(const XcdBarrier& b) {
    asm volatile("s_waitcnt vmcnt(0)" ::: "memory");
    __syncthreads();
    if (threadIdx.x == 0) {
        unsigned* bar = b.bar;
        __builtin_amdgcn_s_waitcnt(0);
        unsigned nloc = b.st[0], nx = b.st[1];
        if (nloc == 0u) { xcd_barrier_complete(bar, b.x, nloc, nx); b.st[0] = nloc; b.st[1] = nx; }
        const unsigned old = xb_add(&bar[XB_XSUB(b.x)], 1u);
        const unsigned gen = old / nloc;
        if (old + 1u == (gen + 1u) * nloc) {
            __builtin_amdgcn_fence(__ATOMIC_RELEASE, "agent");
            asm volatile("s_waitcnt vmcnt(0)" ::: "memory");
            const unsigned og = xb_add(&bar[XB_TOP], 1u);
            const unsigned tg = og / nx;
            if (og + 1u == (tg + 1u) * nx) xb_add(&bar[XB_TOPGEN], 1u);
            else XB_SPIN(xb_ld(&bar[XB_TOPGEN]) == tg, bar);
            __builtin_amdgcn_fence(__ATOMIC_ACQUIRE, "agent");
            xb_add(&bar[XB_XGEN(b.x)], 1u);
            asm volatile("s_waitcnt vmcnt(0)" ::: "memory");
        } else {
            XB_SPIN(xb_ld(&bar[XB_XGEN(b.x)]) == gen, bar);
            __builtin_amdgcn_fence(__ATOMIC_ACQUIRE, "agent");
            asm volatile("s_waitcnt vmcnt(0)" ::: "memory");
        }
    }
    __syncthreads();
}

template <int MODE> __device__ __forceinline__ int dst_row(int n) {
    if (MODE == 1) { if (n < 1024) return n; const int b = (n - 1024) >> 10, f = (n - 1024) & 1023; return 1024 + (f >> 7) * 256 + b * 128 + (f & 127); }
    if (MODE == 2) { const int b = n & 1, j = n >> 1; return (j >> 7) * 256 + b * 128 + (j & 127); }
    return n;
}
template <int MODE> __device__ __forceinline__ void p0_transpose_item(const float* W, int K, int N, bf16_t* WT, LAS float* scr, int item, int lane, const float* kscale = nullptr) {
    const int nblk = N / 32, kb = item / nblk, nb = item % nblk, k0 = 64 * kb, n0 = 32 * nb;
#pragma unroll 8
    for (int i = 0; i < 32; ++i) { const int kk = 2 * i + (lane >> 5); float w = W[(size_t)(k0 + kk) * N + n0 + (lane & 31)]; if (kscale) w *= kscale[k0 + kk]; scr[kk * 33 + (lane & 31)] = w; }
    LDS_WAIT(); asm volatile("" ::: "memory");
    const int c = lane & 7;
#pragma unroll
    for (int j = 0; j < 4; ++j) { const int n = (lane >> 3) + 8 * j; const LAS float* s = scr + (8 * c) * 33 + n;
        v4u o; o.x = cvt_pk_bf16(s[0 * 33], s[1 * 33]); o.y = cvt_pk_bf16(s[2 * 33], s[3 * 33]); o.z = cvt_pk_bf16(s[4 * 33], s[5 * 33]); o.w = cvt_pk_bf16(s[6 * 33], s[7 * 33]);
        *(GAS v4u*)(WT + (size_t)dst_row<MODE>(n0 + n) * K + k0 + 8 * c) = o; }
    LDS_WAIT(); asm volatile("" ::: "memory");
}

template <int MODE, bool I8 = false> __device__ __forceinline__ void p0_quant_strip(const float* W, int N, unsigned char* W8, float* SC, int strip, LAS unsigned char* lds, int wave, int lane) {
    constexpr float QM_ = I8 ? 127.0f : F8MAX;
    LAS float* scr = (LAS float*)(lds + wave * 16384); LAS float* red = (LAS float*)(lds + LDSCTL_OFF + 2048);
    const int n0 = strip * 32, k0 = wave * 128, kk = lane >> 5, n = lane & 31;
    float am = 0.f;
    { const char* Wb = (const char*)W + (size_t)k0 * N * 4; const unsigned loff = (unsigned)((kk * N + n0 + n) * 4);
      float vv[64];
#pragma unroll
      for (int i = 0; i < 64; ++i) vv[i] = *(const float*)(Wb + (size_t)i * (size_t)(2 * N * 4) + loff);
#pragma unroll
      for (int i = 0; i < 64; ++i) { scr[(2 * i + kk) * 32 + n] = vv[i]; am = fmaxf(am, fabsf(vv[i])); } }
    am = fmaxf(am, shx(am, 32));
    if (lane < 32) red[wave * 32 + n] = am;
    __syncthreads();
    float amax = red[n];
#pragma unroll
    for (int w = 1; w < 8; ++w) amax = fmaxf(amax, red[w * 32 + n]);
    const float q = amax > 0.f ? QM_ / amax : 0.f;
    const int dr = dst_row<MODE>(n0 + n);
    if (wave == 0 && lane < 32) SC[dr] = amax * (1.0f / QM_);
#pragma unroll
    for (int c = 0; c < 4; ++c) { float v[16];
#pragma unroll
        for (int j = 0; j < 16; ++j) v[j] = scr[(kk * 64 + c * 16 + j) * 32 + n] * q;
        v4u o; o.x = pg8::pkq4<I8>(v[0], v[1], v[2], v[3]); o.y = pg8::pkq4<I8>(v[4], v[5], v[6], v[7]); o.z = pg8::pkq4<I8>(v[8], v[9], v[10], v[11]); o.w = pg8::pkq4<I8>(v[12], v[13], v[14], v[15]);
        *(GAS v4u*)(W8 + (size_t)dr * 1024 + k0 + kk * 64 + c * 16) = o; }
    __syncthreads();
}
__device__ __forceinline__ float ln_bound(const float* g, const float* b, int lane) {
    float mg = 0.f, mb = 0.f;
#pragma unroll
    for (int j = 0; j < 4; ++j) { const f32x4 a = *(const f32x4*)(g + j * 256 + lane * 4), c = *(const f32x4*)(b + j * 256 + lane * 4);
        mg = fmaxf(mg, fmaxf(fmaxf(fabsf(a[0]), fabsf(a[1])), fmaxf(fabsf(a[2]), fabsf(a[3])))); mb = fmaxf(mb, fmaxf(fmaxf(fabsf(c[0]), fabsf(c[1])), fmaxf(fabsf(c[2]), fabsf(c[3])))); }
#pragma unroll
    for (int o = 1; o < 64; o <<= 1) { mg = fmaxf(mg, shx(mg, o)); mb = fmaxf(mb, shx(mb, o)); }
    return 31.984371f * mg + mb;
}

struct Ptrs {
    const float *x, *rel_bias, *attn_w_in, *attn_lambda, *attn_subln, *attn_w_out, *conv_w_in, *conv_w, *conv_w_out, *router_w, *router_b, *w1, *b1, *w2, *b2, *ln_g, *ln_b;
    float* out; unsigned char* ws;
};

#ifndef DEFER_W
#define DEFER_W 1
#endif
__device__ __forceinline__ void expert_strip(const Ptrs& P, int st, LAS unsigned char* lds, int wave, int lane) {
    unsigned char* ws = P.ws;
    if (st < 128 * 64) { const int j = st >> 6, r = st & 63; p0_quant_strip<2>(P.w1 + (size_t)j * 1024 * 2048, 2048, ws + WS_W1 + (size_t)j * 2048 * 1024, (float*)(ws + WS_S1) + (size_t)j * 2048, r, lds, wave, lane); }
    else { const int q = st - 128 * 64, j = q >> 5, r = q & 31; p0_quant_strip<0>(P.w2 + (size_t)j * 1024 * 1024, 1024, ws + WS_W2 + (size_t)j * 1024 * 1024, (float*)(ws + WS_S2) + (size_t)j * 1024, r, lds, wave, lane); }
}
constexpr int NWAVES_ = 8;
__device__ __forceinline__ void p0_prologue(const Ptrs& P, LAS unsigned char* lds, int gw, int NGW, int wave, int lane) {
    LAS float* scr = (LAS float*)(lds + RING_OFF + wave * 16384);
    unsigned char* ws = P.ws;
    constexpr int I_OUT = 16 * 32, I_R = 16;
    constexpr int I_IN = 16 * 96;
    constexpr int S1 = NA16 * I_OUT, S3 = S1 + NO16 * I_OUT, S4 = S3 + 4 * I_R, S5 = S4 + NQ16 * I_IN, S6 = S5 + NC16 * I_IN;
    { const int wg = gw / NWAVES_, NWG = NGW / NWAVES_;
      constexpr int T1 = 128 * 64, T2 = T1 + 128 * 32, T3 = T2 + NQ8 * 96, T4 = T3 + NC8 * 96, T5 = T4 + NA8 * 32, T6 = T5 + NO8 * 32;
      constexpr int NE0 = DEFER_W ? 32 * 64 + 32 * 32 : T2;
#pragma unroll 1
      for (int s0 = wg; s0 < NE0 + (T6 - T2); s0 += NWG) {
        const int st = (s0 >= NE0) ? T2 + (s0 - NE0) : (DEFER_W ? (s0 < 32 * 64 ? s0 : T1 + (s0 - 32 * 64)) : s0);
        if (st < T2) expert_strip(P, st, lds, wave, lane);
        else if (st < T3) { const int q = st - T2, j = QJ0 + q / 96, r = q % 96; p0_quant_strip<0, I8P>(P.attn_w_in + (size_t)j * 1024 * 3072, 3072, ws + WS_WAI + (size_t)j * 3072 * 1024, (float*)(ws + WS_SD) + (size_t)j * 3072, r, lds, wave, lane); }
        else if (st < T4) { const int q = st - T3, j = CJ0 + q / 96, r = q % 96; p0_quant_strip<1, I8P>(P.conv_w_in + (size_t)j * 1024 * 3072, 3072, ws + WS_WCI + (size_t)j * 3072 * 1024, (float*)(ws + WS_SD + 32 * 1024) + (size_t)j * 3072, r, lds, wave, lane); }
        else if (st < T5) { const int q = st - T4, j = AJ0 + q / 32, r = q % 32; p0_quant_strip<0>(P.attn_w_out + (size_t)j * 1024 * 1024, 1024, ws + WS_WAO8 + (size_t)j * 1024 * 1024, (float*)(ws + WS_SD + 24 * 1024) + (size_t)j * 1024, r, lds, wave, lane); }
        else { const int q = st - T5, j = OJ0 + q / 32, r = q % 32; p0_quant_strip<0, I8P>(P.conv_w_out + (size_t)j * 1024 * 1024, 1024, ws + WS_WCO8 + (size_t)j * 1024 * 1024, (float*)(ws + WS_SD + 56 * 1024) + (size_t)j * 1024, r, lds, wave, lane); }
      } }
    for (int it = gw; it < S6; it += NGW) {
        if (it >= S5) { const int q = it - S5, j = CK0 + q / I_IN, r = q % I_IN; p0_transpose_item<1>(P.conv_w_in + (size_t)j * 1024 * 3072, 1024, 3072, (bf16_t*)(ws + WS_WC16) + (size_t)j * 3072 * 1024, scr, r, lane); }
        else if (it >= S4) { const int q = it - S4, j = QK0 + q / I_IN, r = q % I_IN; p0_transpose_item<0>(P.attn_w_in + (size_t)j * 1024 * 3072, 1024, 3072, (bf16_t*)(ws + WS_WA16) + (size_t)j * 3072 * 1024, scr, r, lane); }
        else if (it < S1) { const int q = it, j = AK0 + q / I_OUT, r = q % I_OUT; p0_transpose_item<0>(P.attn_w_out + (size_t)j * 1024 * 1024, 1024, 1024, (bf16_t*)(ws + WS_WAO) + (size_t)j * 1024 * 1024, scr, r, lane); }
        else if (it < S3) { const int q = it - S1, j = OK0 + q / I_OUT, r = q % I_OUT; p0_transpose_item<0>(P.conv_w_out + (size_t)j * 1024 * 1024, 1024, 1024, (bf16_t*)(ws + WS_WCO) + (size_t)j * 1024 * 1024, scr, r, lane); }
        else { const int q = it - S3, j = q / I_R, r = q % I_R; p0_transpose_item<0>(P.router_w + (size_t)j * 1024 * 32, 1024, 32, (bf16_t*)(ws + WS_WR) + (size_t)j * 32 * 1024, scr, r, lane, P.ln_g + (size_t)(j * 2 + 0) * D); }
    }
    for (int row = gw; row < M; row += NGW) {
        f32x4 a[2][2]; float am = 0.f;
#pragma unroll
        for (int h = 0; h < 2; ++h)
#pragma unroll
            for (int q = 0; q < 2; ++q) { a[h][q] = *(const GAS f32x4*)(P.x + (size_t)row * D + h * 512 + lane * 8 + q * 4);
                am = fmaxf(am, fmaxf(fmaxf(fabsf(a[h][q][0]), fabsf(a[h][q][1])), fmaxf(fabsf(a[h][q][2]), fabsf(a[h][q][3])))); }
#pragma unroll
        for (int o = 1; o < 64; o <<= 1) am = fmaxf(am, shx(am, o));
        const float qs = QMAXP / fmaxf(am, 1e-30f);
        if ((QM & 1) && lane == 0) ((float*)(ws + WS_RS))[row] = am * (1.0f / QMAXP);
#pragma unroll
        for (int h = 0; h < 2; ++h) { v4u o; o.x = cvt_pk_bf16(a[h][0][0], a[h][0][1]); o.y = cvt_pk_bf16(a[h][0][2], a[h][0][3]); o.z = cvt_pk_bf16(a[h][1][0], a[h][1][1]); o.w = cvt_pk_bf16(a[h][1][2], a[h][1][3]);
            *(GAS v4u*)((bf16_t*)(ws + WS_XB) + (size_t)row * D + h * 512 + lane * 8) = o;
            if (QM & 1) { typedef unsigned u32x2 __attribute__((ext_vector_type(2))); u32x2 q8;
            q8.x = pg8::pkq4<I8P>(a[h][0][0] * qs, a[h][0][1] * qs, a[h][0][2] * qs, a[h][0][3] * qs); q8.y = pg8::pkq4<I8P>(a[h][1][0] * qs, a[h][1][1] * qs, a[h][1][2] * qs, a[h][1][3] * qs);
            *(GAS u32x2*)(ws + WS_XI + (size_t)row * D + h * 512 + lane * 8) = q8; } }
    }
}

__device__ __forceinline__ void conv_phase(const bf16_t* GB, const bf16_t* Z, const float* cw, bf16_t* Gout, float* RS, bool o8, int gw, int NGW, int lane) {
    float w[3][16];
#pragma unroll
    for (int j = 0; j < 3; ++j)
#pragma unroll
        for (int h = 0; h < 2; ++h)
#pragma unroll
            for (int q = 0; q < 2; ++q) { const f32x4 t = *(const f32x4*)(cw + j * D + h * 512 + lane * 8 + q * 4); w[j][h * 8 + q * 4 + 0] = t[0]; w[j][h * 8 + q * 4 + 1] = t[1]; w[j][h * 8 + q * 4 + 2] = t[2]; w[j][h * 8 + q * 4 + 3] = t[3]; }
    for (int run = gw; run < M / 32; run += NGW) {
        const int t0 = run * 32; const bool first = (t0 % SEQ) == 0, lastr = ((t0 + 32) % SEQ) == 0;
        v4u zp[2], zc[2], zn[2];
#pragma unroll
        for (int h = 0; h < 2; ++h) { zp[h] = first ? (v4u){0u, 0u, 0u, 0u} : *(const v4u*)(Z + (size_t)(t0 - 1) * D + h * 512 + lane * 8); zc[h] = *(const v4u*)(Z + (size_t)t0 * D + h * 512 + lane * 8); }
        for (int r = 0; r < 32; ++r) { const int t = t0 + r; const bool pad = lastr && (r == 31);
            float o[2][8];
#pragma unroll
            for (int h = 0; h < 2; ++h) {
                zn[h] = pad ? (v4u){0u, 0u, 0u, 0u} : *(const v4u*)(Z + (size_t)(t + 1) * D + h * 512 + lane * 8);
                const v4u gb = *(const v4u*)(GB + (size_t)t * D + h * 512 + lane * 8);
#pragma unroll
                for (int q = 0; q < 4; ++q) { const unsigned up = zp[h][q], uc = zc[h][q], un = zn[h][q], ug = gb[q]; const int c = h * 8 + q * 2;
                    o[h][q * 2 + 0] = bf_lo(ug) * (w[0][c] * bf_lo(up) + w[1][c] * bf_lo(uc) + w[2][c] * bf_lo(un));
                    o[h][q * 2 + 1] = bf_hi(ug) * (w[0][c + 1] * bf_hi(up) + w[1][c + 1] * bf_hi(uc) + w[2][c + 1] * bf_hi(un)); }
                if (!o8) { v4u ov; ov.x = cvt_pk_bf16(o[h][0], o[h][1]); ov.y = cvt_pk_bf16(o[h][2], o[h][3]); ov.z = cvt_pk_bf16(o[h][4], o[h][5]); ov.w = cvt_pk_bf16(o[h][6], o[h][7]);
                    *(v4u*)(Gout + (size_t)t * D + h * 512 + lane * 8) = ov; }
                zp[h] = zc[h]; zc[h] = zn[h];
            }
            if (o8) { float am = 0.f;
#pragma unroll
                for (int h = 0; h < 2; ++h)
#pragma unroll
                    for (int i = 0; i < 8; ++i) am = fmaxf(am, fabsf(o[h][i]));
#pragma unroll
                for (int s_ = 1; s_ < 64; s_ <<= 1) am = fmaxf(am, shx(am, s_));
                const float qs = QMAXP / fmaxf(am, 1e-30f);
                if (lane == 0) RS[t] = am * (1.0f / QMAXP);
#pragma unroll
                for (int h = 0; h < 2; ++h) { typedef unsigned u32x2 __attribute__((ext_vector_type(2))); u32x2 q8;
                    q8.x = pg8::pkq4<I8P>(o[h][0] * qs, o[h][1] * qs, o[h][2] * qs, o[h][3] * qs); q8.y = pg8::pkq4<I8P>(o[h][4] * qs, o[h][5] * qs, o[h][6] * qs, o[h][7] * qs);
                    *(u32x2*)((unsigned char*)Gout + (size_t)t * D + h * 512 + lane * 8) = q8; } }
        }
    }
}

__device__ __forceinline__ void ln2_phase(const bf16_t* Yp, const float* g1, const float* b1, const unsigned char* Y, const float* g, const float* bta, bf16_t* XB, float* out, unsigned char* XI, float* RS, int gw, int NGW, int lane) {
    float gg[16], bb[16];
#pragma unroll
    for (int h = 0; h < 2; ++h)
#pragma unroll
        for (int q = 0; q < 2; ++q) { const f32x4 t = *(const f32x4*)(g + h * 512 + lane * 8 + q * 4), s = *(const f32x4*)(bta + h * 512 + lane * 8 + q * 4);
#pragma unroll
            for (int i = 0; i < 4; ++i) { gg[h * 8 + q * 4 + i] = t[i]; bb[h * 8 + q * 4 + i] = s[i]; } }
    float sXb = 0.f, rsXb = 0.f; if constexpr (!I8P) { const float lb = ln_bound(g, bta, lane); sXb = F8MAX / lb; rsXb = lb * (1.0f / F8MAX); }
    for (int row = gw; row < M; row += NGW) {
        float v[16];
#pragma unroll
        for (int h = 0; h < 2; ++h) { const v4u xr = *(const v4u*)(Yp + (size_t)row * D + h * 512 + lane * 8);
#pragma unroll
            for (int q = 0; q < 4; ++q) { v[h * 8 + q * 2] = bf_lo(xr[q]); v[h * 8 + q * 2 + 1] = bf_hi(xr[q]); } }
        { float s1 = 0.f;
#pragma unroll
          for (int i = 0; i < 16; ++i) s1 += v[i];
          const float m1 = wave_sum(s1) * (1.f / D); float q1 = 0.f;
#pragma unroll
          for (int i = 0; i < 16; ++i) { v[i] -= m1; q1 += v[i] * v[i]; }
          const float r1 = ALPHA / sqrtf(wave_sum(q1) * (1.f / D) + LN_EPS);
#pragma unroll
          for (int h = 0; h < 2; ++h)
#pragma unroll
            for (int q = 0; q < 2; ++q) { const f32x4 t = *(const f32x4*)(g1 + h * 512 + lane * 8 + q * 4), u = *(const f32x4*)(b1 + h * 512 + lane * 8 + q * 4);
#pragma unroll
              for (int i = 0; i < 4; ++i) v[h * 8 + q * 4 + i] = v[h * 8 + q * 4 + i] * r1 * t[i] + ALPHA * u[i]; } }
#pragma unroll
        for (int k = 0; k < 4; ++k)
#pragma unroll
            for (int h = 0; h < 2; ++h) { typedef unsigned u32x2 __attribute__((ext_vector_type(2))); const u32x2 yr = *(const u32x2*)(Y + ((size_t)row * 4 + k) * D + h * 512 + lane * 8);
#pragma unroll
                for (int q = 0; q < 2; ++q) { const f32x2 lo = __builtin_amdgcn_cvt_pk_f32_fp8((int)yr[q], false), hi2 = __builtin_amdgcn_cvt_pk_f32_fp8((int)yr[q], true);
                    v[h * 8 + q * 4 + 0] += lo[0] * (1.0f / YSCALE); v[h * 8 + q * 4 + 1] += lo[1] * (1.0f / YSCALE); v[h * 8 + q * 4 + 2] += hi2[0] * (1.0f / YSCALE); v[h * 8 + q * 4 + 3] += hi2[1] * (1.0f / YSCALE); } }
        float s = 0.f;
#pragma unroll
        for (int i = 0; i < 16; ++i) s += v[i];
        const float mean = wave_sum(s) * (1.f / D); float s2 = 0.f;
#pragma unroll
        for (int i = 0; i < 16; ++i) { v[i] -= mean; s2 += v[i] * v[i]; }
        const float rstd = 1.f / sqrtf(wave_sum(s2) * (1.f / D) + LN_EPS);
#pragma unroll
        for (int i = 0; i < 16; ++i) v[i] = v[i] * rstd * gg[i] + bb[i];
        float sX = sXb, rsX = rsXb;
        if (I8P && XI) { float am = 0.f;
#pragma unroll
            for (int i = 0; i < 16; ++i) am = fmaxf(am, fabsf(v[i]));
#pragma unroll
            for (int o = 1; o < 64; o <<= 1) am = fmaxf(am, shx(am, o));
            sX = QMAXP / fmaxf(am, 1e-30f); rsX = am * (1.0f / QMAXP); }
#pragma unroll
        for (int h = 0; h < 2; ++h) { v4u ov; ov.x = cvt_pk_bf16(v[h * 8 + 0], v[h * 8 + 1]); ov.y = cvt_pk_bf16(v[h * 8 + 2], v[h * 8 + 3]); ov.z = cvt_pk_bf16(v[h * 8 + 4], v[h * 8 + 5]); ov.w = cvt_pk_bf16(v[h * 8 + 6], v[h * 8 + 7]);
            if (!out) *(v4u*)(XB + (size_t)row * D + h * 512 + lane * 8) = ov;
            if (XI) { typedef unsigned u32x2 __attribute__((ext_vector_type(2))); u32x2 q8; q8.x = pg8::pkq4<I8P>(v[h * 8 + 0] * sX, v[h * 8 + 1] * sX, v[h * 8 + 2] * sX, v[h * 8 + 3] * sX); q8.y = pg8::pkq4<I8P>(v[h * 8 + 4] * sX, v[h * 8 + 5] * sX, v[h * 8 + 6] * sX, v[h * 8 + 7] * sX);
                *(u32x2*)(XI + (size_t)row * D + h * 512 + lane * 8) = q8; if (h == 0 && lane == 0) RS[row] = rsX; }
            if (out) { *(f32x4*)(out + (size_t)row * D + h * 512 + lane * 8) = (f32x4){v[h * 8 + 0], v[h * 8 + 1], v[h * 8 + 2], v[h * 8 + 3]};
                       *(f32x4*)(out + (size_t)row * D + h * 512 + lane * 8 + 4) = (f32x4){v[h * 8 + 4], v[h * 8 + 5], v[h * 8 + 6], v[h * 8 + 7]}; } }
    }
}

constexpr int RT_PITCH = 2064, R_OFF_G = 32 * RT_PITCH, R_OFF_LG = R_OFF_G + 8192, R_OFF_CNT = R_OFF_LG + 8 * 16 * 33 * 4, R_OFF_SW = R_OFF_CNT + 256, R_LDS = R_OFF_SW + 256;
typedef __bf16 bf16x2_t __attribute__((ext_vector_type(2)));
__device__ __forceinline__ void router_phase(const bf16_t* Yp, const float* g, const float* bta, const bf16_t* RTg, const float* Wr, const float* rb, unsigned char* X8, int* lslot, float* lgate, unsigned* cnt,
                                             char* lds, int blk0, int G, int tid, int wave, int lane) {
    for (int i = tid; i < 32 * 128; i += 512) { const int e = i >> 7, c = i & 127; *(v4u*)(lds + e * RT_PITCH + c * 16) = *(const v4u*)(RTg + (size_t)e * 1024 + c * 8); }
    float* gl = (float*)(lds + R_OFF_G); float* bl = gl + 1024;
    for (int i = tid; i < 1024; i += 512) { gl[i] = g[i]; bl[i] = bta[i]; }
    float* LG = (float*)(lds + R_OFF_LG) + wave * (16 * 33);
    int* lcnt = (int*)(lds + R_OFF_CNT); int* lbase = lcnt + 32;
    float* sWl = (float*)(lds + R_OFF_SW); float* cBl = sWl + 32;
    __syncthreads();
#pragma unroll 1
    for (int j = 0; j < 4; ++j) { const int e = wave * 4 + j; float a = 0.f, c = 0.f;
#pragma unroll 4
        for (int i = 0; i < 16; ++i) { const int k = lane + 64 * i; a += __uint_as_float((unsigned)(*(const bf16_t*)(lds + e * RT_PITCH + k * 2)) << 16); c += bl[k] * Wr[(size_t)k * 32 + e]; }
        a = wave_sum(a); c = wave_sum(c); if (lane == 0) { sWl[e] = a; cBl[e] = c + rb[e]; } }
    const int t16 = lane & 15, kq = lane >> 4;
    const float sA = F8MAX / ln_bound(g, bta, lane);
#pragma unroll 1
    for (int blk = blk0; blk < M / 128; blk += G) {
        if (tid < 32) lcnt[tid] = 0;
        __syncthreads();
        int my_e, my_rank, my_slot; float my_gate;
        const int r0 = blk * 128 + wave * 16; const size_t rowoff = (size_t)(r0 + t16) * D + kq * 8;
        v4u yv[32];
#pragma unroll
        for (int kb = 0; kb < 32; ++kb) yv[kb] = *(const v4u*)(Yp + rowoff + kb * 32);
        f32x4 acc0 = {0.f, 0.f, 0.f, 0.f}, acc1 = {0.f, 0.f, 0.f, 0.f}, accs = {0.f, 0.f, 0.f, 0.f}, accq = {0.f, 0.f, 0.f, 0.f};
        const bf16x8 ones8 = {(short)0x3F80, (short)0x3F80, (short)0x3F80, (short)0x3F80, (short)0x3F80, (short)0x3F80, (short)0x3F80, (short)0x3F80};
#pragma unroll
        for (int kb = 0; kb < 32; ++kb) { const int c0 = kb * 32 + kq * 8;
            const bf16x8 w0 = *(const bf16x8*)(lds + t16 * RT_PITCH + c0 * 2), w1 = *(const bf16x8*)(lds + (16 + t16) * RT_PITCH + c0 * 2);
            const bf16x8 xb = __builtin_bit_cast(bf16x8, yv[kb]);
            acc0 = __builtin_amdgcn_mfma_f32_16x16x32_bf16(w0, xb, acc0, 0, 0, 0);
            acc1 = __builtin_amdgcn_mfma_f32_16x16x32_bf16(w1, xb, acc1, 0, 0, 0);
            accs = __builtin_amdgcn_mfma_f32_16x16x32_bf16(ones8, xb, accs, 0, 0, 0);
            accq = __builtin_amdgcn_mfma_f32_16x16x32_bf16(xb, xb, accq, 0, 0, 0); }
        const float s = accs[0];
        const int dsel = t16 & 3; float dq_ = dsel == 0 ? accq[0] : (dsel == 1 ? accq[1] : (dsel == 2 ? accq[2] : accq[3]));
        const float s2 = __int_as_float(__builtin_amdgcn_ds_bpermute(((t16 >> 2) * 16 + t16) << 2, __float_as_int(dq_)));
        const float mean = s * (1.f / D); const float var = fmaxf(s2 * (1.f / D) - mean * mean, 0.f);
        const float rstd = 1.f / sqrtf(var + LN_EPS);
        {
            float* lgr = LG + t16 * 33;
#pragma unroll
            for (int i = 0; i < 4; ++i) { const int e0 = kq * 4 + i, e1 = 16 + kq * 4 + i;
                lgr[e0] = rstd * (acc0[i] - mean * sWl[e0]) + cBl[e0]; lgr[e1] = rstd * (acc1[i] - mean * sWl[e1]) + cBl[e1]; }
            LDS_WAIT(); asm volatile("" ::: "memory");
            float t0 = -INFINITY, t1 = -INFINITY, t2 = -INFINITY, t3 = -INFINITY; int i0 = 0, i1 = 0, i2 = 0, i3 = 0;
#pragma unroll
            for (int e = 0; e < 32; ++e) { const float v = lgr[e];
                const bool c0 = v > t0, c1 = v > t1, c2 = v > t2, c3 = v > t3;
                t3 = c2 ? t2 : (c3 ? v : t3); i3 = c2 ? i2 : (c3 ? e : i3);
                t2 = c1 ? t1 : (c2 ? v : t2); i2 = c1 ? i1 : (c2 ? e : i2);
                t1 = c0 ? t0 : (c1 ? v : t1); i1 = c0 ? i0 : (c1 ? e : i1);
                t0 = c0 ? v : t0; i0 = c0 ? e : i0; }
            const float e1 = __expf(t1 - t0), e2 = __expf(t2 - t0), e3 = __expf(t3 - t0); const float inv = 1.f / (1.f + e1 + e2 + e3);
            const int ek = kq == 0 ? i0 : (kq == 1 ? i1 : (kq == 2 ? i2 : i3)); const float gk = (kq == 0 ? 1.f : (kq == 1 ? e1 : (kq == 2 ? e2 : e3))) * inv;
            my_e = ek; my_gate = gk; my_slot = (r0 + t16) * 4 + kq; my_rank = atomicAdd(&lcnt[ek], 1);
            LDS_WAIT(); asm volatile("" ::: "memory");
        }
        const float rs = rstd * sA;
#pragma unroll
        for (int kb = 0; kb < 32; ++kb) { const int c0 = kb * 32 + kq * 8; const v4u y = yv[kb];
            const f32x4 g0 = *(const f32x4*)(gl + c0) * rs, g1 = *(const f32x4*)(gl + c0 + 4) * rs, b0 = *(const f32x4*)(bl + c0) * sA, b1 = *(const f32x4*)(bl + c0 + 4) * sA;
            typedef unsigned u32x2 __attribute__((ext_vector_type(2))); u32x2 q8;
            q8.x = pg8::pk4_fp8((bf_lo(y.x) - mean) * g0[0] + b0[0], (bf_hi(y.x) - mean) * g0[1] + b0[1], (bf_lo(y.y) - mean) * g0[2] + b0[2], (bf_hi(y.y) - mean) * g0[3] + b0[3]);
            q8.y = pg8::pk4_fp8((bf_lo(y.z) - mean) * g1[0] + b1[0], (bf_hi(y.z) - mean) * g1[1] + b1[1], (bf_lo(y.w) - mean) * g1[2] + b1[2], (bf_hi(y.w) - mean) * g1[3] + b1[3]);
            *(u32x2*)(X8 + rowoff + kb * 32) = q8;
            asm volatile("" ::: "memory"); }
        __syncthreads();
        if (tid < 32) lbase[tid] = (int)__hip_atomic_fetch_add(cnt + tid * 64, (unsigned)lcnt[tid], RLX_AGENT);
        __syncthreads();
        { const int pos = lbase[my_e] + my_rank; lslot[(size_t)my_e * LCAP + pos] = my_slot; lgate[(size_t)my_e * LCAP + pos] = my_gate; }
        __syncthreads();
    }
}

__device__ __forceinline__ float attn_obound(const float* gsub, float osc, int lane) {
    float mg = fmaxf(fabsf(gsub[lane]), fabsf(gsub[64 + lane]));
#pragma unroll
    for (int o = 1; o < 64; o <<= 1) mg = fmaxf(mg, shx(mg, o));
    return 11.3137085f * mg * fabsf(osc);
}

constexpr int NWAVES = 8;
constexpr int N_PHASES = 1 + DEPTH * 7;
#ifndef REP_ATTN
#define REP_ATTN 1
#endif
#ifndef KREP_MOE
#define KREP_MOE 1
#endif
#ifndef REP_MOE
#define REP_MOE 1
#endif
#ifndef REP_P0
#define REP_P0 1
#endif
#ifndef REP_THIN
#define REP_THIN 1
#endif
#ifndef REP_DENSE
#define REP_DENSE 1
#endif
#ifndef MK_SPLIT
#define MK_SPLIT 0
#endif
struct Args { const float* in[17]; float* out; unsigned char* ws; int ph_lo, ph_hi, li, pad; };
typedef const __attribute__((address_space(4))) Args* ArgsP;
enum { I_X = 0, I_RELB, I_AWIN, I_ALAM, I_ASUB, I_AWOUT, I_CWIN, I_CW, I_CWOUT, I_RW, I_RB, I_W1, I_B1, I_W2, I_B2, I_LNG, I_LNB };
__global__ void __launch_bounds__(NWAVES * 64, 2) mk_fwd(Args args) {
    extern __shared__ __attribute__((aligned(16))) unsigned char lds[];
    LAS unsigned char* ldsl = (LAS unsigned char*)lds;
    volatile LAS unsigned* MISC = (volatile LAS unsigned*)(ldsl + MISC_OFF);
    const int tid0 = threadIdx.x;
    const int wave0 = __builtin_amdgcn_readfirstlane(tid0 >> 6);
    const int G0 = gridDim.x, bx0 = blockIdx.x;
#define PHASE_BEGIN() int wv_ = wave0; asm volatile("" : "+s"(wv_)); int ln_; asm volatile("v_mbcnt_lo_u32_b32 %0, -1, 0\n\tv_mbcnt_hi_u32_b32 %0, -1, %0" : "=v"(ln_)); int tid = wv_ * 64 + ln_; int G = G0, bx = bx0; asm volatile("" : "+s"(G), "+s"(bx)); const int vcu = (G % 8 == 0) ? (bx % 8) * (G / 8) + bx / 8 : bx; const int NGW = G * NWAVES; \
        const int lane = tid & 63, wave = __builtin_amdgcn_readfirstlane(tid >> 6); const int gw = vcu * NWAVES + wave; (void)lane; (void)gw; (void)NGW; \
        ArgsP ap = (ArgsP)__builtin_amdgcn_kernarg_segment_ptr(); asm volatile("" : "+s"(ap)); unsigned char* ws = ap->ws; gu32* ctl = (gu32*)(ws + WS_CTL); (void)ctl
    for (int u = tid0; u < (LDS_BYTES - LDSCTL_OFF) / 4; u += NWAVES * 64) ((LAS unsigned*)(ldsl + LDSCTL_OFF))[u] = 0u;
    __syncthreads();
    XcdBarrier bar = xcd_barrier_post((unsigned*)(args.ws + WS_CTL) + CW_BAR + (size_t)args.li * 4096, MISC + 8);
    const int lo = args.ph_lo, hi = args.ph_hi;
#define IN(k) (lo <= (k) && (k) < hi)
#define SEAM(k) do { if (IN((k) + 1)) xcd_barrier(bar); } while (0)
    LAS int* tb = (LAS int*)(ldsl + LDSCTL_OFF); LAS int* cn = tb + 64;

    if (IN(0)) { PHASE_BEGIN();
        Ptrs P; P.x = ap->in[I_X]; P.attn_w_in = ap->in[I_AWIN]; P.attn_w_out = ap->in[I_AWOUT]; P.conv_w_in = ap->in[I_CWIN]; P.conv_w_out = ap->in[I_CWOUT]; P.router_w = ap->in[I_RW]; P.ln_g = ap->in[I_LNG]; P.w1 = ap->in[I_W1]; P.w2 = ap->in[I_W2]; P.ws = ws;
        _Pragma("unroll 1") for (int rep = 0; rep < REP_P0; ++rep) p0_prologue(P, ldsl, gw, NGW, wave, lane); SEAM(0); }

#define MOE_GEMMS(L, pb) do { \
            if (IN((pb) + 4)) { PHASE_BEGIN(); \
                pg8::MoeProb<true, true> S{(const char*)(ws + WS_X8), (const char*)(ws + WS_W1) + (size_t)(L) * 32 * 2048 * 1024, (size_t)2048 * 1024, 8, G, vcu, (int)tb[32], tb, cn, (const int*)(ws + WS_LS), lane, tid}; \
                pg8::EpiMoe1 E{ws + WS_A2, ap->in[I_B1] + (size_t)(L) * 32 * 2048, (const float*)(ws + WS_S1) + (size_t)(L) * 32 * 2048, ln_bound(ap->in[I_LNG] + ((L) * 2 + 0) * D, ap->in[I_LNB] + ((L) * 2 + 0) * D, lane) * (1.0f / F8MAX) * (1.0f / KREP_MOE)}; \
                pg8::gemm_phase<pg8::MoeProb<true, true>, pg8::EpiMoe1, true, true, KREP_MOE>(ldsl + RING_OFF, ldsl + XL_OFF, S, E); \
                SEAM((pb) + 4); \
            } \
            if (IN((pb) + 5)) { PHASE_BEGIN(); \
                pg8::MoeProb<false, true> S{(const char*)(ws + WS_A2), (const char*)(ws + WS_W2) + (size_t)(L) * 32 * 1024 * 1024, (size_t)1024 * 1024, 4, G, vcu, (int)tb[32], tb, cn, (const int*)(ws + WS_LS), lane, tid}; \
                pg8::EpiMoe2 E{ws + WS_Y, ap->in[I_B2] + (size_t)(L) * 32 * 1024, (const float*)(ws + WS_S2) + (size_t)(L) * 32 * 1024, (const int*)(ws + WS_LS), (const float*)(ws + WS_LG)}; \
                pg8::gemm_phase<pg8::MoeProb<false, true>, pg8::EpiMoe2, true, true, KREP_MOE>(ldsl + RING_OFF, ldsl + XL_OFF, S, E); \
                SEAM((pb) + 5); \
            } \
        } while (0)
#if REP_MOE == 2
#define MOE_GEMMS_REP(L, pb) MOE_GEMMS(L, pb)
#else
#define MOE_GEMMS_REP(L, pb) do {} while (0)
#endif
#define MOE_HALF(L, pb) do { \
            if (IN((pb) + 3)) { PHASE_BEGIN(); \
                router_phase((const bf16_t*)(ws + WS_YP), ap->in[I_LNG] + ((L) * 2 + 0) * D, ap->in[I_LNB] + ((L) * 2 + 0) * D, (const bf16_t*)(ws + WS_WR) + (size_t)(L) * 32 * 1024, ap->in[I_RW] + (size_t)(L) * 1024 * 32, ap->in[I_RB] + (L) * 32, \
                             ws + WS_X8, (int*)(ws + WS_LS), (float*)(ws + WS_LG), (unsigned*)(ctl + CW_CNT) + (L) * 32 * 64, (char*)lds + RING_OFF, vcu, G, tid, wave, lane); \
                SEAM((pb) + 3); \
            } \
            if (IN((pb) + 4) || IN((pb) + 5)) { PHASE_BEGIN(); \
                if (tid < 64) { const int c_ = (lane < 32) ? (int)__hip_atomic_load(ctl + CW_CNT + ((L) * 32 + (lane & 31)) * 64, RLX_AGENT) : 0; const int t_ = (c_ + 255) >> 8; int p_ = t_; \
                    _Pragma("unroll") for (int o_ = 1; o_ < 32; o_ <<= 1) { const int q_ = __builtin_amdgcn_ds_bpermute((lane - o_) * 4, p_); if (lane >= o_) p_ += q_; } \
                    if (lane < 32) { cn[lane] = c_; tb[lane + 1] = p_; } if (lane == 0) tb[0] = 0; } \
                __syncthreads(); \
            } \
            MOE_GEMMS(L, pb); MOE_GEMMS_REP(L, pb); \
            if (REP_THIN == 2 && IN((pb) + 6)) { PHASE_BEGIN(); \
                ln2_phase((const bf16_t*)(ws + WS_YP), ap->in[I_LNG] + ((L) * 2 + 0) * D, ap->in[I_LNB] + ((L) * 2 + 0) * D, (const unsigned char*)(ws + WS_Y), ap->in[I_LNG] + ((L) * 2 + 1) * D, ap->in[I_LNB] + ((L) * 2 + 1) * D, (bf16_t*)(ws + WS_XB), ((L) == DEPTH - 1) ? ap->out : nullptr, ((((L) == 0) && (CM & 1)) || (((L) == 1) && (QM & 2)) || (((L) == 2) && (CM & 2))) ? ws + WS_XI : nullptr, (float*)(ws + WS_RS), gw, NGW, lane); \
            } \
            if (IN((pb) + 6)) { PHASE_BEGIN(); \
                ln2_phase((const bf16_t*)(ws + WS_YP), ap->in[I_LNG] + ((L) * 2 + 0) * D, ap->in[I_LNB] + ((L) * 2 + 0) * D, (const unsigned char*)(ws + WS_Y), ap->in[I_LNG] + ((L) * 2 + 1) * D, ap->in[I_LNB] + ((L) * 2 + 1) * D, (bf16_t*)(ws + WS_XB), ((L) == DEPTH - 1) ? ap->out : nullptr, ((((L) == 0) && (CM & 1)) || (((L) == 1) && (QM & 2)) || (((L) == 2) && (CM & 2))) ? ws + WS_XI : nullptr, (float*)(ws + WS_RS), gw, NGW, lane); \
                if ((pb) + 7 < N_PHASES) SEAM((pb) + 6); \
            } \
        } while (0)

#pragma unroll 1
    for (int lp = 0; lp < DEPTH / 2; ++lp) {
        {
            const int L = 2 * lp, pb = 1 + L * 7;
            if (IN(pb + 0)) {
                PHASE_BEGIN();
                if (QM == 3 || (QM != 0 && ((QM >> lp) & 1))) {
                pg8::DenseProbT<true> S; S.init(ws + WS_XI, ws + WS_WAI + (size_t)lp * 3072 * 1024, M, 3072, G, bx, tid);
                pg8::EpiQKV8 E{(bf16_t*)(ws + WS_Q), (size_t)(WS_K - WS_Q) / 2, QSCALE, (const float*)(ws + WS_SD) + lp * 3072, (const float*)(ws + WS_RS)};
                pg8::gemm_phase<pg8::DenseProbT<true>, pg8::EpiQKV8, true, true, 1, I8P>(ldsl + RING_OFF, ldsl + XL_OFF, S, E);
                } else {
                pg8::DenseProb S; S.init(ws + WS_XB, (const bf16_t*)(ws + WS_WA16) + (size_t)lp * 3072 * 1024, M, 3072, G, bx, tid);
                pg8::EpiQKV E{(bf16_t*)(ws + WS_Q), (size_t)(WS_K - WS_Q) / 2, QSCALE};
                pg8::gemm_phase<pg8::DenseProb, pg8::EpiQKV, true>(ldsl + RING_OFF, ldsl + XL_OFF, S, E);
                }
                SEAM(pb + 0);
            }
            if (IN(pb + 1)) {
                PHASE_BEGIN();
                const float* lf = ap->in[I_ALAM] + lp * 256;
                const float s1 = wave_sum(lf[lane] * lf[64 + lane]), s2 = wave_sum(lf[128 + lane] * lf[192 + lane]);
                const float lam_init = (lp == 0) ? 0.2f : (0.8f - 0.6f * 0.54881163609402643f);
                const float lam = __expf(s1) - __expf(s2) + lam_init;
                const bool o8 = (AOM == 3) || (AOM != 0 && ((AOM >> lp) & 1));
                const float oscl = o8 ? (1.0f - lam_init) * (F8MAX / attn_obound(ap->in[I_ASUB] + lp * 128, 1.0f - lam_init, lane)) : (1.0f - lam_init);
                int hprev = -1;
#pragma unroll 1
                for (int rep = 0; rep < REP_ATTN; ++rep)
#pragma unroll 1
                for (int i = 0; i < (BATCH * NH * 32) / 256; ++i) {
                    const int item = i * G + vcu;
                    if (item >= BATCH * NH * 32) break;
                    const int bh = item >> 5, qb = item & 31;
                    const bool newh = (i == 0) || ((bh & 7) != hprev); hprev = bh & 7;
                    att::attn_unit(bh >> 3, bh & 7, qb, (const bf16_t*)(ws + WS_Q), (const bf16_t*)(ws + WS_K), (const bf16_t*)(ws + WS_V), (bf16_t*)(ws + WS_O), lam, oscl,
                                   ap->in[I_ASUB] + lp * 128, ap->in[I_RELB], (char*)lds + RING_OFF, tid, newh, o8);
                    if (DEFER_W && lp == 0 && i == (vcu & 15)) {
                        Ptrs P; P.w1 = ap->in[I_W1]; P.w2 = ap->in[I_W2]; P.ws = ws;
                        int ln_s = lane; asm volatile("" : "+v"(ln_s));
                        _Pragma("unroll 1") for (int idx = vcu; idx < 3 * 32 * 96; idx += G) expert_strip(P, idx < 3 * 32 * 64 ? 32 * 64 + idx : 128 * 64 + 32 * 32 + (idx - 3 * 32 * 64), ldsl, wave, ln_s);
                        hprev = -1;
                    }
                }
                SEAM(pb + 1);
            }
            if (IN(pb + 2)) {
                PHASE_BEGIN();
                if ((AOM == 3) || (AOM != 0 && ((AOM >> lp) & 1))) {
                const float lam_init = (lp == 0) ? 0.2f : (0.8f - 0.6f * 0.54881163609402643f);
                pg8::DenseProbT<true> S; S.init(ws + WS_O, ws + WS_WAO8 + (size_t)lp * 1024 * 1024, M, 1024, G, bx, tid);
                pg8::EpiResid8<false> E{(const bf16_t*)(ws + WS_XB), (bf16_t*)(ws + WS_YP), (const float*)(ws + WS_SD + 24 * 1024) + lp * 1024, nullptr, attn_obound(ap->in[I_ASUB] + lp * 128, 1.0f - lam_init, lane) * (1.0f / F8MAX)};
                pg8::gemm_phase<pg8::DenseProbT<true>, pg8::EpiResid8<false>, true, true>(ldsl + RING_OFF, ldsl + XL_OFF, S, E);
                } else {
                pg8::DenseProb S; S.init(ws + WS_O, (const bf16_t*)(ws + WS_WAO) + (size_t)lp * 1024 * 1024, M, 1024, G, bx, tid);
                pg8::EpiResid E{(const bf16_t*)(ws + WS_XB), (bf16_t*)(ws + WS_YP)};
                pg8::gemm_phase<pg8::DenseProb, pg8::EpiResid, true>(ldsl + RING_OFF, ldsl + XL_OFF, S, E);
                }
                SEAM(pb + 2);
            }
            MOE_HALF(L, pb);
        }
        {
            const int L = 2 * lp + 1, pb = 1 + L * 7;
            if (IN(pb + 0)) {
                PHASE_BEGIN();
                if (CM == 3 || (CM != 0 && ((CM >> lp) & 1))) {
                pg8::DenseProbT<true> S; S.init(ws + WS_XI, ws + WS_WCI + (size_t)lp * 3072 * 1024, M, 3072, G, bx, tid);
                pg8::EpiConvIn8 E{(bf16_t*)(ws + WS_Q), (bf16_t*)(ws + WS_K), (const float*)(ws + WS_SD + 32 * 1024) + lp * 3072, (const float*)(ws + WS_RS)};
                pg8::gemm_phase<pg8::DenseProbT<true>, pg8::EpiConvIn8, true, true, 1, I8P>(ldsl + RING_OFF, ldsl + XL_OFF, S, E);
                } else {
                pg8::DenseProb S; S.init(ws + WS_XB, (const bf16_t*)(ws + WS_WC16) + (size_t)lp * 3072 * 1024, M, 3072, G, bx, tid);
                pg8::EpiConvIn E{(bf16_t*)(ws + WS_Q), (bf16_t*)(ws + WS_K)};
                pg8::gemm_phase<pg8::DenseProb, pg8::EpiConvIn, true>(ldsl + RING_OFF, ldsl + XL_OFF, S, E);
                }
                SEAM(pb + 0);
            }
            if (IN(pb + 1)) { PHASE_BEGIN(); conv_phase((const bf16_t*)(ws + WS_Q), (const bf16_t*)(ws + WS_K), ap->in[I_CW] + lp * 3 * D, (bf16_t*)(ws + WS_O), (float*)(ws + WS_RS), (COM == 3) || (COM != 0 && ((COM >> lp) & 1)), gw, NGW, lane); SEAM(pb + 1); }
            if (IN(pb + 2)) {
                PHASE_BEGIN();
                if ((COM == 3) || (COM != 0 && ((COM >> lp) & 1))) {
                pg8::DenseProbT<true> S; S.init(ws + WS_O, ws + WS_WCO8 + (size_t)lp * 1024 * 1024, M, 1024, G, bx, tid);
                pg8::EpiResid8<true> E{(const bf16_t*)(ws + WS_XB), (bf16_t*)(ws + WS_YP), (const float*)(ws + WS_SD + 56 * 1024) + lp * 1024, (const float*)(ws + WS_RS), 1.0f};
                pg8::gemm_phase<pg8::DenseProbT<true>, pg8::EpiResid8<true>, true, true, 1, I8P>(ldsl + RING_OFF, ldsl + XL_OFF, S, E);
                } else {
                pg8::DenseProb S; S.init(ws + WS_O, (const bf16_t*)(ws + WS_WCO) + (size_t)lp * 1024 * 1024, M, 1024, G, bx, tid);
                pg8::EpiResid E{(const bf16_t*)(ws + WS_XB), (bf16_t*)(ws + WS_YP)};
                pg8::gemm_phase<pg8::DenseProb, pg8::EpiResid, true>(ldsl + RING_OFF, ldsl + XL_OFF, S, E);
                }
                SEAM(pb + 2);
            }
            MOE_HALF(L, pb);
        }
    }
#undef IN
#undef SEAM
}

extern "C" void kernel_launch(void* const* d_in, const int* in_sizes, int n_in, void* d_out, int out_size, void* d_ws, size_t ws_size, hipStream_t stream) {
    static int grid = 0;
    if (grid == 0) {
        if (n_in != 17 || in_sizes[0] != M * D || out_size != M * D || ws_size < WS_END) {
            fprintf(stderr, "kernel_launch: shape mismatch: n_in %d in0 %d out %d ws %zu (need %zu)\n", n_in, n_in > 0 ? in_sizes[0] : -1, out_size, ws_size, (size_t)WS_END); grid = -1; return; }
        int dev = 0, cus = 0, per_cu = 0;
        if (hipGetDevice(&dev) != hipSuccess || hipDeviceGetAttribute(&cus, hipDeviceAttributeMultiprocessorCount, dev) != hipSuccess) { grid = -1; return; }
        if (hipFuncSetAttribute((const void*)mk_fwd, hipFuncAttributeMaxDynamicSharedMemorySize, LDS_BYTES) != hipSuccess) { fprintf(stderr, "kernel_launch: hipFuncSetAttribute failed\n"); grid = -1; return; }
        if (hipOccupancyMaxActiveBlocksPerMultiprocessor(&per_cu, (const void*)mk_fwd, NWAVES * 64, LDS_BYTES) != hipSuccess || per_cu < 1)
            fprintf(stderr, "kernel_launch: occupancy query reports %d workgroups per CU\n", per_cu);
        (void)hipGetLastError();
        grid = cus;
    }
    if (grid < 0) return;
    if (hipMemsetAsync((char*)d_ws + WS_CTL, 0, CTL_ZERO_BYTES, stream) != hipSuccess) { fprintf(stderr, "kernel_launch: memset failed\n"); return; }
    Args a{};
    for (int i = 0; i < 17; ++i) a.in[i] = (const float*)d_in[i];
    a.out = (float*)d_out; a.ws = (unsigned char*)d_ws; a.pad = 0;
#if MK_SPLIT
    for (int p = 0; p < N_PHASES; ++p) { a.ph_lo = p; a.ph_hi = p + 1; a.li = p; hipLaunchKernelGGL(mk_fwd, dim3(grid), dim3(NWAVES * 64), LDS_BYTES, stream, a); }
#else
    a.ph_lo = 0; a.ph_hi = N_PHASES; a.li = 0;
    hipLaunchKernelGGL(mk_fwd, dim3(grid), dim3(NWAVES * 64), LDS_BYTES, stream, a);
#endif
    const hipError_t le = hipPeekAtLastError();
    if (le != hipSuccess) fprintf(stderr, "kernel_launch: launch failed: %s\n", hipGetErrorName(le));
}
```

```cpp
#include <hip/hip_runtime.h>
#include <hip/hip_bf16.h>
#include <cstdio>
#include <cstdint>

constexpr int BATCH = 16, SEQ = 4096, D = 1024, M = BATCH * SEQ, DEPTH = 4, NH = 8, NE = 32, TOPK = 4;
constexpr float LN_EPS = 1e-5f;
constexpr float ALPHA = 1.6817928305074290f;
constexpr float LOG2E = 1.4426950408889634f;
constexpr float QSCALE = 0.125f * LOG2E;
constexpr int LCAP = 65536;
constexpr int MAXRT = 1056;

constexpr size_t MiB = 1ull << 20;
constexpr size_t WS_CTL = 0, CTL_ZERO_BYTES = 1 * MiB;
constexpr size_t WS_WAI = 1 * MiB;
constexpr size_t WS_WAO = WS_WAI + 12 * MiB;
constexpr size_t WS_WCI = WS_WAO + 4 * MiB;
constexpr size_t WS_WCO = WS_WCI + 12 * MiB;
constexpr size_t WS_WR  = WS_WCO + 4 * MiB;
constexpr size_t WS_W1  = WS_WR + 1 * MiB;
constexpr size_t WS_W2  = WS_W1 + 256 * MiB;
constexpr size_t WS_S1  = WS_W2 + 128 * MiB;
constexpr size_t WS_S2  = WS_S1 + 1 * MiB;
constexpr size_t WS_SD  = WS_S2 + 512 * 1024;
constexpr size_t WS_RS  = WS_SD + 64 * 1024;
constexpr size_t WS_XB  = WS_S2 + 1 * MiB;
constexpr size_t WS_XI  = WS_XB + 128 * MiB;
constexpr size_t WS_X8  = WS_XI + 128 * MiB;
constexpr size_t WS_YP  = WS_X8 + 64 * MiB;
constexpr size_t WS_Q   = WS_YP + 128 * MiB;
constexpr size_t WS_K   = WS_Q + 128 * MiB;
constexpr size_t WS_V   = WS_K + 128 * MiB;
constexpr size_t WS_O   = WS_V + 128 * MiB;
constexpr size_t WS_LS  = WS_O + 128 * MiB;
constexpr size_t WS_LG  = WS_LS + 8 * MiB;
constexpr size_t WS_A2  = WS_LG + 8 * MiB;
constexpr size_t WS_Y   = WS_A2 + 264 * MiB;
constexpr size_t WS_WA16 = WS_Y + 513 * MiB;
constexpr size_t WS_WC16 = WS_WA16 + 12 * MiB;
constexpr size_t WS_WAO8 = WS_WC16 + 12 * MiB;
constexpr size_t WS_WCO8 = WS_WAO8 + 2 * MiB;
constexpr size_t WS_END = WS_WCO8 + 2 * MiB;
#ifndef F8_QKV_MASK
#define F8_QKV_MASK 3
#endif
#ifndef F8_CONV_MASK
#define F8_CONV_MASK 3
#endif
#ifndef F8_AOUT_MASK
#define F8_AOUT_MASK 3
#endif
#ifndef F8_COUT_MASK
#define F8_COUT_MASK 3
#endif
constexpr int QM = F8_QKV_MASK, CM = F8_CONV_MASK, AOM = F8_AOUT_MASK, COM = F8_COUT_MASK;
constexpr int NA8 = (AOM & 1) + (AOM >> 1), NO8 = (COM & 1) + (COM >> 1), AJ0 = (AOM & 1) ? 0 : 1, OJ0 = (COM & 1) ? 0 : 1;
constexpr int NA16 = 2 - NA8, NO16 = 2 - NO8, AK0 = (AOM & 1) ? 1 : 0, OK0 = (COM & 1) ? 1 : 0;
constexpr int NQ8 = (QM & 1) + (QM >> 1), NC8 = (CM & 1) + (CM >> 1), QJ0 = (QM & 1) ? 0 : 1, CJ0 = (CM & 1) ? 0 : 1;
constexpr int NQ16 = 2 - NQ8, NC16 = 2 - NC8, QK0 = (QM & 1) ? 1 : 0, CK0 = (CM & 1) ? 1 : 0;
constexpr float F8MAX = 448.0f * 0.999f;
constexpr bool I8P = true;
constexpr float QMAXP = I8P ? 127.0f : 448.0f * 0.999f;
constexpr float YSCALE = 16.0f;
constexpr float A2SCALE = 8.0f;
constexpr int CW_TMO = 0, CW_CODE = 1;
constexpr int CW_BAR = 4096;
constexpr int CW_CNT = 16384;

constexpr int RING_OFF = 0, RING_BYTES = 131072;
constexpr int LDSCTL_OFF = RING_BYTES, MISC_OFF = LDSCTL_OFF + 1024;
constexpr int XL_OFF = LDSCTL_OFF + 4096;
constexpr int LDS_BYTES = 147456;

#define GAS __attribute__((address_space(1)))
#define LAS __attribute__((address_space(3)))
typedef unsigned short bf16_t;
typedef unsigned v4u __attribute__((ext_vector_type(4)));
typedef float f32x4 __attribute__((ext_vector_type(4)));
typedef float f32x2 __attribute__((ext_vector_type(2)));
typedef short bf16x8 __attribute__((ext_vector_type(8)));
typedef float f32x16 __attribute__((ext_vector_type(16)));
typedef short s16x4 __attribute__((ext_vector_type(4)));
typedef GAS unsigned gu32;
#define RLX_AGENT __ATOMIC_RELAXED, __HIP_MEMORY_SCOPE_AGENT
#define LDS_WAIT() asm volatile("s_waitcnt lgkmcnt(0)" ::: "memory")
#define VM_WAIT() asm volatile("s_waitcnt vmcnt(0)" ::: "memory")

__device__ __forceinline__ unsigned cvt_pk_bf16(float lo, float hi) { unsigned r; asm volatile("v_cvt_pk_bf16_f32 %0, %1, %2" : "=v"(r) : "v"(lo), "v"(hi)); return r; }
__device__ __forceinline__ float bf_lo(unsigned u) { return __uint_as_float(u << 16); }
__device__ __forceinline__ float bf_hi(unsigned u) { return __uint_as_float(u & 0xffff0000u); }
__device__ __forceinline__ int lane_local() { int l; asm volatile("v_mbcnt_lo_u32_b32 %0, -1, 0\n\tv_mbcnt_hi_u32_b32 %0, -1, %0" : "=v"(l)); return l; }
__device__ __forceinline__ float shx(float v, int m, int l) { return __int_as_float(__builtin_amdgcn_ds_bpermute((l ^ m) << 2, __float_as_int(v))); }
__device__ __forceinline__ float shx(float v, int m) { return shx(v, m, lane_local()); }
__device__ __forceinline__ float wave_sum(float v) {
    const int l_ = lane_local();
#pragma unroll
    for (int o = 1; o < 64; o <<= 1) v += shx(v, o, l_);
    return v;
}

#ifndef KREP_MOE
#define KREP_MOE 1
#endif
namespace pg8 {
constexpr float KREP_MOE_ = (float)KREP_MOE;
#define PG8_LAS __attribute__((address_space(3)))
constexpr int BM = 256, BK = 64, HALF = 128, HTB = HALF * BK * 2, STAGE_BYTES = 8 * HTB, NXCD = 8, WGM = 8, KD = 1024, NTK = KD / BK;

__host__ __device__ __forceinline__ int lds_byte(int r, int c) { const int st = (r >> 4) * 2 + (c >> 5), rr = r & 15, cc = c & 31, ob = rr * 64 + cc * 2; return st * 1024 + (ob ^ (((ob >> 9) & 1) << 5)); }
__host__ __device__ __forceinline__ void stage_rc(int b, int& R, int& C) { const int st = b / 1024, sb = b % 1024, swz = sb ^ (((sb >> 9) & 1) << 5); R = (st >> 1) * 16 + swz / 64; C = (st & 1) * 32 + (swz % 64) / 2; }
__host__ __device__ __forceinline__ int perm32(int rho) { const int n = rho >> 4, i = rho & 15; return 8 * (i >> 2) + 4 * n + (i & 3); }

struct Unit { int pm, pn, e, valid, lr0; };
__device__ __forceinline__ void dma1k(const void* src, PG8_LAS unsigned char* dst, int lane) {
    __builtin_amdgcn_global_load_lds((const __attribute__((address_space(1))) unsigned*)((const char*)src + lane * 16), (PG8_LAS unsigned*)dst, 16, 0, 0);
}
constexpr int XL_EPI = 4096, XL_GATHER = 1024, XL_BYTES = 2 * (XL_EPI + XL_GATHER);

template <bool F8> struct DenseProbT {
    static constexpr bool GATHER = false;
    static constexpr int RP = F8 ? 1024 : 2048;
    const char* A; const char* Bt; int nM, nN, nwg, G, c, tid;
    __device__ void init(const void* A_, const void* Bt_, int Mrows, int N, int G_, int c_, int tid_) { A = (const char*)A_; Bt = (const char*)Bt_; nM = Mrows / BM; nN = N / BM; nwg = nM * nN; G = G_; c = c_; tid = tid_; }
    __device__ __forceinline__ bool next(int i, Unit& u) const {
        const long L = (long)i * G + c; if (L >= nwg) return false;
        int wgid = (int)L; { const int q = nwg / NXCD, r = nwg % NXCD, xcd = wgid % NXCD, off = wgid / NXCD; wgid = (xcd < r ? xcd * (q + 1) : r * (q + 1) + (xcd - r) * q) + off; }
        const int nig = WGM * nN, gid = wgid / nig, fm = gid * WGM, gsz = (nM - fm) < WGM ? (nM - fm) : WGM;
        u.pm = fm + ((wgid % nig) % gsz); u.pn = (wgid % nig) / gsz; u.e = 0; u.valid = 256; u.lr0 = 0; return true;
    }
    __device__ __forceinline__ void a_off(const Unit& u, const int (&RA)[2], const int (&CA)[2], unsigned (&vo)[2][2]) const {
#pragma unroll
        for (int h = 0; h < 2; ++h)
#pragma unroll
            for (int i = 0; i < 2; ++i) vo[h][i] = (unsigned)((u.pm * BM + h * HALF + RA[i]) * RP + CA[i] * 2);
    }
    __device__ __forceinline__ unsigned a_tile(const Unit& u) const { return (unsigned)u.pm * (unsigned)(BM * RP); }
    __device__ __forceinline__ unsigned b_off(const Unit& u) const { return (unsigned)u.pn * (unsigned)(BM * RP); }    __device__ __forceinline__ void dma_rows(const Unit&, PG8_LAS unsigned char*, int, int) const {}
    __device__ __forceinline__ void a_off_lds(const Unit&, const int (&)[2], const int (&)[2], const PG8_LAS unsigned char*, unsigned (&)[2][2]) const {}
};
typedef DenseProbT<false> DenseProb;

template <bool GATHER_, bool F8> struct MoeProb {
    static constexpr bool GATHER = GATHER_;
    static constexpr int RP = F8 ? 1024 : 2048;
    const char* A; const char* Bt; size_t b_estride; int nN, G, v, RT; const PG8_LAS int* tb; const PG8_LAS int* cn; const int* lslot; int lane, tid;
    __device__ __forceinline__ bool next(int i, Unit& u) const {
        const int L = i * G + v; if (L >= RT * nN) return false;
        const int rt = L / nN; u.pm = rt; u.pn = L - rt * nN;
        const unsigned long long bal = __ballot(lane < 32 && rt >= tb[(lane & 31) + 1]);
        const int e = __builtin_amdgcn_readfirstlane(__popcll(bal)); u.e = e;
        const int tb_e = __builtin_amdgcn_readfirstlane(tb[e]), cn_e = __builtin_amdgcn_readfirstlane(cn[e]);
        u.lr0 = 256 * (rt - tb_e); const int rem = cn_e - u.lr0; u.valid = rem < 256 ? rem : 256; return true;
    }
    __device__ __forceinline__ void a_off(const Unit& u, const int (&RA)[2], const int (&CA)[2], unsigned (&vo)[2][2]) const {
        if constexpr (GATHER) {
            const int* ls = lslot + (size_t)u.e * LCAP + u.lr0;
#pragma unroll
            for (int h = 0; h < 2; ++h)
#pragma unroll
                for (int i = 0; i < 2; ++i) { const int rl = h * HALF + RA[i]; const int slot = ls[rl < u.valid ? rl : 0]; vo[h][i] = (unsigned)((slot >> 2) * RP + CA[i] * 2); }
        } else {
#pragma unroll
            for (int h = 0; h < 2; ++h)
#pragma unroll
                for (int i = 0; i < 2; ++i) vo[h][i] = (unsigned)((u.pm * BM + h * HALF + RA[i]) * RP + CA[i] * 2);
        }
    }
    __device__ __forceinline__ unsigned a_tile(const Unit& u) const { return (unsigned)u.pm * (unsigned)(BM * RP); }
    __device__ __forceinline__ unsigned b_off(const Unit& u) const { return (unsigned)u.e * (unsigned)b_estride + (unsigned)u.pn * (unsigned)(BM * RP); }
    __device__ __forceinline__ void dma_rows(const Unit& u, PG8_LAS unsigned char* dst, int wid, int lane_) const { if constexpr (GATHER) { if (wid == 0) dma1k(lslot + (size_t)u.e * LCAP + u.lr0, dst, lane_); } }
    __device__ __forceinline__ void a_off_lds(const Unit& u, const int (&RA)[2], const int (&CA)[2], const PG8_LAS unsigned char* src, unsigned (&vo)[2][2]) const {
        if constexpr (GATHER) { const PG8_LAS int* ls = (const PG8_LAS int*)src;
#pragma unroll
            for (int h = 0; h < 2; ++h)
#pragma unroll
                for (int i = 0; i < 2; ++i) { const int rl = h * HALF + RA[i]; const int slot = ls[rl < u.valid ? rl : 0]; vo[h][i] = (unsigned)((slot >> 2) * RP + CA[i] * 2); } }
    }
};

__device__ __forceinline__ v4u pack8(const f32x4 v0, const f32x4 v1) { v4u w; w.x = cvt_pk_bf16(v0[0], v0[1]); w.y = cvt_pk_bf16(v0[2], v0[3]); w.z = cvt_pk_bf16(v1[0], v1[1]); w.w = cvt_pk_bf16(v1[2], v1[3]); return w; }

__device__ __forceinline__ void st16(void* base, unsigned off, v4u v) { *(v4u*)((char*)base + off) = v; }
struct EpiQKV {
    __device__ __forceinline__ void dma(const Unit&, PG8_LAS unsigned char*, int, int) const {}
    bf16_t* O; size_t stride; float scale0;
    __device__ __forceinline__ void operator()(const f32x4 (&acc)[2][2][4][2], const Unit& u, int wr, int wc, int fr_, int fq_, const PG8_LAS unsigned char* xl) const {
        int fr = fr_, fq = fq_; asm volatile("" : "+v"(fr), "+v"(fq));
        const int row0 = u.pm * BM + wr * 64 + fr; const int t = u.pn >> 2; const int colt = (u.pn & 3) * BM;
        bf16_t* base = O + (size_t)t * stride; const float sc = (t == 0) ? scale0 : 1.f; const unsigned off0 = (unsigned)(row0 * D + colt + wc * 32 + 8 * fq) * 2u;
#pragma unroll
        for (int ai = 0; ai < 2; ++ai)
#pragma unroll
            for (int m = 0; m < 4; ++m)
#pragma unroll
                for (int bj = 0; bj < 2; ++bj) st16(base, off0 + (unsigned)((ai * HALF + m * 16) * D + bj * HALF) * 2u, pack8(acc[ai][bj][m][0] * sc, acc[ai][bj][m][1] * sc));
    }
};
struct EpiConvIn {
    __device__ __forceinline__ void dma(const Unit&, PG8_LAS unsigned char*, int, int) const {}
    bf16_t* GB; bf16_t* Z;
    __device__ __forceinline__ void operator()(const f32x4 (&acc)[2][2][4][2], const Unit& u, int wr, int wc, int fr_, int fq_, const PG8_LAS unsigned char* xl) const {
        int fr = fr_, fq = fq_; asm volatile("" : "+v"(fr), "+v"(fq));
        const int row0 = u.pm * BM + wr * 64 + fr;
        if (u.pn < 4) { const unsigned off0 = (unsigned)(row0 * D + u.pn * BM + wc * 32 + 8 * fq) * 2u;
#pragma unroll
            for (int ai = 0; ai < 2; ++ai)
#pragma unroll
                for (int m = 0; m < 4; ++m)
#pragma unroll
                    for (int bj = 0; bj < 2; ++bj) st16(GB, off0 + (unsigned)((ai * HALF + m * 16) * D + bj * HALF) * 2u, pack8(acc[ai][bj][m][0], acc[ai][bj][m][1]));
        } else { const unsigned off0 = (unsigned)(row0 * D + (u.pn - 4) * HALF + wc * 32 + 8 * fq) * 2u;
#pragma unroll
            for (int ai = 0; ai < 2; ++ai)
#pragma unroll
                for (int m = 0; m < 4; ++m) st16(Z, off0 + (unsigned)((ai * HALF + m * 16) * D) * 2u, pack8(acc[ai][0][m][0] * acc[ai][1][m][0], acc[ai][0][m][1] * acc[ai][1][m][1]));
        }
    }
};
struct EpiQKV8 {
    bf16_t* O; size_t stride; float scale0; const float* sw; const float* rs;
    __device__ __forceinline__ void dma(const Unit& u, PG8_LAS unsigned char* xl, int wid, int lane) const {
        if (wid == 0) dma1k(sw + u.pn * BM, xl, lane); else if (wid == 1) dma1k(rs + u.pm * BM, xl + 1024, lane);
    }
    __device__ __forceinline__ void operator()(const f32x4 (&acc)[2][2][4][2], const Unit& u, int wr, int wc, int fr_, int fq_, const PG8_LAS unsigned char* xl) const {
        int fr = fr_, fq = fq_; asm volatile("" : "+v"(fr), "+v"(fq));
        const int row0 = u.pm * BM + wr * 64 + fr; const int t = u.pn >> 2; const int colt = (u.pn & 3) * BM; const int cl = wc * 32 + 8 * fq;
        bf16_t* base = O + (size_t)t * stride; const float sc = (t == 0) ? scale0 : 1.f; const unsigned off0 = (unsigned)(row0 * D + colt + cl) * 2u;
        const PG8_LAS float* sp = (const PG8_LAS float*)xl + cl; const PG8_LAS float* rp = (const PG8_LAS float*)(xl + 1024) + wr * 64 + fr;
        f32x4 sv[2][2];
#pragma unroll
        for (int bj = 0; bj < 2; ++bj)
#pragma unroll
            for (int n = 0; n < 2; ++n) sv[bj][n] = *(const PG8_LAS f32x4*)(sp + bj * HALF + 4 * n) * sc;
#pragma unroll
        for (int ai = 0; ai < 2; ++ai)
#pragma unroll
            for (int m = 0; m < 4; ++m) { const float r = rp[ai * HALF + m * 16];
#pragma unroll
                for (int bj = 0; bj < 2; ++bj) st16(base, off0 + (unsigned)((ai * HALF + m * 16) * D + bj * HALF) * 2u, pack8(acc[ai][bj][m][0] * (sv[bj][0] * r), acc[ai][bj][m][1] * (sv[bj][1] * r))); }
    }
};
struct EpiConvIn8 {
    bf16_t* GB; bf16_t* Z; const float* sw; const float* rs;
    __device__ __forceinline__ void dma(const Unit& u, PG8_LAS unsigned char* xl, int wid, int lane) const { if (wid == 0) dma1k(sw + u.pn * BM, xl, lane); else if (wid == 1) dma1k(rs + u.pm * BM, xl + 1024, lane); }
    __device__ __forceinline__ void operator()(const f32x4 (&acc)[2][2][4][2], const Unit& u, int wr, int wc, int fr_, int fq_, const PG8_LAS unsigned char* xl) const {
        int fr = fr_, fq = fq_; asm volatile("" : "+v"(fr), "+v"(fq));
        const int row0 = u.pm * BM + wr * 64 + fr; const int cl = wc * 32 + 8 * fq;
        const PG8_LAS float* sp = (const PG8_LAS float*)xl + cl; const PG8_LAS float* rp = (const PG8_LAS float*)(xl + 1024) + wr * 64 + fr;
        f32x4 sv[2][2];
#pragma unroll
        for (int bj = 0; bj < 2; ++bj)
#pragma unroll
            for (int n = 0; n < 2; ++n) sv[bj][n] = *(const PG8_LAS f32x4*)(sp + bj * HALF + 4 * n);
        if (u.pn < 4) { const unsigned off0 = (unsigned)(row0 * D + u.pn * BM + cl) * 2u;
#pragma unroll
            for (int ai = 0; ai < 2; ++ai)
#pragma unroll
                for (int m = 0; m < 4; ++m) { const float r = rp[ai * HALF + m * 16];
#pragma unroll
                    for (int bj = 0; bj < 2; ++bj) st16(GB, off0 + (unsigned)((ai * HALF + m * 16) * D + bj * HALF) * 2u, pack8(acc[ai][bj][m][0] * (sv[bj][0] * r), acc[ai][bj][m][1] * (sv[bj][1] * r))); }
        } else { const unsigned off0 = (unsigned)(row0 * D + (u.pn - 4) * HALF + cl) * 2u;
            const f32x4 sz0 = sv[0][0] * sv[1][0], sz1 = sv[0][1] * sv[1][1];
#pragma unroll
            for (int ai = 0; ai < 2; ++ai)
#pragma unroll
                for (int m = 0; m < 4; ++m) { const float r = rp[ai * HALF + m * 16], r2 = r * r;
                    st16(Z, off0 + (unsigned)((ai * HALF + m * 16) * D) * 2u, pack8(acc[ai][0][m][0] * acc[ai][1][m][0] * (sz0 * r2), acc[ai][0][m][1] * acc[ai][1][m][1] * (sz1 * r2))); }
        }
    }
};
struct EpiResid {
    __device__ __forceinline__ void dma(const Unit&, PG8_LAS unsigned char*, int, int) const {}
    const bf16_t* X; bf16_t* Yp;
    __device__ __forceinline__ void operator()(const f32x4 (&acc)[2][2][4][2], const Unit& u, int wr, int wc, int fr_, int fq_, const PG8_LAS unsigned char* xl) const {
        int fr = fr_, fq = fq_; asm volatile("" : "+v"(fr), "+v"(fq));
        const unsigned off0 = (unsigned)((u.pm * BM + wr * 64 + fr) * D + u.pn * BM + wc * 32 + 8 * fq) * 2u;
#pragma unroll
        for (int ai = 0; ai < 2; ++ai)
#pragma unroll
            for (int m = 0; m < 4; ++m)
#pragma unroll
                for (int bj = 0; bj < 2; ++bj) { const unsigned off = off0 + (unsigned)((ai * HALF + m * 16) * D + bj * HALF) * 2u; const v4u xr = *(const v4u*)((const char*)X + off);
                    f32x4 v0 = acc[ai][bj][m][0], v1 = acc[ai][bj][m][1];
                    v0[0] += ALPHA * bf_lo(xr.x); v0[1] += ALPHA * bf_hi(xr.x); v0[2] += ALPHA * bf_lo(xr.y); v0[3] += ALPHA * bf_hi(xr.y);
                    v1[0] += ALPHA * bf_lo(xr.z); v1[1] += ALPHA * bf_hi(xr.z); v1[2] += ALPHA * bf_lo(xr.w); v1[3] += ALPHA * bf_hi(xr.w);
                    st16(Yp, off, pack8(v0, v1)); }
    }
};
template <bool ROWS> struct EpiResid8 {
    const bf16_t* X; bf16_t* Yp; const float* sw; const float* rs; float rsc;
    __device__ __forceinline__ void dma(const Unit& u, PG8_LAS unsigned char* xl, int wid, int lane) const {
        if (wid == 0) dma1k(sw + u.pn * BM, xl, lane); else if (ROWS && wid == 1) dma1k(rs + u.pm * BM, xl + 1024, lane);
    }
    __device__ __forceinline__ void operator()(const f32x4 (&acc)[2][2][4][2], const Unit& u, int wr, int wc, int fr_, int fq_, const PG8_LAS unsigned char* xl) const {
        int fr = fr_, fq = fq_; asm volatile("" : "+v"(fr), "+v"(fq));
        const int cl = wc * 32 + 8 * fq;
        const unsigned off0 = (unsigned)((u.pm * BM + wr * 64 + fr) * D + u.pn * BM + cl) * 2u;
        const PG8_LAS float* sp = (const PG8_LAS float*)xl + cl; const PG8_LAS float* rp = (const PG8_LAS float*)(xl + 1024) + wr * 64 + fr;
        f32x4 sv[2][2];
#pragma unroll
        for (int bj = 0; bj < 2; ++bj)
#pragma unroll
            for (int n = 0; n < 2; ++n) sv[bj][n] = *(const PG8_LAS f32x4*)(sp + bj * HALF + 4 * n) * (ROWS ? 1.0f : rsc);
#pragma unroll
        for (int ai = 0; ai < 2; ++ai)
#pragma unroll
            for (int m = 0; m < 4; ++m) { float r = 1.0f; if (ROWS) r = rp[ai * HALF + m * 16];
#pragma unroll
                for (int bj = 0; bj < 2; ++bj) { const unsigned off = off0 + (unsigned)((ai * HALF + m * 16) * D + bj * HALF) * 2u; const v4u xr = *(const v4u*)((const char*)X + off);
                    f32x4 v0 = acc[ai][bj][m][0] * sv[bj][0], v1 = acc[ai][bj][m][1] * sv[bj][1]; if (ROWS) { v0 *= r; v1 *= r; }
                    v0[0] += ALPHA * bf_lo(xr.x); v0[1] += ALPHA * bf_hi(xr.x); v0[2] += ALPHA * bf_lo(xr.y); v0[3] += ALPHA * bf_hi(xr.y);
                    v1[0] += ALPHA * bf_lo(xr.z); v1[1] += ALPHA * bf_hi(xr.z); v1[2] += ALPHA * bf_lo(xr.w); v1[3] += ALPHA * bf_hi(xr.w);
                    st16(Yp, off, pack8(v0, v1)); } }
    }
};
__device__ __forceinline__ unsigned pk4_fp8(float a, float b, float c, float d) { int p = 0; p = __builtin_amdgcn_cvt_pk_fp8_f32(a, b, p, false); p = __builtin_amdgcn_cvt_pk_fp8_f32(c, d, p, true); return (unsigned)p; }
__device__ __forceinline__ unsigned pk4_i8(float a, float b, float c, float d) {
    unsigned r = 0;
    r = __builtin_amdgcn_cvt_pk_u8_f32(__builtin_rintf(a + 128.f), 0, r); r = __builtin_amdgcn_cvt_pk_u8_f32(__builtin_rintf(b + 128.f), 1, r);
    r = __builtin_amdgcn_cvt_pk_u8_f32(__builtin_rintf(c + 128.f), 2, r); r = __builtin_amdgcn_cvt_pk_u8_f32(__builtin_rintf(d + 128.f), 3, r);
    return r ^ 0x80808080u;
}
template <bool I8> __device__ __forceinline__ unsigned pkq4(float a, float b, float c, float d) { if constexpr (I8) return pk4_i8(a, b, c, d); else return pk4_fp8(a, b, c, d); }
__device__ __forceinline__ f32x2 swiglu8_pk(f32x2 g, f32x2 l8) {
    g.x = fminf(g.x, 7.0f); g.y = fminf(g.y, 7.0f);
    l8.x = fminf(fmaxf(l8.x, -56.0f), 56.0f); l8.y = fminf(fmaxf(l8.y, -56.0f), 56.0f);
    const f32x2 t = g * (-1.702f * LOG2E);
    f32x2 e; e.x = __builtin_amdgcn_exp2f(t.x); e.y = __builtin_amdgcn_exp2f(t.y);
    const f32x2 d = e + 1.0f;
    f32x2 r; r.x = __builtin_amdgcn_rcpf(d.x); r.y = __builtin_amdgcn_rcpf(d.y);
    return (g * r) * (l8 + A2SCALE);
}
struct EpiMoe1 {
    unsigned char* A2; const float* b1; const float* sw; float inv_sa;
    __device__ __forceinline__ void dma(const Unit& u, PG8_LAS unsigned char* xl, int wid, int lane) const {
        if (wid == 0) dma1k(b1 + (size_t)u.e * 2048 + u.pn * BM, xl, lane); else if (wid == 1) dma1k(sw + (size_t)u.e * 2048 + u.pn * BM, xl + 1024, lane);
    }
    __device__ __forceinline__ void operator()(const f32x4 (&acc)[2][2][4][2], const Unit& u, int wr, int wc, int fr_, int fq_, const PG8_LAS unsigned char* xl) const {
        int fr = fr_, fq = fq_; asm volatile("" : "+v"(fr), "+v"(fq));
        const int cl = wc * 32 + 8 * fq; const unsigned off0 = (unsigned)((u.pm * BM + wr * 64 + fr) * D + u.pn * HALF + cl);
        const PG8_LAS float* bp = (const PG8_LAS float*)xl + 2 * cl; f32x4 bb[4];
#pragma unroll
        for (int j = 0; j < 4; ++j) bb[j] = *(const PG8_LAS f32x4*)(bp + 4 * j);
        const PG8_LAS float* sp = (const PG8_LAS float*)(xl + 1024) + cl;
        const f32x4 sg0 = *(const PG8_LAS f32x4*)(sp) * inv_sa, sg1 = *(const PG8_LAS f32x4*)(sp + 4) * inv_sa;
        const f32x4 sl0 = *(const PG8_LAS f32x4*)(sp + HALF) * (inv_sa * A2SCALE), sl1 = *(const PG8_LAS f32x4*)(sp + HALF + 4) * (inv_sa * A2SCALE);
        f32x2 sgp[4] = {{sg0[0], sg0[1]}, {sg0[2], sg0[3]}, {sg1[0], sg1[1]}, {sg1[2], sg1[3]}}, slp[4] = {{sl0[0], sl0[1]}, {sl0[2], sl0[3]}, {sl1[0], sl1[1]}, {sl1[2], sl1[3]}};
        f32x2 bgp[4], blp[4];
#pragma unroll
        for (int q = 0; q < 4; ++q) { bgp[q] = (f32x2){bb[q][0], bb[q][2]}; blp[q] = (f32x2){bb[q][1] * A2SCALE, bb[q][3] * A2SCALE}; }
        const unsigned offp = off0 + ((fq & 1) ? (unsigned)(16 * D - 8) : 0u);
#pragma unroll
        for (int ai = 0; ai < 2; ++ai)
#pragma unroll
            for (int mp = 0; mp < 2; ++mp) { typedef unsigned u32x2 __attribute__((ext_vector_type(2))); u32x2 w[2];
#pragma unroll
                for (int mm = 0; mm < 2; ++mm) { const int m = 2 * mp + mm; f32x2 o[4];
#pragma unroll
                    for (int q = 0; q < 4; ++q) { const f32x4 ga = acc[ai][0][m][q >> 1], la = acc[ai][1][m][q >> 1]; const int h2 = (q & 1) * 2;
                        const f32x2 g = (f32x2){ga[h2], ga[h2 + 1]} * sgp[q] + bgp[q], l8 = (f32x2){la[h2], la[h2 + 1]} * slp[q] + blp[q];
                        o[q] = swiglu8_pk(g, l8); }
                    w[mm].x = pk4_fp8(o[0].x, o[0].y, o[1].x, o[1].y); w[mm].y = pk4_fp8(o[2].x, o[2].y, o[3].x, o[3].y); }
                const auto sx = __builtin_amdgcn_permlane16_swap(w[0].x, w[1].x, false, false); const auto sy = __builtin_amdgcn_permlane16_swap(w[0].y, w[1].y, false, false);
                const v4u ov = {sx[0], sy[0], sx[1], sy[1]};
                *(v4u*)(A2 + (offp + (unsigned)((ai * HALF + mp * 32) * D))) = ov; }
    }
};
struct EpiMoe2 {
    unsigned char* Y; const float* b2; const float* sw; const int* lslot; const float* lgate;
    __device__ __forceinline__ void dma(const Unit& u, PG8_LAS unsigned char* xl, int wid, int lane) const {
        const size_t lb = (size_t)u.e * LCAP + u.lr0;
        if (wid == 0) dma1k(b2 + (size_t)u.e * 1024 + u.pn * BM, xl, lane); else if (wid == 1) dma1k(sw + (size_t)u.e * 1024 + u.pn * BM, xl + 1024, lane);
        else if (wid == 2) dma1k(lslot + lb, xl + 2048, lane); else if (wid == 3) dma1k(lgate + lb, xl + 3072, lane);
    }
    __device__ __forceinline__ void operator()(const f32x4 (&acc)[2][2][4][2], const Unit& u, int wr, int wc, int fr_, int fq_, const PG8_LAS unsigned char* xl) const {
        int fr = fr_, fq = fq_; asm volatile("" : "+v"(fr), "+v"(fq));
        const int rl0 = wr * 64 + fr, cl = wc * 32 + 8 * fq, col0 = u.pn * BM + cl;
        const PG8_LAS float* bp = (const PG8_LAS float*)xl + cl; const PG8_LAS float* sp = (const PG8_LAS float*)(xl + 1024) + cl; f32x4 bv[2][2], sv[2][2];
#pragma unroll
        for (int bj = 0; bj < 2; ++bj)
#pragma unroll
            for (int n = 0; n < 2; ++n) { bv[bj][n] = *(const PG8_LAS f32x4*)(bp + bj * HALF + 4 * n); sv[bj][n] = *(const PG8_LAS f32x4*)(sp + bj * HALF + 4 * n) * (1.0f / (A2SCALE * KREP_MOE_)); }
        const PG8_LAS int* sl = (const PG8_LAS int*)(xl + 2048); const PG8_LAS float* gl = (const PG8_LAS float*)(xl + 3072);
        const unsigned cadj = (unsigned)(u.pn * BM + ((fq & 1) ? (HALF + cl - 8) : cl));
#pragma unroll
        for (int ai = 0; ai < 2; ++ai)
#pragma unroll
            for (int m = 0; m < 4; ++m) { const int rl = rl0 + ai * HALF + m * 16;
                const bool ok = rl < u.valid; const int slot = ok ? sl[rl] : M * 4; const float g = gl[rl] * YSCALE;
                typedef unsigned u32x2 __attribute__((ext_vector_type(2))); u32x2 w[2];
#pragma unroll
                for (int bj = 0; bj < 2; ++bj) { f32x4 v0 = (acc[ai][bj][m][0] * sv[bj][0] + bv[bj][0]) * g, v1 = (acc[ai][bj][m][1] * sv[bj][1] + bv[bj][1]) * g;
#pragma unroll
                    for (int i = 0; i < 4; ++i) { v0[i] = fminf(fmaxf(v0[i], -448.0f), 448.0f); v1[i] = fminf(fmaxf(v1[i], -448.0f), 448.0f); }
                    w[bj].x = pk4_fp8(v0[0], v0[1], v0[2], v0[3]); w[bj].y = pk4_fp8(v1[0], v1[1], v1[2], v1[3]); }
                const auto sx = __builtin_amdgcn_permlane16_swap(w[0].x, w[1].x, false, false); const auto sy = __builtin_amdgcn_permlane16_swap(w[0].y, w[1].y, false, false);
                const v4u o = {sx[0], sy[0], sx[1], sy[1]};
                *(v4u*)(Y + ((unsigned)(slot * D) + cadj)) = o; }
    }
};

typedef int v8i_t __attribute__((ext_vector_type(8))); typedef int v4i_t __attribute__((ext_vector_type(4)));
__device__ __forceinline__ v8i_t cat8(bf16x8 lo, bf16x8 hi) { const v4i_t a = __builtin_bit_cast(v4i_t, lo), b = __builtin_bit_cast(v4i_t, hi); return __builtin_shufflevector(a, b, 0, 1, 2, 3, 4, 5, 6, 7); }
template <class Prob, class Epi, bool ALIGN_EPI, bool F8 = false, int KREP = 1, bool I8 = false>
__device__ __forceinline__ void gemm_phase(PG8_LAS unsigned char* lds, PG8_LAS unsigned char* xl, const Prob& P, const Epi& E) {
    int tid_ = P.tid; asm volatile("" : "+v"(tid_));
    const int tid = tid_, wid = __builtin_amdgcn_readfirstlane(tid >> 6), lane = tid & 63, wr = wid >> 2, wc = wid & 3, fr = lane & 15, fq = lane >> 4;
    constexpr int RP = F8 ? 1024 : 2048, nt = F8 ? 8 : NTK;
    constexpr bool GA = Prob::GATHER;
    int RA[2], CA[2]; unsigned voffB[2], voffA[2];
#pragma unroll
    for (int i = 0; i < 2; ++i) { int R, C; stage_rc(tid * 16 + i * 8192, R, C); const int Rb = (R & ~31) + perm32(R & 31); RA[i] = R; CA[i] = C; voffB[i] = (unsigned)(Rb * RP + C * 2); voffA[i] = (unsigned)(R * RP + C * 2); }
    constexpr unsigned kstep = (unsigned)(BK * 2);
    constexpr unsigned hstep = (unsigned)HALF * RP;
    const unsigned ldsw = (unsigned)wid * 1024u;
    const int aoff = lds_byte(wr * 64 + fr, fq * 8), boff = lds_byte(wc * 32 + fr, fq * 8);
    typedef const __attribute__((address_space(1))) unsigned* gptr_t;
#define PG8_SA(b, h) (((b) * 2 + (h)) * HTB)
#define PG8_SB(b, h) ((4 + (b) * 2 + (h)) * HTB)
#define PG8_STAGE_B(bufoff, uoff) do { _Pragma("unroll") for (int _i = 0; _i < 2; ++_i) \
        __builtin_amdgcn_global_load_lds((gptr_t)(Bb + (voffB[_i] + (unsigned)(uoff))), (PG8_LAS unsigned*)(lds + (bufoff) + ldsw + _i * 8192), 16, 0, 0); } while (0)
#define PG8_STAGE_A(bufoff, koff, h, NX) do { _Pragma("unroll") for (int _i = 0; _i < 2; ++_i) { unsigned _o; \
        if constexpr (GA) _o = ((NX) ? vn[h][_i] : vc[h][_i]) + (unsigned)(koff); else _o = voffA[_i] + (((NX) ? nAo : cAo) + (unsigned)(h) * hstep + (unsigned)(koff)); \
        __builtin_amdgcn_global_load_lds((gptr_t)(Ab + _o), (PG8_LAS unsigned*)(lds + (bufoff) + ldsw + _i * 8192), 16, 0, 0); } } while (0)
#define PG8_LDA(dst, b, h) do { _Pragma("unroll") for (int m = 0; m < 4; ++m) _Pragma("unroll") for (int k = 0; k < 2; ++k) dst[m][k] = *(const PG8_LAS bf16x8*)(lds + PG8_SA(b, h) + aoff + m * 2048 + k * 1024); } while (0)
#define PG8_LDB(dst, b, h) do { _Pragma("unroll") for (int n = 0; n < 2; ++n) _Pragma("unroll") for (int k = 0; k < 2; ++k) dst[n][k] = *(const PG8_LAS bf16x8*)(lds + PG8_SB(b, h) + boff + n * 2048 + k * 1024); } while (0)
#define PG8_MMA(ai, bj, At, Bt) do { __builtin_amdgcn_s_setprio(1); _Pragma("unroll") for (int m = 0; m < 4; ++m) _Pragma("unroll") for (int n = 0; n < 2; ++n) _Pragma("unroll") for (int k = 0; k < 2; ++k) \
        acc[ai][bj][m][n] = __builtin_amdgcn_mfma_f32_16x16x32_bf16(Bt[n][k], At[m][k], acc[ai][bj][m][n], 0, 0, 0); __builtin_amdgcn_s_setprio(0); } while (0)
#define PG8_MMA8(ai, bj, At, Bt) do { __builtin_amdgcn_s_setprio(1); if constexpr (I8) { _Pragma("unroll") for (int k = 0; k < 2; ++k) _Pragma("unroll") for (int m = 0; m < 4; ++m) _Pragma("unroll") for (int n = 0; n < 2; ++n) \
        asm volatile("v_mfma_i32_16x16x64_i8 %0, %1, %2, %0" : "+v"(acc[ai][bj][m][n]) : "v"(Bt[n][k]), "v"(At[m][k])); } else { _Pragma("unroll") for (int m = 0; m < 4; ++m) _Pragma("unroll") for (int n = 0; n < 2; ++n) \
        asm volatile("v_mfma_f32_16x16x128_f8f6f4 %0, %1, %2, %0" : "+v"(acc[ai][bj][m][n]) : "v"(cat8(Bt[n][0], Bt[n][1])), "v"(cat8(At[m][0], At[m][1]))); } __builtin_amdgcn_s_setprio(0); } while (0)
#define PG8_MMA8Z(ai, bj, At, Bt) do { __builtin_amdgcn_s_setprio(1); if constexpr (I8) { _Pragma("unroll") for (int m = 0; m < 4; ++m) _Pragma("unroll") for (int n = 0; n < 2; ++n) \
        asm volatile("v_mfma_i32_16x16x64_i8 %0, %1, %2, 0" : "=&v"(acc[ai][bj][m][n]) : "v"(Bt[n][0]), "v"(At[m][0])); _Pragma("unroll") for (int m = 0; m < 4; ++m) _Pragma("unroll") for (int n = 0; n < 2; ++n) \
        asm volatile("v_mfma_i32_16x16x64_i8 %0, %1, %2, %0" : "+v"(acc[ai][bj][m][n]) : "v"(Bt[n][1]), "v"(At[m][1])); } else { _Pragma("unroll") for (int m = 0; m < 4; ++m) _Pragma("unroll") for (int n = 0; n < 2; ++n) \
        asm volatile("v_mfma_f32_16x16x128_f8f6f4 %0, %1, %2, 0" : "=&v"(acc[ai][bj][m][n]) : "v"(cat8(Bt[n][0], Bt[n][1])), "v"(cat8(At[m][0], At[m][1]))); } __builtin_amdgcn_s_setprio(0); } while (0)
#define PG8_MM(ai, bj, At, Bt) do { if constexpr (F8) PG8_MMA8(ai, bj, At, Bt); else PG8_MMA(ai, bj, At, Bt); } while (0)
#define PG8_MM2(FIRST, ai, At) do { if constexpr (F8) { if (FIRST) { PG8_MMA8Z(ai, 0, At, B0); PG8_MMA8Z(ai, 1, At, B1); } else { PG8_MMA8(ai, 0, At, B0); PG8_MMA8(ai, 1, At, B1); } } else { PG8_MMA(ai, 0, At, B0); PG8_MMA(ai, 1, At, B1); } } while (0)
#define PG8_WAIT_V(n) asm volatile("s_waitcnt vmcnt(" #n ")" ::: "memory")
#define PG8_WAIT_L(n) asm volatile("s_waitcnt lgkmcnt(" #n ")" ::: "memory")
#define PG8_BAR __builtin_amdgcn_s_barrier()
#define PG8_SCHED __builtin_amdgcn_sched_barrier(0)
    Unit cur, nxt; int ui = 0;
    if (!P.next(0, cur)) return;
    f32x4 acc[2][2][4][2];
    if constexpr (!F8) {
#pragma unroll
    for (int a = 0; a < 2; ++a)
#pragma unroll
        for (int b = 0; b < 2; ++b)
#pragma unroll
            for (int m = 0; m < 4; ++m)
#pragma unroll
                for (int n = 0; n < 2; ++n) acc[a][b][m][n] = (f32x4){0.f, 0.f, 0.f, 0.f};
    }
    bf16x8 At[4][2], B0[2][2], B1[2][2];
    unsigned vc[2][2], vn[2][2]; unsigned cAo = 0, nAo = 0;
    if constexpr (GA) { P.a_off(cur, RA, CA, vc); vn[0][0] = vc[0][0]; vn[0][1] = vc[0][1]; vn[1][0] = vc[1][0]; vn[1][1] = vc[1][1]; } else { cAo = P.a_tile(cur); nAo = cAo; vc[0][0] = vn[0][0] = 0; }
    const char* const Ab = P.A; const char* const Bb = P.Bt; unsigned cBo = P.b_off(cur), nBo = cBo;
    PG8_STAGE_B(PG8_SB(0, 0), cBo); PG8_STAGE_B(PG8_SB(0, 1), cBo + hstep); PG8_STAGE_A(PG8_SA(0, 0), 0u, 0, false); PG8_STAGE_A(PG8_SA(0, 1), 0u, 1, false);
    if (wr == 1) PG8_BAR;
    PG8_WAIT_V(2); PG8_BAR;
    PG8_STAGE_B(PG8_SB(1, 0), cBo + kstep); PG8_STAGE_A(PG8_SA(1, 0), kstep, 0, false); PG8_STAGE_B(PG8_SB(1, 1), cBo + hstep + kstep);
    PG8_WAIT_V(6); PG8_BAR;
    for (;;) {
        const bool has_next = P.next(ui + 1, nxt);
        PG8_LAS unsigned char* const xe = xl + (ui & 1) * XL_EPI;
        PG8_LAS unsigned char* const xg = xl + 2 * XL_EPI + ((ui + 1) & 1) * XL_GATHER;
        E.dma(cur, xe, wid, lane);
        if (has_next) { if constexpr (GA) P.dma_rows(nxt, xg, wid, lane); else nAo = P.a_tile(nxt); nBo = P.b_off(nxt); }
        else { nAo = cAo; nBo = cBo; }
#pragma unroll 1
        for (int rep = 0; rep < KREP; ++rep)
#pragma unroll 1
        for (int t = 0; t < nt; t += 2) {
            const bool lastt = (t == nt - 2); const bool last = lastt && (rep == KREP - 1); const bool first = (t == 0) && (rep == 0); (void)first;
            if constexpr (GA) { if (last) { if (has_next) P.a_off_lds(nxt, RA, CA, xg, vn); else { vn[0][0] = vc[0][0]; vn[0][1] = vc[0][1]; vn[1][0] = vc[1][0]; vn[1][1] = vc[1][1]; } } }
            const unsigned k1 = (unsigned)(t + 1) * kstep;
            const unsigned k2 = lastt ? 0u : (unsigned)(t + 2) * kstep, k3 = k2 + kstep;
            const unsigned b2 = (last ? nBo : cBo) + k2, b3 = b2 + kstep;
            PG8_LDB(B0, 0, 0); PG8_LDB(B1, 0, 1); PG8_SCHED; PG8_LDA(At, 0, 0); PG8_STAGE_A(PG8_SA(1, 1), k1, 1, false);
            PG8_WAIT_V(8); PG8_WAIT_L(0); PG8_BAR; PG8_MM2(first, 0, At); PG8_BAR; PG8_SCHED;
            PG8_LDA(At, 0, 1); PG8_STAGE_B(PG8_SB(0, 0), b2); PG8_STAGE_B(PG8_SB(0, 1), b2 + hstep); PG8_STAGE_A(PG8_SA(0, 0), k2, 0, last);
            PG8_WAIT_V(8); PG8_WAIT_L(0); PG8_BAR; PG8_MM2(first, 1, At); PG8_BAR; PG8_SCHED;
            PG8_LDB(B0, 1, 0); PG8_LDB(B1, 1, 1); PG8_SCHED; PG8_LDA(At, 1, 0); PG8_STAGE_A(PG8_SA(0, 1), k2, 1, last);
            PG8_WAIT_V(8); PG8_WAIT_L(0); PG8_BAR; PG8_MM(0, 0, At, B0); PG8_MM(0, 1, At, B1); PG8_BAR; PG8_SCHED;
            PG8_LDA(At, 1, 1); PG8_STAGE_B(PG8_SB(1, 0), b3); PG8_STAGE_B(PG8_SB(1, 1), b3 + hstep); PG8_STAGE_A(PG8_SA(1, 0), k3, 0, last);
            PG8_WAIT_V(8); PG8_WAIT_L(0); PG8_BAR; PG8_MM(1, 0, At, B0); PG8_MM(1, 1, At, B1); PG8_BAR; PG8_SCHED;
        }
        if constexpr (ALIGN_EPI) { if (wr == 0) PG8_BAR; }
        if constexpr (F8) asm volatile("s_nop 15\n\ts_nop 7" ::: "memory");
        if constexpr (I8) {
#pragma unroll
            for (int a = 0; a < 2; ++a)
#pragma unroll
                for (int b = 0; b < 2; ++b)
#pragma unroll
                    for (int m = 0; m < 4; ++m)
#pragma unroll
                        for (int n = 0; n < 2; ++n)
#pragma unroll
                            for (int i = 0; i < 4; ++i) acc[a][b][m][n][i] = (float)__float_as_int(acc[a][b][m][n][i]);
        }
        E(acc, cur, wr, wc, fr, fq, xe);
        if (!has_next) break;
        if constexpr (!F8)
#pragma unroll
        for (int a = 0; a < 2; ++a)
#pragma unroll
            for (int b = 0; b < 2; ++b)
#pragma unroll
                for (int m = 0; m < 4; ++m)
#pragma unroll
                    for (int n = 0; n < 2; ++n) acc[a][b][m][n] = (f32x4){0.f, 0.f, 0.f, 0.f};
        cur = nxt; cBo = nBo; cAo = nAo; ++ui;
        if constexpr (GA) { vc[0][0] = vn[0][0]; vc[0][1] = vn[0][1]; vc[1][0] = vn[1][0]; vc[1][1] = vn[1][1]; }
        if constexpr (ALIGN_EPI) { if (wr == 1) PG8_BAR; }
    }
    PG8_WAIT_V(0);
    if constexpr (!ALIGN_EPI) { if (wr == 0) PG8_BAR; }
    PG8_BAR;
#undef PG8_SA
#undef PG8_SB
#undef PG8_STAGE_A
#undef PG8_STAGE_B
#undef PG8_LDA
#undef PG8_LDB
#undef PG8_MMA
#undef PG8_MMA8
#undef PG8_MM
#undef PG8_MM2
#undef PG8_MMA8Z
#undef PG8_WAIT_V
#undef PG8_WAIT_L
#undef PG8_BAR
#undef PG8_SCHED
}
}

namespace att {
constexpr int QBLK = 32, KVBLK = 64, LDX = 1024, NT = SEQ / KVBLK;
constexpr int SHM_V = KVBLK * 128 * 2, SHM_K = KVBLK * 128 * 2, NSLOT = 3;
constexpr int OFF_V = 0, OFF_K = NSLOT * SHM_V, OFF_WS = NSLOT * (SHM_V + SHM_K), OFF_TBL = OFF_WS + 8 * 64 * 4, ATT_LDS = OFF_TBL + 2048;
constexpr float THR2 = 8.0f * LOG2E;
#define KSWZ(row, colB) ((row) * 256 + ((colB) ^ (((row) & 7) << 4)))
#define SBAR() __builtin_amdgcn_sched_barrier(0)
__device__ __forceinline__ int crow(int r, int hi) { return (r & 3) + 8 * (r >> 2) + 4 * hi; }
__device__ __forceinline__ int v_st(int k, int c) { const int kk = (k & ~0xC) | ((k & 4) << 1) | ((k & 8) >> 1); return ((kk >> 3) * 4 + (c >> 5)) * 512 + ((kk & 7) * 32 + (c & 31)) * 2; }
__device__ __forceinline__ int v_rd_base(int lane) { return ((lane & 3) << 3) | (((lane >> 2) & 3) << 6) | (((lane >> 4) & 1) << 5) | (((lane >> 5) & 1) << 8); }
constexpr int v_rd_off(int d0, int ks, int half) { return d0 * 512 + ks * 4096 + half * 2048; }
template <int OFF> __device__ __forceinline__ s16x4 tr_read(int vb) { s16x4 r; asm volatile("ds_read_b64_tr_b16 %0, %1 offset:%2" : "=&v"(r) : "v"(vb), "i"(OFF) : "memory"); return r; }
#define ATT_RD8(L, H, D0) do { \
    asm volatile("ds_read_b64_tr_b16 %0, %1 offset:%2" : "=&v"(L[0]) : "v"(vb), "i"(v_rd_off(D0, 0, 0)) : "memory"); asm volatile("ds_read_b64_tr_b16 %0, %1 offset:%2" : "=&v"(H[0]) : "v"(vb), "i"(v_rd_off(D0, 0, 1)) : "memory"); \
    asm volatile("ds_read_b64_tr_b16 %0, %1 offset:%2" : "=&v"(L[1]) : "v"(vb), "i"(v_rd_off(D0, 1, 0)) : "memory"); asm volatile("ds_read_b64_tr_b16 %0, %1 offset:%2" : "=&v"(H[1]) : "v"(vb), "i"(v_rd_off(D0, 1, 1)) : "memory"); \
    asm volatile("ds_read_b64_tr_b16 %0, %1 offset:%2" : "=&v"(L[2]) : "v"(vb), "i"(v_rd_off(D0, 2, 0)) : "memory"); asm volatile("ds_read_b64_tr_b16 %0, %1 offset:%2" : "=&v"(H[2]) : "v"(vb), "i"(v_rd_off(D0, 2, 1)) : "memory"); \
    asm volatile("ds_read_b64_tr_b16 %0, %1 offset:%2" : "=&v"(L[3]) : "v"(vb), "i"(v_rd_off(D0, 3, 0)) : "memory"); asm volatile("ds_read_b64_tr_b16 %0, %1 offset:%2" : "=&v"(H[3]) : "v"(vb), "i"(v_rd_off(D0, 3, 1)) : "memory"); } while (0)
#define ATT_PK(L, H) (bf16x8){L[0], L[1], L[2], L[3], H[0], H[1], H[2], H[3]}
#define ATT_MM4(OD, L, H) do { OD = __builtin_amdgcn_mfma_f32_32x32x16_bf16(pa0, ATT_PK(L[0], H[0]), OD, 0, 0, 0); OD = __builtin_amdgcn_mfma_f32_32x32x16_bf16(pa1, ATT_PK(L[1], H[1]), OD, 0, 0, 0); \
    OD = __builtin_amdgcn_mfma_f32_32x32x16_bf16(pa2, ATT_PK(L[2], H[2]), OD, 0, 0, 0); OD = __builtin_amdgcn_mfma_f32_32x32x16_bf16(pa3, ATT_PK(L[3], H[3]), OD, 0, 0, 0); } while (0)
__device__ __forceinline__ void pv_d0(f32x16* o, int vb, bf16x8 pa0, bf16x8 pa1, bf16x8 pa2, bf16x8 pa3) {
  s16x4 la[4], ha[4], lb[4], hb[4];
  ATT_RD8(la, ha, 0); ATT_RD8(lb, hb, 1);
  asm volatile("s_waitcnt lgkmcnt(8)" ::: "memory"); SBAR(); ATT_MM4(o[0], la, ha); SBAR();
  ATT_RD8(la, ha, 2);
  asm volatile("s_waitcnt lgkmcnt(8)" ::: "memory"); SBAR(); ATT_MM4(o[1], lb, hb); SBAR();
  ATT_RD8(lb, hb, 3);
  asm volatile("s_waitcnt lgkmcnt(8)" ::: "memory"); SBAR(); ATT_MM4(o[2], la, ha); SBAR();
  asm volatile("s_waitcnt lgkmcnt(0)" ::: "memory"); SBAR(); ATT_MM4(o[3], lb, hb);
  const bf16x8 ones = {(short)0x3F80, (short)0x3F80, (short)0x3F80, (short)0x3F80, (short)0x3F80, (short)0x3F80, (short)0x3F80, (short)0x3F80};
  o[4] = __builtin_amdgcn_mfma_f32_32x32x16_bf16(pa0, ones, o[4], 0, 0, 0); o[4] = __builtin_amdgcn_mfma_f32_32x32x16_bf16(pa1, ones, o[4], 0, 0, 0);
  o[4] = __builtin_amdgcn_mfma_f32_32x32x16_bf16(pa2, ones, o[4], 0, 0, 0); o[4] = __builtin_amdgcn_mfma_f32_32x32x16_bf16(pa3, ones, o[4], 0, 0, 0);
}
__device__ __forceinline__ void pv_softmax(f32x16* o, int vb, bf16x8 pa0, bf16x8 pa1, bf16x8 pa2, bf16x8 pa3, f32x16& p0, f32x16& p1, float& m_reg, float& alpha, bool& resc) {
  s16x4 la[4], ha[4], lb[4], hb[4];
  ATT_RD8(la, ha, 0); ATT_RD8(lb, hb, 1);
  asm volatile("s_waitcnt lgkmcnt(8)" ::: "memory"); SBAR();
  float a = fmaxf(fmaxf(p0[0], p0[1]), p1[0]), b = fmaxf(fmaxf(p0[2], p0[3]), p1[1]); a = fmaxf(fmaxf(a, p1[2]), p1[3]);
#pragma unroll
  for (int r = 4; r < 16; r += 4) { a = fmaxf(fmaxf(a, p0[r]), p0[r + 1]); b = fmaxf(fmaxf(b, p0[r + 2]), p0[r + 3]); a = fmaxf(fmaxf(a, p1[r]), p1[r + 1]); b = fmaxf(fmaxf(b, p1[r + 2]), p1[r + 3]); }
  float pmax = fmaxf(a, b);
  ATT_MM4(o[0], la, ha); SBAR();
  ATT_RD8(la, ha, 2);
  asm volatile("s_waitcnt lgkmcnt(8)" ::: "memory"); SBAR();
  { auto rr = __builtin_amdgcn_permlane32_swap(__float_as_uint(pmax), __float_as_uint(pmax), false, false);
    pmax = fmaxf(__uint_as_float(rr[0]), __uint_as_float(rr[1])); }
  resc = false; alpha = 1.f;
  if (__builtin_expect(!__all(pmax <= THR2), 0)) { const float dl = fmaxf(pmax, 0.f); m_reg += dl; alpha = __builtin_amdgcn_exp2f(-dl); resc = true;
#pragma unroll
    for (int r = 0; r < 16; ++r) { p0[r] -= dl; p1[r] -= dl; } }
  ATT_MM4(o[1], lb, hb); SBAR();
  ATT_RD8(lb, hb, 3);
  asm volatile("s_waitcnt lgkmcnt(8)" ::: "memory"); SBAR();
#pragma unroll
  for (int r = 0; r < 16; ++r) p0[r] = __builtin_amdgcn_exp2f(p0[r]);
  ATT_MM4(o[2], la, ha); SBAR();
  asm volatile("s_waitcnt lgkmcnt(0)" ::: "memory"); SBAR();
#pragma unroll
  for (int r = 0; r < 16; ++r) p1[r] = __builtin_amdgcn_exp2f(p1[r]);
  ATT_MM4(o[3], lb, hb);
  const bf16x8 ones = {(short)0x3F80, (short)0x3F80, (short)0x3F80, (short)0x3F80, (short)0x3F80, (short)0x3F80, (short)0x3F80, (short)0x3F80};
  o[4] = __builtin_amdgcn_mfma_f32_32x32x16_bf16(pa0, ones, o[4], 0, 0, 0); o[4] = __builtin_amdgcn_mfma_f32_32x32x16_bf16(pa1, ones, o[4], 0, 0, 0);
  o[4] = __builtin_amdgcn_mfma_f32_32x32x16_bf16(pa2, ones, o[4], 0, 0, 0); o[4] = __builtin_amdgcn_mfma_f32_32x32x16_bf16(pa3, ones, o[4], 0, 0, 0);
}
__device__ __forceinline__ void near_bias(f32x16& p0, f32x16& p1, int dq, const float* tbl) {
#pragma unroll
  for (int r = 0; r < 16; ++r) { const int c0 = (r & 3) + 8 * (r >> 2); p0[r] += tbl[dq + c0]; p1[r] += tbl[dq + c0 + 32]; }
}
__device__ __forceinline__ void qkt(f32x16& p0, f32x16& p1, const char* Ks, const bf16x8* qr, int r32, int hi, int mapB) {
  bf16x8 k0[4], k1[4];
#pragma unroll
  for (int d0 = 0; d0 < 4; ++d0) { const int cb = mapB + (d0 * 16 + hi * 8) * 2;
    k0[d0] = *reinterpret_cast<const bf16x8*>(Ks + KSWZ(r32, cb)); k1[d0] = *reinterpret_cast<const bf16x8*>(Ks + KSWZ(32 + r32, cb)); }
  p0 = f32x16{}; p1 = f32x16{};
#pragma unroll
  for (int d0 = 0; d0 < 4; ++d0) {
    p0 = __builtin_amdgcn_mfma_f32_32x32x16_bf16(k0[d0], qr[d0], p0, 0, 0, 0);
    p1 = __builtin_amdgcn_mfma_f32_32x32x16_bf16(k1[d0], qr[d0], p1, 0, 0, 0); }
}
__device__ __forceinline__ void qkt_seed(f32x16& p0, f32x16& p1, const char* Ks, const bf16x8* qr, const int (&koff)[4], const f32x16& seed) {
#pragma unroll
  for (int d0 = 0; d0 < 4; ++d0) {
    const bf16x8 b0 = *reinterpret_cast<const bf16x8*>(Ks + koff[d0]);
    const bf16x8 b1 = *reinterpret_cast<const bf16x8*>(Ks + koff[d0] + 8192);
    if (d0 == 0) { p0 = __builtin_amdgcn_mfma_f32_32x32x16_bf16(b0, qr[0], seed, 0, 0, 0); p1 = __builtin_amdgcn_mfma_f32_32x32x16_bf16(b1, qr[0], seed, 0, 0, 0); }
    else { p0 = __builtin_amdgcn_mfma_f32_32x32x16_bf16(b0, qr[d0], p0, 0, 0, 0); p1 = __builtin_amdgcn_mfma_f32_32x32x16_bf16(b1, qr[d0], p1, 0, 0, 0); } }
}
__device__ __forceinline__ void partialSM_seeded(f32x16& p0, f32x16& p1, float& m_reg, float& alpha, bool& resc, int mode, int dq, const float* tbl) {
  if (mode == 0) {
#pragma unroll
    for (int r = 0; r < 16; ++r) { const int c0 = (r & 3) + 8 * (r >> 2);
      p0[r] += tbl[dq + c0]; p1[r] += tbl[dq + c0 + 32]; }
  }
  float a = fmaxf(fmaxf(p0[0], p0[1]), p1[0]), b = fmaxf(fmaxf(p0[2], p0[3]), p1[1]); a = fmaxf(fmaxf(a, p1[2]), p1[3]);
#pragma unroll
  for (int r = 4; r < 16; r += 4) { a = fmaxf(fmaxf(a, p0[r]), p0[r + 1]); b = fmaxf(fmaxf(b, p0[r + 2]), p0[r + 3]); a = fmaxf(fmaxf(a, p1[r]), p1[r + 1]); b = fmaxf(fmaxf(b, p1[r + 2]), p1[r + 3]); }
  float pmax = fmaxf(a, b);
  { auto rr = __builtin_amdgcn_permlane32_swap(__float_as_uint(pmax), __float_as_uint(pmax), false, false);
    pmax = fmaxf(__uint_as_float(rr[0]), __uint_as_float(rr[1])); }
  resc = false; alpha = 1.f;
  if (__builtin_expect(!__all(pmax <= THR2), 0)) { const float dl = fmaxf(pmax, 0.f); m_reg += dl; alpha = __builtin_amdgcn_exp2f(-dl); resc = true;
#pragma unroll
    for (int r = 0; r < 16; ++r) { p0[r] -= dl; p1[r] -= dl; } }
#pragma unroll
  for (int r = 0; r < 16; ++r) p0[r] = __builtin_amdgcn_exp2f(p0[r]);
}
__device__ __forceinline__ void partialSM(f32x16& p0, f32x16& p1, float& m_reg, float& mn, float& alpha, int mode, float cL, float cR, int dq, const float* tbl) {
  float cadd;
  if (mode == 0) {
#pragma unroll
    for (int r = 0; r < 16; ++r) { const int c0 = (r & 3) + 8 * (r >> 2);
      p0[r] += tbl[dq + c0]; p1[r] += tbl[dq + c0 + 32]; }
    cadd = 0.f;
  } else cadd = (mode < 0) ? cL : cR;
  float pmax = p0[0];
#pragma unroll
  for (int r = 1; r < 16; ++r) pmax = fmaxf(pmax, p0[r]);
#pragma unroll
  for (int r = 0; r < 16; ++r) pmax = fmaxf(pmax, p1[r]);
  { auto rr = __builtin_amdgcn_permlane32_swap(__float_as_uint(pmax), __float_as_uint(pmax), false, false);
    pmax = fmaxf(__uint_as_float(rr[0]), __uint_as_float(rr[1])); }
  pmax += cadd;
  if (__builtin_expect(__all(pmax - m_reg <= THR2), 1)) { mn = m_reg; alpha = 1.f; }
  else { mn = fmaxf(m_reg, pmax); alpha = __builtin_amdgcn_exp2f(m_reg - mn); m_reg = mn; }
  const float sh = cadd - mn;
#pragma unroll
  for (int r = 0; r < 16; ++r) p0[r] += sh;
#pragma unroll
  for (int r = 0; r < 16; ++r) p1[r] += sh;
#pragma unroll
  for (int r = 0; r < 16; ++r) p0[r] = __builtin_amdgcn_exp2f(p0[r]);
}
__device__ __forceinline__ void finishSM(f32x16& p0, f32x16& p1, bf16x8& pa0, bf16x8& pa1, bf16x8& pa2, bf16x8& pa3) {
#define PK8(P, BASE, OUT) do { v4u w = {cvt_pk_bf16(P[BASE + 0], P[BASE + 1]), cvt_pk_bf16(P[BASE + 2], P[BASE + 3]), cvt_pk_bf16(P[BASE + 4], P[BASE + 5]), cvt_pk_bf16(P[BASE + 6], P[BASE + 7])}; OUT = *reinterpret_cast<bf16x8*>(&w); } while (0)
  PK8(p0, 0, pa0); PK8(p0, 8, pa1); PK8(p1, 0, pa2); PK8(p1, 8, pa3);
#undef PK8
}
__device__ __forceinline__ int rel_bucket(int rel) {
  const int n = rel < 0 ? -rel : rel; int b;
  if (n < 8) b = n; else if (n < 12) b = 8; else if (n < 16) b = 9; else if (n < 23) b = 10; else if (n < 32) b = 11; else if (n < 46) b = 12; else if (n < 64) b = 13; else if (n < 91) b = 14; else b = 15;
  return (rel > 0 ? 16 : 0) + b;
}

__device__ __forceinline__ void attn_unit(int b, int h, int qb, const bf16_t* __restrict__ Q, const bf16_t* __restrict__ K, const bf16_t* __restrict__ V, bf16_t* __restrict__ O,
                                          float lam, float osc, const float* __restrict__ g, const float* __restrict__ rel_bias, char* lds, int tid_in, bool build_tbl, bool o8) {
  int tid_ = tid_in; asm volatile("" : "+v"(tid_));
  const int tid = tid_, wid = __builtin_amdgcn_readfirstlane(tid >> 6), lane = tid & 63, r32 = lane & 31, hi = lane >> 5;
  const int map = wid & 1, jq = wid >> 1;
  char* V_lds = lds + OFF_V; char* K_lds = lds + OFF_K;
  float* ws = (float*)(lds + OFF_WS) + wid * 64; float* li_l = ws; float* al_l = ws + 32;
  float* tbl = (float*)(lds + OFF_TBL);
  if (build_tbl) tbl[tid] = rel_bias[rel_bucket(tid - 256) * NH + h] * LOG2E;
  const float cL = rel_bias[15 * NH + h] * LOG2E, cR = rel_bias[31 * NH + h] * LOG2E;
  const long rowbase = (long)b * SEQ; const int qs = qb * 128 + jq * QBLK;
  float m_reg = -1e30f; f32x16 o[5] = {}; bf16x8 qr[4];
  const bf16_t* Qw = Q + (rowbase + qs + r32) * LDX + h * 128 + map * 64 + hi * 8;
#pragma unroll
  for (int d0 = 0; d0 < 4; ++d0) qr[d0] = *reinterpret_cast<const bf16x8*>(Qw + d0 * 16);
  const bf16_t* Kh = K + rowbase * LDX + h * 128; const bf16_t* Vh = V + rowbase * LDX + h * 128;
  const int vb0 = (int)(uintptr_t)V_lds + v_rd_base(lane);
  const int mapB = map * 128;
  int koff[4];
#pragma unroll
  for (int d0 = 0; d0 < 4; ++d0) koff[d0] = KSWZ(r32, mapB + (d0 * 16 + hi * 8) * 2);
  const int dq0 = 256 + 4 * hi - (qs + r32);
  unsigned ksrc[2], vsrc[2];
#pragma unroll
  for (int i = 0; i < 2; ++i) { const int pk = wid + 8 * i;
    const int krow = 4 * pk + (lane >> 4), kc = (lane & 15) ^ (krow & 7); ksrc[i] = (unsigned)(krow * (LDX * 2) + kc * 16);
    const int st = 2 * pk + (lane >> 5), kk = (st >> 2) * 8 + ((lane & 31) >> 2), vk = kk  , vc = (st & 3) * 32 + (lane & 3) * 8;
    vsrc[i] = (unsigned)(vk * (LDX * 2) + vc * 2); }
  typedef const __attribute__((address_space(1))) unsigned* gptr_t; typedef __attribute__((address_space(3))) unsigned* lptr_t;
  const char* const Kg = (const char*)Kh; const char* const Vg = (const char*)Vh;
  const lptr_t kdst = (lptr_t)(__attribute__((address_space(3))) char*)(K_lds) + 0; (void)kdst;
#define DMA_TILE(t, slot) do { const unsigned tb_ = (unsigned)(t) * (unsigned)(KVBLK * LDX * 2); \
    _Pragma("unroll") for (int i_ = 0; i_ < 2; ++i_) { \
      __builtin_amdgcn_global_load_lds((gptr_t)(Kg + (ksrc[i_] + tb_)), (lptr_t)((__attribute__((address_space(3))) char*)K_lds + (slot) + (wid + 8 * i_) * 1024), 16, 0, 0); \
      __builtin_amdgcn_global_load_lds((gptr_t)(Vg + (vsrc[i_] + tb_)), (lptr_t)((__attribute__((address_space(3))) char*)V_lds + (slot) + (wid + 8 * i_) * 1024), 16, 0, 0); } } while (0)
#define WAIT_BAR() do { asm volatile("s_waitcnt vmcnt(0) lgkmcnt(0)" ::: "memory"); __builtin_amdgcn_s_barrier(); asm volatile("" ::: "memory"); } while (0)
#define RESC(a, rs) do { if (rs) { if (hi == 0) al_l[r32] = (a); asm volatile("s_waitcnt lgkmcnt(0)" ::: "memory"); \
    _Pragma("unroll") for (int d = 0; d < 5; ++d) _Pragma("unroll") for (int r = 0; r < 16; ++r) o[d][r] *= al_l[crow(r, hi)]; } } while (0)
#define SEED(md) do { const int md_ = (md); const float sv_ = (md_ == 0 ? 0.f : (md_ < 0 ? cL : cR)) - m_reg; _Pragma("unroll") for (int r = 0; r < 16; ++r) seed[r] = sv_; } while (0)
#define TMODE(k0) (((k0) >= qs + 122) ? 1 : (((k0) <= qs - 154) ? -1 : 0))
#define ROT() do { const int t_ = sl_prev; sl_prev = sl_cur; sl_cur = sl_next; sl_next = t_; } while (0)
  f32x16 pA0, pA1, pB0, pB1, seed; float mnA, alA, alB; bool rsA = false, rsB = false; bf16x8 pa0, pa1, pa2, pa3;
  int sl_prev = 2 * SHM_V, sl_cur = 0, sl_next = SHM_V;
  if (wid >= 4) __builtin_amdgcn_s_setprio(1);
  DMA_TILE(0, 0); DMA_TILE(1, SHM_V);
  WAIT_BAR();
  DMA_TILE(2, 2 * SHM_V);
  qkt(pA0, pA1, K_lds, qr, r32, hi, mapB); partialSM(pA0, pA1, m_reg, mnA, alA, TMODE(0), cL, cR, dq0, tbl);
  _Pragma("unroll") for (int r = 0; r < 16; ++r) pA1[r] = __builtin_amdgcn_exp2f(pA1[r]);
  ROT();
#define QK_SEEDED(P0, P1, DMA_STMT, SEED_STMT) do { bf16x8 k0_[4], k1_[4]; const char* Ks_ = K_lds + sl_cur; \
    _Pragma("unroll") for (int d0 = 0; d0 < 4; ++d0) { k0_[d0] = *reinterpret_cast<const bf16x8*>(Ks_ + koff[d0]); k1_[d0] = *reinterpret_cast<const bf16x8*>(Ks_ + koff[d0] + 8192); } \
    DMA_STMT; SEED_STMT; \
    P0 = __builtin_amdgcn_mfma_f32_32x32x16_bf16(k0_[0], qr[0], seed, 0, 0, 0); P1 = __builtin_amdgcn_mfma_f32_32x32x16_bf16(k1_[0], qr[0], seed, 0, 0, 0); \
    _Pragma("unroll") for (int d0 = 1; d0 < 4; ++d0) { P0 = __builtin_amdgcn_mfma_f32_32x32x16_bf16(k0_[d0], qr[d0], P0, 0, 0, 0); P1 = __builtin_amdgcn_mfma_f32_32x32x16_bf16(k1_[d0], qr[d0], P1, 0, 0, 0); } } while (0)
  for (int j = 1; j + 1 < NT; j += 2) {
    SBAR(); QK_SEEDED(pB0, pB1, if (j > 1) DMA_TILE(j + 1, sl_next), SEED(TMODE(j * KVBLK)));
    finishSM(pA0, pA1, pa0, pa1, pa2, pa3); SBAR();
    if (TMODE(j * KVBLK) == 0) near_bias(pB0, pB1, dq0 + j * KVBLK, tbl);
    pv_softmax(o, vb0 + sl_prev, pa0, pa1, pa2, pa3, pB0, pB1, m_reg, alB, rsB);
    WAIT_BAR();
    RESC(alB, rsB); ROT();
    SBAR(); QK_SEEDED(pA0, pA1, DMA_TILE(j + 2, sl_next), SEED(TMODE((j + 1) * KVBLK)));
    finishSM(pB0, pB1, pa0, pa1, pa2, pa3); SBAR();
    if (TMODE((j + 1) * KVBLK) == 0) near_bias(pA0, pA1, dq0 + (j + 1) * KVBLK, tbl);
    pv_softmax(o, vb0 + sl_prev, pa0, pa1, pa2, pa3, pA0, pA1, m_reg, alA, rsA);
    WAIT_BAR();
    RESC(alA, rsA); ROT();
  }
  SBAR(); QK_SEEDED(pB0, pB1, (void)0, SEED(TMODE((NT - 1) * KVBLK)));
  finishSM(pA0, pA1, pa0, pa1, pa2, pa3); SBAR();
  if (TMODE((NT - 1) * KVBLK) == 0) near_bias(pB0, pB1, dq0 + (NT - 1) * KVBLK, tbl);
  pv_softmax(o, vb0 + sl_prev, pa0, pa1, pa2, pa3, pB0, pB1, m_reg, alB, rsB);
  RESC(alB, rsB);
  finishSM(pB0, pB1, pa0, pa1, pa2, pa3); SBAR();
  pv_d0(o, vb0 + sl_cur, pa0, pa1, pa2, pa3);
  __builtin_amdgcn_s_setprio(0);
  float rli[16];
#pragma unroll
  for (int r = 0; r < 16; ++r) rli[r] = __builtin_amdgcn_rcpf(o[4][r]);
  __syncthreads();
  float* X = (float*)(lds + jq * 16384);
  if (map == 1) {
#pragma unroll
    for (int r = 0; r < 16; ++r) { const int orow = crow(r, hi); const float s = rli[r] * lam;
#pragma unroll
      for (int d0 = 0; d0 < 4; ++d0) X[orow * 128 + d0 * 32 + r32] = o[d0][r] * s; }
  }
  __syncthreads();
  if (map == 0) {
    float ss[16];
#pragma unroll
    for (int r = 0; r < 16; ++r) { const int orow = crow(r, hi); float a = 0.f;
#pragma unroll
      for (int d0 = 0; d0 < 4; ++d0) { const float v = o[d0][r] * rli[r] - X[orow * 128 + d0 * 32 + r32]; o[d0][r] = v; a += v * v; }
      ss[r] = a; }
#pragma unroll
    for (int s = 1; s < 32; s <<= 1)
#pragma unroll
      for (int r = 0; r < 16; ++r) ss[r] += shx(ss[r], s);
    float gg[4];
#pragma unroll
    for (int d0 = 0; d0 < 4; ++d0) gg[d0] = g[d0 * 32 + r32] * osc;
    asm volatile("s_waitcnt lgkmcnt(0)" ::: "memory");
    bf16_t* stg = (bf16_t*)X;
#pragma unroll
    for (int r = 0; r < 16; ++r) { const int orow = crow(r, hi); const float rs = __builtin_amdgcn_rsqf(ss[r] * (1.0f / 128.0f) + LN_EPS);
#pragma unroll
      for (int d0 = 0; d0 < 4; ++d0) { const float v = o[d0][r] * rs * gg[d0]; stg[orow * 128 + d0 * 32 + r32] = (bf16_t)(cvt_pk_bf16(v, v) & 0xffffu); } }
    asm volatile("s_waitcnt lgkmcnt(0)" ::: "memory");
    bf16_t* Ow = O + (rowbase + qs) * LDX + h * 128;
#pragma unroll
    for (int i = 0; i < 8; ++i) { const int row = i * 4 + (lane >> 4), ch = lane & 15; const v4u v = *(const v4u*)(stg + row * 128 + ch * 8);
      if (!o8) *(v4u*)(Ow + (long)row * LDX + ch * 8) = v;
      else { typedef unsigned u32x2 __attribute__((ext_vector_type(2))); u32x2 q8; q8.x = pg8::pk4_fp8(bf_lo(v.x), bf_hi(v.x), bf_lo(v.y), bf_hi(v.y)); q8.y = pg8::pk4_fp8(bf_lo(v.z), bf_hi(v.z), bf_lo(v.w), bf_hi(v.w));
        *(u32x2*)((unsigned char*)O + (size_t)(rowbase + qs + row) * LDX + h * 128 + ch * 8) = q8; } }
    asm volatile("s_waitcnt lgkmcnt(0)" ::: "memory");
  }
  __syncthreads();
#undef DMA_TILE
#undef WAIT_BAR
#undef ROT
#undef RESC
#undef SEED
#undef QK_SEEDED
#undef TMODE
}
#undef KSWZ
#undef SBAR
}

#define XB_TMO      128
#define XB_XCNT(j)  (256  + 64 * (j))
#define XB_XSUB(j)  (1280 + 64 * (j))
#define XB_XGEN(j)  (2304 + 64 * (j))
#define XB_TOP      3328
#define XB_TOPGEN   3392
#define XCD_BAR_WORDS 3456
#define XB_SPIN_CAP (1u << 18)
__device__ __forceinline__ unsigned xb_ld(unsigned* p)              { return __hip_atomic_load(p, __ATOMIC_RELAXED, __HIP_MEMORY_SCOPE_AGENT); }
__device__ __forceinline__ unsigned xb_add(unsigned* p, unsigned v) { return __hip_atomic_fetch_add(p, v, __ATOMIC_RELAXED, __HIP_MEMORY_SCOPE_AGENT); }
__device__ __forceinline__ unsigned xb_xcc_id() { return (unsigned)__builtin_amdgcn_s_getreg((3 << 11) | 20) & 0xFu; }
#define XB_SPIN(cond, bar) do { unsigned _sp = 0; while (cond) { __builtin_amdgcn_s_sleep(1); \
    if ((++_sp & 255u) == 0u) { if (xb_ld(&(bar)[XB_TMO])) break; if (_sp > XB_SPIN_CAP) { atomicAdd(&(bar)[XB_TMO], 1u); break; } } } } while (0)
struct XcdBarrier { unsigned* bar; unsigned x; volatile LAS unsigned* st; };
__device__ __forceinline__ XcdBarrier xcd_barrier_post(unsigned* bar, volatile LAS unsigned* st) {
    XcdBarrier b; b.bar = bar; b.x = xb_xcc_id(); b.st = st;
    if (threadIdx.x == 0) (void)xb_add(&bar[XB_XCNT(b.x)], 1u);
    return b;
}
__device__ __forceinline__ void xcd_barrier_complete(unsigned* bar, unsigned x, unsigned& nloc, unsigned& nx) {
    const unsigned G = gridDim.x * gridDim.y * gridDim.z;
    unsigned sum, cnt, mine, sp = 0u;
    for (;;) {
        sum = 0u; cnt = 0u; mine = 0u;
#pragma unroll
        for (unsigned j = 0; j < 16; ++j) { const unsigned c = xb_ld(&bar[XB_XCNT(j)]); sum += c; cnt += (c > 0u) ? 1u : 0u; mine = (j == x) ? c : mine; }
        if (sum == G) break;
        __builtin_amdgcn_s_sleep(1);
        if ((++sp & 255u) == 0u) { if (xb_ld(&bar[XB_TMO])) break; if (sp > XB_SPIN_CAP) { atomicAdd(&bar[XB_TMO], 1u); break; } }
    }
    nloc = mine > 0u ? mine : 1u; nx = cnt > 0u ? cnt : 1u;
}
__device__ __forceinline__ void xcd_barrier(const XcdBarrier& b) {
    asm volatile("s_waitcnt vmcnt(0)" ::: "memory");
    __syncthreads();
    if (threadIdx.x == 0) {
        unsigned* bar = b.bar;
        __builtin_amdgcn_s_waitcnt(0);
        unsigned nloc = b.st[0], nx = b.st[1];
        if (nloc == 0u) { xcd_barrier_complete(bar, b.x, nloc, nx); b.st[0] = nloc; b.st[1] = nx; }
        const unsigned old = xb_add(&bar[XB_XSUB(b.x)], 1u);
        const unsigned gen = old / nloc;
        if (old + 1u == (gen + 1u) * nloc) {
            __builtin_amdgcn_fence(__ATOMIC_RELEASE, "agent");
            asm volatile("s_waitcnt vmcnt(0)" ::: "memory");
            const unsigned og = xb_add(&bar[XB_TOP], 1u);
            const unsigned tg = og / nx;
            if (og + 1u == (tg + 1u) * nx) xb_add(&bar[XB_TOPGEN], 1u);
            else XB_SPIN(xb_ld(&bar[XB_TOPGEN]) == tg, bar);
            __builtin_amdgcn_fence(__ATOMIC_ACQUIRE, "agent");
            xb_add(&bar[XB_XGEN(b.x)], 1u);
            asm volatile("s_waitcnt vmcnt(0)" ::: "memory");
        } else {
            XB_SPIN(xb_ld(&bar[XB_XGEN(b.x)]) == gen, bar);
            __builtin_amdgcn_fence(__ATOMIC_ACQUIRE, "agent");
            asm volatile("s_waitcnt vmcnt(0)" ::: "memory");
        }
    }
    __syncthreads();
}

template <int MODE> __device__ __forceinline__ int dst_row(int n) {
    if (MODE == 1) { if (n < 1024) return n; const int b = (n - 1024) >> 10, f = (n - 1024) & 1023; return 1024 + (f >> 7) * 256 + b * 128 + (f & 127); }
    if (MODE == 2) { const int b = n & 1, j = n >> 1; return (j >> 7) * 256 + b * 128 + (j & 127); }
    return n;
}
template <int MODE> __device__ __forceinline__ void p0_transpose_item(const float* W, int K, int N, bf16_t* WT, LAS float* scr, int item, int lane, const float* kscale = nullptr) {
    const int nblk = N / 32, kb = item / nblk, nb = item % nblk, k0 = 64 * kb, n0 = 32 * nb;
#pragma unroll 8
    for (int i = 0; i < 32; ++i) { const int kk = 2 * i + (lane >> 5); float w = W[(size_t)(k0 + kk) * N + n0 + (lane & 31)]; if (kscale) w *= kscale[k0 + kk]; scr[kk * 33 + (lane & 31)] = w; }
    LDS_WAIT(); asm volatile("" ::: "memory");
    const int c = lane & 7;
#pragma unroll
    for (int j = 0; j < 4; ++j) { const int n = (lane >> 3) + 8 * j; const LAS float* s = scr + (8 * c) * 33 + n;
        v4u o; o.x = cvt_pk_bf16(s[0 * 33], s[1 * 33]); o.y = cvt_pk_bf16(s[2 * 33], s[3 * 33]); o.z = cvt_pk_bf16(s[4 * 33], s[5 * 33]); o.w = cvt_pk_bf16(s[6 * 33], s[7 * 33]);
        *(GAS v4u*)(WT + (size_t)dst_row<MODE>(n0 + n) * K + k0 + 8 * c) = o; }
    LDS_WAIT(); asm volatile("" ::: "memory");
}

template <int MODE, bool I8 = false> __device__ __forceinline__ void p0_quant_strip(const float* W, int N, unsigned char* W8, float* SC, int strip, LAS unsigned char* lds, int wave, int lane) {
    constexpr float QM_ = I8 ? 127.0f : F8MAX;
    LAS float* scr = (LAS float*)(lds + wave * 16384); LAS float* red = (LAS float*)(lds + LDSCTL_OFF + 2048);
    const int n0 = strip * 32, k0 = wave * 128, kk = lane >> 5, n = lane & 31;
    float am = 0.f;
    { const char* Wb = (const char*)W + (size_t)k0 * N * 4; const unsigned loff = (unsigned)((kk * N + n0 + n) * 4);
      float vv[64];
#pragma unroll
      for (int i = 0; i < 64; ++i) vv[i] = *(const float*)(Wb + (size_t)i * (size_t)(2 * N * 4) + loff);
#pragma unroll
      for (int i = 0; i < 64; ++i) { scr[(2 * i + kk) * 32 + n] = vv[i]; am = fmaxf(am, fabsf(vv[i])); } }
    am = fmaxf(am, shx(am, 32));
    if (lane < 32) red[wave * 32 + n] = am;
    __syncthreads();
    float amax = red[n];
#pragma unroll
    for (int w = 1; w < 8; ++w) amax = fmaxf(amax, red[w * 32 + n]);
    const float q = amax > 0.f ? QM_ / amax : 0.f;
    const int dr = dst_row<MODE>(n0 + n);
    if (wave == 0 && lane < 32) SC[dr] = amax * (1.0f / QM_);
#pragma unroll
    for (int c = 0; c < 4; ++c) { float v[16];
#pragma unroll
        for (int j = 0; j < 16; ++j) v[j] = scr[(kk * 64 + c * 16 + j) * 32 + n] * q;
        v4u o; o.x = pg8::pkq4<I8>(v[0], v[1], v[2], v[3]); o.y = pg8::pkq4<I8>(v[4], v[5], v[6], v[7]); o.z = pg8::pkq4<I8>(v[8], v[9], v[10], v[11]); o.w = pg8::pkq4<I8>(v[12], v[13], v[14], v[15]);
        *(GAS v4u*)(W8 + (size_t)dr * 1024 + k0 + kk * 64 + c * 16) = o; }
    __syncthreads();
}
struct StripSrc { const float* W; int N; unsigned char* W8; float* SC; int strip; bool glu; };
__device__ __forceinline__ void dstrip_desc(const float* w1, const float* w2, unsigned char* ws, int st, StripSrc& d) {
    if (st < 128 * 64) { const int j = st >> 6; d.W = w1 + (size_t)j * 1024 * 2048; d.N = 2048; d.W8 = ws + WS_W1 + (size_t)j * 2048 * 1024; d.SC = (float*)(ws + WS_S1) + (size_t)j * 2048; d.strip = st & 63; d.glu = true; }
    else { const int q = st - 128 * 64, j = q >> 5; d.W = w2 + (size_t)j * 1024 * 1024; d.N = 1024; d.W8 = ws + WS_W2 + (size_t)j * 1024 * 1024; d.SC = (float*)(ws + WS_S2) + (size_t)j * 1024; d.strip = q & 31; d.glu = false; }
}
__device__ __forceinline__ void dstrip_issue(const StripSrc& d, int wave, int lane, float (&vv)[64]) {
    const int n0 = d.strip * 32, k0 = wave * 128, kk = lane >> 5, n = lane & 31;
    const char* Wb = (const char*)d.W + (size_t)k0 * d.N * 4; const unsigned loff = (unsigned)((kk * d.N + n0 + n) * 4); const size_t rs2 = (size_t)d.N * 8;
#pragma unroll
    for (int i = 0; i < 64; ++i) vv[i] = *(const float*)(Wb + (size_t)i * rs2 + loff);
}
__device__ __forceinline__ void dstrip_finish(const StripSrc& d, LAS unsigned char* lds, int wave, int lane, int par, float (&vv)[64]) {
    LAS float* scr = (LAS float*)(lds + wave * 16384); LAS float* red = (LAS float*)(lds + LDSCTL_OFF + 2048 + par * 1024);
    const int n0 = d.strip * 32, k0 = wave * 128, kk = lane >> 5, n = lane & 31;
    float am = 0.f;
#pragma unroll
    for (int i = 0; i < 64; ++i) { scr[(2 * i + kk) * 32 + n] = vv[i]; am = fmaxf(am, fabsf(vv[i])); }
    am = fmaxf(am, shx(am, 32));
    if (lane < 32) red[wave * 32 + n] = am;
    asm volatile("s_waitcnt lgkmcnt(0)" ::: "memory"); __builtin_amdgcn_s_barrier(); asm volatile("" ::: "memory");
    float amax = red[n];
#pragma unroll
    for (int w = 1; w < 8; ++w) amax = fmaxf(amax, red[w * 32 + n]);
    const float q = amax > 0.f ? F8MAX / amax : 0.f;
    const int dr = d.glu ? dst_row<2>(n0 + n) : (n0 + n);
    if (wave == 0 && lane < 32) d.SC[dr] = amax * (1.0f / F8MAX);
#pragma unroll
    for (int c = 0; c < 4; ++c) { float v[16];
#pragma unroll
        for (int j = 0; j < 16; ++j) v[j] = scr[(kk * 64 + c * 16 + j) * 32 + n] * q;
        v4u o; o.x = pg8::pk4_fp8(v[0], v[1], v[2], v[3]); o.y = pg8::pk4_fp8(v[4], v[5], v[6], v[7]); o.z = pg8::pk4_fp8(v[8], v[9], v[10], v[11]); o.w = pg8::pk4_fp8(v[12], v[13], v[14], v[15]);
        *(GAS v4u*)(d.W8 + (size_t)dr * 1024 + k0 + kk * 64 + c * 16) = o; }
    asm volatile("s_waitcnt lgkmcnt(0)" ::: "memory");
}
__device__ __forceinline__ void deferred_strips(const float* w1, const float* w2, unsigned char* ws, LAS unsigned char* lds, int first, int stride, int wave, int lane) {
    constexpr int NT = 3 * 32 * 96;
    auto stq = [](int idx) { return idx < 3 * 32 * 64 ? 32 * 64 + idx : 128 * 64 + 32 * 32 + (idx - 3 * 32 * 64); };
    float va[64], vb[64]; StripSrc da, db; int idx = first, par = 0;
    if (idx < NT) { dstrip_desc(w1, w2, ws, stq(idx), da); dstrip_issue(da, wave, lane, va); }
#pragma unroll 1
    while (idx < NT) {
        const int i1 = idx + stride; if (i1 < NT) { dstrip_desc(w1, w2, ws, stq(i1), db); dstrip_issue(db, wave, lane, vb); }
        dstrip_finish(da, lds, wave, lane, par, va); par ^= 1;
        if (i1 >= NT) break;
        const int i2 = i1 + stride; if (i2 < NT) { dstrip_desc(w1, w2, ws, stq(i2), da); dstrip_issue(da, wave, lane, va); }
        dstrip_finish(db, lds, wave, lane, par, vb); par ^= 1;
        idx = i2;
    }
    __syncthreads();
}
__device__ __forceinline__ float ln_bound(const float* g, const float* b, int lane) {
    float mg = 0.f, mb = 0.f;
#pragma unroll
    for (int j = 0; j < 4; ++j) { const f32x4 a = *(const f32x4*)(g + j * 256 + lane * 4), c = *(const f32x4*)(b + j * 256 + lane * 4);
        mg = fmaxf(mg, fmaxf(fmaxf(fabsf(a[0]), fabsf(a[1])), fmaxf(fabsf(a[2]), fabsf(a[3])))); mb = fmaxf(mb, fmaxf(fmaxf(fabsf(c[0]), fabsf(c[1])), fmaxf(fabsf(c[2]), fabsf(c[3])))); }
#pragma unroll
    for (int o = 1; o < 64; o <<= 1) { mg = fmaxf(mg, shx(mg, o)); mb = fmaxf(mb, shx(mb, o)); }
    return 31.984371f * mg + mb;
}

struct Ptrs {
    const float *x, *rel_bias, *attn_w_in, *attn_lambda, *attn_subln, *attn_w_out, *conv_w_in, *conv_w, *conv_w_out, *router_w, *router_b, *w1, *b1, *w2, *b2, *ln_g, *ln_b;
    float* out; unsigned char* ws;
};

#ifndef DEFER_W
#define DEFER_W 1
#endif
__device__ __forceinline__ void expert_strip(const Ptrs& P, int st, LAS unsigned char* lds, int wave, int lane) {
    unsigned char* ws = P.ws;
    if (st < 128 * 64) { const int j = st >> 6, r = st & 63; p0_quant_strip<2>(P.w1 + (size_t)j * 1024 * 2048, 2048, ws + WS_W1 + (size_t)j * 2048 * 1024, (float*)(ws + WS_S1) + (size_t)j * 2048, r, lds, wave, lane); }
    else { const int q = st - 128 * 64, j = q >> 5, r = q & 31; p0_quant_strip<0>(P.w2 + (size_t)j * 1024 * 1024, 1024, ws + WS_W2 + (size_t)j * 1024 * 1024, (float*)(ws + WS_S2) + (size_t)j * 1024, r, lds, wave, lane); }
}
constexpr int NWAVES_ = 8;
__device__ __forceinline__ void p0_prologue(const Ptrs& P, LAS unsigned char* lds, int gw, int NGW, int wave, int lane) {
    LAS float* scr = (LAS float*)(lds + RING_OFF + wave * 16384);
    unsigned char* ws = P.ws;
    constexpr int I_OUT = 16 * 32, I_R = 16;
    constexpr int I_IN = 16 * 96;
    constexpr int S1 = NA16 * I_OUT, S3 = S1 + NO16 * I_OUT, S4 = S3 + 4 * I_R, S5 = S4 + NQ16 * I_IN, S6 = S5 + NC16 * I_IN;
    { const int wg = gw / NWAVES_, NWG = NGW / NWAVES_;
      constexpr int T1 = 128 * 64, T2 = T1 + 128 * 32, T3 = T2 + NQ8 * 96, T4 = T3 + NC8 * 96, T5 = T4 + NA8 * 32, T6 = T5 + NO8 * 32;
      constexpr int NE0 = DEFER_W ? 32 * 64 + 32 * 32 : T2;
#pragma unroll 1
      for (int s0 = wg; s0 < NE0 + (T6 - T2); s0 += NWG) {
        const int st = (s0 >= NE0) ? T2 + (s0 - NE0) : (DEFER_W ? (s0 < 32 * 64 ? s0 : T1 + (s0 - 32 * 64)) : s0);
        if (st < T2) expert_strip(P, st, lds, wave, lane);
        else if (st < T3) { const int q = st - T2, j = QJ0 + q / 96, r = q % 96; p0_quant_strip<0, I8P>(P.attn_w_in + (size_t)j * 1024 * 3072, 3072, ws + WS_WAI + (size_t)j * 3072 * 1024, (float*)(ws + WS_SD) + (size_t)j * 3072, r, lds, wave, lane); }
        else if (st < T4) { const int q = st - T3, j = CJ0 + q / 96, r = q % 96; p0_quant_strip<1, I8P>(P.conv_w_in + (size_t)j * 1024 * 3072, 3072, ws + WS_WCI + (size_t)j * 3072 * 1024, (float*)(ws + WS_SD + 32 * 1024) + (size_t)j * 3072, r, lds, wave, lane); }
        else if (st < T5) { const int q = st - T4, j = AJ0 + q / 32, r = q % 32; p0_quant_strip<0>(P.attn_w_out + (size_t)j * 1024 * 1024, 1024, ws + WS_WAO8 + (size_t)j * 1024 * 1024, (float*)(ws + WS_SD + 24 * 1024) + (size_t)j * 1024, r, lds, wave, lane); }
        else { const int q = st - T5, j = OJ0 + q / 32, r = q % 32; p0_quant_strip<0, I8P>(P.conv_w_out + (size_t)j * 1024 * 1024, 1024, ws + WS_WCO8 + (size_t)j * 1024 * 1024, (float*)(ws + WS_SD + 56 * 1024) + (size_t)j * 1024, r, lds, wave, lane); }
      } }
    for (int it = gw; it < S6; it += NGW) {
        if (it >= S5) { const int q = it - S5, j = CK0 + q / I_IN, r = q % I_IN; p0_transpose_item<1>(P.conv_w_in + (size_t)j * 1024 * 3072, 1024, 3072, (bf16_t*)(ws + WS_WC16) + (size_t)j * 3072 * 1024, scr, r, lane); }
        else if (it >= S4) { const int q = it - S4, j = QK0 + q / I_IN, r = q % I_IN; p0_transpose_item<0>(P.attn_w_in + (size_t)j * 1024 * 3072, 1024, 3072, (bf16_t*)(ws + WS_WA16) + (size_t)j * 3072 * 1024, scr, r, lane); }
        else if (it < S1) { const int q = it, j = AK0 + q / I_OUT, r = q % I_OUT; p0_transpose_item<0>(P.attn_w_out + (size_t)j * 1024 * 1024, 1024, 1024, (bf16_t*)(ws + WS_WAO) + (size_t)j * 1024 * 1024, scr, r, lane); }
        else if (it < S3) { const int q = it - S1, j = OK0 + q / I_OUT, r = q % I_OUT; p0_transpose_item<0>(P.conv_w_out + (size_t)j * 1024 * 1024, 1024, 1024, (bf16_t*)(ws + WS_WCO) + (size_t)j * 1024 * 1024, scr, r, lane); }
        else { const int q = it - S3, j = q / I_R, r = q % I_R; p0_transpose_item<0>(P.router_w + (size_t)j * 1024 * 32, 1024, 32, (bf16_t*)(ws + WS_WR) + (size_t)j * 32 * 1024, scr, r, lane, P.ln_g + (size_t)(j * 2 + 0) * D); }
    }
    for (int row = gw; row < M; row += NGW) {
        f32x4 a[2][2]; float am = 0.f;
#pragma unroll
        for (int h = 0; h < 2; ++h)
#pragma unroll
            for (int q = 0; q < 2; ++q) { a[h][q] = *(const GAS f32x4*)(P.x + (size_t)row * D + h * 512 + lane * 8 + q * 4);
                am = fmaxf(am, fmaxf(fmaxf(fabsf(a[h][q][0]), fabsf(a[h][q][1])), fmaxf(fabsf(a[h][q][2]), fabsf(a[h][q][3])))); }
#pragma unroll
        for (int o = 1; o < 64; o <<= 1) am = fmaxf(am, shx(am, o));
        const float qs = QMAXP / fmaxf(am, 1e-30f);
        if ((QM & 1) && lane == 0) ((float*)(ws + WS_RS))[row] = am * (1.0f / QMAXP);
#pragma unroll
        for (int h = 0; h < 2; ++h) { v4u o; o.x = cvt_pk_bf16(a[h][0][0], a[h][0][1]); o.y = cvt_pk_bf16(a[h][0][2], a[h][0][3]); o.z = cvt_pk_bf16(a[h][1][0], a[h][1][1]); o.w = cvt_pk_bf16(a[h][1][2], a[h][1][3]);
            *(GAS v4u*)((bf16_t*)(ws + WS_XB) + (size_t)row * D + h * 512 + lane * 8) = o;
            if (QM & 1) { typedef unsigned u32x2 __attribute__((ext_vector_type(2))); u32x2 q8;
            q8.x = pg8::pkq4<I8P>(a[h][0][0] * qs, a[h][0][1] * qs, a[h][0][2] * qs, a[h][0][3] * qs); q8.y = pg8::pkq4<I8P>(a[h][1][0] * qs, a[h][1][1] * qs, a[h][1][2] * qs, a[h][1][3] * qs);
            *(GAS u32x2*)(ws + WS_XI + (size_t)row * D + h * 512 + lane * 8) = q8; } }
    }
}

__device__ __forceinline__ void conv_phase(const bf16_t* GB, const bf16_t* Z, const float* cw, bf16_t* Gout, float* RS, bool o8, int gw, int NGW, int lane) {
    float w[3][16];
#pragma unroll
    for (int j = 0; j < 3; ++j)
#pragma unroll
        for (int h = 0; h < 2; ++h)
#pragma unroll
            for (int q = 0; q < 2; ++q) { const f32x4 t = *(const f32x4*)(cw + j * D + h * 512 + lane * 8 + q * 4); w[j][h * 8 + q * 4 + 0] = t[0]; w[j][h * 8 + q * 4 + 1] = t[1]; w[j][h * 8 + q * 4 + 2] = t[2]; w[j][h * 8 + q * 4 + 3] = t[3]; }
    for (int run = gw; run < M / 32; run += NGW) {
        const int t0 = run * 32; const bool first = (t0 % SEQ) == 0, lastr = ((t0 + 32) % SEQ) == 0;
        v4u zp[2], zc[2], zn[2];
#pragma unroll
        for (int h = 0; h < 2; ++h) { zp[h] = first ? (v4u){0u, 0u, 0u, 0u} : *(const v4u*)(Z + (size_t)(t0 - 1) * D + h * 512 + lane * 8); zc[h] = *(const v4u*)(Z + (size_t)t0 * D + h * 512 + lane * 8); }
        for (int r = 0; r < 32; ++r) { const int t = t0 + r; const bool pad = lastr && (r == 31);
            float o[2][8];
#pragma unroll
            for (int h = 0; h < 2; ++h) {
                zn[h] = pad ? (v4u){0u, 0u, 0u, 0u} : *(const v4u*)(Z + (size_t)(t + 1) * D + h * 512 + lane * 8);
                const v4u gb = *(const v4u*)(GB + (size_t)t * D + h * 512 + lane * 8);
#pragma unroll
                for (int q = 0; q < 4; ++q) { const unsigned up = zp[h][q], uc = zc[h][q], un = zn[h][q], ug = gb[q]; const int c = h * 8 + q * 2;
                    o[h][q * 2 + 0] = bf_lo(ug) * (w[0][c] * bf_lo(up) + w[1][c] * bf_lo(uc) + w[2][c] * bf_lo(un));
                    o[h][q * 2 + 1] = bf_hi(ug) * (w[0][c + 1] * bf_hi(up) + w[1][c + 1] * bf_hi(uc) + w[2][c + 1] * bf_hi(un)); }
                if (!o8) { v4u ov; ov.x = cvt_pk_bf16(o[h][0], o[h][1]); ov.y = cvt_pk_bf16(o[h][2], o[h][3]); ov.z = cvt_pk_bf16(o[h][4], o[h][5]); ov.w = cvt_pk_bf16(o[h][6], o[h][7]);
                    *(v4u*)(Gout + (size_t)t * D + h * 512 + lane * 8) = ov; }
                zp[h] = zc[h]; zc[h] = zn[h];
            }
            if (o8) { float am = 0.f;
#pragma unroll
                for (int h = 0; h < 2; ++h)
#pragma unroll
                    for (int i = 0; i < 8; ++i) am = fmaxf(am, fabsf(o[h][i]));
#pragma unroll
                for (int s_ = 1; s_ < 64; s_ <<= 1) am = fmaxf(am, shx(am, s_));
                const float qs = QMAXP / fmaxf(am, 1e-30f);
                if (lane == 0) RS[t] = am * (1.0f / QMAXP);
#pragma unroll
                for (int h = 0; h < 2; ++h) { typedef unsigned u32x2 __attribute__((ext_vector_type(2))); u32x2 q8;
                    q8.x = pg8::pkq4<I8P>(o[h][0] * qs, o[h][1] * qs, o[h][2] * qs, o[h][3] * qs); q8.y = pg8::pkq4<I8P>(o[h][4] * qs, o[h][5] * qs, o[h][6] * qs, o[h][7] * qs);
                    *(u32x2*)((unsigned char*)Gout + (size_t)t * D + h * 512 + lane * 8) = q8; } }
        }
    }
}

__device__ __forceinline__ void ln2_phase(const bf16_t* Yp, const float* g1, const float* b1, const unsigned char* Y, const float* g, const float* bta, bf16_t* XB, float* out, unsigned char* XI, float* RS, int gw, int NGW, int lane) {
    float gg[16], bb[16];
#pragma unroll
    for (int h = 0; h < 2; ++h)
#pragma unroll
        for (int q = 0; q < 2; ++q) { const f32x4 t = *(const f32x4*)(g + h * 512 + lane * 8 + q * 4), s = *(const f32x4*)(bta + h * 512 + lane * 8 + q * 4);
#pragma unroll
            for (int i = 0; i < 4; ++i) { gg[h * 8 + q * 4 + i] = t[i]; bb[h * 8 + q * 4 + i] = s[i]; } }
    float sXb = 0.f, rsXb = 0.f; if constexpr (!I8P) { const float lb = ln_bound(g, bta, lane); sXb = F8MAX / lb; rsXb = lb * (1.0f / F8MAX); }
    for (int row = gw; row < M; row += NGW) {
        float v[16];
#pragma unroll
        for (int h = 0; h < 2; ++h) { const v4u xr = *(const v4u*)(Yp + (size_t)row * D + h * 512 + lane * 8);
#pragma unroll
            for (int q = 0; q < 4; ++q) { v[h * 8 + q * 2] = bf_lo(xr[q]); v[h * 8 + q * 2 + 1] = bf_hi(xr[q]); } }
        { float s1 = 0.f;
#pragma unroll
          for (int i = 0; i < 16; ++i) s1 += v[i];
          const float m1 = wave_sum(s1) * (1.f / D); float q1 = 0.f;
#pragma unroll
          for (int i = 0; i < 16; ++i) { v[i] -= m1; q1 += v[i] * v[i]; }
          const float r1 = ALPHA / sqrtf(wave_sum(q1) * (1.f / D) + LN_EPS);
#pragma unroll
          for (int h = 0; h < 2; ++h)
#pragma unroll
            for (int q = 0; q < 2; ++q) { const f32x4 t = *(const f32x4*)(g1 + h * 512 + lane * 8 + q * 4), u = *(const f32x4*)(b1 + h * 512 + lane * 8 + q * 4);
#pragma unroll
              for (int i = 0; i < 4; ++i) v[h * 8 + q * 4 + i] = v[h * 8 + q * 4 + i] * r1 * t[i] + ALPHA * u[i]; } }
#pragma unroll
        for (int k = 0; k < 4; ++k)
#pragma unroll
            for (int h = 0; h < 2; ++h) { typedef unsigned u32x2 __attribute__((ext_vector_type(2))); const u32x2 yr = *(const u32x2*)(Y + ((size_t)row * 4 + k) * D + h * 512 + lane * 8);
#pragma unroll
                for (int q = 0; q < 2; ++q) { const f32x2 lo = __builtin_amdgcn_cvt_pk_f32_fp8((int)yr[q], false), hi2 = __builtin_amdgcn_cvt_pk_f32_fp8((int)yr[q], true);
                    v[h * 8 + q * 4 + 0] += lo[0] * (1.0f / YSCALE); v[h * 8 + q * 4 + 1] += lo[1] * (1.0f / YSCALE); v[h * 8 + q * 4 + 2] += hi2[0] * (1.0f / YSCALE); v[h * 8 + q * 4 + 3] += hi2[1] * (1.0f / YSCALE); } }
        float s = 0.f;
#pragma unroll
        for (int i = 0; i < 16; ++i) s += v[i];
        const float mean = wave_sum(s) * (1.f / D); float s2 = 0.f;
#pragma unroll
        for (int i = 0; i < 16; ++i) { v[i] -= mean; s2 += v[i] * v[i]; }
        const float rstd = 1.f / sqrtf(wave_sum(s2) * (1.f / D) + LN_EPS);
#pragma unroll
        for (int i = 0; i < 16; ++i) v[i] = v[i] * rstd * gg[i] + bb[i];
        float sX = sXb, rsX = rsXb;
        if (I8P && XI) { float am = 0.f;
#pragma unroll
            for (int i = 0; i < 16; ++i) am = fmaxf(am, fabsf(v[i]));
#pragma unroll
            for (int o = 1; o < 64; o <<= 1) am = fmaxf(am, shx(am, o));
            sX = QMAXP / fmaxf(am, 1e-30f); rsX = am * (1.0f / QMAXP); }
#pragma unroll
        for (int h = 0; h < 2; ++h) { v4u ov; ov.x = cvt_pk_bf16(v[h * 8 + 0], v[h * 8 + 1]); ov.y = cvt_pk_bf16(v[h * 8 + 2], v[h * 8 + 3]); ov.z = cvt_pk_bf16(v[h * 8 + 4], v[h * 8 + 5]); ov.w = cvt_pk_bf16(v[h * 8 + 6], v[h * 8 + 7]);
            if (!out) *(v4u*)(XB + (size_t)row * D + h * 512 + lane * 8) = ov;
            if (XI) { typedef unsigned u32x2 __attribute__((ext_vector_type(2))); u32x2 q8; q8.x = pg8::pkq4<I8P>(v[h * 8 + 0] * sX, v[h * 8 + 1] * sX, v[h * 8 + 2] * sX, v[h * 8 + 3] * sX); q8.y = pg8::pkq4<I8P>(v[h * 8 + 4] * sX, v[h * 8 + 5] * sX, v[h * 8 + 6] * sX, v[h * 8 + 7] * sX);
                *(u32x2*)(XI + (size_t)row * D + h * 512 + lane * 8) = q8; if (h == 0 && lane == 0) RS[row] = rsX; }
            if (out) { *(f32x4*)(out + (size_t)row * D + h * 512 + lane * 8) = (f32x4){v[h * 8 + 0], v[h * 8 + 1], v[h * 8 + 2], v[h * 8 + 3]};
                       *(f32x4*)(out + (size_t)row * D + h * 512 + lane * 8 + 4) = (f32x4){v[h * 8 + 4], v[h * 8 + 5], v[h * 8 + 6], v[h * 8 + 7]}; } }
    }
}

constexpr int RT_PITCH = 2064, R_OFF_G = 32 * RT_PITCH, R_OFF_LG = R_OFF_G + 8192, R_OFF_CNT = R_OFF_LG + 8 * 16 * 33 * 4, R_OFF_SW = R_OFF_CNT + 256, R_LDS = R_OFF_SW + 256;
typedef __bf16 bf16x2_t __attribute__((ext_vector_type(2)));
__device__ __forceinline__ void router_phase(const bf16_t* Yp, const float* g, const float* bta, const bf16_t* RTg, const float* Wr, const float* rb, unsigned char* X8, int* lslot, float* lgate, unsigned* cnt,
                                             char* lds, int blk0, int G, int tid, int wave, int lane) {
    for (int i = tid; i < 32 * 128; i += 512) { const int e = i >> 7, c = i & 127; *(v4u*)(lds + e * RT_PITCH + c * 16) = *(const v4u*)(RTg + (size_t)e * 1024 + c * 8); }
    float* gl = (float*)(lds + R_OFF_G); float* bl = gl + 1024;
    for (int i = tid; i < 1024; i += 512) { gl[i] = g[i]; bl[i] = bta[i]; }
    float* LG = (float*)(lds + R_OFF_LG) + wave * (16 * 33);
    int* lcnt = (int*)(lds + R_OFF_CNT); int* lbase = lcnt + 32;
    float* sWl = (float*)(lds + R_OFF_SW); float* cBl = sWl + 32;
    __syncthreads();
#pragma unroll 1
    for (int j = 0; j < 4; ++j) { const int e = wave * 4 + j; float a = 0.f, c = 0.f;
#pragma unroll 4
        for (int i = 0; i < 16; ++i) { const int k = lane + 64 * i; a += __uint_as_float((unsigned)(*(const bf16_t*)(lds + e * RT_PITCH + k * 2)) << 16); c += bl[k] * Wr[(size_t)k * 32 + e]; }
        a = wave_sum(a); c = wave_sum(c); if (lane == 0) { sWl[e] = a; cBl[e] = c + rb[e]; } }
    const int t16 = lane & 15, kq = lane >> 4;
    const float sA = F8MAX / ln_bound(g, bta, lane);
#pragma unroll 1
    for (int blk = blk0; blk < M / 128; blk += G) {
        if (tid < 32) lcnt[tid] = 0;
        __syncthreads();
        int my_e, my_rank, my_slot; float my_gate;
        const int r0 = blk * 128 + wave * 16; const size_t rowoff = (size_t)(r0 + t16) * D + kq * 8;
        v4u yv[32];
#pragma unroll
        for (int kb = 0; kb < 32; ++kb) yv[kb] = *(const v4u*)(Yp + rowoff + kb * 32);
        f32x4 acc0 = {0.f, 0.f, 0.f, 0.f}, acc1 = {0.f, 0.f, 0.f, 0.f}, accs = {0.f, 0.f, 0.f, 0.f}, accq = {0.f, 0.f, 0.f, 0.f};
        const bf16x8 ones8 = {(short)0x3F80, (short)0x3F80, (short)0x3F80, (short)0x3F80, (short)0x3F80, (short)0x3F80, (short)0x3F80, (short)0x3F80};
#pragma unroll
        for (int kb = 0; kb < 32; ++kb) { const int c0 = kb * 32 + kq * 8;
            const bf16x8 w0 = *(const bf16x8*)(lds + t16 * RT_PITCH + c0 * 2), w1 = *(const bf16x8*)(lds + (16 + t16) * RT_PITCH + c0 * 2);
            const bf16x8 xb = __builtin_bit_cast(bf16x8, yv[kb]);
            acc0 = __builtin_amdgcn_mfma_f32_16x16x32_bf16(w0, xb, acc0, 0, 0, 0);
            acc1 = __builtin_amdgcn_mfma_f32_16x16x32_bf16(w1, xb, acc1, 0, 0, 0);
            accs = __builtin_amdgcn_mfma_f32_16x16x32_bf16(ones8, xb, accs, 0, 0, 0);
            accq = __builtin_amdgcn_mfma_f32_16x16x32_bf16(xb, xb, accq, 0, 0, 0); }
        const float s = accs[0];
        const int dsel = t16 & 3; float dq_ = dsel == 0 ? accq[0] : (dsel == 1 ? accq[1] : (dsel == 2 ? accq[2] : accq[3]));
        const float s2 = __int_as_float(__builtin_amdgcn_ds_bpermute(((t16 >> 2) * 16 + t16) << 2, __float_as_int(dq_)));
        const float mean = s * (1.f / D); const float var = fmaxf(s2 * (1.f / D) - mean * mean, 0.f);
        const float rstd = 1.f / sqrtf(var + LN_EPS);
        {
            float* lgr = LG + t16 * 33;
#pragma unroll
            for (int i = 0; i < 4; ++i) { const int e0 = kq * 4 + i, e1 = 16 + kq * 4 + i;
                lgr[e0] = rstd * (acc0[i] - mean * sWl[e0]) + cBl[e0]; lgr[e1] = rstd * (acc1[i] - mean * sWl[e1]) + cBl[e1]; }
            LDS_WAIT(); asm volatile("" ::: "memory");
            float t0 = -INFINITY, t1 = -INFINITY, t2 = -INFINITY, t3 = -INFINITY; int i0 = 0, i1 = 0, i2 = 0, i3 = 0;
#pragma unroll
            for (int e = 0; e < 32; ++e) { const float v = lgr[e];
                const bool c0 = v > t0, c1 = v > t1, c2 = v > t2, c3 = v > t3;
                t3 = c2 ? t2 : (c3 ? v : t3); i3 = c2 ? i2 : (c3 ? e : i3);
                t2 = c1 ? t1 : (c2 ? v : t2); i2 = c1 ? i1 : (c2 ? e : i2);
                t1 = c0 ? t0 : (c1 ? v : t1); i1 = c0 ? i0 : (c1 ? e : i1);
                t0 = c0 ? v : t0; i0 = c0 ? e : i0; }
            const float e1 = __expf(t1 - t0), e2 = __expf(t2 - t0), e3 = __expf(t3 - t0); const float inv = 1.f / (1.f + e1 + e2 + e3);
            const int ek = kq == 0 ? i0 : (kq == 1 ? i1 : (kq == 2 ? i2 : i3)); const float gk = (kq == 0 ? 1.f : (kq == 1 ? e1 : (kq == 2 ? e2 : e3))) * inv;
            my_e = ek; my_gate = gk; my_slot = (r0 + t16) * 4 + kq; my_rank = atomicAdd(&lcnt[ek], 1);
            LDS_WAIT(); asm volatile("" ::: "memory");
        }
        const float rs = rstd * sA;
#pragma unroll
        for (int kb = 0; kb < 32; ++kb) { const int c0 = kb * 32 + kq * 8; const v4u y = yv[kb];
            const f32x4 g0 = *(const f32x4*)(gl + c0) * rs, g1 = *(const f32x4*)(gl + c0 + 4) * rs, b0 = *(const f32x4*)(bl + c0) * sA, b1 = *(const f32x4*)(bl + c0 + 4) * sA;
            typedef unsigned u32x2 __attribute__((ext_vector_type(2))); u32x2 q8;
            q8.x = pg8::pk4_fp8((bf_lo(y.x) - mean) * g0[0] + b0[0], (bf_hi(y.x) - mean) * g0[1] + b0[1], (bf_lo(y.y) - mean) * g0[2] + b0[2], (bf_hi(y.y) - mean) * g0[3] + b0[3]);
            q8.y = pg8::pk4_fp8((bf_lo(y.z) - mean) * g1[0] + b1[0], (bf_hi(y.z) - mean) * g1[1] + b1[1], (bf_lo(y.w) - mean) * g1[2] + b1[2], (bf_hi(y.w) - mean) * g1[3] + b1[3]);
            *(u32x2*)(X8 + rowoff + kb * 32) = q8;
            asm volatile("" ::: "memory"); }
        __syncthreads();
        if (tid < 32) lbase[tid] = (int)__hip_atomic_fetch_add(cnt + tid * 64, (unsigned)lcnt[tid], RLX_AGENT);
        __syncthreads();
        { const int pos = lbase[my_e] + my_rank; lslot[(size_t)my_e * LCAP + pos] = my_slot; lgate[(size_t)my_e * LCAP + pos] = my_gate; }
        __syncthreads();
    }
}

__device__ __forceinline__ float attn_obound(const float* gsub, float osc, int lane) {
    float mg = fmaxf(fabsf(gsub[lane]), fabsf(gsub[64 + lane]));
#pragma unroll
    for (int o = 1; o < 64; o <<= 1) mg = fmaxf(mg, shx(mg, o));
    return 11.3137085f * mg * fabsf(osc);
}

constexpr int NWAVES = 8;
constexpr int N_PHASES = 1 + DEPTH * 7;
#ifndef REP_ATTN
#define REP_ATTN 1
#endif
#ifndef KREP_MOE
#define KREP_MOE 1
#endif
#ifndef REP_MOE
#define REP_MOE 1
#endif
#ifndef REP_P0
#define REP_P0 1
#endif
#ifndef REP_THIN
#define REP_THIN 1
#endif
#ifndef REP_DENSE
#define REP_DENSE 1
#endif
#ifndef MK_SPLIT
#define MK_SPLIT 0
#endif
struct Args { const float* in[17]; float* out; unsigned char* ws; int ph_lo, ph_hi, li, pad; };
typedef const __attribute__((address_space(4))) Args* ArgsP;
enum { I_X = 0, I_RELB, I_AWIN, I_ALAM, I_ASUB, I_AWOUT, I_CWIN, I_CW, I_CWOUT, I_RW, I_RB, I_W1, I_B1, I_W2, I_B2, I_LNG, I_LNB };
__global__ void __launch_bounds__(NWAVES * 64, 2) mk_fwd(Args args) {
    extern __shared__ __attribute__((aligned(16))) unsigned char lds[];
    LAS unsigned char* ldsl = (LAS unsigned char*)lds;
    volatile LAS unsigned* MISC = (volatile LAS unsigned*)(ldsl + MISC_OFF);
    const int tid0 = threadIdx.x;
    const int wave0 = __builtin_amdgcn_readfirstlane(tid0 >> 6);
    const int G0 = gridDim.x, bx0 = blockIdx.x;
#define PHASE_BEGIN() int wv_ = wave0; asm volatile("" : "+s"(wv_)); int ln_; asm volatile("v_mbcnt_lo_u32_b32 %0, -1, 0\n\tv_mbcnt_hi_u32_b32 %0, -1, %0" : "=v"(ln_)); int tid = wv_ * 64 + ln_; int G = G0, bx = bx0; asm volatile("" : "+s"(G), "+s"(bx)); const int vcu = (G % 8 == 0) ? (bx % 8) * (G / 8) + bx / 8 : bx; const int NGW = G * NWAVES; \
        const int lane = tid & 63, wave = __builtin_amdgcn_readfirstlane(tid >> 6); const int gw = vcu * NWAVES + wave; (void)lane; (void)gw; (void)NGW; \
        ArgsP ap = (ArgsP)__builtin_amdgcn_kernarg_segment_ptr(); asm volatile("" : "+s"(ap)); unsigned char* ws = ap->ws; gu32* ctl = (gu32*)(ws + WS_CTL); (void)ctl
    for (int u = tid0; u < (LDS_BYTES - LDSCTL_OFF) / 4; u += NWAVES * 64) ((LAS unsigned*)(ldsl + LDSCTL_OFF))[u] = 0u;
    __syncthreads();
    XcdBarrier bar = xcd_barrier_post((unsigned*)(args.ws + WS_CTL) + CW_BAR + (size_t)args.li * 4096, MISC + 8);
    const int lo = args.ph_lo, hi = args.ph_hi;
#define IN(k) (lo <= (k) && (k) < hi)
#define SEAM(k) do { if (IN((k) + 1)) xcd_barrier(bar); } while (0)
    LAS int* tb = (LAS int*)(ldsl + LDSCTL_OFF); LAS int* cn = tb + 64;

    if (IN(0)) { PHASE_BEGIN();
        Ptrs P; P.x = ap->in[I_X]; P.attn_w_in = ap->in[I_AWIN]; P.attn_w_out = ap->in[I_AWOUT]; P.conv_w_in = ap->in[I_CWIN]; P.conv_w_out = ap->in[I_CWOUT]; P.router_w = ap->in[I_RW]; P.ln_g = ap->in[I_LNG]; P.w1 = ap->in[I_W1]; P.w2 = ap->in[I_W2]; P.ws = ws;
        _Pragma("unroll 1") for (int rep = 0; rep < REP_P0; ++rep) p0_prologue(P, ldsl, gw, NGW, wave, lane); SEAM(0); }

#define MOE_GEMMS(L, pb) do { \
            if (IN((pb) + 4)) { PHASE_BEGIN(); \
                pg8::MoeProb<true, true> S{(const char*)(ws + WS_X8), (const char*)(ws + WS_W1) + (size_t)(L) * 32 * 2048 * 1024, (size_t)2048 * 1024, 8, G, vcu, (int)tb[32], tb, cn, (const int*)(ws + WS_LS), lane, tid}; \
                pg8::EpiMoe1 E{ws + WS_A2, ap->in[I_B1] + (size_t)(L) * 32 * 2048, (const float*)(ws + WS_S1) + (size_t)(L) * 32 * 2048, ln_bound(ap->in[I_LNG] + ((L) * 2 + 0) * D, ap->in[I_LNB] + ((L) * 2 + 0) * D, lane) * (1.0f / F8MAX) * (1.0f / KREP_MOE)}; \
                pg8::gemm_phase<pg8::MoeProb<true, true>, pg8::EpiMoe1, true, true, KREP_MOE>(ldsl + RING_OFF, ldsl + XL_OFF, S, E); \
                SEAM((pb) + 4); \
            } \
            if (IN((pb) + 5)) { PHASE_BEGIN(); \
                pg8::MoeProb<false, true> S{(const char*)(ws + WS_A2), (const char*)(ws + WS_W2) + (size_t)(L) * 32 * 1024 * 1024, (size_t)1024 * 1024, 4, G, vcu, (int)tb[32], tb, cn, (const int*)(ws + WS_LS), lane, tid}; \
                pg8::EpiMoe2 E{ws + WS_Y, ap->in[I_B2] + (size_t)(L) * 32 * 1024, (const float*)(ws + WS_S2) + (size_t)(L) * 32 * 1024, (const int*)(ws + WS_LS), (const float*)(ws + WS_LG)}; \
                pg8::gemm_phase<pg8::MoeProb<false, true>, pg8::EpiMoe2, true, true, KREP_MOE>(ldsl + RING_OFF, ldsl + XL_OFF, S, E); \
                SEAM((pb) + 5); \
            } \
        } while (0)
#if REP_MOE == 2
#define MOE_GEMMS_REP(L, pb) MOE_GEMMS(L, pb)
#else
#define MOE_GEMMS_REP(L, pb) do {} while (0)
#endif
#define MOE_HALF(L, pb) do { \
            if (IN((pb) + 3)) { PHASE_BEGIN(); \
                router_phase((const bf16_t*)(ws + WS_YP), ap->in[I_LNG] + ((L) * 2 + 0) * D, ap->in[I_LNB] + ((L) * 2 + 0) * D, (const bf16_t*)(ws + WS_WR) + (size_t)(L) * 32 * 1024, ap->in[I_RW] + (size_t)(L) * 1024 * 32, ap->in[I_RB] + (L) * 32, \
                             ws + WS_X8, (int*)(ws + WS_LS), (float*)(ws + WS_LG), (unsigned*)(ctl + CW_CNT) + (L) * 32 * 64, (char*)lds + RING_OFF, vcu, G, tid, wave, lane); \
                SEAM((pb) + 3); \
            } \
            if (IN((pb) + 4) || IN((pb) + 5)) { PHASE_BEGIN(); \
                if (tid < 64) { const int c_ = (lane < 32) ? (int)__hip_atomic_load(ctl + CW_CNT + ((L) * 32 + (lane & 31)) * 64, RLX_AGENT) : 0; const int t_ = (c_ + 255) >> 8; int p_ = t_; \
                    _Pragma("unroll") for (int o_ = 1; o_ < 32; o_ <<= 1) { const int q_ = __builtin_amdgcn_ds_bpermute((lane - o_) * 4, p_); if (lane >= o_) p_ += q_; } \
                    if (lane < 32) { cn[lane] = c_; tb[lane + 1] = p_; } if (lane == 0) tb[0] = 0; } \
                __syncthreads(); \
            } \
            MOE_GEMMS(L, pb); MOE_GEMMS_REP(L, pb); \
            if (REP_THIN == 2 && IN((pb) + 6)) { PHASE_BEGIN(); \
                ln2_phase((const bf16_t*)(ws + WS_YP), ap->in[I_LNG] + ((L) * 2 + 0) * D, ap->in[I_LNB] + ((L) * 2 + 0) * D, (const unsigned char*)(ws + WS_Y), ap->in[I_LNG] + ((L) * 2 + 1) * D, ap->in[I_LNB] + ((L) * 2 + 1) * D, (bf16_t*)(ws + WS_XB), ((L) == DEPTH - 1) ? ap->out : nullptr, ((((L) == 0) && (CM & 1)) || (((L) == 1) && (QM & 2)) || (((L) == 2) && (CM & 2))) ? ws + WS_XI : nullptr, (float*)(ws + WS_RS), gw, NGW, lane); \
            } \
            if (IN((pb) + 6)) { PHASE_BEGIN(); \
                ln2_phase((const bf16_t*)(ws + WS_YP), ap->in[I_LNG] + ((L) * 2 + 0) * D, ap->in[I_LNB] + ((L) * 2 + 0) * D, (const unsigned char*)(ws + WS_Y), ap->in[I_LNG] + ((L) * 2 + 1) * D, ap->in[I_LNB] + ((L) * 2 + 1) * D, (bf16_t*)(ws + WS_XB), ((L) == DEPTH - 1) ? ap->out : nullptr, ((((L) == 0) && (CM & 1)) || (((L) == 1) && (QM & 2)) || (((L) == 2) && (CM & 2))) ? ws + WS_XI : nullptr, (float*)(ws + WS_RS), gw, NGW, lane); \
                if ((pb) + 7 < N_PHASES) SEAM((pb) + 6); \
            } \
        } while (0)

#pragma unroll 1
    for (int lp = 0; lp < DEPTH / 2; ++lp) {
        {
            const int L = 2 * lp, pb = 1 + L * 7;
            if (IN(pb + 0)) {
                PHASE_BEGIN();
                if (QM == 3 || (QM != 0 && ((QM >> lp) & 1))) {
                pg8::DenseProbT<true> S; S.init(ws + WS_XI, ws + WS_WAI + (size_t)lp * 3072 * 1024, M, 3072, G, bx, tid);
                pg8::EpiQKV8 E{(bf16_t*)(ws + WS_Q), (size_t)(WS_K - WS_Q) / 2, QSCALE, (const float*)(ws + WS_SD) + lp * 3072, (const float*)(ws + WS_RS)};
                pg8::gemm_phase<pg8::DenseProbT<true>, pg8::EpiQKV8, true, true, 1, I8P>(ldsl + RING_OFF, ldsl + XL_OFF, S, E);
                } else {
                pg8::DenseProb S; S.init(ws + WS_XB, (const bf16_t*)(ws + WS_WA16) + (size_t)lp * 3072 * 1024, M, 3072, G, bx, tid);
                pg8::EpiQKV E{(bf16_t*)(ws + WS_Q), (size_t)(WS_K - WS_Q) / 2, QSCALE};
                pg8::gemm_phase<pg8::DenseProb, pg8::EpiQKV, true>(ldsl + RING_OFF, ldsl + XL_OFF, S, E);
                }
                SEAM(pb + 0);
            }
            if (IN(pb + 1)) {
                PHASE_BEGIN();
                const float* lf = ap->in[I_ALAM] + lp * 256;
                const float s1 = wave_sum(lf[lane] * lf[64 + lane]), s2 = wave_sum(lf[128 + lane] * lf[192 + lane]);
                const float lam_init = (lp == 0) ? 0.2f : (0.8f - 0.6f * 0.54881163609402643f);
                const float lam = __expf(s1) - __expf(s2) + lam_init;
                const bool o8 = (AOM == 3) || (AOM != 0 && ((AOM >> lp) & 1));
                const float oscl = o8 ? (1.0f - lam_init) * (F8MAX / attn_obound(ap->in[I_ASUB] + lp * 128, 1.0f - lam_init, lane)) : (1.0f - lam_init);
                int hprev = -1;
#pragma unroll 1
                for (int rep = 0; rep < REP_ATTN; ++rep)
#pragma unroll 1
                for (int i = 0; i < (BATCH * NH * 32) / 256; ++i) {
                    const int item = i * G + vcu;
                    if (item >= BATCH * NH * 32) break;
                    const int bh = item >> 5, qb = item & 31;
                    const bool newh = (i == 0) || ((bh & 7) != hprev); hprev = bh & 7;
                    att::attn_unit(bh >> 3, bh & 7, qb, (const bf16_t*)(ws + WS_Q), (const bf16_t*)(ws + WS_K), (const bf16_t*)(ws + WS_V), (bf16_t*)(ws + WS_O), lam, oscl,
                                   ap->in[I_ASUB] + lp * 128, ap->in[I_RELB], (char*)lds + RING_OFF, tid, newh, o8);
                    if (DEFER_W && lp == 0 && i == (vcu & 15)) {
                        Ptrs P; P.w1 = ap->in[I_W1]; P.w2 = ap->in[I_W2]; P.ws = ws;
                        int ln_s = lane; asm volatile("" : "+v"(ln_s));
                        deferred_strips(P.w1, P.w2, ws, ldsl, vcu, G, wave, ln_s);
                        hprev = -1;
                    }
                }
                SEAM(pb + 1);
            }
            if (IN(pb + 2)) {
                PHASE_BEGIN();
                if ((AOM == 3) || (AOM != 0 && ((AOM >> lp) & 1))) {
                const float lam_init = (lp == 0) ? 0.2f : (0.8f - 0.6f * 0.54881163609402643f);
                pg8::DenseProbT<true> S; S.init(ws + WS_O, ws + WS_WAO8 + (size_t)lp * 1024 * 1024, M, 1024, G, bx, tid);
                pg8::EpiResid8<false> E{(const bf16_t*)(ws + WS_XB), (bf16_t*)(ws + WS_YP), (const float*)(ws + WS_SD + 24 * 1024) + lp * 1024, nullptr, attn_obound(ap->in[I_ASUB] + lp * 128, 1.0f - lam_init, lane) * (1.0f / F8MAX)};
                pg8::gemm_phase<pg8::DenseProbT<true>, pg8::EpiResid8<false>, true, true>(ldsl + RING_OFF, ldsl + XL_OFF, S, E);
                } else {
                pg8::DenseProb S; S.init(ws + WS_O, (const bf16_t*)(ws + WS_WAO) + (size_t)lp * 1024 * 1024, M, 1024, G, bx, tid);
                pg8::EpiResid E{(const bf16_t*)(ws + WS_XB), (bf16_t*)(ws + WS_YP)};
                pg8::gemm_phase<pg8::DenseProb, pg8::EpiResid, true>(ldsl + RING_OFF, ldsl + XL_OFF, S, E);
                }
                SEAM(pb + 2);
            }
            MOE_HALF(L, pb);
        }
        {
            const int L = 2 * lp + 1, pb = 1 + L * 7;
            if (IN(pb + 0)) {
                PHASE_BEGIN();
                if (CM == 3 || (CM != 0 && ((CM >> lp) & 1))) {
                pg8::DenseProbT<true> S; S.init(ws + WS_XI, ws + WS_WCI + (size_t)lp * 3072 * 1024, M, 3072, G, bx, tid);
                pg8::EpiConvIn8 E{(bf16_t*)(ws + WS_Q), (bf16_t*)(ws + WS_K), (const float*)(ws + WS_SD + 32 * 1024) + lp * 3072, (const float*)(ws + WS_RS)};
                pg8::gemm_phase<pg8::DenseProbT<true>, pg8::EpiConvIn8, true, true, 1, I8P>(ldsl + RING_OFF, ldsl + XL_OFF, S, E);
                } else {
                pg8::DenseProb S; S.init(ws + WS_XB, (const bf16_t*)(ws + WS_WC16) + (size_t)lp * 3072 * 1024, M, 3072, G, bx, tid);
                pg8::EpiConvIn E{(bf16_t*)(ws + WS_Q), (bf16_t*)(ws + WS_K)};
                pg8::gemm_phase<pg8::DenseProb, pg8::EpiConvIn, true>(ldsl + RING_OFF, ldsl + XL_OFF, S, E);
                }
                SEAM(pb + 0);
            }
            if (IN(pb + 1)) { PHASE_BEGIN(); conv_phase((const bf16_t*)(ws + WS_Q), (const bf16_t*)(ws + WS_K), ap->in[I_CW] + lp * 3 * D, (bf16_t*)(ws + WS_O), (float*)(ws + WS_RS), (COM == 3) || (COM != 0 && ((COM >> lp) & 1)), gw, NGW, lane); SEAM(pb + 1); }
            if (IN(pb + 2)) {
                PHASE_BEGIN();
                if ((COM == 3) || (COM != 0 && ((COM >> lp) & 1))) {
                pg8::DenseProbT<true> S; S.init(ws + WS_O, ws + WS_WCO8 + (size_t)lp * 1024 * 1024, M, 1024, G, bx, tid);
                pg8::EpiResid8<true> E{(const bf16_t*)(ws + WS_XB), (bf16_t*)(ws + WS_YP), (const float*)(ws + WS_SD + 56 * 1024) + lp * 1024, (const float*)(ws + WS_RS), 1.0f};
                pg8::gemm_phase<pg8::DenseProbT<true>, pg8::EpiResid8<true>, true, true, 1, I8P>(ldsl + RING_OFF, ldsl + XL_OFF, S, E);
                } else {
                pg8::DenseProb S; S.init(ws + WS_O, (const bf16_t*)(ws + WS_WCO) + (size_t)lp * 1024 * 1024, M, 1024, G, bx, tid);
                pg8::EpiResid E{(const bf16_t*)(ws + WS_XB), (bf16_t*)(ws + WS_YP)};
                pg8::gemm_phase<pg8::DenseProb, pg8::EpiResid, true>(ldsl + RING_OFF, ldsl + XL_OFF, S, E);
                }
                SEAM(pb + 2);
            }
            MOE_HALF(L, pb);
        }
    }
#undef IN
#undef SEAM
}

extern "C" void kernel_launch(void* const* d_in, const int* in_sizes, int n_in, void* d_out, int out_size, void* d_ws, size_t ws_size, hipStream_t stream) {
    static int grid = 0;
    if (grid == 0) {
        if (n_in != 17 || in_sizes[0] != M * D || out_size != M * D || ws_size < WS_END) {
            fprintf(stderr, "kernel_launch: shape mismatch: n_in %d in0 %d out %d ws %zu (need %zu)\n", n_in, n_in > 0 ? in_sizes[0] : -1, out_size, ws_size, (size_t)WS_END); grid = -1; return; }
        int dev = 0, cus = 0, per_cu = 0;
        if (hipGetDevice(&dev) != hipSuccess || hipDeviceGetAttribute(&cus, hipDeviceAttributeMultiprocessorCount, dev) != hipSuccess) { grid = -1; return; }
        if (hipFuncSetAttribute((const void*)mk_fwd, hipFuncAttributeMaxDynamicSharedMemorySize, LDS_BYTES) != hipSuccess) { fprintf(stderr, "kernel_launch: hipFuncSetAttribute failed\n"); grid = -1; return; }
        if (hipOccupancyMaxActiveBlocksPerMultiprocessor(&per_cu, (const void*)mk_fwd, NWAVES * 64, LDS_BYTES) != hipSuccess || per_cu < 1)
            fprintf(stderr, "kernel_launch: occupancy query reports %d workgroups per CU\n", per_cu);
        (void)hipGetLastError();
        grid = cus;
    }
    if (grid < 0) return;
    if (hipMemsetAsync((char*)d_ws + WS_CTL, 0, CTL_ZERO_BYTES, stream) != hipSuccess) { fprintf(stderr, "kernel_launch: memset failed\n"); return; }
    Args a{};
    for (int i = 0; i < 17; ++i) a.in[i] = (const float*)d_in[i];
    a.out = (float*)d_out; a.ws = (unsigned char*)d_ws; a.pad = 0;
#if MK_SPLIT
    for (int p = 0; p < N_PHASES; ++p) { a.ph_lo = p; a.ph_hi = p + 1; a.li = p; hipLaunchKernelGGL(mk_fwd, dim3(grid), dim3(NWAVES * 64), LDS_BYTES, stream, a); }
#else
    a.ph_lo = 0; a.ph_hi = N_PHASES; a.li = 0;
    hipLaunchKernelGGL(mk_fwd, dim3(grid), dim3(NWAVES * 64), LDS_BYTES, stream, a);
#endif
    const hipError_t le = hipPeekAtLastError();
    if (le != hipSuccess) fprintf(stderr, "kernel_launch: launch failed: %s\n", hipGetErrorName(le));
}
```

```cpp
#include <hip/hip_runtime.h>
#include <hip/hip_bf16.h>
#include <cstdio>
#include <cstdint>

constexpr int BATCH = 16, SEQ = 4096, D = 1024, M = BATCH * SEQ, DEPTH = 4, NH = 8, NE = 32, TOPK = 4;
constexpr float LN_EPS = 1e-5f;
constexpr float ALPHA = 1.6817928305074290f;
constexpr float LOG2E = 1.4426950408889634f;
constexpr float QSCALE = 0.125f * LOG2E;
constexpr int LCAP = 65536;
constexpr int MAXRT = 1056;

constexpr size_t MiB = 1ull << 20;
constexpr size_t WS_CTL = 0, CTL_ZERO_BYTES = 1 * MiB;
constexpr size_t WS_WAI = 1 * MiB;
constexpr size_t WS_WAO = WS_WAI + 12 * MiB;
constexpr size_t WS_WCI = WS_WAO + 4 * MiB;
constexpr size_t WS_WCO = WS_WCI + 12 * MiB;
constexpr size_t WS_WR  = WS_WCO + 4 * MiB;
constexpr size_t WS_W1  = WS_WR + 1 * MiB;
constexpr size_t WS_W2  = WS_W1 + 256 * MiB;
constexpr size_t WS_S1  = WS_W2 + 128 * MiB;
constexpr size_t WS_S2  = WS_S1 + 1 * MiB;
constexpr size_t WS_SD  = WS_S2 + 512 * 1024;
constexpr size_t WS_RS  = WS_SD + 64 * 1024;
constexpr size_t WS_XB  = WS_S2 + 1 * MiB;
constexpr size_t WS_XI  = WS_XB + 128 * MiB;
constexpr size_t WS_X8  = WS_XI + 128 * MiB;
constexpr size_t WS_YP  = WS_X8 + 64 * MiB;
constexpr size_t WS_Q   = WS_YP + 128 * MiB;
constexpr size_t WS_K   = WS_Q + 128 * MiB;
constexpr size_t WS_V   = WS_K + 128 * MiB;
constexpr size_t WS_O   = WS_V + 128 * MiB;
constexpr size_t WS_LS  = WS_O + 128 * MiB;
constexpr size_t WS_LG  = WS_LS + 8 * MiB;
constexpr size_t WS_A2  = WS_LG + 8 * MiB;
constexpr size_t WS_Y   = WS_A2 + 264 * MiB;
constexpr size_t WS_WA16 = WS_Y + 513 * MiB;
constexpr size_t WS_WC16 = WS_WA16 + 12 * MiB;
constexpr size_t WS_WAO8 = WS_WC16 + 12 * MiB;
constexpr size_t WS_WCO8 = WS_WAO8 + 2 * MiB;
constexpr size_t WS_END = WS_WCO8 + 2 * MiB;
#ifndef F8_QKV_MASK
#define F8_QKV_MASK 3
#endif
#ifndef F8_CONV_MASK
#define F8_CONV_MASK 3
#endif
#ifndef F8_AOUT_MASK
#define F8_AOUT_MASK 3
#endif
#ifndef F8_COUT_MASK
#define F8_COUT_MASK 3
#endif
constexpr int QM = F8_QKV_MASK, CM = F8_CONV_MASK, AOM = F8_AOUT_MASK, COM = F8_COUT_MASK;
constexpr int NA8 = (AOM & 1) + (AOM >> 1), NO8 = (COM & 1) + (COM >> 1), AJ0 = (AOM & 1) ? 0 : 1, OJ0 = (COM & 1) ? 0 : 1;
constexpr int NA16 = 2 - NA8, NO16 = 2 - NO8, AK0 = (AOM & 1) ? 1 : 0, OK0 = (COM & 1) ? 1 : 0;
constexpr int NQ8 = (QM & 1) + (QM >> 1), NC8 = (CM & 1) + (CM >> 1), QJ0 = (QM & 1) ? 0 : 1, CJ0 = (CM & 1) ? 0 : 1;
constexpr int NQ16 = 2 - NQ8, NC16 = 2 - NC8, QK0 = (QM & 1) ? 1 : 0, CK0 = (CM & 1) ? 1 : 0;
constexpr float F8MAX = 448.0f * 0.999f;
constexpr bool I8P = true;
constexpr float QMAXP = I8P ? 127.0f : 448.0f * 0.999f;
constexpr float YSCALE = 16.0f;
constexpr float A2SCALE = 8.0f;
constexpr int CW_TMO = 0, CW_CODE = 1;
constexpr int CW_BAR = 4096;
constexpr int CW_CNT = 16384;

constexpr int RING_OFF = 0, RING_BYTES = 131072;
constexpr int LDSCTL_OFF = RING_BYTES, MISC_OFF = LDSCTL_OFF + 1024;
constexpr int XL_OFF = LDSCTL_OFF + 4096;
constexpr int LDS_BYTES = 147456;

#define GAS __attribute__((address_space(1)))
#define LAS __attribute__((address_space(3)))
typedef unsigned short bf16_t;
typedef unsigned v4u __attribute__((ext_vector_type(4)));
typedef float f32x4 __attribute__((ext_vector_type(4)));
typedef float f32x2 __attribute__((ext_vector_type(2)));
typedef short bf16x8 __attribute__((ext_vector_type(8)));
typedef float f32x16 __attribute__((ext_vector_type(16)));
typedef short s16x4 __attribute__((ext_vector_type(4)));
typedef GAS unsigned gu32;
#define RLX_AGENT __ATOMIC_RELAXED, __HIP_MEMORY_SCOPE_AGENT
#define LDS_WAIT() asm volatile("s_waitcnt lgkmcnt(0)" ::: "memory")
#define VM_WAIT() asm volatile("s_waitcnt vmcnt(0)" ::: "memory")

__device__ __forceinline__ unsigned cvt_pk_bf16(float lo, float hi) { unsigned r; asm volatile("v_cvt_pk_bf16_f32 %0, %1, %2" : "=v"(r) : "v"(lo), "v"(hi)); return r; }
__device__ __forceinline__ float bf_lo(unsigned u) { return __uint_as_float(u << 16); }
__device__ __forceinline__ float bf_hi(unsigned u) { return __uint_as_float(u & 0xffff0000u); }
__device__ __forceinline__ int lane_local() { int l; asm volatile("v_mbcnt_lo_u32_b32 %0, -1, 0\n\tv_mbcnt_hi_u32_b32 %0, -1, %0" : "=v"(l)); return l; }
__device__ __forceinline__ float shx(float v, int m, int l) { return __int_as_float(__builtin_amdgcn_ds_bpermute((l ^ m) << 2, __float_as_int(v))); }
__device__ __forceinline__ float shx(float v, int m) { return shx(v, m, lane_local()); }
__device__ __forceinline__ float wave_sum(float v) {
    const int l_ = lane_local();
#pragma unroll
    for (int o = 1; o < 64; o <<= 1) v += shx(v, o, l_);
    return v;
}

#ifndef KREP_MOE
#define KREP_MOE 1
#endif
namespace pg8 {
constexpr float KREP_MOE_ = (float)KREP_MOE;
#define PG8_LAS __attribute__((address_space(3)))
constexpr int BM = 256, BK = 64, HALF = 128, HTB = HALF * BK * 2, STAGE_BYTES = 8 * HTB, NXCD = 8, WGM = 8, KD = 1024, NTK = KD / BK;

__host__ __device__ __forceinline__ int lds_byte(int r, int c) { const int st = (r >> 4) * 2 + (c >> 5), rr = r & 15, cc = c & 31, ob = rr * 64 + cc * 2; return st * 1024 + (ob ^ (((ob >> 9) & 1) << 5)); }
__host__ __device__ __forceinline__ void stage_rc(int b, int& R, int& C) { const int st = b / 1024, sb = b % 1024, swz = sb ^ (((sb >> 9) & 1) << 5); R = (st >> 1) * 16 + swz / 64; C = (st & 1) * 32 + (swz % 64) / 2; }
__host__ __device__ __forceinline__ int perm32(int rho) { const int n = rho >> 4, i = rho & 15; return 8 * (i >> 2) + 4 * n + (i & 3); }

struct Unit { int pm, pn, e, valid, lr0; };
__device__ __forceinline__ void dma1k(const void* src, PG8_LAS unsigned char* dst, int lane) {
    __builtin_amdgcn_global_load_lds((const __attribute__((address_space(1))) unsigned*)((const char*)src + lane * 16), (PG8_LAS unsigned*)dst, 16, 0, 0);
}
constexpr int XL_EPI = 4096, XL_GATHER = 1024, XL_BYTES = 2 * (XL_EPI + XL_GATHER);

template <bool F8> struct DenseProbT {
    static constexpr bool GATHER = false;
    static constexpr int RP = F8 ? 1024 : 2048;
    const char* A; const char* Bt; int nM, nN, nwg, G, c, tid;
    __device__ void init(const void* A_, const void* Bt_, int Mrows, int N, int G_, int c_, int tid_) { A = (const char*)A_; Bt = (const char*)Bt_; nM = Mrows / BM; nN = N / BM; nwg = nM * nN; G = G_; c = c_; tid = tid_; }
    __device__ __forceinline__ bool next(int i, Unit& u) const {
        const long L = (long)i * G + c; if (L >= nwg) return false;
        int wgid = (int)L; { const int q = nwg / NXCD, r = nwg % NXCD, xcd = wgid % NXCD, off = wgid / NXCD; wgid = (xcd < r ? xcd * (q + 1) : r * (q + 1) + (xcd - r) * q) + off; }
        const int nig = WGM * nN, gid = wgid / nig, fm = gid * WGM, gsz = (nM - fm) < WGM ? (nM - fm) : WGM;
        u.pm = fm + ((wgid % nig) % gsz); u.pn = (wgid % nig) / gsz; u.e = 0; u.valid = 256; u.lr0 = 0; return true;
    }
    __device__ __forceinline__ void a_off(const Unit& u, const int (&RA)[2], const int (&CA)[2], unsigned (&vo)[2][2]) const {
#pragma unroll
        for (int h = 0; h < 2; ++h)
#pragma unroll
            for (int i = 0; i < 2; ++i) vo[h][i] = (unsigned)((u.pm * BM + h * HALF + RA[i]) * RP + CA[i] * 2);
    }
    __device__ __forceinline__ unsigned a_tile(const Unit& u) const { return (unsigned)u.pm * (unsigned)(BM * RP); }
    __device__ __forceinline__ unsigned b_off(const Unit& u) const { return (unsigned)u.pn * (unsigned)(BM * RP); }    __device__ __forceinline__ void dma_rows(const Unit&, PG8_LAS unsigned char*, int, int) const {}
    __device__ __forceinline__ void a_off_lds(const Unit&, const int (&)[2], const int (&)[2], const PG8_LAS unsigned char*, unsigned (&)[2][2]) const {}
};
typedef DenseProbT<false> DenseProb;

template <bool GATHER_, bool F8> struct MoeProb {
    static constexpr bool GATHER = GATHER_;
    static constexpr int RP = F8 ? 1024 : 2048;
    const char* A; const char* Bt; size_t b_estride; int nN, G, v, RT; const PG8_LAS int* tb; const PG8_LAS int* cn; const int* lslot; int lane, tid;
    __device__ __forceinline__ bool next(int i, Unit& u) const {
        const int L = i * G + v; if (L >= RT * nN) return false;
        const int rt = L / nN; u.pm = rt; u.pn = L - rt * nN;
        const unsigned long long bal = __ballot(lane < 32 && rt >= tb[(lane & 31) + 1]);
        const int e = __builtin_amdgcn_readfirstlane(__popcll(bal)); u.e = e;
        const int tb_e = __builtin_amdgcn_readfirstlane(tb[e]), cn_e = __builtin_amdgcn_readfirstlane(cn[e]);
        u.lr0 = 256 * (rt - tb_e); const int rem = cn_e - u.lr0; u.valid = rem < 256 ? rem : 256; return true;
    }
    __device__ __forceinline__ void a_off(const Unit& u, const int (&RA)[2], const int (&CA)[2], unsigned (&vo)[2][2]) const {
        if constexpr (GATHER) {
            const int* ls = lslot + (size_t)u.e * LCAP + u.lr0;
#pragma unroll
            for (int h = 0; h < 2; ++h)
#pragma unroll
                for (int i = 0; i < 2; ++i) { const int rl = h * HALF + RA[i]; const int slot = ls[rl < u.valid ? rl : 0]; vo[h][i] = (unsigned)((slot >> 2) * RP + CA[i] * 2); }
        } else {
#pragma unroll
            for (int h = 0; h < 2; ++h)
#pragma unroll
                for (int i = 0; i < 2; ++i) vo[h][i] = (unsigned)((u.pm * BM + h * HALF + RA[i]) * RP + CA[i] * 2);
        }
    }
    __device__ __forceinline__ unsigned a_tile(const Unit& u) const { return (unsigned)u.pm * (unsigned)(BM * RP); }
    __device__ __forceinline__ unsigned b_off(const Unit& u) const { return (unsigned)u.e * (unsigned)b_estride + (unsigned)u.pn * (unsigned)(BM * RP); }
    __device__ __forceinline__ void dma_rows(const Unit& u, PG8_LAS unsigned char* dst, int wid, int lane_) const { if constexpr (GATHER) { if (wid == 0) dma1k(lslot + (size_t)u.e * LCAP + u.lr0, dst, lane_); } }
    __device__ __forceinline__ void a_off_lds(const Unit& u, const int (&RA)[2], const int (&CA)[2], const PG8_LAS unsigned char* src, unsigned (&vo)[2][2]) const {
        if constexpr (GATHER) { const PG8_LAS int* ls = (const PG8_LAS int*)src;
#pragma unroll
            for (int h = 0; h < 2; ++h)
#pragma unroll
                for (int i = 0; i < 2; ++i) { const int rl = h * HALF + RA[i]; const int slot = ls[rl < u.valid ? rl : 0]; vo[h][i] = (unsigned)((slot >> 2) * RP + CA[i] * 2); } }
    }
};

__device__ __forceinline__ v4u pack8(const f32x4 v0, const f32x4 v1) { v4u w; w.x = cvt_pk_bf16(v0[0], v0[1]); w.y = cvt_pk_bf16(v0[2], v0[3]); w.z = cvt_pk_bf16(v1[0], v1[1]); w.w = cvt_pk_bf16(v1[2], v1[3]); return w; }

__device__ __forceinline__ void st16(void* base, unsigned off, v4u v) { *(v4u*)((char*)base + off) = v; }
struct EpiQKV {
    __device__ __forceinline__ void dma(const Unit&, PG8_LAS unsigned char*, int, int) const {}
    bf16_t* O; size_t stride; float scale0;
    __device__ __forceinline__ void operator()(const f32x4 (&acc)[2][2][4][2], const Unit& u, int wr, int wc, int fr_, int fq_, const PG8_LAS unsigned char* xl) const {
        int fr = fr_, fq = fq_; asm volatile("" : "+v"(fr), "+v"(fq));
        const int row0 = u.pm * BM + wr * 64 + fr; const int t = u.pn >> 2; const int colt = (u.pn & 3) * BM;
        bf16_t* base = O + (size_t)t * stride; const float sc = (t == 0) ? scale0 : 1.f; const unsigned off0 = (unsigned)(row0 * D + colt + wc * 32 + 8 * fq) * 2u;
#pragma unroll
        for (int ai = 0; ai < 2; ++ai)
#pragma unroll
            for (int m = 0; m < 4; ++m)
#pragma unroll
                for (int bj = 0; bj < 2; ++bj) st16(base, off0 + (unsigned)((ai * HALF + m * 16) * D + bj * HALF) * 2u, pack8(acc[ai][bj][m][0] * sc, acc[ai][bj][m][1] * sc));
    }
};
struct EpiConvIn {
    __device__ __forceinline__ void dma(const Unit&, PG8_LAS unsigned char*, int, int) const {}
    bf16_t* GB; bf16_t* Z;
    __device__ __forceinline__ void operator()(const f32x4 (&acc)[2][2][4][2], const Unit& u, int wr, int wc, int fr_, int fq_, const PG8_LAS unsigned char* xl) const {
        int fr = fr_, fq = fq_; asm volatile("" : "+v"(fr), "+v"(fq));
        const int row0 = u.pm * BM + wr * 64 + fr;
        if (u.pn < 4) { const unsigned off0 = (unsigned)(row0 * D + u.pn * BM + wc * 32 + 8 * fq) * 2u;
#pragma unroll
            for (int ai = 0; ai < 2; ++ai)
#pragma unroll
                for (int m = 0; m < 4; ++m)
#pragma unroll
                    for (int bj = 0; bj < 2; ++bj) st16(GB, off0 + (unsigned)((ai * HALF + m * 16) * D + bj * HALF) * 2u, pack8(acc[ai][bj][m][0], acc[ai][bj][m][1]));
        } else { const unsigned off0 = (unsigned)(row0 * D + (u.pn - 4) * HALF + wc * 32 + 8 * fq) * 2u;
#pragma unroll
            for (int ai = 0; ai < 2; ++ai)
#pragma unroll
                for (int m = 0; m < 4; ++m) st16(Z, off0 + (unsigned)((ai * HALF + m * 16) * D) * 2u, pack8(acc[ai][0][m][0] * acc[ai][1][m][0], acc[ai][0][m][1] * acc[ai][1][m][1]));
        }
    }
};
struct EpiQKV8 {
    bf16_t* O; size_t stride; float scale0; const float* sw; const float* rs;
    __device__ __forceinline__ void dma(const Unit& u, PG8_LAS unsigned char* xl, int wid, int lane) const {
        if (wid == 0) dma1k(sw + u.pn * BM, xl, lane); else if (wid == 1) dma1k(rs + u.pm * BM, xl + 1024, lane);
    }
    __device__ __forceinline__ void operator()(const f32x4 (&acc)[2][2][4][2], const Unit& u, int wr, int wc, int fr_, int fq_, const PG8_LAS unsigned char* xl) const {
        int fr = fr_, fq = fq_; asm volatile("" : "+v"(fr), "+v"(fq));
        const int row0 = u.pm * BM + wr * 64 + fr; const int t = u.pn >> 2; const int colt = (u.pn & 3) * BM; const int cl = wc * 32 + 8 * fq;
        bf16_t* base = O + (size_t)t * stride; const float sc = (t == 0) ? scale0 : 1.f; const unsigned off0 = (unsigned)(row0 * D + colt + cl) * 2u;
        const PG8_LAS float* sp = (const PG8_LAS float*)xl + cl; const PG8_LAS float* rp = (const PG8_LAS float*)(xl + 1024) + wr * 64 + fr;
        f32x4 sv[2][2];
#pragma unroll
        for (int bj = 0; bj < 2; ++bj)
#pragma unroll
            for (int n = 0; n < 2; ++n) sv[bj][n] = *(const PG8_LAS f32x4*)(sp + bj * HALF + 4 * n) * sc;
#pragma unroll
        for (int ai = 0; ai < 2; ++ai)
#pragma unroll
            for (int m = 0; m < 4; ++m) { const float r = rp[ai * HALF + m * 16];
#pragma unroll
                for (int bj = 0; bj < 2; ++bj) st16(base, off0 + (unsigned)((ai * HALF + m * 16) * D + bj * HALF) * 2u, pack8(acc[ai][bj][m][0] * (sv[bj][0] * r), acc[ai][bj][m][1] * (sv[bj][1] * r))); }
    }
};
struct EpiConvIn8 {
    bf16_t* GB; bf16_t* Z; const float* sw; const float* rs;
    __device__ __forceinline__ void dma(const Unit& u, PG8_LAS unsigned char* xl, int wid, int lane) const { if (wid == 0) dma1k(sw + u.pn * BM, xl, lane); else if (wid == 1) dma1k(rs + u.pm * BM, xl + 1024, lane); }
    __device__ __forceinline__ void operator()(const f32x4 (&acc)[2][2][4][2], const Unit& u, int wr, int wc, int fr_, int fq_, const PG8_LAS unsigned char* xl) const {
        int fr = fr_, fq = fq_; asm volatile("" : "+v"(fr), "+v"(fq));
        const int row0 = u.pm * BM + wr * 64 + fr; const int cl = wc * 32 + 8 * fq;
        const PG8_LAS float* sp = (const PG8_LAS float*)xl + cl; const PG8_LAS float* rp = (const PG8_LAS float*)(xl + 1024) + wr * 64 + fr;
        f32x4 sv[2][2];
#pragma unroll
        for (int bj = 0; bj < 2; ++bj)
#pragma unroll
            for (int n = 0; n < 2; ++n) sv[bj][n] = *(const PG8_LAS f32x4*)(sp + bj * HALF + 4 * n);
        if (u.pn < 4) { const unsigned off0 = (unsigned)(row0 * D + u.pn * BM + cl) * 2u;
#pragma unroll
            for (int ai = 0; ai < 2; ++ai)
#pragma unroll
                for (int m = 0; m < 4; ++m) { const float r = rp[ai * HALF + m * 16];
#pragma unroll
                    for (int bj = 0; bj < 2; ++bj) st16(GB, off0 + (unsigned)((ai * HALF + m * 16) * D + bj * HALF) * 2u, pack8(acc[ai][bj][m][0] * (sv[bj][0] * r), acc[ai][bj][m][1] * (sv[bj][1] * r))); }
        } else { const unsigned off0 = (unsigned)(row0 * D + (u.pn - 4) * HALF + cl) * 2u;
            const f32x4 sz0 = sv[0][0] * sv[1][0], sz1 = sv[0][1] * sv[1][1];
#pragma unroll
            for (int ai = 0; ai < 2; ++ai)
#pragma unroll
                for (int m = 0; m < 4; ++m) { const float r = rp[ai * HALF + m * 16], r2 = r * r;
                    st16(Z, off0 + (unsigned)((ai * HALF + m * 16) * D) * 2u, pack8(acc[ai][0][m][0] * acc[ai][1][m][0] * (sz0 * r2), acc[ai][0][m][1] * acc[ai][1][m][1] * (sz1 * r2))); }
        }
    }
};
struct EpiResid {
    __device__ __forceinline__ void dma(const Unit&, PG8_LAS unsigned char*, int, int) const {}
    const bf16_t* X; bf16_t* Yp;
    __device__ __forceinline__ void operator()(const f32x4 (&acc)[2][2][4][2], const Unit& u, int wr, int wc, int fr_, int fq_, const PG8_LAS unsigned char* xl) const {
        int fr = fr_, fq = fq_; asm volatile("" : "+v"(fr), "+v"(fq));
        const unsigned off0 = (unsigned)((u.pm * BM + wr * 64 + fr) * D + u.pn * BM + wc * 32 + 8 * fq) * 2u;
#pragma unroll
        for (int ai = 0; ai < 2; ++ai)
#pragma unroll
            for (int m = 0; m < 4; ++m)
#pragma unroll
                for (int bj = 0; bj < 2; ++bj) { const unsigned off = off0 + (unsigned)((ai * HALF + m * 16) * D + bj * HALF) * 2u; const v4u xr = *(const v4u*)((const char*)X + off);
                    f32x4 v0 = acc[ai][bj][m][0], v1 = acc[ai][bj][m][1];
                    v0[0] += ALPHA * bf_lo(xr.x); v0[1] += ALPHA * bf_hi(xr.x); v0[2] += ALPHA * bf_lo(xr.y); v0[3] += ALPHA * bf_hi(xr.y);
                    v1[0] += ALPHA * bf_lo(xr.z); v1[1] += ALPHA * bf_hi(xr.z); v1[2] += ALPHA * bf_lo(xr.w); v1[3] += ALPHA * bf_hi(xr.w);
                    st16(Yp, off, pack8(v0, v1)); }
    }
};
template <bool ROWS> struct EpiResid8 {
    const bf16_t* X; bf16_t* Yp; const float* sw; const float* rs; float rsc;
    __device__ __forceinline__ void dma(const Unit& u, PG8_LAS unsigned char* xl, int wid, int lane) const {
        if (wid == 0) dma1k(sw + u.pn * BM, xl, lane); else if (ROWS && wid == 1) dma1k(rs + u.pm * BM, xl + 1024, lane);
    }
    __device__ __forceinline__ void operator()(const f32x4 (&acc)[2][2][4][2], const Unit& u, int wr, int wc, int fr_, int fq_, const PG8_LAS unsigned char* xl) const {
        int fr = fr_, fq = fq_; asm volatile("" : "+v"(fr), "+v"(fq));
        const int cl = wc * 32 + 8 * fq;
        const unsigned off0 = (unsigned)((u.pm * BM + wr * 64 + fr) * D + u.pn * BM + cl) * 2u;
        const PG8_LAS float* sp = (const PG8_LAS float*)xl + cl; const PG8_LAS float* rp = (const PG8_LAS float*)(xl + 1024) + wr * 64 + fr;
        f32x4 sv[2][2];
#pragma unroll
        for (int bj = 0; bj < 2; ++bj)
#pragma unroll
            for (int n = 0; n < 2; ++n) sv[bj][n] = *(const PG8_LAS f32x4*)(sp + bj * HALF + 4 * n) * (ROWS ? 1.0f : rsc);
#pragma unroll
        for (int ai = 0; ai < 2; ++ai)
#pragma unroll
            for (int m = 0; m < 4; ++m) { float r = 1.0f; if (ROWS) r = rp[ai * HALF + m * 16];
#pragma unroll
                for (int bj = 0; bj < 2; ++bj) { const unsigned off = off0 + (unsigned)((ai * HALF + m * 16) * D + bj * HALF) * 2u; const v4u xr = *(const v4u*)((const char*)X + off);
                    f32x4 v0 = acc[ai][bj][m][0] * sv[bj][0], v1 = acc[ai][bj][m][1] * sv[bj][1]; if (ROWS) { v0 *= r; v1 *= r; }
                    v0[0] += ALPHA * bf_lo(xr.x); v0[1] += ALPHA * bf_hi(xr.x); v0[2] += ALPHA * bf_lo(xr.y); v0[3] += ALPHA * bf_hi(xr.y);
                    v1[0] += ALPHA * bf_lo(xr.z); v1[1] += ALPHA * bf_hi(xr.z); v1[2] += ALPHA * bf_lo(xr.w); v1[3] += ALPHA * bf_hi(xr.w);
                    st16(Yp, off, pack8(v0, v1)); } }
    }
};
__device__ __forceinline__ unsigned pk4_fp8(float a, float b, float c, float d) { int p = 0; p = __builtin_amdgcn_cvt_pk_fp8_f32(a, b, p, false); p = __builtin_amdgcn_cvt_pk_fp8_f32(c, d, p, true); return (unsigned)p; }
__device__ __forceinline__ unsigned pk4_i8(float a, float b, float c, float d) {
    unsigned r = 0;
    r = __builtin_amdgcn_cvt_pk_u8_f32(__builtin_rintf(a + 128.f), 0, r); r = __builtin_amdgcn_cvt_pk_u8_f32(__builtin_rintf(b + 128.f), 1, r);
    r = __builtin_amdgcn_cvt_pk_u8_f32(__builtin_rintf(c + 128.f), 2, r); r = __builtin_amdgcn_cvt_pk_u8_f32(__builtin_rintf(d + 128.f), 3, r);
    return r ^ 0x80808080u;
}
template <bool I8> __device__ __forceinline__ unsigned pkq4(float a, float b, float c, float d) { if constexpr (I8) return pk4_i8(a, b, c, d); else return pk4_fp8(a, b, c, d); }
__device__ __forceinline__ f32x2 swiglu8_pk(f32x2 g, f32x2 l8) {
    g.x = fminf(g.x, 7.0f); g.y = fminf(g.y, 7.0f);
    l8.x = fminf(fmaxf(l8.x, -56.0f), 56.0f); l8.y = fminf(fmaxf(l8.y, -56.0f), 56.0f);
    const f32x2 t = g * (-1.702f * LOG2E);
    f32x2 e; e.x = __builtin_amdgcn_exp2f(t.x); e.y = __builtin_amdgcn_exp2f(t.y);
    const f32x2 d = e + 1.0f;
    f32x2 r; r.x = __builtin_amdgcn_rcpf(d.x); r.y = __builtin_amdgcn_rcpf(d.y);
    return (g * r) * (l8 + A2SCALE);
}
struct EpiMoe1 {
    unsigned char* A2; const float* b1; const float* sw; float inv_sa;
    __device__ __forceinline__ void dma(const Unit& u, PG8_LAS unsigned char* xl, int wid, int lane) const {
        if (wid == 0) dma1k(b1 + (size_t)u.e * 2048 + u.pn * BM, xl, lane); else if (wid == 1) dma1k(sw + (size_t)u.e * 2048 + u.pn * BM, xl + 1024, lane);
    }
    __device__ __forceinline__ void operator()(const f32x4 (&acc)[2][2][4][2], const Unit& u, int wr, int wc, int fr_, int fq_, const PG8_LAS unsigned char* xl) const {
        int fr = fr_, fq = fq_; asm volatile("" : "+v"(fr), "+v"(fq));
        const int cl = wc * 32 + 8 * fq; const unsigned off0 = (unsigned)((u.pm * BM + wr * 64 + fr) * D + u.pn * HALF + cl);
        const PG8_LAS float* bp = (const PG8_LAS float*)xl + 2 * cl; f32x4 bb[4];
#pragma unroll
        for (int j = 0; j < 4; ++j) bb[j] = *(const PG8_LAS f32x4*)(bp + 4 * j);
        const PG8_LAS float* sp = (const PG8_LAS float*)(xl + 1024) + cl;
        const f32x4 sg0 = *(const PG8_LAS f32x4*)(sp) * inv_sa, sg1 = *(const PG8_LAS f32x4*)(sp + 4) * inv_sa;
        const f32x4 sl0 = *(const PG8_LAS f32x4*)(sp + HALF) * (inv_sa * A2SCALE), sl1 = *(const PG8_LAS f32x4*)(sp + HALF + 4) * (inv_sa * A2SCALE);
        f32x2 sgp[4] = {{sg0[0], sg0[1]}, {sg0[2], sg0[3]}, {sg1[0], sg1[1]}, {sg1[2], sg1[3]}}, slp[4] = {{sl0[0], sl0[1]}, {sl0[2], sl0[3]}, {sl1[0], sl1[1]}, {sl1[2], sl1[3]}};
        f32x2 bgp[4], blp[4];
#pragma unroll
        for (int q = 0; q < 4; ++q) { bgp[q] = (f32x2){bb[q][0], bb[q][2]}; blp[q] = (f32x2){bb[q][1] * A2SCALE, bb[q][3] * A2SCALE}; }
        const unsigned offp = off0 + ((fq & 1) ? (unsigned)(16 * D - 8) : 0u);
#pragma unroll
        for (int ai = 0; ai < 2; ++ai)
#pragma unroll
            for (int mp = 0; mp < 2; ++mp) { typedef unsigned u32x2 __attribute__((ext_vector_type(2))); u32x2 w[2];
#pragma unroll
                for (int mm = 0; mm < 2; ++mm) { const int m = 2 * mp + mm; f32x2 o[4];
#pragma unroll
                    for (int q = 0; q < 4; ++q) { const f32x4 ga = acc[ai][0][m][q >> 1], la = acc[ai][1][m][q >> 1]; const int h2 = (q & 1) * 2;
                        const f32x2 g = (f32x2){ga[h2], ga[h2 + 1]} * sgp[q] + bgp[q], l8 = (f32x2){la[h2], la[h2 + 1]} * slp[q] + blp[q];
                        o[q] = swiglu8_pk(g, l8); }
                    w[mm].x = pk4_fp8(o[0].x, o[0].y, o[1].x, o[1].y); w[mm].y = pk4_fp8(o[2].x, o[2].y, o[3].x, o[3].y); }
                const auto sx = __builtin_amdgcn_permlane16_swap(w[0].x, w[1].x, false, false); const auto sy = __builtin_amdgcn_permlane16_swap(w[0].y, w[1].y, false, false);
                const v4u ov = {sx[0], sy[0], sx[1], sy[1]};
                *(v4u*)(A2 + (offp + (unsigned)((ai * HALF + mp * 32) * D))) = ov; }
    }
};
struct EpiMoe2 {
    unsigned char* Y; const float* b2; const float* sw; const int* lslot; const float* lgate;
    __device__ __forceinline__ void dma(const Unit& u, PG8_LAS unsigned char* xl, int wid, int lane) const {
        const size_t lb = (size_t)u.e * LCAP + u.lr0;
        if (wid == 0) dma1k(b2 + (size_t)u.e * 1024 + u.pn * BM, xl, lane); else if (wid == 1) dma1k(sw + (size_t)u.e * 1024 + u.pn * BM, xl + 1024, lane);
        else if (wid == 2) dma1k(lslot + lb, xl + 2048, lane); else if (wid == 3) dma1k(lgate + lb, xl + 3072, lane);
    }
    __device__ __forceinline__ void operator()(const f32x4 (&acc)[2][2][4][2], const Unit& u, int wr, int wc, int fr_, int fq_, const PG8_LAS unsigned char* xl) const {
        int fr = fr_, fq = fq_; asm volatile("" : "+v"(fr), "+v"(fq));
        const int rl0 = wr * 64 + fr, cl = wc * 32 + 8 * fq, col0 = u.pn * BM + cl;
        const PG8_LAS float* bp = (const PG8_LAS float*)xl + cl; const PG8_LAS float* sp = (const PG8_LAS float*)(xl + 1024) + cl; f32x4 bv[2][2], sv[2][2];
#pragma unroll
        for (int bj = 0; bj < 2; ++bj)
#pragma unroll
            for (int n = 0; n < 2; ++n) { bv[bj][n] = *(const PG8_LAS f32x4*)(bp + bj * HALF + 4 * n); sv[bj][n] = *(const PG8_LAS f32x4*)(sp + bj * HALF + 4 * n) * (1.0f / (A2SCALE * KREP_MOE_)); }
        const PG8_LAS int* sl = (const PG8_LAS int*)(xl + 2048); const PG8_LAS float* gl = (const PG8_LAS float*)(xl + 3072);
        const unsigned cadj = (unsigned)(u.pn * BM + ((fq & 1) ? (HALF + cl - 8) : cl));
#pragma unroll
        for (int ai = 0; ai < 2; ++ai)
#pragma unroll
            for (int m = 0; m < 4; ++m) { const int rl = rl0 + ai * HALF + m * 16;
                const bool ok = rl < u.valid; const int slot = ok ? sl[rl] : M * 4; const float g = gl[rl] * YSCALE;
                typedef unsigned u32x2 __attribute__((ext_vector_type(2))); u32x2 w[2];
#pragma unroll
                for (int bj = 0; bj < 2; ++bj) { f32x4 v0 = (acc[ai][bj][m][0] * sv[bj][0] + bv[bj][0]) * g, v1 = (acc[ai][bj][m][1] * sv[bj][1] + bv[bj][1]) * g;
#pragma unroll
                    for (int i = 0; i < 4; ++i) { v0[i] = fminf(fmaxf(v0[i], -448.0f), 448.0f); v1[i] = fminf(fmaxf(v1[i], -448.0f), 448.0f); }
                    w[bj].x = pk4_fp8(v0[0], v0[1], v0[2], v0[3]); w[bj].y = pk4_fp8(v1[0], v1[1], v1[2], v1[3]); }
                const auto sx = __builtin_amdgcn_permlane16_swap(w[0].x, w[1].x, false, false); const auto sy = __builtin_amdgcn_permlane16_swap(w[0].y, w[1].y, false, false);
                const v4u o = {sx[0], sy[0], sx[1], sy[1]};
                *(v4u*)(Y + ((unsigned)(slot * D) + cadj)) = o; }
    }
};

typedef int v8i_t __attribute__((ext_vector_type(8))); typedef int v4i_t __attribute__((ext_vector_type(4)));
__device__ __forceinline__ v8i_t cat8(bf16x8 lo, bf16x8 hi) { const v4i_t a = __builtin_bit_cast(v4i_t, lo), b = __builtin_bit_cast(v4i_t, hi); return __builtin_shufflevector(a, b, 0, 1, 2, 3, 4, 5, 6, 7); }
template <class Prob, class Epi, bool ALIGN_EPI, bool F8 = false, int KREP = 1, bool I8 = false>
__device__ __forceinline__ void gemm_phase(PG8_LAS unsigned char* lds, PG8_LAS unsigned char* xl, const Prob& P, const Epi& E) {
    int tid_ = P.tid; asm volatile("" : "+v"(tid_));
    const int tid = tid_, wid = __builtin_amdgcn_readfirstlane(tid >> 6), lane = tid & 63, wr = wid >> 2, wc = wid & 3, fr = lane & 15, fq = lane >> 4;
    constexpr int RP = F8 ? 1024 : 2048, nt = F8 ? 8 : NTK;
    constexpr bool GA = Prob::GATHER;
    int RA[2], CA[2]; unsigned voffB[2], voffA[2];
#pragma unroll
    for (int i = 0; i < 2; ++i) { int R, C; stage_rc(tid * 16 + i * 8192, R, C); const int Rb = (R & ~31) + perm32(R & 31); RA[i] = R; CA[i] = C; voffB[i] = (unsigned)(Rb * RP + C * 2); voffA[i] = (unsigned)(R * RP + C * 2); }
    constexpr unsigned kstep = (unsigned)(BK * 2);
    constexpr unsigned hstep = (unsigned)HALF * RP;
    const unsigned ldsw = (unsigned)wid * 1024u;
    const int aoff = lds_byte(wr * 64 + fr, fq * 8), boff = lds_byte(wc * 32 + fr, fq * 8);
    typedef const __attribute__((address_space(1))) unsigned* gptr_t;
#define PG8_SA(b, h) (((b) * 2 + (h)) * HTB)
#define PG8_SB(b, h) ((4 + (b) * 2 + (h)) * HTB)
#define PG8_STAGE_B(bufoff, uoff) do { _Pragma("unroll") for (int _i = 0; _i < 2; ++_i) \
        __builtin_amdgcn_global_load_lds((gptr_t)(Bb + (voffB[_i] + (unsigned)(uoff))), (PG8_LAS unsigned*)(lds + (bufoff) + ldsw + _i * 8192), 16, 0, 0); } while (0)
#define PG8_STAGE_A(bufoff, koff, h, NX) do { _Pragma("unroll") for (int _i = 0; _i < 2; ++_i) { unsigned _o; \
        if constexpr (GA) _o = ((NX) ? vn[h][_i] : vc[h][_i]) + (unsigned)(koff); else _o = voffA[_i] + (((NX) ? nAo : cAo) + (unsigned)(h) * hstep + (unsigned)(koff)); \
        __builtin_amdgcn_global_load_lds((gptr_t)(Ab + _o), (PG8_LAS unsigned*)(lds + (bufoff) + ldsw + _i * 8192), 16, 0, 0); } } while (0)
#define PG8_LDA(dst, b, h) do { _Pragma("unroll") for (int m = 0; m < 4; ++m) _Pragma("unroll") for (int k = 0; k < 2; ++k) dst[m][k] = *(const PG8_LAS bf16x8*)(lds + PG8_SA(b, h) + aoff + m * 2048 + k * 1024); } while (0)
#define PG8_LDB(dst, b, h) do { _Pragma("unroll") for (int n = 0; n < 2; ++n) _Pragma("unroll") for (int k = 0; k < 2; ++k) dst[n][k] = *(const PG8_LAS bf16x8*)(lds + PG8_SB(b, h) + boff + n * 2048 + k * 1024); } while (0)
#define PG8_MMA(ai, bj, At, Bt) do { __builtin_amdgcn_s_setprio(1); _Pragma("unroll") for (int m = 0; m < 4; ++m) _Pragma("unroll") for (int n = 0; n < 2; ++n) _Pragma("unroll") for (int k = 0; k < 2; ++k) \
        acc[ai][bj][m][n] = __builtin_amdgcn_mfma_f32_16x16x32_bf16(Bt[n][k], At[m][k], acc[ai][bj][m][n], 0, 0, 0); __builtin_amdgcn_s_setprio(0); } while (0)
#define PG8_MMA8(ai, bj, At, Bt) do { __builtin_amdgcn_s_setprio(1); if constexpr (I8) { _Pragma("unroll") for (int k = 0; k < 2; ++k) _Pragma("unroll") for (int m = 0; m < 4; ++m) _Pragma("unroll") for (int n = 0; n < 2; ++n) \
        asm volatile("v_mfma_i32_16x16x64_i8 %0, %1, %2, %0" : "+v"(acc[ai][bj][m][n]) : "v"(Bt[n][k]), "v"(At[m][k])); } else { _Pragma("unroll") for (int m = 0; m < 4; ++m) _Pragma("unroll") for (int n = 0; n < 2; ++n) \
        asm volatile("v_mfma_f32_16x16x128_f8f6f4 %0, %1, %2, %0" : "+v"(acc[ai][bj][m][n]) : "v"(cat8(Bt[n][0], Bt[n][1])), "v"(cat8(At[m][0], At[m][1]))); } __builtin_amdgcn_s_setprio(0); } while (0)
#define PG8_MMA8Z(ai, bj, At, Bt) do { __builtin_amdgcn_s_setprio(1); if constexpr (I8) { _Pragma("unroll") for (int m = 0; m < 4; ++m) _Pragma("unroll") for (int n = 0; n < 2; ++n) \
        asm volatile("v_mfma_i32_16x16x64_i8 %0, %1, %2, 0" : "=&v"(acc[ai][bj][m][n]) : "v"(Bt[n][0]), "v"(At[m][0])); _Pragma("unroll") for (int m = 0; m < 4; ++m) _Pragma("unroll") for (int n = 0; n < 2; ++n) \
        asm volatile("v_mfma_i32_16x16x64_i8 %0, %1, %2, %0" : "+v"(acc[ai][bj][m][n]) : "v"(Bt[n][1]), "v"(At[m][1])); } else { _Pragma("unroll") for (int m = 0; m < 4; ++m) _Pragma("unroll") for (int n = 0; n < 2; ++n) \
        asm volatile("v_mfma_f32_16x16x128_f8f6f4 %0, %1, %2, 0" : "=&v"(acc[ai][bj][m][n]) : "v"(cat8(Bt[n][0], Bt[n][1])), "v"(cat8(At[m][0], At[m][1]))); } __builtin_amdgcn_s_setprio(0); } while (0)
#define PG8_MM(ai, bj, At, Bt) do { if constexpr (F8) PG8_MMA8(ai, bj, At, Bt); else PG8_MMA(ai, bj, At, Bt); } while (0)
#define PG8_MM2(FIRST, ai, At) do { if constexpr (F8) { if (FIRST) { PG8_MMA8Z(ai, 0, At, B0); PG8_MMA8Z(ai, 1, At, B1); } else { PG8_MMA8(ai, 0, At, B0); PG8_MMA8(ai, 1, At, B1); } } else { PG8_MMA(ai, 0, At, B0); PG8_MMA(ai, 1, At, B1); } } while (0)
#define PG8_WAIT_V(n) asm volatile("s_waitcnt vmcnt(" #n ")" ::: "memory")
#define PG8_WAIT_L(n) asm volatile("s_waitcnt lgkmcnt(" #n ")" ::: "memory")
#define PG8_BAR __builtin_amdgcn_s_barrier()
#define PG8_SCHED __builtin_amdgcn_sched_barrier(0)
    Unit cur, nxt; int ui = 0;
    if (!P.next(0, cur)) return;
    f32x4 acc[2][2][4][2];
    if constexpr (!F8) {
#pragma unroll
    for (int a = 0; a < 2; ++a)
#pragma unroll
        for (int b = 0; b < 2; ++b)
#pragma unroll
            for (int m = 0; m < 4; ++m)
#pragma unroll
                for (int n = 0; n < 2; ++n) acc[a][b][m][n] = (f32x4){0.f, 0.f, 0.f, 0.f};
    }
    bf16x8 At[4][2], B0[2][2], B1[2][2];
    unsigned vc[2][2], vn[2][2]; unsigned cAo = 0, nAo = 0;
    if constexpr (GA) { P.a_off(cur, RA, CA, vc); vn[0][0] = vc[0][0]; vn[0][1] = vc[0][1]; vn[1][0] = vc[1][0]; vn[1][1] = vc[1][1]; } else { cAo = P.a_tile(cur); nAo = cAo; vc[0][0] = vn[0][0] = 0; }
    const char* const Ab = P.A; const char* const Bb = P.Bt; unsigned cBo = P.b_off(cur), nBo = cBo;
    PG8_STAGE_B(PG8_SB(0, 0), cBo); PG8_STAGE_B(PG8_SB(0, 1), cBo + hstep); PG8_STAGE_A(PG8_SA(0, 0), 0u, 0, false); PG8_STAGE_A(PG8_SA(0, 1), 0u, 1, false);
    if (wr == 1) PG8_BAR;
    PG8_WAIT_V(2); PG8_BAR;
    PG8_STAGE_B(PG8_SB(1, 0), cBo + kstep); PG8_STAGE_A(PG8_SA(1, 0), kstep, 0, false); PG8_STAGE_B(PG8_SB(1, 1), cBo + hstep + kstep);
    PG8_WAIT_V(6); PG8_BAR;
    for (;;) {
        const bool has_next = P.next(ui + 1, nxt);
        PG8_LAS unsigned char* const xe = xl + (ui & 1) * XL_EPI;
        PG8_LAS unsigned char* const xg = xl + 2 * XL_EPI + ((ui + 1) & 1) * XL_GATHER;
        E.dma(cur, xe, wid, lane);
        if (has_next) { if constexpr (GA) P.dma_rows(nxt, xg, wid, lane); else nAo = P.a_tile(nxt); nBo = P.b_off(nxt); }
        else { nAo = cAo; nBo = cBo; }
#pragma unroll 1
        for (int rep = 0; rep < KREP; ++rep)
#pragma unroll 1
        for (int t = 0; t < nt; t += 2) {
            const bool lastt = (t == nt - 2); const bool last = lastt && (rep == KREP - 1); const bool first = (t == 0) && (rep == 0); (void)first;
            if constexpr (GA) { if (last) { if (has_next) P.a_off_lds(nxt, RA, CA, xg, vn); else { vn[0][0] = vc[0][0]; vn[0][1] = vc[0][1]; vn[1][0] = vc[1][0]; vn[1][1] = vc[1][1]; } } }
            const unsigned k1 = (unsigned)(t + 1) * kstep;
            const unsigned k2 = lastt ? 0u : (unsigned)(t + 2) * kstep, k3 = k2 + kstep;
            const unsigned b2 = (last ? nBo : cBo) + k2, b3 = b2 + kstep;
            PG8_LDB(B0, 0, 0); PG8_LDB(B1, 0, 1); PG8_SCHED; PG8_LDA(At, 0, 0); PG8_STAGE_A(PG8_SA(1, 1), k1, 1, false);
            PG8_WAIT_V(8); PG8_WAIT_L(0); PG8_BAR; PG8_MM2(first, 0, At); PG8_BAR; PG8_SCHED;
            PG8_LDA(At, 0, 1); PG8_STAGE_B(PG8_SB(0, 0), b2); PG8_STAGE_B(PG8_SB(0, 1), b2 + hstep); PG8_STAGE_A(PG8_SA(0, 0), k2, 0, last);
            PG8_WAIT_V(8); PG8_WAIT_L(0); PG8_BAR; PG8_MM2(first, 1, At); PG8_BAR; PG8_SCHED;
            PG8_LDB(B0, 1, 0); PG8_LDB(B1, 1, 1); PG8_SCHED; PG8_LDA(At, 1, 0); PG8_STAGE_A(PG8_SA(0, 1), k2, 1, last);
            PG8_WAIT_V(8); PG8_WAIT_L(0); PG8_BAR; PG8_MM(0, 0, At, B0); PG8_MM(0, 1, At, B1); PG8_BAR; PG8_SCHED;
            PG8_LDA(At, 1, 1); PG8_STAGE_B(PG8_SB(1, 0), b3); PG8_STAGE_B(PG8_SB(1, 1), b3 + hstep); PG8_STAGE_A(PG8_SA(1, 0), k3, 0, last);
            PG8_WAIT_V(8); PG8_WAIT_L(0); PG8_BAR; PG8_MM(1, 0, At, B0); PG8_MM(1, 1, At, B1); PG8_BAR; PG8_SCHED;
        }
        if constexpr (ALIGN_EPI) { if (wr == 0) PG8_BAR; }
        if constexpr (F8) asm volatile("s_nop 15\n\ts_nop 7" ::: "memory");
        if constexpr (I8) {
#pragma unroll
            for (int a = 0; a < 2; ++a)
#pragma unroll
                for (int b = 0; b < 2; ++b)
#pragma unroll
                    for (int m = 0; m < 4; ++m)
#pragma unroll
                        for (int n = 0; n < 2; ++n)
#pragma unroll
                            for (int i = 0; i < 4; ++i) acc[a][b][m][n][i] = (float)__float_as_int(acc[a][b][m][n][i]);
        }
        E(acc, cur, wr, wc, fr, fq, xe);
        if (!has_next) break;
        if constexpr (!F8)
#pragma unroll
        for (int a = 0; a < 2; ++a)
#pragma unroll
            for (int b = 0; b < 2; ++b)
#pragma unroll
                for (int m = 0; m < 4; ++m)
#pragma unroll
                    for (int n = 0; n < 2; ++n) acc[a][b][m][n] = (f32x4){0.f, 0.f, 0.f, 0.f};
        cur = nxt; cBo = nBo; cAo = nAo; ++ui;
        if constexpr (GA) { vc[0][0] = vn[0][0]; vc[0][1] = vn[0][1]; vc[1][0] = vn[1][0]; vc[1][1] = vn[1][1]; }
        if constexpr (ALIGN_EPI) { if (wr == 1) PG8_BAR; }
    }
    PG8_WAIT_V(0);
    if constexpr (!ALIGN_EPI) { if (wr == 0) PG8_BAR; }
    PG8_BAR;
#undef PG8_SA
#undef PG8_SB
#undef PG8_STAGE_A
#undef PG8_STAGE_B
#undef PG8_LDA
#undef PG8_LDB
#undef PG8_MMA
#undef PG8_MMA8
#undef PG8_MM
#undef PG8_MM2
#undef PG8_MMA8Z
#undef PG8_WAIT_V
#undef PG8_WAIT_L
#undef PG8_BAR
#undef PG8_SCHED
}
}

namespace att {
constexpr int QBLK = 32, KVBLK = 64, LDX = 1024, NT = SEQ / KVBLK;
constexpr int SHM_V = KVBLK * 128 * 2, SHM_K = KVBLK * 128 * 2, NSLOT = 3;
constexpr int OFF_V = 0, OFF_K = NSLOT * SHM_V, OFF_WS = NSLOT * (SHM_V + SHM_K), OFF_TBL = OFF_WS + 8 * 64 * 4, ATT_LDS = OFF_TBL + 2048;
constexpr float THR2 = 8.0f * LOG2E;
#define KSWZ(row, colB) ((row) * 256 + ((colB) ^ (((row) & 7) << 4)))
#define SBAR() __builtin_amdgcn_sched_barrier(0)
__device__ __forceinline__ int crow(int r, int hi) { return (r & 3) + 8 * (r >> 2) + 4 * hi; }
__device__ __forceinline__ int v_st(int k, int c) { const int kk = (k & ~0xC) | ((k & 4) << 1) | ((k & 8) >> 1); return ((kk >> 3) * 4 + (c >> 5)) * 512 + ((kk & 7) * 32 + (c & 31)) * 2; }
__device__ __forceinline__ int v_rd_base(int lane) { return ((lane & 3) << 3) | (((lane >> 2) & 3) << 6) | (((lane >> 4) & 1) << 5) | (((lane >> 5) & 1) << 8); }
constexpr int v_rd_off(int d0, int ks, int half) { return d0 * 512 + ks * 4096 + half * 2048; }
template <int OFF> __device__ __forceinline__ s16x4 tr_read(int vb) { s16x4 r; asm volatile("ds_read_b64_tr_b16 %0, %1 offset:%2" : "=&v"(r) : "v"(vb), "i"(OFF) : "memory"); return r; }
#define ATT_RD8(L, H, D0) do { \
    asm volatile("ds_read_b64_tr_b16 %0, %1 offset:%2" : "=&v"(L[0]) : "v"(vb), "i"(v_rd_off(D0, 0, 0)) : "memory"); asm volatile("ds_read_b64_tr_b16 %0, %1 offset:%2" : "=&v"(H[0]) : "v"(vb), "i"(v_rd_off(D0, 0, 1)) : "memory"); \
    asm volatile("ds_read_b64_tr_b16 %0, %1 offset:%2" : "=&v"(L[1]) : "v"(vb), "i"(v_rd_off(D0, 1, 0)) : "memory"); asm volatile("ds_read_b64_tr_b16 %0, %1 offset:%2" : "=&v"(H[1]) : "v"(vb), "i"(v_rd_off(D0, 1, 1)) : "memory"); \
    asm volatile("ds_read_b64_tr_b16 %0, %1 offset:%2" : "=&v"(L[2]) : "v"(vb), "i"(v_rd_off(D0, 2, 0)) : "memory"); asm volatile("ds_read_b64_tr_b16 %0, %1 offset:%2" : "=&v"(H[2]) : "v"(vb), "i"(v_rd_off(D0, 2, 1)) : "memory"); \
    asm volatile("ds_read_b64_tr_b16 %0, %1 offset:%2" : "=&v"(L[3]) : "v"(vb), "i"(v_rd_off(D0, 3, 0)) : "memory"); asm volatile("ds_read_b64_tr_b16 %0, %1 offset:%2" : "=&v"(H[3]) : "v"(vb), "i"(v_rd_off(D0, 3, 1)) : "memory"); } while (0)
#define ATT_PK(L, H) (bf16x8){L[0], L[1], L[2], L[3], H[0], H[1], H[2], H[3]}
#define ATT_MM4(OD, L, H) do { OD = __builtin_amdgcn_mfma_f32_32x32x16_bf16(pa0, ATT_PK(L[0], H[0]), OD, 0, 0, 0); OD = __builtin_amdgcn_mfma_f32_32x32x16_bf16(pa1, ATT_PK(L[1], H[1]), OD, 0, 0, 0); \
    OD = __builtin_amdgcn_mfma_f32_32x32x16_bf16(pa2, ATT_PK(L[2], H[2]), OD, 0, 0, 0); OD = __builtin_amdgcn_mfma_f32_32x32x16_bf16(pa3, ATT_PK(L[3], H[3]), OD, 0, 0, 0); } while (0)
__device__ __forceinline__ void pv_d0(f32x16* o, int vb, bf16x8 pa0, bf16x8 pa1, bf16x8 pa2, bf16x8 pa3) {
  s16x4 la[4], ha[4], lb[4], hb[4];
  ATT_RD8(la, ha, 0); ATT_RD8(lb, hb, 1);
  asm volatile("s_waitcnt lgkmcnt(8)" ::: "memory"); SBAR(); ATT_MM4(o[0], la, ha); SBAR();
  ATT_RD8(la, ha, 2);
  asm volatile("s_waitcnt lgkmcnt(8)" ::: "memory"); SBAR(); ATT_MM4(o[1], lb, hb); SBAR();
  ATT_RD8(lb, hb, 3);
  asm volatile("s_waitcnt lgkmcnt(8)" ::: "memory"); SBAR(); ATT_MM4(o[2], la, ha); SBAR();
  asm volatile("s_waitcnt lgkmcnt(0)" ::: "memory"); SBAR(); ATT_MM4(o[3], lb, hb);
  const bf16x8 ones = {(short)0x3F80, (short)0x3F80, (short)0x3F80, (short)0x3F80, (short)0x3F80, (short)0x3F80, (short)0x3F80, (short)0x3F80};
  o[4] = __builtin_amdgcn_mfma_f32_32x32x16_bf16(pa0, ones, o[4], 0, 0, 0); o[4] = __builtin_amdgcn_mfma_f32_32x32x16_bf16(pa1, ones, o[4], 0, 0, 0);
  o[4] = __builtin_amdgcn_mfma_f32_32x32x16_bf16(pa2, ones, o[4], 0, 0, 0); o[4] = __builtin_amdgcn_mfma_f32_32x32x16_bf16(pa3, ones, o[4], 0, 0, 0);
}
__device__ __forceinline__ void pv_softmax(f32x16* o, int vb, bf16x8 pa0, bf16x8 pa1, bf16x8 pa2, bf16x8 pa3, f32x16& p0, f32x16& p1, float& m_reg, float& alpha, bool& resc) {
  s16x4 la[4], ha[4], lb[4], hb[4];
  ATT_RD8(la, ha, 0); ATT_RD8(lb, hb, 1);
  asm volatile("s_waitcnt lgkmcnt(8)" ::: "memory"); SBAR();
  float a = fmaxf(fmaxf(p0[0], p0[1]), p1[0]), b = fmaxf(fmaxf(p0[2], p0[3]), p1[1]); a = fmaxf(fmaxf(a, p1[2]), p1[3]);
#pragma unroll
  for (int r = 4; r < 16; r += 4) { a = fmaxf(fmaxf(a, p0[r]), p0[r + 1]); b = fmaxf(fmaxf(b, p0[r + 2]), p0[r + 3]); a = fmaxf(fmaxf(a, p1[r]), p1[r + 1]); b = fmaxf(fmaxf(b, p1[r + 2]), p1[r + 3]); }
  float pmax = fmaxf(a, b);
  ATT_MM4(o[0], la, ha); SBAR();
  ATT_RD8(la, ha, 2);
  asm volatile("s_waitcnt lgkmcnt(8)" ::: "memory"); SBAR();
  { auto rr = __builtin_amdgcn_permlane32_swap(__float_as_uint(pmax), __float_as_uint(pmax), false, false);
    pmax = fmaxf(__uint_as_float(rr[0]), __uint_as_float(rr[1])); }
  resc = false; alpha = 1.f;
  if (__builtin_expect(!__all(pmax <= THR2), 0)) { const float dl = fmaxf(pmax, 0.f); m_reg += dl; alpha = __builtin_amdgcn_exp2f(-dl); resc = true;
#pragma unroll
    for (int r = 0; r < 16; ++r) { p0[r] -= dl; p1[r] -= dl; } }
  ATT_MM4(o[1], lb, hb); SBAR();
  ATT_RD8(lb, hb, 3);
  asm volatile("s_waitcnt lgkmcnt(8)" ::: "memory"); SBAR();
#pragma unroll
  for (int r = 0; r < 16; ++r) p0[r] = __builtin_amdgcn_exp2f(p0[r]);
  ATT_MM4(o[2], la, ha); SBAR();
  asm volatile("s_waitcnt lgkmcnt(0)" ::: "memory"); SBAR();
#pragma unroll
  for (int r = 0; r < 16; ++r) p1[r] = __builtin_amdgcn_exp2f(p1[r]);
  ATT_MM4(o[3], lb, hb);
  const bf16x8 ones = {(short)0x3F80, (short)0x3F80, (short)0x3F80, (short)0x3F80, (short)0x3F80, (short)0x3F80, (short)0x3F80, (short)0x3F80};
  o[4] = __builtin_amdgcn_mfma_f32_32x32x16_bf16(pa0, ones, o[4], 0, 0, 0); o[4] = __builtin_amdgcn_mfma_f32_32x32x16_bf16(pa1, ones, o[4], 0, 0, 0);
  o[4] = __builtin_amdgcn_mfma_f32_32x32x16_bf16(pa2, ones, o[4], 0, 0, 0); o[4] = __builtin_amdgcn_mfma_f32_32x32x16_bf16(pa3, ones, o[4], 0, 0, 0);
}
__device__ __forceinline__ void near_bias(f32x16& p0, f32x16& p1, int dq, const float* tbl) {
#pragma unroll
  for (int r = 0; r < 16; ++r) { const int c0 = (r & 3) + 8 * (r >> 2); p0[r] += tbl[dq + c0]; p1[r] += tbl[dq + c0 + 32]; }
}
__device__ __forceinline__ void qkt(f32x16& p0, f32x16& p1, const char* Ks, const bf16x8* qr, int r32, int hi, int mapB) {
  bf16x8 k0[4], k1[4];
#pragma unroll
  for (int d0 = 0; d0 < 4; ++d0) { const int cb = mapB + (d0 * 16 + hi * 8) * 2;
    k0[d0] = *reinterpret_cast<const bf16x8*>(Ks + KSWZ(r32, cb)); k1[d0] = *reinterpret_cast<const bf16x8*>(Ks + KSWZ(32 + r32, cb)); }
  p0 = f32x16{}; p1 = f32x16{};
#pragma unroll
  for (int d0 = 0; d0 < 4; ++d0) {
    p0 = __builtin_amdgcn_mfma_f32_32x32x16_bf16(k0[d0], qr[d0], p0, 0, 0, 0);
    p1 = __builtin_amdgcn_mfma_f32_32x32x16_bf16(k1[d0], qr[d0], p1, 0, 0, 0); }
}
__device__ __forceinline__ void qkt_seed(f32x16& p0, f32x16& p1, const char* Ks, const bf16x8* qr, const int (&koff)[4], const f32x16& seed) {
#pragma unroll
  for (int d0 = 0; d0 < 4; ++d0) {
    const bf16x8 b0 = *reinterpret_cast<const bf16x8*>(Ks + koff[d0]);
    const bf16x8 b1 = *reinterpret_cast<const bf16x8*>(Ks + koff[d0] + 8192);
    if (d0 == 0) { p0 = __builtin_amdgcn_mfma_f32_32x32x16_bf16(b0, qr[0], seed, 0, 0, 0); p1 = __builtin_amdgcn_mfma_f32_32x32x16_bf16(b1, qr[0], seed, 0, 0, 0); }
    else { p0 = __builtin_amdgcn_mfma_f32_32x32x16_bf16(b0, qr[d0], p0, 0, 0, 0); p1 = __builtin_amdgcn_mfma_f32_32x32x16_bf16(b1, qr[d0], p1, 0, 0, 0); } }
}
__device__ __forceinline__ void partialSM_seeded(f32x16& p0, f32x16& p1, float& m_reg, float& alpha, bool& resc, int mode, int dq, const float* tbl) {
  if (mode == 0) {
#pragma unroll
    for (int r = 0; r < 16; ++r) { const int c0 = (r & 3) + 8 * (r >> 2);
      p0[r] += tbl[dq + c0]; p1[r] += tbl[dq + c0 + 32]; }
  }
  float a = fmaxf(fmaxf(p0[0], p0[1]), p1[0]), b = fmaxf(fmaxf(p0[2], p0[3]), p1[1]); a = fmaxf(fmaxf(a, p1[2]), p1[3]);
#pragma unroll
  for (int r = 4; r < 16; r += 4) { a = fmaxf(fmaxf(a, p0[r]), p0[r + 1]); b = fmaxf(fmaxf(b, p0[r + 2]), p0[r + 3]); a = fmaxf(fmaxf(a, p1[r]), p1[r + 1]); b = fmaxf(fmaxf(b, p1[r + 2]), p1[r + 3]); }
  float pmax = fmaxf(a, b);
  { auto rr = __builtin_amdgcn_permlane32_swap(__float_as_uint(pmax), __float_as_uint(pmax), false, false);
    pmax = fmaxf(__uint_as_float(rr[0]), __uint_as_float(rr[1])); }
  resc = false; alpha = 1.f;
  if (__builtin_expect(!__all(pmax <= THR2), 0)) { const float dl = fmaxf(pmax, 0.f); m_reg += dl; alpha = __builtin_amdgcn_exp2f(-dl); resc = true;
#pragma unroll
    for (int r = 0; r < 16; ++r) { p0[r] -= dl; p1[r] -= dl; } }
#pragma unroll
  for (int r = 0; r < 16; ++r) p0[r] = __builtin_amdgcn_exp2f(p0[r]);
}
__device__ __forceinline__ void partialSM(f32x16& p0, f32x16& p1, float& m_reg, float& mn, float& alpha, int mode, float cL, float cR, int dq, const float* tbl) {
  float cadd;
  if (mode == 0) {
#pragma unroll
    for (int r = 0; r < 16; ++r) { const int c0 = (r & 3) + 8 * (r >> 2);
      p0[r] += tbl[dq + c0]; p1[r] += tbl[dq + c0 + 32]; }
    cadd = 0.f;
  } else cadd = (mode < 0) ? cL : cR;
  float pmax = p0[0];
#pragma unroll
  for (int r = 1; r < 16; ++r) pmax = fmaxf(pmax, p0[r]);
#pragma unroll
  for (int r = 0; r < 16; ++r) pmax = fmaxf(pmax, p1[r]);
  { auto rr = __builtin_amdgcn_permlane32_swap(__float_as_uint(pmax), __float_as_uint(pmax), false, false);
    pmax = fmaxf(__uint_as_float(rr[0]), __uint_as_float(rr[1])); }
  pmax += cadd;
  if (__builtin_expect(__all(pmax - m_reg <= THR2), 1)) { mn = m_reg; alpha = 1.f; }
  else { mn = fmaxf(m_reg, pmax); alpha = __builtin_amdgcn_exp2f(m_reg - mn); m_reg = mn; }
  const float sh = cadd - mn;
#pragma unroll
  for (int r = 0; r < 16; ++r) p0[r] += sh;
#pragma unroll
  for (int r = 0; r < 16; ++r) p1[r] += sh;
#pragma unroll
  for (int r = 0; r < 16; ++r) p0[r] = __builtin_amdgcn_exp2f(p0[r]);
}
__device__ __forceinline__ void finishSM(f32x16& p0, f32x16& p1, bf16x8& pa0, bf16x8& pa1, bf16x8& pa2, bf16x8& pa3) {
#define PK8(P, BASE, OUT) do { v4u w = {cvt_pk_bf16(P[BASE + 0], P[BASE + 1]), cvt_pk_bf16(P[BASE + 2], P[BASE + 3]), cvt_pk_bf16(P[BASE + 4], P[BASE + 5]), cvt_pk_bf16(P[BASE + 6], P[BASE + 7])}; OUT = *reinterpret_cast<bf16x8*>(&w); } while (0)
  PK8(p0, 0, pa0); PK8(p0, 8, pa1); PK8(p1, 0, pa2); PK8(p1, 8, pa3);
#undef PK8
}
__device__ __forceinline__ int rel_bucket(int rel) {
  const int n = rel < 0 ? -rel : rel; int b;
  if (n < 8) b = n; else if (n < 12) b = 8; else if (n < 16) b = 9; else if (n < 23) b = 10; else if (n < 32) b = 11; else if (n < 46) b = 12; else if (n < 64) b = 13; else if (n < 91) b = 14; else b = 15;
  return (rel > 0 ? 16 : 0) + b;
}

__device__ __forceinline__ void attn_unit(int b, int h, int qb, const bf16_t* __restrict__ Q, const bf16_t* __restrict__ K, const bf16_t* __restrict__ V, bf16_t* __restrict__ O,
                                          float lam, float osc, const float* __restrict__ g, const float* __restrict__ rel_bias, char* lds, int tid_in, bool build_tbl, bool o8) {
  int tid_ = tid_in; asm volatile("" : "+v"(tid_));
  const int tid = tid_, wid = __builtin_amdgcn_readfirstlane(tid >> 6), lane = tid & 63, r32 = lane & 31, hi = lane >> 5;
  const int map = wid & 1, jq = wid >> 1;
  char* V_lds = lds + OFF_V; char* K_lds = lds + OFF_K;
  float* ws = (float*)(lds + OFF_WS) + wid * 64; float* li_l = ws; float* al_l = ws + 32;
  float* tbl = (float*)(lds + OFF_TBL);
  if (build_tbl) tbl[tid] = rel_bias[rel_bucket(tid - 256) * NH + h] * LOG2E;
  const float cL = rel_bias[15 * NH + h] * LOG2E, cR = rel_bias[31 * NH + h] * LOG2E;
  const long rowbase = (long)b * SEQ; const int qs = qb * 128 + jq * QBLK;
  float m_reg = -1e30f; f32x16 o[5] = {}; bf16x8 qr[4];
  const bf16_t* Qw = Q + (rowbase + qs + r32) * LDX + h * 128 + map * 64 + hi * 8;
#pragma unroll
  for (int d0 = 0; d0 < 4; ++d0) qr[d0] = *reinterpret_cast<const bf16x8*>(Qw + d0 * 16);
  const bf16_t* Kh = K + rowbase * LDX + h * 128; const bf16_t* Vh = V + rowbase * LDX + h * 128;
  const int vb0 = (int)(uintptr_t)V_lds + v_rd_base(lane);
  const int mapB = map * 128;
  int koff[4];
#pragma unroll
  for (int d0 = 0; d0 < 4; ++d0) koff[d0] = KSWZ(r32, mapB + (d0 * 16 + hi * 8) * 2);
  const int dq0 = 256 + 4 * hi - (qs + r32);
  unsigned ksrc[2], vsrc[2];
#pragma unroll
  for (int i = 0; i < 2; ++i) { const int pk = wid + 8 * i;
    const int krow = 4 * pk + (lane >> 4), kc = (lane & 15) ^ (krow & 7); ksrc[i] = (unsigned)(krow * (LDX * 2) + kc * 16);
    const int st = 2 * pk + (lane >> 5), kk = (st >> 2) * 8 + ((lane & 31) >> 2), vk = kk  , vc = (st & 3) * 32 + (lane & 3) * 8;
    vsrc[i] = (unsigned)(vk * (LDX * 2) + vc * 2); }
  typedef const __attribute__((address_space(1))) unsigned* gptr_t; typedef __attribute__((address_space(3))) unsigned* lptr_t;
  const char* const Kg = (const char*)Kh; const char* const Vg = (const char*)Vh;
  const lptr_t kdst = (lptr_t)(__attribute__((address_space(3))) char*)(K_lds) + 0; (void)kdst;
#define DMA_TILE(t, slot) do { const unsigned tb_ = (unsigned)(t) * (unsigned)(KVBLK * LDX * 2); \
    _Pragma("unroll") for (int i_ = 0; i_ < 2; ++i_) { \
      __builtin_amdgcn_global_load_lds((gptr_t)(Kg + (ksrc[i_] + tb_)), (lptr_t)((__attribute__((address_space(3))) char*)K_lds + (slot) + (wid + 8 * i_) * 1024), 16, 0, 0); \
      __builtin_amdgcn_global_load_lds((gptr_t)(Vg + (vsrc[i_] + tb_)), (lptr_t)((__attribute__((address_space(3))) char*)V_lds + (slot) + (wid + 8 * i_) * 1024), 16, 0, 0); } } while (0)
#define WAIT_BAR() do { asm volatile("s_waitcnt vmcnt(0) lgkmcnt(0)" ::: "memory"); __builtin_amdgcn_s_barrier(); asm volatile("" ::: "memory"); } while (0)
#define RESC(a, rs) do { if (rs) { if (hi == 0) al_l[r32] = (a); asm volatile("s_waitcnt lgkmcnt(0)" ::: "memory"); \
    _Pragma("unroll") for (int d = 0; d < 5; ++d) _Pragma("unroll") for (int r = 0; r < 16; ++r) o[d][r] *= al_l[crow(r, hi)]; } } while (0)
#define SEED(md) do { const int md_ = (md); const float sv_ = (md_ == 0 ? 0.f : (md_ < 0 ? cL : cR)) - m_reg; _Pragma("unroll") for (int r = 0; r < 16; ++r) seed[r] = sv_; } while (0)
#define TMODE(k0) (((k0) >= qs + 122) ? 1 : (((k0) <= qs - 154) ? -1 : 0))
#define ROT() do { const int t_ = sl_prev; sl_prev = sl_cur; sl_cur = sl_next; sl_next = t_; } while (0)
  f32x16 pA0, pA1, pB0, pB1, seed; float mnA, alA, alB; bool rsA = false, rsB = false; bf16x8 pa0, pa1, pa2, pa3;
  int sl_prev = 2 * SHM_V, sl_cur = 0, sl_next = SHM_V;
  if (wid >= 4) __builtin_amdgcn_s_setprio(1);
  DMA_TILE(0, 0); DMA_TILE(1, SHM_V);
  WAIT_BAR();
  DMA_TILE(2, 2 * SHM_V);
  qkt(pA0, pA1, K_lds, qr, r32, hi, mapB); partialSM(pA0, pA1, m_reg, mnA, alA, TMODE(0), cL, cR, dq0, tbl);
  _Pragma("unroll") for (int r = 0; r < 16; ++r) pA1[r] = __builtin_amdgcn_exp2f(pA1[r]);
  ROT();
#define QK_SEEDED(P0, P1, DMA_STMT, SEED_STMT) do { bf16x8 k0_[4], k1_[4]; const char* Ks_ = K_lds + sl_cur; \
    _Pragma("unroll") for (int d0 = 0; d0 < 4; ++d0) { k0_[d0] = *reinterpret_cast<const bf16x8*>(Ks_ + koff[d0]); k1_[d0] = *reinterpret_cast<const bf16x8*>(Ks_ + koff[d0] + 8192); } \
    DMA_STMT; SEED_STMT; \
    P0 = __builtin_amdgcn_mfma_f32_32x32x16_bf16(k0_[0], qr[0], seed, 0, 0, 0); P1 = __builtin_amdgcn_mfma_f32_32x32x16_bf16(k1_[0], qr[0], seed, 0, 0, 0); \
    _Pragma("unroll") for (int d0 = 1; d0 < 4; ++d0) { P0 = __builtin_amdgcn_mfma_f32_32x32x16_bf16(k0_[d0], qr[d0], P0, 0, 0, 0); P1 = __builtin_amdgcn_mfma_f32_32x32x16_bf16(k1_[d0], qr[d0], P1, 0, 0, 0); } } while (0)
  for (int j = 1; j + 1 < NT; j += 2) {
    SBAR(); QK_SEEDED(pB0, pB1, if (j > 1) DMA_TILE(j + 1, sl_next), SEED(TMODE(j * KVBLK)));
    finishSM(pA0, pA1, pa0, pa1, pa2, pa3); SBAR();
    if (TMODE(j * KVBLK) == 0) near_bias(pB0, pB1, dq0 + j * KVBLK, tbl);
    pv_softmax(o, vb0 + sl_prev, pa0, pa1, pa2, pa3, pB0, pB1, m_reg, alB, rsB);
    WAIT_BAR();
    RESC(alB, rsB); ROT();
    SBAR(); QK_SEEDED(pA0, pA1, DMA_TILE(j + 2, sl_next), SEED(TMODE((j + 1) * KVBLK)));
    finishSM(pB0, pB1, pa0, pa1, pa2, pa3); SBAR();
    if (TMODE((j + 1) * KVBLK) == 0) near_bias(pA0, pA1, dq0 + (j + 1) * KVBLK, tbl);
    pv_softmax(o, vb0 + sl_prev, pa0, pa1, pa2, pa3, pA0, pA1, m_reg, alA, rsA);
    WAIT_BAR();
    RESC(alA, rsA); ROT();
  }
  SBAR(); QK_SEEDED(pB0, pB1, (void)0, SEED(TMODE((NT - 1) * KVBLK)));
  finishSM(pA0, pA1, pa0, pa1, pa2, pa3); SBAR();
  if (TMODE((NT - 1) * KVBLK) == 0) near_bias(pB0, pB1, dq0 + (NT - 1) * KVBLK, tbl);
  pv_softmax(o, vb0 + sl_prev, pa0, pa1, pa2, pa3, pB0, pB1, m_reg, alB, rsB);
  RESC(alB, rsB);
  finishSM(pB0, pB1, pa0, pa1, pa2, pa3); SBAR();
  pv_d0(o, vb0 + sl_cur, pa0, pa1, pa2, pa3);
  __builtin_amdgcn_s_setprio(0);
  float rli[16];
#pragma unroll
  for (int r = 0; r < 16; ++r) rli[r] = __builtin_amdgcn_rcpf(o[4][r]);
  __syncthreads();
  float* X = (float*)(lds + jq * 16384);
  if (map == 1) {
#pragma unroll
    for (int r = 0; r < 16; ++r) { const int orow = crow(r, hi); const float s = rli[r] * lam;
#pragma unroll
      for (int d0 = 0; d0 < 4; ++d0) X[orow * 128 + d0 * 32 + r32] = o[d0][r] * s; }
  }
  __syncthreads();
  if (map == 0) {
    float ss[16];
#pragma unroll
    for (int r = 0; r < 16; ++r) { const int orow = crow(r, hi); float a = 0.f;
#pragma unroll
      for (int d0 = 0; d0 < 4; ++d0) { const float v = o[d0][r] * rli[r] - X[orow * 128 + d0 * 32 + r32]; o[d0][r] = v; a += v * v; }
      ss[r] = a; }
#pragma unroll
    for (int s = 1; s < 32; s <<= 1)
#pragma unroll
      for (int r = 0; r < 16; ++r) ss[r] += shx(ss[r], s);
    float gg[4];
#pragma unroll
    for (int d0 = 0; d0 < 4; ++d0) gg[d0] = g[d0 * 32 + r32] * osc;
    asm volatile("s_waitcnt lgkmcnt(0)" ::: "memory");
    bf16_t* stg = (bf16_t*)X;
#pragma unroll
    for (int r = 0; r < 16; ++r) { const int orow = crow(r, hi); const float rs = __builtin_amdgcn_rsqf(ss[r] * (1.0f / 128.0f) + LN_EPS);
#pragma unroll
      for (int d0 = 0; d0 < 4; ++d0) { const float v = o[d0][r] * rs * gg[d0]; stg[orow * 128 + d0 * 32 + r32] = (bf16_t)(cvt_pk_bf16(v, v) & 0xffffu); } }
    asm volatile("s_waitcnt lgkmcnt(0)" ::: "memory");
    bf16_t* Ow = O + (rowbase + qs) * LDX + h * 128;
#pragma unroll
    for (int i = 0; i < 8; ++i) { const int row = i * 4 + (lane >> 4), ch = lane & 15; const v4u v = *(const v4u*)(stg + row * 128 + ch * 8);
      if (!o8) *(v4u*)(Ow + (long)row * LDX + ch * 8) = v;
      else { typedef unsigned u32x2 __attribute__((ext_vector_type(2))); u32x2 q8; q8.x = pg8::pk4_fp8(bf_lo(v.x), bf_hi(v.x), bf_lo(v.y), bf_hi(v.y)); q8.y = pg8::pk4_fp8(bf_lo(v.z), bf_hi(v.z), bf_lo(v.w), bf_hi(v.w));
        *(u32x2*)((unsigned char*)O + (size_t)(rowbase + qs + row) * LDX + h * 128 + ch * 8) = q8; } }
    asm volatile("s_waitcnt lgkmcnt(0)" ::: "memory");
  }
  __syncthreads();
#undef DMA_TILE
#undef WAIT_BAR
#undef ROT
#undef RESC
#undef SEED
#undef QK_SEEDED
#undef TMODE
}
#undef KSWZ
#undef SBAR
}

#define XB_TMO      128
#define XB_XCNT(j)  (256  + 64 * (j))
#define XB_XSUB(j)  (1280 + 64 * (j))
#define XB_XGEN(j)  (2304 + 64 * (j))
#define XB_TOP      3328
#define XB_TOPGEN   3392
#define XCD_BAR_WORDS 3456
#define XB_SPIN_CAP (1u << 18)
__device__ __forceinline__ unsigned xb_ld(unsigned* p)              { return __hip_atomic_load(p, __ATOMIC_RELAXED, __HIP_MEMORY_SCOPE_AGENT); }
__device__ __forceinline__ unsigned xb_add(unsigned* p, unsigned v) { return __hip_atomic_fetch_add(p, v, __ATOMIC_RELAXED, __HIP_MEMORY_SCOPE_AGENT); }
__device__ __forceinline__ unsigned xb_xcc_id() { return (unsigned)__builtin_amdgcn_s_getreg((3 << 11) | 20) & 0xFu; }
#define XB_SPIN(cond, bar) do { unsigned _sp = 0; while (cond) { __builtin_amdgcn_s_sleep(1); \
    if ((++_sp & 255u) == 0u) { if (xb_ld(&(bar)[XB_TMO])) break; if (_sp > XB_SPIN_CAP) { atomicAdd(&(bar)[XB_TMO], 1u); break; } } } } while (0)
struct XcdBarrier { unsigned* bar; unsigned x; volatile LAS unsigned* st; };
__device__ __forceinline__ XcdBarrier xcd_barrier_post(unsigned* bar, volatile LAS unsigned* st) {
    XcdBarrier b; b.bar = bar; b.x = xb_xcc_id(); b.st = st;
    if (threadIdx.x == 0) (void)xb_add(&bar[XB_XCNT(b.x)], 1u);
    return b;
}
__device__ __forceinline__ void xcd_barrier_complete(unsigned* bar, unsigned x, unsigned& nloc, unsigned& nx) {
    const unsigned G = gridDim.x * gridDim.y * gridDim.z;
    unsigned sum, cnt, mine, sp = 0u;
    for (;;) {
        sum = 0u; cnt = 0u; mine = 0u;
#pragma unroll
        for (unsigned j = 0; j < 16; ++j) { const unsigned c = xb_ld(&bar[XB_XCNT(j)]); sum += c; cnt += (c > 0u) ? 1u : 0u; mine = (j == x) ? c : mine; }
        if (sum == G) break;
        __builtin_amdgcn_s_sleep(1);
        if ((++sp & 255u) == 0u) { if (xb_ld(&bar[XB_TMO])) break; if (sp > XB_SPIN_CAP) { atomicAdd(&bar[XB_TMO], 1u); break; } }
    }
    nloc = mine > 0u ? mine : 1u; nx = cnt > 0u ? cnt : 1u;
}
__device__ __forceinline__ void xcd_barrier(const XcdBarrier& b) {
    asm volatile("s_waitcnt vmcnt(0)" ::: "memory");
    __syncthreads();
    if (threadIdx.x == 0) {
        unsigned* bar = b.bar;
        __builtin_amdgcn_s_waitcnt(0);
        unsigned nloc = b.st[0], nx = b.st[1];
        if (nloc == 0u) { xcd_barrier_complete(bar, b.x, nloc, nx); b.st[0] = nloc; b.st[1] = nx; }
        const unsigned old = xb_add(&bar[XB_XSUB(b.x)], 1u);
        const unsigned gen = old / nloc;
        if (old + 1u == (gen + 1u) * nloc) {
            __builtin_amdgcn_fence(__ATOMIC_RELEASE, "agent");
            asm volatile("s_waitcnt vmcnt(0)" ::: "memory");
            const unsigned og = xb_add(&bar[XB_TOP], 1u);
            const unsigned tg = og / nx;
            if (og + 1u == (tg + 1u) * nx) xb_add(&bar[XB_TOPGEN], 1u);
            else XB_SPIN(xb_ld(&bar[XB_TOPGEN]) == tg, bar);
            __builtin_amdgcn_fence(__ATOMIC_ACQUIRE, "agent");
            xb_add(&bar[XB_XGEN(b.x)], 1u);
            asm volatile("s_waitcnt vmcnt(0)" ::: "memory");
        } else {
            XB_SPIN(xb_ld(&bar[XB_XGEN(b.x)]) == gen, bar);
            __builtin_amdgcn_fence(__ATOMIC_ACQUIRE, "agent");
            asm volatile("s_waitcnt vmcnt(0)" ::: "memory");
        }
    }
    __syncthreads();
}

template <int MODE> __device__ __forceinline__ int dst_row(int n) {
    if (MODE == 1) { if (n < 1024) return n; const int b = (n - 1024) >> 10, f = (n - 1024) & 1023; return 1024 + (f >> 7) * 256 + b * 128 + (f & 127); }
    if (MODE == 2) { const int b = n & 1, j = n >> 1; return (j >> 7) * 256 + b * 128 + (j & 127); }
    return n;
}
template <int MODE> __device__ __forceinline__ void p0_transpose_item(const float* W, int K, int N, bf16_t* WT, LAS float* scr, int item, int lane, const float* kscale = nullptr) {
    const int nblk = N / 32, kb = item / nblk, nb = item % nblk, k0 = 64 * kb, n0 = 32 * nb;
#pragma unroll 8
    for (int i = 0; i < 32; ++i) { const int kk = 2 * i + (lane >> 5); float w = W[(size_t)(k0 + kk) * N + n0 + (lane & 31)]; if (kscale) w *= kscale[k0 + kk]; scr[kk * 33 + (lane & 31)] = w; }
    LDS_WAIT(); asm volatile("" ::: "memory");
    const int c = lane & 7;
#pragma unroll
    for (int j = 0; j < 4; ++j) { const int n = (lane >> 3) + 8 * j; const LAS float* s = scr + (8 * c) * 33 + n;
        v4u o; o.x = cvt_pk_bf16(s[0 * 33], s[1 * 33]); o.y = cvt_pk_bf16(s[2 * 33], s[3 * 33]); o.z = cvt_pk_bf16(s[4 * 33], s[5 * 33]); o.w = cvt_pk_bf16(s[6 * 33], s[7 * 33]);
        *(GAS v4u*)(WT + (size_t)dst_row<MODE>(n0 + n) * K + k0 + 8 * c) = o; }
    LDS_WAIT(); asm volatile("" ::: "memory");
}

template <int MODE, bool I8 = false> __device__ __forceinline__ void p0_quant_strip(const float* W, int N, unsigned char* W8, float* SC, int strip, LAS unsigned char* lds, int wave, int lane) {
    constexpr float QM_ = I8 ? 127.0f : F8MAX;
    LAS float* scr = (LAS float*)(lds + wave * 16384); LAS float* red = (LAS float*)(lds + LDSCTL_OFF + 2048);
    const int n0 = strip * 32, k0 = wave * 128, kk = lane >> 5, n = lane & 31;
    float am = 0.f;
    { const char* Wb = (const char*)W + (size_t)k0 * N * 4; const unsigned loff = (unsigned)((kk * N + n0 + n) * 4);
      float vv[64];
#pragma unroll
      for (int i = 0; i < 64; ++i) vv[i] = *(const float*)(Wb + (size_t)i * (size_t)(2 * N * 4) + loff);
#pragma unroll
      for (int i = 0; i < 64; ++i) { scr[(2 * i + kk) * 32 + n] = vv[i]; am = fmaxf(am, fabsf(vv[i])); } }
    am = fmaxf(am, shx(am, 32));
    if (lane < 32) red[wave * 32 + n] = am;
    __syncthreads();
    float amax = red[n];
#pragma unroll
    for (int w = 1; w < 8; ++w) amax = fmaxf(amax, red[w * 32 + n]);
    const float q = amax > 0.f ? QM_ / amax : 0.f;
    const int dr = dst_row<MODE>(n0 + n);
    if (wave == 0 && lane < 32) SC[dr] = amax * (1.0f / QM_);
#pragma unroll
    for (int c = 0; c < 4; ++c) { float v[16];
#pragma unroll
        for (int j = 0; j < 16; ++j) v[j] = scr[(kk * 64 + c * 16 + j) * 32 + n] * q;
        v4u o; o.x = pg8::pkq4<I8>(v[0], v[1], v[2], v[3]); o.y = pg8::pkq4<I8>(v[4], v[5], v[6], v[7]); o.z = pg8::pkq4<I8>(v[8], v[9], v[10], v[11]); o.w = pg8::pkq4<I8>(v[12], v[13], v[14], v[15]);
        *(GAS v4u*)(W8 + (size_t)dr * 1024 + k0 + kk * 64 + c * 16) = o; }
    __syncthreads();
}
struct StripSrc { const float* W; int N; unsigned char* W8; float* SC; int strip; bool glu; };
__device__ __forceinline__ void dstrip_desc(const float* w1, const float* w2, unsigned char* ws, int st, StripSrc& d) {
    if (st < 128 * 64) { const int j = st >> 6; d.W = w1 + (size_t)j * 1024 * 2048; d.N = 2048; d.W8 = ws + WS_W1 + (size_t)j * 2048 * 1024; d.SC = (float*)(ws + WS_S1) + (size_t)j * 2048; d.strip = st & 63; d.glu = true; }
    else { const int q = st - 128 * 64, j = q >> 5; d.W = w2 + (size_t)j * 1024 * 1024; d.N = 1024; d.W8 = ws + WS_W2 + (size_t)j * 1024 * 1024; d.SC = (float*)(ws + WS_S2) + (size_t)j * 1024; d.strip = q & 31; d.glu = false; }
}
__device__ __forceinline__ void dstrip_issue(const StripSrc& d, int wave, int lane, f32x4 (&vv)[16]) {
    const int n0 = d.strip * 32, k0 = wave * 128, r8 = lane >> 3, cg = lane & 7;
    const char* Wb = (const char*)d.W + (size_t)k0 * d.N * 4; const unsigned loff = (unsigned)((r8 * d.N + n0 + 4 * cg) * 4); const size_t rs8 = (size_t)d.N * 32;
#pragma unroll
    for (int i = 0; i < 16; ++i) vv[i] = *(const f32x4*)(Wb + (size_t)i * rs8 + loff);
}
__device__ __forceinline__ void dstrip_finish(const StripSrc& d, LAS unsigned char* lds, int wave, int lane, int par, f32x4 (&vv)[16]) {
    LAS float* scr = (LAS float*)(lds + wave * 16384); LAS float* red = (LAS float*)(lds + LDSCTL_OFF + 2048 + par * 1024);
    const int n0 = d.strip * 32, k0 = wave * 128, kk = lane >> 5, n = lane & 31, r8 = lane >> 3, cg = lane & 7;
    f32x4 am = {0.f, 0.f, 0.f, 0.f};
#pragma unroll
    for (int i = 0; i < 16; ++i) { *(LAS f32x4*)(scr + (8 * i + r8) * 32 + 4 * cg) = vv[i];
#pragma unroll
        for (int j = 0; j < 4; ++j) am[j] = fmaxf(am[j], fabsf(vv[i][j])); }
    { const int l_ = lane_local();
#pragma unroll
      for (int o = 8; o < 64; o <<= 1)
#pragma unroll
        for (int j = 0; j < 4; ++j) am[j] = fmaxf(am[j], shx(am[j], o, l_)); }
    if (lane < 8) *(LAS f32x4*)(red + wave * 32 + 4 * cg) = am;
    asm volatile("s_waitcnt lgkmcnt(0)" ::: "memory"); __builtin_amdgcn_s_barrier(); asm volatile("" ::: "memory");
    float amax = red[n];
#pragma unroll
    for (int w = 1; w < 8; ++w) amax = fmaxf(amax, red[w * 32 + n]);
    const float q = amax > 0.f ? F8MAX / amax : 0.f;
    const int dr = d.glu ? dst_row<2>(n0 + n) : (n0 + n);
    if (wave == 0 && lane < 32) d.SC[dr] = amax * (1.0f / F8MAX);
#pragma unroll
    for (int c = 0; c < 4; ++c) { float v[16];
#pragma unroll
        for (int j = 0; j < 16; ++j) v[j] = scr[(kk * 64 + c * 16 + j) * 32 + n] * q;
        v4u o; o.x = pg8::pk4_fp8(v[0], v[1], v[2], v[3]); o.y = pg8::pk4_fp8(v[4], v[5], v[6], v[7]); o.z = pg8::pk4_fp8(v[8], v[9], v[10], v[11]); o.w = pg8::pk4_fp8(v[12], v[13], v[14], v[15]);
        *(GAS v4u*)(d.W8 + (size_t)dr * 1024 + k0 + kk * 64 + c * 16) = o; }
    asm volatile("s_waitcnt lgkmcnt(0)" ::: "memory");
}
__device__ __forceinline__ void deferred_strips(const float* w1, const float* w2, unsigned char* ws, LAS unsigned char* lds, int first, int stride, int wave, int lane) {
    constexpr int NT = 128 * 96;
    auto stq = [](int idx) { return idx; };
    f32x4 va[16], vb[16]; StripSrc da, db; int idx = first, par = 0;
    if (idx < NT) { dstrip_desc(w1, w2, ws, stq(idx), da); dstrip_issue(da, wave, lane, va); }
#pragma unroll 1
    while (idx < NT) {
        const int i1 = idx + stride; if (i1 < NT) { dstrip_desc(w1, w2, ws, stq(i1), db); dstrip_issue(db, wave, lane, vb); }
        dstrip_finish(da, lds, wave, lane, par, va); par ^= 1;
        if (i1 >= NT) break;
        const int i2 = i1 + stride; if (i2 < NT) { dstrip_desc(w1, w2, ws, stq(i2), da); dstrip_issue(da, wave, lane, va); }
        dstrip_finish(db, lds, wave, lane, par, vb); par ^= 1;
        idx = i2;
    }
    __syncthreads();
}
__device__ __forceinline__ float ln_bound(const float* g, const float* b, int lane) {
    float mg = 0.f, mb = 0.f;
#pragma unroll
    for (int j = 0; j < 4; ++j) { const f32x4 a = *(const f32x4*)(g + j * 256 + lane * 4), c = *(const f32x4*)(b + j * 256 + lane * 4);
        mg = fmaxf(mg, fmaxf(fmaxf(fabsf(a[0]), fabsf(a[1])), fmaxf(fabsf(a[2]), fabsf(a[3])))); mb = fmaxf(mb, fmaxf(fmaxf(fabsf(c[0]), fabsf(c[1])), fmaxf(fabsf(c[2]), fabsf(c[3])))); }
#pragma unroll
    for (int o = 1; o < 64; o <<= 1) { mg = fmaxf(mg, shx(mg, o)); mb = fmaxf(mb, shx(mb, o)); }
    return 31.984371f * mg + mb;
}

struct Ptrs {
    const float *x, *rel_bias, *attn_w_in, *attn_lambda, *attn_subln, *attn_w_out, *conv_w_in, *conv_w, *conv_w_out, *router_w, *router_b, *w1, *b1, *w2, *b2, *ln_g, *ln_b;
    float* out; unsigned char* ws;
};

#ifndef DEFER_W
#define DEFER_W 1
#endif
__device__ __forceinline__ void expert_strip(const Ptrs& P, int st, LAS unsigned char* lds, int wave, int lane) {
    unsigned char* ws = P.ws;
    if (st < 128 * 64) { const int j = st >> 6, r = st & 63; p0_quant_strip<2>(P.w1 + (size_t)j * 1024 * 2048, 2048, ws + WS_W1 + (size_t)j * 2048 * 1024, (float*)(ws + WS_S1) + (size_t)j * 2048, r, lds, wave, lane); }
    else { const int q = st - 128 * 64, j = q >> 5, r = q & 31; p0_quant_strip<0>(P.w2 + (size_t)j * 1024 * 1024, 1024, ws + WS_W2 + (size_t)j * 1024 * 1024, (float*)(ws + WS_S2) + (size_t)j * 1024, r, lds, wave, lane); }
}
constexpr int NWAVES_ = 8;
__device__ __forceinline__ void p0_prologue(const Ptrs& P, LAS unsigned char* lds, int gw, int NGW, int wave, int lane) {
    LAS float* scr = (LAS float*)(lds + RING_OFF + wave * 16384);
    unsigned char* ws = P.ws;
    constexpr int I_OUT = 16 * 32, I_R = 16;
    constexpr int I_IN = 16 * 96;
    constexpr int S1 = NA16 * I_OUT, S3 = S1 + NO16 * I_OUT, S4 = S3 + 4 * I_R, S5 = S4 + NQ16 * I_IN, S6 = S5 + NC16 * I_IN;
    { const int wg = gw / NWAVES_, NWG = NGW / NWAVES_;
      constexpr int T1 = 128 * 64, T2 = T1 + 128 * 32, T3 = T2 + NQ8 * 96, T4 = T3 + NC8 * 96, T5 = T4 + NA8 * 32, T6 = T5 + NO8 * 32;
      constexpr int NE0 = DEFER_W ? 0 : T2;
#pragma unroll 1
      for (int s0 = wg; s0 < NE0 + (T6 - T2); s0 += NWG) {
        const int st = (s0 >= NE0) ? T2 + (s0 - NE0) : s0;
        if (st < T2) expert_strip(P, st, lds, wave, lane);
        else if (st < T3) { const int q = st - T2, j = QJ0 + q / 96, r = q % 96; p0_quant_strip<0, I8P>(P.attn_w_in + (size_t)j * 1024 * 3072, 3072, ws + WS_WAI + (size_t)j * 3072 * 1024, (float*)(ws + WS_SD) + (size_t)j * 3072, r, lds, wave, lane); }
        else if (st < T4) { const int q = st - T3, j = CJ0 + q / 96, r = q % 96; p0_quant_strip<1, I8P>(P.conv_w_in + (size_t)j * 1024 * 3072, 3072, ws + WS_WCI + (size_t)j * 3072 * 1024, (float*)(ws + WS_SD + 32 * 1024) + (size_t)j * 3072, r, lds, wave, lane); }
        else if (st < T5) { const int q = st - T4, j = AJ0 + q / 32, r = q % 32; p0_quant_strip<0>(P.attn_w_out + (size_t)j * 1024 * 1024, 1024, ws + WS_WAO8 + (size_t)j * 1024 * 1024, (float*)(ws + WS_SD + 24 * 1024) + (size_t)j * 1024, r, lds, wave, lane); }
        else { const int q = st - T5, j = OJ0 + q / 32, r = q % 32; p0_quant_strip<0, I8P>(P.conv_w_out + (size_t)j * 1024 * 1024, 1024, ws + WS_WCO8 + (size_t)j * 1024 * 1024, (float*)(ws + WS_SD + 56 * 1024) + (size_t)j * 1024, r, lds, wave, lane); }
      } }
    for (int it = gw; it < S6; it += NGW) {
        if (it >= S5) { const int q = it - S5, j = CK0 + q / I_IN, r = q % I_IN; p0_transpose_item<1>(P.conv_w_in + (size_t)j * 1024 * 3072, 1024, 3072, (bf16_t*)(ws + WS_WC16) + (size_t)j * 3072 * 1024, scr, r, lane); }
        else if (it >= S4) { const int q = it - S4, j = QK0 + q / I_IN, r = q % I_IN; p0_transpose_item<0>(P.attn_w_in + (size_t)j * 1024 * 3072, 1024, 3072, (bf16_t*)(ws + WS_WA16) + (size_t)j * 3072 * 1024, scr, r, lane); }
        else if (it < S1) { const int q = it, j = AK0 + q / I_OUT, r = q % I_OUT; p0_transpose_item<0>(P.attn_w_out + (size_t)j * 1024 * 1024, 1024, 1024, (bf16_t*)(ws + WS_WAO) + (size_t)j * 1024 * 1024, scr, r, lane); }
        else if (it < S3) { const int q = it - S1, j = OK0 + q / I_OUT, r = q % I_OUT; p0_transpose_item<0>(P.conv_w_out + (size_t)j * 1024 * 1024, 1024, 1024, (bf16_t*)(ws + WS_WCO) + (size_t)j * 1024 * 1024, scr, r, lane); }
        else { const int q = it - S3, j = q / I_R, r = q % I_R; p0_transpose_item<0>(P.router_w + (size_t)j * 1024 * 32, 1024, 32, (bf16_t*)(ws + WS_WR) + (size_t)j * 32 * 1024, scr, r, lane, P.ln_g + (size_t)(j * 2 + 0) * D); }
    }
    for (int row = gw; row < M; row += NGW) {
        f32x4 a[2][2]; float am = 0.f;
#pragma unroll
        for (int h = 0; h < 2; ++h)
#pragma unroll
            for (int q = 0; q < 2; ++q) { a[h][q] = *(const GAS f32x4*)(P.x + (size_t)row * D + h * 512 + lane * 8 + q * 4);
                am = fmaxf(am, fmaxf(fmaxf(fabsf(a[h][q][0]), fabsf(a[h][q][1])), fmaxf(fabsf(a[h][q][2]), fabsf(a[h][q][3])))); }
#pragma unroll
        for (int o = 1; o < 64; o <<= 1) am = fmaxf(am, shx(am, o));
        const float qs = QMAXP / fmaxf(am, 1e-30f);
        if ((QM & 1) && lane == 0) ((float*)(ws + WS_RS))[row] = am * (1.0f / QMAXP);
#pragma unroll
        for (int h = 0; h < 2; ++h) { v4u o; o.x = cvt_pk_bf16(a[h][0][0], a[h][0][1]); o.y = cvt_pk_bf16(a[h][0][2], a[h][0][3]); o.z = cvt_pk_bf16(a[h][1][0], a[h][1][1]); o.w = cvt_pk_bf16(a[h][1][2], a[h][1][3]);
            *(GAS v4u*)((bf16_t*)(ws + WS_XB) + (size_t)row * D + h * 512 + lane * 8) = o;
            if (QM & 1) { typedef unsigned u32x2 __attribute__((ext_vector_type(2))); u32x2 q8;
            q8.x = pg8::pkq4<I8P>(a[h][0][0] * qs, a[h][0][1] * qs, a[h][0][2] * qs, a[h][0][3] * qs); q8.y = pg8::pkq4<I8P>(a[h][1][0] * qs, a[h][1][1] * qs, a[h][1][2] * qs, a[h][1][3] * qs);
            *(GAS u32x2*)(ws + WS_XI + (size_t)row * D + h * 512 + lane * 8) = q8; } }
    }
}

__device__ __forceinline__ void conv_phase(const bf16_t* GB, const bf16_t* Z, const float* cw, bf16_t* Gout, float* RS, bool o8, int gw, int NGW, int lane) {
    float w[3][16];
#pragma unroll
    for (int j = 0; j < 3; ++j)
#pragma unroll
        for (int h = 0; h < 2; ++h)
#pragma unroll
            for (int q = 0; q < 2; ++q) { const f32x4 t = *(const f32x4*)(cw + j * D + h * 512 + lane * 8 + q * 4); w[j][h * 8 + q * 4 + 0] = t[0]; w[j][h * 8 + q * 4 + 1] = t[1]; w[j][h * 8 + q * 4 + 2] = t[2]; w[j][h * 8 + q * 4 + 3] = t[3]; }
    for (int run = gw; run < M / 32; run += NGW) {
        const int t0 = run * 32; const bool first = (t0 % SEQ) == 0, lastr = ((t0 + 32) % SEQ) == 0;
        v4u zp[2], zc[2], zn[2];
#pragma unroll
        for (int h = 0; h < 2; ++h) { zp[h] = first ? (v4u){0u, 0u, 0u, 0u} : *(const v4u*)(Z + (size_t)(t0 - 1) * D + h * 512 + lane * 8); zc[h] = *(const v4u*)(Z + (size_t)t0 * D + h * 512 + lane * 8); }
        for (int r = 0; r < 32; ++r) { const int t = t0 + r; const bool pad = lastr && (r == 31);
            float o[2][8];
#pragma unroll
            for (int h = 0; h < 2; ++h) {
                zn[h] = pad ? (v4u){0u, 0u, 0u, 0u} : *(const v4u*)(Z + (size_t)(t + 1) * D + h * 512 + lane * 8);
                const v4u gb = *(const v4u*)(GB + (size_t)t * D + h * 512 + lane * 8);
#pragma unroll
                for (int q = 0; q < 4; ++q) { const unsigned up = zp[h][q], uc = zc[h][q], un = zn[h][q], ug = gb[q]; const int c = h * 8 + q * 2;
                    o[h][q * 2 + 0] = bf_lo(ug) * (w[0][c] * bf_lo(up) + w[1][c] * bf_lo(uc) + w[2][c] * bf_lo(un));
                    o[h][q * 2 + 1] = bf_hi(ug) * (w[0][c + 1] * bf_hi(up) + w[1][c + 1] * bf_hi(uc) + w[2][c + 1] * bf_hi(un)); }
                if (!o8) { v4u ov; ov.x = cvt_pk_bf16(o[h][0], o[h][1]); ov.y = cvt_pk_bf16(o[h][2], o[h][3]); ov.z = cvt_pk_bf16(o[h][4], o[h][5]); ov.w = cvt_pk_bf16(o[h][6], o[h][7]);
                    *(v4u*)(Gout + (size_t)t * D + h * 512 + lane * 8) = ov; }
                zp[h] = zc[h]; zc[h] = zn[h];
            }
            if (o8) { float am = 0.f;
#pragma unroll
                for (int h = 0; h < 2; ++h)
#pragma unroll
                    for (int i = 0; i < 8; ++i) am = fmaxf(am, fabsf(o[h][i]));
#pragma unroll
                for (int s_ = 1; s_ < 64; s_ <<= 1) am = fmaxf(am, shx(am, s_));
                const float qs = QMAXP / fmaxf(am, 1e-30f);
                if (lane == 0) RS[t] = am * (1.0f / QMAXP);
#pragma unroll
                for (int h = 0; h < 2; ++h) { typedef unsigned u32x2 __attribute__((ext_vector_type(2))); u32x2 q8;
                    q8.x = pg8::pkq4<I8P>(o[h][0] * qs, o[h][1] * qs, o[h][2] * qs, o[h][3] * qs); q8.y = pg8::pkq4<I8P>(o[h][4] * qs, o[h][5] * qs, o[h][6] * qs, o[h][7] * qs);
                    *(u32x2*)((unsigned char*)Gout + (size_t)t * D + h * 512 + lane * 8) = q8; } }
        }
    }
}

__device__ __forceinline__ void ln2_phase(const bf16_t* Yp, const float* g1, const float* b1, const unsigned char* Y, const float* g, const float* bta, bf16_t* XB, float* out, unsigned char* XI, float* RS, int gw, int NGW, int lane) {
    float gg[16], bb[16];
#pragma unroll
    for (int h = 0; h < 2; ++h)
#pragma unroll
        for (int q = 0; q < 2; ++q) { const f32x4 t = *(const f32x4*)(g + h * 512 + lane * 8 + q * 4), s = *(const f32x4*)(bta + h * 512 + lane * 8 + q * 4);
#pragma unroll
            for (int i = 0; i < 4; ++i) { gg[h * 8 + q * 4 + i] = t[i]; bb[h * 8 + q * 4 + i] = s[i]; } }
    float sXb = 0.f, rsXb = 0.f; if constexpr (!I8P) { const float lb = ln_bound(g, bta, lane); sXb = F8MAX / lb; rsXb = lb * (1.0f / F8MAX); }
    for (int row = gw; row < M; row += NGW) {
        float v[16];
#pragma unroll
        for (int h = 0; h < 2; ++h) { const v4u xr = *(const v4u*)(Yp + (size_t)row * D + h * 512 + lane * 8);
#pragma unroll
            for (int q = 0; q < 4; ++q) { v[h * 8 + q * 2] = bf_lo(xr[q]); v[h * 8 + q * 2 + 1] = bf_hi(xr[q]); } }
        { float s1 = 0.f;
#pragma unroll
          for (int i = 0; i < 16; ++i) s1 += v[i];
          const float m1 = wave_sum(s1) * (1.f / D); float q1 = 0.f;
#pragma unroll
          for (int i = 0; i < 16; ++i) { v[i] -= m1; q1 += v[i] * v[i]; }
          const float r1 = ALPHA / sqrtf(wave_sum(q1) * (1.f / D) + LN_EPS);
#pragma unroll
          for (int h = 0; h < 2; ++h)
#pragma unroll
            for (int q = 0; q < 2; ++q) { const f32x4 t = *(const f32x4*)(g1 + h * 512 + lane * 8 + q * 4), u = *(const f32x4*)(b1 + h * 512 + lane * 8 + q * 4);
#pragma unroll
              for (int i = 0; i < 4; ++i) v[h * 8 + q * 4 + i] = v[h * 8 + q * 4 + i] * r1 * t[i] + ALPHA * u[i]; } }
#pragma unroll
        for (int k = 0; k < 4; ++k)
#pragma unroll
            for (int h = 0; h < 2; ++h) { typedef unsigned u32x2 __attribute__((ext_vector_type(2))); const u32x2 yr = *(const u32x2*)(Y + ((size_t)row * 4 + k) * D + h * 512 + lane * 8);
#pragma unroll
                for (int q = 0; q < 2; ++q) { const f32x2 lo = __builtin_amdgcn_cvt_pk_f32_fp8((int)yr[q], false), hi2 = __builtin_amdgcn_cvt_pk_f32_fp8((int)yr[q], true);
                    v[h * 8 + q * 4 + 0] += lo[0] * (1.0f / YSCALE); v[h * 8 + q * 4 + 1] += lo[1] * (1.0f / YSCALE); v[h * 8 + q * 4 + 2] += hi2[0] * (1.0f / YSCALE); v[h * 8 + q * 4 + 3] += hi2[1] * (1.0f / YSCALE); } }
        float s = 0.f;
#pragma unroll
        for (int i = 0; i < 16; ++i) s += v[i];
        const float mean = wave_sum(s) * (1.f / D); float s2 = 0.f;
#pragma unroll
        for (int i = 0; i < 16; ++i) { v[i] -= mean; s2 += v[i] * v[i]; }
        const float rstd = 1.f / sqrtf(wave_sum(s2) * (1.f / D) + LN_EPS);
#pragma unroll
        for (int i = 0; i < 16; ++i) v[i] = v[i] * rstd * gg[i] + bb[i];
        float sX = sXb, rsX = rsXb;
        if (I8P && XI) { float am = 0.f;
#pragma unroll
            for (int i = 0; i < 16; ++i) am = fmaxf(am, fabsf(v[i]));
#pragma unroll
            for (int o = 1; o < 64; o <<= 1) am = fmaxf(am, shx(am, o));
            sX = QMAXP / fmaxf(am, 1e-30f); rsX = am * (1.0f / QMAXP); }
#pragma unroll
        for (int h = 0; h < 2; ++h) { v4u ov; ov.x = cvt_pk_bf16(v[h * 8 + 0], v[h * 8 + 1]); ov.y = cvt_pk_bf16(v[h * 8 + 2], v[h * 8 + 3]); ov.z = cvt_pk_bf16(v[h * 8 + 4], v[h * 8 + 5]); ov.w = cvt_pk_bf16(v[h * 8 + 6], v[h * 8 + 7]);
            if (!out) *(v4u*)(XB + (size_t)row * D + h * 512 + lane * 8) = ov;
            if (XI) { typedef unsigned u32x2 __attribute__((ext_vector_type(2))); u32x2 q8; q8.x = pg8::pkq4<I8P>(v[h * 8 + 0] * sX, v[h * 8 + 1] * sX, v[h * 8 + 2] * sX, v[h * 8 + 3] * sX); q8.y = pg8::pkq4<I8P>(v[h * 8 + 4] * sX, v[h * 8 + 5] * sX, v[h * 8 + 6] * sX, v[h * 8 + 7] * sX);
                *(u32x2*)(XI + (size_t)row * D + h * 512 + lane * 8) = q8; if (h == 0 && lane == 0) RS[row] = rsX; }
            if (out) { *(f32x4*)(out + (size_t)row * D + h * 512 + lane * 8) = (f32x4){v[h * 8 + 0], v[h * 8 + 1], v[h * 8 + 2], v[h * 8 + 3]};
                       *(f32x4*)(out + (size_t)row * D + h * 512 + lane * 8 + 4) = (f32x4){v[h * 8 + 4], v[h * 8 + 5], v[h * 8 + 6], v[h * 8 + 7]}; } }
    }
}

constexpr int RT_PITCH = 2064, R_OFF_G = 32 * RT_PITCH, R_OFF_LG = R_OFF_G + 8192, R_OFF_CNT = R_OFF_LG + 8 * 16 * 33 * 4, R_OFF_SW = R_OFF_CNT + 256, R_LDS = R_OFF_SW + 256;
typedef __bf16 bf16x2_t __attribute__((ext_vector_type(2)));
__device__ __forceinline__ void router_phase(const bf16_t* Yp, const float* g, const float* bta, const bf16_t* RTg, const float* Wr, const float* rb, unsigned char* X8, int* lslot, float* lgate, unsigned* cnt,
                                             char* lds, int blk0, int G, int tid, int wave, int lane) {
    for (int i = tid; i < 32 * 128; i += 512) { const int e = i >> 7, c = i & 127; *(v4u*)(lds + e * RT_PITCH + c * 16) = *(const v4u*)(RTg + (size_t)e * 1024 + c * 8); }
    float* gl = (float*)(lds + R_OFF_G); float* bl = gl + 1024;
    for (int i = tid; i < 1024; i += 512) { gl[i] = g[i]; bl[i] = bta[i]; }
    float* LG = (float*)(lds + R_OFF_LG) + wave * (16 * 33);
    int* lcnt = (int*)(lds + R_OFF_CNT); int* lbase = lcnt + 32;
    float* sWl = (float*)(lds + R_OFF_SW); float* cBl = sWl + 32;
    __syncthreads();
#pragma unroll 1
    for (int j = 0; j < 4; ++j) { const int e = wave * 4 + j; float a = 0.f, c = 0.f;
#pragma unroll 4
        for (int i = 0; i < 16; ++i) { const int k = lane + 64 * i; a += __uint_as_float((unsigned)(*(const bf16_t*)(lds + e * RT_PITCH + k * 2)) << 16); c += bl[k] * Wr[(size_t)k * 32 + e]; }
        a = wave_sum(a); c = wave_sum(c); if (lane == 0) { sWl[e] = a; cBl[e] = c + rb[e]; } }
    const int t16 = lane & 15, kq = lane >> 4;
    const float sA = F8MAX / ln_bound(g, bta, lane);
#pragma unroll 1
    for (int blk = blk0; blk < M / 128; blk += G) {
        if (tid < 32) lcnt[tid] = 0;
        __syncthreads();
        int my_e, my_rank, my_slot; float my_gate;
        const int r0 = blk * 128 + wave * 16; const size_t rowoff = (size_t)(r0 + t16) * D + kq * 8;
        v4u yv[32];
#pragma unroll
        for (int kb = 0; kb < 32; ++kb) yv[kb] = *(const v4u*)(Yp + rowoff + kb * 32);
        f32x4 acc0 = {0.f, 0.f, 0.f, 0.f}, acc1 = {0.f, 0.f, 0.f, 0.f}, accs = {0.f, 0.f, 0.f, 0.f}, accq = {0.f, 0.f, 0.f, 0.f};
        const bf16x8 ones8 = {(short)0x3F80, (short)0x3F80, (short)0x3F80, (short)0x3F80, (short)0x3F80, (short)0x3F80, (short)0x3F80, (short)0x3F80};
#pragma unroll
        for (int kb = 0; kb < 32; ++kb) { const int c0 = kb * 32 + kq * 8;
            const bf16x8 w0 = *(const bf16x8*)(lds + t16 * RT_PITCH + c0 * 2), w1 = *(const bf16x8*)(lds + (16 + t16) * RT_PITCH + c0 * 2);
            const bf16x8 xb = __builtin_bit_cast(bf16x8, yv[kb]);
            acc0 = __builtin_amdgcn_mfma_f32_16x16x32_bf16(w0, xb, acc0, 0, 0, 0);
            acc1 = __builtin_amdgcn_mfma_f32_16x16x32_bf16(w1, xb, acc1, 0, 0, 0);
            accs = __builtin_amdgcn_mfma_f32_16x16x32_bf16(ones8, xb, accs, 0, 0, 0);
            accq = __builtin_amdgcn_mfma_f32_16x16x32_bf16(xb, xb, accq, 0, 0, 0); }
        const float s = accs[0];
        const int dsel = t16 & 3; float dq_ = dsel == 0 ? accq[0] : (dsel == 1 ? accq[1] : (dsel == 2 ? accq[2] : accq[3]));
        const float s2 = __int_as_float(__builtin_amdgcn_ds_bpermute(((t16 >> 2) * 16 + t16) << 2, __float_as_int(dq_)));
        const float mean = s * (1.f / D); const float var = fmaxf(s2 * (1.f / D) - mean * mean, 0.f);
        const float rstd = 1.f / sqrtf(var + LN_EPS);
        {
            float* lgr = LG + t16 * 33;
#pragma unroll
            for (int i = 0; i < 4; ++i) { const int e0 = kq * 4 + i, e1 = 16 + kq * 4 + i;
                lgr[e0] = rstd * (acc0[i] - mean * sWl[e0]) + cBl[e0]; lgr[e1] = rstd * (acc1[i] - mean * sWl[e1]) + cBl[e1]; }
            LDS_WAIT(); asm volatile("" ::: "memory");
            float t0 = -INFINITY, t1 = -INFINITY, t2 = -INFINITY, t3 = -INFINITY; int i0 = 0, i1 = 0, i2 = 0, i3 = 0;
#pragma unroll
            for (int e = 0; e < 32; ++e) { const float v = lgr[e];
                const bool c0 = v > t0, c1 = v > t1, c2 = v > t2, c3 = v > t3;
                t3 = c2 ? t2 : (c3 ? v : t3); i3 = c2 ? i2 : (c3 ? e : i3);
                t2 = c1 ? t1 : (c2 ? v : t2); i2 = c1 ? i1 : (c2 ? e : i2);
                t1 = c0 ? t0 : (c1 ? v : t1); i1 = c0 ? i0 : (c1 ? e : i1);
                t0 = c0 ? v : t0; i0 = c0 ? e : i0; }
            const float e1 = __expf(t1 - t0), e2 = __expf(t2 - t0), e3 = __expf(t3 - t0); const float inv = 1.f / (1.f + e1 + e2 + e3);
            const int ek = kq == 0 ? i0 : (kq == 1 ? i1 : (kq == 2 ? i2 : i3)); const float gk = (kq == 0 ? 1.f : (kq == 1 ? e1 : (kq == 2 ? e2 : e3))) * inv;
            my_e = ek; my_gate = gk; my_slot = (r0 + t16) * 4 + kq; my_rank = atomicAdd(&lcnt[ek], 1);
            LDS_WAIT(); asm volatile("" ::: "memory");
        }
        const float rs = rstd * sA;
#pragma unroll
        for (int kb = 0; kb < 32; ++kb) { const int c0 = kb * 32 + kq * 8; const v4u y = yv[kb];
            const f32x4 g0 = *(const f32x4*)(gl + c0) * rs, g1 = *(const f32x4*)(gl + c0 + 4) * rs, b0 = *(const f32x4*)(bl + c0) * sA, b1 = *(const f32x4*)(bl + c0 + 4) * sA;
            typedef unsigned u32x2 __attribute__((ext_vector_type(2))); u32x2 q8;
            q8.x = pg8::pk4_fp8((bf_lo(y.x) - mean) * g0[0] + b0[0], (bf_hi(y.x) - mean) * g0[1] + b0[1], (bf_lo(y.y) - mean) * g0[2] + b0[2], (bf_hi(y.y) - mean) * g0[3] + b0[3]);
            q8.y = pg8::pk4_fp8((bf_lo(y.z) - mean) * g1[0] + b1[0], (bf_hi(y.z) - mean) * g1[1] + b1[1], (bf_lo(y.w) - mean) * g1[2] + b1[2], (bf_hi(y.w) - mean) * g1[3] + b1[3]);
            *(u32x2*)(X8 + rowoff + kb * 32) = q8;
            asm volatile("" ::: "memory"); }
        __syncthreads();
        if (tid < 32) lbase[tid] = (int)__hip_atomic_fetch_add(cnt + tid * 64, (unsigned)lcnt[tid], RLX_AGENT);
        __syncthreads();
        { const int pos = lbase[my_e] + my_rank; lslot[(size_t)my_e * LCAP + pos] = my_slot; lgate[(size_t)my_e * LCAP + pos] = my_gate; }
        __syncthreads();
    }
}

__device__ __forceinline__ float attn_obound(const float* gsub, float osc, int lane) {
    float mg = fmaxf(fabsf(gsub[lane]), fabsf(gsub[64 + lane]));
#pragma unroll
    for (int o = 1; o < 64; o <<= 1) mg = fmaxf(mg, shx(mg, o));
    return 11.3137085f * mg * fabsf(osc);
}

constexpr int NWAVES = 8;
constexpr int N_PHASES = 1 + DEPTH * 7;
#ifndef REP_ATTN
#define REP_ATTN 1
#endif
#ifndef KREP_MOE
#define KREP_MOE 1
#endif
#ifndef REP_MOE
#define REP_MOE 1
#endif
#ifndef REP_P0
#define REP_P0 1
#endif
#ifndef REP_THIN
#define REP_THIN 1
#endif
#ifndef REP_DENSE
#define REP_DENSE 1
#endif
#ifndef MK_SPLIT
#define MK_SPLIT 0
#endif
struct Args { const float* in[17]; float* out; unsigned char* ws; int ph_lo, ph_hi, li, pad; };
typedef const __attribute__((address_space(4))) Args* ArgsP;
enum { I_X = 0, I_RELB, I_AWIN, I_ALAM, I_ASUB, I_AWOUT, I_CWIN, I_CW, I_CWOUT, I_RW, I_RB, I_W1, I_B1, I_W2, I_B2, I_LNG, I_LNB };
__global__ void __launch_bounds__(NWAVES * 64, 2) mk_fwd(Args args) {
    extern __shared__ __attribute__((aligned(16))) unsigned char lds[];
    LAS unsigned char* ldsl = (LAS unsigned char*)lds;
    volatile LAS unsigned* MISC = (volatile LAS unsigned*)(ldsl + MISC_OFF);
    const int tid0 = threadIdx.x;
    const int wave0 = __builtin_amdgcn_readfirstlane(tid0 >> 6);
    const int G0 = gridDim.x, bx0 = blockIdx.x;
#define PHASE_BEGIN() int wv_ = wave0; asm volatile("" : "+s"(wv_)); int ln_; asm volatile("v_mbcnt_lo_u32_b32 %0, -1, 0\n\tv_mbcnt_hi_u32_b32 %0, -1, %0" : "=v"(ln_)); int tid = wv_ * 64 + ln_; int G = G0, bx = bx0; asm volatile("" : "+s"(G), "+s"(bx)); const int vcu = (G % 8 == 0) ? (bx % 8) * (G / 8) + bx / 8 : bx; const int NGW = G * NWAVES; \
        const int lane = tid & 63, wave = __builtin_amdgcn_readfirstlane(tid >> 6); const int gw = vcu * NWAVES + wave; (void)lane; (void)gw; (void)NGW; \
        ArgsP ap = (ArgsP)__builtin_amdgcn_kernarg_segment_ptr(); asm volatile("" : "+s"(ap)); unsigned char* ws = ap->ws; gu32* ctl = (gu32*)(ws + WS_CTL); (void)ctl
    for (int u = tid0; u < (LDS_BYTES - LDSCTL_OFF) / 4; u += NWAVES * 64) ((LAS unsigned*)(ldsl + LDSCTL_OFF))[u] = 0u;
    __syncthreads();
    XcdBarrier bar = xcd_barrier_post((unsigned*)(args.ws + WS_CTL) + CW_BAR + (size_t)args.li * 4096, MISC + 8);
    const int lo = args.ph_lo, hi = args.ph_hi;
#define IN(k) (lo <= (k) && (k) < hi)
#define SEAM(k) do { if (IN((k) + 1)) xcd_barrier(bar); } while (0)
    LAS int* tb = (LAS int*)(ldsl + LDSCTL_OFF); LAS int* cn = tb + 64;

    if (IN(0)) { PHASE_BEGIN();
        Ptrs P; P.x = ap->in[I_X]; P.attn_w_in = ap->in[I_AWIN]; P.attn_w_out = ap->in[I_AWOUT]; P.conv_w_in = ap->in[I_CWIN]; P.conv_w_out = ap->in[I_CWOUT]; P.router_w = ap->in[I_RW]; P.ln_g = ap->in[I_LNG]; P.w1 = ap->in[I_W1]; P.w2 = ap->in[I_W2]; P.ws = ws;
        _Pragma("unroll 1") for (int rep = 0; rep < REP_P0; ++rep) p0_prologue(P, ldsl, gw, NGW, wave, lane); SEAM(0); }

#define MOE_GEMMS(L, pb) do { \
            if (IN((pb) + 4)) { PHASE_BEGIN(); \
                pg8::MoeProb<true, true> S{(const char*)(ws + WS_X8), (const char*)(ws + WS_W1) + (size_t)(L) * 32 * 2048 * 1024, (size_t)2048 * 1024, 8, G, vcu, (int)tb[32], tb, cn, (const int*)(ws + WS_LS), lane, tid}; \
                pg8::EpiMoe1 E{ws + WS_A2, ap->in[I_B1] + (size_t)(L) * 32 * 2048, (const float*)(ws + WS_S1) + (size_t)(L) * 32 * 2048, ln_bound(ap->in[I_LNG] + ((L) * 2 + 0) * D, ap->in[I_LNB] + ((L) * 2 + 0) * D, lane) * (1.0f / F8MAX) * (1.0f / KREP_MOE)}; \
                pg8::gemm_phase<pg8::MoeProb<true, true>, pg8::EpiMoe1, true, true, KREP_MOE>(ldsl + RING_OFF, ldsl + XL_OFF, S, E); \
                SEAM((pb) + 4); \
            } \
            if (IN((pb) + 5)) { PHASE_BEGIN(); \
                pg8::MoeProb<false, true> S{(const char*)(ws + WS_A2), (const char*)(ws + WS_W2) + (size_t)(L) * 32 * 1024 * 1024, (size_t)1024 * 1024, 4, G, vcu, (int)tb[32], tb, cn, (const int*)(ws + WS_LS), lane, tid}; \
                pg8::EpiMoe2 E{ws + WS_Y, ap->in[I_B2] + (size_t)(L) * 32 * 1024, (const float*)(ws + WS_S2) + (size_t)(L) * 32 * 1024, (const int*)(ws + WS_LS), (const float*)(ws + WS_LG)}; \
                pg8::gemm_phase<pg8::MoeProb<false, true>, pg8::EpiMoe2, true, true, KREP_MOE>(ldsl + RING_OFF, ldsl + XL_OFF, S, E); \
                SEAM((pb) + 5); \
            } \
        } while (0)
#if REP_MOE == 2
#define MOE_GEMMS_REP(L, pb) MOE_GEMMS(L, pb)
#else
#define MOE_GEMMS_REP(L, pb) do {} while (0)
#endif
#define MOE_HALF(L, pb) do { \
            if (IN((pb) + 3)) { PHASE_BEGIN(); \
                router_phase((const bf16_t*)(ws + WS_YP), ap->in[I_LNG] + ((L) * 2 + 0) * D, ap->in[I_LNB] + ((L) * 2 + 0) * D, (const bf16_t*)(ws + WS_WR) + (size_t)(L) * 32 * 1024, ap->in[I_RW] + (size_t)(L) * 1024 * 32, ap->in[I_RB] + (L) * 32, \
                             ws + WS_X8, (int*)(ws + WS_LS), (float*)(ws + WS_LG), (unsigned*)(ctl + CW_CNT) + (L) * 32 * 64, (char*)lds + RING_OFF, vcu, G, tid, wave, lane); \
                SEAM((pb) + 3); \
            } \
            if (IN((pb) + 4) || IN((pb) + 5)) { PHASE_BEGIN(); \
                if (tid < 64) { const int c_ = (lane < 32) ? (int)__hip_atomic_load(ctl + CW_CNT + ((L) * 32 + (lane & 31)) * 64, RLX_AGENT) : 0; const int t_ = (c_ + 255) >> 8; int p_ = t_; \
                    _Pragma("unroll") for (int o_ = 1; o_ < 32; o_ <<= 1) { const int q_ = __builtin_amdgcn_ds_bpermute((lane - o_) * 4, p_); if (lane >= o_) p_ += q_; } \
                    if (lane < 32) { cn[lane] = c_; tb[lane + 1] = p_; } if (lane == 0) tb[0] = 0; } \
                __syncthreads(); \
            } \
            MOE_GEMMS(L, pb); MOE_GEMMS_REP(L, pb); \
            if (REP_THIN == 2 && IN((pb) + 6)) { PHASE_BEGIN(); \
                ln2_phase((const bf16_t*)(ws + WS_YP), ap->in[I_LNG] + ((L) * 2 + 0) * D, ap->in[I_LNB] + ((L) * 2 + 0) * D, (const unsigned char*)(ws + WS_Y), ap->in[I_LNG] + ((L) * 2 + 1) * D, ap->in[I_LNB] + ((L) * 2 + 1) * D, (bf16_t*)(ws + WS_XB), ((L) == DEPTH - 1) ? ap->out : nullptr, ((((L) == 0) && (CM & 1)) || (((L) == 1) && (QM & 2)) || (((L) == 2) && (CM & 2))) ? ws + WS_XI : nullptr, (float*)(ws + WS_RS), gw, NGW, lane); \
            } \
            if (IN((pb) + 6)) { PHASE_BEGIN(); \
                ln2_phase((const bf16_t*)(ws + WS_YP), ap->in[I_LNG] + ((L) * 2 + 0) * D, ap->in[I_LNB] + ((L) * 2 + 0) * D, (const unsigned char*)(ws + WS_Y), ap->in[I_LNG] + ((L) * 2 + 1) * D, ap->in[I_LNB] + ((L) * 2 + 1) * D, (bf16_t*)(ws + WS_XB), ((L) == DEPTH - 1) ? ap->out : nullptr, ((((L) == 0) && (CM & 1)) || (((L) == 1) && (QM & 2)) || (((L) == 2) && (CM & 2))) ? ws + WS_XI : nullptr, (float*)(ws + WS_RS), gw, NGW, lane); \
                if ((pb) + 7 < N_PHASES) SEAM((pb) + 6); \
            } \
        } while (0)

#pragma unroll 1
    for (int lp = 0; lp < DEPTH / 2; ++lp) {
        {
            const int L = 2 * lp, pb = 1 + L * 7;
            if (IN(pb + 0)) {
                PHASE_BEGIN();
                if (QM == 3 || (QM != 0 && ((QM >> lp) & 1))) {
                pg8::DenseProbT<true> S; S.init(ws + WS_XI, ws + WS_WAI + (size_t)lp * 3072 * 1024, M, 3072, G, bx, tid);
                pg8::EpiQKV8 E{(bf16_t*)(ws + WS_Q), (size_t)(WS_K - WS_Q) / 2, QSCALE, (const float*)(ws + WS_SD) + lp * 3072, (const float*)(ws + WS_RS)};
                pg8::gemm_phase<pg8::DenseProbT<true>, pg8::EpiQKV8, true, true, 1, I8P>(ldsl + RING_OFF, ldsl + XL_OFF, S, E);
                } else {
                pg8::DenseProb S; S.init(ws + WS_XB, (const bf16_t*)(ws + WS_WA16) + (size_t)lp * 3072 * 1024, M, 3072, G, bx, tid);
                pg8::EpiQKV E{(bf16_t*)(ws + WS_Q), (size_t)(WS_K - WS_Q) / 2, QSCALE};
                pg8::gemm_phase<pg8::DenseProb, pg8::EpiQKV, true>(ldsl + RING_OFF, ldsl + XL_OFF, S, E);
                }
                SEAM(pb + 0);
            }
            if (IN(pb + 1)) {
                PHASE_BEGIN();
                const float* lf = ap->in[I_ALAM] + lp * 256;
                const float s1 = wave_sum(lf[lane] * lf[64 + lane]), s2 = wave_sum(lf[128 + lane] * lf[192 + lane]);
                const float lam_init = (lp == 0) ? 0.2f : (0.8f - 0.6f * 0.54881163609402643f);
                const float lam = __expf(s1) - __expf(s2) + lam_init;
                const bool o8 = (AOM == 3) || (AOM != 0 && ((AOM >> lp) & 1));
                const float oscl = o8 ? (1.0f - lam_init) * (F8MAX / attn_obound(ap->in[I_ASUB] + lp * 128, 1.0f - lam_init, lane)) : (1.0f - lam_init);
                int hprev = -1;
#pragma unroll 1
                for (int rep = 0; rep < REP_ATTN; ++rep)
#pragma unroll 1
                for (int i = 0; i < (BATCH * NH * 32) / 256; ++i) {
                    const int item = i * G + vcu;
                    if (item >= BATCH * NH * 32) break;
                    const int bh = item >> 5, qb = item & 31;
                    const bool newh = (i == 0) || ((bh & 7) != hprev); hprev = bh & 7;
                    att::attn_unit(bh >> 3, bh & 7, qb, (const bf16_t*)(ws + WS_Q), (const bf16_t*)(ws + WS_K), (const bf16_t*)(ws + WS_V), (bf16_t*)(ws + WS_O), lam, oscl,
                                   ap->in[I_ASUB] + lp * 128, ap->in[I_RELB], (char*)lds + RING_OFF, tid, newh, o8);
                    if (DEFER_W && lp == 0 && i == (vcu & 15)) {
                        Ptrs P; P.w1 = ap->in[I_W1]; P.w2 = ap->in[I_W2]; P.ws = ws;
                        int ln_s = lane; asm volatile("" : "+v"(ln_s));
                        deferred_strips(P.w1, P.w2, ws, ldsl, vcu, G, wave, ln_s);
                        hprev = -1;
                    }
                }
                SEAM(pb + 1);
            }
            if (IN(pb + 2)) {
                PHASE_BEGIN();
                if ((AOM == 3) || (AOM != 0 && ((AOM >> lp) & 1))) {
                const float lam_init = (lp == 0) ? 0.2f : (0.8f - 0.6f * 0.54881163609402643f);
                pg8::DenseProbT<true> S; S.init(ws + WS_O, ws + WS_WAO8 + (size_t)lp * 1024 * 1024, M, 1024, G, bx, tid);
                pg8::EpiResid8<false> E{(const bf16_t*)(ws + WS_XB), (bf16_t*)(ws + WS_YP), (const float*)(ws + WS_SD + 24 * 1024) + lp * 1024, nullptr, attn_obound(ap->in[I_ASUB] + lp * 128, 1.0f - lam_init, lane) * (1.0f / F8MAX)};
                pg8::gemm_phase<pg8::DenseProbT<true>, pg8::EpiResid8<false>, true, true>(ldsl + RING_OFF, ldsl + XL_OFF, S, E);
                } else {
                pg8::DenseProb S; S.init(ws + WS_O, (const bf16_t*)(ws + WS_WAO) + (size_t)lp * 1024 * 1024, M, 1024, G, bx, tid);
                pg8::EpiResid E{(const bf16_t*)(ws + WS_XB), (bf16_t*)(ws + WS_YP)};
                pg8::gemm_phase<pg8::DenseProb, pg8::EpiResid, true>(ldsl + RING_OFF, ldsl + XL_OFF, S, E);
                }
                SEAM(pb + 2);
            }
            MOE_HALF(L, pb);
        }
        {
            const int L = 2 * lp + 1, pb = 1 + L * 7;
            if (IN(pb + 0)) {
                PHASE_BEGIN();
                if (CM == 3 || (CM != 0 && ((CM >> lp) & 1))) {
                pg8::DenseProbT<true> S; S.init(ws + WS_XI, ws + WS_WCI + (size_t)lp * 3072 * 1024, M, 3072, G, bx, tid);
                pg8::EpiConvIn8 E{(bf16_t*)(ws + WS_Q), (bf16_t*)(ws + WS_K), (const float*)(ws + WS_SD + 32 * 1024) + lp * 3072, (const float*)(ws + WS_RS)};
                pg8::gemm_phase<pg8::DenseProbT<true>, pg8::EpiConvIn8, true, true, 1, I8P>(ldsl + RING_OFF, ldsl + XL_OFF, S, E);
                } else {
                pg8::DenseProb S; S.init(ws + WS_XB, (const bf16_t*)(ws + WS_WC16) + (size_t)lp * 3072 * 1024, M, 3072, G, bx, tid);
                pg8::EpiConvIn E{(bf16_t*)(ws + WS_Q), (bf16_t*)(ws + WS_K)};
                pg8::gemm_phase<pg8::DenseProb, pg8::EpiConvIn, true>(ldsl + RING_OFF, ldsl + XL_OFF, S, E);
                }
                SEAM(pb + 0);
            }
            if (IN(pb + 1)) { PHASE_BEGIN(); conv_phase((const bf16_t*)(ws + WS_Q), (const bf16_t*)(ws + WS_K), ap->in[I_CW] + lp * 3 * D, (bf16_t*)(ws + WS_O), (float*)(ws + WS_RS), (COM == 3) || (COM != 0 && ((COM >> lp) & 1)), gw, NGW, lane); SEAM(pb + 1); }
            if (IN(pb + 2)) {
                PHASE_BEGIN();
                if ((COM == 3) || (COM != 0 && ((COM >> lp) & 1))) {
                pg8::DenseProbT<true> S; S.init(ws + WS_O, ws + WS_WCO8 + (size_t)lp * 1024 * 1024, M, 1024, G, bx, tid);
                pg8::EpiResid8<true> E{(const bf16_t*)(ws + WS_XB), (bf16_t*)(ws + WS_YP), (const float*)(ws + WS_SD + 56 * 1024) + lp * 1024, (const float*)(ws + WS_RS), 1.0f};
                pg8::gemm_phase<pg8::DenseProbT<true>, pg8::EpiResid8<true>, true, true, 1, I8P>(ldsl + RING_OFF, ldsl + XL_OFF, S, E);
                } else {
                pg8::DenseProb S; S.init(ws + WS_O, (const bf16_t*)(ws + WS_WCO) + (size_t)lp * 1024 * 1024, M, 1024, G, bx, tid);
                pg8::EpiResid E{(const bf16_t*)(ws + WS_XB), (bf16_t*)(ws + WS_YP)};
                pg8::gemm_phase<pg8::DenseProb, pg8::EpiResid, true>(ldsl + RING_OFF, ldsl + XL_OFF, S, E);
                }
                SEAM(pb + 2);
            }
            MOE_HALF(L, pb);
        }
    }
#undef IN
#undef SEAM
}

extern "C" void kernel_launch(void* const* d_in, const int* in_sizes, int n_in, void* d_out, int out_size, void* d_ws, size_t ws_size, hipStream_t stream) {
    static int grid = 0;
    if (grid == 0) {
        if (n_in != 17 || in_sizes[0] != M * D || out_size != M * D || ws_size < WS_END) {
            fprintf(stderr, "kernel_launch: shape mismatch: n_in %d in0 %d out %d ws %zu (need %zu)\n", n_in, n_in > 0 ? in_sizes[0] : -1, out_size, ws_size, (size_t)WS_END); grid = -1; return; }
        int dev = 0, cus = 0, per_cu = 0;
        if (hipGetDevice(&dev) != hipSuccess || hipDeviceGetAttribute(&cus, hipDeviceAttributeMultiprocessorCount, dev) != hipSuccess) { grid = -1; return; }
        if (hipFuncSetAttribute((const void*)mk_fwd, hipFuncAttributeMaxDynamicSharedMemorySize, LDS_BYTES) != hipSuccess) { fprintf(stderr, "kernel_launch: hipFuncSetAttribute failed\n"); grid = -1; return; }
        if (hipOccupancyMaxActiveBlocksPerMultiprocessor(&per_cu, (const void*)mk_fwd, NWAVES * 64, LDS_BYTES) != hipSuccess || per_cu < 1)
            fprintf(stderr, "kernel_launch: occupancy query reports %d workgroups per CU\n", per_cu);
        (void)hipGetLastError();
        grid = cus;
    }
    if (grid < 0) return;
    if (hipMemsetAsync((char*)d_ws + WS_CTL, 0, CTL_ZERO_BYTES, stream) != hipSuccess) { fprintf(stderr, "kernel_launch: memset failed\n"); return; }
    Args a{};
    for (int i = 0; i < 17; ++i) a.in[i] = (const float*)d_in[i];
    a.out = (float*)d_out; a.ws = (unsigned char*)d_ws; a.pad = 0;
#if MK_SPLIT
    for (int p = 0; p < N_PHASES; ++p) { a.ph_lo = p; a.ph_hi = p + 1; a.li = p; hipLaunchKernelGGL(mk_fwd, dim3(grid), dim3(NWAVES * 64), LDS_BYTES, stream, a); }
#else
    a.ph_lo = 0; a.ph_hi = N_PHASES; a.li = 0;
    hipLaunchKernelGGL(mk_fwd, dim3(grid), dim3(NWAVES * 64), LDS_BYTES, stream, a);
#endif
    const hipError_t le = hipPeekAtLastError();
    if (le != hipSuccess) fprintf(stderr, "kernel_launch: launch failed: %s\n", hipGetErrorName(le));
}
```

```cpp
#include <hip/hip_runtime.h>
#include <hip/hip_bf16.h>
#include <cstdio>
#include <cstdint>

constexpr int BATCH = 16, SEQ = 4096, D = 1024, M = BATCH * SEQ, DEPTH = 4, NH = 8, NE = 32, TOPK = 4;
constexpr float LN_EPS = 1e-5f;
constexpr float ALPHA = 1.6817928305074290f;
constexpr float LOG2E = 1.4426950408889634f;
constexpr float QSCALE = 0.125f * LOG2E;
constexpr int LCAP = 65536;
constexpr int MAXRT = 1056;

constexpr size_t MiB = 1ull << 20;
constexpr size_t WS_CTL = 0, CTL_ZERO_BYTES = 1 * MiB;
constexpr size_t WS_WAI = 1 * MiB;
constexpr size_t WS_WAO = WS_WAI + 12 * MiB;
constexpr size_t WS_WCI = WS_WAO + 4 * MiB;
constexpr size_t WS_WCO = WS_WCI + 12 * MiB;
constexpr size_t WS_WR  = WS_WCO + 4 * MiB;
constexpr size_t WS_W1  = WS_WR + 1 * MiB;
constexpr size_t WS_W2  = WS_W1 + 256 * MiB;
constexpr size_t WS_S1  = WS_W2 + 128 * MiB;
constexpr size_t WS_S2  = WS_S1 + 1 * MiB;
constexpr size_t WS_SD  = WS_S2 + 512 * 1024;
constexpr size_t WS_RS  = WS_SD + 64 * 1024;
constexpr size_t WS_XB  = WS_S2 + 1 * MiB;
constexpr size_t WS_XI  = WS_XB + 128 * MiB;
constexpr size_t WS_X8  = WS_XI + 128 * MiB;
constexpr size_t WS_YP  = WS_X8 + 64 * MiB;
constexpr size_t WS_Q   = WS_YP + 128 * MiB;
constexpr size_t WS_K   = WS_Q + 128 * MiB;
constexpr size_t WS_V   = WS_K + 128 * MiB;
constexpr size_t WS_O   = WS_V + 128 * MiB;
constexpr size_t WS_LS  = WS_O + 128 * MiB;
constexpr size_t WS_LG  = WS_LS + 8 * MiB;
constexpr size_t WS_A2  = WS_LG + 8 * MiB;
constexpr size_t WS_Y   = WS_A2 + 264 * MiB;
constexpr size_t WS_WA16 = WS_Y + 513 * MiB;
constexpr size_t WS_WC16 = WS_WA16 + 12 * MiB;
constexpr size_t WS_WAO8 = WS_WC16 + 12 * MiB;
constexpr size_t WS_WCO8 = WS_WAO8 + 2 * MiB;
constexpr size_t WS_END = WS_WCO8 + 2 * MiB;
#ifndef F8_QKV_MASK
#define F8_QKV_MASK 3
#endif
#ifndef F8_CONV_MASK
#define F8_CONV_MASK 3
#endif
#ifndef F8_AOUT_MASK
#define F8_AOUT_MASK 3
#endif
#ifndef F8_COUT_MASK
#define F8_COUT_MASK 3
#endif
constexpr int QM = F8_QKV_MASK, CM = F8_CONV_MASK, AOM = F8_AOUT_MASK, COM = F8_COUT_MASK;
constexpr int NA8 = (AOM & 1) + (AOM >> 1), NO8 = (COM & 1) + (COM >> 1), AJ0 = (AOM & 1) ? 0 : 1, OJ0 = (COM & 1) ? 0 : 1;
constexpr int NA16 = 2 - NA8, NO16 = 2 - NO8, AK0 = (AOM & 1) ? 1 : 0, OK0 = (COM & 1) ? 1 : 0;
constexpr int NQ8 = (QM & 1) + (QM >> 1), NC8 = (CM & 1) + (CM >> 1), QJ0 = (QM & 1) ? 0 : 1, CJ0 = (CM & 1) ? 0 : 1;
constexpr int NQ16 = 2 - NQ8, NC16 = 2 - NC8, QK0 = (QM & 1) ? 1 : 0, CK0 = (CM & 1) ? 1 : 0;
constexpr float F8MAX = 448.0f * 0.999f;
constexpr bool I8P = true;
constexpr float QMAXP = I8P ? 127.0f : 448.0f * 0.999f;
constexpr float YSCALE = 16.0f;
constexpr float A2SCALE = 8.0f;
constexpr int CW_TMO = 0, CW_CODE = 1;
constexpr int CW_BAR = 4096;
constexpr int CW_CNT = 16384;

constexpr int RING_OFF = 0, RING_BYTES = 131072;
constexpr int LDSCTL_OFF = RING_BYTES, MISC_OFF = LDSCTL_OFF + 1024;
constexpr int XL_OFF = LDSCTL_OFF + 4096;
constexpr int LDS_BYTES = 147456;

#define GAS __attribute__((address_space(1)))
#define LAS __attribute__((address_space(3)))
typedef unsigned short bf16_t;
typedef unsigned v4u __attribute__((ext_vector_type(4)));
typedef float f32x4 __attribute__((ext_vector_type(4)));
typedef float f32x2 __attribute__((ext_vector_type(2)));
typedef short bf16x8 __attribute__((ext_vector_type(8)));
typedef float f32x16 __attribute__((ext_vector_type(16)));
typedef short s16x4 __attribute__((ext_vector_type(4)));
typedef GAS unsigned gu32;
#define RLX_AGENT __ATOMIC_RELAXED, __HIP_MEMORY_SCOPE_AGENT
#define LDS_WAIT() asm volatile("s_waitcnt lgkmcnt(0)" ::: "memory")
#define VM_WAIT() asm volatile("s_waitcnt vmcnt(0)" ::: "memory")

__device__ __forceinline__ unsigned cvt_pk_bf16(float lo, float hi) { unsigned r; asm volatile("v_cvt_pk_bf16_f32 %0, %1, %2" : "=v"(r) : "v"(lo), "v"(hi)); return r; }
__device__ __forceinline__ float bf_lo(unsigned u) { return __uint_as_float(u << 16); }
__device__ __forceinline__ float bf_hi(unsigned u) { return __uint_as_float(u & 0xffff0000u); }
__device__ __forceinline__ int lane_local() { int l; asm volatile("v_mbcnt_lo_u32_b32 %0, -1, 0\n\tv_mbcnt_hi_u32_b32 %0, -1, %0" : "=v"(l)); return l; }
__device__ __forceinline__ float shx(float v, int m, int l) { return __int_as_float(__builtin_amdgcn_ds_bpermute((l ^ m) << 2, __float_as_int(v))); }
__device__ __forceinline__ float shx(float v, int m) { return shx(v, m, lane_local()); }
__device__ __forceinline__ float wave_sum(float v) {
    const int l_ = lane_local();
#pragma unroll
    for (int o = 1; o < 64; o <<= 1) v += shx(v, o, l_);
    return v;
}

#ifndef KREP_MOE
#define KREP_MOE 1
#endif
namespace pg8 {
constexpr float KREP_MOE_ = (float)KREP_MOE;
#define PG8_LAS __attribute__((address_space(3)))
constexpr int BM = 256, BK = 64, HALF = 128, HTB = HALF * BK * 2, STAGE_BYTES = 8 * HTB, NXCD = 8, WGM = 8, KD = 1024, NTK = KD / BK;

__host__ __device__ __forceinline__ int lds_byte(int r, int c) { const int st = (r >> 4) * 2 + (c >> 5), rr = r & 15, cc = c & 31, ob = rr * 64 + cc * 2; return st * 1024 + (ob ^ (((ob >> 9) & 1) << 5)); }
__host__ __device__ __forceinline__ void stage_rc(int b, int& R, int& C) { const int st = b / 1024, sb = b % 1024, swz = sb ^ (((sb >> 9) & 1) << 5); R = (st >> 1) * 16 + swz / 64; C = (st & 1) * 32 + (swz % 64) / 2; }
__host__ __device__ __forceinline__ int perm32(int rho) { const int n = rho >> 4, i = rho & 15; return 8 * (i >> 2) + 4 * n + (i & 3); }

struct Unit { int pm, pn, e, valid, lr0; };
__device__ __forceinline__ void dma1k(const void* src, PG8_LAS unsigned char* dst, int lane) {
    __builtin_amdgcn_global_load_lds((const __attribute__((address_space(1))) unsigned*)((const char*)src + lane * 16), (PG8_LAS unsigned*)dst, 16, 0, 0);
}
constexpr int XL_EPI = 4096, XL_GATHER = 1024, XL_BYTES = 2 * (XL_EPI + XL_GATHER);

template <bool F8> struct DenseProbT {
    static constexpr bool GATHER = false;
    static constexpr int RP = F8 ? 1024 : 2048;
    const char* A; const char* Bt; int nM, nN, nwg, G, c, tid;
    __device__ void init(const void* A_, const void* Bt_, int Mrows, int N, int G_, int c_, int tid_) { A = (const char*)A_; Bt = (const char*)Bt_; nM = Mrows / BM; nN = N / BM; nwg = nM * nN; G = G_; c = c_; tid = tid_; }
    __device__ __forceinline__ bool next(int i, Unit& u) const {
        const long L = (long)i * G + c; if (L >= nwg) return false;
        int wgid = (int)L; { const int q = nwg / NXCD, r = nwg % NXCD, xcd = wgid % NXCD, off = wgid / NXCD; wgid = (xcd < r ? xcd * (q + 1) : r * (q + 1) + (xcd - r) * q) + off; }
        const int nig = WGM * nN, gid = wgid / nig, fm = gid * WGM, gsz = (nM - fm) < WGM ? (nM - fm) : WGM;
        u.pm = fm + ((wgid % nig) % gsz); u.pn = (wgid % nig) / gsz; u.e = 0; u.valid = 256; u.lr0 = 0; return true;
    }
    __device__ __forceinline__ void a_off(const Unit& u, const int (&RA)[2], const int (&CA)[2], unsigned (&vo)[2][2]) const {
#pragma unroll
        for (int h = 0; h < 2; ++h)
#pragma unroll
            for (int i = 0; i < 2; ++i) vo[h][i] = (unsigned)((u.pm * BM + h * HALF + RA[i]) * RP + CA[i] * 2);
    }
    __device__ __forceinline__ unsigned a_tile(const Unit& u) const { return (unsigned)u.pm * (unsigned)(BM * RP); }
    __device__ __forceinline__ unsigned b_off(const Unit& u) const { return (unsigned)u.pn * (unsigned)(BM * RP); }    __device__ __forceinline__ void dma_rows(const Unit&, PG8_LAS unsigned char*, int, int) const {}
    __device__ __forceinline__ void a_off_lds(const Unit&, const int (&)[2], const int (&)[2], const PG8_LAS unsigned char*, unsigned (&)[2][2]) const {}
};
typedef DenseProbT<false> DenseProb;

template <bool GATHER_, bool F8> struct MoeProb {
    static constexpr bool GATHER = GATHER_;
    static constexpr int RP = F8 ? 1024 : 2048;
    const char* A; const char* Bt; size_t b_estride; int nN, G, v, RT; const PG8_LAS int* tb; const PG8_LAS int* cn; const int* lslot; int lane, tid;
    __device__ __forceinline__ bool next(int i, Unit& u) const {
        const int L = i * G + v; if (L >= RT * nN) return false;
        const int rt = L / nN; u.pm = rt; u.pn = L - rt * nN;
        const unsigned long long bal = __ballot(lane < 32 && rt >= tb[(lane & 31) + 1]);
        const int e = __builtin_amdgcn_readfirstlane(__popcll(bal)); u.e = e;
        const int tb_e = __builtin_amdgcn_readfirstlane(tb[e]), cn_e = __builtin_amdgcn_readfirstlane(cn[e]);
        u.lr0 = 256 * (rt - tb_e); const int rem = cn_e - u.lr0; u.valid = rem < 256 ? rem : 256; return true;
    }
    __device__ __forceinline__ void a_off(const Unit& u, const int (&RA)[2], const int (&CA)[2], unsigned (&vo)[2][2]) const {
        if constexpr (GATHER) {
            const int* ls = lslot + (size_t)u.e * LCAP + u.lr0;
#pragma unroll
            for (int h = 0; h < 2; ++h)
#pragma unroll
                for (int i = 0; i < 2; ++i) { const int rl = h * HALF + RA[i]; const int slot = ls[rl < u.valid ? rl : 0]; vo[h][i] = (unsigned)((slot >> 2) * RP + CA[i] * 2); }
        } else {
#pragma unroll
            for (int h = 0; h < 2; ++h)
#pragma unroll
                for (int i = 0; i < 2; ++i) vo[h][i] = (unsigned)((u.pm * BM + h * HALF + RA[i]) * RP + CA[i] * 2);
        }
    }
    __device__ __forceinline__ unsigned a_tile(const Unit& u) const { return (unsigned)u.pm * (unsigned)(BM * RP); }
    __device__ __forceinline__ unsigned b_off(const Unit& u) const { return (unsigned)u.e * (unsigned)b_estride + (unsigned)u.pn * (unsigned)(BM * RP); }
    __device__ __forceinline__ void dma_rows(const Unit& u, PG8_LAS unsigned char* dst, int wid, int lane_) const { if constexpr (GATHER) { if (wid == 0) dma1k(lslot + (size_t)u.e * LCAP + u.lr0, dst, lane_); } }
    __device__ __forceinline__ void a_off_lds(const Unit& u, const int (&RA)[2], const int (&CA)[2], const PG8_LAS unsigned char* src, unsigned (&vo)[2][2]) const {
        if constexpr (GATHER) { const PG8_LAS int* ls = (const PG8_LAS int*)src;
#pragma unroll
            for (int h = 0; h < 2; ++h)
#pragma unroll
                for (int i = 0; i < 2; ++i) { const int rl = h * HALF + RA[i]; const int slot = ls[rl < u.valid ? rl : 0]; vo[h][i] = (unsigned)((slot >> 2) * RP + CA[i] * 2); } }
    }
};

__device__ __forceinline__ v4u pack8(const f32x4 v0, const f32x4 v1) { v4u w; w.x = cvt_pk_bf16(v0[0], v0[1]); w.y = cvt_pk_bf16(v0[2], v0[3]); w.z = cvt_pk_bf16(v1[0], v1[1]); w.w = cvt_pk_bf16(v1[2], v1[3]); return w; }

__device__ __forceinline__ void st16(void* base, unsigned off, v4u v) { *(v4u*)((char*)base + off) = v; }
struct EpiQKV {
    __device__ __forceinline__ void dma(const Unit&, PG8_LAS unsigned char*, int, int) const {}
    bf16_t* O; size_t stride; float scale0;
    __device__ __forceinline__ void operator()(const f32x4 (&acc)[2][2][4][2], const Unit& u, int wr, int wc, int fr_, int fq_, const PG8_LAS unsigned char* xl) const {
        int fr = fr_, fq = fq_; asm volatile("" : "+v"(fr), "+v"(fq));
        const int row0 = u.pm * BM + wr * 64 + fr; const int t = u.pn >> 2; const int colt = (u.pn & 3) * BM;
        bf16_t* base = O + (size_t)t * stride; const float sc = (t == 0) ? scale0 : 1.f; const unsigned off0 = (unsigned)(row0 * D + colt + wc * 32 + 8 * fq) * 2u;
#pragma unroll
        for (int ai = 0; ai < 2; ++ai)
#pragma unroll
            for (int m = 0; m < 4; ++m)
#pragma unroll
                for (int bj = 0; bj < 2; ++bj) st16(base, off0 + (unsigned)((ai * HALF + m * 16) * D + bj * HALF) * 2u, pack8(acc[ai][bj][m][0] * sc, acc[ai][bj][m][1] * sc));
    }
};
struct EpiConvIn {
    __device__ __forceinline__ void dma(const Unit&, PG8_LAS unsigned char*, int, int) const {}
    bf16_t* GB; bf16_t* Z;
    __device__ __forceinline__ void operator()(const f32x4 (&acc)[2][2][4][2], const Unit& u, int wr, int wc, int fr_, int fq_, const PG8_LAS unsigned char* xl) const {
        int fr = fr_, fq = fq_; asm volatile("" : "+v"(fr), "+v"(fq));
        const int row0 = u.pm * BM + wr * 64 + fr;
        if (u.pn < 4) { const unsigned off0 = (unsigned)(row0 * D + u.pn * BM + wc * 32 + 8 * fq) * 2u;
#pragma unroll
            for (int ai = 0; ai < 2; ++ai)
#pragma unroll
                for (int m = 0; m < 4; ++m)
#pragma unroll
                    for (int bj = 0; bj < 2; ++bj) st16(GB, off0 + (unsigned)((ai * HALF + m * 16) * D + bj * HALF) * 2u, pack8(acc[ai][bj][m][0], acc[ai][bj][m][1]));
        } else { const unsigned off0 = (unsigned)(row0 * D + (u.pn - 4) * HALF + wc * 32 + 8 * fq) * 2u;
#pragma unroll
            for (int ai = 0; ai < 2; ++ai)
#pragma unroll
                for (int m = 0; m < 4; ++m) st16(Z, off0 + (unsigned)((ai * HALF + m * 16) * D) * 2u, pack8(acc[ai][0][m][0] * acc[ai][1][m][0], acc[ai][0][m][1] * acc[ai][1][m][1]));
        }
    }
};
struct EpiQKV8 {
    bf16_t* O; size_t stride; float scale0; const float* sw; const float* rs;
    __device__ __forceinline__ void dma(const Unit& u, PG8_LAS unsigned char* xl, int wid, int lane) const {
        if (wid == 0) dma1k(sw + u.pn * BM, xl, lane); else if (wid == 1) dma1k(rs + u.pm * BM, xl + 1024, lane);
    }
    __device__ __forceinline__ void operator()(const f32x4 (&acc)[2][2][4][2], const Unit& u, int wr, int wc, int fr_, int fq_, const PG8_LAS unsigned char* xl) const {
        int fr = fr_, fq = fq_; asm volatile("" : "+v"(fr), "+v"(fq));
        const int row0 = u.pm * BM + wr * 64 + fr; const int t = u.pn >> 2; const int colt = (u.pn & 3) * BM; const int cl = wc * 32 + 8 * fq;
        bf16_t* base = O + (size_t)t * stride; const float sc = (t == 0) ? scale0 : 1.f; const unsigned off0 = (unsigned)(row0 * D + colt + cl) * 2u;
        const PG8_LAS float* sp = (const PG8_LAS float*)xl + cl; const PG8_LAS float* rp = (const PG8_LAS float*)(xl + 1024) + wr * 64 + fr;
        f32x4 sv[2][2];
#pragma unroll
        for (int bj = 0; bj < 2; ++bj)
#pragma unroll
            for (int n = 0; n < 2; ++n) sv[bj][n] = *(const PG8_LAS f32x4*)(sp + bj * HALF + 4 * n) * sc;
#pragma unroll
        for (int ai = 0; ai < 2; ++ai)
#pragma unroll
            for (int m = 0; m < 4; ++m) { const float r = rp[ai * HALF + m * 16];
#pragma unroll
                for (int bj = 0; bj < 2; ++bj) st16(base, off0 + (unsigned)((ai * HALF + m * 16) * D + bj * HALF) * 2u, pack8(acc[ai][bj][m][0] * (sv[bj][0] * r), acc[ai][bj][m][1] * (sv[bj][1] * r))); }
    }
};
struct EpiConvIn8 {
    bf16_t* GB; bf16_t* Z; const float* sw; const float* rs;
    __device__ __forceinline__ void dma(const Unit& u, PG8_LAS unsigned char* xl, int wid, int lane) const { if (wid == 0) dma1k(sw + u.pn * BM, xl, lane); else if (wid == 1) dma1k(rs + u.pm * BM, xl + 1024, lane); }
    __device__ __forceinline__ void operator()(const f32x4 (&acc)[2][2][4][2], const Unit& u, int wr, int wc, int fr_, int fq_, const PG8_LAS unsigned char* xl) const {
        int fr = fr_, fq = fq_; asm volatile("" : "+v"(fr), "+v"(fq));
        const int row0 = u.pm * BM + wr * 64 + fr; const int cl = wc * 32 + 8 * fq;
        const PG8_LAS float* sp = (const PG8_LAS float*)xl + cl; const PG8_LAS float* rp = (const PG8_LAS float*)(xl + 1024) + wr * 64 + fr;
        f32x4 sv[2][2];
#pragma unroll
        for (int bj = 0; bj < 2; ++bj)
#pragma unroll
            for (int n = 0; n < 2; ++n) sv[bj][n] = *(const PG8_LAS f32x4*)(sp + bj * HALF + 4 * n);
        if (u.pn < 4) { const unsigned off0 = (unsigned)(row0 * D + u.pn * BM + cl) * 2u;
#pragma unroll
            for (int ai = 0; ai < 2; ++ai)
#pragma unroll
                for (int m = 0; m < 4; ++m) { const float r = rp[ai * HALF + m * 16];
#pragma unroll
                    for (int bj = 0; bj < 2; ++bj) st16(GB, off0 + (unsigned)((ai * HALF + m * 16) * D + bj * HALF) * 2u, pack8(acc[ai][bj][m][0] * (sv[bj][0] * r), acc[ai][bj][m][1] * (sv[bj][1] * r))); }
        } else { const unsigned off0 = (unsigned)(row0 * D + (u.pn - 4) * HALF + cl) * 2u;
            const f32x4 sz0 = sv[0][0] * sv[1][0], sz1 = sv[0][1] * sv[1][1];
#pragma unroll
            for (int ai = 0; ai < 2; ++ai)
#pragma unroll
                for (int m = 0; m < 4; ++m) { const float r = rp[ai * HALF + m * 16], r2 = r * r;
                    st16(Z, off0 + (unsigned)((ai * HALF + m * 16) * D) * 2u, pack8(acc[ai][0][m][0] * acc[ai][1][m][0] * (sz0 * r2), acc[ai][0][m][1] * acc[ai][1][m][1] * (sz1 * r2))); }
        }
    }
};
struct EpiResid {
    __device__ __forceinline__ void dma(const Unit&, PG8_LAS unsigned char*, int, int) const {}
    const bf16_t* X; bf16_t* Yp;
    __device__ __forceinline__ void operator()(const f32x4 (&acc)[2][2][4][2], const Unit& u, int wr, int wc, int fr_, int fq_, const PG8_LAS unsigned char* xl) const {
        int fr = fr_, fq = fq_; asm volatile("" : "+v"(fr), "+v"(fq));
        const unsigned off0 = (unsigned)((u.pm * BM + wr * 64 + fr) * D + u.pn * BM + wc * 32 + 8 * fq) * 2u;
#pragma unroll
        for (int ai = 0; ai < 2; ++ai)
#pragma unroll
            for (int m = 0; m < 4; ++m)
#pragma unroll
                for (int bj = 0; bj < 2; ++bj) { const unsigned off = off0 + (unsigned)((ai * HALF + m * 16) * D + bj * HALF) * 2u; const v4u xr = *(const v4u*)((const char*)X + off);
                    f32x4 v0 = acc[ai][bj][m][0], v1 = acc[ai][bj][m][1];
                    v0[0] += ALPHA * bf_lo(xr.x); v0[1] += ALPHA * bf_hi(xr.x); v0[2] += ALPHA * bf_lo(xr.y); v0[3] += ALPHA * bf_hi(xr.y);
                    v1[0] += ALPHA * bf_lo(xr.z); v1[1] += ALPHA * bf_hi(xr.z); v1[2] += ALPHA * bf_lo(xr.w); v1[3] += ALPHA * bf_hi(xr.w);
                    st16(Yp, off, pack8(v0, v1)); }
    }
};
template <bool ROWS> struct EpiResid8 {
    const bf16_t* X; bf16_t* Yp; const float* sw; const float* rs; float rsc;
    __device__ __forceinline__ void dma(const Unit& u, PG8_LAS unsigned char* xl, int wid, int lane) const {
        if (wid == 0) dma1k(sw + u.pn * BM, xl, lane); else if (ROWS && wid == 1) dma1k(rs + u.pm * BM, xl + 1024, lane);
    }
    __device__ __forceinline__ void operator()(const f32x4 (&acc)[2][2][4][2], const Unit& u, int wr, int wc, int fr_, int fq_, const PG8_LAS unsigned char* xl) const {
        int fr = fr_, fq = fq_; asm volatile("" : "+v"(fr), "+v"(fq));
        const int cl = wc * 32 + 8 * fq;
        const unsigned off0 = (unsigned)((u.pm * BM + wr * 64 + fr) * D + u.pn * BM + cl) * 2u;
        const PG8_LAS float* sp = (const PG8_LAS float*)xl + cl; const PG8_LAS float* rp = (const PG8_LAS float*)(xl + 1024) + wr * 64 + fr;
        f32x4 sv[2][2];
#pragma unroll
        for (int bj = 0; bj < 2; ++bj)
#pragma unroll
            for (int n = 0; n < 2; ++n) sv[bj][n] = *(const PG8_LAS f32x4*)(sp + bj * HALF + 4 * n) * (ROWS ? 1.0f : rsc);
#pragma unroll
        for (int ai = 0; ai < 2; ++ai)
#pragma unroll
            for (int m = 0; m < 4; ++m) { float r = 1.0f; if (ROWS) r = rp[ai * HALF + m * 16];
#pragma unroll
                for (int bj = 0; bj < 2; ++bj) { const unsigned off = off0 + (unsigned)((ai * HALF + m * 16) * D + bj * HALF) * 2u; const v4u xr = *(const v4u*)((const char*)X + off);
                    f32x4 v0 = acc[ai][bj][m][0] * sv[bj][0], v1 = acc[ai][bj][m][1] * sv[bj][1]; if (ROWS) { v0 *= r; v1 *= r; }
                    v0[0] += ALPHA * bf_lo(xr.x); v0[1] += ALPHA * bf_hi(xr.x); v0[2] += ALPHA * bf_lo(xr.y); v0[3] += ALPHA * bf_hi(xr.y);
                    v1[0] += ALPHA * bf_lo(xr.z); v1[1] += ALPHA * bf_hi(xr.z); v1[2] += ALPHA * bf_lo(xr.w); v1[3] += ALPHA * bf_hi(xr.w);
                    st16(Yp, off, pack8(v0, v1)); } }
    }
};
__device__ __forceinline__ unsigned pk4_fp8(float a, float b, float c, float d) { int p = 0; p = __builtin_amdgcn_cvt_pk_fp8_f32(a, b, p, false); p = __builtin_amdgcn_cvt_pk_fp8_f32(c, d, p, true); return (unsigned)p; }
__device__ __forceinline__ unsigned pk4_i8(float a, float b, float c, float d) {
    unsigned r = 0;
    r = __builtin_amdgcn_cvt_pk_u8_f32(__builtin_rintf(a + 128.f), 0, r); r = __builtin_amdgcn_cvt_pk_u8_f32(__builtin_rintf(b + 128.f), 1, r);
    r = __builtin_amdgcn_cvt_pk_u8_f32(__builtin_rintf(c + 128.f), 2, r); r = __builtin_amdgcn_cvt_pk_u8_f32(__builtin_rintf(d + 128.f), 3, r);
    return r ^ 0x80808080u;
}
template <bool I8> __device__ __forceinline__ unsigned pkq4(float a, float b, float c, float d) { if constexpr (I8) return pk4_i8(a, b, c, d); else return pk4_fp8(a, b, c, d); }
__device__ __forceinline__ f32x2 swiglu8_pk(f32x2 g, f32x2 l8) {
    g.x = fminf(g.x, 7.0f); g.y = fminf(g.y, 7.0f);
    l8.x = fminf(fmaxf(l8.x, -56.0f), 56.0f); l8.y = fminf(fmaxf(l8.y, -56.0f), 56.0f);
    const f32x2 t = g * (-1.702f * LOG2E);
    f32x2 e; e.x = __builtin_amdgcn_exp2f(t.x); e.y = __builtin_amdgcn_exp2f(t.y);
    const f32x2 d = e + 1.0f;
    f32x2 r; r.x = __builtin_amdgcn_rcpf(d.x); r.y = __builtin_amdgcn_rcpf(d.y);
    return (g * r) * (l8 + A2SCALE);
}
struct EpiMoe1 {
    unsigned char* A2; const float* b1; const float* sw; float inv_sa;
    __device__ __forceinline__ void dma(const Unit& u, PG8_LAS unsigned char* xl, int wid, int lane) const {
        if (wid == 0) dma1k(b1 + (size_t)u.e * 2048 + u.pn * BM, xl, lane); else if (wid == 1) dma1k(sw + (size_t)u.e * 2048 + u.pn * BM, xl + 1024, lane);
    }
    __device__ __forceinline__ void operator()(const f32x4 (&acc)[2][2][4][2], const Unit& u, int wr, int wc, int fr_, int fq_, const PG8_LAS unsigned char* xl) const {
        int fr = fr_, fq = fq_; asm volatile("" : "+v"(fr), "+v"(fq));
        const int cl = wc * 32 + 8 * fq; const unsigned off0 = (unsigned)((u.pm * BM + wr * 64 + fr) * D + u.pn * HALF + cl);
        const PG8_LAS float* bp = (const PG8_LAS float*)xl + 2 * cl; f32x4 bb[4];
#pragma unroll
        for (int j = 0; j < 4; ++j) bb[j] = *(const PG8_LAS f32x4*)(bp + 4 * j);
        const PG8_LAS float* sp = (const PG8_LAS float*)(xl + 1024) + cl;
        const f32x4 sg0 = *(const PG8_LAS f32x4*)(sp) * inv_sa, sg1 = *(const PG8_LAS f32x4*)(sp + 4) * inv_sa;
        const f32x4 sl0 = *(const PG8_LAS f32x4*)(sp + HALF) * (inv_sa * A2SCALE), sl1 = *(const PG8_LAS f32x4*)(sp + HALF + 4) * (inv_sa * A2SCALE);
        f32x2 sgp[4] = {{sg0[0], sg0[1]}, {sg0[2], sg0[3]}, {sg1[0], sg1[1]}, {sg1[2], sg1[3]}}, slp[4] = {{sl0[0], sl0[1]}, {sl0[2], sl0[3]}, {sl1[0], sl1[1]}, {sl1[2], sl1[3]}};
        f32x2 bgp[4], blp[4];
#pragma unroll
        for (int q = 0; q < 4; ++q) { bgp[q] = (f32x2){bb[q][0], bb[q][2]}; blp[q] = (f32x2){bb[q][1] * A2SCALE, bb[q][3] * A2SCALE}; }
        const unsigned offp = off0 + ((fq & 1) ? (unsigned)(16 * D - 8) : 0u);
#pragma unroll
        for (int ai = 0; ai < 2; ++ai)
#pragma unroll
            for (int mp = 0; mp < 2; ++mp) { typedef unsigned u32x2 __attribute__((ext_vector_type(2))); u32x2 w[2];
#pragma unroll
                for (int mm = 0; mm < 2; ++mm) { const int m = 2 * mp + mm; f32x2 o[4];
#pragma unroll
                    for (int q = 0; q < 4; ++q) { const f32x4 ga = acc[ai][0][m][q >> 1], la = acc[ai][1][m][q >> 1]; const int h2 = (q & 1) * 2;
                        const f32x2 g = (f32x2){ga[h2], ga[h2 + 1]} * sgp[q] + bgp[q], l8 = (f32x2){la[h2], la[h2 + 1]} * slp[q] + blp[q];
                        o[q] = swiglu8_pk(g, l8); }
                    w[mm].x = pk4_fp8(o[0].x, o[0].y, o[1].x, o[1].y); w[mm].y = pk4_fp8(o[2].x, o[2].y, o[3].x, o[3].y); }
                const auto sx = __builtin_amdgcn_permlane16_swap(w[0].x, w[1].x, false, false); const auto sy = __builtin_amdgcn_permlane16_swap(w[0].y, w[1].y, false, false);
                const v4u ov = {sx[0], sy[0], sx[1], sy[1]};
                *(v4u*)(A2 + (offp + (unsigned)((ai * HALF + mp * 32) * D))) = ov; }
    }
};
struct EpiMoe2 {
    unsigned char* Y; const float* b2; const float* sw; const int* lslot; const float* lgate;
    __device__ __forceinline__ void dma(const Unit& u, PG8_LAS unsigned char* xl, int wid, int lane) const {
        const size_t lb = (size_t)u.e * LCAP + u.lr0;
        if (wid == 0) dma1k(b2 + (size_t)u.e * 1024 + u.pn * BM, xl, lane); else if (wid == 1) dma1k(sw + (size_t)u.e * 1024 + u.pn * BM, xl + 1024, lane);
        else if (wid == 2) dma1k(lslot + lb, xl + 2048, lane); else if (wid == 3) dma1k(lgate + lb, xl + 3072, lane);
    }
    __device__ __forceinline__ void operator()(const f32x4 (&acc)[2][2][4][2], const Unit& u, int wr, int wc, int fr_, int fq_, const PG8_LAS unsigned char* xl) const {
        int fr = fr_, fq = fq_; asm volatile("" : "+v"(fr), "+v"(fq));
        const int rl0 = wr * 64 + fr, cl = wc * 32 + 8 * fq, col0 = u.pn * BM + cl;
        const PG8_LAS float* bp = (const PG8_LAS float*)xl + cl; const PG8_LAS float* sp = (const PG8_LAS float*)(xl + 1024) + cl; f32x4 bv[2][2], sv[2][2];
#pragma unroll
        for (int bj = 0; bj < 2; ++bj)
#pragma unroll
            for (int n = 0; n < 2; ++n) { bv[bj][n] = *(const PG8_LAS f32x4*)(bp + bj * HALF + 4 * n); sv[bj][n] = *(const PG8_LAS f32x4*)(sp + bj * HALF + 4 * n) * (1.0f / (A2SCALE * KREP_MOE_)); }
        const PG8_LAS int* sl = (const PG8_LAS int*)(xl + 2048); const PG8_LAS float* gl = (const PG8_LAS float*)(xl + 3072);
        const unsigned cadj = (unsigned)(u.pn * BM + ((fq & 1) ? (HALF + cl - 8) : cl));
#pragma unroll
        for (int ai = 0; ai < 2; ++ai)
#pragma unroll
            for (int m = 0; m < 4; ++m) { const int rl = rl0 + ai * HALF + m * 16;
                const bool ok = rl < u.valid; const int slot = ok ? sl[rl] : M * 4; const float g = gl[rl] * YSCALE;
                typedef unsigned u32x2 __attribute__((ext_vector_type(2))); u32x2 w[2];
#pragma unroll
                for (int bj = 0; bj < 2; ++bj) { f32x4 v0 = (acc[ai][bj][m][0] * sv[bj][0] + bv[bj][0]) * g, v1 = (acc[ai][bj][m][1] * sv[bj][1] + bv[bj][1]) * g;
#pragma unroll
                    for (int i = 0; i < 4; ++i) { v0[i] = fminf(fmaxf(v0[i], -448.0f), 448.0f); v1[i] = fminf(fmaxf(v1[i], -448.0f), 448.0f); }
                    w[bj].x = pk4_fp8(v0[0], v0[1], v0[2], v0[3]); w[bj].y = pk4_fp8(v1[0], v1[1], v1[2], v1[3]); }
                const auto sx = __builtin_amdgcn_permlane16_swap(w[0].x, w[1].x, false, false); const auto sy = __builtin_amdgcn_permlane16_swap(w[0].y, w[1].y, false, false);
                const v4u o = {sx[0], sy[0], sx[1], sy[1]};
                *(v4u*)(Y + ((unsigned)(slot * D) + cadj)) = o; }
    }
};

typedef int v8i_t __attribute__((ext_vector_type(8))); typedef int v4i_t __attribute__((ext_vector_type(4)));
__device__ __forceinline__ v8i_t cat8(bf16x8 lo, bf16x8 hi) { const v4i_t a = __builtin_bit_cast(v4i_t, lo), b = __builtin_bit_cast(v4i_t, hi); return __builtin_shufflevector(a, b, 0, 1, 2, 3, 4, 5, 6, 7); }
template <class Prob, class Epi, bool ALIGN_EPI, bool F8 = false, int KREP = 1, bool I8 = false>
__device__ __forceinline__ void gemm_phase(PG8_LAS unsigned char* lds, PG8_LAS unsigned char* xl, const Prob& P, const Epi& E) {
    int tid_ = P.tid; asm volatile("" : "+v"(tid_));
    const int tid = tid_, wid = __builtin_amdgcn_readfirstlane(tid >> 6), lane = tid & 63, wr = wid >> 2, wc = wid & 3, fr = lane & 15, fq = lane >> 4;
    constexpr int RP = F8 ? 1024 : 2048, nt = F8 ? 8 : NTK;
    constexpr bool GA = Prob::GATHER;
    int RA[2], CA[2]; unsigned voffB[2], voffA[2];
#pragma unroll
    for (int i = 0; i < 2; ++i) { int R, C; stage_rc(tid * 16 + i * 8192, R, C); const int Rb = (R & ~31) + perm32(R & 31); RA[i] = R; CA[i] = C; voffB[i] = (unsigned)(Rb * RP + C * 2); voffA[i] = (unsigned)(R * RP + C * 2); }
    constexpr unsigned kstep = (unsigned)(BK * 2);
    constexpr unsigned hstep = (unsigned)HALF * RP;
    const unsigned ldsw = (unsigned)wid * 1024u;
    const int aoff = lds_byte(wr * 64 + fr, fq * 8), boff = lds_byte(wc * 32 + fr, fq * 8);
    typedef const __attribute__((address_space(1))) unsigned* gptr_t;
#define PG8_SA(b, h) (((b) * 2 + (h)) * HTB)
#define PG8_SB(b, h) ((4 + (b) * 2 + (h)) * HTB)
#define PG8_STAGE_B(bufoff, uoff) do { _Pragma("unroll") for (int _i = 0; _i < 2; ++_i) \
        __builtin_amdgcn_global_load_lds((gptr_t)(Bb + (voffB[_i] + (unsigned)(uoff))), (PG8_LAS unsigned*)(lds + (bufoff) + ldsw + _i * 8192), 16, 0, 0); } while (0)
#define PG8_STAGE_A(bufoff, koff, h, NX) do { _Pragma("unroll") for (int _i = 0; _i < 2; ++_i) { unsigned _o; \
        if constexpr (GA) _o = ((NX) ? vn[h][_i] : vc[h][_i]) + (unsigned)(koff); else _o = voffA[_i] + (((NX) ? nAo : cAo) + (unsigned)(h) * hstep + (unsigned)(koff)); \
        __builtin_amdgcn_global_load_lds((gptr_t)(Ab + _o), (PG8_LAS unsigned*)(lds + (bufoff) + ldsw + _i * 8192), 16, 0, 0); } } while (0)
#define PG8_LDA(dst, b, h) do { _Pragma("unroll") for (int m = 0; m < 4; ++m) _Pragma("unroll") for (int k = 0; k < 2; ++k) dst[m][k] = *(const PG8_LAS bf16x8*)(lds + PG8_SA(b, h) + aoff + m * 2048 + k * 1024); } while (0)
#define PG8_LDB(dst, b, h) do { _Pragma("unroll") for (int n = 0; n < 2; ++n) _Pragma("unroll") for (int k = 0; k < 2; ++k) dst[n][k] = *(const PG8_LAS bf16x8*)(lds + PG8_SB(b, h) + boff + n * 2048 + k * 1024); } while (0)
#define PG8_MMA(ai, bj, At, Bt) do { __builtin_amdgcn_s_setprio(1); _Pragma("unroll") for (int m = 0; m < 4; ++m) _Pragma("unroll") for (int n = 0; n < 2; ++n) _Pragma("unroll") for (int k = 0; k < 2; ++k) \
        acc[ai][bj][m][n] = __builtin_amdgcn_mfma_f32_16x16x32_bf16(Bt[n][k], At[m][k], acc[ai][bj][m][n], 0, 0, 0); __builtin_amdgcn_s_setprio(0); } while (0)
#define PG8_MMA8(ai, bj, At, Bt) do { __builtin_amdgcn_s_setprio(1); if constexpr (I8) { _Pragma("unroll") for (int k = 0; k < 2; ++k) _Pragma("unroll") for (int m = 0; m < 4; ++m) _Pragma("unroll") for (int n = 0; n < 2; ++n) \
        asm volatile("v_mfma_i32_16x16x64_i8 %0, %1, %2, %0" : "+v"(acc[ai][bj][m][n]) : "v"(Bt[n][k]), "v"(At[m][k])); } else { _Pragma("unroll") for (int m = 0; m < 4; ++m) _Pragma("unroll") for (int n = 0; n < 2; ++n) \
        asm volatile("v_mfma_f32_16x16x128_f8f6f4 %0, %1, %2, %0" : "+v"(acc[ai][bj][m][n]) : "v"(cat8(Bt[n][0], Bt[n][1])), "v"(cat8(At[m][0], At[m][1]))); } __builtin_amdgcn_s_setprio(0); } while (0)
#define PG8_MMA8Z(ai, bj, At, Bt) do { __builtin_amdgcn_s_setprio(1); if constexpr (I8) { _Pragma("unroll") for (int m = 0; m < 4; ++m) _Pragma("unroll") for (int n = 0; n < 2; ++n) \
        asm volatile("v_mfma_i32_16x16x64_i8 %0, %1, %2, 0" : "=&v"(acc[ai][bj][m][n]) : "v"(Bt[n][0]), "v"(At[m][0])); _Pragma("unroll") for (int m = 0; m < 4; ++m) _Pragma("unroll") for (int n = 0; n < 2; ++n) \
        asm volatile("v_mfma_i32_16x16x64_i8 %0, %1, %2, %0" : "+v"(acc[ai][bj][m][n]) : "v"(Bt[n][1]), "v"(At[m][1])); } else { _Pragma("unroll") for (int m = 0; m < 4; ++m) _Pragma("unroll") for (int n = 0; n < 2; ++n) \
        asm volatile("v_mfma_f32_16x16x128_f8f6f4 %0, %1, %2, 0" : "=&v"(acc[ai][bj][m][n]) : "v"(cat8(Bt[n][0], Bt[n][1])), "v"(cat8(At[m][0], At[m][1]))); } __builtin_amdgcn_s_setprio(0); } while (0)
#define PG8_MM(ai, bj, At, Bt) do { if constexpr (F8) PG8_MMA8(ai, bj, At, Bt); else PG8_MMA(ai, bj, At, Bt); } while (0)
#define PG8_MM2(FIRST, ai, At) do { if constexpr (F8) { if (FIRST) { PG8_MMA8Z(ai, 0, At, B0); PG8_MMA8Z(ai, 1, At, B1); } else { PG8_MMA8(ai, 0, At, B0); PG8_MMA8(ai, 1, At, B1); } } else { PG8_MMA(ai, 0, At, B0); PG8_MMA(ai, 1, At, B1); } } while (0)
#define PG8_WAIT_V(n) asm volatile("s_waitcnt vmcnt(" #n ")" ::: "memory")
#define PG8_WAIT_L(n) asm volatile("s_waitcnt lgkmcnt(" #n ")" ::: "memory")
#define PG8_BAR __builtin_amdgcn_s_barrier()
#define PG8_SCHED __builtin_amdgcn_sched_barrier(0)
    Unit cur, nxt; int ui = 0;
    if (!P.next(0, cur)) return;
    f32x4 acc[2][2][4][2];
    if constexpr (!F8) {
#pragma unroll
    for (int a = 0; a < 2; ++a)
#pragma unroll
        for (int b = 0; b < 2; ++b)
#pragma unroll
            for (int m = 0; m < 4; ++m)
#pragma unroll
                for (int n = 0; n < 2; ++n) acc[a][b][m][n] = (f32x4){0.f, 0.f, 0.f, 0.f};
    }
    bf16x8 At[4][2], B0[2][2], B1[2][2];
    unsigned vc[2][2], vn[2][2]; unsigned cAo = 0, nAo = 0;
    if constexpr (GA) { P.a_off(cur, RA, CA, vc); vn[0][0] = vc[0][0]; vn[0][1] = vc[0][1]; vn[1][0] = vc[1][0]; vn[1][1] = vc[1][1]; } else { cAo = P.a_tile(cur); nAo = cAo; vc[0][0] = vn[0][0] = 0; }
    const char* const Ab = P.A; const char* const Bb = P.Bt; unsigned cBo = P.b_off(cur), nBo = cBo;
    PG8_STAGE_B(PG8_SB(0, 0), cBo); PG8_STAGE_B(PG8_SB(0, 1), cBo + hstep); PG8_STAGE_A(PG8_SA(0, 0), 0u, 0, false); PG8_STAGE_A(PG8_SA(0, 1), 0u, 1, false);
    if (wr == 1) PG8_BAR;
    PG8_WAIT_V(2); PG8_BAR;
    PG8_STAGE_B(PG8_SB(1, 0), cBo + kstep); PG8_STAGE_A(PG8_SA(1, 0), kstep, 0, false); PG8_STAGE_B(PG8_SB(1, 1), cBo + hstep + kstep);
    PG8_WAIT_V(6); PG8_BAR;
    for (;;) {
        const bool has_next = P.next(ui + 1, nxt);
        PG8_LAS unsigned char* const xe = xl + (ui & 1) * XL_EPI;
        PG8_LAS unsigned char* const xg = xl + 2 * XL_EPI + ((ui + 1) & 1) * XL_GATHER;
        E.dma(cur, xe, wid, lane);
        if (has_next) { if constexpr (GA) P.dma_rows(nxt, xg, wid, lane); else nAo = P.a_tile(nxt); nBo = P.b_off(nxt); }
        else { nAo = cAo; nBo = cBo; }
#pragma unroll 1
        for (int rep = 0; rep < KREP; ++rep)
#pragma unroll 1
        for (int t = 0; t < nt; t += 2) {
            const bool lastt = (t == nt - 2); const bool last = lastt && (rep == KREP - 1); const bool first = (t == 0) && (rep == 0); (void)first;
            if constexpr (GA) { if (last) { if (has_next) P.a_off_lds(nxt, RA, CA, xg, vn); else { vn[0][0] = vc[0][0]; vn[0][1] = vc[0][1]; vn[1][0] = vc[1][0]; vn[1][1] = vc[1][1]; } } }
            const unsigned k1 = (unsigned)(t + 1) * kstep;
            const unsigned k2 = lastt ? 0u : (unsigned)(t + 2) * kstep, k3 = k2 + kstep;
            const unsigned b2 = (last ? nBo : cBo) + k2, b3 = b2 + kstep;
            PG8_LDB(B0, 0, 0); PG8_LDB(B1, 0, 1); PG8_SCHED; PG8_LDA(At, 0, 0); PG8_STAGE_A(PG8_SA(1, 1), k1, 1, false);
            PG8_WAIT_V(8); PG8_WAIT_L(0); PG8_BAR; PG8_MM2(first, 0, At); PG8_BAR; PG8_SCHED;
            PG8_LDA(At, 0, 1); PG8_STAGE_B(PG8_SB(0, 0), b2); PG8_STAGE_B(PG8_SB(0, 1), b2 + hstep); PG8_STAGE_A(PG8_SA(0, 0), k2, 0, last);
            PG8_WAIT_V(8); PG8_WAIT_L(0); PG8_BAR; PG8_MM2(first, 1, At); PG8_BAR; PG8_SCHED;
            PG8_LDB(B0, 1, 0); PG8_LDB(B1, 1, 1); PG8_SCHED; PG8_LDA(At, 1, 0); PG8_STAGE_A(PG8_SA(0, 1), k2, 1, last);
            PG8_WAIT_V(8); PG8_WAIT_L(0); PG8_BAR; PG8_MM(0, 0, At, B0); PG8_MM(0, 1, At, B1); PG8_BAR; PG8_SCHED;
            PG8_LDA(At, 1, 1); PG8_STAGE_B(PG8_SB(1, 0), b3); PG8_STAGE_B(PG8_SB(1, 1), b3 + hstep); PG8_STAGE_A(PG8_SA(1, 0), k3, 0, last);
            PG8_WAIT_V(8); PG8_WAIT_L(0); PG8_BAR; PG8_MM(1, 0, At, B0); PG8_MM(1, 1, At, B1); PG8_BAR; PG8_SCHED;
        }
        if constexpr (ALIGN_EPI) { if (wr == 0) PG8_BAR; }
        if constexpr (F8) asm volatile("s_nop 15\n\ts_nop 7" ::: "memory");
        if constexpr (I8) {
#pragma unroll
            for (int a = 0; a < 2; ++a)
#pragma unroll
                for (int b = 0; b < 2; ++b)
#pragma unroll
                    for (int m = 0; m < 4; ++m)
#pragma unroll
                        for (int n = 0; n < 2; ++n)
#pragma unroll
                            for (int i = 0; i < 4; ++i) acc[a][b][m][n][i] = (float)__float_as_int(acc[a][b][m][n][i]);
        }
        E(acc, cur, wr, wc, fr, fq, xe);
        if (!has_next) break;
        if constexpr (!F8)
#pragma unroll
        for (int a = 0; a < 2; ++a)
#pragma unroll
            for (int b = 0; b < 2; ++b)
#pragma unroll
                for (int m = 0; m < 4; ++m)
#pragma unroll
                    for (int n = 0; n < 2; ++n) acc[a][b][m][n] = (f32x4){0.f, 0.f, 0.f, 0.f};
        cur = nxt; cBo = nBo; cAo = nAo; ++ui;
        if constexpr (GA) { vc[0][0] = vn[0][0]; vc[0][1] = vn[0][1]; vc[1][0] = vn[1][0]; vc[1][1] = vn[1][1]; }
        if constexpr (ALIGN_EPI) { if (wr == 1) PG8_BAR; }
    }
    PG8_WAIT_V(0);
    if constexpr (!ALIGN_EPI) { if (wr == 0) PG8_BAR; }
    PG8_BAR;
#undef PG8_SA
#undef PG8_SB
#undef PG8_STAGE_A
#undef PG8_STAGE_B
#undef PG8_LDA
#undef PG8_LDB
#undef PG8_MMA
#undef PG8_MMA8
#undef PG8_MM
#undef PG8_MM2
#undef PG8_MMA8Z
#undef PG8_WAIT_V
#undef PG8_WAIT_L
#undef PG8_BAR
#undef PG8_SCHED
}
}

namespace att {
constexpr int QBLK = 32, KVBLK = 64, LDX = 1024, NT = SEQ / KVBLK;
constexpr int SHM_V = KVBLK * 128 * 2, SHM_K = KVBLK * 128 * 2, NSLOT = 3;
constexpr int OFF_V = 0, OFF_K = NSLOT * SHM_V, OFF_WS = NSLOT * (SHM_V + SHM_K), OFF_TBL = OFF_WS + 8 * 64 * 4, ATT_LDS = OFF_TBL + 2048;
constexpr float THR2 = 8.0f * LOG2E;
#define KSWZ(row, colB) ((row) * 256 + ((colB) ^ (((row) & 7) << 4)))
#define SBAR() __builtin_amdgcn_sched_barrier(0)
__device__ __forceinline__ int crow(int r, int hi) { return (r & 3) + 8 * (r >> 2) + 4 * hi; }
__device__ __forceinline__ int v_st(int k, int c) { const int kk = (k & ~0xC) | ((k & 4) << 1) | ((k & 8) >> 1); return ((kk >> 3) * 4 + (c >> 5)) * 512 + ((kk & 7) * 32 + (c & 31)) * 2; }
__device__ __forceinline__ int v_rd_base(int lane) { return ((lane & 3) << 3) | (((lane >> 2) & 3) << 6) | (((lane >> 4) & 1) << 5) | (((lane >> 5) & 1) << 8); }
constexpr int v_rd_off(int d0, int ks, int half) { return d0 * 512 + ks * 4096 + half * 2048; }
template <int OFF> __device__ __forceinline__ s16x4 tr_read(int vb) { s16x4 r; asm volatile("ds_read_b64_tr_b16 %0, %1 offset:%2" : "=&v"(r) : "v"(vb), "i"(OFF) : "memory"); return r; }
#define ATT_RD8(L, H, D0) do { \
    asm volatile("ds_read_b64_tr_b16 %0, %1 offset:%2" : "=&v"(L[0]) : "v"(vb), "i"(v_rd_off(D0, 0, 0)) : "memory"); asm volatile("ds_read_b64_tr_b16 %0, %1 offset:%2" : "=&v"(H[0]) : "v"(vb), "i"(v_rd_off(D0, 0, 1)) : "memory"); \
    asm volatile("ds_read_b64_tr_b16 %0, %1 offset:%2" : "=&v"(L[1]) : "v"(vb), "i"(v_rd_off(D0, 1, 0)) : "memory"); asm volatile("ds_read_b64_tr_b16 %0, %1 offset:%2" : "=&v"(H[1]) : "v"(vb), "i"(v_rd_off(D0, 1, 1)) : "memory"); \
    asm volatile("ds_read_b64_tr_b16 %0, %1 offset:%2" : "=&v"(L[2]) : "v"(vb), "i"(v_rd_off(D0, 2, 0)) : "memory"); asm volatile("ds_read_b64_tr_b16 %0, %1 offset:%2" : "=&v"(H[2]) : "v"(vb), "i"(v_rd_off(D0, 2, 1)) : "memory"); \
    asm volatile("ds_read_b64_tr_b16 %0, %1 offset:%2" : "=&v"(L[3]) : "v"(vb), "i"(v_rd_off(D0, 3, 0)) : "memory"); asm volatile("ds_read_b64_tr_b16 %0, %1 offset:%2" : "=&v"(H[3]) : "v"(vb), "i"(v_rd_off(D0, 3, 1)) : "memory"); } while (0)
#define ATT_PK(L, H) (bf16x8){L[0], L[1], L[2], L[3], H[0], H[1], H[2], H[3]}
#define ATT_MM4(OD, L, H) do { OD = __builtin_amdgcn_mfma_f32_32x32x16_bf16(pa0, ATT_PK(L[0], H[0]), OD, 0, 0, 0); OD = __builtin_amdgcn_mfma_f32_32x32x16_bf16(pa1, ATT_PK(L[1], H[1]), OD, 0, 0, 0); \
    OD = __builtin_amdgcn_mfma_f32_32x32x16_bf16(pa2, ATT_PK(L[2], H[2]), OD, 0, 0, 0); OD = __builtin_amdgcn_mfma_f32_32x32x16_bf16(pa3, ATT_PK(L[3], H[3]), OD, 0, 0, 0); } while (0)
__device__ __forceinline__ void pv_d0(f32x16* o, int vb, bf16x8 pa0, bf16x8 pa1, bf16x8 pa2, bf16x8 pa3) {
  s16x4 la[4], ha[4], lb[4], hb[4];
  ATT_RD8(la, ha, 0); ATT_RD8(lb, hb, 1);
  asm volatile("s_waitcnt lgkmcnt(8)" ::: "memory"); SBAR(); ATT_MM4(o[0], la, ha); SBAR();
  ATT_RD8(la, ha, 2);
  asm volatile("s_waitcnt lgkmcnt(8)" ::: "memory"); SBAR(); ATT_MM4(o[1], lb, hb); SBAR();
  ATT_RD8(lb, hb, 3);
  asm volatile("s_waitcnt lgkmcnt(8)" ::: "memory"); SBAR(); ATT_MM4(o[2], la, ha); SBAR();
  asm volatile("s_waitcnt lgkmcnt(0)" ::: "memory"); SBAR(); ATT_MM4(o[3], lb, hb);
  const bf16x8 ones = {(short)0x3F80, (short)0x3F80, (short)0x3F80, (short)0x3F80, (short)0x3F80, (short)0x3F80, (short)0x3F80, (short)0x3F80};
  o[4] = __builtin_amdgcn_mfma_f32_32x32x16_bf16(pa0, ones, o[4], 0, 0, 0); o[4] = __builtin_amdgcn_mfma_f32_32x32x16_bf16(pa1, ones, o[4], 0, 0, 0);
  o[4] = __builtin_amdgcn_mfma_f32_32x32x16_bf16(pa2, ones, o[4], 0, 0, 0); o[4] = __builtin_amdgcn_mfma_f32_32x32x16_bf16(pa3, ones, o[4], 0, 0, 0);
}
__device__ __forceinline__ void pv_softmax(f32x16* o, int vb, bf16x8 pa0, bf16x8 pa1, bf16x8 pa2, bf16x8 pa3, f32x16& p0, f32x16& p1, float& m_reg, float& alpha, bool& resc) {
  s16x4 la[4], ha[4], lb[4], hb[4];
  ATT_RD8(la, ha, 0); ATT_RD8(lb, hb, 1);
  asm volatile("s_waitcnt lgkmcnt(8)" ::: "memory"); SBAR();
  float a = fmaxf(fmaxf(p0[0], p0[1]), p1[0]), b = fmaxf(fmaxf(p0[2], p0[3]), p1[1]); a = fmaxf(fmaxf(a, p1[2]), p1[3]);
#pragma unroll
  for (int r = 4; r < 16; r += 4) { a = fmaxf(fmaxf(a, p0[r]), p0[r + 1]); b = fmaxf(fmaxf(b, p0[r + 2]), p0[r + 3]); a = fmaxf(fmaxf(a, p1[r]), p1[r + 1]); b = fmaxf(fmaxf(b, p1[r + 2]), p1[r + 3]); }
  float pmax = fmaxf(a, b);
  ATT_MM4(o[0], la, ha); SBAR();
  ATT_RD8(la, ha, 2);
  asm volatile("s_waitcnt lgkmcnt(8)" ::: "memory"); SBAR();
  { auto rr = __builtin_amdgcn_permlane32_swap(__float_as_uint(pmax), __float_as_uint(pmax), false, false);
    pmax = fmaxf(__uint_as_float(rr[0]), __uint_as_float(rr[1])); }
  resc = false; alpha = 1.f;
  if (__builtin_expect(!__all(pmax <= THR2), 0)) { const float dl = fmaxf(pmax, 0.f); m_reg += dl; alpha = __builtin_amdgcn_exp2f(-dl); resc = true;
#pragma unroll
    for (int r = 0; r < 16; ++r) { p0[r] -= dl; p1[r] -= dl; } }
  ATT_MM4(o[1], lb, hb); SBAR();
  ATT_RD8(lb, hb, 3);
  asm volatile("s_waitcnt lgkmcnt(8)" ::: "memory"); SBAR();
#pragma unroll
  for (int r = 0; r < 16; ++r) p0[r] = __builtin_amdgcn_exp2f(p0[r]);
  ATT_MM4(o[2], la, ha); SBAR();
  asm volatile("s_waitcnt lgkmcnt(0)" ::: "memory"); SBAR();
#pragma unroll
  for (int r = 0; r < 16; ++r) p1[r] = __builtin_amdgcn_exp2f(p1[r]);
  ATT_MM4(o[3], lb, hb);
  const bf16x8 ones = {(short)0x3F80, (short)0x3F80, (short)0x3F80, (short)0x3F80, (short)0x3F80, (short)0x3F80, (short)0x3F80, (short)0x3F80};
  o[4] = __builtin_amdgcn_mfma_f32_32x32x16_bf16(pa0, ones, o[4], 0, 0, 0); o[4] = __builtin_amdgcn_mfma_f32_32x32x16_bf16(pa1, ones, o[4], 0, 0, 0);
  o[4] = __builtin_amdgcn_mfma_f32_32x32x16_bf16(pa2, ones, o[4], 0, 0, 0); o[4] = __builtin_amdgcn_mfma_f32_32x32x16_bf16(pa3, ones, o[4], 0, 0, 0);
}
__device__ __forceinline__ void near_bias(f32x16& p0, f32x16& p1, int dq, const float* tbl) {
#pragma unroll
  for (int r = 0; r < 16; ++r) { const int c0 = (r & 3) + 8 * (r >> 2); p0[r] += tbl[dq + c0]; p1[r] += tbl[dq + c0 + 32]; }
}
__device__ __forceinline__ void qkt(f32x16& p0, f32x16& p1, const char* Ks, const bf16x8* qr, int r32, int hi, int mapB) {
  bf16x8 k0[4], k1[4];
#pragma unroll
  for (int d0 = 0; d0 < 4; ++d0) { const int cb = mapB + (d0 * 16 + hi * 8) * 2;
    k0[d0] = *reinterpret_cast<const bf16x8*>(Ks + KSWZ(r32, cb)); k1[d0] = *reinterpret_cast<const bf16x8*>(Ks + KSWZ(32 + r32, cb)); }
  p0 = f32x16{}; p1 = f32x16{};
#pragma unroll
  for (int d0 = 0; d0 < 4; ++d0) {
    p0 = __builtin_amdgcn_mfma_f32_32x32x16_bf16(k0[d0], qr[d0], p0, 0, 0, 0);
    p1 = __builtin_amdgcn_mfma_f32_32x32x16_bf16(k1[d0], qr[d0], p1, 0, 0, 0); }
}
__device__ __forceinline__ void qkt_seed(f32x16& p0, f32x16& p1, const char* Ks, const bf16x8* qr, const int (&koff)[4], const f32x16& seed) {
#pragma unroll
  for (int d0 = 0; d0 < 4; ++d0) {
    const bf16x8 b0 = *reinterpret_cast<const bf16x8*>(Ks + koff[d0]);
    const bf16x8 b1 = *reinterpret_cast<const bf16x8*>(Ks + koff[d0] + 8192);
    if (d0 == 0) { p0 = __builtin_amdgcn_mfma_f32_32x32x16_bf16(b0, qr[0], seed, 0, 0, 0); p1 = __builtin_amdgcn_mfma_f32_32x32x16_bf16(b1, qr[0], seed, 0, 0, 0); }
    else { p0 = __builtin_amdgcn_mfma_f32_32x32x16_bf16(b0, qr[d0], p0, 0, 0, 0); p1 = __builtin_amdgcn_mfma_f32_32x32x16_bf16(b1, qr[d0], p1, 0, 0, 0); } }
}
__device__ __forceinline__ void partialSM_seeded(f32x16& p0, f32x16& p1, float& m_reg, float& alpha, bool& resc, int mode, int dq, const float* tbl) {
  if (mode == 0) {
#pragma unroll
    for (int r = 0; r < 16; ++r) { const int c0 = (r & 3) + 8 * (r >> 2);
      p0[r] += tbl[dq + c0]; p1[r] += tbl[dq + c0 + 32]; }
  }
  float a = fmaxf(fmaxf(p0[0], p0[1]), p1[0]), b = fmaxf(fmaxf(p0[2], p0[3]), p1[1]); a = fmaxf(fmaxf(a, p1[2]), p1[3]);
#pragma unroll
  for (int r = 4; r < 16; r += 4) { a = fmaxf(fmaxf(a, p0[r]), p0[r + 1]); b = fmaxf(fmaxf(b, p0[r + 2]), p0[r + 3]); a = fmaxf(fmaxf(a, p1[r]), p1[r + 1]); b = fmaxf(fmaxf(b, p1[r + 2]), p1[r + 3]); }
  float pmax = fmaxf(a, b);
  { auto rr = __builtin_amdgcn_permlane32_swap(__float_as_uint(pmax), __float_as_uint(pmax), false, false);
    pmax = fmaxf(__uint_as_float(rr[0]), __uint_as_float(rr[1])); }
  resc = false; alpha = 1.f;
  if (__builtin_expect(!__all(pmax <= THR2), 0)) { const float dl = fmaxf(pmax, 0.f); m_reg += dl; alpha = __builtin_amdgcn_exp2f(-dl); resc = true;
#pragma unroll
    for (int r = 0; r < 16; ++r) { p0[r] -= dl; p1[r] -= dl; } }
#pragma unroll
  for (int r = 0; r < 16; ++r) p0[r] = __builtin_amdgcn_exp2f(p0[r]);
}
__device__ __forceinline__ void partialSM(f32x16& p0, f32x16& p1, float& m_reg, float& mn, float& alpha, int mode, float cL, float cR, int dq, const float* tbl) {
  float cadd;
  if (mode == 0) {
#pragma unroll
    for (int r = 0; r < 16; ++r) { const int c0 = (r & 3) + 8 * (r >> 2);
      p0[r] += tbl[dq + c0]; p1[r] += tbl[dq + c0 + 32]; }
    cadd = 0.f;
  } else cadd = (mode < 0) ? cL : cR;
  float pmax = p0[0];
#pragma unroll
  for (int r = 1; r < 16; ++r) pmax = fmaxf(pmax, p0[r]);
#pragma unroll
  for (int r = 0; r < 16; ++r) pmax = fmaxf(pmax, p1[r]);
  { auto rr = __builtin_amdgcn_permlane32_swap(__float_as_uint(pmax), __float_as_uint(pmax), false, false);
    pmax = fmaxf(__uint_as_float(rr[0]), __uint_as_float(rr[1])); }
  pmax += cadd;
  if (__builtin_expect(__all(pmax - m_reg <= THR2), 1)) { mn = m_reg; alpha = 1.f; }
  else { mn = fmaxf(m_reg, pmax); alpha = __builtin_amdgcn_exp2f(m_reg - mn); m_reg = mn; }
  const float sh = cadd - mn;
#pragma unroll
  for (int r = 0; r < 16; ++r) p0[r] += sh;
#pragma unroll
  for (int r = 0; r < 16; ++r) p1[r] += sh;
#pragma unroll
  for (int r = 0; r < 16; ++r) p0[r] = __builtin_amdgcn_exp2f(p0[r]);
}
__device__ __forceinline__ void finishSM(f32x16& p0, f32x16& p1, bf16x8& pa0, bf16x8& pa1, bf16x8& pa2, bf16x8& pa3) {
#define PK8(P, BASE, OUT) do { v4u w = {cvt_pk_bf16(P[BASE + 0], P[BASE + 1]), cvt_pk_bf16(P[BASE + 2], P[BASE + 3]), cvt_pk_bf16(P[BASE + 4], P[BASE + 5]), cvt_pk_bf16(P[BASE + 6], P[BASE + 7])}; OUT = *reinterpret_cast<bf16x8*>(&w); } while (0)
  PK8(p0, 0, pa0); PK8(p0, 8, pa1); PK8(p1, 0, pa2); PK8(p1, 8, pa3);
#undef PK8
}
__device__ __forceinline__ int rel_bucket(int rel) {
  const int n = rel < 0 ? -rel : rel; int b;
  if (n < 8) b = n; else if (n < 12) b = 8; else if (n < 16) b = 9; else if (n < 23) b = 10; else if (n < 32) b = 11; else if (n < 46) b = 12; else if (n < 64) b = 13; else if (n < 91) b = 14; else b = 15;
  return (rel > 0 ? 16 : 0) + b;
}

__device__ __forceinline__ void attn_unit(int b, int h, int qb, const bf16_t* __restrict__ Q, const bf16_t* __restrict__ K, const bf16_t* __restrict__ V, bf16_t* __restrict__ O,
                                          float lam, float osc, const float* __restrict__ g, const float* __restrict__ rel_bias, char* lds, int tid_in, bool build_tbl, bool o8) {
  int tid_ = tid_in; asm volatile("" : "+v"(tid_));
  const int tid = tid_, wid = __builtin_amdgcn_readfirstlane(tid >> 6), lane = tid & 63, r32 = lane & 31, hi = lane >> 5;
  const int map = wid & 1, jq = wid >> 1;
  char* V_lds = lds + OFF_V; char* K_lds = lds + OFF_K;
  float* ws = (float*)(lds + OFF_WS) + wid * 64; float* li_l = ws; float* al_l = ws + 32;
  float* tbl = (float*)(lds + OFF_TBL);
  if (build_tbl) tbl[tid] = rel_bias[rel_bucket(tid - 256) * NH + h] * LOG2E;
  const float cL = rel_bias[15 * NH + h] * LOG2E, cR = rel_bias[31 * NH + h] * LOG2E;
  const long rowbase = (long)b * SEQ; const int qs = qb * 128 + jq * QBLK;
  float m_reg = -1e30f; f32x16 o[5] = {}; bf16x8 qr[4];
  const bf16_t* Qw = Q + (rowbase + qs + r32) * LDX + h * 128 + map * 64 + hi * 8;
#pragma unroll
  for (int d0 = 0; d0 < 4; ++d0) qr[d0] = *reinterpret_cast<const bf16x8*>(Qw + d0 * 16);
  const bf16_t* Kh = K + rowbase * LDX + h * 128; const bf16_t* Vh = V + rowbase * LDX + h * 128;
  const int vb0 = (int)(uintptr_t)V_lds + v_rd_base(lane);
  const int mapB = map * 128;
  int koff[4];
#pragma unroll
  for (int d0 = 0; d0 < 4; ++d0) koff[d0] = KSWZ(r32, mapB + (d0 * 16 + hi * 8) * 2);
  const int dq0 = 256 + 4 * hi - (qs + r32);
  unsigned ksrc[2], vsrc[2];
#pragma unroll
  for (int i = 0; i < 2; ++i) { const int pk = wid + 8 * i;
    const int krow = 4 * pk + (lane >> 4), kc = (lane & 15) ^ (krow & 7); ksrc[i] = (unsigned)(krow * (LDX * 2) + kc * 16);
    const int st = 2 * pk + (lane >> 5), kk = (st >> 2) * 8 + ((lane & 31) >> 2), vk = kk  , vc = (st & 3) * 32 + (lane & 3) * 8;
    vsrc[i] = (unsigned)(vk * (LDX * 2) + vc * 2); }
  typedef const __attribute__((address_space(1))) unsigned* gptr_t; typedef __attribute__((address_space(3))) unsigned* lptr_t;
  const char* const Kg = (const char*)Kh; const char* const Vg = (const char*)Vh;
  const lptr_t kdst = (lptr_t)(__attribute__((address_space(3))) char*)(K_lds) + 0; (void)kdst;
#define DMA_TILE(t, slot) do { const unsigned tb_ = (unsigned)(t) * (unsigned)(KVBLK * LDX * 2); \
    _Pragma("unroll") for (int i_ = 0; i_ < 2; ++i_) { \
      __builtin_amdgcn_global_load_lds((gptr_t)(Kg + (ksrc[i_] + tb_)), (lptr_t)((__attribute__((address_space(3))) char*)K_lds + (slot) + (wid + 8 * i_) * 1024), 16, 0, 0); \
      __builtin_amdgcn_global_load_lds((gptr_t)(Vg + (vsrc[i_] + tb_)), (lptr_t)((__attribute__((address_space(3))) char*)V_lds + (slot) + (wid + 8 * i_) * 1024), 16, 0, 0); } } while (0)
#define WAIT_BAR() do { asm volatile("s_waitcnt vmcnt(0) lgkmcnt(0)" ::: "memory"); __builtin_amdgcn_s_barrier(); asm volatile("" ::: "memory"); } while (0)
#define RESC(a, rs) do { if (rs) { if (hi == 0) al_l[r32] = (a); asm volatile("s_waitcnt lgkmcnt(0)" ::: "memory"); \
    _Pragma("unroll") for (int d = 0; d < 5; ++d) _Pragma("unroll") for (int r = 0; r < 16; ++r) o[d][r] *= al_l[crow(r, hi)]; } } while (0)
#define SEED(md) do { const int md_ = (md); const float sv_ = (md_ == 0 ? 0.f : (md_ < 0 ? cL : cR)) - m_reg; _Pragma("unroll") for (int r = 0; r < 16; ++r) seed[r] = sv_; } while (0)
#define TMODE(k0) (((k0) >= qs + 122) ? 1 : (((k0) <= qs - 154) ? -1 : 0))
#define ROT() do { const int t_ = sl_prev; sl_prev = sl_cur; sl_cur = sl_next; sl_next = t_; } while (0)
  f32x16 pA0, pA1, pB0, pB1, seed; float mnA, alA, alB; bool rsA = false, rsB = false; bf16x8 pa0, pa1, pa2, pa3;
  int sl_prev = 2 * SHM_V, sl_cur = 0, sl_next = SHM_V;
  if (wid >= 4) __builtin_amdgcn_s_setprio(1);
  DMA_TILE(0, 0); DMA_TILE(1, SHM_V);
  WAIT_BAR();
  DMA_TILE(2, 2 * SHM_V);
  qkt(pA0, pA1, K_lds, qr, r32, hi, mapB); partialSM(pA0, pA1, m_reg, mnA, alA, TMODE(0), cL, cR, dq0, tbl);
  _Pragma("unroll") for (int r = 0; r < 16; ++r) pA1[r] = __builtin_amdgcn_exp2f(pA1[r]);
  ROT();
#define QK_SEEDED(P0, P1, DMA_STMT, SEED_STMT) do { bf16x8 k0_[4], k1_[4]; const char* Ks_ = K_lds + sl_cur; \
    _Pragma("unroll") for (int d0 = 0; d0 < 4; ++d0) { k0_[d0] = *reinterpret_cast<const bf16x8*>(Ks_ + koff[d0]); k1_[d0] = *reinterpret_cast<const bf16x8*>(Ks_ + koff[d0] + 8192); } \
    DMA_STMT; SEED_STMT; \
    P0 = __builtin_amdgcn_mfma_f32_32x32x16_bf16(k0_[0], qr[0], seed, 0, 0, 0); P1 = __builtin_amdgcn_mfma_f32_32x32x16_bf16(k1_[0], qr[0], seed, 0, 0, 0); \
    _Pragma("unroll") for (int d0 = 1; d0 < 4; ++d0) { P0 = __builtin_amdgcn_mfma_f32_32x32x16_bf16(k0_[d0], qr[d0], P0, 0, 0, 0); P1 = __builtin_amdgcn_mfma_f32_32x32x16_bf16(k1_[d0], qr[d0], P1, 0, 0, 0); } } while (0)
  for (int j = 1; j + 1 < NT; j += 2) {
    SBAR(); QK_SEEDED(pB0, pB1, if (j > 1) DMA_TILE(j + 1, sl_next), SEED(TMODE(j * KVBLK)));
    finishSM(pA0, pA1, pa0, pa1, pa2, pa3); SBAR();
    if (TMODE(j * KVBLK) == 0) near_bias(pB0, pB1, dq0 + j * KVBLK, tbl);
    pv_softmax(o, vb0 + sl_prev, pa0, pa1, pa2, pa3, pB0, pB1, m_reg, alB, rsB);
    WAIT_BAR();
    RESC(alB, rsB); ROT();
    SBAR(); QK_SEEDED(pA0, pA1, DMA_TILE(j + 2, sl_next), SEED(TMODE((j + 1) * KVBLK)));
    finishSM(pB0, pB1, pa0, pa1, pa2, pa3); SBAR();
    if (TMODE((j + 1) * KVBLK) == 0) near_bias(pA0, pA1, dq0 + (j + 1) * KVBLK, tbl);
    pv_softmax(o, vb0 + sl_prev, pa0, pa1, pa2, pa3, pA0, pA1, m_reg, alA, rsA);
    WAIT_BAR();
    RESC(alA, rsA); ROT();
  }
  SBAR(); QK_SEEDED(pB0, pB1, (void)0, SEED(TMODE((NT - 1) * KVBLK)));
  finishSM(pA0, pA1, pa0, pa1, pa2, pa3); SBAR();
  if (TMODE((NT - 1) * KVBLK) == 0) near_bias(pB0, pB1, dq0 + (NT - 1) * KVBLK, tbl);
  pv_softmax(o, vb0 + sl_prev, pa0, pa1, pa2, pa3, pB0, pB1, m_reg, alB, rsB);
  RESC(alB, rsB);
  finishSM(pB0, pB1, pa0, pa1, pa2, pa3); SBAR();
  pv_d0(o, vb0 + sl_cur, pa0, pa1, pa2, pa3);
  __builtin_amdgcn_s_setprio(0);
  float rli[16];
#pragma unroll
  for (int r = 0; r < 16; ++r) rli[r] = __builtin_amdgcn_rcpf(o[4][r]);
  __syncthreads();
  float* X = (float*)(lds + jq * 16384);
  if (map == 1) {
#pragma unroll
    for (int r = 0; r < 16; ++r) { const int orow = crow(r, hi); const float s = rli[r] * lam;
#pragma unroll
      for (int d0 = 0; d0 < 4; ++d0) X[orow * 128 + d0 * 32 + r32] = o[d0][r] * s; }
  }
  __syncthreads();
  if (map == 0) {
    float ss[16];
#pragma unroll
    for (int r = 0; r < 16; ++r) { const int orow = crow(r, hi); float a = 0.f;
#pragma unroll
      for (int d0 = 0; d0 < 4; ++d0) { const float v = o[d0][r] * rli[r] - X[orow * 128 + d0 * 32 + r32]; o[d0][r] = v; a += v * v; }
      ss[r] = a; }
#pragma unroll
    for (int s = 1; s < 32; s <<= 1)
#pragma unroll
      for (int r = 0; r < 16; ++r) ss[r] += shx(ss[r], s);
    float gg[4];
#pragma unroll
    for (int d0 = 0; d0 < 4; ++d0) gg[d0] = g[d0 * 32 + r32] * osc;
    asm volatile("s_waitcnt lgkmcnt(0)" ::: "memory");
    bf16_t* stg = (bf16_t*)X;
#pragma unroll
    for (int r = 0; r < 16; ++r) { const int orow = crow(r, hi); const float rs = __builtin_amdgcn_rsqf(ss[r] * (1.0f / 128.0f) + LN_EPS);
#pragma unroll
      for (int d0 = 0; d0 < 4; ++d0) { const float v = o[d0][r] * rs * gg[d0]; stg[orow * 128 + d0 * 32 + r32] = (bf16_t)(cvt_pk_bf16(v, v) & 0xffffu); } }
    asm volatile("s_waitcnt lgkmcnt(0)" ::: "memory");
    bf16_t* Ow = O + (rowbase + qs) * LDX + h * 128;
#pragma unroll
    for (int i = 0; i < 8; ++i) { const int row = i * 4 + (lane >> 4), ch = lane & 15; const v4u v = *(const v4u*)(stg + row * 128 + ch * 8);
      if (!o8) *(v4u*)(Ow + (long)row * LDX + ch * 8) = v;
      else { typedef unsigned u32x2 __attribute__((ext_vector_type(2))); u32x2 q8; q8.x = pg8::pk4_fp8(bf_lo(v.x), bf_hi(v.x), bf_lo(v.y), bf_hi(v.y)); q8.y = pg8::pk4_fp8(bf_lo(v.z), bf_hi(v.z), bf_lo(v.w), bf_hi(v.w));
        *(u32x2*)((unsigned char*)O + (size_t)(rowbase + qs + row) * LDX + h * 128 + ch * 8) = q8; } }
    asm volatile("s_waitcnt lgkmcnt(0)" ::: "memory");
  }
  __syncthreads();
#undef DMA_TILE
#undef WAIT_BAR
#undef ROT
#undef RESC
#undef SEED
#undef QK_SEEDED
#undef TMODE
}
#undef KSWZ
#undef SBAR
}

#define XB_TMO      128
#define XB_XCNT(j)  (256  + 64 * (j))
#define XB_XSUB(j)  (1280 + 64 * (j))
#define XB_XGEN(j)  (2304 + 64 * (j))
#define XB_TOP      3328
#define XB_TOPGEN   3392
#define XCD_BAR_WORDS 3456
#define XB_SPIN_CAP (1u << 18)
__device__ __forceinline__ unsigned xb_ld(unsigned* p)              { return __hip_atomic_load(p, __ATOMIC_RELAXED, __HIP_MEMORY_SCOPE_AGENT); }
__device__ __forceinline__ unsigned xb_add(unsigned* p, unsigned v) { return __hip_atomic_fetch_add(p, v, __ATOMIC_RELAXED, __HIP_MEMORY_SCOPE_AGENT); }
__device__ __forceinline__ unsigned xb_xcc_id() { return (unsigned)__builtin_amdgcn_s_getreg((3 << 11) | 20) & 0xFu; }
#define XB_SPIN(cond, bar) do { unsigned _sp = 0; while (cond) { __builtin_amdgcn_s_sleep(1); \
    if ((++_sp & 255u) == 0u) { if (xb_ld(&(bar)[XB_TMO])) break; if (_sp > XB_SPIN_CAP) { atomicAdd(&(bar)[XB_TMO], 1u); break; } } } } while (0)
struct XcdBarrier { unsigned* bar; unsigned x; volatile LAS unsigned* st; };
__device__ __forceinline__ XcdBarrier xcd_barrier_post(unsigned* bar, volatile LAS unsigned* st) {
    XcdBarrier b; b.bar = bar; b.x = xb_xcc_id(); b.st = st;
    if (threadIdx.x == 0) (void)xb_add(&bar[XB_XCNT(b.x)], 1u);
    return b;
}
__device__ __forceinline__ void xcd_barrier_complete(unsigned* bar, unsigned x, unsigned& nloc, unsigned& nx) {
    const unsigned G = gridDim.x * gridDim.y * gridDim.z;
    unsigned sum, cnt, mine, sp = 0u;
    for (;;) {
        sum = 0u; cnt = 0u; mine = 0u;
#pragma unroll
        for (unsigned j = 0; j < 16; ++j) { const unsigned c = xb_ld(&bar[XB_XCNT(j)]); sum += c; cnt += (c > 0u) ? 1u : 0u; mine = (j == x) ? c : mine; }
        if (sum == G) break;
        __builtin_amdgcn_s_sleep(1);
        if ((++sp & 255u) == 0u) { if (xb_ld(&bar[XB_TMO])) break; if (sp > XB_SPIN_CAP) { atomicAdd(&bar[XB_TMO], 1u); break; } }
    }
    nloc = mine > 0u ? mine : 1u; nx = cnt > 0u ? cnt : 1u;
}
__device__ __forceinline__ void xcd_barrier(const XcdBarrier& b) {
    asm volatile("s_waitcnt vmcnt(0)" ::: "memory");
    __syncthreads();
    if (threadIdx.x == 0) {
        unsigned* bar = b.bar;
        __builtin_amdgcn_s_waitcnt(0);
        unsigned nloc = b.st[0], nx = b.st[1];
        if (nloc == 0u) { xcd_barrier_complete(bar, b.x, nloc, nx); b.st[0] = nloc; b.st[1] = nx; }
        const unsigned old = xb_add(&bar[XB_XSUB(b.x)], 1u);
        const unsigned gen = old / nloc;
        if (old + 1u == (gen + 1u) * nloc) {
            __builtin_amdgcn_fence(__ATOMIC_RELEASE, "agent");
            asm volatile("s_waitcnt vmcnt(0)" ::: "memory");
            const unsigned og = xb_add(&bar[XB_TOP], 1u);
            const unsigned tg = og / nx;
            if (og + 1u == (tg + 1u) * nx) xb_add(&bar[XB_TOPGEN], 1u);
            else XB_SPIN(xb_ld(&bar[XB_TOPGEN]) == tg, bar);
            __builtin_amdgcn_fence(__ATOMIC_ACQUIRE, "agent");
            xb_add(&bar[XB_XGEN(b.x)], 1u);
            asm volatile("s_waitcnt vmcnt(0)" ::: "memory");
        } else {
            XB_SPIN(xb_ld(&bar[XB_XGEN(b.x)]) == gen, bar);
            __builtin_amdgcn_fence(__ATOMIC_ACQUIRE, "agent");
            asm volatile("s_waitcnt vmcnt(0)" ::: "memory");
        }
    }
    __syncthreads();
}

template <int MODE> __device__ __forceinline__ int dst_row(int n) {
    if (MODE == 1) { if (n < 1024) return n; const int b = (n - 1024) >> 10, f = (n - 1024) & 1023; return 1024 + (f >> 7) * 256 + b * 128 + (f & 127); }
    if (MODE == 2) { const int b = n & 1, j = n >> 1; return (j >> 7) * 256 + b * 128 + (j & 127); }
    return n;
}
template <int MODE> __device__ __forceinline__ void p0_transpose_item(const float* W, int K, int N, bf16_t* WT, LAS float* scr, int item, int lane, const float* kscale = nullptr) {
    const int nblk = N / 32, kb = item / nblk, nb = item % nblk, k0 = 64 * kb, n0 = 32 * nb;
#pragma unroll 8
    for (int i = 0; i < 32; ++i) { const int kk = 2 * i + (lane >> 5); float w = W[(size_t)(k0 + kk) * N + n0 + (lane & 31)]; if (kscale) w *= kscale[k0 + kk]; scr[kk * 33 + (lane & 31)] = w; }
    LDS_WAIT(); asm volatile("" ::: "memory");
    const int c = lane & 7;
#pragma unroll
    for (int j = 0; j < 4; ++j) { const int n = (lane >> 3) + 8 * j; const LAS float* s = scr + (8 * c) * 33 + n;
        v4u o; o.x = cvt_pk_bf16(s[0 * 33], s[1 * 33]); o.y = cvt_pk_bf16(s[2 * 33], s[3 * 33]); o.z = cvt_pk_bf16(s[4 * 33], s[5 * 33]); o.w = cvt_pk_bf16(s[6 * 33], s[7 * 33]);
        *(GAS v4u*)(WT + (size_t)dst_row<MODE>(n0 + n) * K + k0 + 8 * c) = o; }
    LDS_WAIT(); asm volatile("" ::: "memory");
}

template <int MODE, bool I8 = false> __device__ __forceinline__ void p0_quant_strip(const float* W, int N, unsigned char* W8, float* SC, int strip, LAS unsigned char* lds, int wave, int lane) {
    constexpr float QM_ = I8 ? 127.0f : F8MAX;
    LAS float* scr = (LAS float*)(lds + wave * 16384); LAS float* red = (LAS float*)(lds + LDSCTL_OFF + 2048);
    const int n0 = strip * 32, k0 = wave * 128, kk = lane >> 5, n = lane & 31;
    float am = 0.f;
    { const char* Wb = (const char*)W + (size_t)k0 * N * 4; const unsigned loff = (unsigned)((kk * N + n0 + n) * 4);
      float vv[64];
#pragma unroll
      for (int i = 0; i < 64; ++i) vv[i] = *(const float*)(Wb + (size_t)i * (size_t)(2 * N * 4) + loff);
#pragma unroll
      for (int i = 0; i < 64; ++i) { scr[(2 * i + kk) * 32 + n] = vv[i]; am = fmaxf(am, fabsf(vv[i])); } }
    am = fmaxf(am, shx(am, 32));
    if (lane < 32) red[wave * 32 + n] = am;
    __syncthreads();
    float amax = red[n];
#pragma unroll
    for (int w = 1; w < 8; ++w) amax = fmaxf(amax, red[w * 32 + n]);
    const float q = amax > 0.f ? QM_ / amax : 0.f;
    const int dr = dst_row<MODE>(n0 + n);
    if (wave == 0 && lane < 32) SC[dr] = amax * (1.0f / QM_);
#pragma unroll
    for (int c = 0; c < 4; ++c) { float v[16];
#pragma unroll
        for (int j = 0; j < 16; ++j) v[j] = scr[(kk * 64 + c * 16 + j) * 32 + n] * q;
        v4u o; o.x = pg8::pkq4<I8>(v[0], v[1], v[2], v[3]); o.y = pg8::pkq4<I8>(v[4], v[5], v[6], v[7]); o.z = pg8::pkq4<I8>(v[8], v[9], v[10], v[11]); o.w = pg8::pkq4<I8>(v[12], v[13], v[14], v[15]);
        *(GAS v4u*)(W8 + (size_t)dr * 1024 + k0 + kk * 64 + c * 16) = o; }
    __syncthreads();
}
struct StripSrc { const float* W; int N; unsigned char* W8; float* SC; int strip; bool glu; };
__device__ __forceinline__ void dstrip_desc(const float* w1, const float* w2, unsigned char* ws, int st, StripSrc& d) {
    if (st < 128 * 64) { const int j = st >> 6; d.W = w1 + (size_t)j * 1024 * 2048; d.N = 2048; d.W8 = ws + WS_W1 + (size_t)j * 2048 * 1024; d.SC = (float*)(ws + WS_S1) + (size_t)j * 2048; d.strip = st & 63; d.glu = true; }
    else { const int q = st - 128 * 64, j = q >> 5; d.W = w2 + (size_t)j * 1024 * 1024; d.N = 1024; d.W8 = ws + WS_W2 + (size_t)j * 1024 * 1024; d.SC = (float*)(ws + WS_S2) + (size_t)j * 1024; d.strip = q & 31; d.glu = false; }
}
__device__ __forceinline__ void dstrip_issue(const StripSrc& d, int wave, int lane, f32x4 (&vv)[16]) {
    const int n0 = d.strip * 32, k0 = wave * 128, r8 = lane >> 3, cg = lane & 7;
    const char* Wb = (const char*)d.W + (size_t)k0 * d.N * 4; const unsigned loff = (unsigned)((r8 * d.N + n0 + 4 * cg) * 4); const size_t rs8 = (size_t)d.N * 32;
#pragma unroll
    for (int i = 0; i < 16; ++i) vv[i] = *(const f32x4*)(Wb + (size_t)i * rs8 + loff);
}
__device__ __forceinline__ void dstrip_finish(const StripSrc& d, LAS unsigned char* lds, int wave, int lane, int par, f32x4 (&vv)[16]) {
    LAS float* scr = (LAS float*)(lds + wave * 16384); LAS float* red = (LAS float*)(lds + LDSCTL_OFF + 2048 + par * 1024);
    const int n0 = d.strip * 32, k0 = wave * 128, kk = lane >> 5, n = lane & 31, r8 = lane >> 3, cg = lane & 7;
    f32x4 am = {0.f, 0.f, 0.f, 0.f};
#pragma unroll
    for (int i = 0; i < 16; ++i) { *(LAS f32x4*)(scr + (8 * i + r8) * 32 + 4 * cg) = vv[i];
#pragma unroll
        for (int j = 0; j < 4; ++j) am[j] = fmaxf(am[j], fabsf(vv[i][j])); }
    { const int l_ = lane_local();
#pragma unroll
      for (int o = 8; o < 64; o <<= 1)
#pragma unroll
        for (int j = 0; j < 4; ++j) am[j] = fmaxf(am[j], shx(am[j], o, l_)); }
    if (lane < 8) *(LAS f32x4*)(red + wave * 32 + 4 * cg) = am;
    asm volatile("s_waitcnt lgkmcnt(0)" ::: "memory"); __builtin_amdgcn_s_barrier(); asm volatile("" ::: "memory");
    float amax = red[n];
#pragma unroll
    for (int w = 1; w < 8; ++w) amax = fmaxf(amax, red[w * 32 + n]);
    const float q = amax > 0.f ? F8MAX / amax : 0.f;
    const int dr = d.glu ? dst_row<2>(n0 + n) : (n0 + n);
    if (wave == 0 && lane < 32) d.SC[dr] = amax * (1.0f / F8MAX);
#pragma unroll
    for (int c = 0; c < 4; ++c) { float v[16];
#pragma unroll
        for (int j = 0; j < 16; ++j) v[j] = scr[(kk * 64 + c * 16 + j) * 32 + n] * q;
        v4u o; o.x = pg8::pk4_fp8(v[0], v[1], v[2], v[3]); o.y = pg8::pk4_fp8(v[4], v[5], v[6], v[7]); o.z = pg8::pk4_fp8(v[8], v[9], v[10], v[11]); o.w = pg8::pk4_fp8(v[12], v[13], v[14], v[15]);
        *(GAS v4u*)(d.W8 + (size_t)dr * 1024 + k0 + kk * 64 + c * 16) = o; }
    asm volatile("s_waitcnt lgkmcnt(0)" ::: "memory");
}
__device__ __forceinline__ void deferred_strips(const float* w1, const float* w2, unsigned char* ws, LAS unsigned char* lds, int first, int stride, int wave, int lane) {
    constexpr int NT = 128 * 96;
    auto stq = [](int idx) { return idx; };
    f32x4 va[16], vb[16]; StripSrc da, db; int idx = first, par = 0;
    if (idx < NT) { dstrip_desc(w1, w2, ws, stq(idx), da); dstrip_issue(da, wave, lane, va); }
#pragma unroll 1
    while (idx < NT) {
        const int i1 = idx + stride; if (i1 < NT) { dstrip_desc(w1, w2, ws, stq(i1), db); dstrip_issue(db, wave, lane, vb); }
        dstrip_finish(da, lds, wave, lane, par, va); par ^= 1;
        if (i1 >= NT) break;
        const int i2 = i1 + stride; if (i2 < NT) { dstrip_desc(w1, w2, ws, stq(i2), da); dstrip_issue(da, wave, lane, va); }
        dstrip_finish(db, lds, wave, lane, par, vb); par ^= 1;
        idx = i2;
    }
    __syncthreads();
}
__device__ __forceinline__ float ln_bound(const float* g, const float* b, int lane) {
    float mg = 0.f, mb = 0.f;
#pragma unroll
    for (int j = 0; j < 4; ++j) { const f32x4 a = *(const f32x4*)(g + j * 256 + lane * 4), c = *(const f32x4*)(b + j * 256 + lane * 4);
        mg = fmaxf(mg, fmaxf(fmaxf(fabsf(a[0]), fabsf(a[1])), fmaxf(fabsf(a[2]), fabsf(a[3])))); mb = fmaxf(mb, fmaxf(fmaxf(fabsf(c[0]), fabsf(c[1])), fmaxf(fabsf(c[2]), fabsf(c[3])))); }
#pragma unroll
    for (int o = 1; o < 64; o <<= 1) { mg = fmaxf(mg, shx(mg, o)); mb = fmaxf(mb, shx(mb, o)); }
    return 31.984371f * mg + mb;
}

struct Ptrs {
    const float *x, *rel_bias, *attn_w_in, *attn_lambda, *attn_subln, *attn_w_out, *conv_w_in, *conv_w, *conv_w_out, *router_w, *router_b, *w1, *b1, *w2, *b2, *ln_g, *ln_b;
    float* out; unsigned char* ws;
};

#ifndef DEFER_W
#define DEFER_W 1
#endif
__device__ __forceinline__ void expert_strip(const Ptrs& P, int st, LAS unsigned char* lds, int wave, int lane) {
    unsigned char* ws = P.ws;
    if (st < 128 * 64) { const int j = st >> 6, r = st & 63; p0_quant_strip<2>(P.w1 + (size_t)j * 1024 * 2048, 2048, ws + WS_W1 + (size_t)j * 2048 * 1024, (float*)(ws + WS_S1) + (size_t)j * 2048, r, lds, wave, lane); }
    else { const int q = st - 128 * 64, j = q >> 5, r = q & 31; p0_quant_strip<0>(P.w2 + (size_t)j * 1024 * 1024, 1024, ws + WS_W2 + (size_t)j * 1024 * 1024, (float*)(ws + WS_S2) + (size_t)j * 1024, r, lds, wave, lane); }
}
constexpr int NWAVES_ = 8;
__device__ __forceinline__ void p0_prologue(const Ptrs& P, LAS unsigned char* lds, int gw, int NGW, int wave, int lane) {
    LAS float* scr = (LAS float*)(lds + RING_OFF + wave * 16384);
    unsigned char* ws = P.ws;
    constexpr int I_OUT = 16 * 32, I_R = 16;
    constexpr int I_IN = 16 * 96;
    constexpr int S1 = NA16 * I_OUT, S3 = S1 + NO16 * I_OUT, S4 = S3 + 4 * I_R, S5 = S4 + NQ16 * I_IN, S6 = S5 + NC16 * I_IN;
    { const int wg = gw / NWAVES_, NWG = NGW / NWAVES_;
      constexpr int T1 = 128 * 64, T2 = T1 + 128 * 32, T3 = T2 + NQ8 * 96, T4 = T3 + NC8 * 96, T5 = T4 + NA8 * 32, T6 = T5 + NO8 * 32;
      constexpr int NE0 = DEFER_W ? 0 : T2;
#pragma unroll 1
      for (int s0 = wg; s0 < NE0 + (T6 - T2); s0 += NWG) {
        const int st = (s0 >= NE0) ? T2 + (s0 - NE0) : s0;
        if (st < T2) expert_strip(P, st, lds, wave, lane);
        else if (st < T3) { const int q = st - T2, j = QJ0 + q / 96, r = q % 96; p0_quant_strip<0, I8P>(P.attn_w_in + (size_t)j * 1024 * 3072, 3072, ws + WS_WAI + (size_t)j * 3072 * 1024, (float*)(ws + WS_SD) + (size_t)j * 3072, r, lds, wave, lane); }
        else if (st < T4) { const int q = st - T3, j = CJ0 + q / 96, r = q % 96; p0_quant_strip<1, I8P>(P.conv_w_in + (size_t)j * 1024 * 3072, 3072, ws + WS_WCI + (size_t)j * 3072 * 1024, (float*)(ws + WS_SD + 32 * 1024) + (size_t)j * 3072, r, lds, wave, lane); }
        else if (st < T5) { const int q = st - T4, j = AJ0 + q / 32, r = q % 32; p0_quant_strip<0>(P.attn_w_out + (size_t)j * 1024 * 1024, 1024, ws + WS_WAO8 + (size_t)j * 1024 * 1024, (float*)(ws + WS_SD + 24 * 1024) + (size_t)j * 1024, r, lds, wave, lane); }
        else { const int q = st - T5, j = OJ0 + q / 32, r = q % 32; p0_quant_strip<0, I8P>(P.conv_w_out + (size_t)j * 1024 * 1024, 1024, ws + WS_WCO8 + (size_t)j * 1024 * 1024, (float*)(ws + WS_SD + 56 * 1024) + (size_t)j * 1024, r, lds, wave, lane); }
      } }
    for (int it = gw; it < S6; it += NGW) {
        if (it >= S5) { const int q = it - S5, j = CK0 + q / I_IN, r = q % I_IN; p0_transpose_item<1>(P.conv_w_in + (size_t)j * 1024 * 3072, 1024, 3072, (bf16_t*)(ws + WS_WC16) + (size_t)j * 3072 * 1024, scr, r, lane); }
        else if (it >= S4) { const int q = it - S4, j = QK0 + q / I_IN, r = q % I_IN; p0_transpose_item<0>(P.attn_w_in + (size_t)j * 1024 * 3072, 1024, 3072, (bf16_t*)(ws + WS_WA16) + (size_t)j * 3072 * 1024, scr, r, lane); }
        else if (it < S1) { const int q = it, j = AK0 + q / I_OUT, r = q % I_OUT; p0_transpose_item<0>(P.attn_w_out + (size_t)j * 1024 * 1024, 1024, 1024, (bf16_t*)(ws + WS_WAO) + (size_t)j * 1024 * 1024, scr, r, lane); }
        else if (it < S3) { const int q = it - S1, j = OK0 + q / I_OUT, r = q % I_OUT; p0_transpose_item<0>(P.conv_w_out + (size_t)j * 1024 * 1024, 1024, 1024, (bf16_t*)(ws + WS_WCO) + (size_t)j * 1024 * 1024, scr, r, lane); }
        else { const int q = it - S3, j = q / I_R, r = q % I_R; p0_transpose_item<0>(P.router_w + (size_t)j * 1024 * 32, 1024, 32, (bf16_t*)(ws + WS_WR) + (size_t)j * 32 * 1024, scr, r, lane, P.ln_g + (size_t)(j * 2 + 0) * D); }
    }
    for (int row = gw; row < M; row += NGW) {
        f32x4 a[2][2]; float am = 0.f;
#pragma unroll
        for (int h = 0; h < 2; ++h)
#pragma unroll
            for (int q = 0; q < 2; ++q) { a[h][q] = *(const GAS f32x4*)(P.x + (size_t)row * D + h * 512 + lane * 8 + q * 4);
                am = fmaxf(am, fmaxf(fmaxf(fabsf(a[h][q][0]), fabsf(a[h][q][1])), fmaxf(fabsf(a[h][q][2]), fabsf(a[h][q][3])))); }
#pragma unroll
        for (int o = 1; o < 64; o <<= 1) am = fmaxf(am, shx(am, o));
        const float qs = QMAXP / fmaxf(am, 1e-30f);
        if ((QM & 1) && lane == 0) ((float*)(ws + WS_RS))[row] = am * (1.0f / QMAXP);
#pragma unroll
        for (int h = 0; h < 2; ++h) { v4u o; o.x = cvt_pk_bf16(a[h][0][0], a[h][0][1]); o.y = cvt_pk_bf16(a[h][0][2], a[h][0][3]); o.z = cvt_pk_bf16(a[h][1][0], a[h][1][1]); o.w = cvt_pk_bf16(a[h][1][2], a[h][1][3]);
            *(GAS v4u*)((bf16_t*)(ws + WS_XB) + (size_t)row * D + h * 512 + lane * 8) = o;
            if (QM & 1) { typedef unsigned u32x2 __attribute__((ext_vector_type(2))); u32x2 q8;
            q8.x = pg8::pkq4<I8P>(a[h][0][0] * qs, a[h][0][1] * qs, a[h][0][2] * qs, a[h][0][3] * qs); q8.y = pg8::pkq4<I8P>(a[h][1][0] * qs, a[h][1][1] * qs, a[h][1][2] * qs, a[h][1][3] * qs);
            *(GAS u32x2*)(ws + WS_XI + (size_t)row * D + h * 512 + lane * 8) = q8; } }
    }
}

__device__ __forceinline__ void conv_phase(const bf16_t* GB, const bf16_t* Z, const float* cw, bf16_t* Gout, float* RS, bool o8, int gw, int NGW, int lane) {
    float w[3][16];
#pragma unroll
    for (int j = 0; j < 3; ++j)
#pragma unroll
        for (int h = 0; h < 2; ++h)
#pragma unroll
            for (int q = 0; q < 2; ++q) { const f32x4 t = *(const f32x4*)(cw + j * D + h * 512 + lane * 8 + q * 4); w[j][h * 8 + q * 4 + 0] = t[0]; w[j][h * 8 + q * 4 + 1] = t[1]; w[j][h * 8 + q * 4 + 2] = t[2]; w[j][h * 8 + q * 4 + 3] = t[3]; }
    for (int run = gw; run < M / 32; run += NGW) {
        const int t0 = run * 32; const bool first = (t0 % SEQ) == 0, lastr = ((t0 + 32) % SEQ) == 0;
        v4u zp[2], zc[2], zn[2];
#pragma unroll
        for (int h = 0; h < 2; ++h) { zp[h] = first ? (v4u){0u, 0u, 0u, 0u} : *(const v4u*)(Z + (size_t)(t0 - 1) * D + h * 512 + lane * 8); zc[h] = *(const v4u*)(Z + (size_t)t0 * D + h * 512 + lane * 8); }
        for (int r = 0; r < 32; ++r) { const int t = t0 + r; const bool pad = lastr && (r == 31);
            float o[2][8];
#pragma unroll
            for (int h = 0; h < 2; ++h) {
                zn[h] = pad ? (v4u){0u, 0u, 0u, 0u} : *(const v4u*)(Z + (size_t)(t + 1) * D + h * 512 + lane * 8);
                const v4u gb = *(const v4u*)(GB + (size_t)t * D + h * 512 + lane * 8);
#pragma unroll
                for (int q = 0; q < 4; ++q) { const unsigned up = zp[h][q], uc = zc[h][q], un = zn[h][q], ug = gb[q]; const int c = h * 8 + q * 2;
                    o[h][q * 2 + 0] = bf_lo(ug) * (w[0][c] * bf_lo(up) + w[1][c] * bf_lo(uc) + w[2][c] * bf_lo(un));
                    o[h][q * 2 + 1] = bf_hi(ug) * (w[0][c + 1] * bf_hi(up) + w[1][c + 1] * bf_hi(uc) + w[2][c + 1] * bf_hi(un)); }
                if (!o8) { v4u ov; ov.x = cvt_pk_bf16(o[h][0], o[h][1]); ov.y = cvt_pk_bf16(o[h][2], o[h][3]); ov.z = cvt_pk_bf16(o[h][4], o[h][5]); ov.w = cvt_pk_bf16(o[h][6], o[h][7]);
                    *(v4u*)(Gout + (size_t)t * D + h * 512 + lane * 8) = ov; }
                zp[h] = zc[h]; zc[h] = zn[h];
            }
            if (o8) { float am = 0.f;
#pragma unroll
                for (int h = 0; h < 2; ++h)
#pragma unroll
                    for (int i = 0; i < 8; ++i) am = fmaxf(am, fabsf(o[h][i]));
#pragma unroll
                for (int s_ = 1; s_ < 64; s_ <<= 1) am = fmaxf(am, shx(am, s_));
                const float qs = QMAXP / fmaxf(am, 1e-30f);
                if (lane == 0) RS[t] = am * (1.0f / QMAXP);
#pragma unroll
                for (int h = 0; h < 2; ++h) { typedef unsigned u32x2 __attribute__((ext_vector_type(2))); u32x2 q8;
                    q8.x = pg8::pkq4<I8P>(o[h][0] * qs, o[h][1] * qs, o[h][2] * qs, o[h][3] * qs); q8.y = pg8::pkq4<I8P>(o[h][4] * qs, o[h][5] * qs, o[h][6] * qs, o[h][7] * qs);
                    *(u32x2*)((unsigned char*)Gout + (size_t)t * D + h * 512 + lane * 8) = q8; } }
        }
    }
}

__device__ __forceinline__ void ln2_phase(const bf16_t* Yp, const float* g1, const float* b1, const unsigned char* Y, const float* g, const float* bta, bf16_t* XB, float* out, unsigned char* XI, float* RS, int gw, int NGW, int lane) {
    float gg[16], bb[16];
#pragma unroll
    for (int h = 0; h < 2; ++h)
#pragma unroll
        for (int q = 0; q < 2; ++q) { const f32x4 t = *(const f32x4*)(g + h * 512 + lane * 8 + q * 4), s = *(const f32x4*)(bta + h * 512 + lane * 8 + q * 4);
#pragma unroll
            for (int i = 0; i < 4; ++i) { gg[h * 8 + q * 4 + i] = t[i]; bb[h * 8 + q * 4 + i] = s[i]; } }
    float sXb = 0.f, rsXb = 0.f; if constexpr (!I8P) { const float lb = ln_bound(g, bta, lane); sXb = F8MAX / lb; rsXb = lb * (1.0f / F8MAX); }
    for (int row = gw; row < M; row += NGW) {
        float v[16];
#pragma unroll
        for (int h = 0; h < 2; ++h) { const v4u xr = *(const v4u*)(Yp + (size_t)row * D + h * 512 + lane * 8);
#pragma unroll
            for (int q = 0; q < 4; ++q) { v[h * 8 + q * 2] = bf_lo(xr[q]); v[h * 8 + q * 2 + 1] = bf_hi(xr[q]); } }
        { float s1 = 0.f;
#pragma unroll
          for (int i = 0; i < 16; ++i) s1 += v[i];
          const float m1 = wave_sum(s1) * (1.f / D); float q1 = 0.f;
#pragma unroll
          for (int i = 0; i < 16; ++i) { v[i] -= m1; q1 += v[i] * v[i]; }
          const float r1 = ALPHA / sqrtf(wave_sum(q1) * (1.f / D) + LN_EPS);
#pragma unroll
          for (int h = 0; h < 2; ++h)
#pragma unroll
            for (int q = 0; q < 2; ++q) { const f32x4 t = *(const f32x4*)(g1 + h * 512 + lane * 8 + q * 4), u = *(const f32x4*)(b1 + h * 512 + lane * 8 + q * 4);
#pragma unroll
              for (int i = 0; i < 4; ++i) v[h * 8 + q * 4 + i] = v[h * 8 + q * 4 + i] * r1 * t[i] + ALPHA * u[i]; } }
#pragma unroll
        for (int k = 0; k < 4; ++k)
#pragma unroll
            for (int h = 0; h < 2; ++h) { typedef unsigned u32x2 __attribute__((ext_vector_type(2))); const u32x2 yr = *(const u32x2*)(Y + ((size_t)row * 4 + k) * D + h * 512 + lane * 8);
#pragma unroll
                for (int q = 0; q < 2; ++q) { const f32x2 lo = __builtin_amdgcn_cvt_pk_f32_fp8((int)yr[q], false), hi2 = __builtin_amdgcn_cvt_pk_f32_fp8((int)yr[q], true);
                    v[h * 8 + q * 4 + 0] += lo[0] * (1.0f / YSCALE); v[h * 8 + q * 4 + 1] += lo[1] * (1.0f / YSCALE); v[h * 8 + q * 4 + 2] += hi2[0] * (1.0f / YSCALE); v[h * 8 + q * 4 + 3] += hi2[1] * (1.0f / YSCALE); } }
        float s = 0.f;
#pragma unroll
        for (int i = 0; i < 16; ++i) s += v[i];
        const float mean = wave_sum(s) * (1.f / D); float s2 = 0.f;
#pragma unroll
        for (int i = 0; i < 16; ++i) { v[i] -= mean; s2 += v[i] * v[i]; }
        const float rstd = 1.f / sqrtf(wave_sum(s2) * (1.f / D) + LN_EPS);
#pragma unroll
        for (int i = 0; i < 16; ++i) v[i] = v[i] * rstd * gg[i] + bb[i];
        float sX = sXb, rsX = rsXb;
        if (I8P && XI) { float am = 0.f;
#pragma unroll
            for (int i = 0; i < 16; ++i) am = fmaxf(am, fabsf(v[i]));
#pragma unroll
            for (int o = 1; o < 64; o <<= 1) am = fmaxf(am, shx(am, o));
            sX = QMAXP / fmaxf(am, 1e-30f); rsX = am * (1.0f / QMAXP); }
#pragma unroll
        for (int h = 0; h < 2; ++h) { v4u ov; ov.x = cvt_pk_bf16(v[h * 8 + 0], v[h * 8 + 1]); ov.y = cvt_pk_bf16(v[h * 8 + 2], v[h * 8 + 3]); ov.z = cvt_pk_bf16(v[h * 8 + 4], v[h * 8 + 5]); ov.w = cvt_pk_bf16(v[h * 8 + 6], v[h * 8 + 7]);
            if (!out) *(v4u*)(XB + (size_t)row * D + h * 512 + lane * 8) = ov;
            if (XI) { typedef unsigned u32x2 __attribute__((ext_vector_type(2))); u32x2 q8; q8.x = pg8::pkq4<I8P>(v[h * 8 + 0] * sX, v[h * 8 + 1] * sX, v[h * 8 + 2] * sX, v[h * 8 + 3] * sX); q8.y = pg8::pkq4<I8P>(v[h * 8 + 4] * sX, v[h * 8 + 5] * sX, v[h * 8 + 6] * sX, v[h * 8 + 7] * sX);
                *(u32x2*)(XI + (size_t)row * D + h * 512 + lane * 8) = q8; if (h == 0 && lane == 0) RS[row] = rsX; }
            if (out) { *(f32x4*)(out + (size_t)row * D + h * 512 + lane * 8) = (f32x4){v[h * 8 + 0], v[h * 8 + 1], v[h * 8 + 2], v[h * 8 + 3]};
                       *(f32x4*)(out + (size_t)row * D + h * 512 + lane * 8 + 4) = (f32x4){v[h * 8 + 4], v[h * 8 + 5], v[h * 8 + 6], v[h * 8 + 7]}; } }
    }
}

constexpr int RT_PITCH = 2064, R_OFF_G = 32 * RT_PITCH, R_OFF_LG = R_OFF_G + 8192, R_OFF_CNT = R_OFF_LG + 8 * 16 * 33 * 4, R_OFF_SW = R_OFF_CNT + 256, R_LDS = R_OFF_SW + 256;
typedef __bf16 bf16x2_t __attribute__((ext_vector_type(2)));
__device__ __forceinline__ void router_phase(const bf16_t* Yp, const float* g, const float* bta, const bf16_t* RTg, const float* Wr, const float* rb, unsigned char* X8, int* lslot, float* lgate, unsigned* cnt,
                                             char* lds, int blk0, int G, int tid, int wave, int lane) {
    for (int i = tid; i < 32 * 128; i += 512) { const int e = i >> 7, c = i & 127; *(v4u*)(lds + e * RT_PITCH + c * 16) = *(const v4u*)(RTg + (size_t)e * 1024 + c * 8); }
    float* gl = (float*)(lds + R_OFF_G); float* bl = gl + 1024;
    for (int i = tid; i < 1024; i += 512) { gl[i] = g[i]; bl[i] = bta[i]; }
    float* LG = (float*)(lds + R_OFF_LG) + wave * (16 * 33);
    int* lcnt = (int*)(lds + R_OFF_CNT); int* lbase = lcnt + 32;
    float* sWl = (float*)(lds + R_OFF_SW); float* cBl = sWl + 32;
    __syncthreads();
#pragma unroll 1
    for (int j = 0; j < 4; ++j) { const int e = wave * 4 + j; float a = 0.f, c = 0.f;
#pragma unroll 4
        for (int i = 0; i < 16; ++i) { const int k = lane + 64 * i; a += __uint_as_float((unsigned)(*(const bf16_t*)(lds + e * RT_PITCH + k * 2)) << 16); c += bl[k] * Wr[(size_t)k * 32 + e]; }
        a = wave_sum(a); c = wave_sum(c); if (lane == 0) { sWl[e] = a; cBl[e] = c + rb[e]; } }
    const int t16 = lane & 15, kq = lane >> 4;
    const float sA = F8MAX / ln_bound(g, bta, lane);
#pragma unroll 1
    for (int blk = blk0; blk < M / 128; blk += G) {
        if (tid < 32) lcnt[tid] = 0;
        __syncthreads();
        int my_e, my_rank, my_slot; float my_gate;
        const int r0 = blk * 128 + wave * 16; const size_t rowoff = (size_t)(r0 + t16) * D + kq * 8;
        v4u yv[32];
#pragma unroll
        for (int kb = 0; kb < 32; ++kb) yv[kb] = *(const v4u*)(Yp + rowoff + kb * 32);
        f32x4 acc0 = {0.f, 0.f, 0.f, 0.f}, acc1 = {0.f, 0.f, 0.f, 0.f}, accs = {0.f, 0.f, 0.f, 0.f}, accq = {0.f, 0.f, 0.f, 0.f};
        const bf16x8 ones8 = {(short)0x3F80, (short)0x3F80, (short)0x3F80, (short)0x3F80, (short)0x3F80, (short)0x3F80, (short)0x3F80, (short)0x3F80};
#pragma unroll
        for (int kb = 0; kb < 32; ++kb) { const int c0 = kb * 32 + kq * 8;
            const bf16x8 w0 = *(const bf16x8*)(lds + t16 * RT_PITCH + c0 * 2), w1 = *(const bf16x8*)(lds + (16 + t16) * RT_PITCH + c0 * 2);
            const bf16x8 xb = __builtin_bit_cast(bf16x8, yv[kb]);
            acc0 = __builtin_amdgcn_mfma_f32_16x16x32_bf16(w0, xb, acc0, 0, 0, 0);
            acc1 = __builtin_amdgcn_mfma_f32_16x16x32_bf16(w1, xb, acc1, 0, 0, 0);
            accs = __builtin_amdgcn_mfma_f32_16x16x32_bf16(ones8, xb, accs, 0, 0, 0);
            accq = __builtin_amdgcn_mfma_f32_16x16x32_bf16(xb, xb, accq, 0, 0, 0); }
        const float s = accs[0];
        const int dsel = t16 & 3; float dq_ = dsel == 0 ? accq[0] : (dsel == 1 ? accq[1] : (dsel == 2 ? accq[2] : accq[3]));
        const float s2 = __int_as_float(__builtin_amdgcn_ds_bpermute(((t16 >> 2) * 16 + t16) << 2, __float_as_int(dq_)));
        const float mean = s * (1.f / D); const float var = fmaxf(s2 * (1.f / D) - mean * mean, 0.f);
        const float rstd = 1.f / sqrtf(var + LN_EPS);
        {
            float* lgr = LG + t16 * 33;
#pragma unroll
            for (int i = 0; i < 4; ++i) { const int e0 = kq * 4 + i, e1 = 16 + kq * 4 + i;
                lgr[e0] = rstd * (acc0[i] - mean * sWl[e0]) + cBl[e0]; lgr[e1] = rstd * (acc1[i] - mean * sWl[e1]) + cBl[e1]; }
            LDS_WAIT(); asm volatile("" ::: "memory");
            float t0 = -INFINITY, t1 = -INFINITY, t2 = -INFINITY, t3 = -INFINITY; int i0 = 0, i1 = 0, i2 = 0, i3 = 0;
#pragma unroll
            for (int e = 0; e < 32; ++e) { const float v = lgr[e];
                const bool c0 = v > t0, c1 = v > t1, c2 = v > t2, c3 = v > t3;
                t3 = c2 ? t2 : (c3 ? v : t3); i3 = c2 ? i2 : (c3 ? e : i3);
                t2 = c1 ? t1 : (c2 ? v : t2); i2 = c1 ? i1 : (c2 ? e : i2);
                t1 = c0 ? t0 : (c1 ? v : t1); i1 = c0 ? i0 : (c1 ? e : i1);
                t0 = c0 ? v : t0; i0 = c0 ? e : i0; }
            const float e1 = __expf(t1 - t0), e2 = __expf(t2 - t0), e3 = __expf(t3 - t0); const float inv = 1.f / (1.f + e1 + e2 + e3);
            const int ek = kq == 0 ? i0 : (kq == 1 ? i1 : (kq == 2 ? i2 : i3)); const float gk = (kq == 0 ? 1.f : (kq == 1 ? e1 : (kq == 2 ? e2 : e3))) * inv;
            my_e = ek; my_gate = gk; my_slot = (r0 + t16) * 4 + kq; my_rank = atomicAdd(&lcnt[ek], 1);
            LDS_WAIT(); asm volatile("" ::: "memory");
        }
        const float rs = rstd * sA;
#pragma unroll
        for (int kb = 0; kb < 32; ++kb) { const int c0 = kb * 32 + kq * 8; const v4u y = yv[kb];
            const f32x4 g0 = *(const f32x4*)(gl + c0) * rs, g1 = *(const f32x4*)(gl + c0 + 4) * rs, b0 = *(const f32x4*)(bl + c0) * sA, b1 = *(const f32x4*)(bl + c0 + 4) * sA;
            typedef unsigned u32x2 __attribute__((ext_vector_type(2))); u32x2 q8;
            q8.x = pg8::pk4_fp8((bf_lo(y.x) - mean) * g0[0] + b0[0], (bf_hi(y.x) - mean) * g0[1] + b0[1], (bf_lo(y.y) - mean) * g0[2] + b0[2], (bf_hi(y.y) - mean) * g0[3] + b0[3]);
            q8.y = pg8::pk4_fp8((bf_lo(y.z) - mean) * g1[0] + b1[0], (bf_hi(y.z) - mean) * g1[1] + b1[1], (bf_lo(y.w) - mean) * g1[2] + b1[2], (bf_hi(y.w) - mean) * g1[3] + b1[3]);
            *(u32x2*)(X8 + rowoff + kb * 32) = q8;
            asm volatile("" ::: "memory"); }
        __syncthreads();
        if (tid < 32) lbase[tid] = (int)__hip_atomic_fetch_add(cnt + tid * 64, (unsigned)lcnt[tid], RLX_AGENT);
        __syncthreads();
        { const int pos = lbase[my_e] + my_rank; lslot[(size_t)my_e * LCAP + pos] = my_slot; lgate[(size_t)my_e * LCAP + pos] = my_gate; }
        __syncthreads();
    }
}

__device__ __forceinline__ float attn_obound(const float* gsub, float osc, int lane) {
    float mg = fmaxf(fabsf(gsub[lane]), fabsf(gsub[64 + lane]));
#pragma unroll
    for (int o = 1; o < 64; o <<= 1) mg = fmaxf(mg, shx(mg, o));
    return 11.3137085f * mg * fabsf(osc);
}

constexpr int NWAVES = 8;
constexpr int N_PHASES = 1 + DEPTH * 7;
#ifndef REP_ATTN
#define REP_ATTN 1
#endif
#ifndef KREP_MOE
#define KREP_MOE 1
#endif
#ifndef REP_MOE
#define REP_MOE 1
#endif
#ifndef REP_P0
#define REP_P0 1
#endif
#ifndef REP_THIN
#define REP_THIN 1
#endif
#ifndef REP_DENSE
#define REP_DENSE 1
#endif
#ifndef MK_SPLIT
#define MK_SPLIT 0
#endif
struct Args { const float* in[17]; float* out; unsigned char* ws; int ph_lo, ph_hi, li, pad; };
typedef const __attribute__((address_space(4))) Args* ArgsP;
enum { I_X = 0, I_RELB, I_AWIN, I_ALAM, I_ASUB, I_AWOUT, I_CWIN, I_CW, I_CWOUT, I_RW, I_RB, I_W1, I_B1, I_W2, I_B2, I_LNG, I_LNB };
__global__ void __launch_bounds__(NWAVES * 64, 2) mk_fwd(Args args) {
    extern __shared__ __attribute__((aligned(16))) unsigned char lds[];
    LAS unsigned char* ldsl = (LAS unsigned char*)lds;
    volatile LAS unsigned* MISC = (volatile LAS unsigned*)(ldsl + MISC_OFF);
    const int tid0 = threadIdx.x;
    const int wave0 = __builtin_amdgcn_readfirstlane(tid0 >> 6);
    const int G0 = gridDim.x, bx0 = blockIdx.x;
#define PHASE_BEGIN() int wv_ = wave0; asm volatile("" : "+s"(wv_)); int ln_; asm volatile("v_mbcnt_lo_u32_b32 %0, -1, 0\n\tv_mbcnt_hi_u32_b32 %0, -1, %0" : "=v"(ln_)); int tid = wv_ * 64 + ln_; int G = G0, bx = bx0; asm volatile("" : "+s"(G), "+s"(bx)); const int vcu = (G % 8 == 0) ? (bx % 8) * (G / 8) + bx / 8 : bx; const int NGW = G * NWAVES; \
        const int lane = tid & 63, wave = __builtin_amdgcn_readfirstlane(tid >> 6); const int gw = vcu * NWAVES + wave; (void)lane; (void)gw; (void)NGW; \
        ArgsP ap = (ArgsP)__builtin_amdgcn_kernarg_segment_ptr(); asm volatile("" : "+s"(ap)); unsigned char* ws = ap->ws; gu32* ctl = (gu32*)(ws + WS_CTL); (void)ctl
    for (int u = tid0; u < (LDS_BYTES - LDSCTL_OFF) / 4; u += NWAVES * 64) ((LAS unsigned*)(ldsl + LDSCTL_OFF))[u] = 0u;
    __syncthreads();
    XcdBarrier bar = xcd_barrier_post((unsigned*)(args.ws + WS_CTL) + CW_BAR + (size_t)args.li * 4096, MISC + 8);
    const int lo = args.ph_lo, hi = args.ph_hi;
#define IN(k) (lo <= (k) && (k) < hi)
#define SEAM(k) do { if (IN((k) + 1)) xcd_barrier(bar); } while (0)
    LAS int* tb = (LAS int*)(ldsl + LDSCTL_OFF); LAS int* cn = tb + 64;

    if (IN(0)) { PHASE_BEGIN();
        Ptrs P; P.x = ap->in[I_X]; P.attn_w_in = ap->in[I_AWIN]; P.attn_w_out = ap->in[I_AWOUT]; P.conv_w_in = ap->in[I_CWIN]; P.conv_w_out = ap->in[I_CWOUT]; P.router_w = ap->in[I_RW]; P.ln_g = ap->in[I_LNG]; P.w1 = ap->in[I_W1]; P.w2 = ap->in[I_W2]; P.ws = ws;
        _Pragma("unroll 1") for (int rep = 0; rep < REP_P0; ++rep) p0_prologue(P, ldsl, gw, NGW, wave, lane); SEAM(0); }

#define MOE_GEMMS(L, pb) do { \
            if (IN((pb) + 4)) { PHASE_BEGIN(); \
                pg8::MoeProb<true, true> S{(const char*)(ws + WS_X8), (const char*)(ws + WS_W1) + (size_t)(L) * 32 * 2048 * 1024, (size_t)2048 * 1024, 8, G, vcu, (int)tb[32], tb, cn, (const int*)(ws + WS_LS), lane, tid}; \
                pg8::EpiMoe1 E{ws + WS_A2, ap->in[I_B1] + (size_t)(L) * 32 * 2048, (const float*)(ws + WS_S1) + (size_t)(L) * 32 * 2048, ln_bound(ap->in[I_LNG] + ((L) * 2 + 0) * D, ap->in[I_LNB] + ((L) * 2 + 0) * D, lane) * (1.0f / F8MAX) * (1.0f / KREP_MOE)}; \
                pg8::gemm_phase<pg8::MoeProb<true, true>, pg8::EpiMoe1, true, true, KREP_MOE>(ldsl + RING_OFF, ldsl + XL_OFF, S, E); \
                SEAM((pb) + 4); \
            } \
            if (IN((pb) + 5)) { PHASE_BEGIN(); \
                pg8::MoeProb<false, true> S{(const char*)(ws + WS_A2), (const char*)(ws + WS_W2) + (size_t)(L) * 32 * 1024 * 1024, (size_t)1024 * 1024, 4, G, vcu, (int)tb[32], tb, cn, (const int*)(ws + WS_LS), lane, tid}; \
                pg8::EpiMoe2 E{ws + WS_Y, ap->in[I_B2] + (size_t)(L) * 32 * 1024, (const float*)(ws + WS_S2) + (size_t)(L) * 32 * 1024, (const int*)(ws + WS_LS), (const float*)(ws + WS_LG)}; \
                pg8::gemm_phase<pg8::MoeProb<false, true>, pg8::EpiMoe2, true, true, KREP_MOE>(ldsl + RING_OFF, ldsl + XL_OFF, S, E); \
                SEAM((pb) + 5); \
            } \
        } while (0)
#if REP_MOE == 2
#define MOE_GEMMS_REP(L, pb) MOE_GEMMS(L, pb)
#else
#define MOE_GEMMS_REP(L, pb) do {} while (0)
#endif
#define MOE_HALF(L, pb) do { \
            if (IN((pb) + 3)) { PHASE_BEGIN(); \
                router_phase((const bf16_t*)(ws + WS_YP), ap->in[I_LNG] + ((L) * 2 + 0) * D, ap->in[I_LNB] + ((L) * 2 + 0) * D, (const bf16_t*)(ws + WS_WR) + (size_t)(L) * 32 * 1024, ap->in[I_RW] + (size_t)(L) * 1024 * 32, ap->in[I_RB] + (L) * 32, \
                             ws + WS_X8, (int*)(ws + WS_LS), (float*)(ws + WS_LG), (unsigned*)(ctl + CW_CNT) + (L) * 32 * 64, (char*)lds + RING_OFF, vcu, G, tid, wave, lane); \
                SEAM((pb) + 3); \
            } \
            if (IN((pb) + 4) || IN((pb) + 5)) { PHASE_BEGIN(); \
                if (tid < 64) { const int c_ = (lane < 32) ? (int)__hip_atomic_load(ctl + CW_CNT + ((L) * 32 + (lane & 31)) * 64, RLX_AGENT) : 0; const int t_ = (c_ + 255) >> 8; int p_ = t_; \
                    _Pragma("unroll") for (int o_ = 1; o_ < 32; o_ <<= 1) { const int q_ = __builtin_amdgcn_ds_bpermute((lane - o_) * 4, p_); if (lane >= o_) p_ += q_; } \
                    if (lane < 32) { cn[lane] = c_; tb[lane + 1] = p_; } if (lane == 0) tb[0] = 0; } \
                __syncthreads(); \
            } \
            MOE_GEMMS(L, pb); MOE_GEMMS_REP(L, pb); \
            if (REP_THIN == 2 && IN((pb) + 6)) { PHASE_BEGIN(); \
                ln2_phase((const bf16_t*)(ws + WS_YP), ap->in[I_LNG] + ((L) * 2 + 0) * D, ap->in[I_LNB] + ((L) * 2 + 0) * D, (const unsigned char*)(ws + WS_Y), ap->in[I_LNG] + ((L) * 2 + 1) * D, ap->in[I_LNB] + ((L) * 2 + 1) * D, (bf16_t*)(ws + WS_XB), ((L) == DEPTH - 1) ? ap->out : nullptr, ((((L) == 0) && (CM & 1)) || (((L) == 1) && (QM & 2)) || (((L) == 2) && (CM & 2))) ? ws + WS_XI : nullptr, (float*)(ws + WS_RS), gw, NGW, lane); \
            } \
            if (IN((pb) + 6)) { PHASE_BEGIN(); \
                ln2_phase((const bf16_t*)(ws + WS_YP), ap->in[I_LNG] + ((L) * 2 + 0) * D, ap->in[I_LNB] + ((L) * 2 + 0) * D, (const unsigned char*)(ws + WS_Y), ap->in[I_LNG] + ((L) * 2 + 1) * D, ap->in[I_LNB] + ((L) * 2 + 1) * D, (bf16_t*)(ws + WS_XB), ((L) == DEPTH - 1) ? ap->out : nullptr, ((((L) == 0) && (CM & 1)) || (((L) == 1) && (QM & 2)) || (((L) == 2) && (CM & 2))) ? ws + WS_XI : nullptr, (float*)(ws + WS_RS), gw, NGW, lane); \
                if ((pb) + 7 < N_PHASES) SEAM((pb) + 6); \
            } \
        } while (0)

#pragma unroll 1
    for (int lp = 0; lp < DEPTH / 2; ++lp) {
        {
            const int L = 2 * lp, pb = 1 + L * 7;
            if (IN(pb + 0)) {
                PHASE_BEGIN();
                if (QM == 3 || (QM != 0 && ((QM >> lp) & 1))) {
                pg8::DenseProbT<true> S; S.init(ws + WS_XI, ws + WS_WAI + (size_t)lp * 3072 * 1024, M, 3072, G, bx, tid);
                pg8::EpiQKV8 E{(bf16_t*)(ws + WS_Q), (size_t)(WS_K - WS_Q) / 2, QSCALE, (const float*)(ws + WS_SD) + lp * 3072, (const float*)(ws + WS_RS)};
                pg8::gemm_phase<pg8::DenseProbT<true>, pg8::EpiQKV8, true, true, 1, I8P>(ldsl + RING_OFF, ldsl + XL_OFF, S, E);
                } else {
                pg8::DenseProb S; S.init(ws + WS_XB, (const bf16_t*)(ws + WS_WA16) + (size_t)lp * 3072 * 1024, M, 3072, G, bx, tid);
                pg8::EpiQKV E{(bf16_t*)(ws + WS_Q), (size_t)(WS_K - WS_Q) / 2, QSCALE};
                pg8::gemm_phase<pg8::DenseProb, pg8::EpiQKV, true>(ldsl + RING_OFF, ldsl + XL_OFF, S, E);
                }
                SEAM(pb + 0);
            }
            if (IN(pb + 1)) {
                PHASE_BEGIN();
                const float* lf = ap->in[I_ALAM] + lp * 256;
                const float s1 = wave_sum(lf[lane] * lf[64 + lane]), s2 = wave_sum(lf[128 + lane] * lf[192 + lane]);
                const float lam_init = (lp == 0) ? 0.2f : (0.8f - 0.6f * 0.54881163609402643f);
                const float lam = __expf(s1) - __expf(s2) + lam_init;
                const bool o8 = (AOM == 3) || (AOM != 0 && ((AOM >> lp) & 1));
                const float oscl = o8 ? (1.0f - lam_init) * (F8MAX / attn_obound(ap->in[I_ASUB] + lp * 128, 1.0f - lam_init, lane)) : (1.0f - lam_init);
                int hprev = -1; bool strips_done = !(DEFER_W && lp == 0);
#pragma unroll 1
                for (int rep = 0; rep < REP_ATTN; ++rep)
#pragma unroll 1
                for (int i = 0; i < (BATCH * NH * 32) / 256; ++i) {
                    const int item = i * G + vcu;
                    if (item >= BATCH * NH * 32) break;
                    const int bh = item >> 5, qb = item & 31;
                    const bool newh = (i == 0) || ((bh & 7) != hprev); hprev = bh & 7;
                    att::attn_unit(bh >> 3, bh & 7, qb, (const bf16_t*)(ws + WS_Q), (const bf16_t*)(ws + WS_K), (const bf16_t*)(ws + WS_V), (bf16_t*)(ws + WS_O), lam, oscl,
                                   ap->in[I_ASUB] + lp * 128, ap->in[I_RELB], (char*)lds + RING_OFF, tid, newh, o8);
                    if (!strips_done && i == (vcu & 15)) { strips_done = true;
                        Ptrs P; P.w1 = ap->in[I_W1]; P.w2 = ap->in[I_W2]; P.ws = ws;
                        int ln_s = lane; asm volatile("" : "+v"(ln_s));
                        deferred_strips(P.w1, P.w2, ws, ldsl, vcu, G, wave, ln_s);
                        hprev = -1;
                    }
                }
                if (!strips_done) { int ln_s = lane; asm volatile("" : "+v"(ln_s)); deferred_strips(ap->in[I_W1], ap->in[I_W2], ws, ldsl, vcu, G, wave, ln_s); }
                SEAM(pb + 1);
            }
            if (IN(pb + 2)) {
                PHASE_BEGIN();
                if ((AOM == 3) || (AOM != 0 && ((AOM >> lp) & 1))) {
                const float lam_init = (lp == 0) ? 0.2f : (0.8f - 0.6f * 0.54881163609402643f);
                pg8::DenseProbT<true> S; S.init(ws + WS_O, ws + WS_WAO8 + (size_t)lp * 1024 * 1024, M, 1024, G, bx, tid);
                pg8::EpiResid8<false> E{(const bf16_t*)(ws + WS_XB), (bf16_t*)(ws + WS_YP), (const float*)(ws + WS_SD + 24 * 1024) + lp * 1024, nullptr, attn_obound(ap->in[I_ASUB] + lp * 128, 1.0f - lam_init, lane) * (1.0f / F8MAX)};
                pg8::gemm_phase<pg8::DenseProbT<true>, pg8::EpiResid8<false>, true, true>(ldsl + RING_OFF, ldsl + XL_OFF, S, E);
                } else {
                pg8::DenseProb S; S.init(ws + WS_O, (const bf16_t*)(ws + WS_WAO) + (size_t)lp * 1024 * 1024, M, 1024, G, bx, tid);
                pg8::EpiResid E{(const bf16_t*)(ws + WS_XB), (bf16_t*)(ws + WS_YP)};
                pg8::gemm_phase<pg8::DenseProb, pg8::EpiResid, true>(ldsl + RING_OFF, ldsl + XL_OFF, S, E);
                }
                SEAM(pb + 2);
            }
            MOE_HALF(L, pb);
        }
        {
            const int L = 2 * lp + 1, pb = 1 + L * 7;
            if (IN(pb + 0)) {
                PHASE_BEGIN();
                if (CM == 3 || (CM != 0 && ((CM >> lp) & 1))) {
                pg8::DenseProbT<true> S; S.init(ws + WS_XI, ws + WS_WCI + (size_t)lp * 3072 * 1024, M, 3072, G, bx, tid);
                pg8::EpiConvIn8 E{(bf16_t*)(ws + WS_Q), (bf16_t*)(ws + WS_K), (const float*)(ws + WS_SD + 32 * 1024) + lp * 3072, (const float*)(ws + WS_RS)};
                pg8::gemm_phase<pg8::DenseProbT<true>, pg8::EpiConvIn8, true, true, 1, I8P>(ldsl + RING_OFF, ldsl + XL_OFF, S, E);
                } else {
                pg8::DenseProb S; S.init(ws + WS_XB, (const bf16_t*)(ws + WS_WC16) + (size_t)lp * 3072 * 1024, M, 3072, G, bx, tid);
                pg8::EpiConvIn E{(bf16_t*)(ws + WS_Q), (bf16_t*)(ws + WS_K)};
                pg8::gemm_phase<pg8::DenseProb, pg8::EpiConvIn, true>(ldsl + RING_OFF, ldsl + XL_OFF, S, E);
                }
                SEAM(pb + 0);
            }
            if (IN(pb + 1)) { PHASE_BEGIN(); conv_phase((const bf16_t*)(ws + WS_Q), (const bf16_t*)(ws + WS_K), ap->in[I_CW] + lp * 3 * D, (bf16_t*)(ws + WS_O), (float*)(ws + WS_RS), (COM == 3) || (COM != 0 && ((COM >> lp) & 1)), gw, NGW, lane); SEAM(pb + 1); }
            if (IN(pb + 2)) {
                PHASE_BEGIN();
                if ((COM == 3) || (COM != 0 && ((COM >> lp) & 1))) {
                pg8::DenseProbT<true> S; S.init(ws + WS_O, ws + WS_WCO8 + (size_t)lp * 1024 * 1024, M, 1024, G, bx, tid);
                pg8::EpiResid8<true> E{(const bf16_t*)(ws + WS_XB), (bf16_t*)(ws + WS_YP), (const float*)(ws + WS_SD + 56 * 1024) + lp * 1024, (const float*)(ws + WS_RS), 1.0f};
                pg8::gemm_phase<pg8::DenseProbT<true>, pg8::EpiResid8<true>, true, true, 1, I8P>(ldsl + RING_OFF, ldsl + XL_OFF, S, E);
                } else {
                pg8::DenseProb S; S.init(ws + WS_O, (const bf16_t*)(ws + WS_WCO) + (size_t)lp * 1024 * 1024, M, 1024, G, bx, tid);
                pg8::EpiResid E{(const bf16_t*)(ws + WS_XB), (bf16_t*)(ws + WS_YP)};
                pg8::gemm_phase<pg8::DenseProb, pg8::EpiResid, true>(ldsl + RING_OFF, ldsl + XL_OFF, S, E);
                }
                SEAM(pb + 2);
            }
            MOE_HALF(L, pb);
        }
    }
#undef IN
#undef SEAM
}

extern "C" void kernel_launch(void* const* d_in, const int* in_sizes, int n_in, void* d_out, int out_size, void* d_ws, size_t ws_size, hipStream_t stream) {
    static int grid = 0;
    if (grid == 0) {
        if (n_in != 17 || in_sizes[0] != M * D || out_size != M * D || ws_size < WS_END) {
            fprintf(stderr, "kernel_launch: shape mismatch: n_in %d in0 %d out %d ws %zu (need %zu)\n", n_in, n_in > 0 ? in_sizes[0] : -1, out_size, ws_size, (size_t)WS_END); grid = -1; return; }
        int dev = 0, cus = 0, per_cu = 0;
        if (hipGetDevice(&dev) != hipSuccess || hipDeviceGetAttribute(&cus, hipDeviceAttributeMultiprocessorCount, dev) != hipSuccess) { grid = -1; return; }
        if (hipFuncSetAttribute((const void*)mk_fwd, hipFuncAttributeMaxDynamicSharedMemorySize, LDS_BYTES) != hipSuccess) { fprintf(stderr, "kernel_launch: hipFuncSetAttribute failed\n"); grid = -1; return; }
        if (hipOccupancyMaxActiveBlocksPerMultiprocessor(&per_cu, (const void*)mk_fwd, NWAVES * 64, LDS_BYTES) != hipSuccess || per_cu < 1)
            fprintf(stderr, "kernel_launch: occupancy query reports %d workgroups per CU\n", per_cu);
        (void)hipGetLastError();
        grid = cus;
    }
    if (grid < 0) return;
    if (hipMemsetAsync((char*)d_ws + WS_CTL, 0, CTL_ZERO_BYTES, stream) != hipSuccess) { fprintf(stderr, "kernel_launch: memset failed\n"); return; }
    Args a{};
    for (int i = 0; i < 17; ++i) a.in[i] = (const float*)d_in[i];
    a.out = (float*)d_out; a.ws = (unsigned char*)d_ws; a.pad = 0;
#if MK_SPLIT
    for (int p = 0; p < N_PHASES; ++p) { a.ph_lo = p; a.ph_hi = p + 1; a.li = p; hipLaunchKernelGGL(mk_fwd, dim3(grid), dim3(NWAVES * 64), LDS_BYTES, stream, a); }
#else
    a.ph_lo = 0; a.ph_hi = N_PHASES; a.li = 0;
    hipLaunchKernelGGL(mk_fwd, dim3(grid), dim3(NWAVES * 64), LDS_BYTES, stream, a);
#endif
    const hipError_t le = hipPeekAtLastError();
    if (le != hipSuccess) fprintf(stderr, "kernel_launch: launch failed: %s\n", hipGetErrorName(le));
}
```

```cpp
#include <hip/hip_runtime.h>
#include <hip/hip_bf16.h>
#include <cstdio>
#include <cstdint>

constexpr int BATCH = 16, SEQ = 4096, D = 1024, M = BATCH * SEQ, DEPTH = 4, NH = 8, NE = 32, TOPK = 4;
constexpr float LN_EPS = 1e-5f;
constexpr float ALPHA = 1.6817928305074290f;
constexpr float LOG2E = 1.4426950408889634f;
constexpr float QSCALE = 0.125f * LOG2E;
constexpr int LCAP = 65536;
constexpr int MAXRT = 1056;

constexpr size_t MiB = 1ull << 20;
constexpr size_t WS_CTL = 0, CTL_ZERO_BYTES = 1 * MiB;
constexpr size_t WS_WAI = 1 * MiB;
constexpr size_t WS_WAO = WS_WAI + 12 * MiB;
constexpr size_t WS_WCI = WS_WAO + 4 * MiB;
constexpr size_t WS_WCO = WS_WCI + 12 * MiB;
constexpr size_t WS_WR  = WS_WCO + 4 * MiB;
constexpr size_t WS_W1  = WS_WR + 1 * MiB;
constexpr size_t WS_W2  = WS_W1 + 256 * MiB;
constexpr size_t WS_S1  = WS_W2 + 128 * MiB;
constexpr size_t WS_S2  = WS_S1 + 1 * MiB;
constexpr size_t WS_SD  = WS_S2 + 512 * 1024;
constexpr size_t WS_RS  = WS_SD + 64 * 1024;
constexpr size_t WS_XB  = WS_S2 + 1 * MiB;
constexpr size_t WS_XI  = WS_XB + 128 * MiB;
constexpr size_t WS_X8  = WS_XI + 128 * MiB;
constexpr size_t WS_YP  = WS_X8 + 64 * MiB;
constexpr size_t WS_Q   = WS_YP + 128 * MiB;
constexpr size_t WS_K   = WS_Q + 128 * MiB;
constexpr size_t WS_V   = WS_K + 128 * MiB;
constexpr size_t WS_O   = WS_V + 128 * MiB;
constexpr size_t WS_LS  = WS_O + 128 * MiB;
constexpr size_t WS_LG  = WS_LS + 8 * MiB;
constexpr size_t WS_A2  = WS_LG + 8 * MiB;
constexpr size_t WS_Y   = WS_A2 + 264 * MiB;
constexpr size_t WS_WA16 = WS_Y + 513 * MiB;
constexpr size_t WS_WC16 = WS_WA16 + 12 * MiB;
constexpr size_t WS_WAO8 = WS_WC16 + 12 * MiB;
constexpr size_t WS_WCO8 = WS_WAO8 + 2 * MiB;
constexpr size_t WS_END = WS_WCO8 + 2 * MiB;
#ifndef F8_QKV_MASK
#define F8_QKV_MASK 3
#endif
#ifndef F8_CONV_MASK
#define F8_CONV_MASK 3
#endif
#ifndef F8_AOUT_MASK
#define F8_AOUT_MASK 3
#endif
#ifndef F8_COUT_MASK
#define F8_COUT_MASK 3
#endif
constexpr int QM = F8_QKV_MASK, CM = F8_CONV_MASK, AOM = F8_AOUT_MASK, COM = F8_COUT_MASK;
constexpr int NA8 = (AOM & 1) + (AOM >> 1), NO8 = (COM & 1) + (COM >> 1), AJ0 = (AOM & 1) ? 0 : 1, OJ0 = (COM & 1) ? 0 : 1;
constexpr int NA16 = 2 - NA8, NO16 = 2 - NO8, AK0 = (AOM & 1) ? 1 : 0, OK0 = (COM & 1) ? 1 : 0;
constexpr int NQ8 = (QM & 1) + (QM >> 1), NC8 = (CM & 1) + (CM >> 1), QJ0 = (QM & 1) ? 0 : 1, CJ0 = (CM & 1) ? 0 : 1;
constexpr int NQ16 = 2 - NQ8, NC16 = 2 - NC8, QK0 = (QM & 1) ? 1 : 0, CK0 = (CM & 1) ? 1 : 0;
constexpr float F8MAX = 448.0f * 0.999f;
constexpr bool I8P = true;
constexpr float QMAXP = I8P ? 127.0f : 448.0f * 0.999f;
constexpr float YSCALE = 16.0f;
constexpr float A2SCALE = 8.0f;
constexpr int CW_TMO = 0, CW_CODE = 1;
constexpr int CW_BAR = 4096;
constexpr int CW_CNT = 16384;

constexpr int RING_OFF = 0, RING_BYTES = 131072;
constexpr int LDSCTL_OFF = RING_BYTES, MISC_OFF = LDSCTL_OFF + 1024;
constexpr int XL_OFF = LDSCTL_OFF + 4096;
constexpr int LDS_BYTES = 147456;

#define GAS __attribute__((address_space(1)))
#define LAS __attribute__((address_space(3)))
typedef unsigned short bf16_t;
typedef unsigned v4u __attribute__((ext_vector_type(4)));
typedef float f32x4 __attribute__((ext_vector_type(4)));
typedef float f32x2 __attribute__((ext_vector_type(2)));
typedef short bf16x8 __attribute__((ext_vector_type(8)));
typedef float f32x16 __attribute__((ext_vector_type(16)));
typedef short s16x4 __attribute__((ext_vector_type(4)));
typedef GAS unsigned gu32;
#define RLX_AGENT __ATOMIC_RELAXED, __HIP_MEMORY_SCOPE_AGENT
#define LDS_WAIT() asm volatile("s_waitcnt lgkmcnt(0)" ::: "memory")
#define VM_WAIT() asm volatile("s_waitcnt vmcnt(0)" ::: "memory")

__device__ __forceinline__ unsigned cvt_pk_bf16(float lo, float hi) { unsigned r; asm volatile("v_cvt_pk_bf16_f32 %0, %1, %2" : "=v"(r) : "v"(lo), "v"(hi)); return r; }
__device__ __forceinline__ float bf_lo(unsigned u) { return __uint_as_float(u << 16); }
__device__ __forceinline__ float bf_hi(unsigned u) { return __uint_as_float(u & 0xffff0000u); }
__device__ __forceinline__ int lane_local() { int l; asm volatile("v_mbcnt_lo_u32_b32 %0, -1, 0\n\tv_mbcnt_hi_u32_b32 %0, -1, %0" : "=v"(l)); return l; }
__device__ __forceinline__ float shx(float v, int m, int l) { return __int_as_float(__builtin_amdgcn_ds_bpermute((l ^ m) << 2, __float_as_int(v))); }
__device__ __forceinline__ float shx(float v, int m) { return shx(v, m, lane_local()); }
__device__ __forceinline__ float wave_sum(float v) {
    const int l_ = lane_local();
#pragma unroll
    for (int o = 1; o < 64; o <<= 1) v += shx(v, o, l_);
    return v;
}

#ifndef KREP_MOE
#define KREP_MOE 1
#endif
namespace pg8 {
constexpr float KREP_MOE_ = (float)KREP_MOE;
#define PG8_LAS __attribute__((address_space(3)))
constexpr int BM = 256, BK = 64, HALF = 128, HTB = HALF * BK * 2, STAGE_BYTES = 8 * HTB, NXCD = 8, WGM = 8, KD = 1024, NTK = KD / BK;

__host__ __device__ __forceinline__ int lds_byte(int r, int c) { const int st = (r >> 4) * 2 + (c >> 5), rr = r & 15, cc = c & 31, ob = rr * 64 + cc * 2; return st * 1024 + (ob ^ (((ob >> 9) & 1) << 5)); }
__host__ __device__ __forceinline__ void stage_rc(int b, int& R, int& C) { const int st = b / 1024, sb = b % 1024, swz = sb ^ (((sb >> 9) & 1) << 5); R = (st >> 1) * 16 + swz / 64; C = (st & 1) * 32 + (swz % 64) / 2; }
__host__ __device__ __forceinline__ int perm32(int rho) { const int n = rho >> 4, i = rho & 15; return 8 * (i >> 2) + 4 * n + (i & 3); }

struct Unit { int pm, pn, e, valid, lr0; };
__device__ __forceinline__ void dma1k(const void* src, PG8_LAS unsigned char* dst, int lane) {
    __builtin_amdgcn_global_load_lds((const __attribute__((address_space(1))) unsigned*)((const char*)src + lane * 16), (PG8_LAS unsigned*)dst, 16, 0, 0);
}
constexpr int XL_EPI = 4096, XL_GATHER = 1024, XL_BYTES = 2 * (XL_EPI + XL_GATHER);

template <bool F8> struct DenseProbT {
    static constexpr bool GATHER = false;
    static constexpr int RP = F8 ? 1024 : 2048;
    const char* A; const char* Bt; int nM, nN, nwg, G, c, tid;
    __device__ void init(const void* A_, const void* Bt_, int Mrows, int N, int G_, int c_, int tid_) { A = (const char*)A_; Bt = (const char*)Bt_; nM = Mrows / BM; nN = N / BM; nwg = nM * nN; G = G_; c = c_; tid = tid_; }
    __device__ __forceinline__ bool next(int i, Unit& u) const {
        const long L = (long)i * G + c; if (L >= nwg) return false;
        int wgid = (int)L; { const int q = nwg / NXCD, r = nwg % NXCD, xcd = wgid % NXCD, off = wgid / NXCD; wgid = (xcd < r ? xcd * (q + 1) : r * (q + 1) + (xcd - r) * q) + off; }
        const int nig = WGM * nN, gid = wgid / nig, fm = gid * WGM, gsz = (nM - fm) < WGM ? (nM - fm) : WGM;
        u.pm = fm + ((wgid % nig) % gsz); u.pn = (wgid % nig) / gsz; u.e = 0; u.valid = 256; u.lr0 = 0; return true;
    }
    __device__ __forceinline__ void a_off(const Unit& u, const int (&RA)[2], const int (&CA)[2], unsigned (&vo)[2][2]) const {
#pragma unroll
        for (int h = 0; h < 2; ++h)
#pragma unroll
            for (int i = 0; i < 2; ++i) vo[h][i] = (unsigned)((u.pm * BM + h * HALF + RA[i]) * RP + CA[i] * 2);
    }
    __device__ __forceinline__ unsigned a_tile(const Unit& u) const { return (unsigned)u.pm * (unsigned)(BM * RP); }
    __device__ __forceinline__ unsigned b_off(const Unit& u) const { return (unsigned)u.pn * (unsigned)(BM * RP); }    __device__ __forceinline__ void dma_rows(const Unit&, PG8_LAS unsigned char*, int, int) const {}
    __device__ __forceinline__ void a_off_lds(const Unit&, const int (&)[2], const int (&)[2], const PG8_LAS unsigned char*, unsigned (&)[2][2]) const {}
};
typedef DenseProbT<false> DenseProb;

template <bool GATHER_, bool F8> struct MoeProb {
    static constexpr bool GATHER = GATHER_;
    static constexpr int RP = F8 ? 1024 : 2048;
    const char* A; const char* Bt; size_t b_estride; int nN, G, v, RT; const PG8_LAS int* tb; const PG8_LAS int* cn; const int* lslot; int lane, tid;
    __device__ __forceinline__ bool next(int i, Unit& u) const {
        const int L = i * G + v; if (L >= RT * nN) return false;
        const int rt = L / nN; u.pm = rt; u.pn = L - rt * nN;
        const unsigned long long bal = __ballot(lane < 32 && rt >= tb[(lane & 31) + 1]);
        const int e = __builtin_amdgcn_readfirstlane(__popcll(bal)); u.e = e;
        const int tb_e = __builtin_amdgcn_readfirstlane(tb[e]), cn_e = __builtin_amdgcn_readfirstlane(cn[e]);
        u.lr0 = 256 * (rt - tb_e); const int rem = cn_e - u.lr0; u.valid = rem < 256 ? rem : 256; return true;
    }
    __device__ __forceinline__ void a_off(const Unit& u, const int (&RA)[2], const int (&CA)[2], unsigned (&vo)[2][2]) const {
        if constexpr (GATHER) {
            const int* ls = lslot + (size_t)u.e * LCAP + u.lr0;
#pragma unroll
            for (int h = 0; h < 2; ++h)
#pragma unroll
                for (int i = 0; i < 2; ++i) { const int rl = h * HALF + RA[i]; const int slot = ls[rl < u.valid ? rl : 0]; vo[h][i] = (unsigned)((slot >> 2) * RP + CA[i] * 2); }
        } else {
#pragma unroll
            for (int h = 0; h < 2; ++h)
#pragma unroll
                for (int i = 0; i < 2; ++i) vo[h][i] = (unsigned)((u.pm * BM + h * HALF + RA[i]) * RP + CA[i] * 2);
        }
    }
    __device__ __forceinline__ unsigned a_tile(const Unit& u) const { return (unsigned)u.pm * (unsigned)(BM * RP); }
    __device__ __forceinline__ unsigned b_off(const Unit& u) const { return (unsigned)u.e * (unsigned)b_estride + (unsigned)u.pn * (unsigned)(BM * RP); }
    __device__ __forceinline__ void dma_rows(const Unit& u, PG8_LAS unsigned char* dst, int wid, int lane_) const { if constexpr (GATHER) { if (wid == 0) dma1k(lslot + (size_t)u.e * LCAP + u.lr0, dst, lane_); } }
    __device__ __forceinline__ void a_off_lds(const Unit& u, const int (&RA)[2], const int (&CA)[2], const PG8_LAS unsigned char* src, unsigned (&vo)[2][2]) const {
        if constexpr (GATHER) { const PG8_LAS int* ls = (const PG8_LAS int*)src;
#pragma unroll
            for (int h = 0; h < 2; ++h)
#pragma unroll
                for (int i = 0; i < 2; ++i) { const int rl = h * HALF + RA[i]; const int slot = ls[rl < u.valid ? rl : 0]; vo[h][i] = (unsigned)((slot >> 2) * RP + CA[i] * 2); } }
    }
};

__device__ __forceinline__ v4u pack8(const f32x4 v0, const f32x4 v1) { v4u w; w.x = cvt_pk_bf16(v0[0], v0[1]); w.y = cvt_pk_bf16(v0[2], v0[3]); w.z = cvt_pk_bf16(v1[0], v1[1]); w.w = cvt_pk_bf16(v1[2], v1[3]); return w; }

__device__ __forceinline__ void st16(void* base, unsigned off, v4u v) { *(v4u*)((char*)base + off) = v; }
struct EpiQKV {
    __device__ __forceinline__ void dma(const Unit&, PG8_LAS unsigned char*, int, int) const {}
    bf16_t* O; size_t stride; float scale0;
    __device__ __forceinline__ void operator()(const f32x4 (&acc)[2][2][4][2], const Unit& u, int wr, int wc, int fr_, int fq_, const PG8_LAS unsigned char* xl) const {
        int fr = fr_, fq = fq_; asm volatile("" : "+v"(fr), "+v"(fq));
        const int row0 = u.pm * BM + wr * 64 + fr; const int t = u.pn >> 2; const int colt = (u.pn & 3) * BM;
        bf16_t* base = O + (size_t)t * stride; const float sc = (t == 0) ? scale0 : 1.f; const unsigned off0 = (unsigned)(row0 * D + colt + wc * 32 + 8 * fq) * 2u;
#pragma unroll
        for (int ai = 0; ai < 2; ++ai)
#pragma unroll
            for (int m = 0; m < 4; ++m)
#pragma unroll
                for (int bj = 0; bj < 2; ++bj) st16(base, off0 + (unsigned)((ai * HALF + m * 16) * D + bj * HALF) * 2u, pack8(acc[ai][bj][m][0] * sc, acc[ai][bj][m][1] * sc));
    }
};
struct EpiConvIn {
    __device__ __forceinline__ void dma(const Unit&, PG8_LAS unsigned char*, int, int) const {}
    bf16_t* GB; bf16_t* Z;
    __device__ __forceinline__ void operator()(const f32x4 (&acc)[2][2][4][2], const Unit& u, int wr, int wc, int fr_, int fq_, const PG8_LAS unsigned char* xl) const {
        int fr = fr_, fq = fq_; asm volatile("" : "+v"(fr), "+v"(fq));
        const int row0 = u.pm * BM + wr * 64 + fr;
        if (u.pn < 4) { const unsigned off0 = (unsigned)(row0 * D + u.pn * BM + wc * 32 + 8 * fq) * 2u;
#pragma unroll
            for (int ai = 0; ai < 2; ++ai)
#pragma unroll
                for (int m = 0; m < 4; ++m)
#pragma unroll
                    for (int bj = 0; bj < 2; ++bj) st16(GB, off0 + (unsigned)((ai * HALF + m * 16) * D + bj * HALF) * 2u, pack8(acc[ai][bj][m][0], acc[ai][bj][m][1]));
        } else { const unsigned off0 = (unsigned)(row0 * D + (u.pn - 4) * HALF + wc * 32 + 8 * fq) * 2u;
#pragma unroll
            for (int ai = 0; ai < 2; ++ai)
#pragma unroll
                for (int m = 0; m < 4; ++m) st16(Z, off0 + (unsigned)((ai * HALF + m * 16) * D) * 2u, pack8(acc[ai][0][m][0] * acc[ai][1][m][0], acc[ai][0][m][1] * acc[ai][1][m][1]));
        }
    }
};
struct EpiQKV8 {
    bf16_t* O; size_t stride; float scale0; const float* sw; const float* rs;
    __device__ __forceinline__ void dma(const Unit& u, PG8_LAS unsigned char* xl, int wid, int lane) const {
        if (wid == 0) dma1k(sw + u.pn * BM, xl, lane); else if (wid == 1) dma1k(rs + u.pm * BM, xl + 1024, lane);
    }
    __device__ __forceinline__ void operator()(const f32x4 (&acc)[2][2][4][2], const Unit& u, int wr, int wc, int fr_, int fq_, const PG8_LAS unsigned char* xl) const {
        int fr = fr_, fq = fq_; asm volatile("" : "+v"(fr), "+v"(fq));
        const int row0 = u.pm * BM + wr * 64 + fr; const int t = u.pn >> 2; const int colt = (u.pn & 3) * BM; const int cl = wc * 32 + 8 * fq;
        bf16_t* base = O + (size_t)t * stride; const float sc = (t == 0) ? scale0 : 1.f; const unsigned off0 = (unsigned)(row0 * D + colt + cl) * 2u;
        const PG8_LAS float* sp = (const PG8_LAS float*)xl + cl; const PG8_LAS float* rp = (const PG8_LAS float*)(xl + 1024) + wr * 64 + fr;
        f32x4 sv[2][2];
#pragma unroll
        for (int bj = 0; bj < 2; ++bj)
#pragma unroll
            for (int n = 0; n < 2; ++n) sv[bj][n] = *(const PG8_LAS f32x4*)(sp + bj * HALF + 4 * n) * sc;
#pragma unroll
        for (int ai = 0; ai < 2; ++ai)
#pragma unroll
            for (int m = 0; m < 4; ++m) { const float r = rp[ai * HALF + m * 16];
#pragma unroll
                for (int bj = 0; bj < 2; ++bj) st16(base, off0 + (unsigned)((ai * HALF + m * 16) * D + bj * HALF) * 2u, pack8(acc[ai][bj][m][0] * (sv[bj][0] * r), acc[ai][bj][m][1] * (sv[bj][1] * r))); }
    }
};
struct EpiConvIn8 {
    bf16_t* GB; bf16_t* Z; const float* sw; const float* rs;
    __device__ __forceinline__ void dma(const Unit& u, PG8_LAS unsigned char* xl, int wid, int lane) const { if (wid == 0) dma1k(sw + u.pn * BM, xl, lane); else if (wid == 1) dma1k(rs + u.pm * BM, xl + 1024, lane); }
    __device__ __forceinline__ void operator()(const f32x4 (&acc)[2][2][4][2], const Unit& u, int wr, int wc, int fr_, int fq_, const PG8_LAS unsigned char* xl) const {
        int fr = fr_, fq = fq_; asm volatile("" : "+v"(fr), "+v"(fq));
        const int row0 = u.pm * BM + wr * 64 + fr; const int cl = wc * 32 + 8 * fq;
        const PG8_LAS float* sp = (const PG8_LAS float*)xl + cl; const PG8_LAS float* rp = (const PG8_LAS float*)(xl + 1024) + wr * 64 + fr;
        f32x4 sv[2][2];
#pragma unroll
        for (int bj = 0; bj < 2; ++bj)
#pragma unroll
            for (int n = 0; n < 2; ++n) sv[bj][n] = *(const PG8_LAS f32x4*)(sp + bj * HALF + 4 * n);
        if (u.pn < 4) { const unsigned off0 = (unsigned)(row0 * D + u.pn * BM + cl) * 2u;
#pragma unroll
            for (int ai = 0; ai < 2; ++ai)
#pragma unroll
                for (int m = 0; m < 4; ++m) { const float r = rp[ai * HALF + m * 16];
#pragma unroll
                    for (int bj = 0; bj < 2; ++bj) st16(GB, off0 + (unsigned)((ai * HALF + m * 16) * D + bj * HALF) * 2u, pack8(acc[ai][bj][m][0] * (sv[bj][0] * r), acc[ai][bj][m][1] * (sv[bj][1] * r))); }
        } else { const unsigned off0 = (unsigned)(row0 * D + (u.pn - 4) * HALF + cl) * 2u;
            const f32x4 sz0 = sv[0][0] * sv[1][0], sz1 = sv[0][1] * sv[1][1];
#pragma unroll
            for (int ai = 0; ai < 2; ++ai)
#pragma unroll
                for (int m = 0; m < 4; ++m) { const float r = rp[ai * HALF + m * 16], r2 = r * r;
                    st16(Z, off0 + (unsigned)((ai * HALF + m * 16) * D) * 2u, pack8(acc[ai][0][m][0] * acc[ai][1][m][0] * (sz0 * r2), acc[ai][0][m][1] * acc[ai][1][m][1] * (sz1 * r2))); }
        }
    }
};
struct EpiResid {
    __device__ __forceinline__ void dma(const Unit&, PG8_LAS unsigned char*, int, int) const {}
    const bf16_t* X; bf16_t* Yp;
    __device__ __forceinline__ void operator()(const f32x4 (&acc)[2][2][4][2], const Unit& u, int wr, int wc, int fr_, int fq_, const PG8_LAS unsigned char* xl) const {
        int fr = fr_, fq = fq_; asm volatile("" : "+v"(fr), "+v"(fq));
        const unsigned off0 = (unsigned)((u.pm * BM + wr * 64 + fr) * D + u.pn * BM + wc * 32 + 8 * fq) * 2u;
#pragma unroll
        for (int ai = 0; ai < 2; ++ai)
#pragma unroll
            for (int m = 0; m < 4; ++m)
#pragma unroll
                for (int bj = 0; bj < 2; ++bj) { const unsigned off = off0 + (unsigned)((ai * HALF + m * 16) * D + bj * HALF) * 2u; const v4u xr = *(const v4u*)((const char*)X + off);
                    f32x4 v0 = acc[ai][bj][m][0], v1 = acc[ai][bj][m][1];
                    v0[0] += ALPHA * bf_lo(xr.x); v0[1] += ALPHA * bf_hi(xr.x); v0[2] += ALPHA * bf_lo(xr.y); v0[3] += ALPHA * bf_hi(xr.y);
                    v1[0] += ALPHA * bf_lo(xr.z); v1[1] += ALPHA * bf_hi(xr.z); v1[2] += ALPHA * bf_lo(xr.w); v1[3] += ALPHA * bf_hi(xr.w);
                    st16(Yp, off, pack8(v0, v1)); }
    }
};
template <bool ROWS> struct EpiResid8 {
    const bf16_t* X; bf16_t* Yp; const float* sw; const float* rs; float rsc;
    __device__ __forceinline__ void dma(const Unit& u, PG8_LAS unsigned char* xl, int wid, int lane) const {
        if (wid == 0) dma1k(sw + u.pn * BM, xl, lane); else if (ROWS && wid == 1) dma1k(rs + u.pm * BM, xl + 1024, lane);
    }
    __device__ __forceinline__ void operator()(const f32x4 (&acc)[2][2][4][2], const Unit& u, int wr, int wc, int fr_, int fq_, const PG8_LAS unsigned char* xl) const {
        int fr = fr_, fq = fq_; asm volatile("" : "+v"(fr), "+v"(fq));
        const int cl = wc * 32 + 8 * fq;
        const unsigned off0 = (unsigned)((u.pm * BM + wr * 64 + fr) * D + u.pn * BM + cl) * 2u;
        const PG8_LAS float* sp = (const PG8_LAS float*)xl + cl; const PG8_LAS float* rp = (const PG8_LAS float*)(xl + 1024) + wr * 64 + fr;
        f32x4 sv[2][2];
#pragma unroll
        for (int bj = 0; bj < 2; ++bj)
#pragma unroll
            for (int n = 0; n < 2; ++n) sv[bj][n] = *(const PG8_LAS f32x4*)(sp + bj * HALF + 4 * n) * (ROWS ? 1.0f : rsc);
#pragma unroll
        for (int ai = 0; ai < 2; ++ai)
#pragma unroll
            for (int m = 0; m < 4; ++m) { float r = 1.0f; if (ROWS) r = rp[ai * HALF + m * 16];
#pragma unroll
                for (int bj = 0; bj < 2; ++bj) { const unsigned off = off0 + (unsigned)((ai * HALF + m * 16) * D + bj * HALF) * 2u; const v4u xr = *(const v4u*)((const char*)X + off);
                    f32x4 v0 = acc[ai][bj][m][0] * sv[bj][0], v1 = acc[ai][bj][m][1] * sv[bj][1]; if (ROWS) { v0 *= r; v1 *= r; }
                    v0[0] += ALPHA * bf_lo(xr.x); v0[1] += ALPHA * bf_hi(xr.x); v0[2] += ALPHA * bf_lo(xr.y); v0[3] += ALPHA * bf_hi(xr.y);
                    v1[0] += ALPHA * bf_lo(xr.z); v1[1] += ALPHA * bf_hi(xr.z); v1[2] += ALPHA * bf_lo(xr.w); v1[3] += ALPHA * bf_hi(xr.w);
                    st16(Yp, off, pack8(v0, v1)); } }
    }
};
__device__ __forceinline__ unsigned pk4_fp8(float a, float b, float c, float d) { int p = 0; p = __builtin_amdgcn_cvt_pk_fp8_f32(a, b, p, false); p = __builtin_amdgcn_cvt_pk_fp8_f32(c, d, p, true); return (unsigned)p; }
__device__ __forceinline__ unsigned pk4_i8(float a, float b, float c, float d) {
    unsigned r = 0;
    r = __builtin_amdgcn_cvt_pk_u8_f32(__builtin_rintf(a + 128.f), 0, r); r = __builtin_amdgcn_cvt_pk_u8_f32(__builtin_rintf(b + 128.f), 1, r);
    r = __builtin_amdgcn_cvt_pk_u8_f32(__builtin_rintf(c + 128.f), 2, r); r = __builtin_amdgcn_cvt_pk_u8_f32(__builtin_rintf(d + 128.f), 3, r);
    return r ^ 0x80808080u;
}
template <bool I8> __device__ __forceinline__ unsigned pkq4(float a, float b, float c, float d) { if constexpr (I8) return pk4_i8(a, b, c, d); else return pk4_fp8(a, b, c, d); }
__device__ __forceinline__ f32x2 swiglu8_pk(f32x2 g, f32x2 l8) {
    g.x = fminf(g.x, 7.0f); g.y = fminf(g.y, 7.0f);
    l8.x = fminf(fmaxf(l8.x, -56.0f), 56.0f); l8.y = fminf(fmaxf(l8.y, -56.0f), 56.0f);
    const f32x2 t = g * (-1.702f * LOG2E);
    f32x2 e; e.x = __builtin_amdgcn_exp2f(t.x); e.y = __builtin_amdgcn_exp2f(t.y);
    const f32x2 d = e + 1.0f;
    f32x2 r; r.x = __builtin_amdgcn_rcpf(d.x); r.y = __builtin_amdgcn_rcpf(d.y);
    return (g * r) * (l8 + A2SCALE);
}
struct EpiMoe1 {
    unsigned char* A2; const float* b1; const float* sw; float inv_sa;
    __device__ __forceinline__ void dma(const Unit& u, PG8_LAS unsigned char* xl, int wid, int lane) const {
        if (wid == 0) dma1k(b1 + (size_t)u.e * 2048 + u.pn * BM, xl, lane); else if (wid == 1) dma1k(sw + (size_t)u.e * 2048 + u.pn * BM, xl + 1024, lane);
    }
    __device__ __forceinline__ void operator()(const f32x4 (&acc)[2][2][4][2], const Unit& u, int wr, int wc, int fr_, int fq_, const PG8_LAS unsigned char* xl) const {
        int fr = fr_, fq = fq_; asm volatile("" : "+v"(fr), "+v"(fq));
        const int cl = wc * 32 + 8 * fq; const unsigned off0 = (unsigned)((u.pm * BM + wr * 64 + fr) * D + u.pn * HALF + cl);
        const PG8_LAS float* bp = (const PG8_LAS float*)xl + 2 * cl; f32x4 bb[4];
#pragma unroll
        for (int j = 0; j < 4; ++j) bb[j] = *(const PG8_LAS f32x4*)(bp + 4 * j);
        const PG8_LAS float* sp = (const PG8_LAS float*)(xl + 1024) + cl;
        const f32x4 sg0 = *(const PG8_LAS f32x4*)(sp) * inv_sa, sg1 = *(const PG8_LAS f32x4*)(sp + 4) * inv_sa;
        const f32x4 sl0 = *(const PG8_LAS f32x4*)(sp + HALF) * (inv_sa * A2SCALE), sl1 = *(const PG8_LAS f32x4*)(sp + HALF + 4) * (inv_sa * A2SCALE);
        f32x2 sgp[4] = {{sg0[0], sg0[1]}, {sg0[2], sg0[3]}, {sg1[0], sg1[1]}, {sg1[2], sg1[3]}}, slp[4] = {{sl0[0], sl0[1]}, {sl0[2], sl0[3]}, {sl1[0], sl1[1]}, {sl1[2], sl1[3]}};
        f32x2 bgp[4], blp[4];
#pragma unroll
        for (int q = 0; q < 4; ++q) { bgp[q] = (f32x2){bb[q][0], bb[q][2]}; blp[q] = (f32x2){bb[q][1] * A2SCALE, bb[q][3] * A2SCALE}; }
        const unsigned offp = off0 + ((fq & 1) ? (unsigned)(16 * D - 8) : 0u);
#pragma unroll
        for (int ai = 0; ai < 2; ++ai)
#pragma unroll
            for (int mp = 0; mp < 2; ++mp) { typedef unsigned u32x2 __attribute__((ext_vector_type(2))); u32x2 w[2];
#pragma unroll
                for (int mm = 0; mm < 2; ++mm) { const int m = 2 * mp + mm; f32x2 o[4];
#pragma unroll
                    for (int q = 0; q < 4; ++q) { const f32x4 ga = acc[ai][0][m][q >> 1], la = acc[ai][1][m][q >> 1]; const int h2 = (q & 1) * 2;
                        const f32x2 g = (f32x2){ga[h2], ga[h2 + 1]} * sgp[q] + bgp[q], l8 = (f32x2){la[h2], la[h2 + 1]} * slp[q] + blp[q];
                        o[q] = swiglu8_pk(g, l8); }
                    w[mm].x = pk4_fp8(o[0].x, o[0].y, o[1].x, o[1].y); w[mm].y = pk4_fp8(o[2].x, o[2].y, o[3].x, o[3].y); }
                const auto sx = __builtin_amdgcn_permlane16_swap(w[0].x, w[1].x, false, false); const auto sy = __builtin_amdgcn_permlane16_swap(w[0].y, w[1].y, false, false);
                const v4u ov = {sx[0], sy[0], sx[1], sy[1]};
                *(v4u*)(A2 + (offp + (unsigned)((ai * HALF + mp * 32) * D))) = ov; }
    }
};
struct EpiMoe2 {
    unsigned char* Y; const float* b2; const float* sw; const int* lslot; const float* lgate;
    __device__ __forceinline__ void dma(const Unit& u, PG8_LAS unsigned char* xl, int wid, int lane) const {
        const size_t lb = (size_t)u.e * LCAP + u.lr0;
        if (wid == 0) dma1k(b2 + (size_t)u.e * 1024 + u.pn * BM, xl, lane); else if (wid == 1) dma1k(sw + (size_t)u.e * 1024 + u.pn * BM, xl + 1024, lane);
        else if (wid == 2) dma1k(lslot + lb, xl + 2048, lane); else if (wid == 3) dma1k(lgate + lb, xl + 3072, lane);
    }
    __device__ __forceinline__ void operator()(const f32x4 (&acc)[2][2][4][2], const Unit& u, int wr, int wc, int fr_, int fq_, const PG8_LAS unsigned char* xl) const {
        int fr = fr_, fq = fq_; asm volatile("" : "+v"(fr), "+v"(fq));
        const int rl0 = wr * 64 + fr, cl = wc * 32 + 8 * fq, col0 = u.pn * BM + cl;
        const PG8_LAS float* bp = (const PG8_LAS float*)xl + cl; const PG8_LAS float* sp = (const PG8_LAS float*)(xl + 1024) + cl; f32x4 bv[2][2], sv[2][2];
#pragma unroll
        for (int bj = 0; bj < 2; ++bj)
#pragma unroll
            for (int n = 0; n < 2; ++n) { bv[bj][n] = *(const PG8_LAS f32x4*)(bp + bj * HALF + 4 * n); sv[bj][n] = *(const PG8_LAS f32x4*)(sp + bj * HALF + 4 * n) * (1.0f / (A2SCALE * KREP_MOE_)); }
        const PG8_LAS int* sl = (const PG8_LAS int*)(xl + 2048); const PG8_LAS float* gl = (const PG8_LAS float*)(xl + 3072);
        const unsigned cadj = (unsigned)(u.pn * BM + ((fq & 1) ? (HALF + cl - 8) : cl));
#pragma unroll
        for (int ai = 0; ai < 2; ++ai)
#pragma unroll
            for (int m = 0; m < 4; ++m) { const int rl = rl0 + ai * HALF + m * 16;
                const bool ok = rl < u.valid; const int slot = ok ? sl[rl] : M * 4; const float g = gl[rl] * YSCALE;
                typedef unsigned u32x2 __attribute__((ext_vector_type(2))); u32x2 w[2];
#pragma unroll
                for (int bj = 0; bj < 2; ++bj) { f32x4 v0 = (acc[ai][bj][m][0] * sv[bj][0] + bv[bj][0]) * g, v1 = (acc[ai][bj][m][1] * sv[bj][1] + bv[bj][1]) * g;
#pragma unroll
                    for (int i = 0; i < 4; ++i) { v0[i] = fminf(fmaxf(v0[i], -448.0f), 448.0f); v1[i] = fminf(fmaxf(v1[i], -448.0f), 448.0f); }
                    w[bj].x = pk4_fp8(v0[0], v0[1], v0[2], v0[3]); w[bj].y = pk4_fp8(v1[0], v1[1], v1[2], v1[3]); }
                const auto sx = __builtin_amdgcn_permlane16_swap(w[0].x, w[1].x, false, false); const auto sy = __builtin_amdgcn_permlane16_swap(w[0].y, w[1].y, false, false);
                const v4u o = {sx[0], sy[0], sx[1], sy[1]};
                *(v4u*)(Y + ((unsigned)(slot * D) + cadj)) = o; }
    }
};

typedef int v8i_t __attribute__((ext_vector_type(8))); typedef int v4i_t __attribute__((ext_vector_type(4)));
__device__ __forceinline__ v8i_t cat8(bf16x8 lo, bf16x8 hi) { const v4i_t a = __builtin_bit_cast(v4i_t, lo), b = __builtin_bit_cast(v4i_t, hi); return __builtin_shufflevector(a, b, 0, 1, 2, 3, 4, 5, 6, 7); }
template <class Prob, class Epi, bool ALIGN_EPI, bool F8 = false, int KREP = 1, bool I8 = false>
__device__ __forceinline__ void gemm_phase(PG8_LAS unsigned char* lds, PG8_LAS unsigned char* xl, const Prob& P, const Epi& E) {
    int tid_ = P.tid; asm volatile("" : "+v"(tid_));
    const int tid = tid_, wid = __builtin_amdgcn_readfirstlane(tid >> 6), lane = tid & 63, wr = wid >> 2, wc = wid & 3, fr = lane & 15, fq = lane >> 4;
    constexpr int RP = F8 ? 1024 : 2048, nt = F8 ? 8 : NTK;
    constexpr bool GA = Prob::GATHER;
    int RA[2], CA[2]; unsigned voffB[2], voffA[2];
#pragma unroll
    for (int i = 0; i < 2; ++i) { int R, C; stage_rc(tid * 16 + i * 8192, R, C); const int Rb = (R & ~31) + perm32(R & 31); RA[i] = R; CA[i] = C; voffB[i] = (unsigned)(Rb * RP + C * 2); voffA[i] = (unsigned)(R * RP + C * 2); }
    constexpr unsigned kstep = (unsigned)(BK * 2);
    constexpr unsigned hstep = (unsigned)HALF * RP;
    const unsigned ldsw = (unsigned)wid * 1024u;
    const int aoff = lds_byte(wr * 64 + fr, fq * 8), boff = lds_byte(wc * 32 + fr, fq * 8);
    typedef const __attribute__((address_space(1))) unsigned* gptr_t;
#define PG8_SA(b, h) (((b) * 2 + (h)) * HTB)
#define PG8_SB(b, h) ((4 + (b) * 2 + (h)) * HTB)
#define PG8_STAGE_B(bufoff, uoff) do { _Pragma("unroll") for (int _i = 0; _i < 2; ++_i) \
        __builtin_amdgcn_global_load_lds((gptr_t)(Bb + (voffB[_i] + (unsigned)(uoff))), (PG8_LAS unsigned*)(lds + (bufoff) + ldsw + _i * 8192), 16, 0, 0); } while (0)
#define PG8_STAGE_A(bufoff, koff, h, NX) do { _Pragma("unroll") for (int _i = 0; _i < 2; ++_i) { unsigned _o; \
        if constexpr (GA) _o = ((NX) ? vn[h][_i] : vc[h][_i]) + (unsigned)(koff); else _o = voffA[_i] + (((NX) ? nAo : cAo) + (unsigned)(h) * hstep + (unsigned)(koff)); \
        __builtin_amdgcn_global_load_lds((gptr_t)(Ab + _o), (PG8_LAS unsigned*)(lds + (bufoff) + ldsw + _i * 8192), 16, 0, 0); } } while (0)
#define PG8_LDA(dst, b, h) do { _Pragma("unroll") for (int m = 0; m < 4; ++m) _Pragma("unroll") for (int k = 0; k < 2; ++k) dst[m][k] = *(const PG8_LAS bf16x8*)(lds + PG8_SA(b, h) + aoff + m * 2048 + k * 1024); } while (0)
#define PG8_LDB(dst, b, h) do { _Pragma("unroll") for (int n = 0; n < 2; ++n) _Pragma("unroll") for (int k = 0; k < 2; ++k) dst[n][k] = *(const PG8_LAS bf16x8*)(lds + PG8_SB(b, h) + boff + n * 2048 + k * 1024); } while (0)
#define PG8_MMA(ai, bj, At, Bt) do { __builtin_amdgcn_s_setprio(1); _Pragma("unroll") for (int m = 0; m < 4; ++m) _Pragma("unroll") for (int n = 0; n < 2; ++n) _Pragma("unroll") for (int k = 0; k < 2; ++k) \
        acc[ai][bj][m][n] = __builtin_amdgcn_mfma_f32_16x16x32_bf16(Bt[n][k], At[m][k], acc[ai][bj][m][n], 0, 0, 0); __builtin_amdgcn_s_setprio(0); } while (0)
#define PG8_MMA8(ai, bj, At, Bt) do { __builtin_amdgcn_s_setprio(1); if constexpr (I8) { _Pragma("unroll") for (int k = 0; k < 2; ++k) _Pragma("unroll") for (int m = 0; m < 4; ++m) _Pragma("unroll") for (int n = 0; n < 2; ++n) \
        asm volatile("v_mfma_i32_16x16x64_i8 %0, %1, %2, %0" : "+v"(acc[ai][bj][m][n]) : "v"(Bt[n][k]), "v"(At[m][k])); } else { _Pragma("unroll") for (int m = 0; m < 4; ++m) _Pragma("unroll") for (int n = 0; n < 2; ++n) \
        asm volatile("v_mfma_f32_16x16x128_f8f6f4 %0, %1, %2, %0" : "+v"(acc[ai][bj][m][n]) : "v"(cat8(Bt[n][0], Bt[n][1])), "v"(cat8(At[m][0], At[m][1]))); } __builtin_amdgcn_s_setprio(0); } while (0)
#define PG8_MMA8Z(ai, bj, At, Bt) do { __builtin_amdgcn_s_setprio(1); if constexpr (I8) { _Pragma("unroll") for (int m = 0; m < 4; ++m) _Pragma("unroll") for (int n = 0; n < 2; ++n) \
        asm volatile("v_mfma_i32_16x16x64_i8 %0, %1, %2, 0" : "=&v"(acc[ai][bj][m][n]) : "v"(Bt[n][0]), "v"(At[m][0])); _Pragma("unroll") for (int m = 0; m < 4; ++m) _Pragma("unroll") for (int n = 0; n < 2; ++n) \
        asm volatile("v_mfma_i32_16x16x64_i8 %0, %1, %2, %0" : "+v"(acc[ai][bj][m][n]) : "v"(Bt[n][1]), "v"(At[m][1])); } else { _Pragma("unroll") for (int m = 0; m < 4; ++m) _Pragma("unroll") for (int n = 0; n < 2; ++n) \
        asm volatile("v_mfma_f32_16x16x128_f8f6f4 %0, %1, %2, 0" : "=&v"(acc[ai][bj][m][n]) : "v"(cat8(Bt[n][0], Bt[n][1])), "v"(cat8(At[m][0], At[m][1]))); } __builtin_amdgcn_s_setprio(0); } while (0)
#define PG8_MM(ai, bj, At, Bt) do { if constexpr (F8) PG8_MMA8(ai, bj, At, Bt); else PG8_MMA(ai, bj, At, Bt); } while (0)
#define PG8_MM2(FIRST, ai, At) do { if constexpr (F8) { if (FIRST) { PG8_MMA8Z(ai, 0, At, B0); PG8_MMA8Z(ai, 1, At, B1); } else { PG8_MMA8(ai, 0, At, B0); PG8_MMA8(ai, 1, At, B1); } } else { PG8_MMA(ai, 0, At, B0); PG8_MMA(ai, 1, At, B1); } } while (0)
#define PG8_WAIT_V(n) asm volatile("s_waitcnt vmcnt(" #n ")" ::: "memory")
#define PG8_WAIT_L(n) asm volatile("s_waitcnt lgkmcnt(" #n ")" ::: "memory")
#define PG8_BAR __builtin_amdgcn_s_barrier()
#define PG8_SCHED __builtin_amdgcn_sched_barrier(0)
    Unit cur, nxt; int ui = 0;
    if (!P.next(0, cur)) return;
    f32x4 acc[2][2][4][2];
    if constexpr (!F8) {
#pragma unroll
    for (int a = 0; a < 2; ++a)
#pragma unroll
        for (int b = 0; b < 2; ++b)
#pragma unroll
            for (int m = 0; m < 4; ++m)
#pragma unroll
                for (int n = 0; n < 2; ++n) acc[a][b][m][n] = (f32x4){0.f, 0.f, 0.f, 0.f};
    }
    bf16x8 At[4][2], B0[2][2], B1[2][2];
    unsigned vc[2][2], vn[2][2]; unsigned cAo = 0, nAo = 0;
    if constexpr (GA) { P.a_off(cur, RA, CA, vc); vn[0][0] = vc[0][0]; vn[0][1] = vc[0][1]; vn[1][0] = vc[1][0]; vn[1][1] = vc[1][1]; } else { cAo = P.a_tile(cur); nAo = cAo; vc[0][0] = vn[0][0] = 0; }
    const char* const Ab = P.A; const char* const Bb = P.Bt; unsigned cBo = P.b_off(cur), nBo = cBo;
    PG8_STAGE_B(PG8_SB(0, 0), cBo); PG8_STAGE_B(PG8_SB(0, 1), cBo + hstep); PG8_STAGE_A(PG8_SA(0, 0), 0u, 0, false); PG8_STAGE_A(PG8_SA(0, 1), 0u, 1, false);
    if (wr == 1) PG8_BAR;
    PG8_WAIT_V(2); PG8_BAR;
    PG8_STAGE_B(PG8_SB(1, 0), cBo + kstep); PG8_STAGE_A(PG8_SA(1, 0), kstep, 0, false); PG8_STAGE_B(PG8_SB(1, 1), cBo + hstep + kstep);
    PG8_WAIT_V(6); PG8_BAR;
    for (;;) {
        const bool has_next = P.next(ui + 1, nxt);
        PG8_LAS unsigned char* const xe = xl + (ui & 1) * XL_EPI;
        PG8_LAS unsigned char* const xg = xl + 2 * XL_EPI + ((ui + 1) & 1) * XL_GATHER;
        E.dma(cur, xe, wid, lane);
        if (has_next) { if constexpr (GA) P.dma_rows(nxt, xg, wid, lane); else nAo = P.a_tile(nxt); nBo = P.b_off(nxt); }
        else { nAo = cAo; nBo = cBo; }
#pragma unroll 1
        for (int rep = 0; rep < KREP; ++rep)
#pragma unroll 1
        for (int t = 0; t < nt; t += 2) {
            const bool lastt = (t == nt - 2); const bool last = lastt && (rep == KREP - 1); const bool first = (t == 0) && (rep == 0); (void)first;
            if constexpr (GA) { if (last) { if (has_next) P.a_off_lds(nxt, RA, CA, xg, vn); else { vn[0][0] = vc[0][0]; vn[0][1] = vc[0][1]; vn[1][0] = vc[1][0]; vn[1][1] = vc[1][1]; } } }
            const unsigned k1 = (unsigned)(t + 1) * kstep;
            const unsigned k2 = lastt ? 0u : (unsigned)(t + 2) * kstep, k3 = k2 + kstep;
            const unsigned b2 = (last ? nBo : cBo) + k2, b3 = b2 + kstep;
            PG8_LDB(B0, 0, 0); PG8_LDB(B1, 0, 1); PG8_SCHED; PG8_LDA(At, 0, 0); PG8_STAGE_A(PG8_SA(1, 1), k1, 1, false);
            PG8_WAIT_V(8); PG8_WAIT_L(0); PG8_BAR; PG8_MM2(first, 0, At); PG8_BAR; PG8_SCHED;
            PG8_LDA(At, 0, 1); PG8_STAGE_B(PG8_SB(0, 0), b2); PG8_STAGE_B(PG8_SB(0, 1), b2 + hstep); PG8_STAGE_A(PG8_SA(0, 0), k2, 0, last);
            PG8_WAIT_V(8); PG8_WAIT_L(0); PG8_BAR; PG8_MM2(first, 1, At); PG8_BAR; PG8_SCHED;
            PG8_LDB(B0, 1, 0); PG8_LDB(B1, 1, 1); PG8_SCHED; PG8_LDA(At, 1, 0); PG8_STAGE_A(PG8_SA(0, 1), k2, 1, last);
            PG8_WAIT_V(8); PG8_WAIT_L(0); PG8_BAR; PG8_MM(0, 0, At, B0); PG8_MM(0, 1, At, B1); PG8_BAR; PG8_SCHED;
            PG8_LDA(At, 1, 1); PG8_STAGE_B(PG8_SB(1, 0), b3); PG8_STAGE_B(PG8_SB(1, 1), b3 + hstep); PG8_STAGE_A(PG8_SA(1, 0), k3, 0, last);
            PG8_WAIT_V(8); PG8_WAIT_L(0); PG8_BAR; PG8_MM(1, 0, At, B0); PG8_MM(1, 1, At, B1); PG8_BAR; PG8_SCHED;
        }
        if constexpr (ALIGN_EPI) { if (wr == 0) PG8_BAR; }
        if constexpr (F8) asm volatile("s_nop 15\n\ts_nop 7" ::: "memory");
        if constexpr (I8) {
#pragma unroll
            for (int a = 0; a < 2; ++a)
#pragma unroll
                for (int b = 0; b < 2; ++b)
#pragma unroll
                    for (int m = 0; m < 4; ++m)
#pragma unroll
                        for (int n = 0; n < 2; ++n)
#pragma unroll
                            for (int i = 0; i < 4; ++i) acc[a][b][m][n][i] = (float)__float_as_int(acc[a][b][m][n][i]);
        }
        E(acc, cur, wr, wc, fr, fq, xe);
        if (!has_next) break;
        if constexpr (!F8)
#pragma unroll
        for (int a = 0; a < 2; ++a)
#pragma unroll
            for (int b = 0; b < 2; ++b)
#pragma unroll
                for (int m = 0; m < 4; ++m)
#pragma unroll
                    for (int n = 0; n < 2; ++n) acc[a][b][m][n] = (f32x4){0.f, 0.f, 0.f, 0.f};
        cur = nxt; cBo = nBo; cAo = nAo; ++ui;
        if constexpr (GA) { vc[0][0] = vn[0][0]; vc[0][1] = vn[0][1]; vc[1][0] = vn[1][0]; vc[1][1] = vn[1][1]; }
        if constexpr (ALIGN_EPI) { if (wr == 1) PG8_BAR; }
    }
    PG8_WAIT_V(0);
    if constexpr (!ALIGN_EPI) { if (wr == 0) PG8_BAR; }
    PG8_BAR;
#undef PG8_SA
#undef PG8_SB
#undef PG8_STAGE_A
#undef PG8_STAGE_B
#undef PG8_LDA
#undef PG8_LDB
#undef PG8_MMA
#undef PG8_MMA8
#undef PG8_MM
#undef PG8_MM2
#undef PG8_MMA8Z
#undef PG8_WAIT_V
#undef PG8_WAIT_L
#undef PG8_BAR
#undef PG8_SCHED
}
}

namespace att {
constexpr int QBLK = 32, KVBLK = 64, LDX = 1024, NT = SEQ / KVBLK;
constexpr int SHM_V = KVBLK * 128 * 2, SHM_K = KVBLK * 128 * 2, NSLOT = 3;
constexpr int OFF_V = 0, OFF_K = NSLOT * SHM_V, OFF_WS = NSLOT * (SHM_V + SHM_K), OFF_TBL = OFF_WS + 8 * 64 * 4, ATT_LDS = OFF_TBL + 2048;
constexpr float THR2 = 8.0f * LOG2E;
#define KSWZ(row, colB) ((row) * 256 + ((colB) ^ (((row) & 7) << 4)))
#define SBAR() __builtin_amdgcn_sched_barrier(0)
__device__ __forceinline__ int crow(int r, int hi) { return (r & 3) + 8 * (r >> 2) + 4 * hi; }
__device__ __forceinline__ int v_st(int k, int c) { const int kk = (k & ~0xC) | ((k & 4) << 1) | ((k & 8) >> 1); return ((kk >> 3) * 4 + (c >> 5)) * 512 + ((kk & 7) * 32 + (c & 31)) * 2; }
__device__ __forceinline__ int v_rd_base(int lane) { return ((lane & 3) << 3) | (((lane >> 2) & 3) << 6) | (((lane >> 4) & 1) << 5) | (((lane >> 5) & 1) << 8); }
constexpr int v_rd_off(int d0, int ks, int half) { return d0 * 512 + ks * 4096 + half * 2048; }
template <int OFF> __device__ __forceinline__ s16x4 tr_read(int vb) { s16x4 r; asm volatile("ds_read_b64_tr_b16 %0, %1 offset:%2" : "=&v"(r) : "v"(vb), "i"(OFF) : "memory"); return r; }
#define ATT_RD8(L, H, D0) do { \
    asm volatile("ds_read_b64_tr_b16 %0, %1 offset:%2" : "=&v"(L[0]) : "v"(vb), "i"(v_rd_off(D0, 0, 0)) : "memory"); asm volatile("ds_read_b64_tr_b16 %0, %1 offset:%2" : "=&v"(H[0]) : "v"(vb), "i"(v_rd_off(D0, 0, 1)) : "memory"); \
    asm volatile("ds_read_b64_tr_b16 %0, %1 offset:%2" : "=&v"(L[1]) : "v"(vb), "i"(v_rd_off(D0, 1, 0)) : "memory"); asm volatile("ds_read_b64_tr_b16 %0, %1 offset:%2" : "=&v"(H[1]) : "v"(vb), "i"(v_rd_off(D0, 1, 1)) : "memory"); \
    asm volatile("ds_read_b64_tr_b16 %0, %1 offset:%2" : "=&v"(L[2]) : "v"(vb), "i"(v_rd_off(D0, 2, 0)) : "memory"); asm volatile("ds_read_b64_tr_b16 %0, %1 offset:%2" : "=&v"(H[2]) : "v"(vb), "i"(v_rd_off(D0, 2, 1)) : "memory"); \
    asm volatile("ds_read_b64_tr_b16 %0, %1 offset:%2" : "=&v"(L[3]) : "v"(vb), "i"(v_rd_off(D0, 3, 0)) : "memory"); asm volatile("ds_read_b64_tr_b16 %0, %1 offset:%2" : "=&v"(H[3]) : "v"(vb), "i"(v_rd_off(D0, 3, 1)) : "memory"); } while (0)
#define ATT_PK(L, H) (bf16x8){L[0], L[1], L[2], L[3], H[0], H[1], H[2], H[3]}
#define ATT_MM4(OD, L, H) do { OD = __builtin_amdgcn_mfma_f32_32x32x16_bf16(pa0, ATT_PK(L[0], H[0]), OD, 0, 0, 0); OD = __builtin_amdgcn_mfma_f32_32x32x16_bf16(pa1, ATT_PK(L[1], H[1]), OD, 0, 0, 0); \
    OD = __builtin_amdgcn_mfma_f32_32x32x16_bf16(pa2, ATT_PK(L[2], H[2]), OD, 0, 0, 0); OD = __builtin_amdgcn_mfma_f32_32x32x16_bf16(pa3, ATT_PK(L[3], H[3]), OD, 0, 0, 0); } while (0)
__device__ __forceinline__ void pv_d0(f32x16* o, int vb, bf16x8 pa0, bf16x8 pa1, bf16x8 pa2, bf16x8 pa3) {
  s16x4 la[4], ha[4], lb[4], hb[4];
  ATT_RD8(la, ha, 0); ATT_RD8(lb, hb, 1);
  asm volatile("s_waitcnt lgkmcnt(8)" ::: "memory"); SBAR(); ATT_MM4(o[0], la, ha); SBAR();
  ATT_RD8(la, ha, 2);
  asm volatile("s_waitcnt lgkmcnt(8)" ::: "memory"); SBAR(); ATT_MM4(o[1], lb, hb); SBAR();
  ATT_RD8(lb, hb, 3);
  asm volatile("s_waitcnt lgkmcnt(8)" ::: "memory"); SBAR(); ATT_MM4(o[2], la, ha); SBAR();
  asm volatile("s_waitcnt lgkmcnt(0)" ::: "memory"); SBAR(); ATT_MM4(o[3], lb, hb);
  const bf16x8 ones = {(short)0x3F80, (short)0x3F80, (short)0x3F80, (short)0x3F80, (short)0x3F80, (short)0x3F80, (short)0x3F80, (short)0x3F80};
  o[4] = __builtin_amdgcn_mfma_f32_32x32x16_bf16(pa0, ones, o[4], 0, 0, 0); o[4] = __builtin_amdgcn_mfma_f32_32x32x16_bf16(pa1, ones, o[4], 0, 0, 0);
  o[4] = __builtin_amdgcn_mfma_f32_32x32x16_bf16(pa2, ones, o[4], 0, 0, 0); o[4] = __builtin_amdgcn_mfma_f32_32x32x16_bf16(pa3, ones, o[4], 0, 0, 0);
}
__device__ __forceinline__ void pv_softmax(f32x16* o, int vb, bf16x8 pa0, bf16x8 pa1, bf16x8 pa2, bf16x8 pa3, f32x16& p0, f32x16& p1, float& m_reg, float& alpha, bool& resc) {
  s16x4 la[4], ha[4], lb[4], hb[4];
  ATT_RD8(la, ha, 0); ATT_RD8(lb, hb, 1);
  asm volatile("s_waitcnt lgkmcnt(8)" ::: "memory"); SBAR();
  float a = fmaxf(fmaxf(p0[0], p0[1]), p1[0]), b = fmaxf(fmaxf(p0[2], p0[3]), p1[1]); a = fmaxf(fmaxf(a, p1[2]), p1[3]);
#pragma unroll
  for (int r = 4; r < 16; r += 4) { a = fmaxf(fmaxf(a, p0[r]), p0[r + 1]); b = fmaxf(fmaxf(b, p0[r + 2]), p0[r + 3]); a = fmaxf(fmaxf(a, p1[r]), p1[r + 1]); b = fmaxf(fmaxf(b, p1[r + 2]), p1[r + 3]); }
  float pmax = fmaxf(a, b);
  ATT_MM4(o[0], la, ha); SBAR();
  ATT_RD8(la, ha, 2);
  asm volatile("s_waitcnt lgkmcnt(8)" ::: "memory"); SBAR();
  { auto rr = __builtin_amdgcn_permlane32_swap(__float_as_uint(pmax), __float_as_uint(pmax), false, false);
    pmax = fmaxf(__uint_as_float(rr[0]), __uint_as_float(rr[1])); }
  resc = false; alpha = 1.f;
  if (__builtin_expect(!__all(pmax <= THR2), 0)) { const float dl = fmaxf(pmax, 0.f); m_reg += dl; alpha = __builtin_amdgcn_exp2f(-dl); resc = true;
#pragma unroll
    for (int r = 0; r < 16; ++r) { p0[r] -= dl; p1[r] -= dl; } }
  ATT_MM4(o[1], lb, hb); SBAR();
  ATT_RD8(lb, hb, 3);
  asm volatile("s_waitcnt lgkmcnt(8)" ::: "memory"); SBAR();
#pragma unroll
  for (int r = 0; r < 16; ++r) p0[r] = __builtin_amdgcn_exp2f(p0[r]);
  ATT_MM4(o[2], la, ha); SBAR();
  asm volatile("s_waitcnt lgkmcnt(0)" ::: "memory"); SBAR();
#pragma unroll
  for (int r = 0; r < 16; ++r) p1[r] = __builtin_amdgcn_exp2f(p1[r]);
  ATT_MM4(o[3], lb, hb);
  const bf16x8 ones = {(short)0x3F80, (short)0x3F80, (short)0x3F80, (short)0x3F80, (short)0x3F80, (short)0x3F80, (short)0x3F80, (short)0x3F80};
  o[4] = __builtin_amdgcn_mfma_f32_32x32x16_bf16(pa0, ones, o[4], 0, 0, 0); o[4] = __builtin_amdgcn_mfma_f32_32x32x16_bf16(pa1, ones, o[4], 0, 0, 0);
  o[4] = __builtin_amdgcn_mfma_f32_32x32x16_bf16(pa2, ones, o[4], 0, 0, 0); o[4] = __builtin_amdgcn_mfma_f32_32x32x16_bf16(pa3, ones, o[4], 0, 0, 0);
}
__device__ __forceinline__ void near_bias(f32x16& p0, f32x16& p1, int dq, const float* tbl) {
#pragma unroll
  for (int r = 0; r < 16; ++r) { const int c0 = (r & 3) + 8 * (r >> 2); p0[r] += tbl[dq + c0]; p1[r] += tbl[dq + c0 + 32]; }
}
__device__ __forceinline__ void qkt(f32x16& p0, f32x16& p1, const char* Ks, const bf16x8* qr, int r32, int hi, int mapB) {
  bf16x8 k0[4], k1[4];
#pragma unroll
  for (int d0 = 0; d0 < 4; ++d0) { const int cb = mapB + (d0 * 16 + hi * 8) * 2;
    k0[d0] = *reinterpret_cast<const bf16x8*>(Ks + KSWZ(r32, cb)); k1[d0] = *reinterpret_cast<const bf16x8*>(Ks + KSWZ(32 + r32, cb)); }
  p0 = f32x16{}; p1 = f32x16{};
#pragma unroll
  for (int d0 = 0; d0 < 4; ++d0) {
    p0 = __builtin_amdgcn_mfma_f32_32x32x16_bf16(k0[d0], qr[d0], p0, 0, 0, 0);
    p1 = __builtin_amdgcn_mfma_f32_32x32x16_bf16(k1[d0], qr[d0], p1, 0, 0, 0); }
}
__device__ __forceinline__ void qkt_seed(f32x16& p0, f32x16& p1, const char* Ks, const bf16x8* qr, const int (&koff)[4], const f32x16& seed) {
#pragma unroll
  for (int d0 = 0; d0 < 4; ++d0) {
    const bf16x8 b0 = *reinterpret_cast<const bf16x8*>(Ks + koff[d0]);
    const bf16x8 b1 = *reinterpret_cast<const bf16x8*>(Ks + koff[d0] + 8192);
    if (d0 == 0) { p0 = __builtin_amdgcn_mfma_f32_32x32x16_bf16(b0, qr[0], seed, 0, 0, 0); p1 = __builtin_amdgcn_mfma_f32_32x32x16_bf16(b1, qr[0], seed, 0, 0, 0); }
    else { p0 = __builtin_amdgcn_mfma_f32_32x32x16_bf16(b0, qr[d0], p0, 0, 0, 0); p1 = __builtin_amdgcn_mfma_f32_32x32x16_bf16(b1, qr[d0], p1, 0, 0, 0); } }
}
__device__ __forceinline__ void partialSM_seeded(f32x16& p0, f32x16& p1, float& m_reg, float& alpha, bool& resc, int mode, int dq, const float* tbl) {
  if (mode == 0) {
#pragma unroll
    for (int r = 0; r < 16; ++r) { const int c0 = (r & 3) + 8 * (r >> 2);
      p0[r] += tbl[dq + c0]; p1[r] += tbl[dq + c0 + 32]; }
  }
  float a = fmaxf(fmaxf(p0[0], p0[1]), p1[0]), b = fmaxf(fmaxf(p0[2], p0[3]), p1[1]); a = fmaxf(fmaxf(a, p1[2]), p1[3]);
#pragma unroll
  for (int r = 4; r < 16; r += 4) { a = fmaxf(fmaxf(a, p0[r]), p0[r + 1]); b = fmaxf(fmaxf(b, p0[r + 2]), p0[r + 3]); a = fmaxf(fmaxf(a, p1[r]), p1[r + 1]); b = fmaxf(fmaxf(b, p1[r + 2]), p1[r + 3]); }
  float pmax = fmaxf(a, b);
  { auto rr = __builtin_amdgcn_permlane32_swap(__float_as_uint(pmax), __float_as_uint(pmax), false, false);
    pmax = fmaxf(__uint_as_float(rr[0]), __uint_as_float(rr[1])); }
  resc = false; alpha = 1.f;
  if (__builtin_expect(!__all(pmax <= THR2), 0)) { const float dl = fmaxf(pmax, 0.f); m_reg += dl; alpha = __builtin_amdgcn_exp2f(-dl); resc = true;
#pragma unroll
    for (int r = 0; r < 16; ++r) { p0[r] -= dl; p1[r] -= dl; } }
#pragma unroll
  for (int r = 0; r < 16; ++r) p0[r] = __builtin_amdgcn_exp2f(p0[r]);
}
__device__ __forceinline__ void partialSM(f32x16& p0, f32x16& p1, float& m_reg, float& mn, float& alpha, int mode, float cL, float cR, int dq, const float* tbl) {
  float cadd;
  if (mode == 0) {
#pragma unroll
    for (int r = 0; r < 16; ++r) { const int c0 = (r & 3) + 8 * (r >> 2);
      p0[r] += tbl[dq + c0]; p1[r] += tbl[dq + c0 + 32]; }
    cadd = 0.f;
  } else cadd = (mode < 0) ? cL : cR;
  float pmax = p0[0];
#pragma unroll
  for (int r = 1; r < 16; ++r) pmax = fmaxf(pmax, p0[r]);
#pragma unroll
  for (int r = 0; r < 16; ++r) pmax = fmaxf(pmax, p1[r]);
  { auto rr = __builtin_amdgcn_permlane32_swap(__float_as_uint(pmax), __float_as_uint(pmax), false, false);
    pmax = fmaxf(__uint_as_float(rr[0]), __uint_as_float(rr[1])); }
  pmax += cadd;
  if (__builtin_expect(__all(pmax - m_reg <= THR2), 1)) { mn = m_reg; alpha = 1.f; }
  else { mn = fmaxf(m_reg, pmax); alpha = __builtin_amdgcn_exp2f(m_reg - mn); m_reg = mn; }
  const float sh = cadd - mn;
#pragma unroll
  for (int r = 0; r < 16; ++r) p0[r] += sh;
#pragma unroll
  for (int r = 0; r < 16; ++r) p1[r] += sh;
#pragma unroll
  for (int r = 0; r < 16; ++r) p0[r] = __builtin_amdgcn_exp2f(p0[r]);
}
__device__ __forceinline__ void finishSM(f32x16& p0, f32x16& p1, bf16x8& pa0, bf16x8& pa1, bf16x8& pa2, bf16x8& pa3) {
#define PK8(P, BASE, OUT) do { v4u w = {cvt_pk_bf16(P[BASE + 0], P[BASE + 1]), cvt_pk_bf16(P[BASE + 2], P[BASE + 3]), cvt_pk_bf16(P[BASE + 4], P[BASE + 5]), cvt_pk_bf16(P[BASE + 6], P[BASE + 7])}; OUT = *reinterpret_cast<bf16x8*>(&w); } while (0)
  PK8(p0, 0, pa0); PK8(p0, 8, pa1); PK8(p1, 0, pa2); PK8(p1, 8, pa3);
#undef PK8
}
__device__ __forceinline__ int rel_bucket(int rel) {
  const int n = rel < 0 ? -rel : rel; int b;
  if (n < 8) b = n; else if (n < 12) b = 8; else if (n < 16) b = 9; else if (n < 23) b = 10; else if (n < 32) b = 11; else if (n < 46) b = 12; else if (n < 64) b = 13; else if (n < 91) b = 14; else b = 15;
  return (rel > 0 ? 16 : 0) + b;
}

__device__ __forceinline__ void attn_unit(int b, int h, int qb, const bf16_t* __restrict__ Q, const bf16_t* __restrict__ K, const bf16_t* __restrict__ V, bf16_t* __restrict__ O,
                                          float lam, float osc, const float* __restrict__ g, const float* __restrict__ rel_bias, char* lds, int tid_in, bool build_tbl, bool o8) {
  int tid_ = tid_in; asm volatile("" : "+v"(tid_));
  const int tid = tid_, wid = __builtin_amdgcn_readfirstlane(tid >> 6), lane = tid & 63, r32 = lane & 31, hi = lane >> 5;
  const int map = wid & 1, jq = wid >> 1;
  char* V_lds = lds + OFF_V; char* K_lds = lds + OFF_K;
  float* ws = (float*)(lds + OFF_WS) + wid * 64; float* li_l = ws; float* al_l = ws + 32;
  float* tbl = (float*)(lds + OFF_TBL);
  if (build_tbl) tbl[tid] = rel_bias[rel_bucket(tid - 256) * NH + h] * LOG2E;
  const float cL = rel_bias[15 * NH + h] * LOG2E, cR = rel_bias[31 * NH + h] * LOG2E;
  const long rowbase = (long)b * SEQ; const int qs = qb * 128 + jq * QBLK;
  float m_reg = -1e30f; f32x16 o[5] = {}; bf16x8 qr[4];
  const bf16_t* Qw = Q + (rowbase + qs + r32) * LDX + h * 128 + map * 64 + hi * 8;
#pragma unroll
  for (int d0 = 0; d0 < 4; ++d0) qr[d0] = *reinterpret_cast<const bf16x8*>(Qw + d0 * 16);
  const bf16_t* Kh = K + rowbase * LDX + h * 128; const bf16_t* Vh = V + rowbase * LDX + h * 128;
  const int vb0 = (int)(uintptr_t)V_lds + v_rd_base(lane);
  const int mapB = map * 128;
  int koff[4];
#pragma unroll
  for (int d0 = 0; d0 < 4; ++d0) koff[d0] = KSWZ(r32, mapB + (d0 * 16 + hi * 8) * 2);
  const int dq0 = 256 + 4 * hi - (qs + r32);
  unsigned ksrc[2], vsrc[2];
#pragma unroll
  for (int i = 0; i < 2; ++i) { const int pk = wid + 8 * i;
    const int krow = 4 * pk + (lane >> 4), kc = (lane & 15) ^ (krow & 7); ksrc[i] = (unsigned)(krow * (LDX * 2) + kc * 16);
    const int st = 2 * pk + (lane >> 5), kk = (st >> 2) * 8 + ((lane & 31) >> 2), vk = kk  , vc = (st & 3) * 32 + (lane & 3) * 8;
    vsrc[i] = (unsigned)(vk * (LDX * 2) + vc * 2); }
  typedef const __attribute__((address_space(1))) unsigned* gptr_t; typedef __attribute__((address_space(3))) unsigned* lptr_t;
  const char* const Kg = (const char*)Kh; const char* const Vg = (const char*)Vh;
  const lptr_t kdst = (lptr_t)(__attribute__((address_space(3))) char*)(K_lds) + 0; (void)kdst;
#define DMA_TILE(t, slot) do { const unsigned tb_ = (unsigned)(t) * (unsigned)(KVBLK * LDX * 2); \
    _Pragma("unroll") for (int i_ = 0; i_ < 2; ++i_) { \
      __builtin_amdgcn_global_load_lds((gptr_t)(Kg + (ksrc[i_] + tb_)), (lptr_t)((__attribute__((address_space(3))) char*)K_lds + (slot) + (wid + 8 * i_) * 1024), 16, 0, 0); \
      __builtin_amdgcn_global_load_lds((gptr_t)(Vg + (vsrc[i_] + tb_)), (lptr_t)((__attribute__((address_space(3))) char*)V_lds + (slot) + (wid + 8 * i_) * 1024), 16, 0, 0); } } while (0)
#define WAIT_BAR() do { asm volatile("s_waitcnt vmcnt(0) lgkmcnt(0)" ::: "memory"); __builtin_amdgcn_s_barrier(); asm volatile("" ::: "memory"); } while (0)
#define RESC(a, rs) do { if (rs) { if (hi == 0) al_l[r32] = (a); asm volatile("s_waitcnt lgkmcnt(0)" ::: "memory"); \
    _Pragma("unroll") for (int d = 0; d < 5; ++d) _Pragma("unroll") for (int r = 0; r < 16; ++r) o[d][r] *= al_l[crow(r, hi)]; } } while (0)
#define SEED(md) do { const int md_ = (md); const float sv_ = (md_ == 0 ? 0.f : (md_ < 0 ? cL : cR)) - m_reg; _Pragma("unroll") for (int r = 0; r < 16; ++r) seed[r] = sv_; } while (0)
#define TMODE(k0) (((k0) >= qs + 122) ? 1 : (((k0) <= qs - 154) ? -1 : 0))
#define ROT() do { const int t_ = sl_prev; sl_prev = sl_cur; sl_cur = sl_next; sl_next = t_; } while (0)
  f32x16 pA0, pA1, pB0, pB1, seed; float mnA, alA, alB; bool rsA = false, rsB = false; bf16x8 pa0, pa1, pa2, pa3;
  int sl_prev = 2 * SHM_V, sl_cur = 0, sl_next = SHM_V;
  if (wid >= 4) __builtin_amdgcn_s_setprio(1);
  DMA_TILE(0, 0); DMA_TILE(1, SHM_V);
  WAIT_BAR();
  DMA_TILE(2, 2 * SHM_V);
  qkt(pA0, pA1, K_lds, qr, r32, hi, mapB); partialSM(pA0, pA1, m_reg, mnA, alA, TMODE(0), cL, cR, dq0, tbl);
  _Pragma("unroll") for (int r = 0; r < 16; ++r) pA1[r] = __builtin_amdgcn_exp2f(pA1[r]);
  ROT();
#define QK_SEEDED(P0, P1, DMA_STMT, SEED_STMT) do { bf16x8 k0_[4], k1_[4]; const char* Ks_ = K_lds + sl_cur; \
    _Pragma("unroll") for (int d0 = 0; d0 < 4; ++d0) { k0_[d0] = *reinterpret_cast<const bf16x8*>(Ks_ + koff[d0]); k1_[d0] = *reinterpret_cast<const bf16x8*>(Ks_ + koff[d0] + 8192); } \
    DMA_STMT; SEED_STMT; \
    P0 = __builtin_amdgcn_mfma_f32_32x32x16_bf16(k0_[0], qr[0], seed, 0, 0, 0); P1 = __builtin_amdgcn_mfma_f32_32x32x16_bf16(k1_[0], qr[0], seed, 0, 0, 0); \
    _Pragma("unroll") for (int d0 = 1; d0 < 4; ++d0) { P0 = __builtin_amdgcn_mfma_f32_32x32x16_bf16(k0_[d0], qr[d0], P0, 0, 0, 0); P1 = __builtin_amdgcn_mfma_f32_32x32x16_bf16(k1_[d0], qr[d0], P1, 0, 0, 0); } } while (0)
  for (int j = 1; j + 1 < NT; j += 2) {
    SBAR(); QK_SEEDED(pB0, pB1, if (j > 1) DMA_TILE(j + 1, sl_next), SEED(TMODE(j * KVBLK)));
    finishSM(pA0, pA1, pa0, pa1, pa2, pa3); SBAR();
    if (TMODE(j * KVBLK) == 0) near_bias(pB0, pB1, dq0 + j * KVBLK, tbl);
    pv_softmax(o, vb0 + sl_prev, pa0, pa1, pa2, pa3, pB0, pB1, m_reg, alB, rsB);
    WAIT_BAR();
    RESC(alB, rsB); ROT();
    SBAR(); QK_SEEDED(pA0, pA1, DMA_TILE(j + 2, sl_next), SEED(TMODE((j + 1) * KVBLK)));
    finishSM(pB0, pB1, pa0, pa1, pa2, pa3); SBAR();
    if (TMODE((j + 1) * KVBLK) == 0) near_bias(pA0, pA1, dq0 + (j + 1) * KVBLK, tbl);
    pv_softmax(o, vb0 + sl_prev, pa0, pa1, pa2, pa3, pA0, pA1, m_reg, alA, rsA);
    WAIT_BAR();
    RESC(alA, rsA); ROT();
  }
  SBAR(); QK_SEEDED(pB0, pB1, (void)0, SEED(TMODE((NT - 1) * KVBLK)));
  finishSM(pA0, pA1, pa0, pa1, pa2, pa3); SBAR();
  if (TMODE((NT - 1) * KVBLK) == 0) near_bias(pB0, pB1, dq0 + (NT - 1) * KVBLK, tbl);
  pv_softmax(o, vb0 + sl_prev, pa0, pa1, pa2, pa3, pB0, pB1, m_reg, alB, rsB);
  RESC(alB, rsB);
  finishSM(pB0, pB1, pa0, pa1, pa2, pa3); SBAR();
  pv_d0(o, vb0 + sl_cur, pa0, pa1, pa2, pa3);
  __builtin_amdgcn_s_setprio(0);
  float rli[16];
#pragma unroll
  for (int r = 0; r < 16; ++r) rli[r] = __builtin_amdgcn_rcpf(o[4][r]);
  __syncthreads();
  float* X = (float*)(lds + jq * 16384);
  if (map == 1) {
#pragma unroll
    for (int r = 0; r < 16; ++r) { const int orow = crow(r, hi); const float s = rli[r] * lam;
#pragma unroll
      for (int d0 = 0; d0 < 4; ++d0) X[orow * 128 + d0 * 32 + r32] = o[d0][r] * s; }
  }
  __syncthreads();
  if (map == 0) {
    float ss[16];
#pragma unroll
    for (int r = 0; r < 16; ++r) { const int orow = crow(r, hi); float a = 0.f;
#pragma unroll
      for (int d0 = 0; d0 < 4; ++d0) { const float v = o[d0][r] * rli[r] - X[orow * 128 + d0 * 32 + r32]; o[d0][r] = v; a += v * v; }
      ss[r] = a; }
#pragma unroll
    for (int s = 1; s < 32; s <<= 1)
#pragma unroll
      for (int r = 0; r < 16; ++r) ss[r] += shx(ss[r], s);
    float gg[4];
#pragma unroll
    for (int d0 = 0; d0 < 4; ++d0) gg[d0] = g[d0 * 32 + r32] * osc;
    asm volatile("s_waitcnt lgkmcnt(0)" ::: "memory");
    bf16_t* stg = (bf16_t*)X;
#pragma unroll
    for (int r = 0; r < 16; ++r) { const int orow = crow(r, hi); const float rs = __builtin_amdgcn_rsqf(ss[r] * (1.0f / 128.0f) + LN_EPS);
#pragma unroll
      for (int d0 = 0; d0 < 4; ++d0) { const float v = o[d0][r] * rs * gg[d0]; stg[orow * 128 + d0 * 32 + r32] = (bf16_t)(cvt_pk_bf16(v, v) & 0xffffu); } }
    asm volatile("s_waitcnt lgkmcnt(0)" ::: "memory");
    bf16_t* Ow = O + (rowbase + qs) * LDX + h * 128;
#pragma unroll
    for (int i = 0; i < 8; ++i) { const int row = i * 4 + (lane >> 4), ch = lane & 15; const v4u v = *(const v4u*)(stg + row * 128 + ch * 8);
      if (!o8) *(v4u*)(Ow + (long)row * LDX + ch * 8) = v;
      else { typedef unsigned u32x2 __attribute__((ext_vector_type(2))); u32x2 q8; q8.x = pg8::pk4_fp8(bf_lo(v.x), bf_hi(v.x), bf_lo(v.y), bf_hi(v.y)); q8.y = pg8::pk4_fp8(bf_lo(v.z), bf_hi(v.z), bf_lo(v.w), bf_hi(v.w));
        *(u32x2*)((unsigned char*)O + (size_t)(rowbase + qs + row) * LDX + h * 128 + ch * 8) = q8; } }
    asm volatile("s_waitcnt lgkmcnt(0)" ::: "memory");
  }
  __syncthreads();
#undef DMA_TILE
#undef WAIT_BAR
#undef ROT
#undef RESC
#undef SEED
#undef QK_SEEDED
#undef TMODE
}
#undef KSWZ
#undef SBAR
}

#define XB_TMO      128
#define XB_XCNT(j)  (256  + 64 * (j))
#define XB_XSUB(j)  (1280 + 64 * (j))
#define XB_XGEN(j)  (2304 + 64 * (j))
#define XB_TOP      3328
#define XB_TOPGEN   3392
#define XCD_BAR_WORDS 3456
#define XB_SPIN_CAP (1u << 18)
__device__ __forceinline__ unsigned xb_ld(unsigned* p)              { return __hip_atomic_load(p, __ATOMIC_RELAXED, __HIP_MEMORY_SCOPE_AGENT); }
__device__ __forceinline__ unsigned xb_add(unsigned* p, unsigned v) { return __hip_atomic_fetch_add(p, v, __ATOMIC_RELAXED, __HIP_MEMORY_SCOPE_AGENT); }
__device__ __forceinline__ unsigned xb_xcc_id() { return (unsigned)__builtin_amdgcn_s_getreg((3 << 11) | 20) & 0xFu; }
#define XB_SPIN(cond, bar) do { unsigned _sp = 0; while (cond) { __builtin_amdgcn_s_sleep(1); \
    if ((++_sp & 255u) == 0u) { if (xb_ld(&(bar)[XB_TMO])) break; if (_sp > XB_SPIN_CAP) { atomicAdd(&(bar)[XB_TMO], 1u); break; } } } } while (0)
struct XcdBarrier { unsigned* bar; unsigned x; volatile LAS unsigned* st; };
__device__ __forceinline__ XcdBarrier xcd_barrier_post(unsigned* bar, volatile LAS unsigned* st) {
    XcdBarrier b; b.bar = bar; b.x = xb_xcc_id(); b.st = st;
    if (threadIdx.x == 0) (void)xb_add(&bar[XB_XCNT(b.x)], 1u);
    return b;
}
__device__ __forceinline__ void xcd_barrier_complete(unsigned* bar, unsigned x, unsigned& nloc, unsigned& nx) {
    const unsigned G = gridDim.x * gridDim.y * gridDim.z;
    unsigned sum, cnt, mine, sp = 0u;
    for (;;) {
        sum = 0u; cnt = 0u; mine = 0u;
#pragma unroll
        for (unsigned j = 0; j < 16; ++j) { const unsigned c = xb_ld(&bar[XB_XCNT(j)]); sum += c; cnt += (c > 0u) ? 1u : 0u; mine = (j == x) ? c : mine; }
        if (sum == G) break;
        __builtin_amdgcn_s_sleep(1);
        if ((++sp & 255u) == 0u) { if (xb_ld(&bar[XB_TMO])) break; if (sp > XB_SPIN_CAP) { atomicAdd(&bar[XB_TMO], 1u); break; } }
    }
    nloc = mine > 0u ? mine : 1u; nx = cnt > 0u ? cnt : 1u;
}
__device__ __forceinline__ void xcd_barrier(const XcdBarrier& b) {
    asm volatile("s_waitcnt vmcnt(0)" ::: "memory");
    __syncthreads();
    if (threadIdx.x == 0) {
        unsigned* bar = b.bar;
        __builtin_amdgcn_s_waitcnt(0);
        unsigned nloc = b.st[0], nx = b.st[1];
        if (nloc == 0u) { xcd_barrier_complete(bar, b.x, nloc, nx); b.st[0] = nloc; b.st[1] = nx; }
        const unsigned old = xb_add(&bar[XB_XSUB(b.x)], 1u);
        const unsigned gen = old / nloc;
        if (old + 1u == (gen + 1u) * nloc) {
            __builtin_amdgcn_fence(__ATOMIC_RELEASE, "agent");
            asm volatile("s_waitcnt vmcnt(0)" ::: "memory");
            const unsigned og = xb_add(&bar[XB_TOP], 1u);
            const unsigned tg = og / nx;
            if (og + 1u == (tg + 1u) * nx) xb_add(&bar[XB_TOPGEN], 1u);
            else XB_SPIN(xb_ld(&bar[XB_TOPGEN]) == tg, bar);
            __builtin_amdgcn_fence(__ATOMIC_ACQUIRE, "agent");
            xb_add(&bar[XB_XGEN(b.x)], 1u);
            asm volatile("s_waitcnt vmcnt(0)" ::: "memory");
        } else {
            XB_SPIN(xb_ld(&bar[XB_XGEN(b.x)]) == gen, bar);
            __builtin_amdgcn_fence(__ATOMIC_ACQUIRE, "agent");
            asm volatile("s_waitcnt vmcnt(0)" ::: "memory");
        }
    }
    __syncthreads();
}

template <int MODE> __device__ __forceinline__ int dst_row(int n) {
    if (MODE == 1) { if (n < 1024) return n; const int b = (n - 1024) >> 10, f = (n - 1024) & 1023; return 1024 + (f >> 7) * 256 + b * 128 + (f & 127); }
    if (MODE == 2) { const int b = n & 1, j = n >> 1; return (j >> 7) * 256 + b * 128 + (j & 127); }
    return n;
}
template <int MODE> __device__ __forceinline__ void p0_transpose_item(const float* W, int K, int N, bf16_t* WT, LAS float* scr, int item, int lane, const float* kscale = nullptr) {
    const int nblk = N / 32, kb = item / nblk, nb = item % nblk, k0 = 64 * kb, n0 = 32 * nb;
#pragma unroll 8
    for (int i = 0; i < 32; ++i) { const int kk = 2 * i + (lane >> 5); float w = W[(size_t)(k0 + kk) * N + n0 + (lane & 31)]; if (kscale) w *= kscale[k0 + kk]; scr[kk * 33 + (lane & 31)] = w; }
    LDS_WAIT(); asm volatile("" ::: "memory");
    const int c = lane & 7;
#pragma unroll
    for (int j = 0; j < 4; ++j) { const int n = (lane >> 3) + 8 * j; const LAS float* s = scr + (8 * c) * 33 + n;
        v4u o; o.x = cvt_pk_bf16(s[0 * 33], s[1 * 33]); o.y = cvt_pk_bf16(s[2 * 33], s[3 * 33]); o.z = cvt_pk_bf16(s[4 * 33], s[5 * 33]); o.w = cvt_pk_bf16(s[6 * 33], s[7 * 33]);
        *(GAS v4u*)(WT + (size_t)dst_row<MODE>(n0 + n) * K + k0 + 8 * c) = o; }
    LDS_WAIT(); asm volatile("" ::: "memory");
}

template <int MODE, bool I8 = false> __device__ __forceinline__ void p0_quant_strip(const float* W, int N, unsigned char* W8, float* SC, int strip, LAS unsigned char* lds, int wave, int lane) {
    constexpr float QM_ = I8 ? 127.0f : F8MAX;
    LAS float* scr = (LAS float*)(lds + wave * 16384); LAS float* red = (LAS float*)(lds + LDSCTL_OFF + 2048);
    const int n0 = strip * 32, k0 = wave * 128, kk = lane >> 5, n = lane & 31;
    float am = 0.f;
    { const char* Wb = (const char*)W + (size_t)k0 * N * 4; const unsigned loff = (unsigned)((kk * N + n0 + n) * 4);
      float vv[64];
#pragma unroll
      for (int i = 0; i < 64; ++i) vv[i] = *(const float*)(Wb + (size_t)i * (size_t)(2 * N * 4) + loff);
#pragma unroll
      for (int i = 0; i < 64; ++i) { scr[(2 * i + kk) * 32 + n] = vv[i]; am = fmaxf(am, fabsf(vv[i])); } }
    am = fmaxf(am, shx(am, 32));
    if (lane < 32) red[wave * 32 + n] = am;
    __syncthreads();
    float amax = red[n];
#pragma unroll
    for (int w = 1; w < 8; ++w) amax = fmaxf(amax, red[w * 32 + n]);
    const float q = amax > 0.f ? QM_ / amax : 0.f;
    const int dr = dst_row<MODE>(n0 + n);
    if (wave == 0 && lane < 32) SC[dr] = amax * (1.0f / QM_);
#pragma unroll
    for (int c = 0; c < 4; ++c) { float v[16];
#pragma unroll
        for (int j = 0; j < 16; ++j) v[j] = scr[(kk * 64 + c * 16 + j) * 32 + n] * q;
        v4u o; o.x = pg8::pkq4<I8>(v[0], v[1], v[2], v[3]); o.y = pg8::pkq4<I8>(v[4], v[5], v[6], v[7]); o.z = pg8::pkq4<I8>(v[8], v[9], v[10], v[11]); o.w = pg8::pkq4<I8>(v[12], v[13], v[14], v[15]);
        *(GAS v4u*)(W8 + (size_t)dr * 1024 + k0 + kk * 64 + c * 16) = o; }
    __syncthreads();
}
struct StripSrc { const float* W; int N; unsigned char* W8; float* SC; int strip; bool glu; };
__device__ __forceinline__ void dstrip_desc(const float* w1, const float* w2, unsigned char* ws, int st, StripSrc& d) {
    if (st < 128 * 64) { const int j = st >> 6; d.W = w1 + (size_t)j * 1024 * 2048; d.N = 2048; d.W8 = ws + WS_W1 + (size_t)j * 2048 * 1024; d.SC = (float*)(ws + WS_S1) + (size_t)j * 2048; d.strip = st & 63; d.glu = true; }
    else { const int q = st - 128 * 64, j = q >> 5; d.W = w2 + (size_t)j * 1024 * 1024; d.N = 1024; d.W8 = ws + WS_W2 + (size_t)j * 1024 * 1024; d.SC = (float*)(ws + WS_S2) + (size_t)j * 1024; d.strip = q & 31; d.glu = false; }
}
__device__ __forceinline__ void dstrip_issue(const StripSrc& d, int wave, int lane, f32x4 (&vv)[16]) {
    const int n0 = d.strip * 32, k0 = wave * 128, r8 = lane >> 3, cg = lane & 7;
    const char* Wb = (const char*)d.W + (size_t)k0 * d.N * 4; const unsigned loff = (unsigned)((r8 * d.N + n0 + 4 * cg) * 4); const size_t rs8 = (size_t)d.N * 32;
#pragma unroll
    for (int i = 0; i < 16; ++i) vv[i] = *(const f32x4*)(Wb + (size_t)i * rs8 + loff);
}
__device__ __forceinline__ void dstrip_finish(const StripSrc& d, LAS unsigned char* lds, int wave, int lane, int par, f32x4 (&vv)[16]) {
    LAS float* scr = (LAS float*)(lds + wave * 16384); LAS float* red = (LAS float*)(lds + LDSCTL_OFF + 2048 + par * 1024);
    const int n0 = d.strip * 32, k0 = wave * 128, kk = lane >> 5, n = lane & 31, r8 = lane >> 3, cg = lane & 7;
    f32x4 am = {0.f, 0.f, 0.f, 0.f};
#pragma unroll
    for (int i = 0; i < 16; ++i) { *(LAS f32x4*)(scr + (8 * i + r8) * 32 + 4 * cg) = vv[i];
#pragma unroll
        for (int j = 0; j < 4; ++j) am[j] = fmaxf(am[j], fabsf(vv[i][j])); }
    { const int l_ = lane_local();
#pragma unroll
      for (int o = 8; o < 64; o <<= 1)
#pragma unroll
        for (int j = 0; j < 4; ++j) am[j] = fmaxf(am[j], shx(am[j], o, l_)); }
    if (lane < 8) *(LAS f32x4*)(red + wave * 32 + 4 * cg) = am;
    asm volatile("s_waitcnt lgkmcnt(0)" ::: "memory"); __builtin_amdgcn_s_barrier(); asm volatile("" ::: "memory");
    float amax = red[n];
#pragma unroll
    for (int w = 1; w < 8; ++w) amax = fmaxf(amax, red[w * 32 + n]);
    const float q = amax > 0.f ? F8MAX / amax : 0.f;
    const int dr = d.glu ? dst_row<2>(n0 + n) : (n0 + n);
    if (wave == 0 && lane < 32) d.SC[dr] = amax * (1.0f / F8MAX);
#pragma unroll
    for (int c = 0; c < 4; ++c) { float v[16];
#pragma unroll
        for (int j = 0; j < 16; ++j) v[j] = scr[(kk * 64 + c * 16 + j) * 32 + n] * q;
        v4u o; o.x = pg8::pk4_fp8(v[0], v[1], v[2], v[3]); o.y = pg8::pk4_fp8(v[4], v[5], v[6], v[7]); o.z = pg8::pk4_fp8(v[8], v[9], v[10], v[11]); o.w = pg8::pk4_fp8(v[12], v[13], v[14], v[15]);
        *(GAS v4u*)(d.W8 + (size_t)dr * 1024 + k0 + kk * 64 + c * 16) = o; }
    asm volatile("s_waitcnt lgkmcnt(0)" ::: "memory");
}
__device__ __forceinline__ void deferred_strips(const float* w1, const float* w2, unsigned char* ws, LAS unsigned char* lds, int first, int NT, int wave, int lane) {
    constexpr int stride = 1;
    auto stq = [](int idx) { return idx; };
    f32x4 va[16], vb[16]; StripSrc da, db; int idx = first, par = 0;
    if (idx < NT) { dstrip_desc(w1, w2, ws, stq(idx), da); dstrip_issue(da, wave, lane, va); }
#pragma unroll 1
    while (idx < NT) {
        const int i1 = idx + stride; if (i1 < NT) { dstrip_desc(w1, w2, ws, stq(i1), db); dstrip_issue(db, wave, lane, vb); }
        dstrip_finish(da, lds, wave, lane, par, va); par ^= 1;
        if (i1 >= NT) break;
        const int i2 = i1 + stride; if (i2 < NT) { dstrip_desc(w1, w2, ws, stq(i2), da); dstrip_issue(da, wave, lane, va); }
        dstrip_finish(db, lds, wave, lane, par, vb); par ^= 1;
        idx = i2;
    }
    __syncthreads();
}
__device__ __forceinline__ float ln_bound(const float* g, const float* b, int lane) {
    float mg = 0.f, mb = 0.f;
#pragma unroll
    for (int j = 0; j < 4; ++j) { const f32x4 a = *(const f32x4*)(g + j * 256 + lane * 4), c = *(const f32x4*)(b + j * 256 + lane * 4);
        mg = fmaxf(mg, fmaxf(fmaxf(fabsf(a[0]), fabsf(a[1])), fmaxf(fabsf(a[2]), fabsf(a[3])))); mb = fmaxf(mb, fmaxf(fmaxf(fabsf(c[0]), fabsf(c[1])), fmaxf(fabsf(c[2]), fabsf(c[3])))); }
#pragma unroll
    for (int o = 1; o < 64; o <<= 1) { mg = fmaxf(mg, shx(mg, o)); mb = fmaxf(mb, shx(mb, o)); }
    return 31.984371f * mg + mb;
}

struct Ptrs {
    const float *x, *rel_bias, *attn_w_in, *attn_lambda, *attn_subln, *attn_w_out, *conv_w_in, *conv_w, *conv_w_out, *router_w, *router_b, *w1, *b1, *w2, *b2, *ln_g, *ln_b;
    float* out; unsigned char* ws;
};

#ifndef DEFER_W
#define DEFER_W 1
#endif
__device__ __forceinline__ void expert_strip(const Ptrs& P, int st, LAS unsigned char* lds, int wave, int lane) {
    unsigned char* ws = P.ws;
    if (st < 128 * 64) { const int j = st >> 6, r = st & 63; p0_quant_strip<2>(P.w1 + (size_t)j * 1024 * 2048, 2048, ws + WS_W1 + (size_t)j * 2048 * 1024, (float*)(ws + WS_S1) + (size_t)j * 2048, r, lds, wave, lane); }
    else { const int q = st - 128 * 64, j = q >> 5, r = q & 31; p0_quant_strip<0>(P.w2 + (size_t)j * 1024 * 1024, 1024, ws + WS_W2 + (size_t)j * 1024 * 1024, (float*)(ws + WS_S2) + (size_t)j * 1024, r, lds, wave, lane); }
}
constexpr int NWAVES_ = 8;
__device__ __forceinline__ void p0_prologue(const Ptrs& P, LAS unsigned char* lds, int gw, int NGW, int wave, int lane) {
    LAS float* scr = (LAS float*)(lds + RING_OFF + wave * 16384);
    unsigned char* ws = P.ws;
    constexpr int I_OUT = 16 * 32, I_R = 16;
    constexpr int I_IN = 16 * 96;
    constexpr int S1 = NA16 * I_OUT, S3 = S1 + NO16 * I_OUT, S4 = S3 + 4 * I_R, S5 = S4 + NQ16 * I_IN, S6 = S5 + NC16 * I_IN;
    { const int wg = gw / NWAVES_, NWG = NGW / NWAVES_;
      constexpr int T1 = 128 * 64, T2 = T1 + 128 * 32, T3 = T2 + NQ8 * 96, T4 = T3 + NC8 * 96, T5 = T4 + NA8 * 32, T6 = T5 + NO8 * 32;
      constexpr int NE0 = DEFER_W ? 0 : T2;
#pragma unroll 1
      for (int s0 = wg; s0 < NE0 + (T6 - T2); s0 += NWG) {
        const int st = (s0 >= NE0) ? T2 + (s0 - NE0) : s0;
        if (st < T2) expert_strip(P, st, lds, wave, lane);
        else if (st < T3) { const int q = st - T2, j = QJ0 + q / 96, r = q % 96; p0_quant_strip<0, I8P>(P.attn_w_in + (size_t)j * 1024 * 3072, 3072, ws + WS_WAI + (size_t)j * 3072 * 1024, (float*)(ws + WS_SD) + (size_t)j * 3072, r, lds, wave, lane); }
        else if (st < T4) { const int q = st - T3, j = CJ0 + q / 96, r = q % 96; p0_quant_strip<1, I8P>(P.conv_w_in + (size_t)j * 1024 * 3072, 3072, ws + WS_WCI + (size_t)j * 3072 * 1024, (float*)(ws + WS_SD + 32 * 1024) + (size_t)j * 3072, r, lds, wave, lane); }
        else if (st < T5) { const int q = st - T4, j = AJ0 + q / 32, r = q % 32; p0_quant_strip<0>(P.attn_w_out + (size_t)j * 1024 * 1024, 1024, ws + WS_WAO8 + (size_t)j * 1024 * 1024, (float*)(ws + WS_SD + 24 * 1024) + (size_t)j * 1024, r, lds, wave, lane); }
        else { const int q = st - T5, j = OJ0 + q / 32, r = q % 32; p0_quant_strip<0, I8P>(P.conv_w_out + (size_t)j * 1024 * 1024, 1024, ws + WS_WCO8 + (size_t)j * 1024 * 1024, (float*)(ws + WS_SD + 56 * 1024) + (size_t)j * 1024, r, lds, wave, lane); }
      } }
    for (int it = gw; it < S6; it += NGW) {
        if (it >= S5) { const int q = it - S5, j = CK0 + q / I_IN, r = q % I_IN; p0_transpose_item<1>(P.conv_w_in + (size_t)j * 1024 * 3072, 1024, 3072, (bf16_t*)(ws + WS_WC16) + (size_t)j * 3072 * 1024, scr, r, lane); }
        else if (it >= S4) { const int q = it - S4, j = QK0 + q / I_IN, r = q % I_IN; p0_transpose_item<0>(P.attn_w_in + (size_t)j * 1024 * 3072, 1024, 3072, (bf16_t*)(ws + WS_WA16) + (size_t)j * 3072 * 1024, scr, r, lane); }
        else if (it < S1) { const int q = it, j = AK0 + q / I_OUT, r = q % I_OUT; p0_transpose_item<0>(P.attn_w_out + (size_t)j * 1024 * 1024, 1024, 1024, (bf16_t*)(ws + WS_WAO) + (size_t)j * 1024 * 1024, scr, r, lane); }
        else if (it < S3) { const int q = it - S1, j = OK0 + q / I_OUT, r = q % I_OUT; p0_transpose_item<0>(P.conv_w_out + (size_t)j * 1024 * 1024, 1024, 1024, (bf16_t*)(ws + WS_WCO) + (size_t)j * 1024 * 1024, scr, r, lane); }
        else { const int q = it - S3, j = q / I_R, r = q % I_R; p0_transpose_item<0>(P.router_w + (size_t)j * 1024 * 32, 1024, 32, (bf16_t*)(ws + WS_WR) + (size_t)j * 32 * 1024, scr, r, lane, P.ln_g + (size_t)(j * 2 + 0) * D); }
    }
    for (int row = gw; row < M; row += NGW) {
        f32x4 a[2][2]; float am = 0.f;
#pragma unroll
        for (int h = 0; h < 2; ++h)
#pragma unroll
            for (int q = 0; q < 2; ++q) { a[h][q] = *(const GAS f32x4*)(P.x + (size_t)row * D + h * 512 + lane * 8 + q * 4);
                am = fmaxf(am, fmaxf(fmaxf(fabsf(a[h][q][0]), fabsf(a[h][q][1])), fmaxf(fabsf(a[h][q][2]), fabsf(a[h][q][3])))); }
#pragma unroll
        for (int o = 1; o < 64; o <<= 1) am = fmaxf(am, shx(am, o));
        const float qs = QMAXP / fmaxf(am, 1e-30f);
        if ((QM & 1) && lane == 0) ((float*)(ws + WS_RS))[row] = am * (1.0f / QMAXP);
#pragma unroll
        for (int h = 0; h < 2; ++h) { v4u o; o.x = cvt_pk_bf16(a[h][0][0], a[h][0][1]); o.y = cvt_pk_bf16(a[h][0][2], a[h][0][3]); o.z = cvt_pk_bf16(a[h][1][0], a[h][1][1]); o.w = cvt_pk_bf16(a[h][1][2], a[h][1][3]);
            *(GAS v4u*)((bf16_t*)(ws + WS_XB) + (size_t)row * D + h * 512 + lane * 8) = o;
            if (QM & 1) { typedef unsigned u32x2 __attribute__((ext_vector_type(2))); u32x2 q8;
            q8.x = pg8::pkq4<I8P>(a[h][0][0] * qs, a[h][0][1] * qs, a[h][0][2] * qs, a[h][0][3] * qs); q8.y = pg8::pkq4<I8P>(a[h][1][0] * qs, a[h][1][1] * qs, a[h][1][2] * qs, a[h][1][3] * qs);
            *(GAS u32x2*)(ws + WS_XI + (size_t)row * D + h * 512 + lane * 8) = q8; } }
    }
}

__device__ __forceinline__ void conv_phase(const bf16_t* GB, const bf16_t* Z, const float* cw, bf16_t* Gout, float* RS, bool o8, int gw, int NGW, int lane) {
    float w[3][16];
#pragma unroll
    for (int j = 0; j < 3; ++j)
#pragma unroll
        for (int h = 0; h < 2; ++h)
#pragma unroll
            for (int q = 0; q < 2; ++q) { const f32x4 t = *(const f32x4*)(cw + j * D + h * 512 + lane * 8 + q * 4); w[j][h * 8 + q * 4 + 0] = t[0]; w[j][h * 8 + q * 4 + 1] = t[1]; w[j][h * 8 + q * 4 + 2] = t[2]; w[j][h * 8 + q * 4 + 3] = t[3]; }
    for (int run = gw; run < M / 32; run += NGW) {
        const int t0 = run * 32; const bool first = (t0 % SEQ) == 0, lastr = ((t0 + 32) % SEQ) == 0;
        v4u zp[2], zc[2], zn[2];
#pragma unroll
        for (int h = 0; h < 2; ++h) { zp[h] = first ? (v4u){0u, 0u, 0u, 0u} : *(const v4u*)(Z + (size_t)(t0 - 1) * D + h * 512 + lane * 8); zc[h] = *(const v4u*)(Z + (size_t)t0 * D + h * 512 + lane * 8); }
        for (int r = 0; r < 32; ++r) { const int t = t0 + r; const bool pad = lastr && (r == 31);
            float o[2][8];
#pragma unroll
            for (int h = 0; h < 2; ++h) {
                zn[h] = pad ? (v4u){0u, 0u, 0u, 0u} : *(const v4u*)(Z + (size_t)(t + 1) * D + h * 512 + lane * 8);
                const v4u gb = *(const v4u*)(GB + (size_t)t * D + h * 512 + lane * 8);
#pragma unroll
                for (int q = 0; q < 4; ++q) { const unsigned up = zp[h][q], uc = zc[h][q], un = zn[h][q], ug = gb[q]; const int c = h * 8 + q * 2;
                    o[h][q * 2 + 0] = bf_lo(ug) * (w[0][c] * bf_lo(up) + w[1][c] * bf_lo(uc) + w[2][c] * bf_lo(un));
                    o[h][q * 2 + 1] = bf_hi(ug) * (w[0][c + 1] * bf_hi(up) + w[1][c + 1] * bf_hi(uc) + w[2][c + 1] * bf_hi(un)); }
                if (!o8) { v4u ov; ov.x = cvt_pk_bf16(o[h][0], o[h][1]); ov.y = cvt_pk_bf16(o[h][2], o[h][3]); ov.z = cvt_pk_bf16(o[h][4], o[h][5]); ov.w = cvt_pk_bf16(o[h][6], o[h][7]);
                    *(v4u*)(Gout + (size_t)t * D + h * 512 + lane * 8) = ov; }
                zp[h] = zc[h]; zc[h] = zn[h];
            }
            if (o8) { float am = 0.f;
#pragma unroll
                for (int h = 0; h < 2; ++h)
#pragma unroll
                    for (int i = 0; i < 8; ++i) am = fmaxf(am, fabsf(o[h][i]));
#pragma unroll
                for (int s_ = 1; s_ < 64; s_ <<= 1) am = fmaxf(am, shx(am, s_));
                const float qs = QMAXP / fmaxf(am, 1e-30f);
                if (lane == 0) RS[t] = am * (1.0f / QMAXP);
#pragma unroll
                for (int h = 0; h < 2; ++h) { typedef unsigned u32x2 __attribute__((ext_vector_type(2))); u32x2 q8;
                    q8.x = pg8::pkq4<I8P>(o[h][0] * qs, o[h][1] * qs, o[h][2] * qs, o[h][3] * qs); q8.y = pg8::pkq4<I8P>(o[h][4] * qs, o[h][5] * qs, o[h][6] * qs, o[h][7] * qs);
                    *(u32x2*)((unsigned char*)Gout + (size_t)t * D + h * 512 + lane * 8) = q8; } }
        }
    }
}

__device__ __forceinline__ void ln2_phase(const bf16_t* Yp, const float* g1, const float* b1, const unsigned char* Y, const float* g, const float* bta, bf16_t* XB, float* out, unsigned char* XI, float* RS, int gw, int NGW, int lane) {
    float gg[16], bb[16];
#pragma unroll
    for (int h = 0; h < 2; ++h)
#pragma unroll
        for (int q = 0; q < 2; ++q) { const f32x4 t = *(const f32x4*)(g + h * 512 + lane * 8 + q * 4), s = *(const f32x4*)(bta + h * 512 + lane * 8 + q * 4);
#pragma unroll
            for (int i = 0; i < 4; ++i) { gg[h * 8 + q * 4 + i] = t[i]; bb[h * 8 + q * 4 + i] = s[i]; } }
    float sXb = 0.f, rsXb = 0.f; if constexpr (!I8P) { const float lb = ln_bound(g, bta, lane); sXb = F8MAX / lb; rsXb = lb * (1.0f / F8MAX); }
    for (int row = gw; row < M; row += NGW) {
        float v[16];
#pragma unroll
        for (int h = 0; h < 2; ++h) { const v4u xr = *(const v4u*)(Yp + (size_t)row * D + h * 512 + lane * 8);
#pragma unroll
            for (int q = 0; q < 4; ++q) { v[h * 8 + q * 2] = bf_lo(xr[q]); v[h * 8 + q * 2 + 1] = bf_hi(xr[q]); } }
        { float s1 = 0.f;
#pragma unroll
          for (int i = 0; i < 16; ++i) s1 += v[i];
          const float m1 = wave_sum(s1) * (1.f / D); float q1 = 0.f;
#pragma unroll
          for (int i = 0; i < 16; ++i) { v[i] -= m1; q1 += v[i] * v[i]; }
          const float r1 = ALPHA / sqrtf(wave_sum(q1) * (1.f / D) + LN_EPS);
#pragma unroll
          for (int h = 0; h < 2; ++h)
#pragma unroll
            for (int q = 0; q < 2; ++q) { const f32x4 t = *(const f32x4*)(g1 + h * 512 + lane * 8 + q * 4), u = *(const f32x4*)(b1 + h * 512 + lane * 8 + q * 4);
#pragma unroll
              for (int i = 0; i < 4; ++i) v[h * 8 + q * 4 + i] = v[h * 8 + q * 4 + i] * r1 * t[i] + ALPHA * u[i]; } }
#pragma unroll
        for (int k = 0; k < 4; ++k)
#pragma unroll
            for (int h = 0; h < 2; ++h) { typedef unsigned u32x2 __attribute__((ext_vector_type(2))); const u32x2 yr = *(const u32x2*)(Y + ((size_t)row * 4 + k) * D + h * 512 + lane * 8);
#pragma unroll
                for (int q = 0; q < 2; ++q) { const f32x2 lo = __builtin_amdgcn_cvt_pk_f32_fp8((int)yr[q], false), hi2 = __builtin_amdgcn_cvt_pk_f32_fp8((int)yr[q], true);
                    v[h * 8 + q * 4 + 0] += lo[0] * (1.0f / YSCALE); v[h * 8 + q * 4 + 1] += lo[1] * (1.0f / YSCALE); v[h * 8 + q * 4 + 2] += hi2[0] * (1.0f / YSCALE); v[h * 8 + q * 4 + 3] += hi2[1] * (1.0f / YSCALE); } }
        float s = 0.f;
#pragma unroll
        for (int i = 0; i < 16; ++i) s += v[i];
        const float mean = wave_sum(s) * (1.f / D); float s2 = 0.f;
#pragma unroll
        for (int i = 0; i < 16; ++i) { v[i] -= mean; s2 += v[i] * v[i]; }
        const float rstd = 1.f / sqrtf(wave_sum(s2) * (1.f / D) + LN_EPS);
#pragma unroll
        for (int i = 0; i < 16; ++i) v[i] = v[i] * rstd * gg[i] + bb[i];
        float sX = sXb, rsX = rsXb;
        if (I8P && XI) { float am = 0.f;
#pragma unroll
            for (int i = 0; i < 16; ++i) am = fmaxf(am, fabsf(v[i]));
#pragma unroll
            for (int o = 1; o < 64; o <<= 1) am = fmaxf(am, shx(am, o));
            sX = QMAXP / fmaxf(am, 1e-30f); rsX = am * (1.0f / QMAXP); }
#pragma unroll
        for (int h = 0; h < 2; ++h) { v4u ov; ov.x = cvt_pk_bf16(v[h * 8 + 0], v[h * 8 + 1]); ov.y = cvt_pk_bf16(v[h * 8 + 2], v[h * 8 + 3]); ov.z = cvt_pk_bf16(v[h * 8 + 4], v[h * 8 + 5]); ov.w = cvt_pk_bf16(v[h * 8 + 6], v[h * 8 + 7]);
            if (!out) *(v4u*)(XB + (size_t)row * D + h * 512 + lane * 8) = ov;
            if (XI) { typedef unsigned u32x2 __attribute__((ext_vector_type(2))); u32x2 q8; q8.x = pg8::pkq4<I8P>(v[h * 8 + 0] * sX, v[h * 8 + 1] * sX, v[h * 8 + 2] * sX, v[h * 8 + 3] * sX); q8.y = pg8::pkq4<I8P>(v[h * 8 + 4] * sX, v[h * 8 + 5] * sX, v[h * 8 + 6] * sX, v[h * 8 + 7] * sX);
                *(u32x2*)(XI + (size_t)row * D + h * 512 + lane * 8) = q8; if (h == 0 && lane == 0) RS[row] = rsX; }
            if (out) { *(f32x4*)(out + (size_t)row * D + h * 512 + lane * 8) = (f32x4){v[h * 8 + 0], v[h * 8 + 1], v[h * 8 + 2], v[h * 8 + 3]};
                       *(f32x4*)(out + (size_t)row * D + h * 512 + lane * 8 + 4) = (f32x4){v[h * 8 + 4], v[h * 8 + 5], v[h * 8 + 6], v[h * 8 + 7]}; } }
    }
}

constexpr int RT_PITCH = 2064, R_OFF_G = 32 * RT_PITCH, R_OFF_LG = R_OFF_G + 8192, R_OFF_CNT = R_OFF_LG + 8 * 16 * 33 * 4, R_OFF_SW = R_OFF_CNT + 256, R_LDS = R_OFF_SW + 256;
typedef __bf16 bf16x2_t __attribute__((ext_vector_type(2)));
__device__ __forceinline__ void router_phase(const bf16_t* Yp, const float* g, const float* bta, const bf16_t* RTg, const float* Wr, const float* rb, unsigned char* X8, int* lslot, float* lgate, unsigned* cnt,
                                             char* lds, int blk0, int G, int tid, int wave, int lane) {
    for (int i = tid; i < 32 * 128; i += 512) { const int e = i >> 7, c = i & 127; *(v4u*)(lds + e * RT_PITCH + c * 16) = *(const v4u*)(RTg + (size_t)e * 1024 + c * 8); }
    float* gl = (float*)(lds + R_OFF_G); float* bl = gl + 1024;
    for (int i = tid; i < 1024; i += 512) { gl[i] = g[i]; bl[i] = bta[i]; }
    float* LG = (float*)(lds + R_OFF_LG) + wave * (16 * 33);
    int* lcnt = (int*)(lds + R_OFF_CNT); int* lbase = lcnt + 32;
    float* sWl = (float*)(lds + R_OFF_SW); float* cBl = sWl + 32;
    __syncthreads();
#pragma unroll 1
    for (int j = 0; j < 4; ++j) { const int e = wave * 4 + j; float a = 0.f, c = 0.f;
#pragma unroll 4
        for (int i = 0; i < 16; ++i) { const int k = lane + 64 * i; a += __uint_as_float((unsigned)(*(const bf16_t*)(lds + e * RT_PITCH + k * 2)) << 16); c += bl[k] * Wr[(size_t)k * 32 + e]; }
        a = wave_sum(a); c = wave_sum(c); if (lane == 0) { sWl[e] = a; cBl[e] = c + rb[e]; } }
    const int t16 = lane & 15, kq = lane >> 4;
    const float sA = F8MAX / ln_bound(g, bta, lane);
#pragma unroll 1
    for (int blk = blk0; blk < M / 128; blk += G) {
        if (tid < 32) lcnt[tid] = 0;
        __syncthreads();
        int my_e, my_rank, my_slot; float my_gate;
        const int r0 = blk * 128 + wave * 16; const size_t rowoff = (size_t)(r0 + t16) * D + kq * 8;
        v4u yv[32];
#pragma unroll
        for (int kb = 0; kb < 32; ++kb) yv[kb] = *(const v4u*)(Yp + rowoff + kb * 32);
        f32x4 acc0 = {0.f, 0.f, 0.f, 0.f}, acc1 = {0.f, 0.f, 0.f, 0.f}, accs = {0.f, 0.f, 0.f, 0.f}, accq = {0.f, 0.f, 0.f, 0.f};
        const bf16x8 ones8 = {(short)0x3F80, (short)0x3F80, (short)0x3F80, (short)0x3F80, (short)0x3F80, (short)0x3F80, (short)0x3F80, (short)0x3F80};
#pragma unroll
        for (int kb = 0; kb < 32; ++kb) { const int c0 = kb * 32 + kq * 8;
            const bf16x8 w0 = *(const bf16x8*)(lds + t16 * RT_PITCH + c0 * 2), w1 = *(const bf16x8*)(lds + (16 + t16) * RT_PITCH + c0 * 2);
            const bf16x8 xb = __builtin_bit_cast(bf16x8, yv[kb]);
            acc0 = __builtin_amdgcn_mfma_f32_16x16x32_bf16(w0, xb, acc0, 0, 0, 0);
            acc1 = __builtin_amdgcn_mfma_f32_16x16x32_bf16(w1, xb, acc1, 0, 0, 0);
            accs = __builtin_amdgcn_mfma_f32_16x16x32_bf16(ones8, xb, accs, 0, 0, 0);
            accq = __builtin_amdgcn_mfma_f32_16x16x32_bf16(xb, xb, accq, 0, 0, 0); }
        const float s = accs[0];
        const int dsel = t16 & 3; float dq_ = dsel == 0 ? accq[0] : (dsel == 1 ? accq[1] : (dsel == 2 ? accq[2] : accq[3]));
        const float s2 = __int_as_float(__builtin_amdgcn_ds_bpermute(((t16 >> 2) * 16 + t16) << 2, __float_as_int(dq_)));
        const float mean = s * (1.f / D); const float var = fmaxf(s2 * (1.f / D) - mean * mean, 0.f);
        const float rstd = 1.f / sqrtf(var + LN_EPS);
        {
            float* lgr = LG + t16 * 33;
#pragma unroll
            for (int i = 0; i < 4; ++i) { const int e0 = kq * 4 + i, e1 = 16 + kq * 4 + i;
                lgr[e0] = rstd * (acc0[i] - mean * sWl[e0]) + cBl[e0]; lgr[e1] = rstd * (acc1[i] - mean * sWl[e1]) + cBl[e1]; }
            LDS_WAIT(); asm volatile("" ::: "memory");
            float t0 = -INFINITY, t1 = -INFINITY, t2 = -INFINITY, t3 = -INFINITY; int i0 = 0, i1 = 0, i2 = 0, i3 = 0;
#pragma unroll
            for (int e = 0; e < 32; ++e) { const float v = lgr[e];
                const bool c0 = v > t0, c1 = v > t1, c2 = v > t2, c3 = v > t3;
                t3 = c2 ? t2 : (c3 ? v : t3); i3 = c2 ? i2 : (c3 ? e : i3);
                t2 = c1 ? t1 : (c2 ? v : t2); i2 = c1 ? i1 : (c2 ? e : i2);
                t1 = c0 ? t0 : (c1 ? v : t1); i1 = c0 ? i0 : (c1 ? e : i1);
                t0 = c0 ? v : t0; i0 = c0 ? e : i0; }
            const float e1 = __expf(t1 - t0), e2 = __expf(t2 - t0), e3 = __expf(t3 - t0); const float inv = 1.f / (1.f + e1 + e2 + e3);
            const int ek = kq == 0 ? i0 : (kq == 1 ? i1 : (kq == 2 ? i2 : i3)); const float gk = (kq == 0 ? 1.f : (kq == 1 ? e1 : (kq == 2 ? e2 : e3))) * inv;
            my_e = ek; my_gate = gk; my_slot = (r0 + t16) * 4 + kq; my_rank = atomicAdd(&lcnt[ek], 1);
            LDS_WAIT(); asm volatile("" ::: "memory");
        }
        const float rs = rstd * sA;
#pragma unroll
        for (int kb = 0; kb < 32; ++kb) { const int c0 = kb * 32 + kq * 8; const v4u y = yv[kb];
            const f32x4 g0 = *(const f32x4*)(gl + c0) * rs, g1 = *(const f32x4*)(gl + c0 + 4) * rs, b0 = *(const f32x4*)(bl + c0) * sA, b1 = *(const f32x4*)(bl + c0 + 4) * sA;
            typedef unsigned u32x2 __attribute__((ext_vector_type(2))); u32x2 q8;
            q8.x = pg8::pk4_fp8((bf_lo(y.x) - mean) * g0[0] + b0[0], (bf_hi(y.x) - mean) * g0[1] + b0[1], (bf_lo(y.y) - mean) * g0[2] + b0[2], (bf_hi(y.y) - mean) * g0[3] + b0[3]);
            q8.y = pg8::pk4_fp8((bf_lo(y.z) - mean) * g1[0] + b1[0], (bf_hi(y.z) - mean) * g1[1] + b1[1], (bf_lo(y.w) - mean) * g1[2] + b1[2], (bf_hi(y.w) - mean) * g1[3] + b1[3]);
            *(u32x2*)(X8 + rowoff + kb * 32) = q8;
            asm volatile("" ::: "memory"); }
        __syncthreads();
        if (tid < 32) lbase[tid] = (int)__hip_atomic_fetch_add(cnt + tid * 64, (unsigned)lcnt[tid], RLX_AGENT);
        __syncthreads();
        { const int pos = lbase[my_e] + my_rank; lslot[(size_t)my_e * LCAP + pos] = my_slot; lgate[(size_t)my_e * LCAP + pos] = my_gate; }
        __syncthreads();
    }
}

__device__ __forceinline__ float attn_obound(const float* gsub, float osc, int lane) {
    float mg = fmaxf(fabsf(gsub[lane]), fabsf(gsub[64 + lane]));
#pragma unroll
    for (int o = 1; o < 64; o <<= 1) mg = fmaxf(mg, shx(mg, o));
    return 11.3137085f * mg * fabsf(osc);
}

constexpr int NWAVES = 8;
constexpr int N_PHASES = 1 + DEPTH * 7;
#ifndef REP_ATTN
#define REP_ATTN 1
#endif
#ifndef KREP_MOE
#define KREP_MOE 1
#endif
#ifndef REP_MOE
#define REP_MOE 1
#endif
#ifndef REP_P0
#define REP_P0 1
#endif
#ifndef REP_THIN
#define REP_THIN 1
#endif
#ifndef REP_DENSE
#define REP_DENSE 1
#endif
#ifndef MK_SPLIT
#define MK_SPLIT 0
#endif
struct Args { const float* in[17]; float* out; unsigned char* ws; int ph_lo, ph_hi, li, pad; };
typedef const __attribute__((address_space(4))) Args* ArgsP;
enum { I_X = 0, I_RELB, I_AWIN, I_ALAM, I_ASUB, I_AWOUT, I_CWIN, I_CW, I_CWOUT, I_RW, I_RB, I_W1, I_B1, I_W2, I_B2, I_LNG, I_LNB };
__global__ void __launch_bounds__(NWAVES * 64, 2) mk_fwd(Args args) {
    extern __shared__ __attribute__((aligned(16))) unsigned char lds[];
    LAS unsigned char* ldsl = (LAS unsigned char*)lds;
    volatile LAS unsigned* MISC = (volatile LAS unsigned*)(ldsl + MISC_OFF);
    const int tid0 = threadIdx.x;
    const int wave0 = __builtin_amdgcn_readfirstlane(tid0 >> 6);
    const int G0 = gridDim.x, bx0 = blockIdx.x;
#define PHASE_BEGIN() int wv_ = wave0; asm volatile("" : "+s"(wv_)); int ln_; asm volatile("v_mbcnt_lo_u32_b32 %0, -1, 0\n\tv_mbcnt_hi_u32_b32 %0, -1, %0" : "=v"(ln_)); int tid = wv_ * 64 + ln_; int G = G0, bx = bx0; asm volatile("" : "+s"(G), "+s"(bx)); const int vcu = (G % 8 == 0) ? (bx % 8) * (G / 8) + bx / 8 : bx; const int NGW = G * NWAVES; \
        const int lane = tid & 63, wave = __builtin_amdgcn_readfirstlane(tid >> 6); const int gw = vcu * NWAVES + wave; (void)lane; (void)gw; (void)NGW; \
        ArgsP ap = (ArgsP)__builtin_amdgcn_kernarg_segment_ptr(); asm volatile("" : "+s"(ap)); unsigned char* ws = ap->ws; gu32* ctl = (gu32*)(ws + WS_CTL); (void)ctl
    for (int u = tid0; u < (LDS_BYTES - LDSCTL_OFF) / 4; u += NWAVES * 64) ((LAS unsigned*)(ldsl + LDSCTL_OFF))[u] = 0u;
    __syncthreads();
    XcdBarrier bar = xcd_barrier_post((unsigned*)(args.ws + WS_CTL) + CW_BAR + (size_t)args.li * 4096, MISC + 8);
    const int lo = args.ph_lo, hi = args.ph_hi;
#define IN(k) (lo <= (k) && (k) < hi)
#define SEAM(k) do { if (IN((k) + 1)) xcd_barrier(bar); } while (0)
    LAS int* tb = (LAS int*)(ldsl + LDSCTL_OFF); LAS int* cn = tb + 64;

    if (IN(0)) { PHASE_BEGIN();
        Ptrs P; P.x = ap->in[I_X]; P.attn_w_in = ap->in[I_AWIN]; P.attn_w_out = ap->in[I_AWOUT]; P.conv_w_in = ap->in[I_CWIN]; P.conv_w_out = ap->in[I_CWOUT]; P.router_w = ap->in[I_RW]; P.ln_g = ap->in[I_LNG]; P.w1 = ap->in[I_W1]; P.w2 = ap->in[I_W2]; P.ws = ws;
        _Pragma("unroll 1") for (int rep = 0; rep < REP_P0; ++rep) p0_prologue(P, ldsl, gw, NGW, wave, lane); SEAM(0); }

#define MOE_GEMMS(L, pb) do { \
            if (IN((pb) + 4)) { PHASE_BEGIN(); \
                pg8::MoeProb<true, true> S{(const char*)(ws + WS_X8), (const char*)(ws + WS_W1) + (size_t)(L) * 32 * 2048 * 1024, (size_t)2048 * 1024, 8, G, vcu, (int)tb[32], tb, cn, (const int*)(ws + WS_LS), lane, tid}; \
                pg8::EpiMoe1 E{ws + WS_A2, ap->in[I_B1] + (size_t)(L) * 32 * 2048, (const float*)(ws + WS_S1) + (size_t)(L) * 32 * 2048, ln_bound(ap->in[I_LNG] + ((L) * 2 + 0) * D, ap->in[I_LNB] + ((L) * 2 + 0) * D, lane) * (1.0f / F8MAX) * (1.0f / KREP_MOE)}; \
                pg8::gemm_phase<pg8::MoeProb<true, true>, pg8::EpiMoe1, true, true, KREP_MOE>(ldsl + RING_OFF, ldsl + XL_OFF, S, E); \
                SEAM((pb) + 4); \
            } \
            if (IN((pb) + 5)) { PHASE_BEGIN(); \
                pg8::MoeProb<false, true> S{(const char*)(ws + WS_A2), (const char*)(ws + WS_W2) + (size_t)(L) * 32 * 1024 * 1024, (size_t)1024 * 1024, 4, G, vcu, (int)tb[32], tb, cn, (const int*)(ws + WS_LS), lane, tid}; \
                pg8::EpiMoe2 E{ws + WS_Y, ap->in[I_B2] + (size_t)(L) * 32 * 1024, (const float*)(ws + WS_S2) + (size_t)(L) * 32 * 1024, (const int*)(ws + WS_LS), (const float*)(ws + WS_LG)}; \
                pg8::gemm_phase<pg8::MoeProb<false, true>, pg8::EpiMoe2, true, true, KREP_MOE>(ldsl + RING_OFF, ldsl + XL_OFF, S, E); \
                SEAM((pb) + 5); \
            } \
        } while (0)
#if REP_MOE == 2
#define MOE_GEMMS_REP(L, pb) MOE_GEMMS(L, pb)
#else
#define MOE_GEMMS_REP(L, pb) do {} while (0)
#endif
#define MOE_HALF(L, pb) do { \
            if (IN((pb) + 3)) { PHASE_BEGIN(); \
                router_phase((const bf16_t*)(ws + WS_YP), ap->in[I_LNG] + ((L) * 2 + 0) * D, ap->in[I_LNB] + ((L) * 2 + 0) * D, (const bf16_t*)(ws + WS_WR) + (size_t)(L) * 32 * 1024, ap->in[I_RW] + (size_t)(L) * 1024 * 32, ap->in[I_RB] + (L) * 32, \
                             ws + WS_X8, (int*)(ws + WS_LS), (float*)(ws + WS_LG), (unsigned*)(ctl + CW_CNT) + (L) * 32 * 64, (char*)lds + RING_OFF, vcu, G, tid, wave, lane); \
                SEAM((pb) + 3); \
            } \
            if (IN((pb) + 4) || IN((pb) + 5)) { PHASE_BEGIN(); \
                if (tid < 64) { const int c_ = (lane < 32) ? (int)__hip_atomic_load(ctl + CW_CNT + ((L) * 32 + (lane & 31)) * 64, RLX_AGENT) : 0; const int t_ = (c_ + 255) >> 8; int p_ = t_; \
                    _Pragma("unroll") for (int o_ = 1; o_ < 32; o_ <<= 1) { const int q_ = __builtin_amdgcn_ds_bpermute((lane - o_) * 4, p_); if (lane >= o_) p_ += q_; } \
                    if (lane < 32) { cn[lane] = c_; tb[lane + 1] = p_; } if (lane == 0) tb[0] = 0; } \
                __syncthreads(); \
            } \
            MOE_GEMMS(L, pb); MOE_GEMMS_REP(L, pb); \
            if (REP_THIN == 2 && IN((pb) + 6)) { PHASE_BEGIN(); \
                ln2_phase((const bf16_t*)(ws + WS_YP), ap->in[I_LNG] + ((L) * 2 + 0) * D, ap->in[I_LNB] + ((L) * 2 + 0) * D, (const unsigned char*)(ws + WS_Y), ap->in[I_LNG] + ((L) * 2 + 1) * D, ap->in[I_LNB] + ((L) * 2 + 1) * D, (bf16_t*)(ws + WS_XB), ((L) == DEPTH - 1) ? ap->out : nullptr, ((((L) == 0) && (CM & 1)) || (((L) == 1) && (QM & 2)) || (((L) == 2) && (CM & 2))) ? ws + WS_XI : nullptr, (float*)(ws + WS_RS), gw, NGW, lane); \
            } \
            if (IN((pb) + 6)) { PHASE_BEGIN(); \
                ln2_phase((const bf16_t*)(ws + WS_YP), ap->in[I_LNG] + ((L) * 2 + 0) * D, ap->in[I_LNB] + ((L) * 2 + 0) * D, (const unsigned char*)(ws + WS_Y), ap->in[I_LNG] + ((L) * 2 + 1) * D, ap->in[I_LNB] + ((L) * 2 + 1) * D, (bf16_t*)(ws + WS_XB), ((L) == DEPTH - 1) ? ap->out : nullptr, ((((L) == 0) && (CM & 1)) || (((L) == 1) && (QM & 2)) || (((L) == 2) && (CM & 2))) ? ws + WS_XI : nullptr, (float*)(ws + WS_RS), gw, NGW, lane); \
                if ((pb) + 7 < N_PHASES) SEAM((pb) + 6); \
            } \
        } while (0)

#pragma unroll 1
    for (int lp = 0; lp < DEPTH / 2; ++lp) {
        {
            const int L = 2 * lp, pb = 1 + L * 7;
            if (IN(pb + 0)) {
                PHASE_BEGIN();
                if (QM == 3 || (QM != 0 && ((QM >> lp) & 1))) {
                pg8::DenseProbT<true> S; S.init(ws + WS_XI, ws + WS_WAI + (size_t)lp * 3072 * 1024, M, 3072, G, bx, tid);
                pg8::EpiQKV8 E{(bf16_t*)(ws + WS_Q), (size_t)(WS_K - WS_Q) / 2, QSCALE, (const float*)(ws + WS_SD) + lp * 3072, (const float*)(ws + WS_RS)};
                pg8::gemm_phase<pg8::DenseProbT<true>, pg8::EpiQKV8, true, true, 1, I8P>(ldsl + RING_OFF, ldsl + XL_OFF, S, E);
                } else {
                pg8::DenseProb S; S.init(ws + WS_XB, (const bf16_t*)(ws + WS_WA16) + (size_t)lp * 3072 * 1024, M, 3072, G, bx, tid);
                pg8::EpiQKV E{(bf16_t*)(ws + WS_Q), (size_t)(WS_K - WS_Q) / 2, QSCALE};
                pg8::gemm_phase<pg8::DenseProb, pg8::EpiQKV, true>(ldsl + RING_OFF, ldsl + XL_OFF, S, E);
                }
                SEAM(pb + 0);
            }
            if (IN(pb + 1)) {
                PHASE_BEGIN();
                const float* lf = ap->in[I_ALAM] + lp * 256;
                const float s1 = wave_sum(lf[lane] * lf[64 + lane]), s2 = wave_sum(lf[128 + lane] * lf[192 + lane]);
                const float lam_init = (lp == 0) ? 0.2f : (0.8f - 0.6f * 0.54881163609402643f);
                const float lam = __expf(s1) - __expf(s2) + lam_init;
                const bool o8 = (AOM == 3) || (AOM != 0 && ((AOM >> lp) & 1));
                const float oscl = o8 ? (1.0f - lam_init) * (F8MAX / attn_obound(ap->in[I_ASUB] + lp * 128, 1.0f - lam_init, lane)) : (1.0f - lam_init);
                int hprev = -1; bool strips_done = !(DEFER_W && lp == 0);
#pragma unroll 1
                for (int rep = 0; rep < REP_ATTN; ++rep)
#pragma unroll 1
                for (int i = 0; i < (BATCH * NH * 32) / 256; ++i) {
                    const int item = i * G + vcu;
                    if (item >= BATCH * NH * 32) break;
                    const int bh = item >> 5, qb = item & 31;
                    const bool newh = (i == 0) || ((bh & 7) != hprev); hprev = bh & 7;
                    att::attn_unit(bh >> 3, bh & 7, qb, (const bf16_t*)(ws + WS_Q), (const bf16_t*)(ws + WS_K), (const bf16_t*)(ws + WS_V), (bf16_t*)(ws + WS_O), lam, oscl,
                                   ap->in[I_ASUB] + lp * 128, ap->in[I_RELB], (char*)lds + RING_OFF, tid, newh, o8);
                    if (!strips_done && i == (vcu & 15)) { strips_done = true;
                        Ptrs P; P.w1 = ap->in[I_W1]; P.w2 = ap->in[I_W2]; P.ws = ws;
                        int ln_s = lane; asm volatile("" : "+v"(ln_s));
                        { const int per_ = (128 * 96 + G - 1) / G, f_ = vcu * per_, e_ = (f_ + per_ < 128 * 96) ? f_ + per_ : 128 * 96; deferred_strips(P.w1, P.w2, ws, ldsl, f_, e_, wave, ln_s); }
                        hprev = -1;
                    }
                }
                if (!strips_done) { int ln_s = lane; asm volatile("" : "+v"(ln_s)); const int per_ = (128 * 96 + G - 1) / G, f_ = vcu * per_, e_ = (f_ + per_ < 128 * 96) ? f_ + per_ : 128 * 96; deferred_strips(ap->in[I_W1], ap->in[I_W2], ws, ldsl, f_, e_, wave, ln_s); }
                SEAM(pb + 1);
            }
            if (IN(pb + 2)) {
                PHASE_BEGIN();
                if ((AOM == 3) || (AOM != 0 && ((AOM >> lp) & 1))) {
                const float lam_init = (lp == 0) ? 0.2f : (0.8f - 0.6f * 0.54881163609402643f);
                pg8::DenseProbT<true> S; S.init(ws + WS_O, ws + WS_WAO8 + (size_t)lp * 1024 * 1024, M, 1024, G, bx, tid);
                pg8::EpiResid8<false> E{(const bf16_t*)(ws + WS_XB), (bf16_t*)(ws + WS_YP), (const float*)(ws + WS_SD + 24 * 1024) + lp * 1024, nullptr, attn_obound(ap->in[I_ASUB] + lp * 128, 1.0f - lam_init, lane) * (1.0f / F8MAX)};
                pg8::gemm_phase<pg8::DenseProbT<true>, pg8::EpiResid8<false>, true, true>(ldsl + RING_OFF, ldsl + XL_OFF, S, E);
                } else {
                pg8::DenseProb S; S.init(ws + WS_O, (const bf16_t*)(ws + WS_WAO) + (size_t)lp * 1024 * 1024, M, 1024, G, bx, tid);
                pg8::EpiResid E{(const bf16_t*)(ws + WS_XB), (bf16_t*)(ws + WS_YP)};
                pg8::gemm_phase<pg8::DenseProb, pg8::EpiResid, true>(ldsl + RING_OFF, ldsl + XL_OFF, S, E);
                }
                SEAM(pb + 2);
            }
            MOE_HALF(L, pb);
        }
        {
            const int L = 2 * lp + 1, pb = 1 + L * 7;
            if (IN(pb + 0)) {
                PHASE_BEGIN();
                if (CM == 3 || (CM != 0 && ((CM >> lp) & 1))) {
                pg8::DenseProbT<true> S; S.init(ws + WS_XI, ws + WS_WCI + (size_t)lp * 3072 * 1024, M, 3072, G, bx, tid);
                pg8::EpiConvIn8 E{(bf16_t*)(ws + WS_Q), (bf16_t*)(ws + WS_K), (const float*)(ws + WS_SD + 32 * 1024) + lp * 3072, (const float*)(ws + WS_RS)};
                pg8::gemm_phase<pg8::DenseProbT<true>, pg8::EpiConvIn8, true, true, 1, I8P>(ldsl + RING_OFF, ldsl + XL_OFF, S, E);
                } else {
                pg8::DenseProb S; S.init(ws + WS_XB, (const bf16_t*)(ws + WS_WC16) + (size_t)lp * 3072 * 1024, M, 3072, G, bx, tid);
                pg8::EpiConvIn E{(bf16_t*)(ws + WS_Q), (bf16_t*)(ws + WS_K)};
                pg8::gemm_phase<pg8::DenseProb, pg8::EpiConvIn, true>(ldsl + RING_OFF, ldsl + XL_OFF, S, E);
                }
                SEAM(pb + 0);
            }
            if (IN(pb + 1)) { PHASE_BEGIN(); conv_phase((const bf16_t*)(ws + WS_Q), (const bf16_t*)(ws + WS_K), ap->in[I_CW] + lp * 3 * D, (bf16_t*)(ws + WS_O), (float*)(ws + WS_RS), (COM == 3) || (COM != 0 && ((COM >> lp) & 1)), gw, NGW, lane); SEAM(pb + 1); }
            if (IN(pb + 2)) {
                PHASE_BEGIN();
                if ((COM == 3) || (COM != 0 && ((COM >> lp) & 1))) {
                pg8::DenseProbT<true> S; S.init(ws + WS_O, ws + WS_WCO8 + (size_t)lp * 1024 * 1024, M, 1024, G, bx, tid);
                pg8::EpiResid8<true> E{(const bf16_t*)(ws + WS_XB), (bf16_t*)(ws + WS_YP), (const float*)(ws + WS_SD + 56 * 1024) + lp * 1024, (const float*)(ws + WS_RS), 1.0f};
                pg8::gemm_phase<pg8::DenseProbT<true>, pg8::EpiResid8<true>, true, true, 1, I8P>(ldsl + RING_OFF, ldsl + XL_OFF, S, E);
                } else {
                pg8::DenseProb S; S.init(ws + WS_O, (const bf16_t*)(ws + WS_WCO) + (size_t)lp * 1024 * 1024, M, 1024, G, bx, tid);
                pg8::EpiResid E{(const bf16_t*)(ws + WS_XB), (bf16_t*)(ws + WS_YP)};
                pg8::gemm_phase<pg8::DenseProb, pg8::EpiResid, true>(ldsl + RING_OFF, ldsl + XL_OFF, S, E);
                }
                SEAM(pb + 2);
            }
            MOE_HALF(L, pb);
        }
    }
#undef IN
#undef SEAM
}

extern "C" void kernel_launch(void* const* d_in, const int* in_sizes, int n_in, void* d_out, int out_size, void* d_ws, size_t ws_size, hipStream_t stream) {
    static int grid = 0;
    if (grid == 0) {
        if (n_in != 17 || in_sizes[0] != M * D || out_size != M * D || ws_size < WS_END) {
            fprintf(stderr, "kernel_launch: shape mismatch: n_in %d in0 %d out %d ws %zu (need %zu)\n", n_in, n_in > 0 ? in_sizes[0] : -1, out_size, ws_size, (size_t)WS_END); grid = -1; return; }
        int dev = 0, cus = 0, per_cu = 0;
        if (hipGetDevice(&dev) != hipSuccess || hipDeviceGetAttribute(&cus, hipDeviceAttributeMultiprocessorCount, dev) != hipSuccess) { grid = -1; return; }
        if (hipFuncSetAttribute((const void*)mk_fwd, hipFuncAttributeMaxDynamicSharedMemorySize, LDS_BYTES) != hipSuccess) { fprintf(stderr, "kernel_launch: hipFuncSetAttribute failed\n"); grid = -1; return; }
        if (hipOccupancyMaxActiveBlocksPerMultiprocessor(&per_cu, (const void*)mk_fwd, NWAVES * 64, LDS_BYTES) != hipSuccess || per_cu < 1)
            fprintf(stderr, "kernel_launch: occupancy query reports %d workgroups per CU\n", per_cu);
        (void)hipGetLastError();
        grid = cus;
    }
    if (grid < 0) return;
    if (hipMemsetAsync((char*)d_ws + WS_CTL, 0, CTL_ZERO_BYTES, stream) != hipSuccess) { fprintf(stderr, "kernel_launch: memset failed\n"); return; }
    Args a{};
    for (int i = 0; i < 17; ++i) a.in[i] = (const float*)d_in[i];
    a.out = (float*)d_out; a.ws = (unsigned char*)d_ws; a.pad = 0;
#if MK_SPLIT
    for (int p = 0; p < N_PHASES; ++p) { a.ph_lo = p; a.ph_hi = p + 1; a.li = p; hipLaunchKernelGGL(mk_fwd, dim3(grid), dim3(NWAVES * 64), LDS_BYTES, stream, a); }
#else
    a.ph_lo = 0; a.ph_hi = N_PHASES; a.li = 0;
    hipLaunchKernelGGL(mk_fwd, dim3(grid), dim3(NWAVES * 64), LDS_BYTES, stream, a);
#endif
    const hipError_t le = hipPeekAtLastError();
    if (le != hipSuccess) fprintf(stderr, "kernel_launch: launch failed: %s\n", hipGetErrorName(le));
}
```

```cpp
#include <hip/hip_runtime.h>
#include <hip/hip_bf16.h>
#include <cstdio>
#include <cstdint>

constexpr int BATCH = 16, SEQ = 4096, D = 1024, M = BATCH * SEQ, DEPTH = 4, NH = 8, NE = 32, TOPK = 4;
constexpr float LN_EPS = 1e-5f;
constexpr float ALPHA = 1.6817928305074290f;
constexpr float LOG2E = 1.4426950408889634f;
constexpr float QSCALE = 0.125f * LOG2E;
constexpr int LCAP = 65536;
constexpr int MAXRT = 1056;

constexpr size_t MiB = 1ull << 20;
constexpr size_t WS_CTL = 0, CTL_ZERO_BYTES = 1 * MiB;
constexpr size_t WS_WAI = 1 * MiB;
constexpr size_t WS_WAO = WS_WAI + 12 * MiB;
constexpr size_t WS_WCI = WS_WAO + 4 * MiB;
constexpr size_t WS_WCO = WS_WCI + 12 * MiB;
constexpr size_t WS_WR  = WS_WCO + 4 * MiB;
constexpr size_t WS_W1  = WS_WR + 1 * MiB;
constexpr size_t WS_W2  = WS_W1 + 256 * MiB;
constexpr size_t WS_S1  = WS_W2 + 128 * MiB;
constexpr size_t WS_S2  = WS_S1 + 1 * MiB;
constexpr size_t WS_SD  = WS_S2 + 512 * 1024;
constexpr size_t WS_RS  = WS_SD + 64 * 1024;
constexpr size_t WS_XB  = WS_S2 + 1 * MiB;
constexpr size_t WS_XI  = WS_XB + 128 * MiB;
constexpr size_t WS_X8  = WS_XI + 128 * MiB;
constexpr size_t WS_YP  = WS_X8 + 64 * MiB;
constexpr size_t WS_Q   = WS_YP + 128 * MiB;
constexpr size_t WS_K   = WS_Q + 128 * MiB;
constexpr size_t WS_V   = WS_K + 128 * MiB;
constexpr size_t WS_O   = WS_V + 128 * MiB;
constexpr size_t WS_LS  = WS_O + 128 * MiB;
constexpr size_t WS_LG  = WS_LS + 8 * MiB;
constexpr size_t WS_A2  = WS_LG + 8 * MiB;
constexpr size_t WS_Y   = WS_A2 + 264 * MiB;
constexpr size_t WS_WA16 = WS_Y + 513 * MiB;
constexpr size_t WS_WC16 = WS_WA16 + 12 * MiB;
constexpr size_t WS_WAO8 = WS_WC16 + 12 * MiB;
constexpr size_t WS_WCO8 = WS_WAO8 + 2 * MiB;
constexpr size_t WS_RC = WS_WCO8 + 2 * MiB;
constexpr size_t WS_END = WS_RC + 1 * MiB;
#ifndef F8_QKV_MASK
#define F8_QKV_MASK 3
#endif
#ifndef F8_CONV_MASK
#define F8_CONV_MASK 3
#endif
#ifndef F8_AOUT_MASK
#define F8_AOUT_MASK 3
#endif
#ifndef F8_COUT_MASK
#define F8_COUT_MASK 3
#endif
constexpr int QM = F8_QKV_MASK, CM = F8_CONV_MASK, AOM = F8_AOUT_MASK, COM = F8_COUT_MASK;
constexpr int NA8 = (AOM & 1) + (AOM >> 1), NO8 = (COM & 1) + (COM >> 1), AJ0 = (AOM & 1) ? 0 : 1, OJ0 = (COM & 1) ? 0 : 1;
constexpr int NA16 = 2 - NA8, NO16 = 2 - NO8, AK0 = (AOM & 1) ? 1 : 0, OK0 = (COM & 1) ? 1 : 0;
constexpr int NQ8 = (QM & 1) + (QM >> 1), NC8 = (CM & 1) + (CM >> 1), QJ0 = (QM & 1) ? 0 : 1, CJ0 = (CM & 1) ? 0 : 1;
constexpr int NQ16 = 2 - NQ8, NC16 = 2 - NC8, QK0 = (QM & 1) ? 1 : 0, CK0 = (CM & 1) ? 1 : 0;
constexpr float F8MAX = 448.0f * 0.999f;
constexpr bool I8P = true;
constexpr float QMAXP = I8P ? 127.0f : 448.0f * 0.999f;
constexpr float YSCALE = 16.0f;
constexpr float A2SCALE = 8.0f;
constexpr int CW_TMO = 0, CW_CODE = 1;
constexpr int CW_BAR = 4096;
constexpr int CW_CNT = 16384;

constexpr int RING_OFF = 0, RING_BYTES = 131072;
constexpr int LDSCTL_OFF = RING_BYTES, MISC_OFF = LDSCTL_OFF + 1024;
constexpr int XL_OFF = LDSCTL_OFF + 4096;
constexpr int LDS_BYTES = 147456;

#define GAS __attribute__((address_space(1)))
#define LAS __attribute__((address_space(3)))
typedef unsigned short bf16_t;
typedef unsigned v4u __attribute__((ext_vector_type(4)));
typedef float f32x4 __attribute__((ext_vector_type(4)));
typedef float f32x2 __attribute__((ext_vector_type(2)));
typedef short bf16x8 __attribute__((ext_vector_type(8)));
typedef float f32x16 __attribute__((ext_vector_type(16)));
typedef short s16x4 __attribute__((ext_vector_type(4)));
typedef GAS unsigned gu32;
#define RLX_AGENT __ATOMIC_RELAXED, __HIP_MEMORY_SCOPE_AGENT
#define LDS_WAIT() asm volatile("s_waitcnt lgkmcnt(0)" ::: "memory")
#define VM_WAIT() asm volatile("s_waitcnt vmcnt(0)" ::: "memory")

__device__ __forceinline__ unsigned cvt_pk_bf16(float lo, float hi) { unsigned r; asm volatile("v_cvt_pk_bf16_f32 %0, %1, %2" : "=v"(r) : "v"(lo), "v"(hi)); return r; }
__device__ __forceinline__ float bf_lo(unsigned u) { return __uint_as_float(u << 16); }
__device__ __forceinline__ float bf_hi(unsigned u) { return __uint_as_float(u & 0xffff0000u); }
__device__ __forceinline__ int lane_local() { int l; asm volatile("v_mbcnt_lo_u32_b32 %0, -1, 0\n\tv_mbcnt_hi_u32_b32 %0, -1, %0" : "=v"(l)); return l; }
__device__ __forceinline__ float shx(float v, int m, int l) { return __int_as_float(__builtin_amdgcn_ds_bpermute((l ^ m) << 2, __float_as_int(v))); }
__device__ __forceinline__ float shx(float v, int m) { return shx(v, m, lane_local()); }
__device__ __forceinline__ float wave_sum(float v) {
    const int l_ = lane_local();
#pragma unroll
    for (int o = 1; o < 64; o <<= 1) v += shx(v, o, l_);
    return v;
}

#ifndef KREP_MOE
#define KREP_MOE 1
#endif
namespace pg8 {
constexpr float KREP_MOE_ = (float)KREP_MOE;
#define PG8_LAS __attribute__((address_space(3)))
constexpr int BM = 256, BK = 64, HALF = 128, HTB = HALF * BK * 2, STAGE_BYTES = 8 * HTB, NXCD = 8, WGM = 8, KD = 1024, NTK = KD / BK;

__host__ __device__ __forceinline__ int lds_byte(int r, int c) { const int st = (r >> 4) * 2 + (c >> 5), rr = r & 15, cc = c & 31, ob = rr * 64 + cc * 2; return st * 1024 + (ob ^ (((ob >> 9) & 1) << 5)); }
__host__ __device__ __forceinline__ void stage_rc(int b, int& R, int& C) { const int st = b / 1024, sb = b % 1024, swz = sb ^ (((sb >> 9) & 1) << 5); R = (st >> 1) * 16 + swz / 64; C = (st & 1) * 32 + (swz % 64) / 2; }
__host__ __device__ __forceinline__ int perm32(int rho) { const int n = rho >> 4, i = rho & 15; return 8 * (i >> 2) + 4 * n + (i & 3); }

struct Unit { int pm, pn, e, valid, lr0; };
__device__ __forceinline__ void dma1k(const void* src, PG8_LAS unsigned char* dst, int lane) {
    __builtin_amdgcn_global_load_lds((const __attribute__((address_space(1))) unsigned*)((const char*)src + lane * 16), (PG8_LAS unsigned*)dst, 16, 0, 0);
}
constexpr int XL_EPI = 4096, XL_GATHER = 1024, XL_BYTES = 2 * (XL_EPI + XL_GATHER);

template <bool F8> struct DenseProbT {
    static constexpr bool GATHER = false;
    static constexpr int RP = F8 ? 1024 : 2048;
    const char* A; const char* Bt; int nM, nN, nwg, G, c, tid;
    __device__ void init(const void* A_, const void* Bt_, int Mrows, int N, int G_, int c_, int tid_) { A = (const char*)A_; Bt = (const char*)Bt_; nM = Mrows / BM; nN = N / BM; nwg = nM * nN; G = G_; c = c_; tid = tid_; }
    __device__ __forceinline__ bool next(int i, Unit& u) const {
        const long L = (long)i * G + c; if (L >= nwg) return false;
        int wgid = (int)L; { const int q = nwg / NXCD, r = nwg % NXCD, xcd = wgid % NXCD, off = wgid / NXCD; wgid = (xcd < r ? xcd * (q + 1) : r * (q + 1) + (xcd - r) * q) + off; }
        const int nig = WGM * nN, gid = wgid / nig, fm = gid * WGM, gsz = (nM - fm) < WGM ? (nM - fm) : WGM;
        u.pm = fm + ((wgid % nig) % gsz); u.pn = (wgid % nig) / gsz; u.e = 0; u.valid = 256; u.lr0 = 0; return true;
    }
    __device__ __forceinline__ void a_off(const Unit& u, const int (&RA)[2], const int (&CA)[2], unsigned (&vo)[2][2]) const {
#pragma unroll
        for (int h = 0; h < 2; ++h)
#pragma unroll
            for (int i = 0; i < 2; ++i) vo[h][i] = (unsigned)((u.pm * BM + h * HALF + RA[i]) * RP + CA[i] * 2);
    }
    __device__ __forceinline__ unsigned a_tile(const Unit& u) const { return (unsigned)u.pm * (unsigned)(BM * RP); }
    __device__ __forceinline__ unsigned b_off(const Unit& u) const { return (unsigned)u.pn * (unsigned)(BM * RP); }    __device__ __forceinline__ void dma_rows(const Unit&, PG8_LAS unsigned char*, int, int) const {}
    __device__ __forceinline__ void a_off_lds(const Unit&, const int (&)[2], const int (&)[2], const PG8_LAS unsigned char*, unsigned (&)[2][2]) const {}
};
typedef DenseProbT<false> DenseProb;

template <bool GATHER_, bool F8> struct MoeProb {
    static constexpr bool GATHER = GATHER_;
    static constexpr int RP = F8 ? 1024 : 2048;
    const char* A; const char* Bt; size_t b_estride; int nN, G, v, RT; const PG8_LAS int* tb; const PG8_LAS int* cn; const int* lslot; int lane, tid;
    __device__ __forceinline__ bool next(int i, Unit& u) const {
        const int L = i * G + v; if (L >= RT * nN) return false;
        const int rt = L / nN; u.pm = rt; u.pn = L - rt * nN;
        const unsigned long long bal = __ballot(lane < 32 && rt >= tb[(lane & 31) + 1]);
        const int e = __builtin_amdgcn_readfirstlane(__popcll(bal)); u.e = e;
        const int tb_e = __builtin_amdgcn_readfirstlane(tb[e]), cn_e = __builtin_amdgcn_readfirstlane(cn[e]);
        u.lr0 = 256 * (rt - tb_e); const int rem = cn_e - u.lr0; u.valid = rem < 256 ? rem : 256; return true;
    }
    __device__ __forceinline__ void a_off(const Unit& u, const int (&RA)[2], const int (&CA)[2], unsigned (&vo)[2][2]) const {
        if constexpr (GATHER) {
            const int* ls = lslot + (size_t)u.e * LCAP + u.lr0;
#pragma unroll
            for (int h = 0; h < 2; ++h)
#pragma unroll
                for (int i = 0; i < 2; ++i) { const int rl = h * HALF + RA[i]; const int slot = ls[rl < u.valid ? rl : 0]; vo[h][i] = (unsigned)((slot >> 2) * RP + CA[i] * 2); }
        } else {
#pragma unroll
            for (int h = 0; h < 2; ++h)
#pragma unroll
                for (int i = 0; i < 2; ++i) vo[h][i] = (unsigned)((u.pm * BM + h * HALF + RA[i]) * RP + CA[i] * 2);
        }
    }
    __device__ __forceinline__ unsigned a_tile(const Unit& u) const { return (unsigned)u.pm * (unsigned)(BM * RP); }
    __device__ __forceinline__ unsigned b_off(const Unit& u) const { return (unsigned)u.e * (unsigned)b_estride + (unsigned)u.pn * (unsigned)(BM * RP); }
    __device__ __forceinline__ void dma_rows(const Unit& u, PG8_LAS unsigned char* dst, int wid, int lane_) const { if constexpr (GATHER) { if (wid == 0) dma1k(lslot + (size_t)u.e * LCAP + u.lr0, dst, lane_); } }
    __device__ __forceinline__ void a_off_lds(const Unit& u, const int (&RA)[2], const int (&CA)[2], const PG8_LAS unsigned char* src, unsigned (&vo)[2][2]) const {
        if constexpr (GATHER) { const PG8_LAS int* ls = (const PG8_LAS int*)src;
#pragma unroll
            for (int h = 0; h < 2; ++h)
#pragma unroll
                for (int i = 0; i < 2; ++i) { const int rl = h * HALF + RA[i]; const int slot = ls[rl < u.valid ? rl : 0]; vo[h][i] = (unsigned)((slot >> 2) * RP + CA[i] * 2); } }
    }
};

__device__ __forceinline__ v4u pack8(const f32x4 v0, const f32x4 v1) { v4u w; w.x = cvt_pk_bf16(v0[0], v0[1]); w.y = cvt_pk_bf16(v0[2], v0[3]); w.z = cvt_pk_bf16(v1[0], v1[1]); w.w = cvt_pk_bf16(v1[2], v1[3]); return w; }

__device__ __forceinline__ void st16(void* base, unsigned off, v4u v) { *(v4u*)((char*)base + off) = v; }
struct EpiQKV {
    __device__ __forceinline__ void dma(const Unit&, PG8_LAS unsigned char*, int, int) const {}
    bf16_t* O; size_t stride; float scale0;
    __device__ __forceinline__ void operator()(const f32x4 (&acc)[2][2][4][2], const Unit& u, int wr, int wc, int fr_, int fq_, const PG8_LAS unsigned char* xl) const {
        int fr = fr_, fq = fq_; asm volatile("" : "+v"(fr), "+v"(fq));
        const int row0 = u.pm * BM + wr * 64 + fr; const int t = u.pn >> 2; const int colt = (u.pn & 3) * BM;
        bf16_t* base = O + (size_t)t * stride; const float sc = (t == 0) ? scale0 : 1.f; const unsigned off0 = (unsigned)(row0 * D + colt + wc * 32 + 8 * fq) * 2u;
#pragma unroll
        for (int ai = 0; ai < 2; ++ai)
#pragma unroll
            for (int m = 0; m < 4; ++m)
#pragma unroll
                for (int bj = 0; bj < 2; ++bj) st16(base, off0 + (unsigned)((ai * HALF + m * 16) * D + bj * HALF) * 2u, pack8(acc[ai][bj][m][0] * sc, acc[ai][bj][m][1] * sc));
    }
};
struct EpiConvIn {
    __device__ __forceinline__ void dma(const Unit&, PG8_LAS unsigned char*, int, int) const {}
    bf16_t* GB; bf16_t* Z;
    __device__ __forceinline__ void operator()(const f32x4 (&acc)[2][2][4][2], const Unit& u, int wr, int wc, int fr_, int fq_, const PG8_LAS unsigned char* xl) const {
        int fr = fr_, fq = fq_; asm volatile("" : "+v"(fr), "+v"(fq));
        const int row0 = u.pm * BM + wr * 64 + fr;
        if (u.pn < 4) { const unsigned off0 = (unsigned)(row0 * D + u.pn * BM + wc * 32 + 8 * fq) * 2u;
#pragma unroll
            for (int ai = 0; ai < 2; ++ai)
#pragma unroll
                for (int m = 0; m < 4; ++m)
#pragma unroll
                    for (int bj = 0; bj < 2; ++bj) st16(GB, off0 + (unsigned)((ai * HALF + m * 16) * D + bj * HALF) * 2u, pack8(acc[ai][bj][m][0], acc[ai][bj][m][1]));
        } else { const unsigned off0 = (unsigned)(row0 * D + (u.pn - 4) * HALF + wc * 32 + 8 * fq) * 2u;
#pragma unroll
            for (int ai = 0; ai < 2; ++ai)
#pragma unroll
                for (int m = 0; m < 4; ++m) st16(Z, off0 + (unsigned)((ai * HALF + m * 16) * D) * 2u, pack8(acc[ai][0][m][0] * acc[ai][1][m][0], acc[ai][0][m][1] * acc[ai][1][m][1]));
        }
    }
};
struct EpiQKV8 {
    bf16_t* O; size_t stride; float scale0; const float* sw; const float* rs;
    __device__ __forceinline__ void dma(const Unit& u, PG8_LAS unsigned char* xl, int wid, int lane) const {
        if (wid == 0) dma1k(sw + u.pn * BM, xl, lane); else if (wid == 1) dma1k(rs + u.pm * BM, xl + 1024, lane);
    }
    __device__ __forceinline__ void operator()(const f32x4 (&acc)[2][2][4][2], const Unit& u, int wr, int wc, int fr_, int fq_, const PG8_LAS unsigned char* xl) const {
        int fr = fr_, fq = fq_; asm volatile("" : "+v"(fr), "+v"(fq));
        const int row0 = u.pm * BM + wr * 64 + fr; const int t = u.pn >> 2; const int colt = (u.pn & 3) * BM; const int cl = wc * 32 + 8 * fq;
        bf16_t* base = O + (size_t)t * stride; const float sc = (t == 0) ? scale0 : 1.f; const unsigned off0 = (unsigned)(row0 * D + colt + cl) * 2u;
        const PG8_LAS float* sp = (const PG8_LAS float*)xl + cl; const PG8_LAS float* rp = (const PG8_LAS float*)(xl + 1024) + wr * 64 + fr;
        f32x4 sv[2][2];
#pragma unroll
        for (int bj = 0; bj < 2; ++bj)
#pragma unroll
            for (int n = 0; n < 2; ++n) sv[bj][n] = *(const PG8_LAS f32x4*)(sp + bj * HALF + 4 * n) * sc;
#pragma unroll
        for (int ai = 0; ai < 2; ++ai)
#pragma unroll
            for (int m = 0; m < 4; ++m) { const float r = rp[ai * HALF + m * 16];
#pragma unroll
                for (int bj = 0; bj < 2; ++bj) st16(base, off0 + (unsigned)((ai * HALF + m * 16) * D + bj * HALF) * 2u, pack8(acc[ai][bj][m][0] * (sv[bj][0] * r), acc[ai][bj][m][1] * (sv[bj][1] * r))); }
    }
};
struct EpiConvIn8 {
    bf16_t* GB; bf16_t* Z; const float* sw; const float* rs;
    __device__ __forceinline__ void dma(const Unit& u, PG8_LAS unsigned char* xl, int wid, int lane) const { if (wid == 0) dma1k(sw + u.pn * BM, xl, lane); else if (wid == 1) dma1k(rs + u.pm * BM, xl + 1024, lane); }
    __device__ __forceinline__ void operator()(const f32x4 (&acc)[2][2][4][2], const Unit& u, int wr, int wc, int fr_, int fq_, const PG8_LAS unsigned char* xl) const {
        int fr = fr_, fq = fq_; asm volatile("" : "+v"(fr), "+v"(fq));
        const int row0 = u.pm * BM + wr * 64 + fr; const int cl = wc * 32 + 8 * fq;
        const PG8_LAS float* sp = (const PG8_LAS float*)xl + cl; const PG8_LAS float* rp = (const PG8_LAS float*)(xl + 1024) + wr * 64 + fr;
        f32x4 sv[2][2];
#pragma unroll
        for (int bj = 0; bj < 2; ++bj)
#pragma unroll
            for (int n = 0; n < 2; ++n) sv[bj][n] = *(const PG8_LAS f32x4*)(sp + bj * HALF + 4 * n);
        if (u.pn < 4) { const unsigned off0 = (unsigned)(row0 * D + u.pn * BM + cl) * 2u;
#pragma unroll
            for (int ai = 0; ai < 2; ++ai)
#pragma unroll
                for (int m = 0; m < 4; ++m) { const float r = rp[ai * HALF + m * 16];
#pragma unroll
                    for (int bj = 0; bj < 2; ++bj) st16(GB, off0 + (unsigned)((ai * HALF + m * 16) * D + bj * HALF) * 2u, pack8(acc[ai][bj][m][0] * (sv[bj][0] * r), acc[ai][bj][m][1] * (sv[bj][1] * r))); }
        } else { const unsigned off0 = (unsigned)(row0 * D + (u.pn - 4) * HALF + cl) * 2u;
            const f32x4 sz0 = sv[0][0] * sv[1][0], sz1 = sv[0][1] * sv[1][1];
#pragma unroll
            for (int ai = 0; ai < 2; ++ai)
#pragma unroll
                for (int m = 0; m < 4; ++m) { const float r = rp[ai * HALF + m * 16], r2 = r * r;
                    st16(Z, off0 + (unsigned)((ai * HALF + m * 16) * D) * 2u, pack8(acc[ai][0][m][0] * acc[ai][1][m][0] * (sz0 * r2), acc[ai][0][m][1] * acc[ai][1][m][1] * (sz1 * r2))); }
        }
    }
};
struct EpiResid {
    __device__ __forceinline__ void dma(const Unit&, PG8_LAS unsigned char*, int, int) const {}
    const bf16_t* X; bf16_t* Yp;
    __device__ __forceinline__ void operator()(const f32x4 (&acc)[2][2][4][2], const Unit& u, int wr, int wc, int fr_, int fq_, const PG8_LAS unsigned char* xl) const {
        int fr = fr_, fq = fq_; asm volatile("" : "+v"(fr), "+v"(fq));
        const unsigned off0 = (unsigned)((u.pm * BM + wr * 64 + fr) * D + u.pn * BM + wc * 32 + 8 * fq) * 2u;
#pragma unroll
        for (int ai = 0; ai < 2; ++ai)
#pragma unroll
            for (int m = 0; m < 4; ++m)
#pragma unroll
                for (int bj = 0; bj < 2; ++bj) { const unsigned off = off0 + (unsigned)((ai * HALF + m * 16) * D + bj * HALF) * 2u; const v4u xr = *(const v4u*)((const char*)X + off);
                    f32x4 v0 = acc[ai][bj][m][0], v1 = acc[ai][bj][m][1];
                    v0[0] += ALPHA * bf_lo(xr.x); v0[1] += ALPHA * bf_hi(xr.x); v0[2] += ALPHA * bf_lo(xr.y); v0[3] += ALPHA * bf_hi(xr.y);
                    v1[0] += ALPHA * bf_lo(xr.z); v1[1] += ALPHA * bf_hi(xr.z); v1[2] += ALPHA * bf_lo(xr.w); v1[3] += ALPHA * bf_hi(xr.w);
                    st16(Yp, off, pack8(v0, v1)); }
    }
};
template <bool ROWS> struct EpiResid8 {
    const bf16_t* X; bf16_t* Yp; const float* sw; const float* rs; float rsc;
    __device__ __forceinline__ void dma(const Unit& u, PG8_LAS unsigned char* xl, int wid, int lane) const {
        if (wid == 0) dma1k(sw + u.pn * BM, xl, lane); else if (ROWS && wid == 1) dma1k(rs + u.pm * BM, xl + 1024, lane);
    }
    __device__ __forceinline__ void operator()(const f32x4 (&acc)[2][2][4][2], const Unit& u, int wr, int wc, int fr_, int fq_, const PG8_LAS unsigned char* xl) const {
        int fr = fr_, fq = fq_; asm volatile("" : "+v"(fr), "+v"(fq));
        const int cl = wc * 32 + 8 * fq;
        const unsigned off0 = (unsigned)((u.pm * BM + wr * 64 + fr) * D + u.pn * BM + cl) * 2u;
        const PG8_LAS float* sp = (const PG8_LAS float*)xl + cl; const PG8_LAS float* rp = (const PG8_LAS float*)(xl + 1024) + wr * 64 + fr;
        f32x4 sv[2][2];
#pragma unroll
        for (int bj = 0; bj < 2; ++bj)
#pragma unroll
            for (int n = 0; n < 2; ++n) sv[bj][n] = *(const PG8_LAS f32x4*)(sp + bj * HALF + 4 * n) * (ROWS ? 1.0f : rsc);
#pragma unroll
        for (int ai = 0; ai < 2; ++ai)
#pragma unroll
            for (int m = 0; m < 4; ++m) { float r = 1.0f; if (ROWS) r = rp[ai * HALF + m * 16];
#pragma unroll
                for (int bj = 0; bj < 2; ++bj) { const unsigned off = off0 + (unsigned)((ai * HALF + m * 16) * D + bj * HALF) * 2u; const v4u xr = *(const v4u*)((const char*)X + off);
                    f32x4 v0 = acc[ai][bj][m][0] * sv[bj][0], v1 = acc[ai][bj][m][1] * sv[bj][1]; if (ROWS) { v0 *= r; v1 *= r; }
                    v0[0] += ALPHA * bf_lo(xr.x); v0[1] += ALPHA * bf_hi(xr.x); v0[2] += ALPHA * bf_lo(xr.y); v0[3] += ALPHA * bf_hi(xr.y);
                    v1[0] += ALPHA * bf_lo(xr.z); v1[1] += ALPHA * bf_hi(xr.z); v1[2] += ALPHA * bf_lo(xr.w); v1[3] += ALPHA * bf_hi(xr.w);
                    st16(Yp, off, pack8(v0, v1)); } }
    }
};
__device__ __forceinline__ unsigned pk4_fp8(float a, float b, float c, float d) { int p = 0; p = __builtin_amdgcn_cvt_pk_fp8_f32(a, b, p, false); p = __builtin_amdgcn_cvt_pk_fp8_f32(c, d, p, true); return (unsigned)p; }
__device__ __forceinline__ unsigned pk4_i8(float a, float b, float c, float d) {
    unsigned r = 0;
    r = __builtin_amdgcn_cvt_pk_u8_f32(__builtin_rintf(a + 128.f), 0, r); r = __builtin_amdgcn_cvt_pk_u8_f32(__builtin_rintf(b + 128.f), 1, r);
    r = __builtin_amdgcn_cvt_pk_u8_f32(__builtin_rintf(c + 128.f), 2, r); r = __builtin_amdgcn_cvt_pk_u8_f32(__builtin_rintf(d + 128.f), 3, r);
    return r ^ 0x80808080u;
}
template <bool I8> __device__ __forceinline__ unsigned pkq4(float a, float b, float c, float d) { if constexpr (I8) return pk4_i8(a, b, c, d); else return pk4_fp8(a, b, c, d); }
__device__ __forceinline__ f32x2 swiglu8_pk(f32x2 g, f32x2 l8) {
    g.x = fminf(g.x, 7.0f); g.y = fminf(g.y, 7.0f);
    l8.x = fminf(fmaxf(l8.x, -56.0f), 56.0f); l8.y = fminf(fmaxf(l8.y, -56.0f), 56.0f);
    const f32x2 t = g * (-1.702f * LOG2E);
    f32x2 e; e.x = __builtin_amdgcn_exp2f(t.x); e.y = __builtin_amdgcn_exp2f(t.y);
    const f32x2 d = e + 1.0f;
    f32x2 r; r.x = __builtin_amdgcn_rcpf(d.x); r.y = __builtin_amdgcn_rcpf(d.y);
    return (g * r) * (l8 + A2SCALE);
}
struct EpiMoe1 {
    unsigned char* A2; const float* b1; const float* sw; float inv_sa;
    __device__ __forceinline__ void dma(const Unit& u, PG8_LAS unsigned char* xl, int wid, int lane) const {
        if (wid == 0) dma1k(b1 + (size_t)u.e * 2048 + u.pn * BM, xl, lane); else if (wid == 1) dma1k(sw + (size_t)u.e * 2048 + u.pn * BM, xl + 1024, lane);
    }
    __device__ __forceinline__ void operator()(const f32x4 (&acc)[2][2][4][2], const Unit& u, int wr, int wc, int fr_, int fq_, const PG8_LAS unsigned char* xl) const {
        int fr = fr_, fq = fq_; asm volatile("" : "+v"(fr), "+v"(fq));
        const int cl = wc * 32 + 8 * fq; const unsigned off0 = (unsigned)((u.pm * BM + wr * 64 + fr) * D + u.pn * HALF + cl);
        const PG8_LAS float* bp = (const PG8_LAS float*)xl + 2 * cl; f32x4 bb[4];
#pragma unroll
        for (int j = 0; j < 4; ++j) bb[j] = *(const PG8_LAS f32x4*)(bp + 4 * j);
        const PG8_LAS float* sp = (const PG8_LAS float*)(xl + 1024) + cl;
        const f32x4 sg0 = *(const PG8_LAS f32x4*)(sp) * inv_sa, sg1 = *(const PG8_LAS f32x4*)(sp + 4) * inv_sa;
        const f32x4 sl0 = *(const PG8_LAS f32x4*)(sp + HALF) * (inv_sa * A2SCALE), sl1 = *(const PG8_LAS f32x4*)(sp + HALF + 4) * (inv_sa * A2SCALE);
        f32x2 sgp[4] = {{sg0[0], sg0[1]}, {sg0[2], sg0[3]}, {sg1[0], sg1[1]}, {sg1[2], sg1[3]}}, slp[4] = {{sl0[0], sl0[1]}, {sl0[2], sl0[3]}, {sl1[0], sl1[1]}, {sl1[2], sl1[3]}};
        f32x2 bgp[4], blp[4];
#pragma unroll
        for (int q = 0; q < 4; ++q) { bgp[q] = (f32x2){bb[q][0], bb[q][2]}; blp[q] = (f32x2){bb[q][1] * A2SCALE, bb[q][3] * A2SCALE}; }
        const unsigned offp = off0 + ((fq & 1) ? (unsigned)(16 * D - 8) : 0u);
#pragma unroll
        for (int ai = 0; ai < 2; ++ai)
#pragma unroll
            for (int mp = 0; mp < 2; ++mp) { typedef unsigned u32x2 __attribute__((ext_vector_type(2))); u32x2 w[2];
#pragma unroll
                for (int mm = 0; mm < 2; ++mm) { const int m = 2 * mp + mm; f32x2 o[4];
#pragma unroll
                    for (int q = 0; q < 4; ++q) { const f32x4 ga = acc[ai][0][m][q >> 1], la = acc[ai][1][m][q >> 1]; const int h2 = (q & 1) * 2;
                        const f32x2 g = (f32x2){ga[h2], ga[h2 + 1]} * sgp[q] + bgp[q], l8 = (f32x2){la[h2], la[h2 + 1]} * slp[q] + blp[q];
                        o[q] = swiglu8_pk(g, l8); }
                    w[mm].x = pk4_fp8(o[0].x, o[0].y, o[1].x, o[1].y); w[mm].y = pk4_fp8(o[2].x, o[2].y, o[3].x, o[3].y); }
                const auto sx = __builtin_amdgcn_permlane16_swap(w[0].x, w[1].x, false, false); const auto sy = __builtin_amdgcn_permlane16_swap(w[0].y, w[1].y, false, false);
                const v4u ov = {sx[0], sy[0], sx[1], sy[1]};
                *(v4u*)(A2 + (offp + (unsigned)((ai * HALF + mp * 32) * D))) = ov; }
    }
};
struct EpiMoe2 {
    unsigned char* Y; const float* b2; const float* sw; const int* lslot; const float* lgate;
    __device__ __forceinline__ void dma(const Unit& u, PG8_LAS unsigned char* xl, int wid, int lane) const {
        const size_t lb = (size_t)u.e * LCAP + u.lr0;
        if (wid == 0) dma1k(b2 + (size_t)u.e * 1024 + u.pn * BM, xl, lane); else if (wid == 1) dma1k(sw + (size_t)u.e * 1024 + u.pn * BM, xl + 1024, lane);
        else if (wid == 2) dma1k(lslot + lb, xl + 2048, lane); else if (wid == 3) dma1k(lgate + lb, xl + 3072, lane);
    }
    __device__ __forceinline__ void operator()(const f32x4 (&acc)[2][2][4][2], const Unit& u, int wr, int wc, int fr_, int fq_, const PG8_LAS unsigned char* xl) const {
        int fr = fr_, fq = fq_; asm volatile("" : "+v"(fr), "+v"(fq));
        const int rl0 = wr * 64 + fr, cl = wc * 32 + 8 * fq, col0 = u.pn * BM + cl;
        const PG8_LAS float* bp = (const PG8_LAS float*)xl + cl; const PG8_LAS float* sp = (const PG8_LAS float*)(xl + 1024) + cl; f32x4 bv[2][2], sv[2][2];
#pragma unroll
        for (int bj = 0; bj < 2; ++bj)
#pragma unroll
            for (int n = 0; n < 2; ++n) { bv[bj][n] = *(const PG8_LAS f32x4*)(bp + bj * HALF + 4 * n); sv[bj][n] = *(const PG8_LAS f32x4*)(sp + bj * HALF + 4 * n) * (1.0f / (A2SCALE * KREP_MOE_)); }
        const PG8_LAS int* sl = (const PG8_LAS int*)(xl + 2048); const PG8_LAS float* gl = (const PG8_LAS float*)(xl + 3072);
        const unsigned cadj = (unsigned)(u.pn * BM + ((fq & 1) ? (HALF + cl - 8) : cl));
#pragma unroll
        for (int ai = 0; ai < 2; ++ai)
#pragma unroll
            for (int m = 0; m < 4; ++m) { const int rl = rl0 + ai * HALF + m * 16;
                const bool ok = rl < u.valid; const int slot = ok ? sl[rl] : M * 4; const float g = gl[rl] * YSCALE;
                typedef unsigned u32x2 __attribute__((ext_vector_type(2))); u32x2 w[2];
#pragma unroll
                for (int bj = 0; bj < 2; ++bj) { f32x4 v0 = (acc[ai][bj][m][0] * sv[bj][0] + bv[bj][0]) * g, v1 = (acc[ai][bj][m][1] * sv[bj][1] + bv[bj][1]) * g;
#pragma unroll
                    for (int i = 0; i < 4; ++i) { v0[i] = fminf(fmaxf(v0[i], -448.0f), 448.0f); v1[i] = fminf(fmaxf(v1[i], -448.0f), 448.0f); }
                    w[bj].x = pk4_fp8(v0[0], v0[1], v0[2], v0[3]); w[bj].y = pk4_fp8(v1[0], v1[1], v1[2], v1[3]); }
                const auto sx = __builtin_amdgcn_permlane16_swap(w[0].x, w[1].x, false, false); const auto sy = __builtin_amdgcn_permlane16_swap(w[0].y, w[1].y, false, false);
                const v4u o = {sx[0], sy[0], sx[1], sy[1]};
                *(v4u*)(Y + ((unsigned)(slot * D) + cadj)) = o; }
    }
};

typedef int v8i_t __attribute__((ext_vector_type(8))); typedef int v4i_t __attribute__((ext_vector_type(4)));
__device__ __forceinline__ v8i_t cat8(bf16x8 lo, bf16x8 hi) { const v4i_t a = __builtin_bit_cast(v4i_t, lo), b = __builtin_bit_cast(v4i_t, hi); return __builtin_shufflevector(a, b, 0, 1, 2, 3, 4, 5, 6, 7); }
template <class Prob, class Epi, bool ALIGN_EPI, bool F8 = false, int KREP = 1, bool I8 = false>
__device__ __forceinline__ void gemm_phase(PG8_LAS unsigned char* lds, PG8_LAS unsigned char* xl, const Prob& P, const Epi& E) {
    int tid_ = P.tid; asm volatile("" : "+v"(tid_));
    const int tid = tid_, wid = __builtin_amdgcn_readfirstlane(tid >> 6), lane = tid & 63, wr = wid >> 2, wc = wid & 3, fr = lane & 15, fq = lane >> 4;
    constexpr int RP = F8 ? 1024 : 2048, nt = F8 ? 8 : NTK;
    constexpr bool GA = Prob::GATHER;
    int RA[2], CA[2]; unsigned voffB[2], voffA[2];
#pragma unroll
    for (int i = 0; i < 2; ++i) { int R, C; stage_rc(tid * 16 + i * 8192, R, C); const int Rb = (R & ~31) + perm32(R & 31); RA[i] = R; CA[i] = C; voffB[i] = (unsigned)(Rb * RP + C * 2); voffA[i] = (unsigned)(R * RP + C * 2); }
    constexpr unsigned kstep = (unsigned)(BK * 2);
    constexpr unsigned hstep = (unsigned)HALF * RP;
    const unsigned ldsw = (unsigned)wid * 1024u;
    const int aoff = lds_byte(wr * 64 + fr, fq * 8), boff = lds_byte(wc * 32 + fr, fq * 8);
    typedef const __attribute__((address_space(1))) unsigned* gptr_t;
#define PG8_SA(b, h) (((b) * 2 + (h)) * HTB)
#define PG8_SB(b, h) ((4 + (b) * 2 + (h)) * HTB)
#define PG8_STAGE_B(bufoff, uoff) do { _Pragma("unroll") for (int _i = 0; _i < 2; ++_i) \
        __builtin_amdgcn_global_load_lds((gptr_t)(Bb + (voffB[_i] + (unsigned)(uoff))), (PG8_LAS unsigned*)(lds + (bufoff) + ldsw + _i * 8192), 16, 0, 0); } while (0)
#define PG8_STAGE_A(bufoff, koff, h, NX) do { _Pragma("unroll") for (int _i = 0; _i < 2; ++_i) { unsigned _o; \
        if constexpr (GA) _o = ((NX) ? vn[h][_i] : vc[h][_i]) + (unsigned)(koff); else _o = voffA[_i] + (((NX) ? nAo : cAo) + (unsigned)(h) * hstep + (unsigned)(koff)); \
        __builtin_amdgcn_global_load_lds((gptr_t)(Ab + _o), (PG8_LAS unsigned*)(lds + (bufoff) + ldsw + _i * 8192), 16, 0, 0); } } while (0)
#define PG8_LDA(dst, b, h) do { _Pragma("unroll") for (int m = 0; m < 4; ++m) _Pragma("unroll") for (int k = 0; k < 2; ++k) dst[m][k] = *(const PG8_LAS bf16x8*)(lds + PG8_SA(b, h) + aoff + m * 2048 + k * 1024); } while (0)
#define PG8_LDB(dst, b, h) do { _Pragma("unroll") for (int n = 0; n < 2; ++n) _Pragma("unroll") for (int k = 0; k < 2; ++k) dst[n][k] = *(const PG8_LAS bf16x8*)(lds + PG8_SB(b, h) + boff + n * 2048 + k * 1024); } while (0)
#define PG8_MMA(ai, bj, At, Bt) do { __builtin_amdgcn_s_setprio(1); _Pragma("unroll") for (int m = 0; m < 4; ++m) _Pragma("unroll") for (int n = 0; n < 2; ++n) _Pragma("unroll") for (int k = 0; k < 2; ++k) \
        acc[ai][bj][m][n] = __builtin_amdgcn_mfma_f32_16x16x32_bf16(Bt[n][k], At[m][k], acc[ai][bj][m][n], 0, 0, 0); __builtin_amdgcn_s_setprio(0); } while (0)
#define PG8_MMA8(ai, bj, At, Bt) do { __builtin_amdgcn_s_setprio(1); if constexpr (I8) { _Pragma("unroll") for (int k = 0; k < 2; ++k) _Pragma("unroll") for (int m = 0; m < 4; ++m) _Pragma("unroll") for (int n = 0; n < 2; ++n) \
        asm volatile("v_mfma_i32_16x16x64_i8 %0, %1, %2, %0" : "+v"(acc[ai][bj][m][n]) : "v"(Bt[n][k]), "v"(At[m][k])); } else { _Pragma("unroll") for (int m = 0; m < 4; ++m) _Pragma("unroll") for (int n = 0; n < 2; ++n) \
        asm volatile("v_mfma_f32_16x16x128_f8f6f4 %0, %1, %2, %0" : "+v"(acc[ai][bj][m][n]) : "v"(cat8(Bt[n][0], Bt[n][1])), "v"(cat8(At[m][0], At[m][1]))); } __builtin_amdgcn_s_setprio(0); } while (0)
#define PG8_MMA8Z(ai, bj, At, Bt) do { __builtin_amdgcn_s_setprio(1); if constexpr (I8) { _Pragma("unroll") for (int m = 0; m < 4; ++m) _Pragma("unroll") for (int n = 0; n < 2; ++n) \
        asm volatile("v_mfma_i32_16x16x64_i8 %0, %1, %2, 0" : "=&v"(acc[ai][bj][m][n]) : "v"(Bt[n][0]), "v"(At[m][0])); _Pragma("unroll") for (int m = 0; m < 4; ++m) _Pragma("unroll") for (int n = 0; n < 2; ++n) \
        asm volatile("v_mfma_i32_16x16x64_i8 %0, %1, %2, %0" : "+v"(acc[ai][bj][m][n]) : "v"(Bt[n][1]), "v"(At[m][1])); } else { _Pragma("unroll") for (int m = 0; m < 4; ++m) _Pragma("unroll") for (int n = 0; n < 2; ++n) \
        asm volatile("v_mfma_f32_16x16x128_f8f6f4 %0, %1, %2, 0" : "=&v"(acc[ai][bj][m][n]) : "v"(cat8(Bt[n][0], Bt[n][1])), "v"(cat8(At[m][0], At[m][1]))); } __builtin_amdgcn_s_setprio(0); } while (0)
#define PG8_MM(ai, bj, At, Bt) do { if constexpr (F8) PG8_MMA8(ai, bj, At, Bt); else PG8_MMA(ai, bj, At, Bt); } while (0)
#define PG8_MM2(FIRST, ai, At) do { if constexpr (F8) { if (FIRST) { PG8_MMA8Z(ai, 0, At, B0); PG8_MMA8Z(ai, 1, At, B1); } else { PG8_MMA8(ai, 0, At, B0); PG8_MMA8(ai, 1, At, B1); } } else { PG8_MMA(ai, 0, At, B0); PG8_MMA(ai, 1, At, B1); } } while (0)
#define PG8_WAIT_V(n) asm volatile("s_waitcnt vmcnt(" #n ")" ::: "memory")
#define PG8_WAIT_L(n) asm volatile("s_waitcnt lgkmcnt(" #n ")" ::: "memory")
#define PG8_BAR __builtin_amdgcn_s_barrier()
#define PG8_SCHED __builtin_amdgcn_sched_barrier(0)
    Unit cur, nxt; int ui = 0;
    if (!P.next(0, cur)) return;
    f32x4 acc[2][2][4][2];
    if constexpr (!F8) {
#pragma unroll
    for (int a = 0; a < 2; ++a)
#pragma unroll
        for (int b = 0; b < 2; ++b)
#pragma unroll
            for (int m = 0; m < 4; ++m)
#pragma unroll
                for (int n = 0; n < 2; ++n) acc[a][b][m][n] = (f32x4){0.f, 0.f, 0.f, 0.f};
    }
    bf16x8 At[4][2], B0[2][2], B1[2][2];
    unsigned vc[2][2], vn[2][2]; unsigned cAo = 0, nAo = 0;
    if constexpr (GA) { P.a_off(cur, RA, CA, vc); vn[0][0] = vc[0][0]; vn[0][1] = vc[0][1]; vn[1][0] = vc[1][0]; vn[1][1] = vc[1][1]; } else { cAo = P.a_tile(cur); nAo = cAo; vc[0][0] = vn[0][0] = 0; }
    const char* const Ab = P.A; const char* const Bb = P.Bt; unsigned cBo = P.b_off(cur), nBo = cBo;
    PG8_STAGE_B(PG8_SB(0, 0), cBo); PG8_STAGE_B(PG8_SB(0, 1), cBo + hstep); PG8_STAGE_A(PG8_SA(0, 0), 0u, 0, false); PG8_STAGE_A(PG8_SA(0, 1), 0u, 1, false);
    if (wr == 1) PG8_BAR;
    PG8_WAIT_V(2); PG8_BAR;
    PG8_STAGE_B(PG8_SB(1, 0), cBo + kstep); PG8_STAGE_A(PG8_SA(1, 0), kstep, 0, false); PG8_STAGE_B(PG8_SB(1, 1), cBo + hstep + kstep);
    PG8_WAIT_V(6); PG8_BAR;
    for (;;) {
        const bool has_next = P.next(ui + 1, nxt);
        PG8_LAS unsigned char* const xe = xl + (ui & 1) * XL_EPI;
        PG8_LAS unsigned char* const xg = xl + 2 * XL_EPI + ((ui + 1) & 1) * XL_GATHER;
        E.dma(cur, xe, wid, lane);
        if (has_next) { if constexpr (GA) P.dma_rows(nxt, xg, wid, lane); else nAo = P.a_tile(nxt); nBo = P.b_off(nxt); }
        else { nAo = cAo; nBo = cBo; }
#pragma unroll 1
        for (int rep = 0; rep < KREP; ++rep)
#pragma unroll 1
        for (int t = 0; t < nt; t += 2) {
            const bool lastt = (t == nt - 2); const bool last = lastt && (rep == KREP - 1); const bool first = (t == 0) && (rep == 0); (void)first;
            if constexpr (GA) { if (last) { if (has_next) P.a_off_lds(nxt, RA, CA, xg, vn); else { vn[0][0] = vc[0][0]; vn[0][1] = vc[0][1]; vn[1][0] = vc[1][0]; vn[1][1] = vc[1][1]; } } }
            const unsigned k1 = (unsigned)(t + 1) * kstep;
            const unsigned k2 = lastt ? 0u : (unsigned)(t + 2) * kstep, k3 = k2 + kstep;
            const unsigned b2 = (last ? nBo : cBo) + k2, b3 = b2 + kstep;
            PG8_LDB(B0, 0, 0); PG8_LDB(B1, 0, 1); PG8_SCHED; PG8_LDA(At, 0, 0); PG8_STAGE_A(PG8_SA(1, 1), k1, 1, false);
            PG8_WAIT_V(8); PG8_WAIT_L(0); PG8_BAR; PG8_MM2(first, 0, At); PG8_BAR; PG8_SCHED;
            PG8_LDA(At, 0, 1); PG8_STAGE_B(PG8_SB(0, 0), b2); PG8_STAGE_B(PG8_SB(0, 1), b2 + hstep); PG8_STAGE_A(PG8_SA(0, 0), k2, 0, last);
            PG8_WAIT_V(8); PG8_WAIT_L(0); PG8_BAR; PG8_MM2(first, 1, At); PG8_BAR; PG8_SCHED;
            PG8_LDB(B0, 1, 0); PG8_LDB(B1, 1, 1); PG8_SCHED; PG8_LDA(At, 1, 0); PG8_STAGE_A(PG8_SA(0, 1), k2, 1, last);
            PG8_WAIT_V(8); PG8_WAIT_L(0); PG8_BAR; PG8_MM(0, 0, At, B0); PG8_MM(0, 1, At, B1); PG8_BAR; PG8_SCHED;
            PG8_LDA(At, 1, 1); PG8_STAGE_B(PG8_SB(1, 0), b3); PG8_STAGE_B(PG8_SB(1, 1), b3 + hstep); PG8_STAGE_A(PG8_SA(1, 0), k3, 0, last);
            PG8_WAIT_V(8); PG8_WAIT_L(0); PG8_BAR; PG8_MM(1, 0, At, B0); PG8_MM(1, 1, At, B1); PG8_BAR; PG8_SCHED;
        }
        if constexpr (ALIGN_EPI) { if (wr == 0) PG8_BAR; }
        if constexpr (F8) asm volatile("s_nop 15\n\ts_nop 7" ::: "memory");
        if constexpr (I8) {
#pragma unroll
            for (int a = 0; a < 2; ++a)
#pragma unroll
                for (int b = 0; b < 2; ++b)
#pragma unroll
                    for (int m = 0; m < 4; ++m)
#pragma unroll
                        for (int n = 0; n < 2; ++n)
#pragma unroll
                            for (int i = 0; i < 4; ++i) acc[a][b][m][n][i] = (float)__float_as_int(acc[a][b][m][n][i]);
        }
        E(acc, cur, wr, wc, fr, fq, xe);
        if (!has_next) break;
        if constexpr (!F8)
#pragma unroll
        for (int a = 0; a < 2; ++a)
#pragma unroll
            for (int b = 0; b < 2; ++b)
#pragma unroll
                for (int m = 0; m < 4; ++m)
#pragma unroll
                    for (int n = 0; n < 2; ++n) acc[a][b][m][n] = (f32x4){0.f, 0.f, 0.f, 0.f};
        cur = nxt; cBo = nBo; cAo = nAo; ++ui;
        if constexpr (GA) { vc[0][0] = vn[0][0]; vc[0][1] = vn[0][1]; vc[1][0] = vn[1][0]; vc[1][1] = vn[1][1]; }
        if constexpr (ALIGN_EPI) { if (wr == 1) PG8_BAR; }
    }
    PG8_WAIT_V(0);
    if constexpr (!ALIGN_EPI) { if (wr == 0) PG8_BAR; }
    PG8_BAR;
#undef PG8_SA
#undef PG8_SB
#undef PG8_STAGE_A
#undef PG8_STAGE_B
#undef PG8_LDA
#undef PG8_LDB
#undef PG8_MMA
#undef PG8_MMA8
#undef PG8_MM
#undef PG8_MM2
#undef PG8_MMA8Z
#undef PG8_WAIT_V
#undef PG8_WAIT_L
#undef PG8_BAR
#undef PG8_SCHED
}
}

namespace att {
constexpr int QBLK = 32, KVBLK = 64, LDX = 1024, NT = SEQ / KVBLK;
constexpr int SHM_V = KVBLK * 128 * 2, SHM_K = KVBLK * 128 * 2, NSLOT = 3;
constexpr int OFF_V = 0, OFF_K = NSLOT * SHM_V, OFF_WS = NSLOT * (SHM_V + SHM_K), OFF_TBL = OFF_WS + 8 * 64 * 4, ATT_LDS = OFF_TBL + 2048;
constexpr float THR2 = 8.0f * LOG2E;
#define KSWZ(row, colB) ((row) * 256 + ((colB) ^ (((row) & 7) << 4)))
#define SBAR() __builtin_amdgcn_sched_barrier(0)
__device__ __forceinline__ int crow(int r, int hi) { return (r & 3) + 8 * (r >> 2) + 4 * hi; }
__device__ __forceinline__ int v_st(int k, int c) { const int kk = (k & ~0xC) | ((k & 4) << 1) | ((k & 8) >> 1); return ((kk >> 3) * 4 + (c >> 5)) * 512 + ((kk & 7) * 32 + (c & 31)) * 2; }
__device__ __forceinline__ int v_rd_base(int lane) { return ((lane & 3) << 3) | (((lane >> 2) & 3) << 6) | (((lane >> 4) & 1) << 5) | (((lane >> 5) & 1) << 8); }
constexpr int v_rd_off(int d0, int ks, int half) { return d0 * 512 + ks * 4096 + half * 2048; }
template <int OFF> __device__ __forceinline__ s16x4 tr_read(int vb) { s16x4 r; asm volatile("ds_read_b64_tr_b16 %0, %1 offset:%2" : "=&v"(r) : "v"(vb), "i"(OFF) : "memory"); return r; }
#define ATT_RD8(L, H, D0) do { \
    asm volatile("ds_read_b64_tr_b16 %0, %1 offset:%2" : "=&v"(L[0]) : "v"(vb), "i"(v_rd_off(D0, 0, 0)) : "memory"); asm volatile("ds_read_b64_tr_b16 %0, %1 offset:%2" : "=&v"(H[0]) : "v"(vb), "i"(v_rd_off(D0, 0, 1)) : "memory"); \
    asm volatile("ds_read_b64_tr_b16 %0, %1 offset:%2" : "=&v"(L[1]) : "v"(vb), "i"(v_rd_off(D0, 1, 0)) : "memory"); asm volatile("ds_read_b64_tr_b16 %0, %1 offset:%2" : "=&v"(H[1]) : "v"(vb), "i"(v_rd_off(D0, 1, 1)) : "memory"); \
    asm volatile("ds_read_b64_tr_b16 %0, %1 offset:%2" : "=&v"(L[2]) : "v"(vb), "i"(v_rd_off(D0, 2, 0)) : "memory"); asm volatile("ds_read_b64_tr_b16 %0, %1 offset:%2" : "=&v"(H[2]) : "v"(vb), "i"(v_rd_off(D0, 2, 1)) : "memory"); \
    asm volatile("ds_read_b64_tr_b16 %0, %1 offset:%2" : "=&v"(L[3]) : "v"(vb), "i"(v_rd_off(D0, 3, 0)) : "memory"); asm volatile("ds_read_b64_tr_b16 %0, %1 offset:%2" : "=&v"(H[3]) : "v"(vb), "i"(v_rd_off(D0, 3, 1)) : "memory"); } while (0)
#define ATT_PK(L, H) (bf16x8){L[0], L[1], L[2], L[3], H[0], H[1], H[2], H[3]}
#define ATT_MM4(OD, L, H) do { OD = __builtin_amdgcn_mfma_f32_32x32x16_bf16(pa0, ATT_PK(L[0], H[0]), OD, 0, 0, 0); OD = __builtin_amdgcn_mfma_f32_32x32x16_bf16(pa1, ATT_PK(L[1], H[1]), OD, 0, 0, 0); \
    OD = __builtin_amdgcn_mfma_f32_32x32x16_bf16(pa2, ATT_PK(L[2], H[2]), OD, 0, 0, 0); OD = __builtin_amdgcn_mfma_f32_32x32x16_bf16(pa3, ATT_PK(L[3], H[3]), OD, 0, 0, 0); } while (0)
__device__ __forceinline__ void pv_d0(f32x16* o, int vb, bf16x8 pa0, bf16x8 pa1, bf16x8 pa2, bf16x8 pa3) {
  s16x4 la[4], ha[4], lb[4], hb[4];
  ATT_RD8(la, ha, 0); ATT_RD8(lb, hb, 1);
  asm volatile("s_waitcnt lgkmcnt(8)" ::: "memory"); SBAR(); ATT_MM4(o[0], la, ha); SBAR();
  ATT_RD8(la, ha, 2);
  asm volatile("s_waitcnt lgkmcnt(8)" ::: "memory"); SBAR(); ATT_MM4(o[1], lb, hb); SBAR();
  ATT_RD8(lb, hb, 3);
  asm volatile("s_waitcnt lgkmcnt(8)" ::: "memory"); SBAR(); ATT_MM4(o[2], la, ha); SBAR();
  asm volatile("s_waitcnt lgkmcnt(0)" ::: "memory"); SBAR(); ATT_MM4(o[3], lb, hb);
  const bf16x8 ones = {(short)0x3F80, (short)0x3F80, (short)0x3F80, (short)0x3F80, (short)0x3F80, (short)0x3F80, (short)0x3F80, (short)0x3F80};
  o[4] = __builtin_amdgcn_mfma_f32_32x32x16_bf16(pa0, ones, o[4], 0, 0, 0); o[4] = __builtin_amdgcn_mfma_f32_32x32x16_bf16(pa1, ones, o[4], 0, 0, 0);
  o[4] = __builtin_amdgcn_mfma_f32_32x32x16_bf16(pa2, ones, o[4], 0, 0, 0); o[4] = __builtin_amdgcn_mfma_f32_32x32x16_bf16(pa3, ones, o[4], 0, 0, 0);
}
__device__ __forceinline__ void pv_softmax(f32x16* o, int vb, bf16x8 pa0, bf16x8 pa1, bf16x8 pa2, bf16x8 pa3, f32x16& p0, f32x16& p1, float& m_reg, float& alpha, bool& resc) {
  s16x4 la[4], ha[4], lb[4], hb[4];
  ATT_RD8(la, ha, 0); ATT_RD8(lb, hb, 1);
  asm volatile("s_waitcnt lgkmcnt(8)" ::: "memory"); SBAR();
  float a = fmaxf(fmaxf(p0[0], p0[1]), p1[0]), b = fmaxf(fmaxf(p0[2], p0[3]), p1[1]); a = fmaxf(fmaxf(a, p1[2]), p1[3]);
#pragma unroll
  for (int r = 4; r < 16; r += 4) { a = fmaxf(fmaxf(a, p0[r]), p0[r + 1]); b = fmaxf(fmaxf(b, p0[r + 2]), p0[r + 3]); a = fmaxf(fmaxf(a, p1[r]), p1[r + 1]); b = fmaxf(fmaxf(b, p1[r + 2]), p1[r + 3]); }
  float pmax = fmaxf(a, b);
  ATT_MM4(o[0], la, ha); SBAR();
  ATT_RD8(la, ha, 2);
  asm volatile("s_waitcnt lgkmcnt(8)" ::: "memory"); SBAR();
  { auto rr = __builtin_amdgcn_permlane32_swap(__float_as_uint(pmax), __float_as_uint(pmax), false, false);
    pmax = fmaxf(__uint_as_float(rr[0]), __uint_as_float(rr[1])); }
  resc = false; alpha = 1.f;
  if (__builtin_expect(!__all(pmax <= THR2), 0)) { const float dl = fmaxf(pmax, 0.f); m_reg += dl; alpha = __builtin_amdgcn_exp2f(-dl); resc = true;
#pragma unroll
    for (int r = 0; r < 16; ++r) { p0[r] -= dl; p1[r] -= dl; } }
  ATT_MM4(o[1], lb, hb); SBAR();
  ATT_RD8(lb, hb, 3);
  asm volatile("s_waitcnt lgkmcnt(8)" ::: "memory"); SBAR();
#pragma unroll
  for (int r = 0; r < 16; ++r) p0[r] = __builtin_amdgcn_exp2f(p0[r]);
  ATT_MM4(o[2], la, ha); SBAR();
  asm volatile("s_waitcnt lgkmcnt(0)" ::: "memory"); SBAR();
#pragma unroll
  for (int r = 0; r < 16; ++r) p1[r] = __builtin_amdgcn_exp2f(p1[r]);
  ATT_MM4(o[3], lb, hb);
  const bf16x8 ones = {(short)0x3F80, (short)0x3F80, (short)0x3F80, (short)0x3F80, (short)0x3F80, (short)0x3F80, (short)0x3F80, (short)0x3F80};
  o[4] = __builtin_amdgcn_mfma_f32_32x32x16_bf16(pa0, ones, o[4], 0, 0, 0); o[4] = __builtin_amdgcn_mfma_f32_32x32x16_bf16(pa1, ones, o[4], 0, 0, 0);
  o[4] = __builtin_amdgcn_mfma_f32_32x32x16_bf16(pa2, ones, o[4], 0, 0, 0); o[4] = __builtin_amdgcn_mfma_f32_32x32x16_bf16(pa3, ones, o[4], 0, 0, 0);
}
__device__ __forceinline__ void near_bias(f32x16& p0, f32x16& p1, int dq, const float* tbl) {
#pragma unroll
  for (int r = 0; r < 16; ++r) { const int c0 = (r & 3) + 8 * (r >> 2); p0[r] += tbl[dq + c0]; p1[r] += tbl[dq + c0 + 32]; }
}
__device__ __forceinline__ void qkt(f32x16& p0, f32x16& p1, const char* Ks, const bf16x8* qr, int r32, int hi, int mapB) {
  bf16x8 k0[4], k1[4];
#pragma unroll
  for (int d0 = 0; d0 < 4; ++d0) { const int cb = mapB + (d0 * 16 + hi * 8) * 2;
    k0[d0] = *reinterpret_cast<const bf16x8*>(Ks + KSWZ(r32, cb)); k1[d0] = *reinterpret_cast<const bf16x8*>(Ks + KSWZ(32 + r32, cb)); }
  p0 = f32x16{}; p1 = f32x16{};
#pragma unroll
  for (int d0 = 0; d0 < 4; ++d0) {
    p0 = __builtin_amdgcn_mfma_f32_32x32x16_bf16(k0[d0], qr[d0], p0, 0, 0, 0);
    p1 = __builtin_amdgcn_mfma_f32_32x32x16_bf16(k1[d0], qr[d0], p1, 0, 0, 0); }
}
__device__ __forceinline__ void qkt_seed(f32x16& p0, f32x16& p1, const char* Ks, const bf16x8* qr, const int (&koff)[4], const f32x16& seed) {
#pragma unroll
  for (int d0 = 0; d0 < 4; ++d0) {
    const bf16x8 b0 = *reinterpret_cast<const bf16x8*>(Ks + koff[d0]);
    const bf16x8 b1 = *reinterpret_cast<const bf16x8*>(Ks + koff[d0] + 8192);
    if (d0 == 0) { p0 = __builtin_amdgcn_mfma_f32_32x32x16_bf16(b0, qr[0], seed, 0, 0, 0); p1 = __builtin_amdgcn_mfma_f32_32x32x16_bf16(b1, qr[0], seed, 0, 0, 0); }
    else { p0 = __builtin_amdgcn_mfma_f32_32x32x16_bf16(b0, qr[d0], p0, 0, 0, 0); p1 = __builtin_amdgcn_mfma_f32_32x32x16_bf16(b1, qr[d0], p1, 0, 0, 0); } }
}
__device__ __forceinline__ void partialSM_seeded(f32x16& p0, f32x16& p1, float& m_reg, float& alpha, bool& resc, int mode, int dq, const float* tbl) {
  if (mode == 0) {
#pragma unroll
    for (int r = 0; r < 16; ++r) { const int c0 = (r & 3) + 8 * (r >> 2);
      p0[r] += tbl[dq + c0]; p1[r] += tbl[dq + c0 + 32]; }
  }
  float a = fmaxf(fmaxf(p0[0], p0[1]), p1[0]), b = fmaxf(fmaxf(p0[2], p0[3]), p1[1]); a = fmaxf(fmaxf(a, p1[2]), p1[3]);
#pragma unroll
  for (int r = 4; r < 16; r += 4) { a = fmaxf(fmaxf(a, p0[r]), p0[r + 1]); b = fmaxf(fmaxf(b, p0[r + 2]), p0[r + 3]); a = fmaxf(fmaxf(a, p1[r]), p1[r + 1]); b = fmaxf(fmaxf(b, p1[r + 2]), p1[r + 3]); }
  float pmax = fmaxf(a, b);
  { auto rr = __builtin_amdgcn_permlane32_swap(__float_as_uint(pmax), __float_as_uint(pmax), false, false);
    pmax = fmaxf(__uint_as_float(rr[0]), __uint_as_float(rr[1])); }
  resc = false; alpha = 1.f;
  if (__builtin_expect(!__all(pmax <= THR2), 0)) { const float dl = fmaxf(pmax, 0.f); m_reg += dl; alpha = __builtin_amdgcn_exp2f(-dl); resc = true;
#pragma unroll
    for (int r = 0; r < 16; ++r) { p0[r] -= dl; p1[r] -= dl; } }
#pragma unroll
  for (int r = 0; r < 16; ++r) p0[r] = __builtin_amdgcn_exp2f(p0[r]);
}
__device__ __forceinline__ void partialSM(f32x16& p0, f32x16& p1, float& m_reg, float& mn, float& alpha, int mode, float cL, float cR, int dq, const float* tbl) {
  float cadd;
  if (mode == 0) {
#pragma unroll
    for (int r = 0; r < 16; ++r) { const int c0 = (r & 3) + 8 * (r >> 2);
      p0[r] += tbl[dq + c0]; p1[r] += tbl[dq + c0 + 32]; }
    cadd = 0.f;
  } else cadd = (mode < 0) ? cL : cR;
  float pmax = p0[0];
#pragma unroll
  for (int r = 1; r < 16; ++r) pmax = fmaxf(pmax, p0[r]);
#pragma unroll
  for (int r = 0; r < 16; ++r) pmax = fmaxf(pmax, p1[r]);
  { auto rr = __builtin_amdgcn_permlane32_swap(__float_as_uint(pmax), __float_as_uint(pmax), false, false);
    pmax = fmaxf(__uint_as_float(rr[0]), __uint_as_float(rr[1])); }
  pmax += cadd;
  if (__builtin_expect(__all(pmax - m_reg <= THR2), 1)) { mn = m_reg; alpha = 1.f; }
  else { mn = fmaxf(m_reg, pmax); alpha = __builtin_amdgcn_exp2f(m_reg - mn); m_reg = mn; }
  const float sh = cadd - mn;
#pragma unroll
  for (int r = 0; r < 16; ++r) p0[r] += sh;
#pragma unroll
  for (int r = 0; r < 16; ++r) p1[r] += sh;
#pragma unroll
  for (int r = 0; r < 16; ++r) p0[r] = __builtin_amdgcn_exp2f(p0[r]);
}
__device__ __forceinline__ void finishSM(f32x16& p0, f32x16& p1, bf16x8& pa0, bf16x8& pa1, bf16x8& pa2, bf16x8& pa3) {
#define PK8(P, BASE, OUT) do { v4u w = {cvt_pk_bf16(P[BASE + 0], P[BASE + 1]), cvt_pk_bf16(P[BASE + 2], P[BASE + 3]), cvt_pk_bf16(P[BASE + 4], P[BASE + 5]), cvt_pk_bf16(P[BASE + 6], P[BASE + 7])}; OUT = *reinterpret_cast<bf16x8*>(&w); } while (0)
  PK8(p0, 0, pa0); PK8(p0, 8, pa1); PK8(p1, 0, pa2); PK8(p1, 8, pa3);
#undef PK8
}
__device__ __forceinline__ int rel_bucket(int rel) {
  const int n = rel < 0 ? -rel : rel; int b;
  if (n < 8) b = n; else if (n < 12) b = 8; else if (n < 16) b = 9; else if (n < 23) b = 10; else if (n < 32) b = 11; else if (n < 46) b = 12; else if (n < 64) b = 13; else if (n < 91) b = 14; else b = 15;
  return (rel > 0 ? 16 : 0) + b;
}

__device__ __forceinline__ void attn_unit(int b, int h, int qb, const bf16_t* __restrict__ Q, const bf16_t* __restrict__ K, const bf16_t* __restrict__ V, bf16_t* __restrict__ O,
                                          float lam, float osc, const float* __restrict__ g, const float* __restrict__ rel_bias, char* lds, int tid_in, bool build_tbl, bool o8) {
  int tid_ = tid_in; asm volatile("" : "+v"(tid_));
  const int tid = tid_, wid = __builtin_amdgcn_readfirstlane(tid >> 6), lane = tid & 63, r32 = lane & 31, hi = lane >> 5;
  const int map = wid & 1, jq = wid >> 1;
  char* V_lds = lds + OFF_V; char* K_lds = lds + OFF_K;
  float* ws = (float*)(lds + OFF_WS) + wid * 64; float* li_l = ws; float* al_l = ws + 32;
  float* tbl = (float*)(lds + OFF_TBL);
  if (build_tbl) tbl[tid] = rel_bias[rel_bucket(tid - 256) * NH + h] * LOG2E;
  const float cL = rel_bias[15 * NH + h] * LOG2E, cR = rel_bias[31 * NH + h] * LOG2E;
  const long rowbase = (long)b * SEQ; const int qs = qb * 128 + jq * QBLK;
  float m_reg = -1e30f; f32x16 o[5] = {}; bf16x8 qr[4];
  const bf16_t* Qw = Q + (rowbase + qs + r32) * LDX + h * 128 + map * 64 + hi * 8;
#pragma unroll
  for (int d0 = 0; d0 < 4; ++d0) qr[d0] = *reinterpret_cast<const bf16x8*>(Qw + d0 * 16);
  const bf16_t* Kh = K + rowbase * LDX + h * 128; const bf16_t* Vh = V + rowbase * LDX + h * 128;
  const int vb0 = (int)(uintptr_t)V_lds + v_rd_base(lane);
  const int mapB = map * 128;
  int koff[4];
#pragma unroll
  for (int d0 = 0; d0 < 4; ++d0) koff[d0] = KSWZ(r32, mapB + (d0 * 16 + hi * 8) * 2);
  const int dq0 = 256 + 4 * hi - (qs + r32);
  unsigned ksrc[2], vsrc[2];
#pragma unroll
  for (int i = 0; i < 2; ++i) { const int pk = wid + 8 * i;
    const int krow = 4 * pk + (lane >> 4), kc = (lane & 15) ^ (krow & 7); ksrc[i] = (unsigned)(krow * (LDX * 2) + kc * 16);
    const int st = 2 * pk + (lane >> 5), kk = (st >> 2) * 8 + ((lane & 31) >> 2), vk = kk  , vc = (st & 3) * 32 + (lane & 3) * 8;
    vsrc[i] = (unsigned)(vk * (LDX * 2) + vc * 2); }
  typedef const __attribute__((address_space(1))) unsigned* gptr_t; typedef __attribute__((address_space(3))) unsigned* lptr_t;
  const char* const Kg = (const char*)Kh; const char* const Vg = (const char*)Vh;
  const lptr_t kdst = (lptr_t)(__attribute__((address_space(3))) char*)(K_lds) + 0; (void)kdst;
#define DMA_TILE(t, slot) do { const unsigned tb_ = (unsigned)(t) * (unsigned)(KVBLK * LDX * 2); \
    _Pragma("unroll") for (int i_ = 0; i_ < 2; ++i_) { \
      __builtin_amdgcn_global_load_lds((gptr_t)(Kg + (ksrc[i_] + tb_)), (lptr_t)((__attribute__((address_space(3))) char*)K_lds + (slot) + (wid + 8 * i_) * 1024), 16, 0, 0); \
      __builtin_amdgcn_global_load_lds((gptr_t)(Vg + (vsrc[i_] + tb_)), (lptr_t)((__attribute__((address_space(3))) char*)V_lds + (slot) + (wid + 8 * i_) * 1024), 16, 0, 0); } } while (0)
#define WAIT_BAR() do { asm volatile("s_waitcnt vmcnt(0) lgkmcnt(0)" ::: "memory"); __builtin_amdgcn_s_barrier(); asm volatile("" ::: "memory"); } while (0)
#define RESC(a, rs) do { if (rs) { if (hi == 0) al_l[r32] = (a); asm volatile("s_waitcnt lgkmcnt(0)" ::: "memory"); \
    _Pragma("unroll") for (int d = 0; d < 5; ++d) _Pragma("unroll") for (int r = 0; r < 16; ++r) o[d][r] *= al_l[crow(r, hi)]; } } while (0)
#define SEED(md) do { const int md_ = (md); const float sv_ = (md_ == 0 ? 0.f : (md_ < 0 ? cL : cR)) - m_reg; _Pragma("unroll") for (int r = 0; r < 16; ++r) seed[r] = sv_; } while (0)
#define TMODE(k0) (((k0) >= qs + 122) ? 1 : (((k0) <= qs - 154) ? -1 : 0))
#define ROT() do { const int t_ = sl_prev; sl_prev = sl_cur; sl_cur = sl_next; sl_next = t_; } while (0)
  f32x16 pA0, pA1, pB0, pB1, seed; float mnA, alA, alB; bool rsA = false, rsB = false; bf16x8 pa0, pa1, pa2, pa3;
  int sl_prev = 2 * SHM_V, sl_cur = 0, sl_next = SHM_V;
  if (wid >= 4) __builtin_amdgcn_s_setprio(1);
  DMA_TILE(0, 0); DMA_TILE(1, SHM_V);
  WAIT_BAR();
  DMA_TILE(2, 2 * SHM_V);
  qkt(pA0, pA1, K_lds, qr, r32, hi, mapB); partialSM(pA0, pA1, m_reg, mnA, alA, TMODE(0), cL, cR, dq0, tbl);
  _Pragma("unroll") for (int r = 0; r < 16; ++r) pA1[r] = __builtin_amdgcn_exp2f(pA1[r]);
  ROT();
#define QK_SEEDED(P0, P1, DMA_STMT, SEED_STMT) do { bf16x8 k0_[4], k1_[4]; const char* Ks_ = K_lds + sl_cur; \
    _Pragma("unroll") for (int d0 = 0; d0 < 4; ++d0) { k0_[d0] = *reinterpret_cast<const bf16x8*>(Ks_ + koff[d0]); k1_[d0] = *reinterpret_cast<const bf16x8*>(Ks_ + koff[d0] + 8192); } \
    DMA_STMT; SEED_STMT; \
    P0 = __builtin_amdgcn_mfma_f32_32x32x16_bf16(k0_[0], qr[0], seed, 0, 0, 0); P1 = __builtin_amdgcn_mfma_f32_32x32x16_bf16(k1_[0], qr[0], seed, 0, 0, 0); \
    _Pragma("unroll") for (int d0 = 1; d0 < 4; ++d0) { P0 = __builtin_amdgcn_mfma_f32_32x32x16_bf16(k0_[d0], qr[d0], P0, 0, 0, 0); P1 = __builtin_amdgcn_mfma_f32_32x32x16_bf16(k1_[d0], qr[d0], P1, 0, 0, 0); } } while (0)
  for (int j = 1; j + 1 < NT; j += 2) {
    SBAR(); QK_SEEDED(pB0, pB1, if (j > 1) DMA_TILE(j + 1, sl_next), SEED(TMODE(j * KVBLK)));
    finishSM(pA0, pA1, pa0, pa1, pa2, pa3); SBAR();
    if (TMODE(j * KVBLK) == 0) near_bias(pB0, pB1, dq0 + j * KVBLK, tbl);
    pv_softmax(o, vb0 + sl_prev, pa0, pa1, pa2, pa3, pB0, pB1, m_reg, alB, rsB);
    WAIT_BAR();
    RESC(alB, rsB); ROT();
    SBAR(); QK_SEEDED(pA0, pA1, DMA_TILE(j + 2, sl_next), SEED(TMODE((j + 1) * KVBLK)));
    finishSM(pB0, pB1, pa0, pa1, pa2, pa3); SBAR();
    if (TMODE((j + 1) * KVBLK) == 0) near_bias(pA0, pA1, dq0 + (j + 1) * KVBLK, tbl);
    pv_softmax(o, vb0 + sl_prev, pa0, pa1, pa2, pa3, pA0, pA1, m_reg, alA, rsA);
    WAIT_BAR();
    RESC(alA, rsA); ROT();
  }
  SBAR(); QK_SEEDED(pB0, pB1, (void)0, SEED(TMODE((NT - 1) * KVBLK)));
  finishSM(pA0, pA1, pa0, pa1, pa2, pa3); SBAR();
  if (TMODE((NT - 1) * KVBLK) == 0) near_bias(pB0, pB1, dq0 + (NT - 1) * KVBLK, tbl);
  pv_softmax(o, vb0 + sl_prev, pa0, pa1, pa2, pa3, pB0, pB1, m_reg, alB, rsB);
  RESC(alB, rsB);
  finishSM(pB0, pB1, pa0, pa1, pa2, pa3); SBAR();
  pv_d0(o, vb0 + sl_cur, pa0, pa1, pa2, pa3);
  __builtin_amdgcn_s_setprio(0);
  float rli[16];
#pragma unroll
  for (int r = 0; r < 16; ++r) rli[r] = __builtin_amdgcn_rcpf(o[4][r]);
  __syncthreads();
  float* X = (float*)(lds + jq * 16384);
  if (map == 1) {
#pragma unroll
    for (int r = 0; r < 16; ++r) { const int orow = crow(r, hi); const float s = rli[r] * lam;
#pragma unroll
      for (int d0 = 0; d0 < 4; ++d0) X[orow * 128 + d0 * 32 + r32] = o[d0][r] * s; }
  }
  __syncthreads();
  if (map == 0) {
    float ss[16];
#pragma unroll
    for (int r = 0; r < 16; ++r) { const int orow = crow(r, hi); float a = 0.f;
#pragma unroll
      for (int d0 = 0; d0 < 4; ++d0) { const float v = o[d0][r] * rli[r] - X[orow * 128 + d0 * 32 + r32]; o[d0][r] = v; a += v * v; }
      ss[r] = a; }
#pragma unroll
    for (int s = 1; s < 32; s <<= 1)
#pragma unroll
      for (int r = 0; r < 16; ++r) ss[r] += shx(ss[r], s);
    float gg[4];
#pragma unroll
    for (int d0 = 0; d0 < 4; ++d0) gg[d0] = g[d0 * 32 + r32] * osc;
    asm volatile("s_waitcnt lgkmcnt(0)" ::: "memory");
    bf16_t* stg = (bf16_t*)X;
#pragma unroll
    for (int r = 0; r < 16; ++r) { const int orow = crow(r, hi); const float rs = __builtin_amdgcn_rsqf(ss[r] * (1.0f / 128.0f) + LN_EPS);
#pragma unroll
      for (int d0 = 0; d0 < 4; ++d0) { const float v = o[d0][r] * rs * gg[d0]; stg[orow * 128 + d0 * 32 + r32] = (bf16_t)(cvt_pk_bf16(v, v) & 0xffffu); } }
    asm volatile("s_waitcnt lgkmcnt(0)" ::: "memory");
    bf16_t* Ow = O + (rowbase + qs) * LDX + h * 128;
#pragma unroll
    for (int i = 0; i < 8; ++i) { const int row = i * 4 + (lane >> 4), ch = lane & 15; const v4u v = *(const v4u*)(stg + row * 128 + ch * 8);
      if (!o8) *(v4u*)(Ow + (long)row * LDX + ch * 8) = v;
      else { typedef unsigned u32x2 __attribute__((ext_vector_type(2))); u32x2 q8; q8.x = pg8::pk4_fp8(bf_lo(v.x), bf_hi(v.x), bf_lo(v.y), bf_hi(v.y)); q8.y = pg8::pk4_fp8(bf_lo(v.z), bf_hi(v.z), bf_lo(v.w), bf_hi(v.w));
        *(u32x2*)((unsigned char*)O + (size_t)(rowbase + qs + row) * LDX + h * 128 + ch * 8) = q8; } }
    asm volatile("s_waitcnt lgkmcnt(0)" ::: "memory");
  }
  __syncthreads();
#undef DMA_TILE
#undef WAIT_BAR
#undef ROT
#undef RESC
#undef SEED
#undef QK_SEEDED
#undef TMODE
}
#undef KSWZ
#undef SBAR
}

#define XB_TMO      128
#define XB_XCNT(j)  (256  + 64 * (j))
#define XB_XSUB(j)  (1280 + 64 * (j))
#define XB_XGEN(j)  (2304 + 64 * (j))
#define XB_TOP      3328
#define XB_TOPGEN   3392
#define XCD_BAR_WORDS 3456
#define XB_SPIN_CAP (1u << 18)
__device__ __forceinline__ unsigned xb_ld(unsigned* p)              { return __hip_atomic_load(p, __ATOMIC_RELAXED, __HIP_MEMORY_SCOPE_AGENT); }
__device__ __forceinline__ unsigned xb_add(unsigned* p, unsigned v) { return __hip_atomic_fetch_add(p, v, __ATOMIC_RELAXED, __HIP_MEMORY_SCOPE_AGENT); }
__device__ __forceinline__ unsigned xb_xcc_id() { return (unsigned)__builtin_amdgcn_s_getreg((3 << 11) | 20) & 0xFu; }
#define XB_SPIN(cond, bar) do { unsigned _sp = 0; while (cond) { __builtin_amdgcn_s_sleep(1); \
    if ((++_sp & 255u) == 0u) { if (xb_ld(&(bar)[XB_TMO])) break; if (_sp > XB_SPIN_CAP) { atomicAdd(&(bar)[XB_TMO], 1u); break; } } } } while (0)
struct XcdBarrier { unsigned* bar; unsigned x; volatile LAS unsigned* st; };
__device__ __forceinline__ XcdBarrier xcd_barrier_post(unsigned* bar, volatile LAS unsigned* st) {
    XcdBarrier b; b.bar = bar; b.x = xb_xcc_id(); b.st = st;
    if (threadIdx.x == 0) (void)xb_add(&bar[XB_XCNT(b.x)], 1u);
    return b;
}
__device__ __forceinline__ void xcd_barrier_complete(unsigned* bar, unsigned x, unsigned& nloc, unsigned& nx) {
    const unsigned G = gridDim.x * gridDim.y * gridDim.z;
    unsigned sum, cnt, mine, sp = 0u;
    for (;;) {
        sum = 0u; cnt = 0u; mine = 0u;
#pragma unroll
        for (unsigned j = 0; j < 16; ++j) { const unsigned c = xb_ld(&bar[XB_XCNT(j)]); sum += c; cnt += (c > 0u) ? 1u : 0u; mine = (j == x) ? c : mine; }
        if (sum == G) break;
        __builtin_amdgcn_s_sleep(1);
        if ((++sp & 255u) == 0u) { if (xb_ld(&bar[XB_TMO])) break; if (sp > XB_SPIN_CAP) { atomicAdd(&bar[XB_TMO], 1u); break; } }
    }
    nloc = mine > 0u ? mine : 1u; nx = cnt > 0u ? cnt : 1u;
}
__device__ __forceinline__ void xcd_barrier(const XcdBarrier& b) {
    asm volatile("s_waitcnt vmcnt(0)" ::: "memory");
    __syncthreads();
    if (threadIdx.x == 0) {
        unsigned* bar = b.bar;
        __builtin_amdgcn_s_waitcnt(0);
        unsigned nloc = b.st[0], nx = b.st[1];
        if (nloc == 0u) { xcd_barrier_complete(bar, b.x, nloc, nx); b.st[0] = nloc; b.st[1] = nx; }
        const unsigned old = xb_add(&bar[XB_XSUB(b.x)], 1u);
        const unsigned gen = old / nloc;
        if (old + 1u == (gen + 1u) * nloc) {
            __builtin_amdgcn_fence(__ATOMIC_RELEASE, "agent");
            asm volatile("s_waitcnt vmcnt(0)" ::: "memory");
            const unsigned og = xb_add(&bar[XB_TOP], 1u);
            const unsigned tg = og / nx;
            if (og + 1u == (tg + 1u) * nx) xb_add(&bar[XB_TOPGEN], 1u);
            else XB_SPIN(xb_ld(&bar[XB_TOPGEN]) == tg, bar);
            __builtin_amdgcn_fence(__ATOMIC_ACQUIRE, "agent");
            xb_add(&bar[XB_XGEN(b.x)], 1u);
            asm volatile("s_waitcnt vmcnt(0)" ::: "memory");
        } else {
            XB_SPIN(xb_ld(&bar[XB_XGEN(b.x)]) == gen, bar);
            __builtin_amdgcn_fence(__ATOMIC_ACQUIRE, "agent");
            asm volatile("s_waitcnt vmcnt(0)" ::: "memory");
        }
    }
    __syncthreads();
}

template <int MODE> __device__ __forceinline__ int dst_row(int n) {
    if (MODE == 1) { if (n < 1024) return n; const int b = (n - 1024) >> 10, f = (n - 1024) & 1023; return 1024 + (f >> 7) * 256 + b * 128 + (f & 127); }
    if (MODE == 2) { const int b = n & 1, j = n >> 1; return (j >> 7) * 256 + b * 128 + (j & 127); }
    return n;
}
template <int MODE> __device__ __forceinline__ void p0_transpose_item(const float* W, int K, int N, bf16_t* WT, LAS float* scr, int item, int lane, const float* kscale = nullptr) {
    const int nblk = N / 32, kb = item / nblk, nb = item % nblk, k0 = 64 * kb, n0 = 32 * nb;
#pragma unroll 8
    for (int i = 0; i < 32; ++i) { const int kk = 2 * i + (lane >> 5); float w = W[(size_t)(k0 + kk) * N + n0 + (lane & 31)]; if (kscale) w *= kscale[k0 + kk]; scr[kk * 33 + (lane & 31)] = w; }
    LDS_WAIT(); asm volatile("" ::: "memory");
    const int c = lane & 7;
#pragma unroll
    for (int j = 0; j < 4; ++j) { const int n = (lane >> 3) + 8 * j; const LAS float* s = scr + (8 * c) * 33 + n;
        v4u o; o.x = cvt_pk_bf16(s[0 * 33], s[1 * 33]); o.y = cvt_pk_bf16(s[2 * 33], s[3 * 33]); o.z = cvt_pk_bf16(s[4 * 33], s[5 * 33]); o.w = cvt_pk_bf16(s[6 * 33], s[7 * 33]);
        *(GAS v4u*)(WT + (size_t)dst_row<MODE>(n0 + n) * K + k0 + 8 * c) = o; }
    LDS_WAIT(); asm volatile("" ::: "memory");
}

template <int MODE, bool I8 = false> __device__ __forceinline__ void p0_quant_strip(const float* W, int N, unsigned char* W8, float* SC, int strip, LAS unsigned char* lds, int wave, int lane) {
    constexpr float QM_ = I8 ? 127.0f : F8MAX;
    LAS float* scr = (LAS float*)(lds + wave * 16384); LAS float* red = (LAS float*)(lds + LDSCTL_OFF + 2048);
    const int n0 = strip * 32, k0 = wave * 128, kk = lane >> 5, n = lane & 31;
    float am = 0.f;
    { const char* Wb = (const char*)W + (size_t)k0 * N * 4; const unsigned loff = (unsigned)((kk * N + n0 + n) * 4);
      float vv[64];
#pragma unroll
      for (int i = 0; i < 64; ++i) vv[i] = *(const float*)(Wb + (size_t)i * (size_t)(2 * N * 4) + loff);
#pragma unroll
      for (int i = 0; i < 64; ++i) { scr[(2 * i + kk) * 32 + n] = vv[i]; am = fmaxf(am, fabsf(vv[i])); } }
    am = fmaxf(am, shx(am, 32));
    if (lane < 32) red[wave * 32 + n] = am;
    __syncthreads();
    float amax = red[n];
#pragma unroll
    for (int w = 1; w < 8; ++w) amax = fmaxf(amax, red[w * 32 + n]);
    const float q = amax > 0.f ? QM_ / amax : 0.f;
    const int dr = dst_row<MODE>(n0 + n);
    if (wave == 0 && lane < 32) SC[dr] = amax * (1.0f / QM_);
#pragma unroll
    for (int c = 0; c < 4; ++c) { float v[16];
#pragma unroll
        for (int j = 0; j < 16; ++j) v[j] = scr[(kk * 64 + c * 16 + j) * 32 + n] * q;
        v4u o; o.x = pg8::pkq4<I8>(v[0], v[1], v[2], v[3]); o.y = pg8::pkq4<I8>(v[4], v[5], v[6], v[7]); o.z = pg8::pkq4<I8>(v[8], v[9], v[10], v[11]); o.w = pg8::pkq4<I8>(v[12], v[13], v[14], v[15]);
        *(GAS v4u*)(W8 + (size_t)dr * 1024 + k0 + kk * 64 + c * 16) = o; }
    __syncthreads();
}
struct StripSrc { const float* W; int N; unsigned char* W8; float* SC; int strip; bool glu; };
__device__ __forceinline__ void dstrip_desc(const float* w1, const float* w2, unsigned char* ws, int st, StripSrc& d) {
    if (st < 128 * 64) { const int j = st >> 6; d.W = w1 + (size_t)j * 1024 * 2048; d.N = 2048; d.W8 = ws + WS_W1 + (size_t)j * 2048 * 1024; d.SC = (float*)(ws + WS_S1) + (size_t)j * 2048; d.strip = st & 63; d.glu = true; }
    else { const int q = st - 128 * 64, j = q >> 5; d.W = w2 + (size_t)j * 1024 * 1024; d.N = 1024; d.W8 = ws + WS_W2 + (size_t)j * 1024 * 1024; d.SC = (float*)(ws + WS_S2) + (size_t)j * 1024; d.strip = q & 31; d.glu = false; }
}
__device__ __forceinline__ void dstrip_issue(const StripSrc& d, int wave, int lane, f32x4 (&vv)[16]) {
    const int n0 = d.strip * 32, k0 = wave * 128, r8 = lane >> 3, cg = lane & 7;
    const char* Wb = (const char*)d.W + (size_t)k0 * d.N * 4; const unsigned loff = (unsigned)((r8 * d.N + n0 + 4 * cg) * 4); const size_t rs8 = (size_t)d.N * 32;
#pragma unroll
    for (int i = 0; i < 16; ++i) vv[i] = *(const f32x4*)(Wb + (size_t)i * rs8 + loff);
}
__device__ __forceinline__ void dstrip_finish(const StripSrc& d, LAS unsigned char* lds, int wave, int lane, int par, f32x4 (&vv)[16]) {
    LAS float* scr = (LAS float*)(lds + wave * 16384); LAS float* red = (LAS float*)(lds + LDSCTL_OFF + 2048 + par * 1024);
    const int n0 = d.strip * 32, k0 = wave * 128, kk = lane >> 5, n = lane & 31, r8 = lane >> 3, cg = lane & 7;
    f32x4 am = {0.f, 0.f, 0.f, 0.f};
#pragma unroll
    for (int i = 0; i < 16; ++i) { *(LAS f32x4*)(scr + (8 * i + r8) * 32 + 4 * cg) = vv[i];
#pragma unroll
        for (int j = 0; j < 4; ++j) am[j] = fmaxf(am[j], fabsf(vv[i][j])); }
    { const int l_ = lane_local();
#pragma unroll
      for (int o = 8; o < 64; o <<= 1)
#pragma unroll
        for (int j = 0; j < 4; ++j) am[j] = fmaxf(am[j], shx(am[j], o, l_)); }
    if (lane < 8) *(LAS f32x4*)(red + wave * 32 + 4 * cg) = am;
    asm volatile("s_waitcnt lgkmcnt(0)" ::: "memory"); __builtin_amdgcn_s_barrier(); asm volatile("" ::: "memory");
    float amax = red[n];
#pragma unroll
    for (int w = 1; w < 8; ++w) amax = fmaxf(amax, red[w * 32 + n]);
    const float q = amax > 0.f ? F8MAX / amax : 0.f;
    const int dr = d.glu ? dst_row<2>(n0 + n) : (n0 + n);
    if (wave == 0 && lane < 32) d.SC[dr] = amax * (1.0f / F8MAX);
#pragma unroll
    for (int c = 0; c < 4; ++c) { float v[16];
#pragma unroll
        for (int j = 0; j < 16; ++j) v[j] = scr[(kk * 64 + c * 16 + j) * 32 + n] * q;
        v4u o; o.x = pg8::pk4_fp8(v[0], v[1], v[2], v[3]); o.y = pg8::pk4_fp8(v[4], v[5], v[6], v[7]); o.z = pg8::pk4_fp8(v[8], v[9], v[10], v[11]); o.w = pg8::pk4_fp8(v[12], v[13], v[14], v[15]);
        *(GAS v4u*)(d.W8 + (size_t)dr * 1024 + k0 + kk * 64 + c * 16) = o; }
    asm volatile("s_waitcnt lgkmcnt(0)" ::: "memory");
}
__device__ __forceinline__ void deferred_strips(const float* w1, const float* w2, unsigned char* ws, LAS unsigned char* lds, int first, int NT, int wave, int lane) {
    constexpr int stride = 1;
    auto stq = [](int idx) { return idx; };
    f32x4 va[16], vb[16]; StripSrc da, db; int idx = first, par = 0;
    if (idx < NT) { dstrip_desc(w1, w2, ws, stq(idx), da); dstrip_issue(da, wave, lane, va); }
#pragma unroll 1
    while (idx < NT) {
        const int i1 = idx + stride; if (i1 < NT) { dstrip_desc(w1, w2, ws, stq(i1), db); dstrip_issue(db, wave, lane, vb); }
        dstrip_finish(da, lds, wave, lane, par, va); par ^= 1;
        if (i1 >= NT) break;
        const int i2 = i1 + stride; if (i2 < NT) { dstrip_desc(w1, w2, ws, stq(i2), da); dstrip_issue(da, wave, lane, va); }
        dstrip_finish(db, lds, wave, lane, par, vb); par ^= 1;
        idx = i2;
    }
    __syncthreads();
}
__device__ __forceinline__ float ln_bound(const float* g, const float* b, int lane) {
    float mg = 0.f, mb = 0.f;
#pragma unroll
    for (int j = 0; j < 4; ++j) { const f32x4 a = *(const f32x4*)(g + j * 256 + lane * 4), c = *(const f32x4*)(b + j * 256 + lane * 4);
        mg = fmaxf(mg, fmaxf(fmaxf(fabsf(a[0]), fabsf(a[1])), fmaxf(fabsf(a[2]), fabsf(a[3])))); mb = fmaxf(mb, fmaxf(fmaxf(fabsf(c[0]), fabsf(c[1])), fmaxf(fabsf(c[2]), fabsf(c[3])))); }
#pragma unroll
    for (int o = 1; o < 64; o <<= 1) { mg = fmaxf(mg, shx(mg, o)); mb = fmaxf(mb, shx(mb, o)); }
    return 31.984371f * mg + mb;
}

struct Ptrs {
    const float *x, *rel_bias, *attn_w_in, *attn_lambda, *attn_subln, *attn_w_out, *conv_w_in, *conv_w, *conv_w_out, *router_w, *router_b, *w1, *b1, *w2, *b2, *ln_g, *ln_b;
    float* out; unsigned char* ws;
};

#ifndef DEFER_W
#define DEFER_W 1
#endif
__device__ __forceinline__ void expert_strip(const Ptrs& P, int st, LAS unsigned char* lds, int wave, int lane) {
    unsigned char* ws = P.ws;
    if (st < 128 * 64) { const int j = st >> 6, r = st & 63; p0_quant_strip<2>(P.w1 + (size_t)j * 1024 * 2048, 2048, ws + WS_W1 + (size_t)j * 2048 * 1024, (float*)(ws + WS_S1) + (size_t)j * 2048, r, lds, wave, lane); }
    else { const int q = st - 128 * 64, j = q >> 5, r = q & 31; p0_quant_strip<0>(P.w2 + (size_t)j * 1024 * 1024, 1024, ws + WS_W2 + (size_t)j * 1024 * 1024, (float*)(ws + WS_S2) + (size_t)j * 1024, r, lds, wave, lane); }
}
constexpr int NWAVES_ = 8;
__device__ __forceinline__ void p0_prologue(const Ptrs& P, LAS unsigned char* lds, int gw, int NGW, int wave, int lane) {
    LAS float* scr = (LAS float*)(lds + RING_OFF + wave * 16384);
    unsigned char* ws = P.ws;
    constexpr int I_OUT = 16 * 32, I_R = 16;
    constexpr int I_IN = 16 * 96;
    constexpr int S1 = NA16 * I_OUT, S3 = S1 + NO16 * I_OUT, S4 = S3 + 4 * I_R, S5 = S4 + NQ16 * I_IN, S6 = S5 + NC16 * I_IN;
    { const int wg = gw / NWAVES_, NWG = NGW / NWAVES_;
      constexpr int T1 = 128 * 64, T2 = T1 + 128 * 32, T3 = T2 + NQ8 * 96, T4 = T3 + NC8 * 96, T5 = T4 + NA8 * 32, T6 = T5 + NO8 * 32;
      constexpr int NE0 = DEFER_W ? 0 : T2;
#pragma unroll 1
      for (int s0 = wg; s0 < NE0 + (T6 - T2); s0 += NWG) {
        const int st = (s0 >= NE0) ? T2 + (s0 - NE0) : s0;
        if (st < T2) expert_strip(P, st, lds, wave, lane);
        else if (st < T3) { const int q = st - T2, j = QJ0 + q / 96, r = q % 96; p0_quant_strip<0, I8P>(P.attn_w_in + (size_t)j * 1024 * 3072, 3072, ws + WS_WAI + (size_t)j * 3072 * 1024, (float*)(ws + WS_SD) + (size_t)j * 3072, r, lds, wave, lane); }
        else if (st < T4) { const int q = st - T3, j = CJ0 + q / 96, r = q % 96; p0_quant_strip<1, I8P>(P.conv_w_in + (size_t)j * 1024 * 3072, 3072, ws + WS_WCI + (size_t)j * 3072 * 1024, (float*)(ws + WS_SD + 32 * 1024) + (size_t)j * 3072, r, lds, wave, lane); }
        else if (st < T5) { const int q = st - T4, j = AJ0 + q / 32, r = q % 32; p0_quant_strip<0>(P.attn_w_out + (size_t)j * 1024 * 1024, 1024, ws + WS_WAO8 + (size_t)j * 1024 * 1024, (float*)(ws + WS_SD + 24 * 1024) + (size_t)j * 1024, r, lds, wave, lane); }
        else { const int q = st - T5, j = OJ0 + q / 32, r = q % 32; p0_quant_strip<0, I8P>(P.conv_w_out + (size_t)j * 1024 * 1024, 1024, ws + WS_WCO8 + (size_t)j * 1024 * 1024, (float*)(ws + WS_SD + 56 * 1024) + (size_t)j * 1024, r, lds, wave, lane); }
      } }
    for (int it = gw; it < S6; it += NGW) {
        if (it >= S5) { const int q = it - S5, j = CK0 + q / I_IN, r = q % I_IN; p0_transpose_item<1>(P.conv_w_in + (size_t)j * 1024 * 3072, 1024, 3072, (bf16_t*)(ws + WS_WC16) + (size_t)j * 3072 * 1024, scr, r, lane); }
        else if (it >= S4) { const int q = it - S4, j = QK0 + q / I_IN, r = q % I_IN; p0_transpose_item<0>(P.attn_w_in + (size_t)j * 1024 * 3072, 1024, 3072, (bf16_t*)(ws + WS_WA16) + (size_t)j * 3072 * 1024, scr, r, lane); }
        else if (it < S1) { const int q = it, j = AK0 + q / I_OUT, r = q % I_OUT; p0_transpose_item<0>(P.attn_w_out + (size_t)j * 1024 * 1024, 1024, 1024, (bf16_t*)(ws + WS_WAO) + (size_t)j * 1024 * 1024, scr, r, lane); }
        else if (it < S3) { const int q = it - S1, j = OK0 + q / I_OUT, r = q % I_OUT; p0_transpose_item<0>(P.conv_w_out + (size_t)j * 1024 * 1024, 1024, 1024, (bf16_t*)(ws + WS_WCO) + (size_t)j * 1024 * 1024, scr, r, lane); }
        else { const int q = it - S3, j = q / I_R, r = q % I_R; p0_transpose_item<0>(P.router_w + (size_t)j * 1024 * 32, 1024, 32, (bf16_t*)(ws + WS_WR) + (size_t)j * 32 * 1024, scr, r, lane, P.ln_g + (size_t)(j * 2 + 0) * D); }
    }
    for (int it = gw; it < DEPTH * 32; it += NGW) { const int L = it >> 5, e = it & 31; const float* g_ = P.ln_g + (size_t)(L * 2) * D; const float* b_ = P.ln_b + (size_t)(L * 2) * D; const float* Wr = P.router_w + (size_t)L * 1024 * 32;
        float a = 0.f, c = 0.f;
#pragma unroll 4
        for (int i = 0; i < 16; ++i) { const int k = lane + 64 * i; const float w = Wr[(size_t)k * 32 + e]; a += bf_lo(cvt_pk_bf16(w * g_[k], 0.f)); c += b_[k] * w; }
        a = wave_sum(a); c = wave_sum(c);
        if (lane == 0) { float* RC = (float*)(ws + WS_RC) + L * 64; RC[e] = a; RC[32 + e] = c + P.router_b[L * 32 + e]; } }
    for (int row = gw; row < M; row += NGW) {
        f32x4 a[2][2]; float am = 0.f;
#pragma unroll
        for (int h = 0; h < 2; ++h)
#pragma unroll
            for (int q = 0; q < 2; ++q) { a[h][q] = *(const GAS f32x4*)(P.x + (size_t)row * D + h * 512 + lane * 8 + q * 4);
                am = fmaxf(am, fmaxf(fmaxf(fabsf(a[h][q][0]), fabsf(a[h][q][1])), fmaxf(fabsf(a[h][q][2]), fabsf(a[h][q][3])))); }
#pragma unroll
        for (int o = 1; o < 64; o <<= 1) am = fmaxf(am, shx(am, o));
        const float qs = QMAXP / fmaxf(am, 1e-30f);
        if ((QM & 1) && lane == 0) ((float*)(ws + WS_RS))[row] = am * (1.0f / QMAXP);
#pragma unroll
        for (int h = 0; h < 2; ++h) { v4u o; o.x = cvt_pk_bf16(a[h][0][0], a[h][0][1]); o.y = cvt_pk_bf16(a[h][0][2], a[h][0][3]); o.z = cvt_pk_bf16(a[h][1][0], a[h][1][1]); o.w = cvt_pk_bf16(a[h][1][2], a[h][1][3]);
            *(GAS v4u*)((bf16_t*)(ws + WS_XB) + (size_t)row * D + h * 512 + lane * 8) = o;
            if (QM & 1) { typedef unsigned u32x2 __attribute__((ext_vector_type(2))); u32x2 q8;
            q8.x = pg8::pkq4<I8P>(a[h][0][0] * qs, a[h][0][1] * qs, a[h][0][2] * qs, a[h][0][3] * qs); q8.y = pg8::pkq4<I8P>(a[h][1][0] * qs, a[h][1][1] * qs, a[h][1][2] * qs, a[h][1][3] * qs);
            *(GAS u32x2*)(ws + WS_XI + (size_t)row * D + h * 512 + lane * 8) = q8; } }
    }
}

__device__ __forceinline__ void conv_phase(const bf16_t* GB, const bf16_t* Z, const float* cw, bf16_t* Gout, float* RS, bool o8, int gw, int NGW, int lane) {
    float w[3][16];
#pragma unroll
    for (int j = 0; j < 3; ++j)
#pragma unroll
        for (int h = 0; h < 2; ++h)
#pragma unroll
            for (int q = 0; q < 2; ++q) { const f32x4 t = *(const f32x4*)(cw + j * D + h * 512 + lane * 8 + q * 4); w[j][h * 8 + q * 4 + 0] = t[0]; w[j][h * 8 + q * 4 + 1] = t[1]; w[j][h * 8 + q * 4 + 2] = t[2]; w[j][h * 8 + q * 4 + 3] = t[3]; }
    for (int run = gw; run < M / 32; run += NGW) {
        const int t0 = run * 32; const bool first = (t0 % SEQ) == 0, lastr = ((t0 + 32) % SEQ) == 0;
        v4u zp[2], zc[2], zn[2];
#pragma unroll
        for (int h = 0; h < 2; ++h) { zp[h] = first ? (v4u){0u, 0u, 0u, 0u} : *(const v4u*)(Z + (size_t)(t0 - 1) * D + h * 512 + lane * 8); zc[h] = *(const v4u*)(Z + (size_t)t0 * D + h * 512 + lane * 8); }
        for (int r = 0; r < 32; ++r) { const int t = t0 + r; const bool pad = lastr && (r == 31);
            float o[2][8];
#pragma unroll
            for (int h = 0; h < 2; ++h) {
                zn[h] = pad ? (v4u){0u, 0u, 0u, 0u} : *(const v4u*)(Z + (size_t)(t + 1) * D + h * 512 + lane * 8);
                const v4u gb = *(const v4u*)(GB + (size_t)t * D + h * 512 + lane * 8);
#pragma unroll
                for (int q = 0; q < 4; ++q) { const unsigned up = zp[h][q], uc = zc[h][q], un = zn[h][q], ug = gb[q]; const int c = h * 8 + q * 2;
                    o[h][q * 2 + 0] = bf_lo(ug) * (w[0][c] * bf_lo(up) + w[1][c] * bf_lo(uc) + w[2][c] * bf_lo(un));
                    o[h][q * 2 + 1] = bf_hi(ug) * (w[0][c + 1] * bf_hi(up) + w[1][c + 1] * bf_hi(uc) + w[2][c + 1] * bf_hi(un)); }
                if (!o8) { v4u ov; ov.x = cvt_pk_bf16(o[h][0], o[h][1]); ov.y = cvt_pk_bf16(o[h][2], o[h][3]); ov.z = cvt_pk_bf16(o[h][4], o[h][5]); ov.w = cvt_pk_bf16(o[h][6], o[h][7]);
                    *(v4u*)(Gout + (size_t)t * D + h * 512 + lane * 8) = ov; }
                zp[h] = zc[h]; zc[h] = zn[h];
            }
            if (o8) { float am = 0.f;
#pragma unroll
                for (int h = 0; h < 2; ++h)
#pragma unroll
                    for (int i = 0; i < 8; ++i) am = fmaxf(am, fabsf(o[h][i]));
#pragma unroll
                for (int s_ = 1; s_ < 64; s_ <<= 1) am = fmaxf(am, shx(am, s_));
                const float qs = QMAXP / fmaxf(am, 1e-30f);
                if (lane == 0) RS[t] = am * (1.0f / QMAXP);
#pragma unroll
                for (int h = 0; h < 2; ++h) { typedef unsigned u32x2 __attribute__((ext_vector_type(2))); u32x2 q8;
                    q8.x = pg8::pkq4<I8P>(o[h][0] * qs, o[h][1] * qs, o[h][2] * qs, o[h][3] * qs); q8.y = pg8::pkq4<I8P>(o[h][4] * qs, o[h][5] * qs, o[h][6] * qs, o[h][7] * qs);
                    *(u32x2*)((unsigned char*)Gout + (size_t)t * D + h * 512 + lane * 8) = q8; } }
        }
    }
}

__device__ __forceinline__ void ln2_phase(const bf16_t* Yp, const float* g1, const float* b1, const unsigned char* Y, const float* g, const float* bta, bf16_t* XB, float* out, unsigned char* XI, float* RS, int gw, int NGW, int lane) {
    float gg[16], bb[16];
#pragma unroll
    for (int h = 0; h < 2; ++h)
#pragma unroll
        for (int q = 0; q < 2; ++q) { const f32x4 t = *(const f32x4*)(g + h * 512 + lane * 8 + q * 4), s = *(const f32x4*)(bta + h * 512 + lane * 8 + q * 4);
#pragma unroll
            for (int i = 0; i < 4; ++i) { gg[h * 8 + q * 4 + i] = t[i]; bb[h * 8 + q * 4 + i] = s[i]; } }
    float sXb = 0.f, rsXb = 0.f; if constexpr (!I8P) { const float lb = ln_bound(g, bta, lane); sXb = F8MAX / lb; rsXb = lb * (1.0f / F8MAX); }
    for (int row = gw; row < M; row += NGW) {
        float v[16];
#pragma unroll
        for (int h = 0; h < 2; ++h) { const v4u xr = *(const v4u*)(Yp + (size_t)row * D + h * 512 + lane * 8);
#pragma unroll
            for (int q = 0; q < 4; ++q) { v[h * 8 + q * 2] = bf_lo(xr[q]); v[h * 8 + q * 2 + 1] = bf_hi(xr[q]); } }
        { float s1 = 0.f;
#pragma unroll
          for (int i = 0; i < 16; ++i) s1 += v[i];
          const float m1 = wave_sum(s1) * (1.f / D); float q1 = 0.f;
#pragma unroll
          for (int i = 0; i < 16; ++i) { v[i] -= m1; q1 += v[i] * v[i]; }
          const float r1 = ALPHA / sqrtf(wave_sum(q1) * (1.f / D) + LN_EPS);
#pragma unroll
          for (int h = 0; h < 2; ++h)
#pragma unroll
            for (int q = 0; q < 2; ++q) { const f32x4 t = *(const f32x4*)(g1 + h * 512 + lane * 8 + q * 4), u = *(const f32x4*)(b1 + h * 512 + lane * 8 + q * 4);
#pragma unroll
              for (int i = 0; i < 4; ++i) v[h * 8 + q * 4 + i] = v[h * 8 + q * 4 + i] * r1 * t[i] + ALPHA * u[i]; } }
#pragma unroll
        for (int k = 0; k < 4; ++k)
#pragma unroll
            for (int h = 0; h < 2; ++h) { typedef unsigned u32x2 __attribute__((ext_vector_type(2))); const u32x2 yr = *(const u32x2*)(Y + ((size_t)row * 4 + k) * D + h * 512 + lane * 8);
#pragma unroll
                for (int q = 0; q < 2; ++q) { const f32x2 lo = __builtin_amdgcn_cvt_pk_f32_fp8((int)yr[q], false), hi2 = __builtin_amdgcn_cvt_pk_f32_fp8((int)yr[q], true);
                    v[h * 8 + q * 4 + 0] += lo[0] * (1.0f / YSCALE); v[h * 8 + q * 4 + 1] += lo[1] * (1.0f / YSCALE); v[h * 8 + q * 4 + 2] += hi2[0] * (1.0f / YSCALE); v[h * 8 + q * 4 + 3] += hi2[1] * (1.0f / YSCALE); } }
        float s = 0.f;
#pragma unroll
        for (int i = 0; i < 16; ++i) s += v[i];
        const float mean = wave_sum(s) * (1.f / D); float s2 = 0.f;
#pragma unroll
        for (int i = 0; i < 16; ++i) { v[i] -= mean; s2 += v[i] * v[i]; }
        const float rstd = 1.f / sqrtf(wave_sum(s2) * (1.f / D) + LN_EPS);
#pragma unroll
        for (int i = 0; i < 16; ++i) v[i] = v[i] * rstd * gg[i] + bb[i];
        float sX = sXb, rsX = rsXb;
        if (I8P && XI) { float am = 0.f;
#pragma unroll
            for (int i = 0; i < 16; ++i) am = fmaxf(am, fabsf(v[i]));
#pragma unroll
            for (int o = 1; o < 64; o <<= 1) am = fmaxf(am, shx(am, o));
            sX = QMAXP / fmaxf(am, 1e-30f); rsX = am * (1.0f / QMAXP); }
#pragma unroll
        for (int h = 0; h < 2; ++h) { v4u ov; ov.x = cvt_pk_bf16(v[h * 8 + 0], v[h * 8 + 1]); ov.y = cvt_pk_bf16(v[h * 8 + 2], v[h * 8 + 3]); ov.z = cvt_pk_bf16(v[h * 8 + 4], v[h * 8 + 5]); ov.w = cvt_pk_bf16(v[h * 8 + 6], v[h * 8 + 7]);
            if (!out) *(v4u*)(XB + (size_t)row * D + h * 512 + lane * 8) = ov;
            if (XI) { typedef unsigned u32x2 __attribute__((ext_vector_type(2))); u32x2 q8; q8.x = pg8::pkq4<I8P>(v[h * 8 + 0] * sX, v[h * 8 + 1] * sX, v[h * 8 + 2] * sX, v[h * 8 + 3] * sX); q8.y = pg8::pkq4<I8P>(v[h * 8 + 4] * sX, v[h * 8 + 5] * sX, v[h * 8 + 6] * sX, v[h * 8 + 7] * sX);
                *(u32x2*)(XI + (size_t)row * D + h * 512 + lane * 8) = q8; if (h == 0 && lane == 0) RS[row] = rsX; }
            if (out) { *(f32x4*)(out + (size_t)row * D + h * 512 + lane * 8) = (f32x4){v[h * 8 + 0], v[h * 8 + 1], v[h * 8 + 2], v[h * 8 + 3]};
                       *(f32x4*)(out + (size_t)row * D + h * 512 + lane * 8 + 4) = (f32x4){v[h * 8 + 4], v[h * 8 + 5], v[h * 8 + 6], v[h * 8 + 7]}; } }
    }
}

constexpr int RT_PITCH = 2064, R_OFF_G = 32 * RT_PITCH, R_OFF_LG = R_OFF_G + 8192, R_OFF_CNT = R_OFF_LG + 8 * 16 * 33 * 4, R_OFF_SW = R_OFF_CNT + 256, R_LDS = R_OFF_SW + 256;
typedef __bf16 bf16x2_t __attribute__((ext_vector_type(2)));
__device__ __forceinline__ void router_phase(const bf16_t* Yp, const float* g, const float* bta, const bf16_t* RTg, const float* Wr, const float* rb, unsigned char* X8, int* lslot, float* lgate, unsigned* cnt,
                                             char* lds, int blk0, int G, int tid, int wave, int lane, const float* rc) {
    for (int i = tid; i < 32 * 128; i += 512) { const int e = i >> 7, c = i & 127; *(v4u*)(lds + e * RT_PITCH + c * 16) = *(const v4u*)(RTg + (size_t)e * 1024 + c * 8); }
    float* gl = (float*)(lds + R_OFF_G); float* bl = gl + 1024;
    for (int i = tid; i < 1024; i += 512) { gl[i] = g[i]; bl[i] = bta[i]; }
    float* LG = (float*)(lds + R_OFF_LG) + wave * (16 * 33);
    int* lcnt = (int*)(lds + R_OFF_CNT); int* lbase = lcnt + 32;
    float* sWl = (float*)(lds + R_OFF_SW); float* cBl = sWl + 32;
    __syncthreads();
    if (tid < 64) sWl[tid] = rc[tid];
    const int t16 = lane & 15, kq = lane >> 4;
    const float sA = F8MAX / ln_bound(g, bta, lane);
#pragma unroll 1
    for (int blk = blk0; blk < M / 128; blk += G) {
        if (tid < 32) lcnt[tid] = 0;
        __syncthreads();
        int my_e, my_rank, my_slot; float my_gate;
        const int r0 = blk * 128 + wave * 16; const size_t rowoff = (size_t)(r0 + t16) * D + kq * 8;
        v4u yv[32];
#pragma unroll
        for (int kb = 0; kb < 32; ++kb) yv[kb] = *(const v4u*)(Yp + rowoff + kb * 32);
        f32x4 acc0 = {0.f, 0.f, 0.f, 0.f}, acc1 = {0.f, 0.f, 0.f, 0.f}, accs = {0.f, 0.f, 0.f, 0.f}, accq = {0.f, 0.f, 0.f, 0.f};
        const bf16x8 ones8 = {(short)0x3F80, (short)0x3F80, (short)0x3F80, (short)0x3F80, (short)0x3F80, (short)0x3F80, (short)0x3F80, (short)0x3F80};
#pragma unroll
        for (int kb = 0; kb < 32; ++kb) { const int c0 = kb * 32 + kq * 8;
            const bf16x8 w0 = *(const bf16x8*)(lds + t16 * RT_PITCH + c0 * 2), w1 = *(const bf16x8*)(lds + (16 + t16) * RT_PITCH + c0 * 2);
            const bf16x8 xb = __builtin_bit_cast(bf16x8, yv[kb]);
            acc0 = __builtin_amdgcn_mfma_f32_16x16x32_bf16(w0, xb, acc0, 0, 0, 0);
            acc1 = __builtin_amdgcn_mfma_f32_16x16x32_bf16(w1, xb, acc1, 0, 0, 0);
            accs = __builtin_amdgcn_mfma_f32_16x16x32_bf16(ones8, xb, accs, 0, 0, 0);
            accq = __builtin_amdgcn_mfma_f32_16x16x32_bf16(xb, xb, accq, 0, 0, 0); }
        const float s = accs[0];
        const int dsel = t16 & 3; float dq_ = dsel == 0 ? accq[0] : (dsel == 1 ? accq[1] : (dsel == 2 ? accq[2] : accq[3]));
        const float s2 = __int_as_float(__builtin_amdgcn_ds_bpermute(((t16 >> 2) * 16 + t16) << 2, __float_as_int(dq_)));
        const float mean = s * (1.f / D); const float var = fmaxf(s2 * (1.f / D) - mean * mean, 0.f);
        const float rstd = 1.f / sqrtf(var + LN_EPS);
        {
            float* lgr = LG + t16 * 33;
#pragma unroll
            for (int i = 0; i < 4; ++i) { const int e0 = kq * 4 + i, e1 = 16 + kq * 4 + i;
                lgr[e0] = rstd * (acc0[i] - mean * sWl[e0]) + cBl[e0]; lgr[e1] = rstd * (acc1[i] - mean * sWl[e1]) + cBl[e1]; }
            LDS_WAIT(); asm volatile("" ::: "memory");
            float t0 = -INFINITY, t1 = -INFINITY, t2 = -INFINITY, t3 = -INFINITY; int i0 = 0, i1 = 0, i2 = 0, i3 = 0;
#pragma unroll
            for (int e = 0; e < 32; ++e) { const float v = lgr[e];
                const bool c0 = v > t0, c1 = v > t1, c2 = v > t2, c3 = v > t3;
                t3 = c2 ? t2 : (c3 ? v : t3); i3 = c2 ? i2 : (c3 ? e : i3);
                t2 = c1 ? t1 : (c2 ? v : t2); i2 = c1 ? i1 : (c2 ? e : i2);
                t1 = c0 ? t0 : (c1 ? v : t1); i1 = c0 ? i0 : (c1 ? e : i1);
                t0 = c0 ? v : t0; i0 = c0 ? e : i0; }
            const float e1 = __expf(t1 - t0), e2 = __expf(t2 - t0), e3 = __expf(t3 - t0); const float inv = 1.f / (1.f + e1 + e2 + e3);
            const int ek = kq == 0 ? i0 : (kq == 1 ? i1 : (kq == 2 ? i2 : i3)); const float gk = (kq == 0 ? 1.f : (kq == 1 ? e1 : (kq == 2 ? e2 : e3))) * inv;
            my_e = ek; my_gate = gk; my_slot = (r0 + t16) * 4 + kq; my_rank = atomicAdd(&lcnt[ek], 1);
            LDS_WAIT(); asm volatile("" ::: "memory");
        }
        const float rs = rstd * sA;
#pragma unroll
        for (int kb = 0; kb < 32; ++kb) { const int c0 = kb * 32 + kq * 8; const v4u y = yv[kb];
            const f32x4 g0 = *(const f32x4*)(gl + c0) * rs, g1 = *(const f32x4*)(gl + c0 + 4) * rs, b0 = *(const f32x4*)(bl + c0) * sA, b1 = *(const f32x4*)(bl + c0 + 4) * sA;
            typedef unsigned u32x2 __attribute__((ext_vector_type(2))); u32x2 q8;
            q8.x = pg8::pk4_fp8((bf_lo(y.x) - mean) * g0[0] + b0[0], (bf_hi(y.x) - mean) * g0[1] + b0[1], (bf_lo(y.y) - mean) * g0[2] + b0[2], (bf_hi(y.y) - mean) * g0[3] + b0[3]);
            q8.y = pg8::pk4_fp8((bf_lo(y.z) - mean) * g1[0] + b1[0], (bf_hi(y.z) - mean) * g1[1] + b1[1], (bf_lo(y.w) - mean) * g1[2] + b1[2], (bf_hi(y.w) - mean) * g1[3] + b1[3]);
            *(u32x2*)(X8 + rowoff + kb * 32) = q8;
            asm volatile("" ::: "memory"); }
        __syncthreads();
        if (tid < 32) lbase[tid] = (int)__hip_atomic_fetch_add(cnt + tid * 64, (unsigned)lcnt[tid], RLX_AGENT);
        __syncthreads();
        { const int pos = lbase[my_e] + my_rank; lslot[(size_t)my_e * LCAP + pos] = my_slot; lgate[(size_t)my_e * LCAP + pos] = my_gate; }
        __syncthreads();
    }
}

__device__ __forceinline__ float attn_obound(const float* gsub, float osc, int lane) {
    float mg = fmaxf(fabsf(gsub[lane]), fabsf(gsub[64 + lane]));
#pragma unroll
    for (int o = 1; o < 64; o <<= 1) mg = fmaxf(mg, shx(mg, o));
    return 11.3137085f * mg * fabsf(osc);
}

constexpr int NWAVES = 8;
constexpr int N_PHASES = 1 + DEPTH * 7;
#ifndef REP_ATTN
#define REP_ATTN 1
#endif
#ifndef KREP_MOE
#define KREP_MOE 1
#endif
#ifndef REP_MOE
#define REP_MOE 1
#endif
#ifndef REP_P0
#define REP_P0 1
#endif
#ifndef REP_THIN
#define REP_THIN 1
#endif
#ifndef REP_DENSE
#define REP_DENSE 1
#endif
#ifndef MK_SPLIT
#define MK_SPLIT 0
#endif
struct Args { const float* in[17]; float* out; unsigned char* ws; int ph_lo, ph_hi, li, pad; };
typedef const __attribute__((address_space(4))) Args* ArgsP;
enum { I_X = 0, I_RELB, I_AWIN, I_ALAM, I_ASUB, I_AWOUT, I_CWIN, I_CW, I_CWOUT, I_RW, I_RB, I_W1, I_B1, I_W2, I_B2, I_LNG, I_LNB };
__global__ void __launch_bounds__(NWAVES * 64, 2) mk_fwd(Args args) {
    extern __shared__ __attribute__((aligned(16))) unsigned char lds[];
    LAS unsigned char* ldsl = (LAS unsigned char*)lds;
    volatile LAS unsigned* MISC = (volatile LAS unsigned*)(ldsl + MISC_OFF);
    const int tid0 = threadIdx.x;
    const int wave0 = __builtin_amdgcn_readfirstlane(tid0 >> 6);
    const int G0 = gridDim.x, bx0 = blockIdx.x;
#define PHASE_BEGIN() int wv_ = wave0; asm volatile("" : "+s"(wv_)); int ln_; asm volatile("v_mbcnt_lo_u32_b32 %0, -1, 0\n\tv_mbcnt_hi_u32_b32 %0, -1, %0" : "=v"(ln_)); int tid = wv_ * 64 + ln_; int G = G0, bx = bx0; asm volatile("" : "+s"(G), "+s"(bx)); const int vcu = (G % 8 == 0) ? (bx % 8) * (G / 8) + bx / 8 : bx; const int NGW = G * NWAVES; \
        const int lane = tid & 63, wave = __builtin_amdgcn_readfirstlane(tid >> 6); const int gw = vcu * NWAVES + wave; (void)lane; (void)gw; (void)NGW; \
        ArgsP ap = (ArgsP)__builtin_amdgcn_kernarg_segment_ptr(); asm volatile("" : "+s"(ap)); unsigned char* ws = ap->ws; gu32* ctl = (gu32*)(ws + WS_CTL); (void)ctl
    for (int u = tid0; u < (LDS_BYTES - LDSCTL_OFF) / 4; u += NWAVES * 64) ((LAS unsigned*)(ldsl + LDSCTL_OFF))[u] = 0u;
    __syncthreads();
    XcdBarrier bar = xcd_barrier_post((unsigned*)(args.ws + WS_CTL) + CW_BAR + (size_t)args.li * 4096, MISC + 8);
    const int lo = args.ph_lo, hi = args.ph_hi;
#define IN(k) (lo <= (k) && (k) < hi)
#define SEAM(k) do { if (IN((k) + 1)) xcd_barrier(bar); } while (0)
    LAS int* tb = (LAS int*)(ldsl + LDSCTL_OFF); LAS int* cn = tb + 64;

    if (IN(0)) { PHASE_BEGIN();
        Ptrs P; P.x = ap->in[I_X]; P.attn_w_in = ap->in[I_AWIN]; P.attn_w_out = ap->in[I_AWOUT]; P.conv_w_in = ap->in[I_CWIN]; P.conv_w_out = ap->in[I_CWOUT]; P.router_w = ap->in[I_RW]; P.router_b = ap->in[I_RB]; P.ln_g = ap->in[I_LNG]; P.ln_b = ap->in[I_LNB]; P.w1 = ap->in[I_W1]; P.w2 = ap->in[I_W2]; P.ws = ws;
        _Pragma("unroll 1") for (int rep = 0; rep < REP_P0; ++rep) p0_prologue(P, ldsl, gw, NGW, wave, lane); SEAM(0); }

#define MOE_GEMMS(L, pb) do { \
            if (IN((pb) + 4)) { PHASE_BEGIN(); \
                pg8::MoeProb<true, true> S{(const char*)(ws + WS_X8), (const char*)(ws + WS_W1) + (size_t)(L) * 32 * 2048 * 1024, (size_t)2048 * 1024, 8, G, vcu, (int)tb[32], tb, cn, (const int*)(ws + WS_LS), lane, tid}; \
                pg8::EpiMoe1 E{ws + WS_A2, ap->in[I_B1] + (size_t)(L) * 32 * 2048, (const float*)(ws + WS_S1) + (size_t)(L) * 32 * 2048, ln_bound(ap->in[I_LNG] + ((L) * 2 + 0) * D, ap->in[I_LNB] + ((L) * 2 + 0) * D, lane) * (1.0f / F8MAX) * (1.0f / KREP_MOE)}; \
                pg8::gemm_phase<pg8::MoeProb<true, true>, pg8::EpiMoe1, true, true, KREP_MOE>(ldsl + RING_OFF, ldsl + XL_OFF, S, E); \
                SEAM((pb) + 4); \
            } \
            if (IN((pb) + 5)) { PHASE_BEGIN(); \
                pg8::MoeProb<false, true> S{(const char*)(ws + WS_A2), (const char*)(ws + WS_W2) + (size_t)(L) * 32 * 1024 * 1024, (size_t)1024 * 1024, 4, G, vcu, (int)tb[32], tb, cn, (const int*)(ws + WS_LS), lane, tid}; \
                pg8::EpiMoe2 E{ws + WS_Y, ap->in[I_B2] + (size_t)(L) * 32 * 1024, (const float*)(ws + WS_S2) + (size_t)(L) * 32 * 1024, (const int*)(ws + WS_LS), (const float*)(ws + WS_LG)}; \
                pg8::gemm_phase<pg8::MoeProb<false, true>, pg8::EpiMoe2, true, true, KREP_MOE>(ldsl + RING_OFF, ldsl + XL_OFF, S, E); \
                SEAM((pb) + 5); \
            } \
        } while (0)
#if REP_MOE == 2
#define MOE_GEMMS_REP(L, pb) MOE_GEMMS(L, pb)
#else
#define MOE_GEMMS_REP(L, pb) do {} while (0)
#endif
#define MOE_HALF(L, pb) do { \
            if (IN((pb) + 3)) { PHASE_BEGIN(); \
                router_phase((const bf16_t*)(ws + WS_YP), ap->in[I_LNG] + ((L) * 2 + 0) * D, ap->in[I_LNB] + ((L) * 2 + 0) * D, (const bf16_t*)(ws + WS_WR) + (size_t)(L) * 32 * 1024, ap->in[I_RW] + (size_t)(L) * 1024 * 32, ap->in[I_RB] + (L) * 32, \
                             ws + WS_X8, (int*)(ws + WS_LS), (float*)(ws + WS_LG), (unsigned*)(ctl + CW_CNT) + (L) * 32 * 64, (char*)lds + RING_OFF, vcu, G, tid, wave, lane, (const float*)(ws + WS_RC) + (L) * 64); \
                SEAM((pb) + 3); \
            } \
            if (IN((pb) + 4) || IN((pb) + 5)) { PHASE_BEGIN(); \
                if (tid < 64) { const int c_ = (lane < 32) ? (int)__hip_atomic_load(ctl + CW_CNT + ((L) * 32 + (lane & 31)) * 64, RLX_AGENT) : 0; const int t_ = (c_ + 255) >> 8; int p_ = t_; \
                    _Pragma("unroll") for (int o_ = 1; o_ < 32; o_ <<= 1) { const int q_ = __builtin_amdgcn_ds_bpermute((lane - o_) * 4, p_); if (lane >= o_) p_ += q_; } \
                    if (lane < 32) { cn[lane] = c_; tb[lane + 1] = p_; } if (lane == 0) tb[0] = 0; } \
                __syncthreads(); \
            } \
            MOE_GEMMS(L, pb); MOE_GEMMS_REP(L, pb); \
            if (REP_THIN == 2 && IN((pb) + 6)) { PHASE_BEGIN(); \
                ln2_phase((const bf16_t*)(ws + WS_YP), ap->in[I_LNG] + ((L) * 2 + 0) * D, ap->in[I_LNB] + ((L) * 2 + 0) * D, (const unsigned char*)(ws + WS_Y), ap->in[I_LNG] + ((L) * 2 + 1) * D, ap->in[I_LNB] + ((L) * 2 + 1) * D, (bf16_t*)(ws + WS_XB), ((L) == DEPTH - 1) ? ap->out : nullptr, ((((L) == 0) && (CM & 1)) || (((L) == 1) && (QM & 2)) || (((L) == 2) && (CM & 2))) ? ws + WS_XI : nullptr, (float*)(ws + WS_RS), gw, NGW, lane); \
            } \
            if (IN((pb) + 6)) { PHASE_BEGIN(); \
                ln2_phase((const bf16_t*)(ws + WS_YP), ap->in[I_LNG] + ((L) * 2 + 0) * D, ap->in[I_LNB] + ((L) * 2 + 0) * D, (const unsigned char*)(ws + WS_Y), ap->in[I_LNG] + ((L) * 2 + 1) * D, ap->in[I_LNB] + ((L) * 2 + 1) * D, (bf16_t*)(ws + WS_XB), ((L) == DEPTH - 1) ? ap->out : nullptr, ((((L) == 0) && (CM & 1)) || (((L) == 1) && (QM & 2)) || (((L) == 2) && (CM & 2))) ? ws + WS_XI : nullptr, (float*)(ws + WS_RS), gw, NGW, lane); \
                if ((pb) + 7 < N_PHASES) SEAM((pb) + 6); \
            } \
        } while (0)

#pragma unroll 1
    for (int lp = 0; lp < DEPTH / 2; ++lp) {
        {
            const int L = 2 * lp, pb = 1 + L * 7;
            if (IN(pb + 0)) {
                PHASE_BEGIN();
                if (QM == 3 || (QM != 0 && ((QM >> lp) & 1))) {
                pg8::DenseProbT<true> S; S.init(ws + WS_XI, ws + WS_WAI + (size_t)lp * 3072 * 1024, M, 3072, G, bx, tid);
                pg8::EpiQKV8 E{(bf16_t*)(ws + WS_Q), (size_t)(WS_K - WS_Q) / 2, QSCALE, (const float*)(ws + WS_SD) + lp * 3072, (const float*)(ws + WS_RS)};
                pg8::gemm_phase<pg8::DenseProbT<true>, pg8::EpiQKV8, true, true, 1, I8P>(ldsl + RING_OFF, ldsl + XL_OFF, S, E);
                } else {
                pg8::DenseProb S; S.init(ws + WS_XB, (const bf16_t*)(ws + WS_WA16) + (size_t)lp * 3072 * 1024, M, 3072, G, bx, tid);
                pg8::EpiQKV E{(bf16_t*)(ws + WS_Q), (size_t)(WS_K - WS_Q) / 2, QSCALE};
                pg8::gemm_phase<pg8::DenseProb, pg8::EpiQKV, true>(ldsl + RING_OFF, ldsl + XL_OFF, S, E);
                }
                SEAM(pb + 0);
            }
            if (IN(pb + 1)) {
                PHASE_BEGIN();
                const float* lf = ap->in[I_ALAM] + lp * 256;
                const float s1 = wave_sum(lf[lane] * lf[64 + lane]), s2 = wave_sum(lf[128 + lane] * lf[192 + lane]);
                const float lam_init = (lp == 0) ? 0.2f : (0.8f - 0.6f * 0.54881163609402643f);
                const float lam = __expf(s1) - __expf(s2) + lam_init;
                const bool o8 = (AOM == 3) || (AOM != 0 && ((AOM >> lp) & 1));
                const float oscl = o8 ? (1.0f - lam_init) * (F8MAX / attn_obound(ap->in[I_ASUB] + lp * 128, 1.0f - lam_init, lane)) : (1.0f - lam_init);
                int hprev = -1; bool strips_done = !(DEFER_W && lp == 0);
#pragma unroll 1
                for (int rep = 0; rep < REP_ATTN; ++rep)
#pragma unroll 1
                for (int i = 0; i < (BATCH * NH * 32) / 256; ++i) {
                    const int item = i * G + vcu;
                    if (item >= BATCH * NH * 32) break;
                    const int bh = item >> 5, qb = item & 31;
                    const bool newh = (i == 0) || ((bh & 7) != hprev); hprev = bh & 7;
                    att::attn_unit(bh >> 3, bh & 7, qb, (const bf16_t*)(ws + WS_Q), (const bf16_t*)(ws + WS_K), (const bf16_t*)(ws + WS_V), (bf16_t*)(ws + WS_O), lam, oscl,
                                   ap->in[I_ASUB] + lp * 128, ap->in[I_RELB], (char*)lds + RING_OFF, tid, newh, o8);
                    if (!strips_done && i == (vcu & 15)) { strips_done = true;
                        Ptrs P; P.w1 = ap->in[I_W1]; P.w2 = ap->in[I_W2]; P.ws = ws;
                        int ln_s = lane; asm volatile("" : "+v"(ln_s));
                        { const int per_ = (128 * 96 + G - 1) / G, f_ = vcu * per_, e_ = (f_ + per_ < 128 * 96) ? f_ + per_ : 128 * 96; deferred_strips(P.w1, P.w2, ws, ldsl, f_, e_, wave, ln_s); }
                        hprev = -1;
                    }
                }
                if (!strips_done) { int ln_s = lane; asm volatile("" : "+v"(ln_s)); const int per_ = (128 * 96 + G - 1) / G, f_ = vcu * per_, e_ = (f_ + per_ < 128 * 96) ? f_ + per_ : 128 * 96; deferred_strips(ap->in[I_W1], ap->in[I_W2], ws, ldsl, f_, e_, wave, ln_s); }
                SEAM(pb + 1);
            }
            if (IN(pb + 2)) {
                PHASE_BEGIN();
                if ((AOM == 3) || (AOM != 0 && ((AOM >> lp) & 1))) {
                const float lam_init = (lp == 0) ? 0.2f : (0.8f - 0.6f * 0.54881163609402643f);
                pg8::DenseProbT<true> S; S.init(ws + WS_O, ws + WS_WAO8 + (size_t)lp * 1024 * 1024, M, 1024, G, bx, tid);
                pg8::EpiResid8<false> E{(const bf16_t*)(ws + WS_XB), (bf16_t*)(ws + WS_YP), (const float*)(ws + WS_SD + 24 * 1024) + lp * 1024, nullptr, attn_obound(ap->in[I_ASUB] + lp * 128, 1.0f - lam_init, lane) * (1.0f / F8MAX)};
                pg8::gemm_phase<pg8::DenseProbT<true>, pg8::EpiResid8<false>, true, true>(ldsl + RING_OFF, ldsl + XL_OFF, S, E);
                } else {
                pg8::DenseProb S; S.init(ws + WS_O, (const bf16_t*)(ws + WS_WAO) + (size_t)lp * 1024 * 1024, M, 1024, G, bx, tid);
                pg8::EpiResid E{(const bf16_t*)(ws + WS_XB), (bf16_t*)(ws + WS_YP)};
                pg8::gemm_phase<pg8::DenseProb, pg8::EpiResid, true>(ldsl + RING_OFF, ldsl + XL_OFF, S, E);
                }
                SEAM(pb + 2);
            }
            MOE_HALF(L, pb);
        }
        {
            const int L = 2 * lp + 1, pb = 1 + L * 7;
            if (IN(pb + 0)) {
                PHASE_BEGIN();
                if (CM == 3 || (CM != 0 && ((CM >> lp) & 1))) {
                pg8::DenseProbT<true> S; S.init(ws + WS_XI, ws + WS_WCI + (size_t)lp * 3072 * 1024, M, 3072, G, bx, tid);
                pg8::EpiConvIn8 E{(bf16_t*)(ws + WS_Q), (bf16_t*)(ws + WS_K), (const float*)(ws + WS_SD + 32 * 1024) + lp * 3072, (const float*)(ws + WS_RS)};
                pg8::gemm_phase<pg8::DenseProbT<true>, pg8::EpiConvIn8, true, true, 1, I8P>(ldsl + RING_OFF, ldsl + XL_OFF, S, E);
                } else {
                pg8::DenseProb S; S.init(ws + WS_XB, (const bf16_t*)(ws + WS_WC16) + (size_t)lp * 3072 * 1024, M, 3072, G, bx, tid);
                pg8::EpiConvIn E{(bf16_t*)(ws + WS_Q), (bf16_t*)(ws + WS_K)};
                pg8::gemm_phase<pg8::DenseProb, pg8::EpiConvIn, true>(ldsl + RING_OFF, ldsl + XL_OFF, S, E);
                }
                SEAM(pb + 0);
            }
            if (IN(pb + 1)) { PHASE_BEGIN(); conv_phase((const bf16_t*)(ws + WS_Q), (const bf16_t*)(ws + WS_K), ap->in[I_CW] + lp * 3 * D, (bf16_t*)(ws + WS_O), (float*)(ws + WS_RS), (COM == 3) || (COM != 0 && ((COM >> lp) & 1)), gw, NGW, lane); SEAM(pb + 1); }
            if (IN(pb + 2)) {
                PHASE_BEGIN();
                if ((COM == 3) || (COM != 0 && ((COM >> lp) & 1))) {
                pg8::DenseProbT<true> S; S.init(ws + WS_O, ws + WS_WCO8 + (size_t)lp * 1024 * 1024, M, 1024, G, bx, tid);
                pg8::EpiResid8<true> E{(const bf16_t*)(ws + WS_XB), (bf16_t*)(ws + WS_YP), (const float*)(ws + WS_SD + 56 * 1024) + lp * 1024, (const float*)(ws + WS_RS), 1.0f};
                pg8::gemm_phase<pg8::DenseProbT<true>, pg8::EpiResid8<true>, true, true, 1, I8P>(ldsl + RING_OFF, ldsl + XL_OFF, S, E);
                } else {
                pg8::DenseProb S; S.init(ws + WS_O, (const bf16_t*)(ws + WS_WCO) + (size_t)lp * 1024 * 1024, M, 1024, G, bx, tid);
                pg8::EpiResid E{(const bf16_t*)(ws + WS_XB), (bf16_t*)(ws + WS_YP)};
                pg8::gemm_phase<pg8::DenseProb, pg8::EpiResid, true>(ldsl + RING_OFF, ldsl + XL_OFF, S, E);
                }
                SEAM(pb + 2);
            }
            MOE_HALF(L, pb);
        }
    }
#undef IN
#undef SEAM
}

extern "C" void kernel_launch(void* const* d_in, const int* in_sizes, int n_in, void* d_out, int out_size, void* d_ws, size_t ws_size, hipStream_t stream) {
    static int grid = 0;
    if (grid == 0) {
        if (n_in != 17 || in_sizes[0] != M * D || out_size != M * D || ws_size < WS_END) {
            fprintf(stderr, "kernel_launch: shape mismatch: n_in %d in0 %d out %d ws %zu (need %zu)\n", n_in, n_in > 0 ? in_sizes[0] : -1, out_size, ws_size, (size_t)WS_END); grid = -1; return; }
        int dev = 0, cus = 0, per_cu = 0;
        if (hipGetDevice(&dev) != hipSuccess || hipDeviceGetAttribute(&cus, hipDeviceAttributeMultiprocessorCount, dev) != hipSuccess) { grid = -1; return; }
        if (hipFuncSetAttribute((const void*)mk_fwd, hipFuncAttributeMaxDynamicSharedMemorySize, LDS_BYTES) != hipSuccess) { fprintf(stderr, "kernel_launch: hipFuncSetAttribute failed\n"); grid = -1; return; }
        if (hipOccupancyMaxActiveBlocksPerMultiprocessor(&per_cu, (const void*)mk_fwd, NWAVES * 64, LDS_BYTES) != hipSuccess || per_cu < 1)
            fprintf(stderr, "kernel_launch: occupancy query reports %d workgroups per CU\n", per_cu);
        (void)hipGetLastError();
        grid = cus;
    }
    if (grid < 0) return;
    if (hipMemsetAsync((char*)d_ws + WS_CTL, 0, CTL_ZERO_BYTES, stream) != hipSuccess) { fprintf(stderr, "kernel_launch: memset failed\n"); return; }
    Args a{};
    for (int i = 0; i < 17; ++i) a.in[i] = (const float*)d_in[i];
    a.out = (float*)d_out; a.ws = (unsigned char*)d_ws; a.pad = 0;
#if MK_SPLIT
    for (int p = 0; p < N_PHASES; ++p) { a.ph_lo = p; a.ph_hi = p + 1; a.li = p; hipLaunchKernelGGL(mk_fwd, dim3(grid), dim3(NWAVES * 64), LDS_BYTES, stream, a); }
#else
    a.ph_lo = 0; a.ph_hi = N_PHASES; a.li = 0;
    hipLaunchKernelGGL(mk_fwd, dim3(grid), dim3(NWAVES * 64), LDS_BYTES, stream, a);
#endif
    const hipError_t le = hipPeekAtLastError();
    if (le != hipSuccess) fprintf(stderr, "kernel_launch: launch failed: %s\n", hipGetErrorName(le));
}
```

```cpp
#include <hip/hip_runtime.h>
#include <hip/hip_bf16.h>
#include <cstdio>
#include <cstdint>

constexpr int BATCH = 16, SEQ = 4096, D = 1024, M = BATCH * SEQ, DEPTH = 4, NH = 8, NE = 32, TOPK = 4;
constexpr float LN_EPS = 1e-5f;
constexpr float ALPHA = 1.6817928305074290f;
constexpr float LOG2E = 1.4426950408889634f;
constexpr float QSCALE = 0.125f * LOG2E;
constexpr int LCAP = 65536;
constexpr int MAXRT = 1056;

constexpr size_t MiB = 1ull << 20;
constexpr size_t WS_CTL = 0, CTL_ZERO_BYTES = 1 * MiB;
constexpr size_t WS_WAI = 1 * MiB;
constexpr size_t WS_WAO = WS_WAI + 12 * MiB;
constexpr size_t WS_WCI = WS_WAO + 4 * MiB;
constexpr size_t WS_WCO = WS_WCI + 12 * MiB;
constexpr size_t WS_WR  = WS_WCO + 4 * MiB;
constexpr size_t WS_W1  = WS_WR + 1 * MiB;
constexpr size_t WS_W2  = WS_W1 + 256 * MiB;
constexpr size_t WS_S1  = WS_W2 + 128 * MiB;
constexpr size_t WS_S2  = WS_S1 + 1 * MiB;
constexpr size_t WS_SD  = WS_S2 + 512 * 1024;
constexpr size_t WS_RS  = WS_SD + 64 * 1024;
constexpr size_t WS_XB  = WS_S2 + 1 * MiB;
constexpr size_t WS_XI  = WS_XB + 128 * MiB;
constexpr size_t WS_X8  = WS_XI + 128 * MiB;
constexpr size_t WS_YP  = WS_X8 + 64 * MiB;
constexpr size_t WS_Q   = WS_YP + 128 * MiB;
constexpr size_t WS_K   = WS_Q + 128 * MiB;
constexpr size_t WS_V   = WS_K + 128 * MiB;
constexpr size_t WS_O   = WS_V + 128 * MiB;
constexpr size_t WS_LS  = WS_O + 128 * MiB;
constexpr size_t WS_LG  = WS_LS + 8 * MiB;
constexpr size_t WS_A2  = WS_LG + 8 * MiB;
constexpr size_t WS_Y   = WS_A2 + 264 * MiB;
constexpr size_t WS_WA16 = WS_Y + 513 * MiB;
constexpr size_t WS_WC16 = WS_WA16 + 12 * MiB;
constexpr size_t WS_WAO8 = WS_WC16 + 12 * MiB;
constexpr size_t WS_WCO8 = WS_WAO8 + 2 * MiB;
constexpr size_t WS_RC = WS_WCO8 + 2 * MiB;
constexpr size_t WS_END = WS_RC + 1 * MiB;
#ifndef F8_QKV_MASK
#define F8_QKV_MASK 3
#endif
#ifndef F8_CONV_MASK
#define F8_CONV_MASK 3
#endif
#ifndef F8_AOUT_MASK
#define F8_AOUT_MASK 3
#endif
#ifndef F8_COUT_MASK
#define F8_COUT_MASK 3
#endif
constexpr int QM = F8_QKV_MASK, CM = F8_CONV_MASK, AOM = F8_AOUT_MASK, COM = F8_COUT_MASK;
constexpr int NA8 = (AOM & 1) + (AOM >> 1), NO8 = (COM & 1) + (COM >> 1), AJ0 = (AOM & 1) ? 0 : 1, OJ0 = (COM & 1) ? 0 : 1;
constexpr int NA16 = 2 - NA8, NO16 = 2 - NO8, AK0 = (AOM & 1) ? 1 : 0, OK0 = (COM & 1) ? 1 : 0;
constexpr int NQ8 = (QM & 1) + (QM >> 1), NC8 = (CM & 1) + (CM >> 1), QJ0 = (QM & 1) ? 0 : 1, CJ0 = (CM & 1) ? 0 : 1;
constexpr int NQ16 = 2 - NQ8, NC16 = 2 - NC8, QK0 = (QM & 1) ? 1 : 0, CK0 = (CM & 1) ? 1 : 0;
constexpr float F8MAX = 448.0f * 0.999f;
constexpr bool I8P = true;
constexpr float QMAXP = I8P ? 127.0f : 448.0f * 0.999f;
constexpr float YSCALE = 16.0f;
constexpr float A2SCALE = 8.0f;
constexpr int CW_TMO = 0, CW_CODE = 1;
constexpr int CW_BAR = 4096;
constexpr int CW_CNT = 16384;

constexpr int RING_OFF = 0, RING_BYTES = 131072;
constexpr int LDSCTL_OFF = RING_BYTES, MISC_OFF = LDSCTL_OFF + 1024;
constexpr int XL_OFF = LDSCTL_OFF + 4096;
constexpr int LDS_BYTES = 147456;

#define GAS __attribute__((address_space(1)))
#define LAS __attribute__((address_space(3)))
typedef unsigned short bf16_t;
typedef unsigned v4u __attribute__((ext_vector_type(4)));
typedef float f32x4 __attribute__((ext_vector_type(4)));
typedef float f32x2 __attribute__((ext_vector_type(2)));
typedef short bf16x8 __attribute__((ext_vector_type(8)));
typedef float f32x16 __attribute__((ext_vector_type(16)));
typedef short s16x4 __attribute__((ext_vector_type(4)));
typedef GAS unsigned gu32;
#define RLX_AGENT __ATOMIC_RELAXED, __HIP_MEMORY_SCOPE_AGENT
#define LDS_WAIT() asm volatile("s_waitcnt lgkmcnt(0)" ::: "memory")
#define VM_WAIT() asm volatile("s_waitcnt vmcnt(0)" ::: "memory")

__device__ __forceinline__ unsigned cvt_pk_bf16(float lo, float hi) { unsigned r; asm volatile("v_cvt_pk_bf16_f32 %0, %1, %2" : "=v"(r) : "v"(lo), "v"(hi)); return r; }
__device__ __forceinline__ float bf_lo(unsigned u) { return __uint_as_float(u << 16); }
__device__ __forceinline__ float bf_hi(unsigned u) { return __uint_as_float(u & 0xffff0000u); }
__device__ __forceinline__ int lane_local() { int l; asm volatile("v_mbcnt_lo_u32_b32 %0, -1, 0\n\tv_mbcnt_hi_u32_b32 %0, -1, %0" : "=v"(l)); return l; }
__device__ __forceinline__ float shx(float v, int m, int l) { return __int_as_float(__builtin_amdgcn_ds_bpermute((l ^ m) << 2, __float_as_int(v))); }
__device__ __forceinline__ float shx(float v, int m) { return shx(v, m, lane_local()); }
__device__ __forceinline__ float wave_sum(float v) {
    const int l_ = lane_local();
#pragma unroll
    for (int o = 1; o < 64; o <<= 1) v += shx(v, o, l_);
    return v;
}

#ifndef KREP_MOE
#define KREP_MOE 1
#endif
namespace pg8 {
constexpr float KREP_MOE_ = (float)KREP_MOE;
#define PG8_LAS __attribute__((address_space(3)))
constexpr int BM = 256, BK = 64, HALF = 128, HTB = HALF * BK * 2, STAGE_BYTES = 8 * HTB, NXCD = 8, WGM = 8, KD = 1024, NTK = KD / BK;

__host__ __device__ __forceinline__ int lds_byte(int r, int c) { const int st = (r >> 4) * 2 + (c >> 5), rr = r & 15, cc = c & 31, ob = rr * 64 + cc * 2; return st * 1024 + (ob ^ (((ob >> 9) & 1) << 5)); }
__host__ __device__ __forceinline__ void stage_rc(int b, int& R, int& C) { const int st = b / 1024, sb = b % 1024, swz = sb ^ (((sb >> 9) & 1) << 5); R = (st >> 1) * 16 + swz / 64; C = (st & 1) * 32 + (swz % 64) / 2; }
__host__ __device__ __forceinline__ int perm32(int rho) { const int n = rho >> 4, i = rho & 15; return 8 * (i >> 2) + 4 * n + (i & 3); }

struct Unit { int pm, pn, e, valid, lr0; };
__device__ __forceinline__ void dma1k(const void* src, PG8_LAS unsigned char* dst, int lane) {
    __builtin_amdgcn_global_load_lds((const __attribute__((address_space(1))) unsigned*)((const char*)src + lane * 16), (PG8_LAS unsigned*)dst, 16, 0, 0);
}
constexpr int XL_EPI = 4096, XL_GATHER = 1024, XL_BYTES = 2 * (XL_EPI + XL_GATHER);

template <bool F8> struct DenseProbT {
    static constexpr bool GATHER = false;
    static constexpr int RP = F8 ? 1024 : 2048;
    const char* A; const char* Bt; int nM, nN, nwg, G, c, tid;
    __device__ void init(const void* A_, const void* Bt_, int Mrows, int N, int G_, int c_, int tid_) { A = (const char*)A_; Bt = (const char*)Bt_; nM = Mrows / BM; nN = N / BM; nwg = nM * nN; G = G_; c = c_; tid = tid_; }
    __device__ __forceinline__ bool next(int i, Unit& u) const {
        const long L = (long)i * G + c; if (L >= nwg) return false;
        int wgid = (int)L; { const int q = nwg / NXCD, r = nwg % NXCD, xcd = wgid % NXCD, off = wgid / NXCD; wgid = (xcd < r ? xcd * (q + 1) : r * (q + 1) + (xcd - r) * q) + off; }
        const int nig = WGM * nN, gid = wgid / nig, fm = gid * WGM, gsz = (nM - fm) < WGM ? (nM - fm) : WGM;
        u.pm = fm + ((wgid % nig) % gsz); u.pn = (wgid % nig) / gsz; u.e = 0; u.valid = 256; u.lr0 = 0; return true;
    }
    __device__ __forceinline__ void a_off(const Unit& u, const int (&RA)[2], const int (&CA)[2], unsigned (&vo)[2][2]) const {
#pragma unroll
        for (int h = 0; h < 2; ++h)
#pragma unroll
            for (int i = 0; i < 2; ++i) vo[h][i] = (unsigned)((u.pm * BM + h * HALF + RA[i]) * RP + CA[i] * 2);
    }
    __device__ __forceinline__ unsigned a_tile(const Unit& u) const { return (unsigned)u.pm * (unsigned)(BM * RP); }
    __device__ __forceinline__ unsigned b_off(const Unit& u) const { return (unsigned)u.pn * (unsigned)(BM * RP); }    __device__ __forceinline__ void dma_rows(const Unit&, PG8_LAS unsigned char*, int, int) const {}
    __device__ __forceinline__ void a_off_lds(const Unit&, const int (&)[2], const int (&)[2], const PG8_LAS unsigned char*, unsigned (&)[2][2]) const {}
};
typedef DenseProbT<false> DenseProb;

template <bool GATHER_, bool F8> struct MoeProb {
    static constexpr bool GATHER = GATHER_;
    static constexpr int RP = F8 ? 1024 : 2048;
    const char* A; const char* Bt; size_t b_estride; int nN, G, v, RT; const PG8_LAS int* tb; const PG8_LAS int* cn; const int* lslot; int lane, tid;
    __device__ __forceinline__ bool next(int i, Unit& u) const {
        const int L = i * G + v; if (L >= RT * nN) return false;
        const int rt = L / nN; u.pm = rt; u.pn = L - rt * nN;
        const unsigned long long bal = __ballot(lane < 32 && rt >= tb[(lane & 31) + 1]);
        const int e = __builtin_amdgcn_readfirstlane(__popcll(bal)); u.e = e;
        const int tb_e = __builtin_amdgcn_readfirstlane(tb[e]), cn_e = __builtin_amdgcn_readfirstlane(cn[e]);
        u.lr0 = 256 * (rt - tb_e); const int rem = cn_e - u.lr0; u.valid = rem < 256 ? rem : 256; return true;
    }
    __device__ __forceinline__ void a_off(const Unit& u, const int (&RA)[2], const int (&CA)[2], unsigned (&vo)[2][2]) const {
        if constexpr (GATHER) {
            const int* ls = lslot + (size_t)u.e * LCAP + u.lr0;
#pragma unroll
            for (int h = 0; h < 2; ++h)
#pragma unroll
                for (int i = 0; i < 2; ++i) { const int rl = h * HALF + RA[i]; const int slot = ls[rl < u.valid ? rl : 0]; vo[h][i] = (unsigned)((slot >> 2) * RP + CA[i] * 2); }
        } else {
#pragma unroll
            for (int h = 0; h < 2; ++h)
#pragma unroll
                for (int i = 0; i < 2; ++i) vo[h][i] = (unsigned)((u.pm * BM + h * HALF + RA[i]) * RP + CA[i] * 2);
        }
    }
    __device__ __forceinline__ unsigned a_tile(const Unit& u) const { return (unsigned)u.pm * (unsigned)(BM * RP); }
    __device__ __forceinline__ unsigned b_off(const Unit& u) const { return (unsigned)u.e * (unsigned)b_estride + (unsigned)u.pn * (unsigned)(BM * RP); }
    __device__ __forceinline__ void dma_rows(const Unit& u, PG8_LAS unsigned char* dst, int wid, int lane_) const { if constexpr (GATHER) { if (wid == 0) dma1k(lslot + (size_t)u.e * LCAP + u.lr0, dst, lane_); } }
    __device__ __forceinline__ void a_off_lds(const Unit& u, const int (&RA)[2], const int (&CA)[2], const PG8_LAS unsigned char* src, unsigned (&vo)[2][2]) const {
        if constexpr (GATHER) { const PG8_LAS int* ls = (const PG8_LAS int*)src;
#pragma unroll
            for (int h = 0; h < 2; ++h)
#pragma unroll
                for (int i = 0; i < 2; ++i) { const int rl = h * HALF + RA[i]; const int slot = ls[rl < u.valid ? rl : 0]; vo[h][i] = (unsigned)((slot >> 2) * RP + CA[i] * 2); } }
    }
};

__device__ __forceinline__ v4u pack8(const f32x4 v0, const f32x4 v1) { v4u w; w.x = cvt_pk_bf16(v0[0], v0[1]); w.y = cvt_pk_bf16(v0[2], v0[3]); w.z = cvt_pk_bf16(v1[0], v1[1]); w.w = cvt_pk_bf16(v1[2], v1[3]); return w; }

__device__ __forceinline__ void st16(void* base, unsigned off, v4u v) { *(v4u*)((char*)base + off) = v; }
struct EpiQKV {
    __device__ __forceinline__ void dma(const Unit&, PG8_LAS unsigned char*, int, int) const {}
    bf16_t* O; size_t stride; float scale0;
    __device__ __forceinline__ void operator()(const f32x4 (&acc)[2][2][4][2], const Unit& u, int wr, int wc, int fr_, int fq_, const PG8_LAS unsigned char* xl) const {
        int fr = fr_, fq = fq_; asm volatile("" : "+v"(fr), "+v"(fq));
        const int row0 = u.pm * BM + wr * 64 + fr; const int t = u.pn >> 2; const int colt = (u.pn & 3) * BM;
        bf16_t* base = O + (size_t)t * stride; const float sc = (t == 0) ? scale0 : 1.f; const unsigned off0 = (unsigned)(row0 * D + colt + wc * 32 + 8 * fq) * 2u;
#pragma unroll
        for (int ai = 0; ai < 2; ++ai)
#pragma unroll
            for (int m = 0; m < 4; ++m)
#pragma unroll
                for (int bj = 0; bj < 2; ++bj) st16(base, off0 + (unsigned)((ai * HALF + m * 16) * D + bj * HALF) * 2u, pack8(acc[ai][bj][m][0] * sc, acc[ai][bj][m][1] * sc));
    }
};
struct EpiConvIn {
    __device__ __forceinline__ void dma(const Unit&, PG8_LAS unsigned char*, int, int) const {}
    bf16_t* GB; bf16_t* Z;
    __device__ __forceinline__ void operator()(const f32x4 (&acc)[2][2][4][2], const Unit& u, int wr, int wc, int fr_, int fq_, const PG8_LAS unsigned char* xl) const {
        int fr = fr_, fq = fq_; asm volatile("" : "+v"(fr), "+v"(fq));
        const int row0 = u.pm * BM + wr * 64 + fr;
        if (u.pn < 4) { const unsigned off0 = (unsigned)(row0 * D + u.pn * BM + wc * 32 + 8 * fq) * 2u;
#pragma unroll
            for (int ai = 0; ai < 2; ++ai)
#pragma unroll
                for (int m = 0; m < 4; ++m)
#pragma unroll
                    for (int bj = 0; bj < 2; ++bj) st16(GB, off0 + (unsigned)((ai * HALF + m * 16) * D + bj * HALF) * 2u, pack8(acc[ai][bj][m][0], acc[ai][bj][m][1]));
        } else { const unsigned off0 = (unsigned)(row0 * D + (u.pn - 4) * HALF + wc * 32 + 8 * fq) * 2u;
#pragma unroll
            for (int ai = 0; ai < 2; ++ai)
#pragma unroll
                for (int m = 0; m < 4; ++m) st16(Z, off0 + (unsigned)((ai * HALF + m * 16) * D) * 2u, pack8(acc[ai][0][m][0] * acc[ai][1][m][0], acc[ai][0][m][1] * acc[ai][1][m][1]));
        }
    }
};
struct EpiQKV8 {
    bf16_t* O; size_t stride; float scale0; const float* sw; const float* rs;
    __device__ __forceinline__ void dma(const Unit& u, PG8_LAS unsigned char* xl, int wid, int lane) const {
        if (wid == 0) dma1k(sw + u.pn * BM, xl, lane); else if (wid == 1) dma1k(rs + u.pm * BM, xl + 1024, lane);
    }
    __device__ __forceinline__ void operator()(const f32x4 (&acc)[2][2][4][2], const Unit& u, int wr, int wc, int fr_, int fq_, const PG8_LAS unsigned char* xl) const {
        int fr = fr_, fq = fq_; asm volatile("" : "+v"(fr), "+v"(fq));
        const int row0 = u.pm * BM + wr * 64 + fr; const int t = u.pn >> 2; const int colt = (u.pn & 3) * BM; const int cl = wc * 32 + 8 * fq;
        bf16_t* base = O + (size_t)t * stride; const float sc = (t == 0) ? scale0 : 1.f; const unsigned off0 = (unsigned)(row0 * D + colt + cl) * 2u;
        const PG8_LAS float* sp = (const PG8_LAS float*)xl + cl; const PG8_LAS float* rp = (const PG8_LAS float*)(xl + 1024) + wr * 64 + fr;
        f32x4 sv[2][2];
#pragma unroll
        for (int bj = 0; bj < 2; ++bj)
#pragma unroll
            for (int n = 0; n < 2; ++n) sv[bj][n] = *(const PG8_LAS f32x4*)(sp + bj * HALF + 4 * n) * sc;
#pragma unroll
        for (int ai = 0; ai < 2; ++ai)
#pragma unroll
            for (int m = 0; m < 4; ++m) { const float r = rp[ai * HALF + m * 16];
#pragma unroll
                for (int bj = 0; bj < 2; ++bj) st16(base, off0 + (unsigned)((ai * HALF + m * 16) * D + bj * HALF) * 2u, pack8(acc[ai][bj][m][0] * (sv[bj][0] * r), acc[ai][bj][m][1] * (sv[bj][1] * r))); }
    }
};
struct EpiConvIn8 {
    bf16_t* GB; bf16_t* Z; const float* sw; const float* rs;
    __device__ __forceinline__ void dma(const Unit& u, PG8_LAS unsigned char* xl, int wid, int lane) const { if (wid == 0) dma1k(sw + u.pn * BM, xl, lane); else if (wid == 1) dma1k(rs + u.pm * BM, xl + 1024, lane); }
    __device__ __forceinline__ void operator()(const f32x4 (&acc)[2][2][4][2], const Unit& u, int wr, int wc, int fr_, int fq_, const PG8_LAS unsigned char* xl) const {
        int fr = fr_, fq = fq_; asm volatile("" : "+v"(fr), "+v"(fq));
        const int row0 = u.pm * BM + wr * 64 + fr; const int cl = wc * 32 + 8 * fq;
        const PG8_LAS float* sp = (const PG8_LAS float*)xl + cl; const PG8_LAS float* rp = (const PG8_LAS float*)(xl + 1024) + wr * 64 + fr;
        f32x4 sv[2][2];
#pragma unroll
        for (int bj = 0; bj < 2; ++bj)
#pragma unroll
            for (int n = 0; n < 2; ++n) sv[bj][n] = *(const PG8_LAS f32x4*)(sp + bj * HALF + 4 * n);
        if (u.pn < 4) { const unsigned off0 = (unsigned)(row0 * D + u.pn * BM + cl) * 2u;
#pragma unroll
            for (int ai = 0; ai < 2; ++ai)
#pragma unroll
                for (int m = 0; m < 4; ++m) { const float r = rp[ai * HALF + m * 16];
#pragma unroll
                    for (int bj = 0; bj < 2; ++bj) st16(GB, off0 + (unsigned)((ai * HALF + m * 16) * D + bj * HALF) * 2u, pack8(acc[ai][bj][m][0] * (sv[bj][0] * r), acc[ai][bj][m][1] * (sv[bj][1] * r))); }
        } else { const unsigned off0 = (unsigned)(row0 * D + (u.pn - 4) * HALF + cl) * 2u;
            const f32x4 sz0 = sv[0][0] * sv[1][0], sz1 = sv[0][1] * sv[1][1];
#pragma unroll
            for (int ai = 0; ai < 2; ++ai)
#pragma unroll
                for (int m = 0; m < 4; ++m) { const float r = rp[ai * HALF + m * 16], r2 = r * r;
                    st16(Z, off0 + (unsigned)((ai * HALF + m * 16) * D) * 2u, pack8(acc[ai][0][m][0] * acc[ai][1][m][0] * (sz0 * r2), acc[ai][0][m][1] * acc[ai][1][m][1] * (sz1 * r2))); }
        }
    }
};
struct EpiResid {
    __device__ __forceinline__ void dma(const Unit&, PG8_LAS unsigned char*, int, int) const {}
    const bf16_t* X; bf16_t* Yp;
    __device__ __forceinline__ void operator()(const f32x4 (&acc)[2][2][4][2], const Unit& u, int wr, int wc, int fr_, int fq_, const PG8_LAS unsigned char* xl) const {
        int fr = fr_, fq = fq_; asm volatile("" : "+v"(fr), "+v"(fq));
        const unsigned off0 = (unsigned)((u.pm * BM + wr * 64 + fr) * D + u.pn * BM + wc * 32 + 8 * fq) * 2u;
#pragma unroll
        for (int ai = 0; ai < 2; ++ai)
#pragma unroll
            for (int m = 0; m < 4; ++m)
#pragma unroll
                for (int bj = 0; bj < 2; ++bj) { const unsigned off = off0 + (unsigned)((ai * HALF + m * 16) * D + bj * HALF) * 2u; const v4u xr = *(const v4u*)((const char*)X + off);
                    f32x4 v0 = acc[ai][bj][m][0], v1 = acc[ai][bj][m][1];
                    v0[0] += ALPHA * bf_lo(xr.x); v0[1] += ALPHA * bf_hi(xr.x); v0[2] += ALPHA * bf_lo(xr.y); v0[3] += ALPHA * bf_hi(xr.y);
                    v1[0] += ALPHA * bf_lo(xr.z); v1[1] += ALPHA * bf_hi(xr.z); v1[2] += ALPHA * bf_lo(xr.w); v1[3] += ALPHA * bf_hi(xr.w);
                    st16(Yp, off, pack8(v0, v1)); }
    }
};
template <bool ROWS> struct EpiResid8 {
    const bf16_t* X; bf16_t* Yp; const float* sw; const float* rs; float rsc;
    __device__ __forceinline__ void dma(const Unit& u, PG8_LAS unsigned char* xl, int wid, int lane) const {
        if (wid == 0) dma1k(sw + u.pn * BM, xl, lane); else if (ROWS && wid == 1) dma1k(rs + u.pm * BM, xl + 1024, lane);
    }
    __device__ __forceinline__ void operator()(const f32x4 (&acc)[2][2][4][2], const Unit& u, int wr, int wc, int fr_, int fq_, const PG8_LAS unsigned char* xl) const {
        int fr = fr_, fq = fq_; asm volatile("" : "+v"(fr), "+v"(fq));
        const int cl = wc * 32 + 8 * fq;
        const unsigned off0 = (unsigned)((u.pm * BM + wr * 64 + fr) * D + u.pn * BM + cl) * 2u;
        const PG8_LAS float* sp = (const PG8_LAS float*)xl + cl; const PG8_LAS float* rp = (const PG8_LAS float*)(xl + 1024) + wr * 64 + fr;
        f32x4 sv[2][2];
#pragma unroll
        for (int bj = 0; bj < 2; ++bj)
#pragma unroll
            for (int n = 0; n < 2; ++n) sv[bj][n] = *(const PG8_LAS f32x4*)(sp + bj * HALF + 4 * n) * (ROWS ? 1.0f : rsc);
#pragma unroll
        for (int ai = 0; ai < 2; ++ai)
#pragma unroll
            for (int m = 0; m < 4; ++m) { float r = 1.0f; if (ROWS) r = rp[ai * HALF + m * 16];
#pragma unroll
                for (int bj = 0; bj < 2; ++bj) { const unsigned off = off0 + (unsigned)((ai * HALF + m * 16) * D + bj * HALF) * 2u; const v4u xr = *(const v4u*)((const char*)X + off);
                    f32x4 v0 = acc[ai][bj][m][0] * sv[bj][0], v1 = acc[ai][bj][m][1] * sv[bj][1]; if (ROWS) { v0 *= r; v1 *= r; }
                    v0[0] += ALPHA * bf_lo(xr.x); v0[1] += ALPHA * bf_hi(xr.x); v0[2] += ALPHA * bf_lo(xr.y); v0[3] += ALPHA * bf_hi(xr.y);
                    v1[0] += ALPHA * bf_lo(xr.z); v1[1] += ALPHA * bf_hi(xr.z); v1[2] += ALPHA * bf_lo(xr.w); v1[3] += ALPHA * bf_hi(xr.w);
                    st16(Yp, off, pack8(v0, v1)); } }
    }
};
__device__ __forceinline__ unsigned pk4_fp8(float a, float b, float c, float d) { int p = 0; p = __builtin_amdgcn_cvt_pk_fp8_f32(a, b, p, false); p = __builtin_amdgcn_cvt_pk_fp8_f32(c, d, p, true); return (unsigned)p; }
__device__ __forceinline__ unsigned pk4_i8(float a, float b, float c, float d) {
    unsigned r = 0;
    r = __builtin_amdgcn_cvt_pk_u8_f32(__builtin_rintf(a + 128.f), 0, r); r = __builtin_amdgcn_cvt_pk_u8_f32(__builtin_rintf(b + 128.f), 1, r);
    r = __builtin_amdgcn_cvt_pk_u8_f32(__builtin_rintf(c + 128.f), 2, r); r = __builtin_amdgcn_cvt_pk_u8_f32(__builtin_rintf(d + 128.f), 3, r);
    return r ^ 0x80808080u;
}
template <bool I8> __device__ __forceinline__ unsigned pkq4(float a, float b, float c, float d) { if constexpr (I8) return pk4_i8(a, b, c, d); else return pk4_fp8(a, b, c, d); }
__device__ __forceinline__ f32x2 swiglu8_pk(f32x2 g, f32x2 l8) {
    g.x = fminf(g.x, 7.0f); g.y = fminf(g.y, 7.0f);
    l8.x = fminf(fmaxf(l8.x, -56.0f), 56.0f); l8.y = fminf(fmaxf(l8.y, -56.0f), 56.0f);
    const f32x2 t = g * (-1.702f * LOG2E);
    f32x2 e; e.x = __builtin_amdgcn_exp2f(t.x); e.y = __builtin_amdgcn_exp2f(t.y);
    const f32x2 d = e + 1.0f;
    f32x2 r; r.x = __builtin_amdgcn_rcpf(d.x); r.y = __builtin_amdgcn_rcpf(d.y);
    return (g * r) * (l8 + A2SCALE);
}
struct EpiMoe1 {
    unsigned char* A2; const float* b1; const float* sw; float inv_sa;
    __device__ __forceinline__ void dma(const Unit& u, PG8_LAS unsigned char* xl, int wid, int lane) const {
        if (wid == 0) dma1k(b1 + (size_t)u.e * 2048 + u.pn * BM, xl, lane); else if (wid == 1) dma1k(sw + (size_t)u.e * 2048 + u.pn * BM, xl + 1024, lane);
    }
    __device__ __forceinline__ void operator()(const f32x4 (&acc)[2][2][4][2], const Unit& u, int wr, int wc, int fr_, int fq_, const PG8_LAS unsigned char* xl) const {
        int fr = fr_, fq = fq_; asm volatile("" : "+v"(fr), "+v"(fq));
        const int cl = wc * 32 + 8 * fq; const unsigned off0 = (unsigned)((u.pm * BM + wr * 64 + fr) * D + u.pn * HALF + cl);
        const PG8_LAS float* bp = (const PG8_LAS float*)xl + 2 * cl; f32x4 bb[4];
#pragma unroll
        for (int j = 0; j < 4; ++j) bb[j] = *(const PG8_LAS f32x4*)(bp + 4 * j);
        const PG8_LAS float* sp = (const PG8_LAS float*)(xl + 1024) + cl;
        const f32x4 sg0 = *(const PG8_LAS f32x4*)(sp) * inv_sa, sg1 = *(const PG8_LAS f32x4*)(sp + 4) * inv_sa;
        const f32x4 sl0 = *(const PG8_LAS f32x4*)(sp + HALF) * (inv_sa * A2SCALE), sl1 = *(const PG8_LAS f32x4*)(sp + HALF + 4) * (inv_sa * A2SCALE);
        f32x2 sgp[4] = {{sg0[0], sg0[1]}, {sg0[2], sg0[3]}, {sg1[0], sg1[1]}, {sg1[2], sg1[3]}}, slp[4] = {{sl0[0], sl0[1]}, {sl0[2], sl0[3]}, {sl1[0], sl1[1]}, {sl1[2], sl1[3]}};
        f32x2 bgp[4], blp[4];
#pragma unroll
        for (int q = 0; q < 4; ++q) { bgp[q] = (f32x2){bb[q][0], bb[q][2]}; blp[q] = (f32x2){bb[q][1] * A2SCALE, bb[q][3] * A2SCALE}; }
        const unsigned offp = off0 + ((fq & 1) ? (unsigned)(16 * D - 8) : 0u);
#pragma unroll
        for (int ai = 0; ai < 2; ++ai)
#pragma unroll
            for (int mp = 0; mp < 2; ++mp) { typedef unsigned u32x2 __attribute__((ext_vector_type(2))); u32x2 w[2];
#pragma unroll
                for (int mm = 0; mm < 2; ++mm) { const int m = 2 * mp + mm; f32x2 o[4];
#pragma unroll
                    for (int q = 0; q < 4; ++q) { const f32x4 ga = acc[ai][0][m][q >> 1], la = acc[ai][1][m][q >> 1]; const int h2 = (q & 1) * 2;
                        const f32x2 g = (f32x2){ga[h2], ga[h2 + 1]} * sgp[q] + bgp[q], l8 = (f32x2){la[h2], la[h2 + 1]} * slp[q] + blp[q];
                        o[q] = swiglu8_pk(g, l8); }
                    w[mm].x = pk4_fp8(o[0].x, o[0].y, o[1].x, o[1].y); w[mm].y = pk4_fp8(o[2].x, o[2].y, o[3].x, o[3].y); }
                const auto sx = __builtin_amdgcn_permlane16_swap(w[0].x, w[1].x, false, false); const auto sy = __builtin_amdgcn_permlane16_swap(w[0].y, w[1].y, false, false);
                const v4u ov = {sx[0], sy[0], sx[1], sy[1]};
                *(v4u*)(A2 + (offp + (unsigned)((ai * HALF + mp * 32) * D))) = ov; }
    }
};
struct EpiMoe2 {
    unsigned char* Y; const float* b2; const float* sw; const int* lslot; const float* lgate;
    __device__ __forceinline__ void dma(const Unit& u, PG8_LAS unsigned char* xl, int wid, int lane) const {
        const size_t lb = (size_t)u.e * LCAP + u.lr0;
        if (wid == 0) dma1k(b2 + (size_t)u.e * 1024 + u.pn * BM, xl, lane); else if (wid == 1) dma1k(sw + (size_t)u.e * 1024 + u.pn * BM, xl + 1024, lane);
        else if (wid == 2) dma1k(lslot + lb, xl + 2048, lane); else if (wid == 3) dma1k(lgate + lb, xl + 3072, lane);
    }
    __device__ __forceinline__ void operator()(const f32x4 (&acc)[2][2][4][2], const Unit& u, int wr, int wc, int fr_, int fq_, const PG8_LAS unsigned char* xl) const {
        int fr = fr_, fq = fq_; asm volatile("" : "+v"(fr), "+v"(fq));
        const int rl0 = wr * 64 + fr, cl = wc * 32 + 8 * fq, col0 = u.pn * BM + cl;
        const PG8_LAS float* bp = (const PG8_LAS float*)xl + cl; const PG8_LAS float* sp = (const PG8_LAS float*)(xl + 1024) + cl; f32x4 bv[2][2], sv[2][2];
#pragma unroll
        for (int bj = 0; bj < 2; ++bj)
#pragma unroll
            for (int n = 0; n < 2; ++n) { bv[bj][n] = *(const PG8_LAS f32x4*)(bp + bj * HALF + 4 * n); sv[bj][n] = *(const PG8_LAS f32x4*)(sp + bj * HALF + 4 * n) * (1.0f / (A2SCALE * KREP_MOE_)); }
        const PG8_LAS int* sl = (const PG8_LAS int*)(xl + 2048); const PG8_LAS float* gl = (const PG8_LAS float*)(xl + 3072);
        const unsigned cadj = (unsigned)(u.pn * BM + ((fq & 1) ? (HALF + cl - 8) : cl));
#pragma unroll
        for (int ai = 0; ai < 2; ++ai)
#pragma unroll
            for (int m = 0; m < 4; ++m) { const int rl = rl0 + ai * HALF + m * 16;
                const bool ok = rl < u.valid; const int slot = ok ? sl[rl] : M * 4; const float g = gl[rl] * YSCALE;
                typedef unsigned u32x2 __attribute__((ext_vector_type(2))); u32x2 w[2];
#pragma unroll
                for (int bj = 0; bj < 2; ++bj) { f32x4 v0 = (acc[ai][bj][m][0] * sv[bj][0] + bv[bj][0]) * g, v1 = (acc[ai][bj][m][1] * sv[bj][1] + bv[bj][1]) * g;
#pragma unroll
                    for (int i = 0; i < 4; ++i) { v0[i] = fminf(fmaxf(v0[i], -448.0f), 448.0f); v1[i] = fminf(fmaxf(v1[i], -448.0f), 448.0f); }
                    w[bj].x = pk4_fp8(v0[0], v0[1], v0[2], v0[3]); w[bj].y = pk4_fp8(v1[0], v1[1], v1[2], v1[3]); }
                const auto sx = __builtin_amdgcn_permlane16_swap(w[0].x, w[1].x, false, false); const auto sy = __builtin_amdgcn_permlane16_swap(w[0].y, w[1].y, false, false);
                const v4u o = {sx[0], sy[0], sx[1], sy[1]};
                *(v4u*)(Y + ((unsigned)(slot * D) + cadj)) = o; }
    }
};

typedef int v8i_t __attribute__((ext_vector_type(8))); typedef int v4i_t __attribute__((ext_vector_type(4)));
__device__ __forceinline__ v8i_t cat8(bf16x8 lo, bf16x8 hi) { const v4i_t a = __builtin_bit_cast(v4i_t, lo), b = __builtin_bit_cast(v4i_t, hi); return __builtin_shufflevector(a, b, 0, 1, 2, 3, 4, 5, 6, 7); }
template <class Prob, class Epi, bool ALIGN_EPI, bool F8 = false, int KREP = 1, bool I8 = false>
__device__ __forceinline__ void gemm_phase(PG8_LAS unsigned char* lds, PG8_LAS unsigned char* xl, const Prob& P, const Epi& E) {
    int tid_ = P.tid; asm volatile("" : "+v"(tid_));
    const int tid = tid_, wid = __builtin_amdgcn_readfirstlane(tid >> 6), lane = tid & 63, wr = wid >> 2, wc = wid & 3, fr = lane & 15, fq = lane >> 4;
    constexpr int RP = F8 ? 1024 : 2048, nt = F8 ? 8 : NTK;
    constexpr bool GA = Prob::GATHER;
    int RA[2], CA[2]; unsigned voffB[2], voffA[2];
#pragma unroll
    for (int i = 0; i < 2; ++i) { int R, C; stage_rc(tid * 16 + i * 8192, R, C); const int Rb = (R & ~31) + perm32(R & 31); RA[i] = R; CA[i] = C; voffB[i] = (unsigned)(Rb * RP + C * 2); voffA[i] = (unsigned)(R * RP + C * 2); }
    constexpr unsigned kstep = (unsigned)(BK * 2);
    constexpr unsigned hstep = (unsigned)HALF * RP;
    const unsigned ldsw = (unsigned)wid * 1024u;
    const int aoff = lds_byte(wr * 64 + fr, fq * 8), boff = lds_byte(wc * 32 + fr, fq * 8);
    typedef const __attribute__((address_space(1))) unsigned* gptr_t;
#define PG8_SA(b, h) (((b) * 2 + (h)) * HTB)
#define PG8_SB(b, h) ((4 + (b) * 2 + (h)) * HTB)
#define PG8_STAGE_B(bufoff, uoff) do { _Pragma("unroll") for (int _i = 0; _i < 2; ++_i) \
        __builtin_amdgcn_global_load_lds((gptr_t)(Bb + (voffB[_i] + (unsigned)(uoff))), (PG8_LAS unsigned*)(lds + (bufoff) + ldsw + _i * 8192), 16, 0, 0); } while (0)
#define PG8_STAGE_A(bufoff, koff, h, NX) do { _Pragma("unroll") for (int _i = 0; _i < 2; ++_i) { unsigned _o; \
        if constexpr (GA) _o = ((NX) ? vn[h][_i] : vc[h][_i]) + (unsigned)(koff); else _o = voffA[_i] + (((NX) ? nAo : cAo) + (unsigned)(h) * hstep + (unsigned)(koff)); \
        __builtin_amdgcn_global_load_lds((gptr_t)(Ab + _o), (PG8_LAS unsigned*)(lds + (bufoff) + ldsw + _i * 8192), 16, 0, 0); } } while (0)
#define PG8_LDA(dst, b, h) do { _Pragma("unroll") for (int m = 0; m < 4; ++m) _Pragma("unroll") for (int k = 0; k < 2; ++k) dst[m][k] = *(const PG8_LAS bf16x8*)(lds + PG8_SA(b, h) + aoff + m * 2048 + k * 1024); } while (0)
#define PG8_LDB(dst, b, h) do { _Pragma("unroll") for (int n = 0; n < 2; ++n) _Pragma("unroll") for (int k = 0; k < 2; ++k) dst[n][k] = *(const PG8_LAS bf16x8*)(lds + PG8_SB(b, h) + boff + n * 2048 + k * 1024); } while (0)
#define PG8_MMA(ai, bj, At, Bt) do { __builtin_amdgcn_s_setprio(1); _Pragma("unroll") for (int m = 0; m < 4; ++m) _Pragma("unroll") for (int n = 0; n < 2; ++n) _Pragma("unroll") for (int k = 0; k < 2; ++k) \
        acc[ai][bj][m][n] = __builtin_amdgcn_mfma_f32_16x16x32_bf16(Bt[n][k], At[m][k], acc[ai][bj][m][n], 0, 0, 0); __builtin_amdgcn_s_setprio(0); } while (0)
#define PG8_MMA8(ai, bj, At, Bt) do { __builtin_amdgcn_s_setprio(1); if constexpr (I8) { _Pragma("unroll") for (int k = 0; k < 2; ++k) _Pragma("unroll") for (int m = 0; m < 4; ++m) _Pragma("unroll") for (int n = 0; n < 2; ++n) \
        asm volatile("v_mfma_i32_16x16x64_i8 %0, %1, %2, %0" : "+v"(acc[ai][bj][m][n]) : "v"(Bt[n][k]), "v"(At[m][k])); } else { _Pragma("unroll") for (int m = 0; m < 4; ++m) _Pragma("unroll") for (int n = 0; n < 2; ++n) \
        asm volatile("v_mfma_f32_16x16x128_f8f6f4 %0, %1, %2, %0" : "+v"(acc[ai][bj][m][n]) : "v"(cat8(Bt[n][0], Bt[n][1])), "v"(cat8(At[m][0], At[m][1]))); } __builtin_amdgcn_s_setprio(0); } while (0)
#define PG8_MMA8Z(ai, bj, At, Bt) do { __builtin_amdgcn_s_setprio(1); if constexpr (I8) { _Pragma("unroll") for (int m = 0; m < 4; ++m) _Pragma("unroll") for (int n = 0; n < 2; ++n) \
        asm volatile("v_mfma_i32_16x16x64_i8 %0, %1, %2, 0" : "=&v"(acc[ai][bj][m][n]) : "v"(Bt[n][0]), "v"(At[m][0])); _Pragma("unroll") for (int m = 0; m < 4; ++m) _Pragma("unroll") for (int n = 0; n < 2; ++n) \
        asm volatile("v_mfma_i32_16x16x64_i8 %0, %1, %2, %0" : "+v"(acc[ai][bj][m][n]) : "v"(Bt[n][1]), "v"(At[m][1])); } else { _Pragma("unroll") for (int m = 0; m < 4; ++m) _Pragma("unroll") for (int n = 0; n < 2; ++n) \
        asm volatile("v_mfma_f32_16x16x128_f8f6f4 %0, %1, %2, 0" : "=&v"(acc[ai][bj][m][n]) : "v"(cat8(Bt[n][0], Bt[n][1])), "v"(cat8(At[m][0], At[m][1]))); } __builtin_amdgcn_s_setprio(0); } while (0)
#define PG8_MM(ai, bj, At, Bt) do { if constexpr (F8) PG8_MMA8(ai, bj, At, Bt); else PG8_MMA(ai, bj, At, Bt); } while (0)
#define PG8_MM2(FIRST, ai, At) do { if constexpr (F8) { if (FIRST) { PG8_MMA8Z(ai, 0, At, B0); PG8_MMA8Z(ai, 1, At, B1); } else { PG8_MMA8(ai, 0, At, B0); PG8_MMA8(ai, 1, At, B1); } } else { PG8_MMA(ai, 0, At, B0); PG8_MMA(ai, 1, At, B1); } } while (0)
#define PG8_WAIT_V(n) asm volatile("s_waitcnt vmcnt(" #n ")" ::: "memory")
#define PG8_WAIT_L(n) asm volatile("s_waitcnt lgkmcnt(" #n ")" ::: "memory")
#define PG8_BAR __builtin_amdgcn_s_barrier()
#define PG8_SCHED __builtin_amdgcn_sched_barrier(0)
    Unit cur, nxt; int ui = 0;
    if (!P.next(0, cur)) return;
    f32x4 acc[2][2][4][2];
    if constexpr (!F8) {
#pragma unroll
    for (int a = 0; a < 2; ++a)
#pragma unroll
        for (int b = 0; b < 2; ++b)
#pragma unroll
            for (int m = 0; m < 4; ++m)
#pragma unroll
                for (int n = 0; n < 2; ++n) acc[a][b][m][n] = (f32x4){0.f, 0.f, 0.f, 0.f};
    }
    bf16x8 At[4][2], B0[2][2], B1[2][2];
    unsigned vc[2][2], vn[2][2]; unsigned cAo = 0, nAo = 0;
    if constexpr (GA) { P.a_off(cur, RA, CA, vc); vn[0][0] = vc[0][0]; vn[0][1] = vc[0][1]; vn[1][0] = vc[1][0]; vn[1][1] = vc[1][1]; } else { cAo = P.a_tile(cur); nAo = cAo; vc[0][0] = vn[0][0] = 0; }
    const char* const Ab = P.A; const char* const Bb = P.Bt; unsigned cBo = P.b_off(cur), nBo = cBo;
    PG8_STAGE_B(PG8_SB(0, 0), cBo); PG8_STAGE_B(PG8_SB(0, 1), cBo + hstep); PG8_STAGE_A(PG8_SA(0, 0), 0u, 0, false); PG8_STAGE_A(PG8_SA(0, 1), 0u, 1, false);
    if (wr == 1) PG8_BAR;
    PG8_WAIT_V(2); PG8_BAR;
    PG8_STAGE_B(PG8_SB(1, 0), cBo + kstep); PG8_STAGE_A(PG8_SA(1, 0), kstep, 0, false); PG8_STAGE_B(PG8_SB(1, 1), cBo + hstep + kstep);
    PG8_WAIT_V(6); PG8_BAR;
    for (;;) {
        const bool has_next = P.next(ui + 1, nxt);
        PG8_LAS unsigned char* const xe = xl + (ui & 1) * XL_EPI;
        PG8_LAS unsigned char* const xg = xl + 2 * XL_EPI + ((ui + 1) & 1) * XL_GATHER;
        E.dma(cur, xe, wid, lane);
        if (has_next) { if constexpr (GA) P.dma_rows(nxt, xg, wid, lane); else nAo = P.a_tile(nxt); nBo = P.b_off(nxt); }
        else { nAo = cAo; nBo = cBo; }
#pragma unroll 1
        for (int rep = 0; rep < KREP; ++rep)
#pragma unroll 1
        for (int t = 0; t < nt; t += 2) {
            const bool lastt = (t == nt - 2); const bool last = lastt && (rep == KREP - 1); const bool first = (t == 0) && (rep == 0); (void)first;
            if constexpr (GA) { if (last) { if (has_next) P.a_off_lds(nxt, RA, CA, xg, vn); else { vn[0][0] = vc[0][0]; vn[0][1] = vc[0][1]; vn[1][0] = vc[1][0]; vn[1][1] = vc[1][1]; } } }
            const unsigned k1 = (unsigned)(t + 1) * kstep;
            const unsigned k2 = lastt ? 0u : (unsigned)(t + 2) * kstep, k3 = k2 + kstep;
            const unsigned b2 = (last ? nBo : cBo) + k2, b3 = b2 + kstep;
            PG8_LDB(B0, 0, 0); PG8_LDB(B1, 0, 1); PG8_SCHED; PG8_LDA(At, 0, 0); PG8_STAGE_A(PG8_SA(1, 1), k1, 1, false);
            PG8_WAIT_V(8); PG8_WAIT_L(0); PG8_BAR; PG8_MM2(first, 0, At); PG8_BAR; PG8_SCHED;
            PG8_LDA(At, 0, 1); PG8_STAGE_B(PG8_SB(0, 0), b2); PG8_STAGE_B(PG8_SB(0, 1), b2 + hstep); PG8_STAGE_A(PG8_SA(0, 0), k2, 0, last);
            PG8_WAIT_V(8); PG8_WAIT_L(0); PG8_BAR; PG8_MM2(first, 1, At); PG8_BAR; PG8_SCHED;
            PG8_LDB(B0, 1, 0); PG8_LDB(B1, 1, 1); PG8_SCHED; PG8_LDA(At, 1, 0); PG8_STAGE_A(PG8_SA(0, 1), k2, 1, last);
            PG8_WAIT_V(8); PG8_WAIT_L(0); PG8_BAR; PG8_MM(0, 0, At, B0); PG8_MM(0, 1, At, B1); PG8_BAR; PG8_SCHED;
            PG8_LDA(At, 1, 1); PG8_STAGE_B(PG8_SB(1, 0), b3); PG8_STAGE_B(PG8_SB(1, 1), b3 + hstep); PG8_STAGE_A(PG8_SA(1, 0), k3, 0, last);
            PG8_WAIT_V(8); PG8_WAIT_L(0); PG8_BAR; PG8_MM(1, 0, At, B0); PG8_MM(1, 1, At, B1); PG8_BAR; PG8_SCHED;
        }
        if constexpr (ALIGN_EPI) { if (wr == 0) PG8_BAR; }
        if constexpr (F8) asm volatile("s_nop 15\n\ts_nop 7" ::: "memory");
        if constexpr (I8) {
#pragma unroll
            for (int a = 0; a < 2; ++a)
#pragma unroll
                for (int b = 0; b < 2; ++b)
#pragma unroll
                    for (int m = 0; m < 4; ++m)
#pragma unroll
                        for (int n = 0; n < 2; ++n)
#pragma unroll
                            for (int i = 0; i < 4; ++i) acc[a][b][m][n][i] = (float)__float_as_int(acc[a][b][m][n][i]);
        }
        E(acc, cur, wr, wc, fr, fq, xe);
        if (!has_next) break;
        if constexpr (!F8)
#pragma unroll
        for (int a = 0; a < 2; ++a)
#pragma unroll
            for (int b = 0; b < 2; ++b)
#pragma unroll
                for (int m = 0; m < 4; ++m)
#pragma unroll
                    for (int n = 0; n < 2; ++n) acc[a][b][m][n] = (f32x4){0.f, 0.f, 0.f, 0.f};
        cur = nxt; cBo = nBo; cAo = nAo; ++ui;
        if constexpr (GA) { vc[0][0] = vn[0][0]; vc[0][1] = vn[0][1]; vc[1][0] = vn[1][0]; vc[1][1] = vn[1][1]; }
        if constexpr (ALIGN_EPI) { if (wr == 1) PG8_BAR; }
    }
    PG8_WAIT_V(0);
    if constexpr (!ALIGN_EPI) { if (wr == 0) PG8_BAR; }
    PG8_BAR;
#undef PG8_SA
#undef PG8_SB
#undef PG8_STAGE_A
#undef PG8_STAGE_B
#undef PG8_LDA
#undef PG8_LDB
#undef PG8_MMA
#undef PG8_MMA8
#undef PG8_MM
#undef PG8_MM2
#undef PG8_MMA8Z
#undef PG8_WAIT_V
#undef PG8_WAIT_L
#undef PG8_BAR
#undef PG8_SCHED
}
}

namespace att {
constexpr int QBLK = 32, KVBLK = 64, LDX = 1024, NT = SEQ / KVBLK;
constexpr int SHM_V = KVBLK * 128 * 2, SHM_K = KVBLK * 128 * 2, NSLOT = 3;
constexpr int OFF_V = 0, OFF_K = NSLOT * SHM_V, OFF_WS = NSLOT * (SHM_V + SHM_K), OFF_TBL = OFF_WS + 8 * 64 * 4, ATT_LDS = OFF_TBL + 2048;
constexpr float THR2 = 8.0f * LOG2E;
#define KSWZ(row, colB) ((row) * 256 + ((colB) ^ (((row) & 7) << 4)))
#define SBAR() __builtin_amdgcn_sched_barrier(0)
__device__ __forceinline__ int crow(int r, int hi) { return (r & 3) + 8 * (r >> 2) + 4 * hi; }
__device__ __forceinline__ int v_st(int k, int c) { const int kk = (k & ~0xC) | ((k & 4) << 1) | ((k & 8) >> 1); return ((kk >> 3) * 4 + (c >> 5)) * 512 + ((kk & 7) * 32 + (c & 31)) * 2; }
__device__ __forceinline__ int v_rd_base(int lane) { return ((lane & 3) << 3) | (((lane >> 2) & 3) << 6) | (((lane >> 4) & 1) << 5) | (((lane >> 5) & 1) << 8); }
constexpr int v_rd_off(int d0, int ks, int half) { return d0 * 512 + ks * 4096 + half * 2048; }
template <int OFF> __device__ __forceinline__ s16x4 tr_read(int vb) { s16x4 r; asm volatile("ds_read_b64_tr_b16 %0, %1 offset:%2" : "=&v"(r) : "v"(vb), "i"(OFF) : "memory"); return r; }
#define ATT_RD8(L, H, D0) do { \
    asm volatile("ds_read_b64_tr_b16 %0, %1 offset:%2" : "=&v"(L[0]) : "v"(vb), "i"(v_rd_off(D0, 0, 0)) : "memory"); asm volatile("ds_read_b64_tr_b16 %0, %1 offset:%2" : "=&v"(H[0]) : "v"(vb), "i"(v_rd_off(D0, 0, 1)) : "memory"); \
    asm volatile("ds_read_b64_tr_b16 %0, %1 offset:%2" : "=&v"(L[1]) : "v"(vb), "i"(v_rd_off(D0, 1, 0)) : "memory"); asm volatile("ds_read_b64_tr_b16 %0, %1 offset:%2" : "=&v"(H[1]) : "v"(vb), "i"(v_rd_off(D0, 1, 1)) : "memory"); \
    asm volatile("ds_read_b64_tr_b16 %0, %1 offset:%2" : "=&v"(L[2]) : "v"(vb), "i"(v_rd_off(D0, 2, 0)) : "memory"); asm volatile("ds_read_b64_tr_b16 %0, %1 offset:%2" : "=&v"(H[2]) : "v"(vb), "i"(v_rd_off(D0, 2, 1)) : "memory"); \
    asm volatile("ds_read_b64_tr_b16 %0, %1 offset:%2" : "=&v"(L[3]) : "v"(vb), "i"(v_rd_off(D0, 3, 0)) : "memory"); asm volatile("ds_read_b64_tr_b16 %0, %1 offset:%2" : "=&v"(H[3]) : "v"(vb), "i"(v_rd_off(D0, 3, 1)) : "memory"); } while (0)
#define ATT_PK(L, H) (bf16x8){L[0], L[1], L[2], L[3], H[0], H[1], H[2], H[3]}
#define ATT_MM4(OD, L, H) do { OD = __builtin_amdgcn_mfma_f32_32x32x16_bf16(pa0, ATT_PK(L[0], H[0]), OD, 0, 0, 0); OD = __builtin_amdgcn_mfma_f32_32x32x16_bf16(pa1, ATT_PK(L[1], H[1]), OD, 0, 0, 0); \
    OD = __builtin_amdgcn_mfma_f32_32x32x16_bf16(pa2, ATT_PK(L[2], H[2]), OD, 0, 0, 0); OD = __builtin_amdgcn_mfma_f32_32x32x16_bf16(pa3, ATT_PK(L[3], H[3]), OD, 0, 0, 0); } while (0)
__device__ __forceinline__ void pv_d0(f32x16* o, int vb, bf16x8 pa0, bf16x8 pa1, bf16x8 pa2, bf16x8 pa3) {
  s16x4 la[4], ha[4], lb[4], hb[4];
  ATT_RD8(la, ha, 0); ATT_RD8(lb, hb, 1);
  asm volatile("s_waitcnt lgkmcnt(8)" ::: "memory"); SBAR(); ATT_MM4(o[0], la, ha); SBAR();
  ATT_RD8(la, ha, 2);
  asm volatile("s_waitcnt lgkmcnt(8)" ::: "memory"); SBAR(); ATT_MM4(o[1], lb, hb); SBAR();
  ATT_RD8(lb, hb, 3);
  asm volatile("s_waitcnt lgkmcnt(8)" ::: "memory"); SBAR(); ATT_MM4(o[2], la, ha); SBAR();
  asm volatile("s_waitcnt lgkmcnt(0)" ::: "memory"); SBAR(); ATT_MM4(o[3], lb, hb);
  const bf16x8 ones = {(short)0x3F80, (short)0x3F80, (short)0x3F80, (short)0x3F80, (short)0x3F80, (short)0x3F80, (short)0x3F80, (short)0x3F80};
  o[4] = __builtin_amdgcn_mfma_f32_32x32x16_bf16(pa0, ones, o[4], 0, 0, 0); o[4] = __builtin_amdgcn_mfma_f32_32x32x16_bf16(pa1, ones, o[4], 0, 0, 0);
  o[4] = __builtin_amdgcn_mfma_f32_32x32x16_bf16(pa2, ones, o[4], 0, 0, 0); o[4] = __builtin_amdgcn_mfma_f32_32x32x16_bf16(pa3, ones, o[4], 0, 0, 0);
}
__device__ __forceinline__ void pv_softmax(f32x16* o, int vb, bf16x8 pa0, bf16x8 pa1, bf16x8 pa2, bf16x8 pa3, f32x16& p0, f32x16& p1, float& m_reg, float& alpha, bool& resc) {
  s16x4 la[4], ha[4], lb[4], hb[4];
  ATT_RD8(la, ha, 0); ATT_RD8(lb, hb, 1);
  asm volatile("s_waitcnt lgkmcnt(8)" ::: "memory"); SBAR();
  float a = fmaxf(fmaxf(p0[0], p0[1]), p1[0]), b = fmaxf(fmaxf(p0[2], p0[3]), p1[1]); a = fmaxf(fmaxf(a, p1[2]), p1[3]);
#pragma unroll
  for (int r = 4; r < 16; r += 4) { a = fmaxf(fmaxf(a, p0[r]), p0[r + 1]); b = fmaxf(fmaxf(b, p0[r + 2]), p0[r + 3]); a = fmaxf(fmaxf(a, p1[r]), p1[r + 1]); b = fmaxf(fmaxf(b, p1[r + 2]), p1[r + 3]); }
  float pmax = fmaxf(a, b);
  ATT_MM4(o[0], la, ha); SBAR();
  ATT_RD8(la, ha, 2);
  asm volatile("s_waitcnt lgkmcnt(8)" ::: "memory"); SBAR();
  { auto rr = __builtin_amdgcn_permlane32_swap(__float_as_uint(pmax), __float_as_uint(pmax), false, false);
    pmax = fmaxf(__uint_as_float(rr[0]), __uint_as_float(rr[1])); }
  resc = false; alpha = 1.f;
  if (__builtin_expect(!__all(pmax <= THR2), 0)) { const float dl = fmaxf(pmax, 0.f); m_reg += dl; alpha = __builtin_amdgcn_exp2f(-dl); resc = true;
#pragma unroll
    for (int r = 0; r < 16; ++r) { p0[r] -= dl; p1[r] -= dl; } }
  ATT_MM4(o[1], lb, hb); SBAR();
  ATT_RD8(lb, hb, 3);
  asm volatile("s_waitcnt lgkmcnt(8)" ::: "memory"); SBAR();
#pragma unroll
  for (int r = 0; r < 16; ++r) p0[r] = __builtin_amdgcn_exp2f(p0[r]);
  ATT_MM4(o[2], la, ha); SBAR();
  asm volatile("s_waitcnt lgkmcnt(0)" ::: "memory"); SBAR();
#pragma unroll
  for (int r = 0; r < 16; ++r) p1[r] = __builtin_amdgcn_exp2f(p1[r]);
  ATT_MM4(o[3], lb, hb);
  const bf16x8 ones = {(short)0x3F80, (short)0x3F80, (short)0x3F80, (short)0x3F80, (short)0x3F80, (short)0x3F80, (short)0x3F80, (short)0x3F80};
  o[4] = __builtin_amdgcn_mfma_f32_32x32x16_bf16(pa0, ones, o[4], 0, 0, 0); o[4] = __builtin_amdgcn_mfma_f32_32x32x16_bf16(pa1, ones, o[4], 0, 0, 0);
  o[4] = __builtin_amdgcn_mfma_f32_32x32x16_bf16(pa2, ones, o[4], 0, 0, 0); o[4] = __builtin_amdgcn_mfma_f32_32x32x16_bf16(pa3, ones, o[4], 0, 0, 0);
}
__device__ __forceinline__ void near_bias(f32x16& p0, f32x16& p1, int dq, const float* tbl) {
#pragma unroll
  for (int r = 0; r < 16; ++r) { const int c0 = (r & 3) + 8 * (r >> 2); p0[r] += tbl[dq + c0]; p1[r] += tbl[dq + c0 + 32]; }
}
__device__ __forceinline__ void qkt(f32x16& p0, f32x16& p1, const char* Ks, const bf16x8* qr, int r32, int hi, int mapB) {
  bf16x8 k0[4], k1[4];
#pragma unroll
  for (int d0 = 0; d0 < 4; ++d0) { const int cb = mapB + (d0 * 16 + hi * 8) * 2;
    k0[d0] = *reinterpret_cast<const bf16x8*>(Ks + KSWZ(r32, cb)); k1[d0] = *reinterpret_cast<const bf16x8*>(Ks + KSWZ(32 + r32, cb)); }
  p0 = f32x16{}; p1 = f32x16{};
#pragma unroll
  for (int d0 = 0; d0 < 4; ++d0) {
    p0 = __builtin_amdgcn_mfma_f32_32x32x16_bf16(k0[d0], qr[d0], p0, 0, 0, 0);
    p1 = __builtin_amdgcn_mfma_f32_32x32x16_bf16(k1[d0], qr[d0], p1, 0, 0, 0); }
}
__device__ __forceinline__ void qkt_seed(f32x16& p0, f32x16& p1, const char* Ks, const bf16x8* qr, const int (&koff)[4], const f32x16& seed) {
#pragma unroll
  for (int d0 = 0; d0 < 4; ++d0) {
    const bf16x8 b0 = *reinterpret_cast<const bf16x8*>(Ks + koff[d0]);
    const bf16x8 b1 = *reinterpret_cast<const bf16x8*>(Ks + koff[d0] + 8192);
    if (d0 == 0) { p0 = __builtin_amdgcn_mfma_f32_32x32x16_bf16(b0, qr[0], seed, 0, 0, 0); p1 = __builtin_amdgcn_mfma_f32_32x32x16_bf16(b1, qr[0], seed, 0, 0, 0); }
    else { p0 = __builtin_amdgcn_mfma_f32_32x32x16_bf16(b0, qr[d0], p0, 0, 0, 0); p1 = __builtin_amdgcn_mfma_f32_32x32x16_bf16(b1, qr[d0], p1, 0, 0, 0); } }
}
__device__ __forceinline__ void partialSM_seeded(f32x16& p0, f32x16& p1, float& m_reg, float& alpha, bool& resc, int mode, int dq, const float* tbl) {
  if (mode == 0) {
#pragma unroll
    for (int r = 0; r < 16; ++r) { const int c0 = (r & 3) + 8 * (r >> 2);
      p0[r] += tbl[dq + c0]; p1[r] += tbl[dq + c0 + 32]; }
  }
  float a = fmaxf(fmaxf(p0[0], p0[1]), p1[0]), b = fmaxf(fmaxf(p0[2], p0[3]), p1[1]); a = fmaxf(fmaxf(a, p1[2]), p1[3]);
#pragma unroll
  for (int r = 4; r < 16; r += 4) { a = fmaxf(fmaxf(a, p0[r]), p0[r + 1]); b = fmaxf(fmaxf(b, p0[r + 2]), p0[r + 3]); a = fmaxf(fmaxf(a, p1[r]), p1[r + 1]); b = fmaxf(fmaxf(b, p1[r + 2]), p1[r + 3]); }
  float pmax = fmaxf(a, b);
  { auto rr = __builtin_amdgcn_permlane32_swap(__float_as_uint(pmax), __float_as_uint(pmax), false, false);
    pmax = fmaxf(__uint_as_float(rr[0]), __uint_as_float(rr[1])); }
  resc = false; alpha = 1.f;
  if (__builtin_expect(!__all(pmax <= THR2), 0)) { const float dl = fmaxf(pmax, 0.f); m_reg += dl; alpha = __builtin_amdgcn_exp2f(-dl); resc = true;
#pragma unroll
    for (int r = 0; r < 16; ++r) { p0[r] -= dl; p1[r] -= dl; } }
#pragma unroll
  for (int r = 0; r < 16; ++r) p0[r] = __builtin_amdgcn_exp2f(p0[r]);
}
__device__ __forceinline__ void partialSM(f32x16& p0, f32x16& p1, float& m_reg, float& mn, float& alpha, int mode, float cL, float cR, int dq, const float* tbl) {
  float cadd;
  if (mode == 0) {
#pragma unroll
    for (int r = 0; r < 16; ++r) { const int c0 = (r & 3) + 8 * (r >> 2);
      p0[r] += tbl[dq + c0]; p1[r] += tbl[dq + c0 + 32]; }
    cadd = 0.f;
  } else cadd = (mode < 0) ? cL : cR;
  float pmax = p0[0];
#pragma unroll
  for (int r = 1; r < 16; ++r) pmax = fmaxf(pmax, p0[r]);
#pragma unroll
  for (int r = 0; r < 16; ++r) pmax = fmaxf(pmax, p1[r]);
  { auto rr = __builtin_amdgcn_permlane32_swap(__float_as_uint(pmax), __float_as_uint(pmax), false, false);
    pmax = fmaxf(__uint_as_float(rr[0]), __uint_as_float(rr[1])); }
  pmax += cadd;
  if (__builtin_expect(__all(pmax - m_reg <= THR2), 1)) { mn = m_reg; alpha = 1.f; }
  else { mn = fmaxf(m_reg, pmax); alpha = __builtin_amdgcn_exp2f(m_reg - mn); m_reg = mn; }
  const float sh = cadd - mn;
#pragma unroll
  for (int r = 0; r < 16; ++r) p0[r] += sh;
#pragma unroll
  for (int r = 0; r < 16; ++r) p1[r] += sh;
#pragma unroll
  for (int r = 0; r < 16; ++r) p0[r] = __builtin_amdgcn_exp2f(p0[r]);
}
__device__ __forceinline__ void finishSM(f32x16& p0, f32x16& p1, bf16x8& pa0, bf16x8& pa1, bf16x8& pa2, bf16x8& pa3) {
#define PK8(P, BASE, OUT) do { v4u w = {cvt_pk_bf16(P[BASE + 0], P[BASE + 1]), cvt_pk_bf16(P[BASE + 2], P[BASE + 3]), cvt_pk_bf16(P[BASE + 4], P[BASE + 5]), cvt_pk_bf16(P[BASE + 6], P[BASE + 7])}; OUT = *reinterpret_cast<bf16x8*>(&w); } while (0)
  PK8(p0, 0, pa0); PK8(p0, 8, pa1); PK8(p1, 0, pa2); PK8(p1, 8, pa3);
#undef PK8
}
__device__ __forceinline__ int rel_bucket(int rel) {
  const int n = rel < 0 ? -rel : rel; int b;
  if (n < 8) b = n; else if (n < 12) b = 8; else if (n < 16) b = 9; else if (n < 23) b = 10; else if (n < 32) b = 11; else if (n < 46) b = 12; else if (n < 64) b = 13; else if (n < 91) b = 14; else b = 15;
  return (rel > 0 ? 16 : 0) + b;
}

__device__ __forceinline__ void attn_unit(int b, int h, int qb, const bf16_t* __restrict__ Q, const bf16_t* __restrict__ K, const bf16_t* __restrict__ V, bf16_t* __restrict__ O,
                                          float lam, float osc, const float* __restrict__ g, const float* __restrict__ rel_bias, char* lds, int tid_in, bool build_tbl, bool o8) {
  int tid_ = tid_in; asm volatile("" : "+v"(tid_));
  const int tid = tid_, wid = __builtin_amdgcn_readfirstlane(tid >> 6), lane = tid & 63, r32 = lane & 31, hi = lane >> 5;
  const int map = wid & 1, jq = wid >> 1;
  char* V_lds = lds + OFF_V; char* K_lds = lds + OFF_K;
  float* ws = (float*)(lds + OFF_WS) + wid * 64; float* li_l = ws; float* al_l = ws + 32;
  float* tbl = (float*)(lds + OFF_TBL);
  if (build_tbl) tbl[tid] = rel_bias[rel_bucket(tid - 256) * NH + h] * LOG2E;
  const float cL = rel_bias[15 * NH + h] * LOG2E, cR = rel_bias[31 * NH + h] * LOG2E;
  const long rowbase = (long)b * SEQ; const int qs = qb * 128 + jq * QBLK;
  float m_reg = -1e30f; f32x16 o[5] = {}; bf16x8 qr[4];
  const bf16_t* Qw = Q + (rowbase + qs + r32) * LDX + h * 128 + map * 64 + hi * 8;
#pragma unroll
  for (int d0 = 0; d0 < 4; ++d0) qr[d0] = *reinterpret_cast<const bf16x8*>(Qw + d0 * 16);
  const bf16_t* Kh = K + rowbase * LDX + h * 128; const bf16_t* Vh = V + rowbase * LDX + h * 128;
  const int vb0 = (int)(uintptr_t)V_lds + v_rd_base(lane);
  const int mapB = map * 128;
  int koff[4];
#pragma unroll
  for (int d0 = 0; d0 < 4; ++d0) koff[d0] = KSWZ(r32, mapB + (d0 * 16 + hi * 8) * 2);
  const int dq0 = 256 + 4 * hi - (qs + r32);
  unsigned ksrc[2], vsrc[2];
#pragma unroll
  for (int i = 0; i < 2; ++i) { const int pk = wid + 8 * i;
    const int krow = 4 * pk + (lane >> 4), kc = (lane & 15) ^ (krow & 7); ksrc[i] = (unsigned)(krow * (LDX * 2) + kc * 16);
    const int st = 2 * pk + (lane >> 5), kk = (st >> 2) * 8 + ((lane & 31) >> 2), vk = kk  , vc = (st & 3) * 32 + (lane & 3) * 8;
    vsrc[i] = (unsigned)(vk * (LDX * 2) + vc * 2); }
  typedef const __attribute__((address_space(1))) unsigned* gptr_t; typedef __attribute__((address_space(3))) unsigned* lptr_t;
  const char* const Kg = (const char*)Kh; const char* const Vg = (const char*)Vh;
  const lptr_t kdst = (lptr_t)(__attribute__((address_space(3))) char*)(K_lds) + 0; (void)kdst;
#define DMA_TILE(t, slot) do { const unsigned tb_ = (unsigned)(t) * (unsigned)(KVBLK * LDX * 2); \
    _Pragma("unroll") for (int i_ = 0; i_ < 2; ++i_) { \
      __builtin_amdgcn_global_load_lds((gptr_t)(Kg + (ksrc[i_] + tb_)), (lptr_t)((__attribute__((address_space(3))) char*)K_lds + (slot) + (wid + 8 * i_) * 1024), 16, 0, 0); \
      __builtin_amdgcn_global_load_lds((gptr_t)(Vg + (vsrc[i_] + tb_)), (lptr_t)((__attribute__((address_space(3))) char*)V_lds + (slot) + (wid + 8 * i_) * 1024), 16, 0, 0); } } while (0)
#define WAIT_BAR() do { asm volatile("s_waitcnt vmcnt(0) lgkmcnt(0)" ::: "memory"); __builtin_amdgcn_s_barrier(); asm volatile("" ::: "memory"); } while (0)
#define RESC(a, rs) do { if (rs) { if (hi == 0) al_l[r32] = (a); asm volatile("s_waitcnt lgkmcnt(0)" ::: "memory"); \
    _Pragma("unroll") for (int d = 0; d < 5; ++d) _Pragma("unroll") for (int r = 0; r < 16; ++r) o[d][r] *= al_l[crow(r, hi)]; } } while (0)
#define SEED(md) do { const int md_ = (md); const float sv_ = (md_ == 0 ? 0.f : (md_ < 0 ? cL : cR)) - m_reg; _Pragma("unroll") for (int r = 0; r < 16; ++r) seed[r] = sv_; } while (0)
#define TMODE(k0) (((k0) >= qs + 122) ? 1 : (((k0) <= qs - 154) ? -1 : 0))
#define ROT() do { const int t_ = sl_prev; sl_prev = sl_cur; sl_cur = sl_next; sl_next = t_; } while (0)
  f32x16 pA0, pA1, pB0, pB1, seed; float mnA, alA, alB; bool rsA = false, rsB = false; bf16x8 pa0, pa1, pa2, pa3;
  int sl_prev = 2 * SHM_V, sl_cur = 0, sl_next = SHM_V;
  if (wid >= 4) __builtin_amdgcn_s_setprio(1);
  DMA_TILE(0, 0); DMA_TILE(1, SHM_V);
  WAIT_BAR();
  DMA_TILE(2, 2 * SHM_V);
  qkt(pA0, pA1, K_lds, qr, r32, hi, mapB); partialSM(pA0, pA1, m_reg, mnA, alA, TMODE(0), cL, cR, dq0, tbl);
  _Pragma("unroll") for (int r = 0; r < 16; ++r) pA1[r] = __builtin_amdgcn_exp2f(pA1[r]);
  ROT();
#define QK_SEEDED(P0, P1, DMA_STMT, SEED_STMT) do { bf16x8 k0_[4], k1_[4]; const char* Ks_ = K_lds + sl_cur; \
    _Pragma("unroll") for (int d0 = 0; d0 < 4; ++d0) { k0_[d0] = *reinterpret_cast<const bf16x8*>(Ks_ + koff[d0]); k1_[d0] = *reinterpret_cast<const bf16x8*>(Ks_ + koff[d0] + 8192); } \
    DMA_STMT; SEED_STMT; \
    P0 = __builtin_amdgcn_mfma_f32_32x32x16_bf16(k0_[0], qr[0], seed, 0, 0, 0); P1 = __builtin_amdgcn_mfma_f32_32x32x16_bf16(k1_[0], qr[0], seed, 0, 0, 0); \
    _Pragma("unroll") for (int d0 = 1; d0 < 4; ++d0) { P0 = __builtin_amdgcn_mfma_f32_32x32x16_bf16(k0_[d0], qr[d0], P0, 0, 0, 0); P1 = __builtin_amdgcn_mfma_f32_32x32x16_bf16(k1_[d0], qr[d0], P1, 0, 0, 0); } } while (0)
  for (int j = 1; j + 1 < NT; j += 2) {
    SBAR(); QK_SEEDED(pB0, pB1, if (j > 1) DMA_TILE(j + 1, sl_next), SEED(TMODE(j * KVBLK)));
    finishSM(pA0, pA1, pa0, pa1, pa2, pa3); SBAR();
    if (TMODE(j * KVBLK) == 0) near_bias(pB0, pB1, dq0 + j * KVBLK, tbl);
    pv_softmax(o, vb0 + sl_prev, pa0, pa1, pa2, pa3, pB0, pB1, m_reg, alB, rsB);
    WAIT_BAR();
    RESC(alB, rsB); ROT();
    SBAR(); QK_SEEDED(pA0, pA1, DMA_TILE(j + 2, sl_next), SEED(TMODE((j + 1) * KVBLK)));
    finishSM(pB0, pB1, pa0, pa1, pa2, pa3); SBAR();
    if (TMODE((j + 1) * KVBLK) == 0) near_bias(pA0, pA1, dq0 + (j + 1) * KVBLK, tbl);
    pv_softmax(o, vb0 + sl_prev, pa0, pa1, pa2, pa3, pA0, pA1, m_reg, alA, rsA);
    WAIT_BAR();
    RESC(alA, rsA); ROT();
  }
  SBAR(); QK_SEEDED(pB0, pB1, (void)0, SEED(TMODE((NT - 1) * KVBLK)));
  finishSM(pA0, pA1, pa0, pa1, pa2, pa3); SBAR();
  if (TMODE((NT - 1) * KVBLK) == 0) near_bias(pB0, pB1, dq0 + (NT - 1) * KVBLK, tbl);
  pv_softmax(o, vb0 + sl_prev, pa0, pa1, pa2, pa3, pB0, pB1, m_reg, alB, rsB);
  RESC(alB, rsB);
  finishSM(pB0, pB1, pa0, pa1, pa2, pa3); SBAR();
  pv_d0(o, vb0 + sl_cur, pa0, pa1, pa2, pa3);
  __builtin_amdgcn_s_setprio(0);
  float rli[16];
#pragma unroll
  for (int r = 0; r < 16; ++r) rli[r] = __builtin_amdgcn_rcpf(o[4][r]);
  __syncthreads();
  float* X = (float*)(lds + jq * 16384);
  if (map == 1) {
#pragma unroll
    for (int r = 0; r < 16; ++r) { const int orow = crow(r, hi); const float s = rli[r] * lam;
#pragma unroll
      for (int d0 = 0; d0 < 4; ++d0) X[orow * 128 + d0 * 32 + r32] = o[d0][r] * s; }
  }
  __syncthreads();
  if (map == 0) {
    float ss[16];
#pragma unroll
    for (int r = 0; r < 16; ++r) { const int orow = crow(r, hi); float a = 0.f;
#pragma unroll
      for (int d0 = 0; d0 < 4; ++d0) { const float v = o[d0][r] * rli[r] - X[orow * 128 + d0 * 32 + r32]; o[d0][r] = v; a += v * v; }
      ss[r] = a; }
#pragma unroll
    for (int s = 1; s < 32; s <<= 1)
#pragma unroll
      for (int r = 0; r < 16; ++r) ss[r] += shx(ss[r], s);
    float gg[4];
#pragma unroll
    for (int d0 = 0; d0 < 4; ++d0) gg[d0] = g[d0 * 32 + r32] * osc;
    asm volatile("s_waitcnt lgkmcnt(0)" ::: "memory");
    bf16_t* stg = (bf16_t*)X;
#pragma unroll
    for (int r = 0; r < 16; ++r) { const int orow = crow(r, hi); const float rs = __builtin_amdgcn_rsqf(ss[r] * (1.0f / 128.0f) + LN_EPS);
#pragma unroll
      for (int d0 = 0; d0 < 4; ++d0) { const float v = o[d0][r] * rs * gg[d0]; stg[orow * 128 + d0 * 32 + r32] = (bf16_t)(cvt_pk_bf16(v, v) & 0xffffu); } }
    asm volatile("s_waitcnt lgkmcnt(0)" ::: "memory");
    bf16_t* Ow = O + (rowbase + qs) * LDX + h * 128;
#pragma unroll
    for (int i = 0; i < 8; ++i) { const int row = i * 4 + (lane >> 4), ch = lane & 15; const v4u v = *(const v4u*)(stg + row * 128 + ch * 8);
      if (!o8) *(v4u*)(Ow + (long)row * LDX + ch * 8) = v;
      else { typedef unsigned u32x2 __attribute__((ext_vector_type(2))); u32x2 q8; q8.x = pg8::pk4_fp8(bf_lo(v.x), bf_hi(v.x), bf_lo(v.y), bf_hi(v.y)); q8.y = pg8::pk4_fp8(bf_lo(v.z), bf_hi(v.z), bf_lo(v.w), bf_hi(v.w));
        *(u32x2*)((unsigned char*)O + (size_t)(rowbase + qs + row) * LDX + h * 128 + ch * 8) = q8; } }
    asm volatile("s_waitcnt lgkmcnt(0)" ::: "memory");
  }
  __syncthreads();
#undef DMA_TILE
#undef WAIT_BAR
#undef ROT
#undef RESC
#undef SEED
#undef QK_SEEDED
#undef TMODE
}
#undef KSWZ
#undef SBAR
}

#define XB_TMO      128
#define XB_XCNT(j)  (256  + 64 * (j))
#define XB_XSUB(j)  (1280 + 64 * (j))
#define XB_XGEN(j)  (2304 + 64 * (j))
#define XB_TOP      3328
#define XB_TOPGEN   3392
#define XCD_BAR_WORDS 3456
#define XB_SPIN_CAP (1u << 18)
__device__ __forceinline__ unsigned xb_ld(unsigned* p)              { return __hip_atomic_load(p, __ATOMIC_RELAXED, __HIP_MEMORY_SCOPE_AGENT); }
__device__ __forceinline__ unsigned xb_add(unsigned* p, unsigned v) { return __hip_atomic_fetch_add(p, v, __ATOMIC_RELAXED, __HIP_MEMORY_SCOPE_AGENT); }
__device__ __forceinline__ unsigned xb_xcc_id() { return (unsigned)__builtin_amdgcn_s_getreg((3 << 11) | 20) & 0xFu; }
#define XB_SPIN(cond, bar) do { unsigned _sp = 0; while (cond) { __builtin_amdgcn_s_sleep(1); \
    if ((++_sp & 255u) == 0u) { if (xb_ld(&(bar)[XB_TMO])) break; if (_sp > XB_SPIN_CAP) { atomicAdd(&(bar)[XB_TMO], 1u); break; } } } } while (0)
struct XcdBarrier { unsigned* bar; unsigned x; volatile LAS unsigned* st; };
__device__ __forceinline__ XcdBarrier xcd_barrier_post(unsigned* bar, volatile LAS unsigned* st) {
    XcdBarrier b; b.bar = bar; b.x = xb_xcc_id(); b.st = st;
    if (threadIdx.x == 0) (void)xb_add(&bar[XB_XCNT(b.x)], 1u);
    return b;
}
__device__ __forceinline__ void xcd_barrier_complete(unsigned* bar, unsigned x, unsigned& nloc, unsigned& nx) {
    const unsigned G = gridDim.x * gridDim.y * gridDim.z;
    unsigned sum, cnt, mine, sp = 0u;
    for (;;) {
        sum = 0u; cnt = 0u; mine = 0u;
#pragma unroll
        for (unsigned j = 0; j < 16; ++j) { const unsigned c = xb_ld(&bar[XB_XCNT(j)]); sum += c; cnt += (c > 0u) ? 1u : 0u; mine = (j == x) ? c : mine; }
        if (sum == G) break;
        __builtin_amdgcn_s_sleep(1);
        if ((++sp & 255u) == 0u) { if (xb_ld(&bar[XB_TMO])) break; if (sp > XB_SPIN_CAP) { atomicAdd(&bar[XB_TMO], 1u); break; } }
    }
    nloc = mine > 0u ? mine : 1u; nx = cnt > 0u ? cnt : 1u;
}
__device__ __forceinline__ void xcd_barrier(const XcdBarrier& b) {
    asm volatile("s_waitcnt vmcnt(0)" ::: "memory");
    __syncthreads();
    if (threadIdx.x == 0) {
        unsigned* bar = b.bar;
        __builtin_amdgcn_s_waitcnt(0);
        unsigned nloc = b.st[0], nx = b.st[1];
        if (nloc == 0u) { xcd_barrier_complete(bar, b.x, nloc, nx); b.st[0] = nloc; b.st[1] = nx; }
        const unsigned old = xb_add(&bar[XB_XSUB(b.x)], 1u);
        const unsigned gen = old / nloc;
        if (old + 1u == (gen + 1u) * nloc) {
            __builtin_amdgcn_fence(__ATOMIC_RELEASE, "agent");
            asm volatile("s_waitcnt vmcnt(0)" ::: "memory");
            const unsigned og = xb_add(&bar[XB_TOP], 1u);
            const unsigned tg = og / nx;
            if (og + 1u == (tg + 1u) * nx) xb_add(&bar[XB_TOPGEN], 1u);
            else XB_SPIN(xb_ld(&bar[XB_TOPGEN]) == tg, bar);
            __builtin_amdgcn_fence(__ATOMIC_ACQUIRE, "agent");
            xb_add(&bar[XB_XGEN(b.x)], 1u);
            asm volatile("s_waitcnt vmcnt(0)" ::: "memory");
        } else {
            XB_SPIN(xb_ld(&bar[XB_XGEN(b.x)]) == gen, bar);
            __builtin_amdgcn_fence(__ATOMIC_ACQUIRE, "agent");
            asm volatile("s_waitcnt vmcnt(0)" ::: "memory");
        }
    }
    __syncthreads();
}

template <int MODE> __device__ __forceinline__ int dst_row(int n) {
    if (MODE == 1) { if (n < 1024) return n; const int b = (n - 1024) >> 10, f = (n - 1024) & 1023; return 1024 + (f >> 7) * 256 + b * 128 + (f & 127); }
    if (MODE == 2) { const int b = n & 1, j = n >> 1; return (j >> 7) * 256 + b * 128 + (j & 127); }
    return n;
}
template <int MODE> __device__ __forceinline__ void p0_transpose_item(const float* W, int K, int N, bf16_t* WT, LAS float* scr, int item, int lane, const float* kscale = nullptr) {
    const int nblk = N / 32, kb = item / nblk, nb = item % nblk, k0 = 64 * kb, n0 = 32 * nb;
#pragma unroll 8
    for (int i = 0; i < 32; ++i) { const int kk = 2 * i + (lane >> 5); float w = W[(size_t)(k0 + kk) * N + n0 + (lane & 31)]; if (kscale) w *= kscale[k0 + kk]; scr[kk * 33 + (lane & 31)] = w; }
    LDS_WAIT(); asm volatile("" ::: "memory");
    const int c = lane & 7;
#pragma unroll
    for (int j = 0; j < 4; ++j) { const int n = (lane >> 3) + 8 * j; const LAS float* s = scr + (8 * c) * 33 + n;
        v4u o; o.x = cvt_pk_bf16(s[0 * 33], s[1 * 33]); o.y = cvt_pk_bf16(s[2 * 33], s[3 * 33]); o.z = cvt_pk_bf16(s[4 * 33], s[5 * 33]); o.w = cvt_pk_bf16(s[6 * 33], s[7 * 33]);
        *(GAS v4u*)(WT + (size_t)dst_row<MODE>(n0 + n) * K + k0 + 8 * c) = o; }
    LDS_WAIT(); asm volatile("" ::: "memory");
}

template <int MODE, bool I8 = false> __device__ __forceinline__ void p0_quant_strip(const float* W, int N, unsigned char* W8, float* SC, int strip, LAS unsigned char* lds, int wave, int lane) {
    constexpr float QM_ = I8 ? 127.0f : F8MAX;
    LAS float* scr = (LAS float*)(lds + wave * 16384); LAS float* red = (LAS float*)(lds + LDSCTL_OFF + 2048);
    const int n0 = strip * 32, k0 = wave * 128, kk = lane >> 5, n = lane & 31;
    float am = 0.f;
    { const char* Wb = (const char*)W + (size_t)k0 * N * 4; const unsigned loff = (unsigned)((kk * N + n0 + n) * 4);
      float vv[64];
#pragma unroll
      for (int i = 0; i < 64; ++i) vv[i] = *(const float*)(Wb + (size_t)i * (size_t)(2 * N * 4) + loff);
#pragma unroll
      for (int i = 0; i < 64; ++i) { scr[(2 * i + kk) * 32 + n] = vv[i]; am = fmaxf(am, fabsf(vv[i])); } }
    am = fmaxf(am, shx(am, 32));
    if (lane < 32) red[wave * 32 + n] = am;
    __syncthreads();
    float amax = red[n];
#pragma unroll
    for (int w = 1; w < 8; ++w) amax = fmaxf(amax, red[w * 32 + n]);
    const float q = amax > 0.f ? QM_ / amax : 0.f;
    const int dr = dst_row<MODE>(n0 + n);
    if (wave == 0 && lane < 32) SC[dr] = amax * (1.0f / QM_);
#pragma unroll
    for (int c = 0; c < 4; ++c) { float v[16];
#pragma unroll
        for (int j = 0; j < 16; ++j) v[j] = scr[(kk * 64 + c * 16 + j) * 32 + n] * q;
        v4u o; o.x = pg8::pkq4<I8>(v[0], v[1], v[2], v[3]); o.y = pg8::pkq4<I8>(v[4], v[5], v[6], v[7]); o.z = pg8::pkq4<I8>(v[8], v[9], v[10], v[11]); o.w = pg8::pkq4<I8>(v[12], v[13], v[14], v[15]);
        *(GAS v4u*)(W8 + (size_t)dr * 1024 + k0 + kk * 64 + c * 16) = o; }
    __syncthreads();
}
struct StripSrc { const float* W; int N; unsigned char* W8; float* SC; int strip; bool glu; };
__device__ __forceinline__ void dstrip_desc(const float* w1, const float* w2, unsigned char* ws, int st, StripSrc& d) {
    if (st < 128 * 64) { const int j = st >> 6; d.W = w1 + (size_t)j * 1024 * 2048; d.N = 2048; d.W8 = ws + WS_W1 + (size_t)j * 2048 * 1024; d.SC = (float*)(ws + WS_S1) + (size_t)j * 2048; d.strip = st & 63; d.glu = true; }
    else { const int q = st - 128 * 64, j = q >> 5; d.W = w2 + (size_t)j * 1024 * 1024; d.N = 1024; d.W8 = ws + WS_W2 + (size_t)j * 1024 * 1024; d.SC = (float*)(ws + WS_S2) + (size_t)j * 1024; d.strip = q & 31; d.glu = false; }
}
__device__ __forceinline__ void dstrip_issue(const StripSrc& d, int wave, int lane, f32x4 (&vv)[16]) {
    const int n0 = d.strip * 32, k0 = wave * 128, r8 = lane >> 3, cg = lane & 7;
    const char* Wb = (const char*)d.W + (size_t)k0 * d.N * 4; const unsigned loff = (unsigned)((r8 * d.N + n0 + 4 * cg) * 4); const size_t rs8 = (size_t)d.N * 32;
#pragma unroll
    for (int i = 0; i < 16; ++i) vv[i] = *(const f32x4*)(Wb + (size_t)i * rs8 + loff);
}
__device__ __forceinline__ void dstrip_finish(const StripSrc& d, LAS unsigned char* lds, int wave, int lane, int par, f32x4 (&vv)[16]) {
    LAS float* scr = (LAS float*)(lds + wave * 16384); LAS float* red = (LAS float*)(lds + LDSCTL_OFF + 2048 + par * 1024);
    const int n0 = d.strip * 32, k0 = wave * 128, kk = lane >> 5, n = lane & 31, r8 = lane >> 3, cg = lane & 7;
    f32x4 am = {0.f, 0.f, 0.f, 0.f};
#pragma unroll
    for (int i = 0; i < 16; ++i) { *(LAS f32x4*)(scr + (8 * i + r8) * 32 + 4 * cg) = vv[i];
#pragma unroll
        for (int j = 0; j < 4; ++j) am[j] = fmaxf(am[j], fabsf(vv[i][j])); }
    { const int l_ = lane_local();
#pragma unroll
      for (int o = 8; o < 64; o <<= 1)
#pragma unroll
        for (int j = 0; j < 4; ++j) am[j] = fmaxf(am[j], shx(am[j], o, l_)); }
    if (lane < 8) *(LAS f32x4*)(red + wave * 32 + 4 * cg) = am;
    asm volatile("s_waitcnt lgkmcnt(0)" ::: "memory"); __builtin_amdgcn_s_barrier(); asm volatile("" ::: "memory");
    float amax = red[n];
#pragma unroll
    for (int w = 1; w < 8; ++w) amax = fmaxf(amax, red[w * 32 + n]);
    const float q = amax > 0.f ? F8MAX / amax : 0.f;
    const int dr = d.glu ? dst_row<2>(n0 + n) : (n0 + n);
    if (wave == 0 && lane < 32) d.SC[dr] = amax * (1.0f / F8MAX);
#pragma unroll
    for (int c = 0; c < 4; ++c) { float v[16];
#pragma unroll
        for (int j = 0; j < 16; ++j) v[j] = scr[(kk * 64 + c * 16 + j) * 32 + n] * q;
        v4u o; o.x = pg8::pk4_fp8(v[0], v[1], v[2], v[3]); o.y = pg8::pk4_fp8(v[4], v[5], v[6], v[7]); o.z = pg8::pk4_fp8(v[8], v[9], v[10], v[11]); o.w = pg8::pk4_fp8(v[12], v[13], v[14], v[15]);
        *(LAS v4u*)((LAS unsigned char*)scr + c * 2048 + (n * 2 + kk) * 16) = o; }
#pragma unroll
    for (int i = 0; i < 4; ++i) { const int nn = i * 8 + (lane >> 3), kk2 = (lane >> 2) & 1, c2 = lane & 3;
        const v4u t = *(const LAS v4u*)((const LAS unsigned char*)scr + c2 * 2048 + (nn * 2 + kk2) * 16);
        const int dr2 = d.glu ? dst_row<2>(n0 + nn) : (n0 + nn);
        *(GAS v4u*)(d.W8 + (size_t)dr2 * 1024 + k0 + kk2 * 64 + c2 * 16) = t; }
    asm volatile("s_waitcnt lgkmcnt(0)" ::: "memory");
}
__device__ __forceinline__ void deferred_strips(const float* w1, const float* w2, unsigned char* ws, LAS unsigned char* lds, int first, int NT, int wave, int lane) {
    constexpr int stride = 1;
    auto stq = [](int idx) { return idx; };
    f32x4 va[16], vb[16]; StripSrc da, db; int idx = first, par = 0;
    if (idx < NT) { dstrip_desc(w1, w2, ws, stq(idx), da); dstrip_issue(da, wave, lane, va); }
#pragma unroll 1
    while (idx < NT) {
        const int i1 = idx + stride; if (i1 < NT) { dstrip_desc(w1, w2, ws, stq(i1), db); dstrip_issue(db, wave, lane, vb); }
        dstrip_finish(da, lds, wave, lane, par, va); par ^= 1;
        if (i1 >= NT) break;
        const int i2 = i1 + stride; if (i2 < NT) { dstrip_desc(w1, w2, ws, stq(i2), da); dstrip_issue(da, wave, lane, va); }
        dstrip_finish(db, lds, wave, lane, par, vb); par ^= 1;
        idx = i2;
    }
    __syncthreads();
}
__device__ __forceinline__ float ln_bound(const float* g, const float* b, int lane) {
    float mg = 0.f, mb = 0.f;
#pragma unroll
    for (int j = 0; j < 4; ++j) { const f32x4 a = *(const f32x4*)(g + j * 256 + lane * 4), c = *(const f32x4*)(b + j * 256 + lane * 4);
        mg = fmaxf(mg, fmaxf(fmaxf(fabsf(a[0]), fabsf(a[1])), fmaxf(fabsf(a[2]), fabsf(a[3])))); mb = fmaxf(mb, fmaxf(fmaxf(fabsf(c[0]), fabsf(c[1])), fmaxf(fabsf(c[2]), fabsf(c[3])))); }
#pragma unroll
    for (int o = 1; o < 64; o <<= 1) { mg = fmaxf(mg, shx(mg, o)); mb = fmaxf(mb, shx(mb, o)); }
    return 31.984371f * mg + mb;
}

struct Ptrs {
    const float *x, *rel_bias, *attn_w_in, *attn_lambda, *attn_subln, *attn_w_out, *conv_w_in, *conv_w, *conv_w_out, *router_w, *router_b, *w1, *b1, *w2, *b2, *ln_g, *ln_b;
    float* out; unsigned char* ws;
};

#ifndef DEFER_W
#define DEFER_W 1
#endif
__device__ __forceinline__ void expert_strip(const Ptrs& P, int st, LAS unsigned char* lds, int wave, int lane) {
    unsigned char* ws = P.ws;
    if (st < 128 * 64) { const int j = st >> 6, r = st & 63; p0_quant_strip<2>(P.w1 + (size_t)j * 1024 * 2048, 2048, ws + WS_W1 + (size_t)j * 2048 * 1024, (float*)(ws + WS_S1) + (size_t)j * 2048, r, lds, wave, lane); }
    else { const int q = st - 128 * 64, j = q >> 5, r = q & 31; p0_quant_strip<0>(P.w2 + (size_t)j * 1024 * 1024, 1024, ws + WS_W2 + (size_t)j * 1024 * 1024, (float*)(ws + WS_S2) + (size_t)j * 1024, r, lds, wave, lane); }
}
constexpr int NWAVES_ = 8;
__device__ __forceinline__ void p0_prologue(const Ptrs& P, LAS unsigned char* lds, int gw, int NGW, int wave, int lane) {
    LAS float* scr = (LAS float*)(lds + RING_OFF + wave * 16384);
    unsigned char* ws = P.ws;
    constexpr int I_OUT = 16 * 32, I_R = 16;
    constexpr int I_IN = 16 * 96;
    constexpr int S1 = NA16 * I_OUT, S3 = S1 + NO16 * I_OUT, S4 = S3 + 4 * I_R, S5 = S4 + NQ16 * I_IN, S6 = S5 + NC16 * I_IN;
    { const int wg = gw / NWAVES_, NWG = NGW / NWAVES_;
      constexpr int T1 = 128 * 64, T2 = T1 + 128 * 32, T3 = T2 + NQ8 * 96, T4 = T3 + NC8 * 96, T5 = T4 + NA8 * 32, T6 = T5 + NO8 * 32;
      constexpr int NE0 = DEFER_W ? 0 : T2;
#pragma unroll 1
      for (int s0 = wg; s0 < NE0 + (T6 - T2); s0 += NWG) {
        const int st = (s0 >= NE0) ? T2 + (s0 - NE0) : s0;
        if (st < T2) expert_strip(P, st, lds, wave, lane);
        else if (st < T3) { const int q = st - T2, j = QJ0 + q / 96, r = q % 96; p0_quant_strip<0, I8P>(P.attn_w_in + (size_t)j * 1024 * 3072, 3072, ws + WS_WAI + (size_t)j * 3072 * 1024, (float*)(ws + WS_SD) + (size_t)j * 3072, r, lds, wave, lane); }
        else if (st < T4) { const int q = st - T3, j = CJ0 + q / 96, r = q % 96; p0_quant_strip<1, I8P>(P.conv_w_in + (size_t)j * 1024 * 3072, 3072, ws + WS_WCI + (size_t)j * 3072 * 1024, (float*)(ws + WS_SD + 32 * 1024) + (size_t)j * 3072, r, lds, wave, lane); }
        else if (st < T5) { const int q = st - T4, j = AJ0 + q / 32, r = q % 32; p0_quant_strip<0>(P.attn_w_out + (size_t)j * 1024 * 1024, 1024, ws + WS_WAO8 + (size_t)j * 1024 * 1024, (float*)(ws + WS_SD + 24 * 1024) + (size_t)j * 1024, r, lds, wave, lane); }
        else { const int q = st - T5, j = OJ0 + q / 32, r = q % 32; p0_quant_strip<0, I8P>(P.conv_w_out + (size_t)j * 1024 * 1024, 1024, ws + WS_WCO8 + (size_t)j * 1024 * 1024, (float*)(ws + WS_SD + 56 * 1024) + (size_t)j * 1024, r, lds, wave, lane); }
      } }
    for (int it = gw; it < S6; it += NGW) {
        if (it >= S5) { const int q = it - S5, j = CK0 + q / I_IN, r = q % I_IN; p0_transpose_item<1>(P.conv_w_in + (size_t)j * 1024 * 3072, 1024, 3072, (bf16_t*)(ws + WS_WC16) + (size_t)j * 3072 * 1024, scr, r, lane); }
        else if (it >= S4) { const int q = it - S4, j = QK0 + q / I_IN, r = q % I_IN; p0_transpose_item<0>(P.attn_w_in + (size_t)j * 1024 * 3072, 1024, 3072, (bf16_t*)(ws + WS_WA16) + (size_t)j * 3072 * 1024, scr, r, lane); }
        else if (it < S1) { const int q = it, j = AK0 + q / I_OUT, r = q % I_OUT; p0_transpose_item<0>(P.attn_w_out + (size_t)j * 1024 * 1024, 1024, 1024, (bf16_t*)(ws + WS_WAO) + (size_t)j * 1024 * 1024, scr, r, lane); }
        else if (it < S3) { const int q = it - S1, j = OK0 + q / I_OUT, r = q % I_OUT; p0_transpose_item<0>(P.conv_w_out + (size_t)j * 1024 * 1024, 1024, 1024, (bf16_t*)(ws + WS_WCO) + (size_t)j * 1024 * 1024, scr, r, lane); }
        else { const int q = it - S3, j = q / I_R, r = q % I_R; p0_transpose_item<0>(P.router_w + (size_t)j * 1024 * 32, 1024, 32, (bf16_t*)(ws + WS_WR) + (size_t)j * 32 * 1024, scr, r, lane, P.ln_g + (size_t)(j * 2 + 0) * D); }
    }
    for (int it = gw; it < DEPTH * 32; it += NGW) { const int L = it >> 5, e = it & 31; const float* g_ = P.ln_g + (size_t)(L * 2) * D; const float* b_ = P.ln_b + (size_t)(L * 2) * D; const float* Wr = P.router_w + (size_t)L * 1024 * 32;
        float a = 0.f, c = 0.f;
#pragma unroll 4
        for (int i = 0; i < 16; ++i) { const int k = lane + 64 * i; const float w = Wr[(size_t)k * 32 + e]; a += bf_lo(cvt_pk_bf16(w * g_[k], 0.f)); c += b_[k] * w; }
        a = wave_sum(a); c = wave_sum(c);
        if (lane == 0) { float* RC = (float*)(ws + WS_RC) + L * 64; RC[e] = a; RC[32 + e] = c + P.router_b[L * 32 + e]; } }
    for (int row = gw; row < M; row += NGW) {
        f32x4 a[2][2]; float am = 0.f;
#pragma unroll
        for (int h = 0; h < 2; ++h)
#pragma unroll
            for (int q = 0; q < 2; ++q) { a[h][q] = *(const GAS f32x4*)(P.x + (size_t)row * D + h * 512 + lane * 8 + q * 4);
                am = fmaxf(am, fmaxf(fmaxf(fabsf(a[h][q][0]), fabsf(a[h][q][1])), fmaxf(fabsf(a[h][q][2]), fabsf(a[h][q][3])))); }
#pragma unroll
        for (int o = 1; o < 64; o <<= 1) am = fmaxf(am, shx(am, o));
        const float qs = QMAXP / fmaxf(am, 1e-30f);
        if ((QM & 1) && lane == 0) ((float*)(ws + WS_RS))[row] = am * (1.0f / QMAXP);
#pragma unroll
        for (int h = 0; h < 2; ++h) { v4u o; o.x = cvt_pk_bf16(a[h][0][0], a[h][0][1]); o.y = cvt_pk_bf16(a[h][0][2], a[h][0][3]); o.z = cvt_pk_bf16(a[h][1][0], a[h][1][1]); o.w = cvt_pk_bf16(a[h][1][2], a[h][1][3]);
            *(GAS v4u*)((bf16_t*)(ws + WS_XB) + (size_t)row * D + h * 512 + lane * 8) = o;
            if (QM & 1) { typedef unsigned u32x2 __attribute__((ext_vector_type(2))); u32x2 q8;
            q8.x = pg8::pkq4<I8P>(a[h][0][0] * qs, a[h][0][1] * qs, a[h][0][2] * qs, a[h][0][3] * qs); q8.y = pg8::pkq4<I8P>(a[h][1][0] * qs, a[h][1][1] * qs, a[h][1][2] * qs, a[h][1][3] * qs);
            *(GAS u32x2*)(ws + WS_XI + (size_t)row * D + h * 512 + lane * 8) = q8; } }
    }
}

__device__ __forceinline__ void conv_phase(const bf16_t* GB, const bf16_t* Z, const float* cw, bf16_t* Gout, float* RS, bool o8, int gw, int NGW, int lane) {
    float w[3][16];
#pragma unroll
    for (int j = 0; j < 3; ++j)
#pragma unroll
        for (int h = 0; h < 2; ++h)
#pragma unroll
            for (int q = 0; q < 2; ++q) { const f32x4 t = *(const f32x4*)(cw + j * D + h * 512 + lane * 8 + q * 4); w[j][h * 8 + q * 4 + 0] = t[0]; w[j][h * 8 + q * 4 + 1] = t[1]; w[j][h * 8 + q * 4 + 2] = t[2]; w[j][h * 8 + q * 4 + 3] = t[3]; }
    for (int run = gw; run < M / 32; run += NGW) {
        const int t0 = run * 32; const bool first = (t0 % SEQ) == 0, lastr = ((t0 + 32) % SEQ) == 0;
        v4u zp[2], zc[2], zn[2];
#pragma unroll
        for (int h = 0; h < 2; ++h) { zp[h] = first ? (v4u){0u, 0u, 0u, 0u} : *(const v4u*)(Z + (size_t)(t0 - 1) * D + h * 512 + lane * 8); zc[h] = *(const v4u*)(Z + (size_t)t0 * D + h * 512 + lane * 8); }
        for (int r = 0; r < 32; ++r) { const int t = t0 + r; const bool pad = lastr && (r == 31);
            float o[2][8];
#pragma unroll
            for (int h = 0; h < 2; ++h) {
                zn[h] = pad ? (v4u){0u, 0u, 0u, 0u} : *(const v4u*)(Z + (size_t)(t + 1) * D + h * 512 + lane * 8);
                const v4u gb = *(const v4u*)(GB + (size_t)t * D + h * 512 + lane * 8);
#pragma unroll
                for (int q = 0; q < 4; ++q) { const unsigned up = zp[h][q], uc = zc[h][q], un = zn[h][q], ug = gb[q]; const int c = h * 8 + q * 2;
                    o[h][q * 2 + 0] = bf_lo(ug) * (w[0][c] * bf_lo(up) + w[1][c] * bf_lo(uc) + w[2][c] * bf_lo(un));
                    o[h][q * 2 + 1] = bf_hi(ug) * (w[0][c + 1] * bf_hi(up) + w[1][c + 1] * bf_hi(uc) + w[2][c + 1] * bf_hi(un)); }
                if (!o8) { v4u ov; ov.x = cvt_pk_bf16(o[h][0], o[h][1]); ov.y = cvt_pk_bf16(o[h][2], o[h][3]); ov.z = cvt_pk_bf16(o[h][4], o[h][5]); ov.w = cvt_pk_bf16(o[h][6], o[h][7]);
                    *(v4u*)(Gout + (size_t)t * D + h * 512 + lane * 8) = ov; }
                zp[h] = zc[h]; zc[h] = zn[h];
            }
            if (o8) { float am = 0.f;
#pragma unroll
                for (int h = 0; h < 2; ++h)
#pragma unroll
                    for (int i = 0; i < 8; ++i) am = fmaxf(am, fabsf(o[h][i]));
#pragma unroll
                for (int s_ = 1; s_ < 64; s_ <<= 1) am = fmaxf(am, shx(am, s_));
                const float qs = QMAXP / fmaxf(am, 1e-30f);
                if (lane == 0) RS[t] = am * (1.0f / QMAXP);
#pragma unroll
                for (int h = 0; h < 2; ++h) { typedef unsigned u32x2 __attribute__((ext_vector_type(2))); u32x2 q8;
                    q8.x = pg8::pkq4<I8P>(o[h][0] * qs, o[h][1] * qs, o[h][2] * qs, o[h][3] * qs); q8.y = pg8::pkq4<I8P>(o[h][4] * qs, o[h][5] * qs, o[h][6] * qs, o[h][7] * qs);
                    *(u32x2*)((unsigned char*)Gout + (size_t)t * D + h * 512 + lane * 8) = q8; } }
        }
    }
}

__device__ __forceinline__ void ln2_phase(const bf16_t* Yp, const float* g1, const float* b1, const unsigned char* Y, const float* g, const float* bta, bf16_t* XB, float* out, unsigned char* XI, float* RS, int gw, int NGW, int lane) {
    float gg[16], bb[16];
#pragma unroll
    for (int h = 0; h < 2; ++h)
#pragma unroll
        for (int q = 0; q < 2; ++q) { const f32x4 t = *(const f32x4*)(g + h * 512 + lane * 8 + q * 4), s = *(const f32x4*)(bta + h * 512 + lane * 8 + q * 4);
#pragma unroll
            for (int i = 0; i < 4; ++i) { gg[h * 8 + q * 4 + i] = t[i]; bb[h * 8 + q * 4 + i] = s[i]; } }
    float sXb = 0.f, rsXb = 0.f; if constexpr (!I8P) { const float lb = ln_bound(g, bta, lane); sXb = F8MAX / lb; rsXb = lb * (1.0f / F8MAX); }
    for (int row = gw; row < M; row += NGW) {
        float v[16];
#pragma unroll
        for (int h = 0; h < 2; ++h) { const v4u xr = *(const v4u*)(Yp + (size_t)row * D + h * 512 + lane * 8);
#pragma unroll
            for (int q = 0; q < 4; ++q) { v[h * 8 + q * 2] = bf_lo(xr[q]); v[h * 8 + q * 2 + 1] = bf_hi(xr[q]); } }
        { float s1 = 0.f;
#pragma unroll
          for (int i = 0; i < 16; ++i) s1 += v[i];
          const float m1 = wave_sum(s1) * (1.f / D); float q1 = 0.f;
#pragma unroll
          for (int i = 0; i < 16; ++i) { v[i] -= m1; q1 += v[i] * v[i]; }
          const float r1 = ALPHA / sqrtf(wave_sum(q1) * (1.f / D) + LN_EPS);
#pragma unroll
          for (int h = 0; h < 2; ++h)
#pragma unroll
            for (int q = 0; q < 2; ++q) { const f32x4 t = *(const f32x4*)(g1 + h * 512 + lane * 8 + q * 4), u = *(const f32x4*)(b1 + h * 512 + lane * 8 + q * 4);
#pragma unroll
              for (int i = 0; i < 4; ++i) v[h * 8 + q * 4 + i] = v[h * 8 + q * 4 + i] * r1 * t[i] + ALPHA * u[i]; } }
#pragma unroll
        for (int k = 0; k < 4; ++k)
#pragma unroll
            for (int h = 0; h < 2; ++h) { typedef unsigned u32x2 __attribute__((ext_vector_type(2))); const u32x2 yr = *(const u32x2*)(Y + ((size_t)row * 4 + k) * D + h * 512 + lane * 8);
#pragma unroll
                for (int q = 0; q < 2; ++q) { const f32x2 lo = __builtin_amdgcn_cvt_pk_f32_fp8((int)yr[q], false), hi2 = __builtin_amdgcn_cvt_pk_f32_fp8((int)yr[q], true);
                    v[h * 8 + q * 4 + 0] += lo[0] * (1.0f / YSCALE); v[h * 8 + q * 4 + 1] += lo[1] * (1.0f / YSCALE); v[h * 8 + q * 4 + 2] += hi2[0] * (1.0f / YSCALE); v[h * 8 + q * 4 + 3] += hi2[1] * (1.0f / YSCALE); } }
        float s = 0.f;
#pragma unroll
        for (int i = 0; i < 16; ++i) s += v[i];
        const float mean = wave_sum(s) * (1.f / D); float s2 = 0.f;
#pragma unroll
        for (int i = 0; i < 16; ++i) { v[i] -= mean; s2 += v[i] * v[i]; }
        const float rstd = 1.f / sqrtf(wave_sum(s2) * (1.f / D) + LN_EPS);
#pragma unroll
        for (int i = 0; i < 16; ++i) v[i] = v[i] * rstd * gg[i] + bb[i];
        float sX = sXb, rsX = rsXb;
        if (I8P && XI) { float am = 0.f;
#pragma unroll
            for (int i = 0; i < 16; ++i) am = fmaxf(am, fabsf(v[i]));
#pragma unroll
            for (int o = 1; o < 64; o <<= 1) am = fmaxf(am, shx(am, o));
            sX = QMAXP / fmaxf(am, 1e-30f); rsX = am * (1.0f / QMAXP); }
#pragma unroll
        for (int h = 0; h < 2; ++h) { v4u ov; ov.x = cvt_pk_bf16(v[h * 8 + 0], v[h * 8 + 1]); ov.y = cvt_pk_bf16(v[h * 8 + 2], v[h * 8 + 3]); ov.z = cvt_pk_bf16(v[h * 8 + 4], v[h * 8 + 5]); ov.w = cvt_pk_bf16(v[h * 8 + 6], v[h * 8 + 7]);
            if (!out) *(v4u*)(XB + (size_t)row * D + h * 512 + lane * 8) = ov;
            if (XI) { typedef unsigned u32x2 __attribute__((ext_vector_type(2))); u32x2 q8; q8.x = pg8::pkq4<I8P>(v[h * 8 + 0] * sX, v[h * 8 + 1] * sX, v[h * 8 + 2] * sX, v[h * 8 + 3] * sX); q8.y = pg8::pkq4<I8P>(v[h * 8 + 4] * sX, v[h * 8 + 5] * sX, v[h * 8 + 6] * sX, v[h * 8 + 7] * sX);
                *(u32x2*)(XI + (size_t)row * D + h * 512 + lane * 8) = q8; if (h == 0 && lane == 0) RS[row] = rsX; }
            if (out) { *(f32x4*)(out + (size_t)row * D + h * 512 + lane * 8) = (f32x4){v[h * 8 + 0], v[h * 8 + 1], v[h * 8 + 2], v[h * 8 + 3]};
                       *(f32x4*)(out + (size_t)row * D + h * 512 + lane * 8 + 4) = (f32x4){v[h * 8 + 4], v[h * 8 + 5], v[h * 8 + 6], v[h * 8 + 7]}; } }
    }
}

constexpr int RT_PITCH = 2064, R_OFF_G = 32 * RT_PITCH, R_OFF_LG = R_OFF_G + 8192, R_OFF_CNT = R_OFF_LG + 8 * 16 * 33 * 4, R_OFF_SW = R_OFF_CNT + 256, R_LDS = R_OFF_SW + 256;
typedef __bf16 bf16x2_t __attribute__((ext_vector_type(2)));
__device__ __forceinline__ void router_phase(const bf16_t* Yp, const float* g, const float* bta, const bf16_t* RTg, const float* Wr, const float* rb, unsigned char* X8, int* lslot, float* lgate, unsigned* cnt,
                                             char* lds, int blk0, int G, int tid, int wave, int lane, const float* rc) {
    for (int i = tid; i < 32 * 128; i += 512) { const int e = i >> 7, c = i & 127; *(v4u*)(lds + e * RT_PITCH + c * 16) = *(const v4u*)(RTg + (size_t)e * 1024 + c * 8); }
    float* gl = (float*)(lds + R_OFF_G); float* bl = gl + 1024;
    for (int i = tid; i < 1024; i += 512) { gl[i] = g[i]; bl[i] = bta[i]; }
    float* LG = (float*)(lds + R_OFF_LG) + wave * (16 * 33);
    int* lcnt = (int*)(lds + R_OFF_CNT); int* lbase = lcnt + 32;
    float* sWl = (float*)(lds + R_OFF_SW); float* cBl = sWl + 32;
    __syncthreads();
    if (tid < 64) sWl[tid] = rc[tid];
    const int t16 = lane & 15, kq = lane >> 4;
    const float sA = F8MAX / ln_bound(g, bta, lane);
#pragma unroll 1
    for (int blk = blk0; blk < M / 128; blk += G) {
        if (tid < 32) lcnt[tid] = 0;
        __syncthreads();
        int my_e, my_rank, my_slot; float my_gate;
        const int r0 = blk * 128 + wave * 16; const size_t rowoff = (size_t)(r0 + t16) * D + kq * 8;
        v4u yv[32];
#pragma unroll
        for (int kb = 0; kb < 32; ++kb) yv[kb] = *(const v4u*)(Yp + rowoff + kb * 32);
        f32x4 acc0 = {0.f, 0.f, 0.f, 0.f}, acc1 = {0.f, 0.f, 0.f, 0.f}, accs = {0.f, 0.f, 0.f, 0.f}, accq = {0.f, 0.f, 0.f, 0.f};
        const bf16x8 ones8 = {(short)0x3F80, (short)0x3F80, (short)0x3F80, (short)0x3F80, (short)0x3F80, (short)0x3F80, (short)0x3F80, (short)0x3F80};
#pragma unroll
        for (int kb = 0; kb < 32; ++kb) { const int c0 = kb * 32 + kq * 8;
            const bf16x8 w0 = *(const bf16x8*)(lds + t16 * RT_PITCH + c0 * 2), w1 = *(const bf16x8*)(lds + (16 + t16) * RT_PITCH + c0 * 2);
            const bf16x8 xb = __builtin_bit_cast(bf16x8, yv[kb]);
            acc0 = __builtin_amdgcn_mfma_f32_16x16x32_bf16(w0, xb, acc0, 0, 0, 0);
            acc1 = __builtin_amdgcn_mfma_f32_16x16x32_bf16(w1, xb, acc1, 0, 0, 0);
            accs = __builtin_amdgcn_mfma_f32_16x16x32_bf16(ones8, xb, accs, 0, 0, 0);
            accq = __builtin_amdgcn_mfma_f32_16x16x32_bf16(xb, xb, accq, 0, 0, 0); }
        const float s = accs[0];
        const int dsel = t16 & 3; float dq_ = dsel == 0 ? accq[0] : (dsel == 1 ? accq[1] : (dsel == 2 ? accq[2] : accq[3]));
        const float s2 = __int_as_float(__builtin_amdgcn_ds_bpermute(((t16 >> 2) * 16 + t16) << 2, __float_as_int(dq_)));
        const float mean = s * (1.f / D); const float var = fmaxf(s2 * (1.f / D) - mean * mean, 0.f);
        const float rstd = 1.f / sqrtf(var + LN_EPS);
        {
            float* lgr = LG + t16 * 33;
#pragma unroll
            for (int i = 0; i < 4; ++i) { const int e0 = kq * 4 + i, e1 = 16 + kq * 4 + i;
                lgr[e0] = rstd * (acc0[i] - mean * sWl[e0]) + cBl[e0]; lgr[e1] = rstd * (acc1[i] - mean * sWl[e1]) + cBl[e1]; }
            LDS_WAIT(); asm volatile("" ::: "memory");
            float t0 = -INFINITY, t1 = -INFINITY, t2 = -INFINITY, t3 = -INFINITY; int i0 = 0, i1 = 0, i2 = 0, i3 = 0;
#pragma unroll
            for (int e = 0; e < 32; ++e) { const float v = lgr[e];
                const bool c0 = v > t0, c1 = v > t1, c2 = v > t2, c3 = v > t3;
                t3 = c2 ? t2 : (c3 ? v : t3); i3 = c2 ? i2 : (c3 ? e : i3);
                t2 = c1 ? t1 : (c2 ? v : t2); i2 = c1 ? i1 : (c2 ? e : i2);
                t1 = c0 ? t0 : (c1 ? v : t1); i1 = c0 ? i0 : (c1 ? e : i1);
                t0 = c0 ? v : t0; i0 = c0 ? e : i0; }
            const float e1 = __expf(t1 - t0), e2 = __expf(t2 - t0), e3 = __expf(t3 - t0); const float inv = 1.f / (1.f + e1 + e2 + e3);
            const int ek = kq == 0 ? i0 : (kq == 1 ? i1 : (kq == 2 ? i2 : i3)); const float gk = (kq == 0 ? 1.f : (kq == 1 ? e1 : (kq == 2 ? e2 : e3))) * inv;
            my_e = ek; my_gate = gk; my_slot = (r0 + t16) * 4 + kq; my_rank = atomicAdd(&lcnt[ek], 1);
            LDS_WAIT(); asm volatile("" ::: "memory");
        }
        const float rs = rstd * sA;
#pragma unroll
        for (int kb = 0; kb < 32; ++kb) { const int c0 = kb * 32 + kq * 8; const v4u y = yv[kb];
            const f32x4 g0 = *(const f32x4*)(gl + c0) * rs, g1 = *(const f32x4*)(gl + c0 + 4) * rs, b0 = *(const f32x4*)(bl + c0) * sA, b1 = *(const f32x4*)(bl + c0 + 4) * sA;
            typedef unsigned u32x2 __attribute__((ext_vector_type(2))); u32x2 q8;
            q8.x = pg8::pk4_fp8((bf_lo(y.x) - mean) * g0[0] + b0[0], (bf_hi(y.x) - mean) * g0[1] + b0[1], (bf_lo(y.y) - mean) * g0[2] + b0[2], (bf_hi(y.y) - mean) * g0[3] + b0[3]);
            q8.y = pg8::pk4_fp8((bf_lo(y.z) - mean) * g1[0] + b1[0], (bf_hi(y.z) - mean) * g1[1] + b1[1], (bf_lo(y.w) - mean) * g1[2] + b1[2], (bf_hi(y.w) - mean) * g1[3] + b1[3]);
            *(u32x2*)(X8 + rowoff + kb * 32) = q8;
            asm volatile("" ::: "memory"); }
        __syncthreads();
        if (tid < 32) lbase[tid] = (int)__hip_atomic_fetch_add(cnt + tid * 64, (unsigned)lcnt[tid], RLX_AGENT);
        __syncthreads();
        { const int pos = lbase[my_e] + my_rank; lslot[(size_t)my_e * LCAP + pos] = my_slot; lgate[(size_t)my_e * LCAP + pos] = my_gate; }
        __syncthreads();
    }
}

__device__ __forceinline__ float attn_obound(const float* gsub, float osc, int lane) {
    float mg = fmaxf(fabsf(gsub[lane]), fabsf(gsub[64 + lane]));
#pragma unroll
    for (int o = 1; o < 64; o <<= 1) mg = fmaxf(mg, shx(mg, o));
    return 11.3137085f * mg * fabsf(osc);
}

constexpr int NWAVES = 8;
constexpr int N_PHASES = 1 + DEPTH * 7;
#ifndef REP_ATTN
#define REP_ATTN 1
#endif
#ifndef KREP_MOE
#define KREP_MOE 1
#endif
#ifndef REP_MOE
#define REP_MOE 1
#endif
#ifndef REP_P0
#define REP_P0 1
#endif
#ifndef REP_THIN
#define REP_THIN 1
#endif
#ifndef REP_DENSE
#define REP_DENSE 1
#endif
#ifndef MK_SPLIT
#define MK_SPLIT 0
#endif
struct Args { const float* in[17]; float* out; unsigned char* ws; int ph_lo, ph_hi, li, pad; };
typedef const __attribute__((address_space(4))) Args* ArgsP;
enum { I_X = 0, I_RELB, I_AWIN, I_ALAM, I_ASUB, I_AWOUT, I_CWIN, I_CW, I_CWOUT, I_RW, I_RB, I_W1, I_B1, I_W2, I_B2, I_LNG, I_LNB };
__global__ void __launch_bounds__(NWAVES * 64, 2) mk_fwd(Args args) {
    extern __shared__ __attribute__((aligned(16))) unsigned char lds[];
    LAS unsigned char* ldsl = (LAS unsigned char*)lds;
    volatile LAS unsigned* MISC = (volatile LAS unsigned*)(ldsl + MISC_OFF);
    const int tid0 = threadIdx.x;
    const int wave0 = __builtin_amdgcn_readfirstlane(tid0 >> 6);
    const int G0 = gridDim.x, bx0 = blockIdx.x;
#define PHASE_BEGIN() int wv_ = wave0; asm volatile("" : "+s"(wv_)); int ln_; asm volatile("v_mbcnt_lo_u32_b32 %0, -1, 0\n\tv_mbcnt_hi_u32_b32 %0, -1, %0" : "=v"(ln_)); int tid = wv_ * 64 + ln_; int G = G0, bx = bx0; asm volatile("" : "+s"(G), "+s"(bx)); const int vcu = (G % 8 == 0) ? (bx % 8) * (G / 8) + bx / 8 : bx; const int NGW = G * NWAVES; \
        const int lane = tid & 63, wave = __builtin_amdgcn_readfirstlane(tid >> 6); const int gw = vcu * NWAVES + wave; (void)lane; (void)gw; (void)NGW; \
        ArgsP ap = (ArgsP)__builtin_amdgcn_kernarg_segment_ptr(); asm volatile("" : "+s"(ap)); unsigned char* ws = ap->ws; gu32* ctl = (gu32*)(ws + WS_CTL); (void)ctl
    for (int u = tid0; u < (LDS_BYTES - LDSCTL_OFF) / 4; u += NWAVES * 64) ((LAS unsigned*)(ldsl + LDSCTL_OFF))[u] = 0u;
    __syncthreads();
    XcdBarrier bar = xcd_barrier_post((unsigned*)(args.ws + WS_CTL) + CW_BAR + (size_t)args.li * 4096, MISC + 8);
    const int lo = args.ph_lo, hi = args.ph_hi;
#define IN(k) (lo <= (k) && (k) < hi)
#define SEAM(k) do { if (IN((k) + 1)) xcd_barrier(bar); } while (0)
    LAS int* tb = (LAS int*)(ldsl + LDSCTL_OFF); LAS int* cn = tb + 64;

    if (IN(0)) { PHASE_BEGIN();
        Ptrs P; P.x = ap->in[I_X]; P.attn_w_in = ap->in[I_AWIN]; P.attn_w_out = ap->in[I_AWOUT]; P.conv_w_in = ap->in[I_CWIN]; P.conv_w_out = ap->in[I_CWOUT]; P.router_w = ap->in[I_RW]; P.router_b = ap->in[I_RB]; P.ln_g = ap->in[I_LNG]; P.ln_b = ap->in[I_LNB]; P.w1 = ap->in[I_W1]; P.w2 = ap->in[I_W2]; P.ws = ws;
        _Pragma("unroll 1") for (int rep = 0; rep < REP_P0; ++rep) p0_prologue(P, ldsl, gw, NGW, wave, lane); SEAM(0); }

#define MOE_GEMMS(L, pb) do { \
            if (IN((pb) + 4)) { PHASE_BEGIN(); \
                pg8::MoeProb<true, true> S{(const char*)(ws + WS_X8), (const char*)(ws + WS_W1) + (size_t)(L) * 32 * 2048 * 1024, (size_t)2048 * 1024, 8, G, vcu, (int)tb[32], tb, cn, (const int*)(ws + WS_LS), lane, tid}; \
                pg8::EpiMoe1 E{ws + WS_A2, ap->in[I_B1] + (size_t)(L) * 32 * 2048, (const float*)(ws + WS_S1) + (size_t)(L) * 32 * 2048, ln_bound(ap->in[I_LNG] + ((L) * 2 + 0) * D, ap->in[I_LNB] + ((L) * 2 + 0) * D, lane) * (1.0f / F8MAX) * (1.0f / KREP_MOE)}; \
                pg8::gemm_phase<pg8::MoeProb<true, true>, pg8::EpiMoe1, true, true, KREP_MOE>(ldsl + RING_OFF, ldsl + XL_OFF, S, E); \
                SEAM((pb) + 4); \
            } \
            if (IN((pb) + 5)) { PHASE_BEGIN(); \
                pg8::MoeProb<false, true> S{(const char*)(ws + WS_A2), (const char*)(ws + WS_W2) + (size_t)(L) * 32 * 1024 * 1024, (size_t)1024 * 1024, 4, G, vcu, (int)tb[32], tb, cn, (const int*)(ws + WS_LS), lane, tid}; \
                pg8::EpiMoe2 E{ws + WS_Y, ap->in[I_B2] + (size_t)(L) * 32 * 1024, (const float*)(ws + WS_S2) + (size_t)(L) * 32 * 1024, (const int*)(ws + WS_LS), (const float*)(ws + WS_LG)}; \
                pg8::gemm_phase<pg8::MoeProb<false, true>, pg8::EpiMoe2, true, true, KREP_MOE>(ldsl + RING_OFF, ldsl + XL_OFF, S, E); \
                SEAM((pb) + 5); \
            } \
        } while (0)
#if REP_MOE == 2
#define MOE_GEMMS_REP(L, pb) MOE_GEMMS(L, pb)
#else
#define MOE_GEMMS_REP(L, pb) do {} while (0)
#endif
#define MOE_HALF(L, pb) do { \
            if (IN((pb) + 3)) { PHASE_BEGIN(); \
                router_phase((const bf16_t*)(ws + WS_YP), ap->in[I_LNG] + ((L) * 2 + 0) * D, ap->in[I_LNB] + ((L) * 2 + 0) * D, (const bf16_t*)(ws + WS_WR) + (size_t)(L) * 32 * 1024, ap->in[I_RW] + (size_t)(L) * 1024 * 32, ap->in[I_RB] + (L) * 32, \
                             ws + WS_X8, (int*)(ws + WS_LS), (float*)(ws + WS_LG), (unsigned*)(ctl + CW_CNT) + (L) * 32 * 64, (char*)lds + RING_OFF, vcu, G, tid, wave, lane, (const float*)(ws + WS_RC) + (L) * 64); \
                SEAM((pb) + 3); \
            } \
            if (IN((pb) + 4) || IN((pb) + 5)) { PHASE_BEGIN(); \
                if (tid < 64) { const int c_ = (lane < 32) ? (int)__hip_atomic_load(ctl + CW_CNT + ((L) * 32 + (lane & 31)) * 64, RLX_AGENT) : 0; const int t_ = (c_ + 255) >> 8; int p_ = t_; \
                    _Pragma("unroll") for (int o_ = 1; o_ < 32; o_ <<= 1) { const int q_ = __builtin_amdgcn_ds_bpermute((lane - o_) * 4, p_); if (lane >= o_) p_ += q_; } \
                    if (lane < 32) { cn[lane] = c_; tb[lane + 1] = p_; } if (lane == 0) tb[0] = 0; } \
                __syncthreads(); \
            } \
            MOE_GEMMS(L, pb); MOE_GEMMS_REP(L, pb); \
            if (REP_THIN == 2 && IN((pb) + 6)) { PHASE_BEGIN(); \
                ln2_phase((const bf16_t*)(ws + WS_YP), ap->in[I_LNG] + ((L) * 2 + 0) * D, ap->in[I_LNB] + ((L) * 2 + 0) * D, (const unsigned char*)(ws + WS_Y), ap->in[I_LNG] + ((L) * 2 + 1) * D, ap->in[I_LNB] + ((L) * 2 + 1) * D, (bf16_t*)(ws + WS_XB), ((L) == DEPTH - 1) ? ap->out : nullptr, ((((L) == 0) && (CM & 1)) || (((L) == 1) && (QM & 2)) || (((L) == 2) && (CM & 2))) ? ws + WS_XI : nullptr, (float*)(ws + WS_RS), gw, NGW, lane); \
            } \
            if (IN((pb) + 6)) { PHASE_BEGIN(); \
                ln2_phase((const bf16_t*)(ws + WS_YP), ap->in[I_LNG] + ((L) * 2 + 0) * D, ap->in[I_LNB] + ((L) * 2 + 0) * D, (const unsigned char*)(ws + WS_Y), ap->in[I_LNG] + ((L) * 2 + 1) * D, ap->in[I_LNB] + ((L) * 2 + 1) * D, (bf16_t*)(ws + WS_XB), ((L) == DEPTH - 1) ? ap->out : nullptr, ((((L) == 0) && (CM & 1)) || (((L) == 1) && (QM & 2)) || (((L) == 2) && (CM & 2))) ? ws + WS_XI : nullptr, (float*)(ws + WS_RS), gw, NGW, lane); \
                if ((pb) + 7 < N_PHASES) SEAM((pb) + 6); \
            } \
        } while (0)

#pragma unroll 1
    for (int lp = 0; lp < DEPTH / 2; ++lp) {
        {
            const int L = 2 * lp, pb = 1 + L * 7;
            if (IN(pb + 0)) {
                PHASE_BEGIN();
                if (QM == 3 || (QM != 0 && ((QM >> lp) & 1))) {
                pg8::DenseProbT<true> S; S.init(ws + WS_XI, ws + WS_WAI + (size_t)lp * 3072 * 1024, M, 3072, G, bx, tid);
                pg8::EpiQKV8 E{(bf16_t*)(ws + WS_Q), (size_t)(WS_K - WS_Q) / 2, QSCALE, (const float*)(ws + WS_SD) + lp * 3072, (const float*)(ws + WS_RS)};
                pg8::gemm_phase<pg8::DenseProbT<true>, pg8::EpiQKV8, true, true, 1, I8P>(ldsl + RING_OFF, ldsl + XL_OFF, S, E);
                } else {
                pg8::DenseProb S; S.init(ws + WS_XB, (const bf16_t*)(ws + WS_WA16) + (size_t)lp * 3072 * 1024, M, 3072, G, bx, tid);
                pg8::EpiQKV E{(bf16_t*)(ws + WS_Q), (size_t)(WS_K - WS_Q) / 2, QSCALE};
                pg8::gemm_phase<pg8::DenseProb, pg8::EpiQKV, true>(ldsl + RING_OFF, ldsl + XL_OFF, S, E);
                }
                SEAM(pb + 0);
            }
            if (IN(pb + 1)) {
                PHASE_BEGIN();
                const float* lf = ap->in[I_ALAM] + lp * 256;
                const float s1 = wave_sum(lf[lane] * lf[64 + lane]), s2 = wave_sum(lf[128 + lane] * lf[192 + lane]);
                const float lam_init = (lp == 0) ? 0.2f : (0.8f - 0.6f * 0.54881163609402643f);
                const float lam = __expf(s1) - __expf(s2) + lam_init;
                const bool o8 = (AOM == 3) || (AOM != 0 && ((AOM >> lp) & 1));
                const float oscl = o8 ? (1.0f - lam_init) * (F8MAX / attn_obound(ap->in[I_ASUB] + lp * 128, 1.0f - lam_init, lane)) : (1.0f - lam_init);
                int hprev = -1; bool strips_done = !(DEFER_W && lp == 0);
#pragma unroll 1
                for (int rep = 0; rep < REP_ATTN; ++rep)
#pragma unroll 1
                for (int i = 0; i < (BATCH * NH * 32) / 256; ++i) {
                    const int item = i * G + vcu;
                    if (item >= BATCH * NH * 32) break;
                    const int bh = item >> 5, qb = item & 31;
                    const bool newh = (i == 0) || ((bh & 7) != hprev); hprev = bh & 7;
                    att::attn_unit(bh >> 3, bh & 7, qb, (const bf16_t*)(ws + WS_Q), (const bf16_t*)(ws + WS_K), (const bf16_t*)(ws + WS_V), (bf16_t*)(ws + WS_O), lam, oscl,
                                   ap->in[I_ASUB] + lp * 128, ap->in[I_RELB], (char*)lds + RING_OFF, tid, newh, o8);
                    if (!strips_done && i == (vcu & 15)) { strips_done = true;
                        Ptrs P; P.w1 = ap->in[I_W1]; P.w2 = ap->in[I_W2]; P.ws = ws;
                        int ln_s = lane; asm volatile("" : "+v"(ln_s));
                        { const int per_ = (128 * 96 + G - 1) / G, f_ = vcu * per_, e_ = (f_ + per_ < 128 * 96) ? f_ + per_ : 128 * 96; deferred_strips(P.w1, P.w2, ws, ldsl, f_, e_, wave, ln_s); }
                        hprev = -1;
                    }
                }
                if (!strips_done) { int ln_s = lane; asm volatile("" : "+v"(ln_s)); const int per_ = (128 * 96 + G - 1) / G, f_ = vcu * per_, e_ = (f_ + per_ < 128 * 96) ? f_ + per_ : 128 * 96; deferred_strips(ap->in[I_W1], ap->in[I_W2], ws, ldsl, f_, e_, wave, ln_s); }
                SEAM(pb + 1);
            }
            if (IN(pb + 2)) {
                PHASE_BEGIN();
                if ((AOM == 3) || (AOM != 0 && ((AOM >> lp) & 1))) {
                const float lam_init = (lp == 0) ? 0.2f : (0.8f - 0.6f * 0.54881163609402643f);
                pg8::DenseProbT<true> S; S.init(ws + WS_O, ws + WS_WAO8 + (size_t)lp * 1024 * 1024, M, 1024, G, bx, tid);
                pg8::EpiResid8<false> E{(const bf16_t*)(ws + WS_XB), (bf16_t*)(ws + WS_YP), (const float*)(ws + WS_SD + 24 * 1024) + lp * 1024, nullptr, attn_obound(ap->in[I_ASUB] + lp * 128, 1.0f - lam_init, lane) * (1.0f / F8MAX)};
                pg8::gemm_phase<pg8::DenseProbT<true>, pg8::EpiResid8<false>, true, true>(ldsl + RING_OFF, ldsl + XL_OFF, S, E);
                } else {
                pg8::DenseProb S; S.init(ws + WS_O, (const bf16_t*)(ws + WS_WAO) + (size_t)lp * 1024 * 1024, M, 1024, G, bx, tid);
                pg8::EpiResid E{(const bf16_t*)(ws + WS_XB), (bf16_t*)(ws + WS_YP)};
                pg8::gemm_phase<pg8::DenseProb, pg8::EpiResid, true>(ldsl + RING_OFF, ldsl + XL_OFF, S, E);
                }
                SEAM(pb + 2);
            }
            MOE_HALF(L, pb);
        }
        {
            const int L = 2 * lp + 1, pb = 1 + L * 7;
            if (IN(pb + 0)) {
                PHASE_BEGIN();
                if (CM == 3 || (CM != 0 && ((CM >> lp) & 1))) {
                pg8::DenseProbT<true> S; S.init(ws + WS_XI, ws + WS_WCI + (size_t)lp * 3072 * 1024, M, 3072, G, bx, tid);
                pg8::EpiConvIn8 E{(bf16_t*)(ws + WS_Q), (bf16_t*)(ws + WS_K), (const float*)(ws + WS_SD + 32 * 1024) + lp * 3072, (const float*)(ws + WS_RS)};
                pg8::gemm_phase<pg8::DenseProbT<true>, pg8::EpiConvIn8, true, true, 1, I8P>(ldsl + RING_OFF, ldsl + XL_OFF, S, E);
                } else {
                pg8::DenseProb S; S.init(ws + WS_XB, (const bf16_t*)(ws + WS_WC16) + (size_t)lp * 3072 * 1024, M, 3072, G, bx, tid);
                pg8::EpiConvIn E{(bf16_t*)(ws + WS_Q), (bf16_t*)(ws + WS_K)};
                pg8::gemm_phase<pg8::DenseProb, pg8::EpiConvIn, true>(ldsl + RING_OFF, ldsl + XL_OFF, S, E);
                }
                SEAM(pb + 0);
            }
            if (IN(pb + 1)) { PHASE_BEGIN(); conv_phase((const bf16_t*)(ws + WS_Q), (const bf16_t*)(ws + WS_K), ap->in[I_CW] + lp * 3 * D, (bf16_t*)(ws + WS_O), (float*)(ws + WS_RS), (COM == 3) || (COM != 0 && ((COM >> lp) & 1)), gw, NGW, lane); SEAM(pb + 1); }
            if (IN(pb + 2)) {
                PHASE_BEGIN();
                if ((COM == 3) || (COM != 0 && ((COM >> lp) & 1))) {
                pg8::DenseProbT<true> S; S.init(ws + WS_O, ws + WS_WCO8 + (size_t)lp * 1024 * 1024, M, 1024, G, bx, tid);
                pg8::EpiResid8<true> E{(const bf16_t*)(ws + WS_XB), (bf16_t*)(ws + WS_YP), (const float*)(ws + WS_SD + 56 * 1024) + lp * 1024, (const float*)(ws + WS_RS), 1.0f};
                pg8::gemm_phase<pg8::DenseProbT<true>, pg8::EpiResid8<true>, true, true, 1, I8P>(ldsl + RING_OFF, ldsl + XL_OFF, S, E);
                } else {
                pg8::DenseProb S; S.init(ws + WS_O, (const bf16_t*)(ws + WS_WCO) + (size_t)lp * 1024 * 1024, M, 1024, G, bx, tid);
                pg8::EpiResid E{(const bf16_t*)(ws + WS_XB), (bf16_t*)(ws + WS_YP)};
                pg8::gemm_phase<pg8::DenseProb, pg8::EpiResid, true>(ldsl + RING_OFF, ldsl + XL_OFF, S, E);
                }
                SEAM(pb + 2);
            }
            MOE_HALF(L, pb);
        }
    }
#undef IN
#undef SEAM
}

extern "C" void kernel_launch(void* const* d_in, const int* in_sizes, int n_in, void* d_out, int out_size, void* d_ws, size_t ws_size, hipStream_t stream) {
    static int grid = 0;
    if (grid == 0) {
        if (n_in != 17 || in_sizes[0] != M * D || out_size != M * D || ws_size < WS_END) {
            fprintf(stderr, "kernel_launch: shape mismatch: n_in %d in0 %d out %d ws %zu (need %zu)\n", n_in, n_in > 0 ? in_sizes[0] : -1, out_size, ws_size, (size_t)WS_END); grid = -1; return; }
        int dev = 0, cus = 0, per_cu = 0;
        if (hipGetDevice(&dev) != hipSuccess || hipDeviceGetAttribute(&cus, hipDeviceAttributeMultiprocessorCount, dev) != hipSuccess) { grid = -1; return; }
        if (hipFuncSetAttribute((const void*)mk_fwd, hipFuncAttributeMaxDynamicSharedMemorySize, LDS_BYTES) != hipSuccess) { fprintf(stderr, "kernel_launch: hipFuncSetAttribute failed\n"); grid = -1; return; }
        if (hipOccupancyMaxActiveBlocksPerMultiprocessor(&per_cu, (const void*)mk_fwd, NWAVES * 64, LDS_BYTES) != hipSuccess || per_cu < 1)
            fprintf(stderr, "kernel_launch: occupancy query reports %d workgroups per CU\n", per_cu);
        (void)hipGetLastError();
        grid = cus;
    }
    if (grid < 0) return;
    if (hipMemsetAsync((char*)d_ws + WS_CTL, 0, CTL_ZERO_BYTES, stream) != hipSuccess) { fprintf(stderr, "kernel_launch: memset failed\n"); return; }
    Args a{};
    for (int i = 0; i < 17; ++i) a.in[i] = (const float*)d_in[i];
    a.out = (float*)d_out; a.ws = (unsigned char*)d_ws; a.pad = 0;
#if MK_SPLIT
    for (int p = 0; p < N_PHASES; ++p) { a.ph_lo = p; a.ph_hi = p + 1; a.li = p; hipLaunchKernelGGL(mk_fwd, dim3(grid), dim3(NWAVES * 64), LDS_BYTES, stream, a); }
#else
    a.ph_lo = 0; a.ph_hi = N_PHASES; a.li = 0;
    hipLaunchKernelGGL(mk_fwd, dim3(grid), dim3(NWAVES * 64), LDS_BYTES, stream, a);
#endif
    const hipError_t le = hipPeekAtLastError();
    if (le != hipSuccess) fprintf(stderr, "kernel_launch: launch failed: %s\n", hipGetErrorName(le));
}
```

```cpp
#include <hip/hip_runtime.h>
#include <hip/hip_bf16.h>
#include <cstdio>
#include <cstdint>

constexpr int BATCH = 16, SEQ = 4096, D = 1024, M = BATCH * SEQ, DEPTH = 4, NH = 8, NE = 32, TOPK = 4;
constexpr float LN_EPS = 1e-5f;
constexpr float ALPHA = 1.6817928305074290f;
constexpr float LOG2E = 1.4426950408889634f;
constexpr float QSCALE = 0.125f * LOG2E;
constexpr int LCAP = 65536;
constexpr int MAXRT = 1056;

constexpr size_t MiB = 1ull << 20;
constexpr size_t WS_CTL = 0, CTL_ZERO_BYTES = 1 * MiB;
constexpr size_t WS_WAI = 1 * MiB;
constexpr size_t WS_WAO = WS_WAI + 12 * MiB;
constexpr size_t WS_WCI = WS_WAO + 4 * MiB;
constexpr size_t WS_WCO = WS_WCI + 12 * MiB;
constexpr size_t WS_WR  = WS_WCO + 4 * MiB;
constexpr size_t WS_W1  = WS_WR + 1 * MiB;
constexpr size_t WS_W2  = WS_W1 + 256 * MiB;
constexpr size_t WS_S1  = WS_W2 + 128 * MiB;
constexpr size_t WS_S2  = WS_S1 + 1 * MiB;
constexpr size_t WS_SD  = WS_S2 + 512 * 1024;
constexpr size_t WS_RS  = WS_SD + 64 * 1024;
constexpr size_t WS_XB  = WS_S2 + 1 * MiB;
constexpr size_t WS_XI  = WS_XB + 128 * MiB;
constexpr size_t WS_X8  = WS_XI + 128 * MiB;
constexpr size_t WS_YP  = WS_X8 + 64 * MiB;
constexpr size_t WS_Q   = WS_YP + 128 * MiB;
constexpr size_t WS_K   = WS_Q + 128 * MiB;
constexpr size_t WS_V   = WS_K + 128 * MiB;
constexpr size_t WS_O   = WS_V + 128 * MiB;
constexpr size_t WS_LS  = WS_O + 128 * MiB;
constexpr size_t WS_LG  = WS_LS + 8 * MiB;
constexpr size_t WS_A2  = WS_LG + 8 * MiB;
constexpr size_t WS_Y   = WS_A2 + 264 * MiB;
constexpr size_t WS_WA16 = WS_Y + 513 * MiB;
constexpr size_t WS_WC16 = WS_WA16 + 12 * MiB;
constexpr size_t WS_WAO8 = WS_WC16 + 12 * MiB;
constexpr size_t WS_WCO8 = WS_WAO8 + 2 * MiB;
constexpr size_t WS_RC = WS_WCO8 + 2 * MiB;
constexpr size_t WS_END = WS_RC + 1 * MiB;
#ifndef F8_QKV_MASK
#define F8_QKV_MASK 3
#endif
#ifndef F8_CONV_MASK
#define F8_CONV_MASK 3
#endif
#ifndef F8_AOUT_MASK
#define F8_AOUT_MASK 3
#endif
#ifndef F8_COUT_MASK
#define F8_COUT_MASK 3
#endif
constexpr int QM = F8_QKV_MASK, CM = F8_CONV_MASK, AOM = F8_AOUT_MASK, COM = F8_COUT_MASK;
constexpr int NA8 = (AOM & 1) + (AOM >> 1), NO8 = (COM & 1) + (COM >> 1), AJ0 = (AOM & 1) ? 0 : 1, OJ0 = (COM & 1) ? 0 : 1;
constexpr int NA16 = 2 - NA8, NO16 = 2 - NO8, AK0 = (AOM & 1) ? 1 : 0, OK0 = (COM & 1) ? 1 : 0;
constexpr int NQ8 = (QM & 1) + (QM >> 1), NC8 = (CM & 1) + (CM >> 1), QJ0 = (QM & 1) ? 0 : 1, CJ0 = (CM & 1) ? 0 : 1;
constexpr int NQ16 = 2 - NQ8, NC16 = 2 - NC8, QK0 = (QM & 1) ? 1 : 0, CK0 = (CM & 1) ? 1 : 0;
constexpr float F8MAX = 448.0f * 0.999f;
constexpr bool I8P = true;
constexpr float QMAXP = I8P ? 127.0f : 448.0f * 0.999f;
constexpr float YSCALE = 16.0f;
constexpr float A2SCALE = 8.0f;
constexpr int CW_TMO = 0, CW_CODE = 1;
constexpr int CW_BAR = 4096;
constexpr int CW_CNT = 16384;

constexpr int RING_OFF = 0, RING_BYTES = 131072;
constexpr int LDSCTL_OFF = RING_BYTES, MISC_OFF = LDSCTL_OFF + 1024;
constexpr int XL_OFF = LDSCTL_OFF + 4096;
constexpr int LDS_BYTES = 147456;

#define GAS __attribute__((address_space(1)))
#define LAS __attribute__((address_space(3)))
typedef unsigned short bf16_t;
typedef unsigned v4u __attribute__((ext_vector_type(4)));
typedef float f32x4 __attribute__((ext_vector_type(4)));
typedef float f32x2 __attribute__((ext_vector_type(2)));
typedef short bf16x8 __attribute__((ext_vector_type(8)));
typedef float f32x16 __attribute__((ext_vector_type(16)));
typedef short s16x4 __attribute__((ext_vector_type(4)));
typedef GAS unsigned gu32;
#define RLX_AGENT __ATOMIC_RELAXED, __HIP_MEMORY_SCOPE_AGENT
#define LDS_WAIT() asm volatile("s_waitcnt lgkmcnt(0)" ::: "memory")
#define VM_WAIT() asm volatile("s_waitcnt vmcnt(0)" ::: "memory")

__device__ __forceinline__ unsigned cvt_pk_bf16(float lo, float hi) { unsigned r; asm volatile("v_cvt_pk_bf16_f32 %0, %1, %2" : "=v"(r) : "v"(lo), "v"(hi)); return r; }
__device__ __forceinline__ float bf_lo(unsigned u) { return __uint_as_float(u << 16); }
__device__ __forceinline__ float bf_hi(unsigned u) { return __uint_as_float(u & 0xffff0000u); }
__device__ __forceinline__ int lane_local() { int l; asm volatile("v_mbcnt_lo_u32_b32 %0, -1, 0\n\tv_mbcnt_hi_u32_b32 %0, -1, %0" : "=v"(l)); return l; }
__device__ __forceinline__ float shx(float v, int m, int l) { return __int_as_float(__builtin_amdgcn_ds_bpermute((l ^ m) << 2, __float_as_int(v))); }
__device__ __forceinline__ float shx(float v, int m) { return shx(v, m, lane_local()); }
__device__ __forceinline__ float wave_sum(float v) {
    const int l_ = lane_local();
#pragma unroll
    for (int o = 1; o < 64; o <<= 1) v += shx(v, o, l_);
    return v;
}

#ifndef KREP_MOE
#define KREP_MOE 1
#endif
namespace pg8 {
constexpr float KREP_MOE_ = (float)KREP_MOE;
#define PG8_LAS __attribute__((address_space(3)))
constexpr int BM = 256, BK = 64, HALF = 128, HTB = HALF * BK * 2, STAGE_BYTES = 8 * HTB, NXCD = 8, WGM = 8, KD = 1024, NTK = KD / BK;

__host__ __device__ __forceinline__ int lds_byte(int r, int c) { const int st = (r >> 4) * 2 + (c >> 5), rr = r & 15, cc = c & 31, ob = rr * 64 + cc * 2; return st * 1024 + (ob ^ (((ob >> 9) & 1) << 5)); }
__host__ __device__ __forceinline__ void stage_rc(int b, int& R, int& C) { const int st = b / 1024, sb = b % 1024, swz = sb ^ (((sb >> 9) & 1) << 5); R = (st >> 1) * 16 + swz / 64; C = (st & 1) * 32 + (swz % 64) / 2; }
__host__ __device__ __forceinline__ int perm32(int rho) { const int n = rho >> 4, i = rho & 15; return 8 * (i >> 2) + 4 * n + (i & 3); }

struct Unit { int pm, pn, e, valid, lr0; };
__device__ __forceinline__ void dma1k(const void* src, PG8_LAS unsigned char* dst, int lane) {
    __builtin_amdgcn_global_load_lds((const __attribute__((address_space(1))) unsigned*)((const char*)src + lane * 16), (PG8_LAS unsigned*)dst, 16, 0, 0);
}
constexpr int XL_EPI = 4096, XL_GATHER = 1024, XL_BYTES = 2 * (XL_EPI + XL_GATHER);

template <bool F8> struct DenseProbT {
    static constexpr bool GATHER = false;
    static constexpr int RP = F8 ? 1024 : 2048;
    const char* A; const char* Bt; int nM, nN, nwg, G, c, tid;
    __device__ void init(const void* A_, const void* Bt_, int Mrows, int N, int G_, int c_, int tid_) { A = (const char*)A_; Bt = (const char*)Bt_; nM = Mrows / BM; nN = N / BM; nwg = nM * nN; G = G_; c = c_; tid = tid_; }
    __device__ __forceinline__ bool next(int i, Unit& u) const {
        const long L = (long)i * G + c; if (L >= nwg) return false;
        int wgid = (int)L; { const int q = nwg / NXCD, r = nwg % NXCD, xcd = wgid % NXCD, off = wgid / NXCD; wgid = (xcd < r ? xcd * (q + 1) : r * (q + 1) + (xcd - r) * q) + off; }
        const int nig = WGM * nN, gid = wgid / nig, fm = gid * WGM, gsz = (nM - fm) < WGM ? (nM - fm) : WGM;
        u.pm = fm + ((wgid % nig) % gsz); u.pn = (wgid % nig) / gsz; u.e = 0; u.valid = 256; u.lr0 = 0; return true;
    }
    __device__ __forceinline__ void a_off(const Unit& u, const int (&RA)[2], const int (&CA)[2], unsigned (&vo)[2][2]) const {
#pragma unroll
        for (int h = 0; h < 2; ++h)
#pragma unroll
            for (int i = 0; i < 2; ++i) vo[h][i] = (unsigned)((u.pm * BM + h * HALF + RA[i]) * RP + CA[i] * 2);
    }
    __device__ __forceinline__ unsigned a_tile(const Unit& u) const { return (unsigned)u.pm * (unsigned)(BM * RP); }
    __device__ __forceinline__ unsigned b_off(const Unit& u) const { return (unsigned)u.pn * (unsigned)(BM * RP); }    __device__ __forceinline__ void dma_rows(const Unit&, PG8_LAS unsigned char*, int, int) const {}
    __device__ __forceinline__ void a_off_lds(const Unit&, const int (&)[2], const int (&)[2], const PG8_LAS unsigned char*, unsigned (&)[2][2]) const {}
};
typedef DenseProbT<false> DenseProb;

template <bool GATHER_, bool F8> struct MoeProb {
    static constexpr bool GATHER = GATHER_;
    static constexpr int RP = F8 ? 1024 : 2048;
    const char* A; const char* Bt; size_t b_estride; int nN, G, v, RT; const PG8_LAS int* tb; const PG8_LAS int* cn; const int* lslot; int lane, tid;
    __device__ __forceinline__ bool next(int i, Unit& u) const {
        const int L = i * G + v; if (L >= RT * nN) return false;
        const int rt = L / nN; u.pm = rt; u.pn = L - rt * nN;
        const unsigned long long bal = __ballot(lane < 32 && rt >= tb[(lane & 31) + 1]);
        const int e = __builtin_amdgcn_readfirstlane(__popcll(bal)); u.e = e;
        const int tb_e = __builtin_amdgcn_readfirstlane(tb[e]), cn_e = __builtin_amdgcn_readfirstlane(cn[e]);
        u.lr0 = 256 * (rt - tb_e); const int rem = cn_e - u.lr0; u.valid = rem < 256 ? rem : 256; return true;
    }
    __device__ __forceinline__ void a_off(const Unit& u, const int (&RA)[2], const int (&CA)[2], unsigned (&vo)[2][2]) const {
        if constexpr (GATHER) {
            const int* ls = lslot + (size_t)u.e * LCAP + u.lr0;
#pragma unroll
            for (int h = 0; h < 2; ++h)
#pragma unroll
                for (int i = 0; i < 2; ++i) { const int rl = h * HALF + RA[i]; const int slot = ls[rl < u.valid ? rl : 0]; vo[h][i] = (unsigned)((slot >> 2) * RP + CA[i] * 2); }
        } else {
#pragma unroll
            for (int h = 0; h < 2; ++h)
#pragma unroll
                for (int i = 0; i < 2; ++i) vo[h][i] = (unsigned)((u.pm * BM + h * HALF + RA[i]) * RP + CA[i] * 2);
        }
    }
    __device__ __forceinline__ unsigned a_tile(const Unit& u) const { return (unsigned)u.pm * (unsigned)(BM * RP); }
    __device__ __forceinline__ unsigned b_off(const Unit& u) const { return (unsigned)u.e * (unsigned)b_estride + (unsigned)u.pn * (unsigned)(BM * RP); }
    __device__ __forceinline__ void dma_rows(const Unit& u, PG8_LAS unsigned char* dst, int wid, int lane_) const { if constexpr (GATHER) { if (wid == 0) dma1k(lslot + (size_t)u.e * LCAP + u.lr0, dst, lane_); } }
    __device__ __forceinline__ void a_off_lds(const Unit& u, const int (&RA)[2], const int (&CA)[2], const PG8_LAS unsigned char* src, unsigned (&vo)[2][2]) const {
        if constexpr (GATHER) { const PG8_LAS int* ls = (const PG8_LAS int*)src;
#pragma unroll
            for (int h = 0; h < 2; ++h)
#pragma unroll
                for (int i = 0; i < 2; ++i) { const int rl = h * HALF + RA[i]; const int slot = ls[rl < u.valid ? rl : 0]; vo[h][i] = (unsigned)((slot >> 2) * RP + CA[i] * 2); } }
    }
};

__device__ __forceinline__ v4u pack8(const f32x4 v0, const f32x4 v1) { v4u w; w.x = cvt_pk_bf16(v0[0], v0[1]); w.y = cvt_pk_bf16(v0[2], v0[3]); w.z = cvt_pk_bf16(v1[0], v1[1]); w.w = cvt_pk_bf16(v1[2], v1[3]); return w; }

__device__ __forceinline__ void st16(void* base, unsigned off, v4u v) { *(v4u*)((char*)base + off) = v; }
struct EpiQKV {
    __device__ __forceinline__ void dma(const Unit&, PG8_LAS unsigned char*, int, int) const {}
    bf16_t* O; size_t stride; float scale0;
    __device__ __forceinline__ void operator()(const f32x4 (&acc)[2][2][4][2], const Unit& u, int wr, int wc, int fr_, int fq_, const PG8_LAS unsigned char* xl) const {
        int fr = fr_, fq = fq_; asm volatile("" : "+v"(fr), "+v"(fq));
        const int row0 = u.pm * BM + wr * 64 + fr; const int t = u.pn >> 2; const int colt = (u.pn & 3) * BM;
        bf16_t* base = O + (size_t)t * stride; const float sc = (t == 0) ? scale0 : 1.f; const unsigned off0 = (unsigned)(row0 * D + colt + wc * 32 + 8 * fq) * 2u;
#pragma unroll
        for (int ai = 0; ai < 2; ++ai)
#pragma unroll
            for (int m = 0; m < 4; ++m)
#pragma unroll
                for (int bj = 0; bj < 2; ++bj) st16(base, off0 + (unsigned)((ai * HALF + m * 16) * D + bj * HALF) * 2u, pack8(acc[ai][bj][m][0] * sc, acc[ai][bj][m][1] * sc));
    }
};
struct EpiConvIn {
    __device__ __forceinline__ void dma(const Unit&, PG8_LAS unsigned char*, int, int) const {}
    bf16_t* GB; bf16_t* Z;
    __device__ __forceinline__ void operator()(const f32x4 (&acc)[2][2][4][2], const Unit& u, int wr, int wc, int fr_, int fq_, const PG8_LAS unsigned char* xl) const {
        int fr = fr_, fq = fq_; asm volatile("" : "+v"(fr), "+v"(fq));
        const int row0 = u.pm * BM + wr * 64 + fr;
        if (u.pn < 4) { const unsigned off0 = (unsigned)(row0 * D + u.pn * BM + wc * 32 + 8 * fq) * 2u;
#pragma unroll
            for (int ai = 0; ai < 2; ++ai)
#pragma unroll
                for (int m = 0; m < 4; ++m)
#pragma unroll
                    for (int bj = 0; bj < 2; ++bj) st16(GB, off0 + (unsigned)((ai * HALF + m * 16) * D + bj * HALF) * 2u, pack8(acc[ai][bj][m][0], acc[ai][bj][m][1]));
        } else { const unsigned off0 = (unsigned)(row0 * D + (u.pn - 4) * HALF + wc * 32 + 8 * fq) * 2u;
#pragma unroll
            for (int ai = 0; ai < 2; ++ai)
#pragma unroll
                for (int m = 0; m < 4; ++m) st16(Z, off0 + (unsigned)((ai * HALF + m * 16) * D) * 2u, pack8(acc[ai][0][m][0] * acc[ai][1][m][0], acc[ai][0][m][1] * acc[ai][1][m][1]));
        }
    }
};
struct EpiQKV8 {
    bf16_t* O; size_t stride; float scale0; const float* sw; const float* rs;
    __device__ __forceinline__ void dma(const Unit& u, PG8_LAS unsigned char* xl, int wid, int lane) const {
        if (wid == 0) dma1k(sw + u.pn * BM, xl, lane); else if (wid == 1) dma1k(rs + u.pm * BM, xl + 1024, lane);
    }
    __device__ __forceinline__ void operator()(const f32x4 (&acc)[2][2][4][2], const Unit& u, int wr, int wc, int fr_, int fq_, const PG8_LAS unsigned char* xl) const {
        int fr = fr_, fq = fq_; asm volatile("" : "+v"(fr), "+v"(fq));
        const int row0 = u.pm * BM + wr * 64 + fr; const int t = u.pn >> 2; const int colt = (u.pn & 3) * BM; const int cl = wc * 32 + 8 * fq;
        bf16_t* base = O + (size_t)t * stride; const float sc = (t == 0) ? scale0 : 1.f; const unsigned off0 = (unsigned)(row0 * D + colt + cl) * 2u;
        const PG8_LAS float* sp = (const PG8_LAS float*)xl + cl; const PG8_LAS float* rp = (const PG8_LAS float*)(xl + 1024) + wr * 64 + fr;
        f32x4 sv[2][2];
#pragma unroll
        for (int bj = 0; bj < 2; ++bj)
#pragma unroll
            for (int n = 0; n < 2; ++n) sv[bj][n] = *(const PG8_LAS f32x4*)(sp + bj * HALF + 4 * n) * sc;
#pragma unroll
        for (int ai = 0; ai < 2; ++ai)
#pragma unroll
            for (int m = 0; m < 4; ++m) { const float r = rp[ai * HALF + m * 16];
#pragma unroll
                for (int bj = 0; bj < 2; ++bj) st16(base, off0 + (unsigned)((ai * HALF + m * 16) * D + bj * HALF) * 2u, pack8(acc[ai][bj][m][0] * (sv[bj][0] * r), acc[ai][bj][m][1] * (sv[bj][1] * r))); }
    }
};
struct EpiConvIn8 {
    bf16_t* GB; bf16_t* Z; const float* sw; const float* rs;
    __device__ __forceinline__ void dma(const Unit& u, PG8_LAS unsigned char* xl, int wid, int lane) const { if (wid == 0) dma1k(sw + u.pn * BM, xl, lane); else if (wid == 1) dma1k(rs + u.pm * BM, xl + 1024, lane); }
    __device__ __forceinline__ void operator()(const f32x4 (&acc)[2][2][4][2], const Unit& u, int wr, int wc, int fr_, int fq_, const PG8_LAS unsigned char* xl) const {
        int fr = fr_, fq = fq_; asm volatile("" : "+v"(fr), "+v"(fq));
        const int row0 = u.pm * BM + wr * 64 + fr; const int cl = wc * 32 + 8 * fq;
        const PG8_LAS float* sp = (const PG8_LAS float*)xl + cl; const PG8_LAS float* rp = (const PG8_LAS float*)(xl + 1024) + wr * 64 + fr;
        f32x4 sv[2][2];
#pragma unroll
        for (int bj = 0; bj < 2; ++bj)
#pragma unroll
            for (int n = 0; n < 2; ++n) sv[bj][n] = *(const PG8_LAS f32x4*)(sp + bj * HALF + 4 * n);
        if (u.pn < 4) { const unsigned off0 = (unsigned)(row0 * D + u.pn * BM + cl) * 2u;
#pragma unroll
            for (int ai = 0; ai < 2; ++ai)
#pragma unroll
                for (int m = 0; m < 4; ++m) { const float r = rp[ai * HALF + m * 16];
#pragma unroll
                    for (int bj = 0; bj < 2; ++bj) st16(GB, off0 + (unsigned)((ai * HALF + m * 16) * D + bj * HALF) * 2u, pack8(acc[ai][bj][m][0] * (sv[bj][0] * r), acc[ai][bj][m][1] * (sv[bj][1] * r))); }
        } else { const unsigned off0 = (unsigned)(row0 * D + (u.pn - 4) * HALF + cl) * 2u;
            const f32x4 sz0 = sv[0][0] * sv[1][0], sz1 = sv[0][1] * sv[1][1];
#pragma unroll
            for (int ai = 0; ai < 2; ++ai)
#pragma unroll
                for (int m = 0; m < 4; ++m) { const float r = rp[ai * HALF + m * 16], r2 = r * r;
                    st16(Z, off0 + (unsigned)((ai * HALF + m * 16) * D) * 2u, pack8(acc[ai][0][m][0] * acc[ai][1][m][0] * (sz0 * r2), acc[ai][0][m][1] * acc[ai][1][m][1] * (sz1 * r2))); }
        }
    }
};
struct EpiResid {
    __device__ __forceinline__ void dma(const Unit&, PG8_LAS unsigned char*, int, int) const {}
    const bf16_t* X; bf16_t* Yp;
    __device__ __forceinline__ void operator()(const f32x4 (&acc)[2][2][4][2], const Unit& u, int wr, int wc, int fr_, int fq_, const PG8_LAS unsigned char* xl) const {
        int fr = fr_, fq = fq_; asm volatile("" : "+v"(fr), "+v"(fq));
        const unsigned off0 = (unsigned)((u.pm * BM + wr * 64 + fr) * D + u.pn * BM + wc * 32 + 8 * fq) * 2u;
#pragma unroll
        for (int ai = 0; ai < 2; ++ai)
#pragma unroll
            for (int m = 0; m < 4; ++m)
#pragma unroll
                for (int bj = 0; bj < 2; ++bj) { const unsigned off = off0 + (unsigned)((ai * HALF + m * 16) * D + bj * HALF) * 2u; const v4u xr = *(const v4u*)((const char*)X + off);
                    f32x4 v0 = acc[ai][bj][m][0], v1 = acc[ai][bj][m][1];
                    v0[0] += ALPHA * bf_lo(xr.x); v0[1] += ALPHA * bf_hi(xr.x); v0[2] += ALPHA * bf_lo(xr.y); v0[3] += ALPHA * bf_hi(xr.y);
                    v1[0] += ALPHA * bf_lo(xr.z); v1[1] += ALPHA * bf_hi(xr.z); v1[2] += ALPHA * bf_lo(xr.w); v1[3] += ALPHA * bf_hi(xr.w);
                    st16(Yp, off, pack8(v0, v1)); }
    }
};
template <bool ROWS> struct EpiResid8 {
    const bf16_t* X; bf16_t* Yp; const float* sw; const float* rs; float rsc;
    __device__ __forceinline__ void dma(const Unit& u, PG8_LAS unsigned char* xl, int wid, int lane) const {
        if (wid == 0) dma1k(sw + u.pn * BM, xl, lane); else if (ROWS && wid == 1) dma1k(rs + u.pm * BM, xl + 1024, lane);
    }
    __device__ __forceinline__ void operator()(const f32x4 (&acc)[2][2][4][2], const Unit& u, int wr, int wc, int fr_, int fq_, const PG8_LAS unsigned char* xl) const {
        int fr = fr_, fq = fq_; asm volatile("" : "+v"(fr), "+v"(fq));
        const int cl = wc * 32 + 8 * fq;
        const unsigned off0 = (unsigned)((u.pm * BM + wr * 64 + fr) * D + u.pn * BM + cl) * 2u;
        const PG8_LAS float* sp = (const PG8_LAS float*)xl + cl; const PG8_LAS float* rp = (const PG8_LAS float*)(xl + 1024) + wr * 64 + fr;
        f32x4 sv[2][2];
#pragma unroll
        for (int bj = 0; bj < 2; ++bj)
#pragma unroll
            for (int n = 0; n < 2; ++n) sv[bj][n] = *(const PG8_LAS f32x4*)(sp + bj * HALF + 4 * n) * (ROWS ? 1.0f : rsc);
#pragma unroll
        for (int ai = 0; ai < 2; ++ai)
#pragma unroll
            for (int m = 0; m < 4; ++m) { float r = 1.0f; if (ROWS) r = rp[ai * HALF + m * 16];
#pragma unroll
                for (int bj = 0; bj < 2; ++bj) { const unsigned off = off0 + (unsigned)((ai * HALF + m * 16) * D + bj * HALF) * 2u; const v4u xr = *(const v4u*)((const char*)X + off);
                    f32x4 v0 = acc[ai][bj][m][0] * sv[bj][0], v1 = acc[ai][bj][m][1] * sv[bj][1]; if (ROWS) { v0 *= r; v1 *= r; }
                    v0[0] += ALPHA * bf_lo(xr.x); v0[1] += ALPHA * bf_hi(xr.x); v0[2] += ALPHA * bf_lo(xr.y); v0[3] += ALPHA * bf_hi(xr.y);
                    v1[0] += ALPHA * bf_lo(xr.z); v1[1] += ALPHA * bf_hi(xr.z); v1[2] += ALPHA * bf_lo(xr.w); v1[3] += ALPHA * bf_hi(xr.w);
                    st16(Yp, off, pack8(v0, v1)); } }
    }
};
__device__ __forceinline__ unsigned pk4_fp8(float a, float b, float c, float d) { int p = 0; p = __builtin_amdgcn_cvt_pk_fp8_f32(a, b, p, false); p = __builtin_amdgcn_cvt_pk_fp8_f32(c, d, p, true); return (unsigned)p; }
__device__ __forceinline__ unsigned pk4_i8(float a, float b, float c, float d) {
    unsigned r = 0;
    r = __builtin_amdgcn_cvt_pk_u8_f32(__builtin_rintf(a + 128.f), 0, r); r = __builtin_amdgcn_cvt_pk_u8_f32(__builtin_rintf(b + 128.f), 1, r);
    r = __builtin_amdgcn_cvt_pk_u8_f32(__builtin_rintf(c + 128.f), 2, r); r = __builtin_amdgcn_cvt_pk_u8_f32(__builtin_rintf(d + 128.f), 3, r);
    return r ^ 0x80808080u;
}
template <bool I8> __device__ __forceinline__ unsigned pkq4(float a, float b, float c, float d) { if constexpr (I8) return pk4_i8(a, b, c, d); else return pk4_fp8(a, b, c, d); }
__device__ __forceinline__ f32x2 swiglu8_pk(f32x2 g, f32x2 l8) {
    g.x = fminf(g.x, 7.0f); g.y = fminf(g.y, 7.0f);
    l8.x = fminf(fmaxf(l8.x, -56.0f), 56.0f); l8.y = fminf(fmaxf(l8.y, -56.0f), 56.0f);
    const f32x2 t = g * (-1.702f * LOG2E);
    f32x2 e; e.x = __builtin_amdgcn_exp2f(t.x); e.y = __builtin_amdgcn_exp2f(t.y);
    const f32x2 d = e + 1.0f;
    f32x2 r; r.x = __builtin_amdgcn_rcpf(d.x); r.y = __builtin_amdgcn_rcpf(d.y);
    return (g * r) * (l8 + A2SCALE);
}
struct EpiMoe1 {
    unsigned char* A2; const float* b1; const float* sw; float inv_sa;
    __device__ __forceinline__ void dma(const Unit& u, PG8_LAS unsigned char* xl, int wid, int lane) const {
        if (wid == 0) dma1k(b1 + (size_t)u.e * 2048 + u.pn * BM, xl, lane); else if (wid == 1) dma1k(sw + (size_t)u.e * 2048 + u.pn * BM, xl + 1024, lane);
    }
    __device__ __forceinline__ void operator()(const f32x4 (&acc)[2][2][4][2], const Unit& u, int wr, int wc, int fr_, int fq_, const PG8_LAS unsigned char* xl) const {
        int fr = fr_, fq = fq_; asm volatile("" : "+v"(fr), "+v"(fq));
        const int cl = wc * 32 + 8 * fq; const unsigned off0 = (unsigned)((u.pm * BM + wr * 64 + fr) * D + u.pn * HALF + cl);
        const PG8_LAS float* bp = (const PG8_LAS float*)xl + 2 * cl; f32x4 bb[4];
#pragma unroll
        for (int j = 0; j < 4; ++j) bb[j] = *(const PG8_LAS f32x4*)(bp + 4 * j);
        const PG8_LAS float* sp = (const PG8_LAS float*)(xl + 1024) + cl;
        const f32x4 sg0 = *(const PG8_LAS f32x4*)(sp) * inv_sa, sg1 = *(const PG8_LAS f32x4*)(sp + 4) * inv_sa;
        const f32x4 sl0 = *(const PG8_LAS f32x4*)(sp + HALF) * (inv_sa * A2SCALE), sl1 = *(const PG8_LAS f32x4*)(sp + HALF + 4) * (inv_sa * A2SCALE);
        f32x2 sgp[4] = {{sg0[0], sg0[1]}, {sg0[2], sg0[3]}, {sg1[0], sg1[1]}, {sg1[2], sg1[3]}}, slp[4] = {{sl0[0], sl0[1]}, {sl0[2], sl0[3]}, {sl1[0], sl1[1]}, {sl1[2], sl1[3]}};
        f32x2 bgp[4], blp[4];
#pragma unroll
        for (int q = 0; q < 4; ++q) { bgp[q] = (f32x2){bb[q][0], bb[q][2]}; blp[q] = (f32x2){bb[q][1] * A2SCALE, bb[q][3] * A2SCALE}; }
        const unsigned offp = off0 + ((fq & 1) ? (unsigned)(16 * D - 8) : 0u);
#pragma unroll
        for (int ai = 0; ai < 2; ++ai)
#pragma unroll
            for (int mp = 0; mp < 2; ++mp) { typedef unsigned u32x2 __attribute__((ext_vector_type(2))); u32x2 w[2];
#pragma unroll
                for (int mm = 0; mm < 2; ++mm) { const int m = 2 * mp + mm; f32x2 o[4];
#pragma unroll
                    for (int q = 0; q < 4; ++q) { const f32x4 ga = acc[ai][0][m][q >> 1], la = acc[ai][1][m][q >> 1]; const int h2 = (q & 1) * 2;
                        const f32x2 g = (f32x2){ga[h2], ga[h2 + 1]} * sgp[q] + bgp[q], l8 = (f32x2){la[h2], la[h2 + 1]} * slp[q] + blp[q];
                        o[q] = swiglu8_pk(g, l8); }
                    w[mm].x = pk4_fp8(o[0].x, o[0].y, o[1].x, o[1].y); w[mm].y = pk4_fp8(o[2].x, o[2].y, o[3].x, o[3].y); }
                const auto sx = __builtin_amdgcn_permlane16_swap(w[0].x, w[1].x, false, false); const auto sy = __builtin_amdgcn_permlane16_swap(w[0].y, w[1].y, false, false);
                const v4u ov = {sx[0], sy[0], sx[1], sy[1]};
                *(v4u*)(A2 + (offp + (unsigned)((ai * HALF + mp * 32) * D))) = ov; }
    }
};
struct EpiMoe2 {
    unsigned char* Y; const float* b2; const float* sw; const int* lslot; const float* lgate;
    __device__ __forceinline__ void dma(const Unit& u, PG8_LAS unsigned char* xl, int wid, int lane) const {
        const size_t lb = (size_t)u.e * LCAP + u.lr0;
        if (wid == 0) dma1k(b2 + (size_t)u.e * 1024 + u.pn * BM, xl, lane); else if (wid == 1) dma1k(sw + (size_t)u.e * 1024 + u.pn * BM, xl + 1024, lane);
        else if (wid == 2) dma1k(lslot + lb, xl + 2048, lane); else if (wid == 3) dma1k(lgate + lb, xl + 3072, lane);
    }
    __device__ __forceinline__ void operator()(const f32x4 (&acc)[2][2][4][2], const Unit& u, int wr, int wc, int fr_, int fq_, const PG8_LAS unsigned char* xl) const {
        int fr = fr_, fq = fq_; asm volatile("" : "+v"(fr), "+v"(fq));
        const int rl0 = wr * 64 + fr, cl = wc * 32 + 8 * fq, col0 = u.pn * BM + cl;
        const PG8_LAS float* bp = (const PG8_LAS float*)xl + 64 * wc + 16 * fq;
        const PG8_LAS float* sp = (const PG8_LAS float*)(xl + 1024) + cl; f32x4 bv[2][2], sv[2][2];
#pragma unroll
        for (int bj = 0; bj < 2; ++bj)
#pragma unroll
            for (int n = 0; n < 2; ++n) { bv[bj][n] = *(const PG8_LAS f32x4*)(bp + 8 * bj + 4 * n); sv[bj][n] = *(const PG8_LAS f32x4*)(sp + bj * HALF + 4 * n) * (1.0f / (A2SCALE * KREP_MOE_)); }
        const PG8_LAS int* sl = (const PG8_LAS int*)(xl + 2048); const PG8_LAS float* gl = (const PG8_LAS float*)(xl + 3072);
        const unsigned cadj = (unsigned)(u.pn * BM + 64 * wc + 16 * fq);
#pragma unroll
        for (int ai = 0; ai < 2; ++ai)
#pragma unroll
            for (int m = 0; m < 4; ++m) { const int rl = rl0 + ai * HALF + m * 16;
                const bool ok = rl < u.valid; const int slot = ok ? sl[rl] : M * 4; const float g = gl[rl] * YSCALE;
                typedef unsigned u32x2 __attribute__((ext_vector_type(2))); u32x2 w[2];
#pragma unroll
                for (int bj = 0; bj < 2; ++bj) { f32x4 v0 = (acc[ai][bj][m][0] * sv[bj][0] + bv[bj][0]) * g, v1 = (acc[ai][bj][m][1] * sv[bj][1] + bv[bj][1]) * g;
#pragma unroll
                    for (int i = 0; i < 4; ++i) { v0[i] = fminf(fmaxf(v0[i], -448.0f), 448.0f); v1[i] = fminf(fmaxf(v1[i], -448.0f), 448.0f); }
                    w[bj].x = pk4_fp8(v0[0], v0[1], v0[2], v0[3]); w[bj].y = pk4_fp8(v1[0], v1[1], v1[2], v1[3]); }
                const v4u o = {w[0].x, w[0].y, w[1].x, w[1].y};
                *(v4u*)(Y + ((unsigned)(slot * D) + cadj)) = o; }
    }
};

typedef int v8i_t __attribute__((ext_vector_type(8))); typedef int v4i_t __attribute__((ext_vector_type(4)));
__device__ __forceinline__ v8i_t cat8(bf16x8 lo, bf16x8 hi) { const v4i_t a = __builtin_bit_cast(v4i_t, lo), b = __builtin_bit_cast(v4i_t, hi); return __builtin_shufflevector(a, b, 0, 1, 2, 3, 4, 5, 6, 7); }
template <class Prob, class Epi, bool ALIGN_EPI, bool F8 = false, int KREP = 1, bool I8 = false>
__device__ __forceinline__ void gemm_phase(PG8_LAS unsigned char* lds, PG8_LAS unsigned char* xl, const Prob& P, const Epi& E) {
    int tid_ = P.tid; asm volatile("" : "+v"(tid_));
    const int tid = tid_, wid = __builtin_amdgcn_readfirstlane(tid >> 6), lane = tid & 63, wr = wid >> 2, wc = wid & 3, fr = lane & 15, fq = lane >> 4;
    constexpr int RP = F8 ? 1024 : 2048, nt = F8 ? 8 : NTK;
    constexpr bool GA = Prob::GATHER;
    int RA[2], CA[2]; unsigned voffB[2], voffA[2];
#pragma unroll
    for (int i = 0; i < 2; ++i) { int R, C; stage_rc(tid * 16 + i * 8192, R, C); const int Rb = (R & ~31) + perm32(R & 31); RA[i] = R; CA[i] = C; voffB[i] = (unsigned)(Rb * RP + C * 2); voffA[i] = (unsigned)(R * RP + C * 2); }
    constexpr unsigned kstep = (unsigned)(BK * 2);
    constexpr unsigned hstep = (unsigned)HALF * RP;
    const unsigned ldsw = (unsigned)wid * 1024u;
    const int aoff = lds_byte(wr * 64 + fr, fq * 8), boff = lds_byte(wc * 32 + fr, fq * 8);
    typedef const __attribute__((address_space(1))) unsigned* gptr_t;
#define PG8_SA(b, h) (((b) * 2 + (h)) * HTB)
#define PG8_SB(b, h) ((4 + (b) * 2 + (h)) * HTB)
#define PG8_STAGE_B(bufoff, uoff) do { _Pragma("unroll") for (int _i = 0; _i < 2; ++_i) \
        __builtin_amdgcn_global_load_lds((gptr_t)(Bb + (voffB[_i] + (unsigned)(uoff))), (PG8_LAS unsigned*)(lds + (bufoff) + ldsw + _i * 8192), 16, 0, 0); } while (0)
#define PG8_STAGE_A(bufoff, koff, h, NX) do { _Pragma("unroll") for (int _i = 0; _i < 2; ++_i) { unsigned _o; \
        if constexpr (GA) _o = ((NX) ? vn[h][_i] : vc[h][_i]) + (unsigned)(koff); else _o = voffA[_i] + (((NX) ? nAo : cAo) + (unsigned)(h) * hstep + (unsigned)(koff)); \
        __builtin_amdgcn_global_load_lds((gptr_t)(Ab + _o), (PG8_LAS unsigned*)(lds + (bufoff) + ldsw + _i * 8192), 16, 0, 0); } } while (0)
#define PG8_LDA(dst, b, h) do { _Pragma("unroll") for (int m = 0; m < 4; ++m) _Pragma("unroll") for (int k = 0; k < 2; ++k) dst[m][k] = *(const PG8_LAS bf16x8*)(lds + PG8_SA(b, h) + aoff + m * 2048 + k * 1024); } while (0)
#define PG8_LDB(dst, b, h) do { _Pragma("unroll") for (int n = 0; n < 2; ++n) _Pragma("unroll") for (int k = 0; k < 2; ++k) dst[n][k] = *(const PG8_LAS bf16x8*)(lds + PG8_SB(b, h) + boff + n * 2048 + k * 1024); } while (0)
#define PG8_MMA(ai, bj, At, Bt) do { __builtin_amdgcn_s_setprio(1); _Pragma("unroll") for (int m = 0; m < 4; ++m) _Pragma("unroll") for (int n = 0; n < 2; ++n) _Pragma("unroll") for (int k = 0; k < 2; ++k) \
        acc[ai][bj][m][n] = __builtin_amdgcn_mfma_f32_16x16x32_bf16(Bt[n][k], At[m][k], acc[ai][bj][m][n], 0, 0, 0); __builtin_amdgcn_s_setprio(0); } while (0)
#define PG8_MMA8(ai, bj, At, Bt) do { __builtin_amdgcn_s_setprio(1); if constexpr (I8) { _Pragma("unroll") for (int k = 0; k < 2; ++k) _Pragma("unroll") for (int m = 0; m < 4; ++m) _Pragma("unroll") for (int n = 0; n < 2; ++n) \
        asm volatile("v_mfma_i32_16x16x64_i8 %0, %1, %2, %0" : "+v"(acc[ai][bj][m][n]) : "v"(Bt[n][k]), "v"(At[m][k])); } else { _Pragma("unroll") for (int m = 0; m < 4; ++m) _Pragma("unroll") for (int n = 0; n < 2; ++n) \
        asm volatile("v_mfma_f32_16x16x128_f8f6f4 %0, %1, %2, %0" : "+v"(acc[ai][bj][m][n]) : "v"(cat8(Bt[n][0], Bt[n][1])), "v"(cat8(At[m][0], At[m][1]))); } __builtin_amdgcn_s_setprio(0); } while (0)
#define PG8_MMA8Z(ai, bj, At, Bt) do { __builtin_amdgcn_s_setprio(1); if constexpr (I8) { _Pragma("unroll") for (int m = 0; m < 4; ++m) _Pragma("unroll") for (int n = 0; n < 2; ++n) \
        asm volatile("v_mfma_i32_16x16x64_i8 %0, %1, %2, 0" : "=&v"(acc[ai][bj][m][n]) : "v"(Bt[n][0]), "v"(At[m][0])); _Pragma("unroll") for (int m = 0; m < 4; ++m) _Pragma("unroll") for (int n = 0; n < 2; ++n) \
        asm volatile("v_mfma_i32_16x16x64_i8 %0, %1, %2, %0" : "+v"(acc[ai][bj][m][n]) : "v"(Bt[n][1]), "v"(At[m][1])); } else { _Pragma("unroll") for (int m = 0; m < 4; ++m) _Pragma("unroll") for (int n = 0; n < 2; ++n) \
        asm volatile("v_mfma_f32_16x16x128_f8f6f4 %0, %1, %2, 0" : "=&v"(acc[ai][bj][m][n]) : "v"(cat8(Bt[n][0], Bt[n][1])), "v"(cat8(At[m][0], At[m][1]))); } __builtin_amdgcn_s_setprio(0); } while (0)
#define PG8_MM(ai, bj, At, Bt) do { if constexpr (F8) PG8_MMA8(ai, bj, At, Bt); else PG8_MMA(ai, bj, At, Bt); } while (0)
#define PG8_MM2(FIRST, ai, At) do { if constexpr (F8) { if (FIRST) { PG8_MMA8Z(ai, 0, At, B0); PG8_MMA8Z(ai, 1, At, B1); } else { PG8_MMA8(ai, 0, At, B0); PG8_MMA8(ai, 1, At, B1); } } else { PG8_MMA(ai, 0, At, B0); PG8_MMA(ai, 1, At, B1); } } while (0)
#define PG8_WAIT_V(n) asm volatile("s_waitcnt vmcnt(" #n ")" ::: "memory")
#define PG8_WAIT_L(n) asm volatile("s_waitcnt lgkmcnt(" #n ")" ::: "memory")
#define PG8_BAR __builtin_amdgcn_s_barrier()
#define PG8_SCHED __builtin_amdgcn_sched_barrier(0)
    Unit cur, nxt; int ui = 0;
    if (!P.next(0, cur)) return;
    f32x4 acc[2][2][4][2];
    if constexpr (!F8) {
#pragma unroll
    for (int a = 0; a < 2; ++a)
#pragma unroll
        for (int b = 0; b < 2; ++b)
#pragma unroll
            for (int m = 0; m < 4; ++m)
#pragma unroll
                for (int n = 0; n < 2; ++n) acc[a][b][m][n] = (f32x4){0.f, 0.f, 0.f, 0.f};
    }
    bf16x8 At[4][2], B0[2][2], B1[2][2];
    unsigned vc[2][2], vn[2][2]; unsigned cAo = 0, nAo = 0;
    if constexpr (GA) { P.a_off(cur, RA, CA, vc); vn[0][0] = vc[0][0]; vn[0][1] = vc[0][1]; vn[1][0] = vc[1][0]; vn[1][1] = vc[1][1]; } else { cAo = P.a_tile(cur); nAo = cAo; vc[0][0] = vn[0][0] = 0; }
    const char* const Ab = P.A; const char* const Bb = P.Bt; unsigned cBo = P.b_off(cur), nBo = cBo;
    PG8_STAGE_B(PG8_SB(0, 0), cBo); PG8_STAGE_B(PG8_SB(0, 1), cBo + hstep); PG8_STAGE_A(PG8_SA(0, 0), 0u, 0, false); PG8_STAGE_A(PG8_SA(0, 1), 0u, 1, false);
    if (wr == 1) PG8_BAR;
    PG8_WAIT_V(2); PG8_BAR;
    PG8_STAGE_B(PG8_SB(1, 0), cBo + kstep); PG8_STAGE_A(PG8_SA(1, 0), kstep, 0, false); PG8_STAGE_B(PG8_SB(1, 1), cBo + hstep + kstep);
    PG8_WAIT_V(6); PG8_BAR;
    for (;;) {
        const bool has_next = P.next(ui + 1, nxt);
        PG8_LAS unsigned char* const xe = xl + (ui & 1) * XL_EPI;
        PG8_LAS unsigned char* const xg = xl + 2 * XL_EPI + ((ui + 1) & 1) * XL_GATHER;
        E.dma(cur, xe, wid, lane);
        if (has_next) { if constexpr (GA) P.dma_rows(nxt, xg, wid, lane); else nAo = P.a_tile(nxt); nBo = P.b_off(nxt); }
        else { nAo = cAo; nBo = cBo; }
#pragma unroll 1
        for (int rep = 0; rep < KREP; ++rep)
#pragma unroll 1
        for (int t = 0; t < nt; t += 2) {
            const bool lastt = (t == nt - 2); const bool last = lastt && (rep == KREP - 1); const bool first = (t == 0) && (rep == 0); (void)first;
            if constexpr (GA) { if (last) { if (has_next) P.a_off_lds(nxt, RA, CA, xg, vn); else { vn[0][0] = vc[0][0]; vn[0][1] = vc[0][1]; vn[1][0] = vc[1][0]; vn[1][1] = vc[1][1]; } } }
            const unsigned k1 = (unsigned)(t + 1) * kstep;
            const unsigned k2 = lastt ? 0u : (unsigned)(t + 2) * kstep, k3 = k2 + kstep;
            const unsigned b2 = (last ? nBo : cBo) + k2, b3 = b2 + kstep;
            PG8_LDB(B0, 0, 0); PG8_LDB(B1, 0, 1); PG8_SCHED; PG8_LDA(At, 0, 0); PG8_STAGE_A(PG8_SA(1, 1), k1, 1, false);
            PG8_WAIT_V(8); PG8_WAIT_L(0); PG8_BAR; PG8_MM2(first, 0, At); PG8_BAR; PG8_SCHED;
            PG8_LDA(At, 0, 1); PG8_STAGE_B(PG8_SB(0, 0), b2); PG8_STAGE_B(PG8_SB(0, 1), b2 + hstep); PG8_STAGE_A(PG8_SA(0, 0), k2, 0, last);
            PG8_WAIT_V(8); PG8_WAIT_L(0); PG8_BAR; PG8_MM2(first, 1, At); PG8_BAR; PG8_SCHED;
            PG8_LDB(B0, 1, 0); PG8_LDB(B1, 1, 1); PG8_SCHED; PG8_LDA(At, 1, 0); PG8_STAGE_A(PG8_SA(0, 1), k2, 1, last);
            PG8_WAIT_V(8); PG8_WAIT_L(0); PG8_BAR; PG8_MM(0, 0, At, B0); PG8_MM(0, 1, At, B1); PG8_BAR; PG8_SCHED;
            PG8_LDA(At, 1, 1); PG8_STAGE_B(PG8_SB(1, 0), b3); PG8_STAGE_B(PG8_SB(1, 1), b3 + hstep); PG8_STAGE_A(PG8_SA(1, 0), k3, 0, last);
            PG8_WAIT_V(8); PG8_WAIT_L(0); PG8_BAR; PG8_MM(1, 0, At, B0); PG8_MM(1, 1, At, B1); PG8_BAR; PG8_SCHED;
        }
        if constexpr (ALIGN_EPI) { if (wr == 0) PG8_BAR; }
        if constexpr (F8) asm volatile("s_nop 15\n\ts_nop 7" ::: "memory");
        if constexpr (I8) {
#pragma unroll
            for (int a = 0; a < 2; ++a)
#pragma unroll
                for (int b = 0; b < 2; ++b)
#pragma unroll
                    for (int m = 0; m < 4; ++m)
#pragma unroll
                        for (int n = 0; n < 2; ++n)
#pragma unroll
                            for (int i = 0; i < 4; ++i) acc[a][b][m][n][i] = (float)__float_as_int(acc[a][b][m][n][i]);
        }
        E(acc, cur, wr, wc, fr, fq, xe);
        if (!has_next) break;
        if constexpr (!F8)
#pragma unroll
        for (int a = 0; a < 2; ++a)
#pragma unroll
            for (int b = 0; b < 2; ++b)
#pragma unroll
                for (int m = 0; m < 4; ++m)
#pragma unroll
                    for (int n = 0; n < 2; ++n) acc[a][b][m][n] = (f32x4){0.f, 0.f, 0.f, 0.f};
        cur = nxt; cBo = nBo; cAo = nAo; ++ui;
        if constexpr (GA) { vc[0][0] = vn[0][0]; vc[0][1] = vn[0][1]; vc[1][0] = vn[1][0]; vc[1][1] = vn[1][1]; }
        if constexpr (ALIGN_EPI) { if (wr == 1) PG8_BAR; }
    }
    PG8_WAIT_V(0);
    if constexpr (!ALIGN_EPI) { if (wr == 0) PG8_BAR; }
    PG8_BAR;
#undef PG8_SA
#undef PG8_SB
#undef PG8_STAGE_A
#undef PG8_STAGE_B
#undef PG8_LDA
#undef PG8_LDB
#undef PG8_MMA
#undef PG8_MMA8
#undef PG8_MM
#undef PG8_MM2
#undef PG8_MMA8Z
#undef PG8_WAIT_V
#undef PG8_WAIT_L
#undef PG8_BAR
#undef PG8_SCHED
}
}

namespace att {
constexpr int QBLK = 32, KVBLK = 64, LDX = 1024, NT = SEQ / KVBLK;
constexpr int SHM_V = KVBLK * 128 * 2, SHM_K = KVBLK * 128 * 2, NSLOT = 3;
constexpr int OFF_V = 0, OFF_K = NSLOT * SHM_V, OFF_WS = NSLOT * (SHM_V + SHM_K), OFF_TBL = OFF_WS + 8 * 64 * 4, ATT_LDS = OFF_TBL + 2048;
constexpr float THR2 = 8.0f * LOG2E;
#define KSWZ(row, colB) ((row) * 256 + ((colB) ^ (((row) & 7) << 4)))
#define SBAR() __builtin_amdgcn_sched_barrier(0)
__device__ __forceinline__ int crow(int r, int hi) { return (r & 3) + 8 * (r >> 2) + 4 * hi; }
__device__ __forceinline__ int v_st(int k, int c) { const int kk = (k & ~0xC) | ((k & 4) << 1) | ((k & 8) >> 1); return ((kk >> 3) * 4 + (c >> 5)) * 512 + ((kk & 7) * 32 + (c & 31)) * 2; }
__device__ __forceinline__ int v_rd_base(int lane) { return ((lane & 3) << 3) | (((lane >> 2) & 3) << 6) | (((lane >> 4) & 1) << 5) | (((lane >> 5) & 1) << 8); }
constexpr int v_rd_off(int d0, int ks, int half) { return d0 * 512 + ks * 4096 + half * 2048; }
template <int OFF> __device__ __forceinline__ s16x4 tr_read(int vb) { s16x4 r; asm volatile("ds_read_b64_tr_b16 %0, %1 offset:%2" : "=&v"(r) : "v"(vb), "i"(OFF) : "memory"); return r; }
#define ATT_RD8(L, H, D0) do { \
    asm volatile("ds_read_b64_tr_b16 %0, %1 offset:%2" : "=&v"(L[0]) : "v"(vb), "i"(v_rd_off(D0, 0, 0)) : "memory"); asm volatile("ds_read_b64_tr_b16 %0, %1 offset:%2" : "=&v"(H[0]) : "v"(vb), "i"(v_rd_off(D0, 0, 1)) : "memory"); \
    asm volatile("ds_read_b64_tr_b16 %0, %1 offset:%2" : "=&v"(L[1]) : "v"(vb), "i"(v_rd_off(D0, 1, 0)) : "memory"); asm volatile("ds_read_b64_tr_b16 %0, %1 offset:%2" : "=&v"(H[1]) : "v"(vb), "i"(v_rd_off(D0, 1, 1)) : "memory"); \
    asm volatile("ds_read_b64_tr_b16 %0, %1 offset:%2" : "=&v"(L[2]) : "v"(vb), "i"(v_rd_off(D0, 2, 0)) : "memory"); asm volatile("ds_read_b64_tr_b16 %0, %1 offset:%2" : "=&v"(H[2]) : "v"(vb), "i"(v_rd_off(D0, 2, 1)) : "memory"); \
    asm volatile("ds_read_b64_tr_b16 %0, %1 offset:%2" : "=&v"(L[3]) : "v"(vb), "i"(v_rd_off(D0, 3, 0)) : "memory"); asm volatile("ds_read_b64_tr_b16 %0, %1 offset:%2" : "=&v"(H[3]) : "v"(vb), "i"(v_rd_off(D0, 3, 1)) : "memory"); } while (0)
#define ATT_PK(L, H) (bf16x8){L[0], L[1], L[2], L[3], H[0], H[1], H[2], H[3]}
#define ATT_MM4(OD, L, H) do { OD = __builtin_amdgcn_mfma_f32_32x32x16_bf16(pa0, ATT_PK(L[0], H[0]), OD, 0, 0, 0); OD = __builtin_amdgcn_mfma_f32_32x32x16_bf16(pa1, ATT_PK(L[1], H[1]), OD, 0, 0, 0); \
    OD = __builtin_amdgcn_mfma_f32_32x32x16_bf16(pa2, ATT_PK(L[2], H[2]), OD, 0, 0, 0); OD = __builtin_amdgcn_mfma_f32_32x32x16_bf16(pa3, ATT_PK(L[3], H[3]), OD, 0, 0, 0); } while (0)
__device__ __forceinline__ void pv_d0(f32x16* o, int vb, bf16x8 pa0, bf16x8 pa1, bf16x8 pa2, bf16x8 pa3) {
  s16x4 la[4], ha[4], lb[4], hb[4];
  ATT_RD8(la, ha, 0); ATT_RD8(lb, hb, 1);
  asm volatile("s_waitcnt lgkmcnt(8)" ::: "memory"); SBAR(); ATT_MM4(o[0], la, ha); SBAR();
  ATT_RD8(la, ha, 2);
  asm volatile("s_waitcnt lgkmcnt(8)" ::: "memory"); SBAR(); ATT_MM4(o[1], lb, hb); SBAR();
  ATT_RD8(lb, hb, 3);
  asm volatile("s_waitcnt lgkmcnt(8)" ::: "memory"); SBAR(); ATT_MM4(o[2], la, ha); SBAR();
  asm volatile("s_waitcnt lgkmcnt(0)" ::: "memory"); SBAR(); ATT_MM4(o[3], lb, hb);
  const bf16x8 ones = {(short)0x3F80, (short)0x3F80, (short)0x3F80, (short)0x3F80, (short)0x3F80, (short)0x3F80, (short)0x3F80, (short)0x3F80};
  o[4] = __builtin_amdgcn_mfma_f32_32x32x16_bf16(pa0, ones, o[4], 0, 0, 0); o[4] = __builtin_amdgcn_mfma_f32_32x32x16_bf16(pa1, ones, o[4], 0, 0, 0);
  o[4] = __builtin_amdgcn_mfma_f32_32x32x16_bf16(pa2, ones, o[4], 0, 0, 0); o[4] = __builtin_amdgcn_mfma_f32_32x32x16_bf16(pa3, ones, o[4], 0, 0, 0);
}
__device__ __forceinline__ void pv_softmax(f32x16* o, int vb, bf16x8 pa0, bf16x8 pa1, bf16x8 pa2, bf16x8 pa3, f32x16& p0, f32x16& p1, float& m_reg, float& alpha, bool& resc) {
  s16x4 la[4], ha[4], lb[4], hb[4];
  ATT_RD8(la, ha, 0); ATT_RD8(lb, hb, 1);
  asm volatile("s_waitcnt lgkmcnt(8)" ::: "memory"); SBAR();
  float a = fmaxf(fmaxf(p0[0], p0[1]), p1[0]), b = fmaxf(fmaxf(p0[2], p0[3]), p1[1]); a = fmaxf(fmaxf(a, p1[2]), p1[3]);
#pragma unroll
  for (int r = 4; r < 16; r += 4) { a = fmaxf(fmaxf(a, p0[r]), p0[r + 1]); b = fmaxf(fmaxf(b, p0[r + 2]), p0[r + 3]); a = fmaxf(fmaxf(a, p1[r]), p1[r + 1]); b = fmaxf(fmaxf(b, p1[r + 2]), p1[r + 3]); }
  float pmax = fmaxf(a, b);
  ATT_MM4(o[0], la, ha); SBAR();
  ATT_RD8(la, ha, 2);
  asm volatile("s_waitcnt lgkmcnt(8)" ::: "memory"); SBAR();
  { auto rr = __builtin_amdgcn_permlane32_swap(__float_as_uint(pmax), __float_as_uint(pmax), false, false);
    pmax = fmaxf(__uint_as_float(rr[0]), __uint_as_float(rr[1])); }
  resc = false; alpha = 1.f;
  if (__builtin_expect(!__all(pmax <= THR2), 0)) { const float dl = fmaxf(pmax, 0.f); m_reg += dl; alpha = __builtin_amdgcn_exp2f(-dl); resc = true;
#pragma unroll
    for (int r = 0; r < 16; ++r) { p0[r] -= dl; p1[r] -= dl; } }
  ATT_MM4(o[1], lb, hb); SBAR();
  ATT_RD8(lb, hb, 3);
  asm volatile("s_waitcnt lgkmcnt(8)" ::: "memory"); SBAR();
#pragma unroll
  for (int r = 0; r < 16; ++r) p0[r] = __builtin_amdgcn_exp2f(p0[r]);
  ATT_MM4(o[2], la, ha); SBAR();
  asm volatile("s_waitcnt lgkmcnt(0)" ::: "memory"); SBAR();
#pragma unroll
  for (int r = 0; r < 16; ++r) p1[r] = __builtin_amdgcn_exp2f(p1[r]);
  ATT_MM4(o[3], lb, hb);
  const bf16x8 ones = {(short)0x3F80, (short)0x3F80, (short)0x3F80, (short)0x3F80, (short)0x3F80, (short)0x3F80, (short)0x3F80, (short)0x3F80};
  o[4] = __builtin_amdgcn_mfma_f32_32x32x16_bf16(pa0, ones, o[4], 0, 0, 0); o[4] = __builtin_amdgcn_mfma_f32_32x32x16_bf16(pa1, ones, o[4], 0, 0, 0);
  o[4] = __builtin_amdgcn_mfma_f32_32x32x16_bf16(pa2, ones, o[4], 0, 0, 0); o[4] = __builtin_amdgcn_mfma_f32_32x32x16_bf16(pa3, ones, o[4], 0, 0, 0);
}
__device__ __forceinline__ void near_bias(f32x16& p0, f32x16& p1, int dq, const float* tbl) {
#pragma unroll
  for (int r = 0; r < 16; ++r) { const int c0 = (r & 3) + 8 * (r >> 2); p0[r] += tbl[dq + c0]; p1[r] += tbl[dq + c0 + 32]; }
}
__device__ __forceinline__ void qkt(f32x16& p0, f32x16& p1, const char* Ks, const bf16x8* qr, int r32, int hi, int mapB) {
  bf16x8 k0[4], k1[4];
#pragma unroll
  for (int d0 = 0; d0 < 4; ++d0) { const int cb = mapB + (d0 * 16 + hi * 8) * 2;
    k0[d0] = *reinterpret_cast<const bf16x8*>(Ks + KSWZ(r32, cb)); k1[d0] = *reinterpret_cast<const bf16x8*>(Ks + KSWZ(32 + r32, cb)); }
  p0 = f32x16{}; p1 = f32x16{};
#pragma unroll
  for (int d0 = 0; d0 < 4; ++d0) {
    p0 = __builtin_amdgcn_mfma_f32_32x32x16_bf16(k0[d0], qr[d0], p0, 0, 0, 0);
    p1 = __builtin_amdgcn_mfma_f32_32x32x16_bf16(k1[d0], qr[d0], p1, 0, 0, 0); }
}
__device__ __forceinline__ void qkt_seed(f32x16& p0, f32x16& p1, const char* Ks, const bf16x8* qr, const int (&koff)[4], const f32x16& seed) {
#pragma unroll
  for (int d0 = 0; d0 < 4; ++d0) {
    const bf16x8 b0 = *reinterpret_cast<const bf16x8*>(Ks + koff[d0]);
    const bf16x8 b1 = *reinterpret_cast<const bf16x8*>(Ks + koff[d0] + 8192);
    if (d0 == 0) { p0 = __builtin_amdgcn_mfma_f32_32x32x16_bf16(b0, qr[0], seed, 0, 0, 0); p1 = __builtin_amdgcn_mfma_f32_32x32x16_bf16(b1, qr[0], seed, 0, 0, 0); }
    else { p0 = __builtin_amdgcn_mfma_f32_32x32x16_bf16(b0, qr[d0], p0, 0, 0, 0); p1 = __builtin_amdgcn_mfma_f32_32x32x16_bf16(b1, qr[d0], p1, 0, 0, 0); } }
}
__device__ __forceinline__ void partialSM_seeded(f32x16& p0, f32x16& p1, float& m_reg, float& alpha, bool& resc, int mode, int dq, const float* tbl) {
  if (mode == 0) {
#pragma unroll
    for (int r = 0; r < 16; ++r) { const int c0 = (r & 3) + 8 * (r >> 2);
      p0[r] += tbl[dq + c0]; p1[r] += tbl[dq + c0 + 32]; }
  }
  float a = fmaxf(fmaxf(p0[0], p0[1]), p1[0]), b = fmaxf(fmaxf(p0[2], p0[3]), p1[1]); a = fmaxf(fmaxf(a, p1[2]), p1[3]);
#pragma unroll
  for (int r = 4; r < 16; r += 4) { a = fmaxf(fmaxf(a, p0[r]), p0[r + 1]); b = fmaxf(fmaxf(b, p0[r + 2]), p0[r + 3]); a = fmaxf(fmaxf(a, p1[r]), p1[r + 1]); b = fmaxf(fmaxf(b, p1[r + 2]), p1[r + 3]); }
  float pmax = fmaxf(a, b);
  { auto rr = __builtin_amdgcn_permlane32_swap(__float_as_uint(pmax), __float_as_uint(pmax), false, false);
    pmax = fmaxf(__uint_as_float(rr[0]), __uint_as_float(rr[1])); }
  resc = false; alpha = 1.f;
  if (__builtin_expect(!__all(pmax <= THR2), 0)) { const float dl = fmaxf(pmax, 0.f); m_reg += dl; alpha = __builtin_amdgcn_exp2f(-dl); resc = true;
#pragma unroll
    for (int r = 0; r < 16; ++r) { p0[r] -= dl; p1[r] -= dl; } }
#pragma unroll
  for (int r = 0; r < 16; ++r) p0[r] = __builtin_amdgcn_exp2f(p0[r]);
}
__device__ __forceinline__ void partialSM(f32x16& p0, f32x16& p1, float& m_reg, float& mn, float& alpha, int mode, float cL, float cR, int dq, const float* tbl) {
  float cadd;
  if (mode == 0) {
#pragma unroll
    for (int r = 0; r < 16; ++r) { const int c0 = (r & 3) + 8 * (r >> 2);
      p0[r] += tbl[dq + c0]; p1[r] += tbl[dq + c0 + 32]; }
    cadd = 0.f;
  } else cadd = (mode < 0) ? cL : cR;
  float pmax = p0[0];
#pragma unroll
  for (int r = 1; r < 16; ++r) pmax = fmaxf(pmax, p0[r]);
#pragma unroll
  for (int r = 0; r < 16; ++r) pmax = fmaxf(pmax, p1[r]);
  { auto rr = __builtin_amdgcn_permlane32_swap(__float_as_uint(pmax), __float_as_uint(pmax), false, false);
    pmax = fmaxf(__uint_as_float(rr[0]), __uint_as_float(rr[1])); }
  pmax += cadd;
  if (__builtin_expect(__all(pmax - m_reg <= THR2), 1)) { mn = m_reg; alpha = 1.f; }
  else { mn = fmaxf(m_reg, pmax); alpha = __builtin_amdgcn_exp2f(m_reg - mn); m_reg = mn; }
  const float sh = cadd - mn;
#pragma unroll
  for (int r = 0; r < 16; ++r) p0[r] += sh;
#pragma unroll
  for (int r = 0; r < 16; ++r) p1[r] += sh;
#pragma unroll
  for (int r = 0; r < 16; ++r) p0[r] = __builtin_amdgcn_exp2f(p0[r]);
}
__device__ __forceinline__ void finishSM(f32x16& p0, f32x16& p1, bf16x8& pa0, bf16x8& pa1, bf16x8& pa2, bf16x8& pa3) {
#define PK8(P, BASE, OUT) do { v4u w = {cvt_pk_bf16(P[BASE + 0], P[BASE + 1]), cvt_pk_bf16(P[BASE + 2], P[BASE + 3]), cvt_pk_bf16(P[BASE + 4], P[BASE + 5]), cvt_pk_bf16(P[BASE + 6], P[BASE + 7])}; OUT = *reinterpret_cast<bf16x8*>(&w); } while (0)
  PK8(p0, 0, pa0); PK8(p0, 8, pa1); PK8(p1, 0, pa2); PK8(p1, 8, pa3);
#undef PK8
}
__device__ __forceinline__ int rel_bucket(int rel) {
  const int n = rel < 0 ? -rel : rel; int b;
  if (n < 8) b = n; else if (n < 12) b = 8; else if (n < 16) b = 9; else if (n < 23) b = 10; else if (n < 32) b = 11; else if (n < 46) b = 12; else if (n < 64) b = 13; else if (n < 91) b = 14; else b = 15;
  return (rel > 0 ? 16 : 0) + b;
}

__device__ __forceinline__ void attn_unit(int b, int h, int qb, const bf16_t* __restrict__ Q, const bf16_t* __restrict__ K, const bf16_t* __restrict__ V, bf16_t* __restrict__ O,
                                          float lam, float osc, const float* __restrict__ g, const float* __restrict__ rel_bias, char* lds, int tid_in, bool build_tbl, bool o8) {
  int tid_ = tid_in; asm volatile("" : "+v"(tid_));
  const int tid = tid_, wid = __builtin_amdgcn_readfirstlane(tid >> 6), lane = tid & 63, r32 = lane & 31, hi = lane >> 5;
  const int map = wid & 1, jq = wid >> 1;
  char* V_lds = lds + OFF_V; char* K_lds = lds + OFF_K;
  float* ws = (float*)(lds + OFF_WS) + wid * 64; float* li_l = ws; float* al_l = ws + 32;
  float* tbl = (float*)(lds + OFF_TBL);
  if (build_tbl) tbl[tid] = rel_bias[rel_bucket(tid - 256) * NH + h] * LOG2E;
  const float cL = rel_bias[15 * NH + h] * LOG2E, cR = rel_bias[31 * NH + h] * LOG2E;
  const long rowbase = (long)b * SEQ; const int qs = qb * 128 + jq * QBLK;
  float m_reg = -1e30f; f32x16 o[5] = {}; bf16x8 qr[4];
  const bf16_t* Qw = Q + (rowbase + qs + r32) * LDX + h * 128 + map * 64 + hi * 8;
#pragma unroll
  for (int d0 = 0; d0 < 4; ++d0) qr[d0] = *reinterpret_cast<const bf16x8*>(Qw + d0 * 16);
  const bf16_t* Kh = K + rowbase * LDX + h * 128; const bf16_t* Vh = V + rowbase * LDX + h * 128;
  const int vb0 = (int)(uintptr_t)V_lds + v_rd_base(lane);
  const int mapB = map * 128;
  int koff[4];
#pragma unroll
  for (int d0 = 0; d0 < 4; ++d0) koff[d0] = KSWZ(r32, mapB + (d0 * 16 + hi * 8) * 2);
  const int dq0 = 256 + 4 * hi - (qs + r32);
  unsigned ksrc[2], vsrc[2];
#pragma unroll
  for (int i = 0; i < 2; ++i) { const int pk = wid + 8 * i;
    const int krow = 4 * pk + (lane >> 4), kc = (lane & 15) ^ (krow & 7); ksrc[i] = (unsigned)(krow * (LDX * 2) + kc * 16);
    const int st = 2 * pk + (lane >> 5), kk = (st >> 2) * 8 + ((lane & 31) >> 2), vk = kk  , vc = (st & 3) * 32 + (lane & 3) * 8;
    vsrc[i] = (unsigned)(vk * (LDX * 2) + vc * 2); }
  typedef const __attribute__((address_space(1))) unsigned* gptr_t; typedef __attribute__((address_space(3))) unsigned* lptr_t;
  const char* const Kg = (const char*)Kh; const char* const Vg = (const char*)Vh;
  const lptr_t kdst = (lptr_t)(__attribute__((address_space(3))) char*)(K_lds) + 0; (void)kdst;
#define DMA_TILE(t, slot) do { const unsigned tb_ = (unsigned)(t) * (unsigned)(KVBLK * LDX * 2); \
    _Pragma("unroll") for (int i_ = 0; i_ < 2; ++i_) { \
      __builtin_amdgcn_global_load_lds((gptr_t)(Kg + (ksrc[i_] + tb_)), (lptr_t)((__attribute__((address_space(3))) char*)K_lds + (slot) + (wid + 8 * i_) * 1024), 16, 0, 0); \
      __builtin_amdgcn_global_load_lds((gptr_t)(Vg + (vsrc[i_] + tb_)), (lptr_t)((__attribute__((address_space(3))) char*)V_lds + (slot) + (wid + 8 * i_) * 1024), 16, 0, 0); } } while (0)
#define WAIT_BAR() do { asm volatile("s_waitcnt vmcnt(0) lgkmcnt(0)" ::: "memory"); __builtin_amdgcn_s_barrier(); asm volatile("" ::: "memory"); } while (0)
#define RESC(a, rs) do { if (rs) { if (hi == 0) al_l[r32] = (a); asm volatile("s_waitcnt lgkmcnt(0)" ::: "memory"); \
    _Pragma("unroll") for (int d = 0; d < 5; ++d) _Pragma("unroll") for (int r = 0; r < 16; ++r) o[d][r] *= al_l[crow(r, hi)]; } } while (0)
#define SEED(md) do { const int md_ = (md); const float sv_ = (md_ == 0 ? 0.f : (md_ < 0 ? cL : cR)) - m_reg; _Pragma("unroll") for (int r = 0; r < 16; ++r) seed[r] = sv_; } while (0)
#define TMODE(k0) (((k0) >= qs + 122) ? 1 : (((k0) <= qs - 154) ? -1 : 0))
#define ROT() do { const int t_ = sl_prev; sl_prev = sl_cur; sl_cur = sl_next; sl_next = t_; } while (0)
  f32x16 pA0, pA1, pB0, pB1, seed; float mnA, alA, alB; bool rsA = false, rsB = false; bf16x8 pa0, pa1, pa2, pa3;
  int sl_prev = 2 * SHM_V, sl_cur = 0, sl_next = SHM_V;
  if (wid >= 4) __builtin_amdgcn_s_setprio(1);
  DMA_TILE(0, 0); DMA_TILE(1, SHM_V);
  WAIT_BAR();
  DMA_TILE(2, 2 * SHM_V);
  qkt(pA0, pA1, K_lds, qr, r32, hi, mapB); partialSM(pA0, pA1, m_reg, mnA, alA, TMODE(0), cL, cR, dq0, tbl);
  _Pragma("unroll") for (int r = 0; r < 16; ++r) pA1[r] = __builtin_amdgcn_exp2f(pA1[r]);
  ROT();
#define QK_SEEDED(P0, P1, DMA_STMT, SEED_STMT) do { bf16x8 k0_[4], k1_[4]; const char* Ks_ = K_lds + sl_cur; \
    _Pragma("unroll") for (int d0 = 0; d0 < 4; ++d0) { k0_[d0] = *reinterpret_cast<const bf16x8*>(Ks_ + koff[d0]); k1_[d0] = *reinterpret_cast<const bf16x8*>(Ks_ + koff[d0] + 8192); } \
    DMA_STMT; SEED_STMT; \
    P0 = __builtin_amdgcn_mfma_f32_32x32x16_bf16(k0_[0], qr[0], seed, 0, 0, 0); P1 = __builtin_amdgcn_mfma_f32_32x32x16_bf16(k1_[0], qr[0], seed, 0, 0, 0); \
    _Pragma("unroll") for (int d0 = 1; d0 < 4; ++d0) { P0 = __builtin_amdgcn_mfma_f32_32x32x16_bf16(k0_[d0], qr[d0], P0, 0, 0, 0); P1 = __builtin_amdgcn_mfma_f32_32x32x16_bf16(k1_[d0], qr[d0], P1, 0, 0, 0); } } while (0)
  for (int j = 1; j + 1 < NT; j += 2) {
    SBAR(); QK_SEEDED(pB0, pB1, if (j > 1) DMA_TILE(j + 1, sl_next), SEED(TMODE(j * KVBLK)));
    finishSM(pA0, pA1, pa0, pa1, pa2, pa3); SBAR();
    if (TMODE(j * KVBLK) == 0) near_bias(pB0, pB1, dq0 + j * KVBLK, tbl);
    pv_softmax(o, vb0 + sl_prev, pa0, pa1, pa2, pa3, pB0, pB1, m_reg, alB, rsB);
    WAIT_BAR();
    RESC(alB, rsB); ROT();
    SBAR(); QK_SEEDED(pA0, pA1, DMA_TILE(j + 2, sl_next), SEED(TMODE((j + 1) * KVBLK)));
    finishSM(pB0, pB1, pa0, pa1, pa2, pa3); SBAR();
    if (TMODE((j + 1) * KVBLK) == 0) near_bias(pA0, pA1, dq0 + (j + 1) * KVBLK, tbl);
    pv_softmax(o, vb0 + sl_prev, pa0, pa1, pa2, pa3, pA0, pA1, m_reg, alA, rsA);
    WAIT_BAR();
    RESC(alA, rsA); ROT();
  }
  SBAR(); QK_SEEDED(pB0, pB1, (void)0, SEED(TMODE((NT - 1) * KVBLK)));
  finishSM(pA0, pA1, pa0, pa1, pa2, pa3); SBAR();
  if (TMODE((NT - 1) * KVBLK) == 0) near_bias(pB0, pB1, dq0 + (NT - 1) * KVBLK, tbl);
  pv_softmax(o, vb0 + sl_prev, pa0, pa1, pa2, pa3, pB0, pB1, m_reg, alB, rsB);
  RESC(alB, rsB);
  finishSM(pB0, pB1, pa0, pa1, pa2, pa3); SBAR();
  pv_d0(o, vb0 + sl_cur, pa0, pa1, pa2, pa3);
  __builtin_amdgcn_s_setprio(0);
  float rli[16];
#pragma unroll
  for (int r = 0; r < 16; ++r) rli[r] = __builtin_amdgcn_rcpf(o[4][r]);
  __syncthreads();
  float* X = (float*)(lds + jq * 16384);
  if (map == 1) {
#pragma unroll
    for (int r = 0; r < 16; ++r) { const int orow = crow(r, hi); const float s = rli[r] * lam;
#pragma unroll
      for (int d0 = 0; d0 < 4; ++d0) X[orow * 128 + d0 * 32 + r32] = o[d0][r] * s; }
  }
  __syncthreads();
  if (map == 0) {
    float ss[16];
#pragma unroll
    for (int r = 0; r < 16; ++r) { const int orow = crow(r, hi); float a = 0.f;
#pragma unroll
      for (int d0 = 0; d0 < 4; ++d0) { const float v = o[d0][r] * rli[r] - X[orow * 128 + d0 * 32 + r32]; o[d0][r] = v; a += v * v; }
      ss[r] = a; }
#pragma unroll
    for (int s = 1; s < 32; s <<= 1)
#pragma unroll
      for (int r = 0; r < 16; ++r) ss[r] += shx(ss[r], s);
    float gg[4];
#pragma unroll
    for (int d0 = 0; d0 < 4; ++d0) gg[d0] = g[d0 * 32 + r32] * osc;
    asm volatile("s_waitcnt lgkmcnt(0)" ::: "memory");
    bf16_t* stg = (bf16_t*)X;
#pragma unroll
    for (int r = 0; r < 16; ++r) { const int orow = crow(r, hi); const float rs = __builtin_amdgcn_rsqf(ss[r] * (1.0f / 128.0f) + LN_EPS);
#pragma unroll
      for (int d0 = 0; d0 < 4; ++d0) { const float v = o[d0][r] * rs * gg[d0]; stg[orow * 128 + d0 * 32 + r32] = (bf16_t)(cvt_pk_bf16(v, v) & 0xffffu); } }
    asm volatile("s_waitcnt lgkmcnt(0)" ::: "memory");
    bf16_t* Ow = O + (rowbase + qs) * LDX + h * 128;
#pragma unroll
    for (int i = 0; i < 8; ++i) { const int row = i * 4 + (lane >> 4), ch = lane & 15; const v4u v = *(const v4u*)(stg + row * 128 + ch * 8);
      if (!o8) *(v4u*)(Ow + (long)row * LDX + ch * 8) = v;
      else { typedef unsigned u32x2 __attribute__((ext_vector_type(2))); u32x2 q8; q8.x = pg8::pk4_fp8(bf_lo(v.x), bf_hi(v.x), bf_lo(v.y), bf_hi(v.y)); q8.y = pg8::pk4_fp8(bf_lo(v.z), bf_hi(v.z), bf_lo(v.w), bf_hi(v.w));
        *(u32x2*)((unsigned char*)O + (size_t)(rowbase + qs + row) * LDX + h * 128 + ch * 8) = q8; } }
    asm volatile("s_waitcnt lgkmcnt(0)" ::: "memory");
  }
  __syncthreads();
#undef DMA_TILE
#undef WAIT_BAR
#undef ROT
#undef RESC
#undef SEED
#undef QK_SEEDED
#undef TMODE
}
#undef KSWZ
#undef SBAR
}

#define XB_TMO      128
#define XB_XCNT(j)  (256  + 64 * (j))
#define XB_XSUB(j)  (1280 + 64 * (j))
#define XB_XGEN(j)  (2304 + 64 * (j))
#define XB_TOP      3328
#define XB_TOPGEN   3392
#define XCD_BAR_WORDS 3456
#define XB_SPIN_CAP (1u << 18)
__device__ __forceinline__ unsigned xb_ld(unsigned* p)              { return __hip_atomic_load(p, __ATOMIC_RELAXED, __HIP_MEMORY_SCOPE_AGENT); }
__device__ __forceinline__ unsigned xb_add(unsigned* p, unsigned v) { return __hip_atomic_fetch_add(p, v, __ATOMIC_RELAXED, __HIP_MEMORY_SCOPE_AGENT); }
__device__ __forceinline__ unsigned xb_xcc_id() { return (unsigned)__builtin_amdgcn_s_getreg((3 << 11) | 20) & 0xFu; }
#define XB_SPIN(cond, bar) do { unsigned _sp = 0; while (cond) { __builtin_amdgcn_s_sleep(1); \
    if ((++_sp & 255u) == 0u) { if (xb_ld(&(bar)[XB_TMO])) break; if (_sp > XB_SPIN_CAP) { atomicAdd(&(bar)[XB_TMO], 1u); break; } } } } while (0)
struct XcdBarrier { unsigned* bar; unsigned x; volatile LAS unsigned* st; };
__device__ __forceinline__ XcdBarrier xcd_barrier_post(unsigned* bar, volatile LAS unsigned* st) {
    XcdBarrier b; b.bar = bar; b.x = xb_xcc_id(); b.st = st;
    if (threadIdx.x == 0) (void)xb_add(&bar[XB_XCNT(b.x)], 1u);
    return b;
}
__device__ __forceinline__ void xcd_barrier_complete(unsigned* bar, unsigned x, unsigned& nloc, unsigned& nx) {
    const unsigned G = gridDim.x * gridDim.y * gridDim.z;
    unsigned sum, cnt, mine, sp = 0u;
    for (;;) {
        sum = 0u; cnt = 0u; mine = 0u;
#pragma unroll
        for (unsigned j = 0; j < 16; ++j) { const unsigned c = xb_ld(&bar[XB_XCNT(j)]); sum += c; cnt += (c > 0u) ? 1u : 0u; mine = (j == x) ? c : mine; }
        if (sum == G) break;
        __builtin_amdgcn_s_sleep(1);
        if ((++sp & 255u) == 0u) { if (xb_ld(&bar[XB_TMO])) break; if (sp > XB_SPIN_CAP) { atomicAdd(&bar[XB_TMO], 1u); break; } }
    }
    nloc = mine > 0u ? mine : 1u; nx = cnt > 0u ? cnt : 1u;
}
__device__ __forceinline__ void xcd_barrier(const XcdBarrier& b) {
    asm volatile("s_waitcnt vmcnt(0)" ::: "memory");
    __syncthreads();
    if (threadIdx.x == 0) {
        unsigned* bar = b.bar;
        __builtin_amdgcn_s_waitcnt(0);
        unsigned nloc = b.st[0], nx = b.st[1];
        if (nloc == 0u) { xcd_barrier_complete(bar, b.x, nloc, nx); b.st[0] = nloc; b.st[1] = nx; }
        const unsigned old = xb_add(&bar[XB_XSUB(b.x)], 1u);
        const unsigned gen = old / nloc;
        if (old + 1u == (gen + 1u) * nloc) {
            __builtin_amdgcn_fence(__ATOMIC_RELEASE, "agent");
            asm volatile("s_waitcnt vmcnt(0)" ::: "memory");
            const unsigned og = xb_add(&bar[XB_TOP], 1u);
            const unsigned tg = og / nx;
            if (og + 1u == (tg + 1u) * nx) xb_add(&bar[XB_TOPGEN], 1u);
            else XB_SPIN(xb_ld(&bar[XB_TOPGEN]) == tg, bar);
            __builtin_amdgcn_fence(__ATOMIC_ACQUIRE, "agent");
            xb_add(&bar[XB_XGEN(b.x)], 1u);
            asm volatile("s_waitcnt vmcnt(0)" ::: "memory");
        } else {
            XB_SPIN(xb_ld(&bar[XB_XGEN(b.x)]) == gen, bar);
            __builtin_amdgcn_fence(__ATOMIC_ACQUIRE, "agent");
            asm volatile("s_waitcnt vmcnt(0)" ::: "memory");
        }
    }
    __syncthreads();
}

template <int MODE> __device__ __forceinline__ int dst_row(int n) {
    if (MODE == 1) { if (n < 1024) return n; const int b = (n - 1024) >> 10, f = (n - 1024) & 1023; return 1024 + (f >> 7) * 256 + b * 128 + (f & 127); }
    if (MODE == 2) { const int b = n & 1, j = n >> 1; return (j >> 7) * 256 + b * 128 + (j & 127); }
    if (MODE == 3) { const int c = n & 255; return (n & ~255) + ((c >> 3) & 1) * 128 + (c >> 6) * 32 + ((c >> 4) & 3) * 8 + (c & 7); }
    return n;
}
template <int MODE> __device__ __forceinline__ void p0_transpose_item(const float* W, int K, int N, bf16_t* WT, LAS float* scr, int item, int lane, const float* kscale = nullptr) {
    const int nblk = N / 32, kb = item / nblk, nb = item % nblk, k0 = 64 * kb, n0 = 32 * nb;
#pragma unroll 8
    for (int i = 0; i < 32; ++i) { const int kk = 2 * i + (lane >> 5); float w = W[(size_t)(k0 + kk) * N + n0 + (lane & 31)]; if (kscale) w *= kscale[k0 + kk]; scr[kk * 33 + (lane & 31)] = w; }
    LDS_WAIT(); asm volatile("" ::: "memory");
    const int c = lane & 7;
#pragma unroll
    for (int j = 0; j < 4; ++j) { const int n = (lane >> 3) + 8 * j; const LAS float* s = scr + (8 * c) * 33 + n;
        v4u o; o.x = cvt_pk_bf16(s[0 * 33], s[1 * 33]); o.y = cvt_pk_bf16(s[2 * 33], s[3 * 33]); o.z = cvt_pk_bf16(s[4 * 33], s[5 * 33]); o.w = cvt_pk_bf16(s[6 * 33], s[7 * 33]);
        *(GAS v4u*)(WT + (size_t)dst_row<MODE>(n0 + n) * K + k0 + 8 * c) = o; }
    LDS_WAIT(); asm volatile("" ::: "memory");
}

template <int MODE, bool I8 = false> __device__ __forceinline__ void p0_quant_strip(const float* W, int N, unsigned char* W8, float* SC, int strip, LAS unsigned char* lds, int wave, int lane) {
    constexpr float QM_ = I8 ? 127.0f : F8MAX;
    LAS float* scr = (LAS float*)(lds + wave * 16384); LAS float* red = (LAS float*)(lds + LDSCTL_OFF + 2048);
    const int n0 = strip * 32, k0 = wave * 128, kk = lane >> 5, n = lane & 31;
    float am = 0.f;
    { const char* Wb = (const char*)W + (size_t)k0 * N * 4; const unsigned loff = (unsigned)((kk * N + n0 + n) * 4);
      float vv[64];
#pragma unroll
      for (int i = 0; i < 64; ++i) vv[i] = *(const float*)(Wb + (size_t)i * (size_t)(2 * N * 4) + loff);
#pragma unroll
      for (int i = 0; i < 64; ++i) { scr[(2 * i + kk) * 32 + n] = vv[i]; am = fmaxf(am, fabsf(vv[i])); } }
    am = fmaxf(am, shx(am, 32));
    if (lane < 32) red[wave * 32 + n] = am;
    __syncthreads();
    float amax = red[n];
#pragma unroll
    for (int w = 1; w < 8; ++w) amax = fmaxf(amax, red[w * 32 + n]);
    const float q = amax > 0.f ? QM_ / amax : 0.f;
    const int dr = dst_row<MODE>(n0 + n);
    if (wave == 0 && lane < 32) SC[dr] = amax * (1.0f / QM_);
#pragma unroll
    for (int c = 0; c < 4; ++c) { float v[16];
#pragma unroll
        for (int j = 0; j < 16; ++j) v[j] = scr[(kk * 64 + c * 16 + j) * 32 + n] * q;
        v4u o; o.x = pg8::pkq4<I8>(v[0], v[1], v[2], v[3]); o.y = pg8::pkq4<I8>(v[4], v[5], v[6], v[7]); o.z = pg8::pkq4<I8>(v[8], v[9], v[10], v[11]); o.w = pg8::pkq4<I8>(v[12], v[13], v[14], v[15]);
        *(GAS v4u*)(W8 + (size_t)dr * 1024 + k0 + kk * 64 + c * 16) = o; }
    __syncthreads();
}
struct StripSrc { const float* W; int N; unsigned char* W8; float* SC; int strip; bool glu; };
__device__ __forceinline__ void dstrip_desc(const float* w1, const float* w2, unsigned char* ws, int st, StripSrc& d) {
    if (st < 128 * 64) { const int j = st >> 6; d.W = w1 + (size_t)j * 1024 * 2048; d.N = 2048; d.W8 = ws + WS_W1 + (size_t)j * 2048 * 1024; d.SC = (float*)(ws + WS_S1) + (size_t)j * 2048; d.strip = st & 63; d.glu = true; }
    else { const int q = st - 128 * 64, j = q >> 5; d.W = w2 + (size_t)j * 1024 * 1024; d.N = 1024; d.W8 = ws + WS_W2 + (size_t)j * 1024 * 1024; d.SC = (float*)(ws + WS_S2) + (size_t)j * 1024; d.strip = q & 31; d.glu = false; }
}
__device__ __forceinline__ void dstrip_issue(const StripSrc& d, int wave, int lane, f32x4 (&vv)[16]) {
    const int n0 = d.strip * 32, k0 = wave * 128, r8 = lane >> 3, cg = lane & 7;
    const char* Wb = (const char*)d.W + (size_t)k0 * d.N * 4; const unsigned loff = (unsigned)((r8 * d.N + n0 + 4 * cg) * 4); const size_t rs8 = (size_t)d.N * 32;
#pragma unroll
    for (int i = 0; i < 16; ++i) vv[i] = *(const f32x4*)(Wb + (size_t)i * rs8 + loff);
}
__device__ __forceinline__ void dstrip_finish(const StripSrc& d, LAS unsigned char* lds, int wave, int lane, int par, f32x4 (&vv)[16]) {
    LAS float* scr = (LAS float*)(lds + wave * 16384); LAS float* red = (LAS float*)(lds + LDSCTL_OFF + 2048 + par * 1024);
    const int n0 = d.strip * 32, k0 = wave * 128, kk = lane >> 5, n = lane & 31, r8 = lane >> 3, cg = lane & 7;
    f32x4 am = {0.f, 0.f, 0.f, 0.f};
#pragma unroll
    for (int i = 0; i < 16; ++i) { *(LAS f32x4*)(scr + (8 * i + r8) * 32 + 4 * cg) = vv[i];
#pragma unroll
        for (int j = 0; j < 4; ++j) am[j] = fmaxf(am[j], fabsf(vv[i][j])); }
    { const int l_ = lane_local();
#pragma unroll
      for (int o = 8; o < 64; o <<= 1)
#pragma unroll
        for (int j = 0; j < 4; ++j) am[j] = fmaxf(am[j], shx(am[j], o, l_)); }
    if (lane < 8) *(LAS f32x4*)(red + wave * 32 + 4 * cg) = am;
    asm volatile("s_waitcnt lgkmcnt(0)" ::: "memory"); __builtin_amdgcn_s_barrier(); asm volatile("" ::: "memory");
    float amax = red[n];
#pragma unroll
    for (int w = 1; w < 8; ++w) amax = fmaxf(amax, red[w * 32 + n]);
    const float q = amax > 0.f ? F8MAX / amax : 0.f;
    const int dr = d.glu ? dst_row<2>(n0 + n) : dst_row<3>(n0 + n);
    if (wave == 0 && lane < 32) d.SC[dr] = amax * (1.0f / F8MAX);
#pragma unroll
    for (int c = 0; c < 4; ++c) { float v[16];
#pragma unroll
        for (int j = 0; j < 16; ++j) v[j] = scr[(kk * 64 + c * 16 + j) * 32 + n] * q;
        v4u o; o.x = pg8::pk4_fp8(v[0], v[1], v[2], v[3]); o.y = pg8::pk4_fp8(v[4], v[5], v[6], v[7]); o.z = pg8::pk4_fp8(v[8], v[9], v[10], v[11]); o.w = pg8::pk4_fp8(v[12], v[13], v[14], v[15]);
        *(LAS v4u*)((LAS unsigned char*)scr + c * 2048 + (n * 2 + kk) * 16) = o; }
#pragma unroll
    for (int i = 0; i < 4; ++i) { const int nn = i * 8 + (lane >> 3), kk2 = (lane >> 2) & 1, c2 = lane & 3;
        const v4u t = *(const LAS v4u*)((const LAS unsigned char*)scr + c2 * 2048 + (nn * 2 + kk2) * 16);
        const int dr2 = d.glu ? dst_row<2>(n0 + nn) : dst_row<3>(n0 + nn);
        *(GAS v4u*)(d.W8 + (size_t)dr2 * 1024 + k0 + kk2 * 64 + c2 * 16) = t; }
    asm volatile("s_waitcnt lgkmcnt(0)" ::: "memory");
}
__device__ __forceinline__ void deferred_strips(const float* w1, const float* w2, unsigned char* ws, LAS unsigned char* lds, int first, int NT, int wave, int lane) {
    constexpr int stride = 1;
    auto stq = [](int idx) { return idx; };
    f32x4 va[16], vb[16]; StripSrc da, db; int idx = first, par = 0;
    if (idx < NT) { dstrip_desc(w1, w2, ws, stq(idx), da); dstrip_issue(da, wave, lane, va); }
#pragma unroll 1
    while (idx < NT) {
        const int i1 = idx + stride; if (i1 < NT) { dstrip_desc(w1, w2, ws, stq(i1), db); dstrip_issue(db, wave, lane, vb); }
        dstrip_finish(da, lds, wave, lane, par, va); par ^= 1;
        if (i1 >= NT) break;
        const int i2 = i1 + stride; if (i2 < NT) { dstrip_desc(w1, w2, ws, stq(i2), da); dstrip_issue(da, wave, lane, va); }
        dstrip_finish(db, lds, wave, lane, par, vb); par ^= 1;
        idx = i2;
    }
    __syncthreads();
}
__device__ __forceinline__ float ln_bound(const float* g, const float* b, int lane) {
    float mg = 0.f, mb = 0.f;
#pragma unroll
    for (int j = 0; j < 4; ++j) { const f32x4 a = *(const f32x4*)(g + j * 256 + lane * 4), c = *(const f32x4*)(b + j * 256 + lane * 4);
        mg = fmaxf(mg, fmaxf(fmaxf(fabsf(a[0]), fabsf(a[1])), fmaxf(fabsf(a[2]), fabsf(a[3])))); mb = fmaxf(mb, fmaxf(fmaxf(fabsf(c[0]), fabsf(c[1])), fmaxf(fabsf(c[2]), fabsf(c[3])))); }
#pragma unroll
    for (int o = 1; o < 64; o <<= 1) { mg = fmaxf(mg, shx(mg, o)); mb = fmaxf(mb, shx(mb, o)); }
    return 31.984371f * mg + mb;
}

struct Ptrs {
    const float *x, *rel_bias, *attn_w_in, *attn_lambda, *attn_subln, *attn_w_out, *conv_w_in, *conv_w, *conv_w_out, *router_w, *router_b, *w1, *b1, *w2, *b2, *ln_g, *ln_b;
    float* out; unsigned char* ws;
};

#ifndef DEFER_W
#define DEFER_W 1
#endif
__device__ __forceinline__ void expert_strip(const Ptrs& P, int st, LAS unsigned char* lds, int wave, int lane) {
    unsigned char* ws = P.ws;
    if (st < 128 * 64) { const int j = st >> 6, r = st & 63; p0_quant_strip<2>(P.w1 + (size_t)j * 1024 * 2048, 2048, ws + WS_W1 + (size_t)j * 2048 * 1024, (float*)(ws + WS_S1) + (size_t)j * 2048, r, lds, wave, lane); }
    else { const int q = st - 128 * 64, j = q >> 5, r = q & 31; p0_quant_strip<3>(P.w2 + (size_t)j * 1024 * 1024, 1024, ws + WS_W2 + (size_t)j * 1024 * 1024, (float*)(ws + WS_S2) + (size_t)j * 1024, r, lds, wave, lane); }
}
constexpr int NWAVES_ = 8;
__device__ __forceinline__ void p0_prologue(const Ptrs& P, LAS unsigned char* lds, int gw, int NGW, int wave, int lane) {
    LAS float* scr = (LAS float*)(lds + RING_OFF + wave * 16384);
    unsigned char* ws = P.ws;
    constexpr int I_OUT = 16 * 32, I_R = 16;
    constexpr int I_IN = 16 * 96;
    constexpr int S1 = NA16 * I_OUT, S3 = S1 + NO16 * I_OUT, S4 = S3 + 4 * I_R, S5 = S4 + NQ16 * I_IN, S6 = S5 + NC16 * I_IN;
    { const int wg = gw / NWAVES_, NWG = NGW / NWAVES_;
      constexpr int T1 = 128 * 64, T2 = T1 + 128 * 32, T3 = T2 + NQ8 * 96, T4 = T3 + NC8 * 96, T5 = T4 + NA8 * 32, T6 = T5 + NO8 * 32;
      constexpr int NE0 = DEFER_W ? 0 : T2;
#pragma unroll 1
      for (int s0 = wg; s0 < NE0 + (T6 - T2); s0 += NWG) {
        const int st = (s0 >= NE0) ? T2 + (s0 - NE0) : s0;
        if (st < T2) expert_strip(P, st, lds, wave, lane);
        else if (st < T3) { const int q = st - T2, j = QJ0 + q / 96, r = q % 96; p0_quant_strip<0, I8P>(P.attn_w_in + (size_t)j * 1024 * 3072, 3072, ws + WS_WAI + (size_t)j * 3072 * 1024, (float*)(ws + WS_SD) + (size_t)j * 3072, r, lds, wave, lane); }
        else if (st < T4) { const int q = st - T3, j = CJ0 + q / 96, r = q % 96; p0_quant_strip<1, I8P>(P.conv_w_in + (size_t)j * 1024 * 3072, 3072, ws + WS_WCI + (size_t)j * 3072 * 1024, (float*)(ws + WS_SD + 32 * 1024) + (size_t)j * 3072, r, lds, wave, lane); }
        else if (st < T5) { const int q = st - T4, j = AJ0 + q / 32, r = q % 32; p0_quant_strip<0>(P.attn_w_out + (size_t)j * 1024 * 1024, 1024, ws + WS_WAO8 + (size_t)j * 1024 * 1024, (float*)(ws + WS_SD + 24 * 1024) + (size_t)j * 1024, r, lds, wave, lane); }
        else { const int q = st - T5, j = OJ0 + q / 32, r = q % 32; p0_quant_strip<0, I8P>(P.conv_w_out + (size_t)j * 1024 * 1024, 1024, ws + WS_WCO8 + (size_t)j * 1024 * 1024, (float*)(ws + WS_SD + 56 * 1024) + (size_t)j * 1024, r, lds, wave, lane); }
      } }
    for (int it = gw; it < S6; it += NGW) {
        if (it >= S5) { const int q = it - S5, j = CK0 + q / I_IN, r = q % I_IN; p0_transpose_item<1>(P.conv_w_in + (size_t)j * 1024 * 3072, 1024, 3072, (bf16_t*)(ws + WS_WC16) + (size_t)j * 3072 * 1024, scr, r, lane); }
        else if (it >= S4) { const int q = it - S4, j = QK0 + q / I_IN, r = q % I_IN; p0_transpose_item<0>(P.attn_w_in + (size_t)j * 1024 * 3072, 1024, 3072, (bf16_t*)(ws + WS_WA16) + (size_t)j * 3072 * 1024, scr, r, lane); }
        else if (it < S1) { const int q = it, j = AK0 + q / I_OUT, r = q % I_OUT; p0_transpose_item<0>(P.attn_w_out + (size_t)j * 1024 * 1024, 1024, 1024, (bf16_t*)(ws + WS_WAO) + (size_t)j * 1024 * 1024, scr, r, lane); }
        else if (it < S3) { const int q = it - S1, j = OK0 + q / I_OUT, r = q % I_OUT; p0_transpose_item<0>(P.conv_w_out + (size_t)j * 1024 * 1024, 1024, 1024, (bf16_t*)(ws + WS_WCO) + (size_t)j * 1024 * 1024, scr, r, lane); }
        else { const int q = it - S3, j = q / I_R, r = q % I_R; p0_transpose_item<0>(P.router_w + (size_t)j * 1024 * 32, 1024, 32, (bf16_t*)(ws + WS_WR) + (size_t)j * 32 * 1024, scr, r, lane, P.ln_g + (size_t)(j * 2 + 0) * D); }
    }
    for (int it = gw; it < DEPTH * 32; it += NGW) { const int L = it >> 5, e = it & 31; const float* g_ = P.ln_g + (size_t)(L * 2) * D; const float* b_ = P.ln_b + (size_t)(L * 2) * D; const float* Wr = P.router_w + (size_t)L * 1024 * 32;
        float a = 0.f, c = 0.f;
#pragma unroll 4
        for (int i = 0; i < 16; ++i) { const int k = lane + 64 * i; const float w = Wr[(size_t)k * 32 + e]; a += bf_lo(cvt_pk_bf16(w * g_[k], 0.f)); c += b_[k] * w; }
        a = wave_sum(a); c = wave_sum(c);
        if (lane == 0) { float* RC = (float*)(ws + WS_RC) + L * 64; RC[e] = a; RC[32 + e] = c + P.router_b[L * 32 + e]; } }
    for (int row = gw; row < M; row += NGW) {
        f32x4 a[2][2]; float am = 0.f;
#pragma unroll
        for (int h = 0; h < 2; ++h)
#pragma unroll
            for (int q = 0; q < 2; ++q) { a[h][q] = *(const GAS f32x4*)(P.x + (size_t)row * D + h * 512 + lane * 8 + q * 4);
                am = fmaxf(am, fmaxf(fmaxf(fabsf(a[h][q][0]), fabsf(a[h][q][1])), fmaxf(fabsf(a[h][q][2]), fabsf(a[h][q][3])))); }
#pragma unroll
        for (int o = 1; o < 64; o <<= 1) am = fmaxf(am, shx(am, o));
        const float qs = QMAXP / fmaxf(am, 1e-30f);
        if ((QM & 1) && lane == 0) ((float*)(ws + WS_RS))[row] = am * (1.0f / QMAXP);
#pragma unroll
        for (int h = 0; h < 2; ++h) { v4u o; o.x = cvt_pk_bf16(a[h][0][0], a[h][0][1]); o.y = cvt_pk_bf16(a[h][0][2], a[h][0][3]); o.z = cvt_pk_bf16(a[h][1][0], a[h][1][1]); o.w = cvt_pk_bf16(a[h][1][2], a[h][1][3]);
            *(GAS v4u*)((bf16_t*)(ws + WS_XB) + (size_t)row * D + h * 512 + lane * 8) = o;
            if (QM & 1) { typedef unsigned u32x2 __attribute__((ext_vector_type(2))); u32x2 q8;
            q8.x = pg8::pkq4<I8P>(a[h][0][0] * qs, a[h][0][1] * qs, a[h][0][2] * qs, a[h][0][3] * qs); q8.y = pg8::pkq4<I8P>(a[h][1][0] * qs, a[h][1][1] * qs, a[h][1][2] * qs, a[h][1][3] * qs);
            *(GAS u32x2*)(ws + WS_XI + (size_t)row * D + h * 512 + lane * 8) = q8; } }
    }
}

__device__ __forceinline__ void conv_phase(const bf16_t* GB, const bf16_t* Z, const float* cw, bf16_t* Gout, float* RS, bool o8, int gw, int NGW, int lane) {
    float w[3][16];
#pragma unroll
    for (int j = 0; j < 3; ++j)
#pragma unroll
        for (int h = 0; h < 2; ++h)
#pragma unroll
            for (int q = 0; q < 2; ++q) { const f32x4 t = *(const f32x4*)(cw + j * D + h * 512 + lane * 8 + q * 4); w[j][h * 8 + q * 4 + 0] = t[0]; w[j][h * 8 + q * 4 + 1] = t[1]; w[j][h * 8 + q * 4 + 2] = t[2]; w[j][h * 8 + q * 4 + 3] = t[3]; }
    for (int run = gw; run < M / 32; run += NGW) {
        const int t0 = run * 32; const bool first = (t0 % SEQ) == 0, lastr = ((t0 + 32) % SEQ) == 0;
        v4u zp[2], zc[2], zn[2];
#pragma unroll
        for (int h = 0; h < 2; ++h) { zp[h] = first ? (v4u){0u, 0u, 0u, 0u} : *(const v4u*)(Z + (size_t)(t0 - 1) * D + h * 512 + lane * 8); zc[h] = *(const v4u*)(Z + (size_t)t0 * D + h * 512 + lane * 8); }
        for (int r = 0; r < 32; ++r) { const int t = t0 + r; const bool pad = lastr && (r == 31);
            float o[2][8];
#pragma unroll
            for (int h = 0; h < 2; ++h) {
                zn[h] = pad ? (v4u){0u, 0u, 0u, 0u} : *(const v4u*)(Z + (size_t)(t + 1) * D + h * 512 + lane * 8);
                const v4u gb = *(const v4u*)(GB + (size_t)t * D + h * 512 + lane * 8);
#pragma unroll
                for (int q = 0; q < 4; ++q) { const unsigned up = zp[h][q], uc = zc[h][q], un = zn[h][q], ug = gb[q]; const int c = h * 8 + q * 2;
                    o[h][q * 2 + 0] = bf_lo(ug) * (w[0][c] * bf_lo(up) + w[1][c] * bf_lo(uc) + w[2][c] * bf_lo(un));
                    o[h][q * 2 + 1] = bf_hi(ug) * (w[0][c + 1] * bf_hi(up) + w[1][c + 1] * bf_hi(uc) + w[2][c + 1] * bf_hi(un)); }
                if (!o8) { v4u ov; ov.x = cvt_pk_bf16(o[h][0], o[h][1]); ov.y = cvt_pk_bf16(o[h][2], o[h][3]); ov.z = cvt_pk_bf16(o[h][4], o[h][5]); ov.w = cvt_pk_bf16(o[h][6], o[h][7]);
                    *(v4u*)(Gout + (size_t)t * D + h * 512 + lane * 8) = ov; }
                zp[h] = zc[h]; zc[h] = zn[h];
            }
            if (o8) { float am = 0.f;
#pragma unroll
                for (int h = 0; h < 2; ++h)
#pragma unroll
                    for (int i = 0; i < 8; ++i) am = fmaxf(am, fabsf(o[h][i]));
#pragma unroll
                for (int s_ = 1; s_ < 64; s_ <<= 1) am = fmaxf(am, shx(am, s_));
                const float qs = QMAXP / fmaxf(am, 1e-30f);
                if (lane == 0) RS[t] = am * (1.0f / QMAXP);
#pragma unroll
                for (int h = 0; h < 2; ++h) { typedef unsigned u32x2 __attribute__((ext_vector_type(2))); u32x2 q8;
                    q8.x = pg8::pkq4<I8P>(o[h][0] * qs, o[h][1] * qs, o[h][2] * qs, o[h][3] * qs); q8.y = pg8::pkq4<I8P>(o[h][4] * qs, o[h][5] * qs, o[h][6] * qs, o[h][7] * qs);
                    *(u32x2*)((unsigned char*)Gout + (size_t)t * D + h * 512 + lane * 8) = q8; } }
        }
    }
}

__device__ __forceinline__ void ln2_phase(const bf16_t* Yp, const float* g1, const float* b1, const unsigned char* Y, const float* g, const float* bta, bf16_t* XB, float* out, unsigned char* XI, float* RS, int gw, int NGW, int lane) {
    float gg[16], bb[16];
#pragma unroll
    for (int h = 0; h < 2; ++h)
#pragma unroll
        for (int q = 0; q < 2; ++q) { const f32x4 t = *(const f32x4*)(g + h * 512 + lane * 8 + q * 4), s = *(const f32x4*)(bta + h * 512 + lane * 8 + q * 4);
#pragma unroll
            for (int i = 0; i < 4; ++i) { gg[h * 8 + q * 4 + i] = t[i]; bb[h * 8 + q * 4 + i] = s[i]; } }
    float sXb = 0.f, rsXb = 0.f; if constexpr (!I8P) { const float lb = ln_bound(g, bta, lane); sXb = F8MAX / lb; rsXb = lb * (1.0f / F8MAX); }
    for (int row = gw; row < M; row += NGW) {
        float v[16];
#pragma unroll
        for (int h = 0; h < 2; ++h) { const v4u xr = *(const v4u*)(Yp + (size_t)row * D + h * 512 + lane * 8);
#pragma unroll
            for (int q = 0; q < 4; ++q) { v[h * 8 + q * 2] = bf_lo(xr[q]); v[h * 8 + q * 2 + 1] = bf_hi(xr[q]); } }
        { float s1 = 0.f;
#pragma unroll
          for (int i = 0; i < 16; ++i) s1 += v[i];
          const float m1 = wave_sum(s1) * (1.f / D); float q1 = 0.f;
#pragma unroll
          for (int i = 0; i < 16; ++i) { v[i] -= m1; q1 += v[i] * v[i]; }
          const float r1 = ALPHA / sqrtf(wave_sum(q1) * (1.f / D) + LN_EPS);
#pragma unroll
          for (int h = 0; h < 2; ++h)
#pragma unroll
            for (int q = 0; q < 2; ++q) { const f32x4 t = *(const f32x4*)(g1 + h * 512 + lane * 8 + q * 4), u = *(const f32x4*)(b1 + h * 512 + lane * 8 + q * 4);
#pragma unroll
              for (int i = 0; i < 4; ++i) v[h * 8 + q * 4 + i] = v[h * 8 + q * 4 + i] * r1 * t[i] + ALPHA * u[i]; } }
#pragma unroll
        for (int k = 0; k < 4; ++k)
#pragma unroll
            for (int h = 0; h < 2; ++h) { typedef unsigned u32x2 __attribute__((ext_vector_type(2))); const u32x2 yr = *(const u32x2*)(Y + ((size_t)row * 4 + k) * D + h * 512 + lane * 8);
#pragma unroll
                for (int q = 0; q < 2; ++q) { const f32x2 lo = __builtin_amdgcn_cvt_pk_f32_fp8((int)yr[q], false), hi2 = __builtin_amdgcn_cvt_pk_f32_fp8((int)yr[q], true);
                    v[h * 8 + q * 4 + 0] += lo[0] * (1.0f / YSCALE); v[h * 8 + q * 4 + 1] += lo[1] * (1.0f / YSCALE); v[h * 8 + q * 4 + 2] += hi2[0] * (1.0f / YSCALE); v[h * 8 + q * 4 + 3] += hi2[1] * (1.0f / YSCALE); } }
        float s = 0.f;
#pragma unroll
        for (int i = 0; i < 16; ++i) s += v[i];
        const float mean = wave_sum(s) * (1.f / D); float s2 = 0.f;
#pragma unroll
        for (int i = 0; i < 16; ++i) { v[i] -= mean; s2 += v[i] * v[i]; }
        const float rstd = 1.f / sqrtf(wave_sum(s2) * (1.f / D) + LN_EPS);
#pragma unroll
        for (int i = 0; i < 16; ++i) v[i] = v[i] * rstd * gg[i] + bb[i];
        float sX = sXb, rsX = rsXb;
        if (I8P && XI) { float am = 0.f;
#pragma unroll
            for (int i = 0; i < 16; ++i) am = fmaxf(am, fabsf(v[i]));
#pragma unroll
            for (int o = 1; o < 64; o <<= 1) am = fmaxf(am, shx(am, o));
            sX = QMAXP / fmaxf(am, 1e-30f); rsX = am * (1.0f / QMAXP); }
#pragma unroll
        for (int h = 0; h < 2; ++h) { v4u ov; ov.x = cvt_pk_bf16(v[h * 8 + 0], v[h * 8 + 1]); ov.y = cvt_pk_bf16(v[h * 8 + 2], v[h * 8 + 3]); ov.z = cvt_pk_bf16(v[h * 8 + 4], v[h * 8 + 5]); ov.w = cvt_pk_bf16(v[h * 8 + 6], v[h * 8 + 7]);
            if (!out) *(v4u*)(XB + (size_t)row * D + h * 512 + lane * 8) = ov;
            if (XI) { typedef unsigned u32x2 __attribute__((ext_vector_type(2))); u32x2 q8; q8.x = pg8::pkq4<I8P>(v[h * 8 + 0] * sX, v[h * 8 + 1] * sX, v[h * 8 + 2] * sX, v[h * 8 + 3] * sX); q8.y = pg8::pkq4<I8P>(v[h * 8 + 4] * sX, v[h * 8 + 5] * sX, v[h * 8 + 6] * sX, v[h * 8 + 7] * sX);
                *(u32x2*)(XI + (size_t)row * D + h * 512 + lane * 8) = q8; if (h == 0 && lane == 0) RS[row] = rsX; }
            if (out) { *(f32x4*)(out + (size_t)row * D + h * 512 + lane * 8) = (f32x4){v[h * 8 + 0], v[h * 8 + 1], v[h * 8 + 2], v[h * 8 + 3]};
                       *(f32x4*)(out + (size_t)row * D + h * 512 + lane * 8 + 4) = (f32x4){v[h * 8 + 4], v[h * 8 + 5], v[h * 8 + 6], v[h * 8 + 7]}; } }
    }
}

constexpr int RT_PITCH = 2064, R_OFF_G = 32 * RT_PITCH, R_OFF_LG = R_OFF_G + 8192, R_OFF_CNT = R_OFF_LG + 8 * 16 * 33 * 4, R_OFF_SW = R_OFF_CNT + 256, R_LDS = R_OFF_SW + 256;
typedef __bf16 bf16x2_t __attribute__((ext_vector_type(2)));
__device__ __forceinline__ void router_phase(const bf16_t* Yp, const float* g, const float* bta, const bf16_t* RTg, const float* Wr, const float* rb, unsigned char* X8, int* lslot, float* lgate, unsigned* cnt,
                                             char* lds, int blk0, int G, int tid, int wave, int lane, const float* rc) {
    for (int i = tid; i < 32 * 128; i += 512) { const int e = i >> 7, c = i & 127; *(v4u*)(lds + e * RT_PITCH + c * 16) = *(const v4u*)(RTg + (size_t)e * 1024 + c * 8); }
    float* gl = (float*)(lds + R_OFF_G); float* bl = gl + 1024;
    for (int i = tid; i < 1024; i += 512) { gl[i] = g[i]; bl[i] = bta[i]; }
    float* LG = (float*)(lds + R_OFF_LG) + wave * (16 * 33);
    int* lcnt = (int*)(lds + R_OFF_CNT); int* lbase = lcnt + 32;
    float* sWl = (float*)(lds + R_OFF_SW); float* cBl = sWl + 32;
    __syncthreads();
    if (tid < 64) sWl[tid] = rc[tid];
    const int t16 = lane & 15, kq = lane >> 4;
    const float sA = F8MAX / ln_bound(g, bta, lane);
#pragma unroll 1
    for (int blk = blk0; blk < M / 128; blk += G) {
        if (tid < 32) lcnt[tid] = 0;
        __syncthreads();
        int my_e, my_rank, my_slot; float my_gate;
        const int r0 = blk * 128 + wave * 16; const size_t rowoff = (size_t)(r0 + t16) * D + kq * 8;
        v4u yv[32];
#pragma unroll
        for (int kb = 0; kb < 32; ++kb) yv[kb] = *(const v4u*)(Yp + rowoff + kb * 32);
        f32x4 acc0 = {0.f, 0.f, 0.f, 0.f}, acc1 = {0.f, 0.f, 0.f, 0.f}, accs = {0.f, 0.f, 0.f, 0.f}, accq = {0.f, 0.f, 0.f, 0.f};
        const bf16x8 ones8 = {(short)0x3F80, (short)0x3F80, (short)0x3F80, (short)0x3F80, (short)0x3F80, (short)0x3F80, (short)0x3F80, (short)0x3F80};
#pragma unroll
        for (int kb = 0; kb < 32; ++kb) { const int c0 = kb * 32 + kq * 8;
            const bf16x8 w0 = *(const bf16x8*)(lds + t16 * RT_PITCH + c0 * 2), w1 = *(const bf16x8*)(lds + (16 + t16) * RT_PITCH + c0 * 2);
            const bf16x8 xb = __builtin_bit_cast(bf16x8, yv[kb]);
            acc0 = __builtin_amdgcn_mfma_f32_16x16x32_bf16(w0, xb, acc0, 0, 0, 0);
            acc1 = __builtin_amdgcn_mfma_f32_16x16x32_bf16(w1, xb, acc1, 0, 0, 0);
            accs = __builtin_amdgcn_mfma_f32_16x16x32_bf16(ones8, xb, accs, 0, 0, 0);
            accq = __builtin_amdgcn_mfma_f32_16x16x32_bf16(xb, xb, accq, 0, 0, 0); }
        const float s = accs[0];
        const int dsel = t16 & 3; float dq_ = dsel == 0 ? accq[0] : (dsel == 1 ? accq[1] : (dsel == 2 ? accq[2] : accq[3]));
        const float s2 = __int_as_float(__builtin_amdgcn_ds_bpermute(((t16 >> 2) * 16 + t16) << 2, __float_as_int(dq_)));
        const float mean = s * (1.f / D); const float var = fmaxf(s2 * (1.f / D) - mean * mean, 0.f);
        const float rstd = 1.f / sqrtf(var + LN_EPS);
        {
            float* lgr = LG + t16 * 33;
#pragma unroll
            for (int i = 0; i < 4; ++i) { const int e0 = kq * 4 + i, e1 = 16 + kq * 4 + i;
                lgr[e0] = rstd * (acc0[i] - mean * sWl[e0]) + cBl[e0]; lgr[e1] = rstd * (acc1[i] - mean * sWl[e1]) + cBl[e1]; }
            LDS_WAIT(); asm volatile("" ::: "memory");
            float t0 = -INFINITY, t1 = -INFINITY, t2 = -INFINITY, t3 = -INFINITY; int i0 = 0, i1 = 0, i2 = 0, i3 = 0;
#pragma unroll
            for (int e = 0; e < 32; ++e) { const float v = lgr[e];
                const bool c0 = v > t0, c1 = v > t1, c2 = v > t2, c3 = v > t3;
                t3 = c2 ? t2 : (c3 ? v : t3); i3 = c2 ? i2 : (c3 ? e : i3);
                t2 = c1 ? t1 : (c2 ? v : t2); i2 = c1 ? i1 : (c2 ? e : i2);
                t1 = c0 ? t0 : (c1 ? v : t1); i1 = c0 ? i0 : (c1 ? e : i1);
                t0 = c0 ? v : t0; i0 = c0 ? e : i0; }
            const float e1 = __expf(t1 - t0), e2 = __expf(t2 - t0), e3 = __expf(t3 - t0); const float inv = 1.f / (1.f + e1 + e2 + e3);
            const int ek = kq == 0 ? i0 : (kq == 1 ? i1 : (kq == 2 ? i2 : i3)); const float gk = (kq == 0 ? 1.f : (kq == 1 ? e1 : (kq == 2 ? e2 : e3))) * inv;
            my_e = ek; my_gate = gk; my_slot = (r0 + t16) * 4 + kq; my_rank = atomicAdd(&lcnt[ek], 1);
            LDS_WAIT(); asm volatile("" ::: "memory");
        }
        const float rs = rstd * sA;
#pragma unroll
        for (int kb = 0; kb < 32; ++kb) { const int c0 = kb * 32 + kq * 8; const v4u y = yv[kb];
            const f32x4 g0 = *(const f32x4*)(gl + c0) * rs, g1 = *(const f32x4*)(gl + c0 + 4) * rs, b0 = *(const f32x4*)(bl + c0) * sA, b1 = *(const f32x4*)(bl + c0 + 4) * sA;
            typedef unsigned u32x2 __attribute__((ext_vector_type(2))); u32x2 q8;
            q8.x = pg8::pk4_fp8((bf_lo(y.x) - mean) * g0[0] + b0[0], (bf_hi(y.x) - mean) * g0[1] + b0[1], (bf_lo(y.y) - mean) * g0[2] + b0[2], (bf_hi(y.y) - mean) * g0[3] + b0[3]);
            q8.y = pg8::pk4_fp8((bf_lo(y.z) - mean) * g1[0] + b1[0], (bf_hi(y.z) - mean) * g1[1] + b1[1], (bf_lo(y.w) - mean) * g1[2] + b1[2], (bf_hi(y.w) - mean) * g1[3] + b1[3]);
            *(u32x2*)(X8 + rowoff + kb * 32) = q8;
            asm volatile("" ::: "memory"); }
        __syncthreads();
        if (tid < 32) lbase[tid] = (int)__hip_atomic_fetch_add(cnt + tid * 64, (unsigned)lcnt[tid], RLX_AGENT);
        __syncthreads();
        { const int pos = lbase[my_e] + my_rank; lslot[(size_t)my_e * LCAP + pos] = my_slot; lgate[(size_t)my_e * LCAP + pos] = my_gate; }
        __syncthreads();
    }
}

__device__ __forceinline__ float attn_obound(const float* gsub, float osc, int lane) {
    float mg = fmaxf(fabsf(gsub[lane]), fabsf(gsub[64 + lane]));
#pragma unroll
    for (int o = 1; o < 64; o <<= 1) mg = fmaxf(mg, shx(mg, o));
    return 11.3137085f * mg * fabsf(osc);
}

constexpr int NWAVES = 8;
constexpr int N_PHASES = 1 + DEPTH * 7;
#ifndef REP_ATTN
#define REP_ATTN 1
#endif
#ifndef KREP_MOE
#define KREP_MOE 1
#endif
#ifndef REP_MOE
#define REP_MOE 1
#endif
#ifndef REP_P0
#define REP_P0 1
#endif
#ifndef REP_THIN
#define REP_THIN 1
#endif
#ifndef REP_DENSE
#define REP_DENSE 1
#endif
#ifndef MK_SPLIT
#define MK_SPLIT 0
#endif
struct Args { const float* in[17]; float* out; unsigned char* ws; int ph_lo, ph_hi, li, pad; };
typedef const __attribute__((address_space(4))) Args* ArgsP;
enum { I_X = 0, I_RELB, I_AWIN, I_ALAM, I_ASUB, I_AWOUT, I_CWIN, I_CW, I_CWOUT, I_RW, I_RB, I_W1, I_B1, I_W2, I_B2, I_LNG, I_LNB };
__global__ void __launch_bounds__(NWAVES * 64, 2) mk_fwd(Args args) {
    extern __shared__ __attribute__((aligned(16))) unsigned char lds[];
    LAS unsigned char* ldsl = (LAS unsigned char*)lds;
    volatile LAS unsigned* MISC = (volatile LAS unsigned*)(ldsl + MISC_OFF);
    const int tid0 = threadIdx.x;
    const int wave0 = __builtin_amdgcn_readfirstlane(tid0 >> 6);
    const int G0 = gridDim.x, bx0 = blockIdx.x;
#define PHASE_BEGIN() int wv_ = wave0; asm volatile("" : "+s"(wv_)); int ln_; asm volatile("v_mbcnt_lo_u32_b32 %0, -1, 0\n\tv_mbcnt_hi_u32_b32 %0, -1, %0" : "=v"(ln_)); int tid = wv_ * 64 + ln_; int G = G0, bx = bx0; asm volatile("" : "+s"(G), "+s"(bx)); const int vcu = (G % 8 == 0) ? (bx % 8) * (G / 8) + bx / 8 : bx; const int NGW = G * NWAVES; \
        const int lane = tid & 63, wave = __builtin_amdgcn_readfirstlane(tid >> 6); const int gw = vcu * NWAVES + wave; (void)lane; (void)gw; (void)NGW; \
        ArgsP ap = (ArgsP)__builtin_amdgcn_kernarg_segment_ptr(); asm volatile("" : "+s"(ap)); unsigned char* ws = ap->ws; gu32* ctl = (gu32*)(ws + WS_CTL); (void)ctl
    for (int u = tid0; u < (LDS_BYTES - LDSCTL_OFF) / 4; u += NWAVES * 64) ((LAS unsigned*)(ldsl + LDSCTL_OFF))[u] = 0u;
    __syncthreads();
    XcdBarrier bar = xcd_barrier_post((unsigned*)(args.ws + WS_CTL) + CW_BAR + (size_t)args.li * 4096, MISC + 8);
    const int lo = args.ph_lo, hi = args.ph_hi;
#define IN(k) (lo <= (k) && (k) < hi)
#define SEAM(k) do { if (IN((k) + 1)) xcd_barrier(bar); } while (0)
    LAS int* tb = (LAS int*)(ldsl + LDSCTL_OFF); LAS int* cn = tb + 64;

    if (IN(0)) { PHASE_BEGIN();
        Ptrs P; P.x = ap->in[I_X]; P.attn_w_in = ap->in[I_AWIN]; P.attn_w_out = ap->in[I_AWOUT]; P.conv_w_in = ap->in[I_CWIN]; P.conv_w_out = ap->in[I_CWOUT]; P.router_w = ap->in[I_RW]; P.router_b = ap->in[I_RB]; P.ln_g = ap->in[I_LNG]; P.ln_b = ap->in[I_LNB]; P.w1 = ap->in[I_W1]; P.w2 = ap->in[I_W2]; P.ws = ws;
        _Pragma("unroll 1") for (int rep = 0; rep < REP_P0; ++rep) p0_prologue(P, ldsl, gw, NGW, wave, lane); SEAM(0); }

#define MOE_GEMMS(L, pb) do { \
            if (IN((pb) + 4)) { PHASE_BEGIN(); \
                pg8::MoeProb<true, true> S{(const char*)(ws + WS_X8), (const char*)(ws + WS_W1) + (size_t)(L) * 32 * 2048 * 1024, (size_t)2048 * 1024, 8, G, vcu, (int)tb[32], tb, cn, (const int*)(ws + WS_LS), lane, tid}; \
                pg8::EpiMoe1 E{ws + WS_A2, ap->in[I_B1] + (size_t)(L) * 32 * 2048, (const float*)(ws + WS_S1) + (size_t)(L) * 32 * 2048, ln_bound(ap->in[I_LNG] + ((L) * 2 + 0) * D, ap->in[I_LNB] + ((L) * 2 + 0) * D, lane) * (1.0f / F8MAX) * (1.0f / KREP_MOE)}; \
                pg8::gemm_phase<pg8::MoeProb<true, true>, pg8::EpiMoe1, true, true, KREP_MOE>(ldsl + RING_OFF, ldsl + XL_OFF, S, E); \
                SEAM((pb) + 4); \
            } \
            if (IN((pb) + 5)) { PHASE_BEGIN(); \
                pg8::MoeProb<false, true> S{(const char*)(ws + WS_A2), (const char*)(ws + WS_W2) + (size_t)(L) * 32 * 1024 * 1024, (size_t)1024 * 1024, 4, G, vcu, (int)tb[32], tb, cn, (const int*)(ws + WS_LS), lane, tid}; \
                pg8::EpiMoe2 E{ws + WS_Y, ap->in[I_B2] + (size_t)(L) * 32 * 1024, (const float*)(ws + WS_S2) + (size_t)(L) * 32 * 1024, (const int*)(ws + WS_LS), (const float*)(ws + WS_LG)}; \
                pg8::gemm_phase<pg8::MoeProb<false, true>, pg8::EpiMoe2, true, true, KREP_MOE>(ldsl + RING_OFF, ldsl + XL_OFF, S, E); \
                SEAM((pb) + 5); \
            } \
        } while (0)
#if REP_MOE == 2
#define MOE_GEMMS_REP(L, pb) MOE_GEMMS(L, pb)
#else
#define MOE_GEMMS_REP(L, pb) do {} while (0)
#endif
#define MOE_HALF(L, pb) do { \
            if (IN((pb) + 3)) { PHASE_BEGIN(); \
                router_phase((const bf16_t*)(ws + WS_YP), ap->in[I_LNG] + ((L) * 2 + 0) * D, ap->in[I_LNB] + ((L) * 2 + 0) * D, (const bf16_t*)(ws + WS_WR) + (size_t)(L) * 32 * 1024, ap->in[I_RW] + (size_t)(L) * 1024 * 32, ap->in[I_RB] + (L) * 32, \
                             ws + WS_X8, (int*)(ws + WS_LS), (float*)(ws + WS_LG), (unsigned*)(ctl + CW_CNT) + (L) * 32 * 64, (char*)lds + RING_OFF, vcu, G, tid, wave, lane, (const float*)(ws + WS_RC) + (L) * 64); \
                SEAM((pb) + 3); \
            } \
            if (IN((pb) + 4) || IN((pb) + 5)) { PHASE_BEGIN(); \
                if (tid < 64) { const int c_ = (lane < 32) ? (int)__hip_atomic_load(ctl + CW_CNT + ((L) * 32 + (lane & 31)) * 64, RLX_AGENT) : 0; const int t_ = (c_ + 255) >> 8; int p_ = t_; \
                    _Pragma("unroll") for (int o_ = 1; o_ < 32; o_ <<= 1) { const int q_ = __builtin_amdgcn_ds_bpermute((lane - o_) * 4, p_); if (lane >= o_) p_ += q_; } \
                    if (lane < 32) { cn[lane] = c_; tb[lane + 1] = p_; } if (lane == 0) tb[0] = 0; } \
                __syncthreads(); \
            } \
            MOE_GEMMS(L, pb); MOE_GEMMS_REP(L, pb); \
            if (REP_THIN == 2 && IN((pb) + 6)) { PHASE_BEGIN(); \
                ln2_phase((const bf16_t*)(ws + WS_YP), ap->in[I_LNG] + ((L) * 2 + 0) * D, ap->in[I_LNB] + ((L) * 2 + 0) * D, (const unsigned char*)(ws + WS_Y), ap->in[I_LNG] + ((L) * 2 + 1) * D, ap->in[I_LNB] + ((L) * 2 + 1) * D, (bf16_t*)(ws + WS_XB), ((L) == DEPTH - 1) ? ap->out : nullptr, ((((L) == 0) && (CM & 1)) || (((L) == 1) && (QM & 2)) || (((L) == 2) && (CM & 2))) ? ws + WS_XI : nullptr, (float*)(ws + WS_RS), gw, NGW, lane); \
            } \
            if (IN((pb) + 6)) { PHASE_BEGIN(); \
                ln2_phase((const bf16_t*)(ws + WS_YP), ap->in[I_LNG] + ((L) * 2 + 0) * D, ap->in[I_LNB] + ((L) * 2 + 0) * D, (const unsigned char*)(ws + WS_Y), ap->in[I_LNG] + ((L) * 2 + 1) * D, ap->in[I_LNB] + ((L) * 2 + 1) * D, (bf16_t*)(ws + WS_XB), ((L) == DEPTH - 1) ? ap->out : nullptr, ((((L) == 0) && (CM & 1)) || (((L) == 1) && (QM & 2)) || (((L) == 2) && (CM & 2))) ? ws + WS_XI : nullptr, (float*)(ws + WS_RS), gw, NGW, lane); \
                if ((pb) + 7 < N_PHASES) SEAM((pb) + 6); \
            } \
        } while (0)

#pragma unroll 1
    for (int lp = 0; lp < DEPTH / 2; ++lp) {
        {
            const int L = 2 * lp, pb = 1 + L * 7;
            if (IN(pb + 0)) {
                PHASE_BEGIN();
                if (QM == 3 || (QM != 0 && ((QM >> lp) & 1))) {
                pg8::DenseProbT<true> S; S.init(ws + WS_XI, ws + WS_WAI + (size_t)lp * 3072 * 1024, M, 3072, G, bx, tid);
                pg8::EpiQKV8 E{(bf16_t*)(ws + WS_Q), (size_t)(WS_K - WS_Q) / 2, QSCALE, (const float*)(ws + WS_SD) + lp * 3072, (const float*)(ws + WS_RS)};
                pg8::gemm_phase<pg8::DenseProbT<true>, pg8::EpiQKV8, true, true, 1, I8P>(ldsl + RING_OFF, ldsl + XL_OFF, S, E);
                } else {
                pg8::DenseProb S; S.init(ws + WS_XB, (const bf16_t*)(ws + WS_WA16) + (size_t)lp * 3072 * 1024, M, 3072, G, bx, tid);
                pg8::EpiQKV E{(bf16_t*)(ws + WS_Q), (size_t)(WS_K - WS_Q) / 2, QSCALE};
                pg8::gemm_phase<pg8::DenseProb, pg8::EpiQKV, true>(ldsl + RING_OFF, ldsl + XL_OFF, S, E);
                }
                SEAM(pb + 0);
            }
            if (IN(pb + 1)) {
                PHASE_BEGIN();
                const float* lf = ap->in[I_ALAM] + lp * 256;
                const float s1 = wave_sum(lf[lane] * lf[64 + lane]), s2 = wave_sum(lf[128 + lane] * lf[192 + lane]);
                const float lam_init = (lp == 0) ? 0.2f : (0.8f - 0.6f * 0.54881163609402643f);
                const float lam = __expf(s1) - __expf(s2) + lam_init;
                const bool o8 = (AOM == 3) || (AOM != 0 && ((AOM >> lp) & 1));
                const float oscl = o8 ? (1.0f - lam_init) * (F8MAX / attn_obound(ap->in[I_ASUB] + lp * 128, 1.0f - lam_init, lane)) : (1.0f - lam_init);
                int hprev = -1; bool strips_done = !(DEFER_W && lp == 0);
#pragma unroll 1
                for (int rep = 0; rep < REP_ATTN; ++rep)
#pragma unroll 1
                for (int i = 0; i < (BATCH * NH * 32) / 256; ++i) {
                    const int item = i * G + vcu;
                    if (item >= BATCH * NH * 32) break;
                    const int bh = item >> 5, qb = item & 31;
                    const bool newh = (i == 0) || ((bh & 7) != hprev); hprev = bh & 7;
                    att::attn_unit(bh >> 3, bh & 7, qb, (const bf16_t*)(ws + WS_Q), (const bf16_t*)(ws + WS_K), (const bf16_t*)(ws + WS_V), (bf16_t*)(ws + WS_O), lam, oscl,
                                   ap->in[I_ASUB] + lp * 128, ap->in[I_RELB], (char*)lds + RING_OFF, tid, newh, o8);
                    if (!strips_done && i == (vcu & 15)) { strips_done = true;
                        Ptrs P; P.w1 = ap->in[I_W1]; P.w2 = ap->in[I_W2]; P.ws = ws;
                        int ln_s = lane; asm volatile("" : "+v"(ln_s));
                        { const int per_ = (128 * 96 + G - 1) / G, f_ = vcu * per_, e_ = (f_ + per_ < 128 * 96) ? f_ + per_ : 128 * 96; deferred_strips(P.w1, P.w2, ws, ldsl, f_, e_, wave, ln_s); }
                        hprev = -1;
                    }
                }
                if (!strips_done) { int ln_s = lane; asm volatile("" : "+v"(ln_s)); const int per_ = (128 * 96 + G - 1) / G, f_ = vcu * per_, e_ = (f_ + per_ < 128 * 96) ? f_ + per_ : 128 * 96; deferred_strips(ap->in[I_W1], ap->in[I_W2], ws, ldsl, f_, e_, wave, ln_s); }
                SEAM(pb + 1);
            }
            if (IN(pb + 2)) {
                PHASE_BEGIN();
                if ((AOM == 3) || (AOM != 0 && ((AOM >> lp) & 1))) {
                const float lam_init = (lp == 0) ? 0.2f : (0.8f - 0.6f * 0.54881163609402643f);
                pg8::DenseProbT<true> S; S.init(ws + WS_O, ws + WS_WAO8 + (size_t)lp * 1024 * 1024, M, 1024, G, bx, tid);
                pg8::EpiResid8<false> E{(const bf16_t*)(ws + WS_XB), (bf16_t*)(ws + WS_YP), (const float*)(ws + WS_SD + 24 * 1024) + lp * 1024, nullptr, attn_obound(ap->in[I_ASUB] + lp * 128, 1.0f - lam_init, lane) * (1.0f / F8MAX)};
                pg8::gemm_phase<pg8::DenseProbT<true>, pg8::EpiResid8<false>, true, true>(ldsl + RING_OFF, ldsl + XL_OFF, S, E);
                } else {
                pg8::DenseProb S; S.init(ws + WS_O, (const bf16_t*)(ws + WS_WAO) + (size_t)lp * 1024 * 1024, M, 1024, G, bx, tid);
                pg8::EpiResid E{(const bf16_t*)(ws + WS_XB), (bf16_t*)(ws + WS_YP)};
                pg8::gemm_phase<pg8::DenseProb, pg8::EpiResid, true>(ldsl + RING_OFF, ldsl + XL_OFF, S, E);
                }
                SEAM(pb + 2);
            }
            MOE_HALF(L, pb);
        }
        {
            const int L = 2 * lp + 1, pb = 1 + L * 7;
            if (IN(pb + 0)) {
                PHASE_BEGIN();
                if (CM == 3 || (CM != 0 && ((CM >> lp) & 1))) {
                pg8::DenseProbT<true> S; S.init(ws + WS_XI, ws + WS_WCI + (size_t)lp * 3072 * 1024, M, 3072, G, bx, tid);
                pg8::EpiConvIn8 E{(bf16_t*)(ws + WS_Q), (bf16_t*)(ws + WS_K), (const float*)(ws + WS_SD + 32 * 1024) + lp * 3072, (const float*)(ws + WS_RS)};
                pg8::gemm_phase<pg8::DenseProbT<true>, pg8::EpiConvIn8, true, true, 1, I8P>(ldsl + RING_OFF, ldsl + XL_OFF, S, E);
                } else {
                pg8::DenseProb S; S.init(ws + WS_XB, (const bf16_t*)(ws + WS_WC16) + (size_t)lp * 3072 * 1024, M, 3072, G, bx, tid);
                pg8::EpiConvIn E{(bf16_t*)(ws + WS_Q), (bf16_t*)(ws + WS_K)};
                pg8::gemm_phase<pg8::DenseProb, pg8::EpiConvIn, true>(ldsl + RING_OFF, ldsl + XL_OFF, S, E);
                }
                SEAM(pb + 0);
            }
            if (IN(pb + 1)) { PHASE_BEGIN(); conv_phase((const bf16_t*)(ws + WS_Q), (const bf16_t*)(ws + WS_K), ap->in[I_CW] + lp * 3 * D, (bf16_t*)(ws + WS_O), (float*)(ws + WS_RS), (COM == 3) || (COM != 0 && ((COM >> lp) & 1)), gw, NGW, lane); SEAM(pb + 1); }
            if (IN(pb + 2)) {
                PHASE_BEGIN();
                if ((COM == 3) || (COM != 0 && ((COM >> lp) & 1))) {
                pg8::DenseProbT<true> S; S.init(ws + WS_O, ws + WS_WCO8 + (size_t)lp * 1024 * 1024, M, 1024, G, bx, tid);
                pg8::EpiResid8<true> E{(const bf16_t*)(ws + WS_XB), (bf16_t*)(ws + WS_YP), (const float*)(ws + WS_SD + 56 * 1024) + lp * 1024, (const float*)(ws + WS_RS), 1.0f};
                pg8::gemm_phase<pg8::DenseProbT<true>, pg8::EpiResid8<true>, true, true, 1, I8P>(ldsl + RING_OFF, ldsl + XL_OFF, S, E);
                } else {
                pg8::DenseProb S; S.init(ws + WS_O, (const bf16_t*)(ws + WS_WCO) + (size_t)lp * 1024 * 1024, M, 1024, G, bx, tid);
                pg8::EpiResid E{(const bf16_t*)(ws + WS_XB), (bf16_t*)(ws + WS_YP)};
                pg8::gemm_phase<pg8::DenseProb, pg8::EpiResid, true>(ldsl + RING_OFF, ldsl + XL_OFF, S, E);
                }
                SEAM(pb + 2);
            }
            MOE_HALF(L, pb);
        }
    }
#undef IN
#undef SEAM
}

extern "C" void kernel_launch(void* const* d_in, const int* in_sizes, int n_in, void* d_out, int out_size, void* d_ws, size_t ws_size, hipStream_t stream) {
    static int grid = 0;
    if (grid == 0) {
        if (n_in != 17 || in_sizes[0] != M * D || out_size != M * D || ws_size < WS_END) {
            fprintf(stderr, "kernel_launch: shape mismatch: n_in %d in0 %d out %d ws %zu (need %zu)\n", n_in, n_in > 0 ? in_sizes[0] : -1, out_size, ws_size, (size_t)WS_END); grid = -1; return; }
        int dev = 0, cus = 0, per_cu = 0;
        if (hipGetDevice(&dev) != hipSuccess || hipDeviceGetAttribute(&cus, hipDeviceAttributeMultiprocessorCount, dev) != hipSuccess) { grid = -1; return; }
        if (hipFuncSetAttribute((const void*)mk_fwd, hipFuncAttributeMaxDynamicSharedMemorySize, LDS_BYTES) != hipSuccess) { fprintf(stderr, "kernel_launch: hipFuncSetAttribute failed\n"); grid = -1; return; }
        if (hipOccupancyMaxActiveBlocksPerMultiprocessor(&per_cu, (const void*)mk_fwd, NWAVES * 64, LDS_BYTES) != hipSuccess || per_cu < 1)
            fprintf(stderr, "kernel_launch: occupancy query reports %d workgroups per CU\n", per_cu);
        (void)hipGetLastError();
        grid = cus;
    }
    if (grid < 0) return;
    if (hipMemsetAsync((char*)d_ws + WS_CTL, 0, CTL_ZERO_BYTES, stream) != hipSuccess) { fprintf(stderr, "kernel_launch: memset failed\n"); return; }
    Args a{};
    for (int i = 0; i < 17; ++i) a.in[i] = (const float*)d_in[i];
    a.out = (float*)d_out; a.ws = (unsigned char*)d_ws; a.pad = 0;
#if MK_SPLIT
    for (int p = 0; p < N_PHASES; ++p) { a.ph_lo = p; a.ph_hi = p + 1; a.li = p; hipLaunchKernelGGL(mk_fwd, dim3(grid), dim3(NWAVES * 64), LDS_BYTES, stream, a); }
#else
    a.ph_lo = 0; a.ph_hi = N_PHASES; a.li = 0;
    hipLaunchKernelGGL(mk_fwd, dim3(grid), dim3(NWAVES * 64), LDS_BYTES, stream, a);
#endif
    const hipError_t le = hipPeekAtLastError();
    if (le != hipSuccess) fprintf(stderr, "kernel_launch: launch failed: %s\n", hipGetErrorName(le));
}
```
